# Optimizing an MI355X kernel written in HIP

```python
import math
import jax
import jax.numpy as jnp
from jax import lax
import numpy as np


D_MODEL = 1024
BATCH = 8
SEQ = 2048
DEPTH = 1

MIX_WIDTH = D_MODEL
MLA_HEADS = 8
MLA_NOPE_DIM = 64
MLA_ROPE_DIM = 32
MLA_V_DIM = MIX_WIDTH // 2 // MLA_HEADS
MLA_Q_RANK = D_MODEL // 4
MLA_KV_RANK = D_MODEL // 8
ROPE_BASE = 10000.0
DIFF_HEADS = 4
DIFF_HEAD_DIM = MIX_WIDTH // 4 // DIFF_HEADS
DIFF_V_DIM = 2 * DIFF_HEAD_DIM
N_IN = MLA_Q_RANK + MLA_KV_RANK + MLA_ROPE_DIM + 3 * DIFF_HEADS * DIFF_V_DIM
N_EXPERTS = 256
TOP_K = 8
N_GROUPS = 8
TOPK_GROUPS = 4
EXPERT_DIM = D_MODEL // 4
SHARED_DIM = D_MODEL // 4
ROUTED_SCALE = 2.5
MOE_BLOCK = 128
Q_BLOCK = 128
NORM_EPS = 1e-6
SUBLN_EPS = 1e-5
NEG_INF = -1e30
MAX_POS_OFFSET = 1024

kernel_name = 'hybrid_mla_diffattn_moe_block'


def _rms_norm(x, g, eps=NORM_EPS):
    xf = x.astype(jnp.float32)
    y = xf * lax.rsqrt(jnp.mean(xf * xf, axis=-1, keepdims=True) + eps)
    return (y * g.astype(jnp.float32)).astype(x.dtype)


def _rope_cos_sin(positions, dim, dtype):
    inv = 1.0 / (ROPE_BASE ** (jnp.arange(0, dim, 2, dtype=jnp.float32) / dim))
    ang = positions.astype(jnp.float32)[..., None] * inv
    return jnp.cos(ang).astype(dtype), jnp.sin(ang).astype(dtype)


def _rotate(x, cos, sin):
    x1, x2 = jnp.split(x, 2, axis=-1)
    return jnp.concatenate([x1 * cos - x2 * sin, x2 * cos + x1 * sin], axis=-1)


def _causal_mask(q0, seq):
    q_idx = q0 + jnp.arange(Q_BLOCK)
    k_idx = jnp.arange(seq)
    return q_idx[:, None] >= k_idx[None, :]


def _sweep_query_blocks(block_fn, seq):
    out = lax.map(block_fn, jnp.arange(seq // Q_BLOCK))
    nb, b, h, qb, dv = out.shape
    return out.transpose(1, 2, 0, 3, 4).reshape(b, h, nb * qb, dv)


def _mla(cq, ckv, k_rope, positions, q_norm_g, kv_norm_g, w_uq, w_ukv):
    B, S, _ = cq.shape
    q = jnp.einsum('bsr,rhd->bhsd', _rms_norm(cq, q_norm_g), w_uq)
    kv = jnp.einsum('bsr,rhd->bhsd', _rms_norm(ckv, kv_norm_g), w_ukv)
    q_nope, q_rope = q[..., :MLA_NOPE_DIM], q[..., MLA_NOPE_DIM:]
    k_nope, v = kv[..., :MLA_NOPE_DIM], kv[..., MLA_NOPE_DIM:]
    cos, sin = _rope_cos_sin(positions, MLA_ROPE_DIM, cq.dtype)
    q_rope = _rotate(q_rope, cos[:, None], sin[:, None])
    k_rope = _rotate(k_rope, cos, sin)
    scale = 1.0 / math.sqrt(MLA_NOPE_DIM + MLA_ROPE_DIM)

    def block(i):
        q0 = i * Q_BLOCK
        qn = lax.dynamic_slice_in_dim(q_nope, q0, Q_BLOCK, axis=2)
        qr = lax.dynamic_slice_in_dim(q_rope, q0, Q_BLOCK, axis=2)
        s = (jnp.einsum('bhqd,bhkd->bhqk', qn, k_nope)
             + jnp.einsum('bhqd,bkd->bhqk', qr, k_rope)).astype(jnp.float32) * scale
        s = jnp.where(_causal_mask(q0, S), s, NEG_INF)
        p = jax.nn.softmax(s, axis=-1).astype(v.dtype)
        return jnp.einsum('bhqk,bhkd->bhqd', p, v)

    o = _sweep_query_blocks(block, S)
    return o.transpose(0, 2, 1, 3).reshape(B, S, MLA_HEADS * MLA_V_DIM)


def _diff_attention(dq, dk, dv, positions, lam_q1, lam_k1, lam_q2, lam_k2, subln_g, lambda_init):
    B, S, _ = dq.shape
    q = dq.reshape(B, S, DIFF_HEADS, 2, DIFF_HEAD_DIM).transpose(0, 2, 3, 1, 4)
    k = dk.reshape(B, S, DIFF_HEADS, 2, DIFF_HEAD_DIM).transpose(0, 2, 3, 1, 4)
    v = dv.reshape(B, S, DIFF_HEADS, DIFF_V_DIM).transpose(0, 2, 1, 3)
    f32 = jnp.float32
    lam = (jnp.exp(jnp.sum(lam_q1.astype(f32) * lam_k1.astype(f32)))
           - jnp.exp(jnp.sum(lam_q2.astype(f32) * lam_k2.astype(f32))) + lambda_init)
    slopes = jnp.exp2(-8.0 * jnp.arange(1, DIFF_HEADS + 1, dtype=f32) / DIFF_HEADS)
    pos = positions.astype(f32)
    scale = 1.0 / math.sqrt(DIFF_HEAD_DIM)

    def block(i):
        q0 = i * Q_BLOCK
        qi = lax.dynamic_slice_in_dim(q, q0, Q_BLOCK, axis=3)
        s = jnp.einsum('bhcqd,bhckd->bhcqk', qi, k).astype(f32) * scale
        pq = lax.dynamic_slice_in_dim(pos, q0, Q_BLOCK, axis=1)
        dist = jnp.abs(pq[:, None, :, None] - pos[:, None, None, :])
        s = s + (-slopes[None, :, None, None] * dist)[:, :, None]
        s = jnp.where(_causal_mask(q0, S), s, NEG_INF)
        p = jax.nn.softmax(s, axis=-1)
        a = (p[:, :, 0] - lam * p[:, :, 1]).astype(v.dtype)
        return jnp.einsum('bhqk,bhkd->bhqd', a, v)

    o = _sweep_query_blocks(block, S)
    o = _rms_norm(o, subln_g, SUBLN_EPS) * (1.0 - lambda_init)
    return o.transpose(0, 2, 1, 3).reshape(B, S, DIFF_HEADS * DIFF_V_DIM)


def _mixer(h, positions, w_in, q_norm_g, kv_norm_g, w_uq, w_ukv,
           lam_q1, lam_k1, lam_q2, lam_k2, subln_g, w_o, lambda_init):
    proj = h @ w_in
    d3 = DIFF_HEADS * DIFF_V_DIM
    a = MLA_Q_RANK
    b = a + MLA_KV_RANK
    c = b + MLA_ROPE_DIM
    cq, ckv, k_rope, dq, dk, dv = jnp.split(proj, [a, b, c, c + d3, c + 2 * d3], axis=-1)
    mla_out = _mla(cq, ckv, k_rope, positions, q_norm_g, kv_norm_g, w_uq, w_ukv)
    diff_out = _diff_attention(dq, dk, dv, positions, lam_q1, lam_k1, lam_q2, lam_k2,
                               subln_g, lambda_init)
    return jnp.concatenate([mla_out, diff_out], axis=-1) @ w_o


def _moe(h, router_w, router_b, w_gate, w_up, w_down, sw_gate, sw_up, sw_down):
    B, S, D = h.shape
    T = B * S
    A = T * TOP_K
    hf = h.reshape(T, D)
    scores = jax.nn.sigmoid((hf @ router_w).astype(jnp.float32))
    sel = scores + router_b.astype(jnp.float32)
    grouped = sel.reshape(T, N_GROUPS, N_EXPERTS // N_GROUPS)
    group_score = jnp.sum(lax.top_k(grouped, 2)[0], axis=-1)
    _, top_groups = lax.top_k(group_score, TOPK_GROUPS)
    group_mask = jnp.sum(jax.nn.one_hot(top_groups, N_GROUPS), axis=1) > 0
    expert_mask = jnp.repeat(group_mask, N_EXPERTS // N_GROUPS, axis=1)
    _, idx = lax.top_k(jnp.where(expert_mask, sel, -jnp.inf), TOP_K)
    wts = jnp.take_along_axis(scores, idx, axis=1)
    wts = wts / jnp.sum(wts, axis=-1, keepdims=True) * ROUTED_SCALE
    flat_e = idx.reshape(A).astype(jnp.int32)
    flat_tok = jnp.repeat(jnp.arange(T, dtype=jnp.int32), TOP_K)
    flat_w = wts.reshape(A)
    e_sorted, order = lax.sort((flat_e, jnp.arange(A, dtype=jnp.int32)), num_keys=1, is_stable=True)
    counts = jnp.bincount(flat_e, length=N_EXPERTS)
    starts = jnp.cumsum(counts) - counts
    padded = (counts + MOE_BLOCK - 1) // MOE_BLOCK * MOE_BLOCK
    pends = jnp.cumsum(padded)
    pstarts = pends - padded
    dest = pstarts[e_sorted] + (jnp.arange(A, dtype=jnp.int32) - starts[e_sorted])
    P = A + N_EXPERTS * MOE_BLOCK
    n_blocks = P // MOE_BLOCK
    buf_tok = jnp.zeros((P,), jnp.int32).at[dest].set(flat_tok[order])
    buf_w = jnp.zeros((P,), h.dtype).at[dest].set(flat_w[order].astype(h.dtype))
    blk_expert = jnp.minimum(
        jnp.searchsorted(pends, jnp.arange(n_blocks, dtype=jnp.int32) * MOE_BLOCK, side='right'),
        N_EXPERTS - 1)

    def run(bi):
        rows = lax.dynamic_slice_in_dim(buf_tok, bi * MOE_BLOCK, MOE_BLOCK)
        rw = lax.dynamic_slice_in_dim(buf_w, bi * MOE_BLOCK, MOE_BLOCK)
        e = blk_expert[bi]
        xb = hf[rows]
        y = (jax.nn.silu(xb @ w_gate[e]) * (xb @ w_up[e])) @ w_down[e]
        return y * rw[:, None]

    y_buf = lax.map(run, jnp.arange(n_blocks)).reshape(P, D)
    routed = jax.ops.segment_sum(y_buf, buf_tok, num_segments=T)
    shared = (jax.nn.silu(hf @ sw_gate) * (hf @ sw_up)) @ sw_down
    return (routed + shared).reshape(B, S, D)


def setup_inputs(seed: int = 0) -> dict:
    key = jax.random.key(seed)
    ks = iter(jax.random.split(key, 40))
    L, D = DEPTH, D_MODEL

    def nrm(shape, scale):
        return scale * jax.random.normal(next(ks), shape, jnp.float32)

    def gain(shape):
        return 1.0 + nrm(shape, 0.02)

    x = nrm((BATCH, SEQ, D), 1.0)
    c = nrm((BATCH, D), 1.0)
    offs = jax.random.randint(next(ks), (BATCH, 1), 0, MAX_POS_OFFSET, dtype=jnp.int32)
    positions = jnp.arange(SEQ, dtype=jnp.int32)[None, :] + offs
    return {
        'x': x, 'c': c, 'positions': positions,
        'w_ada': nrm((L, D, 6 * D), 0.5 * D ** -0.5),
        'b_ada': nrm((L, 6 * D), 0.02),
        'attn_pre_g': gain((L, D)),
        'attn_post_g': gain((L, D)),
        'w_in': nrm((L, D, N_IN), D ** -0.5),
        'q_norm_g': gain((L, MLA_Q_RANK)),
        'kv_norm_g': gain((L, MLA_KV_RANK)),
        'w_uq': nrm((L, MLA_Q_RANK, MLA_HEADS, MLA_NOPE_DIM + MLA_ROPE_DIM), MLA_Q_RANK ** -0.5),
        'w_ukv': nrm((L, MLA_KV_RANK, MLA_HEADS, MLA_NOPE_DIM + MLA_V_DIM), MLA_KV_RANK ** -0.5),
        'lam_q1': nrm((L, DIFF_HEAD_DIM), 0.1),
        'lam_k1': nrm((L, DIFF_HEAD_DIM), 0.1),
        'lam_q2': nrm((L, DIFF_HEAD_DIM), 0.1),
        'lam_k2': nrm((L, DIFF_HEAD_DIM), 0.1),
        'diff_subln_g': gain((L, DIFF_V_DIM)),
        'w_o': nrm((L, MIX_WIDTH, D), MIX_WIDTH ** -0.5),
        'ffn_pre_g': gain((L, D)),
        'ffn_post_g': gain((L, D)),
        'router_w': nrm((L, D, N_EXPERTS), D ** -0.5),
        'router_b': nrm((L, N_EXPERTS), 0.01),
        'exp_w_gate': nrm((L, N_EXPERTS, D, EXPERT_DIM), D ** -0.5),
        'exp_w_up': nrm((L, N_EXPERTS, D, EXPERT_DIM), D ** -0.5),
        'exp_w_down': nrm((L, N_EXPERTS, EXPERT_DIM, D), EXPERT_DIM ** -0.5),
        'shared_w_gate': nrm((L, D, SHARED_DIM), D ** -0.5),
        'shared_w_up': nrm((L, D, SHARED_DIM), D ** -0.5),
        'shared_w_down': nrm((L, SHARED_DIM, D), SHARED_DIM ** -0.5),
    }


def reference(x, c, positions, w_ada, b_ada, attn_pre_g, attn_post_g, w_in, q_norm_g, kv_norm_g,
              w_uq, w_ukv, lam_q1, lam_k1, lam_q2, lam_k2, diff_subln_g, w_o, ffn_pre_g, ffn_post_g,
              router_w, router_b, exp_w_gate, exp_w_up, exp_w_down,
              shared_w_gate, shared_w_up, shared_w_down):
    for l in range(DEPTH):
        lambda_init = 0.8 - 0.6 * math.exp(-0.3 * l)
        mod = jax.nn.silu(c) @ w_ada[l] + b_ada[l]
        sh_a, sc_a, g_a, sh_f, sc_f, g_f = jnp.split(mod[:, None, :], 6, axis=-1)
        h = _rms_norm(x, attn_pre_g[l]) * (1.0 + sc_a) + sh_a
        y = _mixer(h, positions, w_in[l], q_norm_g[l], kv_norm_g[l], w_uq[l], w_ukv[l],
                   lam_q1[l], lam_k1[l], lam_q2[l], lam_k2[l], diff_subln_g[l], w_o[l], lambda_init)
        x = x + g_a * _rms_norm(y, attn_post_g[l])
        h = _rms_norm(x, ffn_pre_g[l]) * (1.0 + sc_f) + sh_f
        y = _moe(h, router_w[l], router_b[l], exp_w_gate[l], exp_w_up[l], exp_w_down[l],
                 shared_w_gate[l], shared_w_up[l], shared_w_down[l])
        x = x + g_f * _rms_norm(y, ffn_post_g[l])
    return x
```

```cpp
#include <hip/hip_runtime.h>
#include <hip/hip_cooperative_groups.h>
#include <cstdio>
#include <cstdint>
namespace cg = cooperative_groups;

#ifndef NAIVE_CORE
#define NAIVE_CORE 0
#endif
#ifndef NAIVE_ATTN
#define NAIVE_ATTN 0
#endif

typedef unsigned short bf16_t;
typedef short bf16x8 __attribute__((ext_vector_type(8)));
typedef short s16x4 __attribute__((ext_vector_type(4)));
typedef short v4i16_t __attribute__((ext_vector_type(4)));
typedef float f32x16 __attribute__((ext_vector_type(16)));
typedef float f32x4 __attribute__((ext_vector_type(4)));
typedef float f32x2 __attribute__((ext_vector_type(2)));
typedef unsigned u32x4 __attribute__((ext_vector_type(4)));
typedef unsigned u32x2 __attribute__((ext_vector_type(2)));
#define LAS __attribute__((address_space(3)))

constexpr int Dm = 1024, NB = 8, SEQ = 2048, T = NB * SEQ;
constexpr int NIN = 1952;
constexpr int C_CQ = 0, C_CKV = 256, C_KR = 384, C_DQ = 416, C_DK = 928, C_DV = 1440;
constexpr int NE = 256, TOPK = 8, AR = T * TOPK, HROWS = AR + T;
constexpr int LISTCAP = T;
constexpr float LOG2E = 1.4426950408889634f;
constexpr float LAMBDA_INIT = 0.2f;

constexpr size_t MiB = 1u << 20;
constexpr size_t WS_CTL = 0, CTL_BYTES = 65536;
constexpr size_t WS_MOD = 65536;
constexpr size_t WS_ROPE = 1 * MiB;
constexpr size_t WS_H1 = 4 * MiB;
constexpr size_t WS_PROJ = 36 * MiB;
constexpr size_t WS_CQN = 100 * MiB;
constexpr size_t WS_CKVN = 108 * MiB;
constexpr size_t WS_QM = 112 * MiB;
constexpr size_t WS_KF = 136 * MiB;
constexpr size_t WS_VM = 160 * MiB;
constexpr size_t WS_ATT = 176 * MiB;
constexpr size_t WS_OD0 = 208 * MiB;
constexpr size_t WS_Y1 = 240 * MiB;
constexpr size_t WS_H2 = 304 * MiB;
constexpr size_t WS_LOG = 336 * MiB;
constexpr size_t WS_LA = 352 * MiB;
constexpr size_t WS_LW = 368 * MiB;
constexpr size_t WS_HB = 384 * MiB;
constexpr size_t WS_YB = 456 * MiB;
constexpr size_t WS_END = 744 * MiB;

constexpr int LDS_BYTES = 40960;

struct Params {
    const float* in[28];
    float* out;
    char* ws;
};

__device__ __forceinline__ unsigned short f2bf(float f) { __bf16 b = (__bf16)f; return __builtin_bit_cast(unsigned short, b); }
__device__ __forceinline__ unsigned pk2(float lo, float hi) { return (unsigned)f2bf(lo) | ((unsigned)f2bf(hi) << 16); }
__device__ __forceinline__ float bf2f(unsigned short b) { return __uint_as_float(((unsigned)b) << 16); }
__device__ __forceinline__ float bflo(unsigned u) { return __uint_as_float(u << 16); }
__device__ __forceinline__ float bfhi(unsigned u) { return __uint_as_float(u & 0xffff0000u); }
__device__ __forceinline__ int crow(int r, int hi) { return (r & 3) + 8 * (r >> 2) + 4 * hi; }
__device__ __forceinline__ float wave_sum(float v) {
#pragma unroll
    for (int o = 32; o >= 1; o >>= 1) v += __shfl_xor(v, o);
    return v;
}
__device__ __forceinline__ float wave_max(float v) {
#pragma unroll
    for (int o = 32; o >= 1; o >>= 1) v = fmaxf(v, __shfl_xor(v, o));
    return v;
}
__device__ __forceinline__ float silu_f(float v) { return v / (1.f + __expf(-v)); }
__device__ __forceinline__ s16x4 tr_read(LAS char* p) {
    return __builtin_bit_cast(s16x4, __builtin_amdgcn_ds_read_tr16_b64_v4i16((LAS v4i16_t*)p));
}
#define MFMA32(a, b, c) __builtin_amdgcn_mfma_f32_32x32x16_bf16(a, b, c, 0, 0, 0)

template <int NBMODE> __device__ __forceinline__ int nb_of(int wn, int ni) { return NBMODE == 0 ? 64 * wn + 32 * ni : 32 * wn + 64 * ni; }

template <int NBMODE, class AF, class BF, class EF>
__device__ __forceinline__ void gemm_tile(LAS char* L, int nk, long ldw, AF arow, BF bcol, EF epi) {
    const int tid = threadIdx.x, lane = tid & 63, wave = tid >> 6;
    const int wm = wave & 1, wn = wave >> 1, l31 = lane & 31, hi = lane >> 5;
    const int a_chunk = tid & 3, a_row = tid >> 2;
    const bf16_t* ap0 = arow(a_row) + a_chunk * 8;
    const bf16_t* ap1 = arow(a_row + 64) + a_chunk * 8;
    const int a_w0 = a_row * 64 + 16 * (a_chunk ^ ((a_row >> 2) & 3));
    const int a_w1 = a_w0 + 4096;
    const int b_n4 = tid & 31, b_kr = tid >> 5;
    const float* bp = bcol(4 * b_n4) + (long)b_kr * ldw;
    const int b_w = 8192 + b_kr * 320 + 8 * b_n4;
    const int sw = (l31 >> 2) & 3;
    const int xoff = (64 * wm + l31) * 64;
    const int woff = 8192 + (8 * hi + ((lane & 15) >> 2)) * 320 + 2 * (16 * ((lane >> 4) & 1) + 4 * (lane & 3));
    f32x16 acc[2][2];
#pragma unroll
    for (int i = 0; i < 2; ++i)
#pragma unroll
        for (int j = 0; j < 2; ++j)
#pragma unroll
            for (int r = 0; r < 16; ++r) acc[i][j][r] = 0.f;
    u32x4 ra0, ra1; f32x4 rb[4];
    ra0 = *(const u32x4*)(ap0); ra1 = *(const u32x4*)(ap1);
#pragma unroll
    for (int i = 0; i < 4; ++i) rb[i] = *(const f32x4*)(bp + (long)(8 * i) * ldw);
    for (int kt = 0; kt < nk; ++kt) {
        *(LAS u32x4*)(L + a_w0) = ra0; *(LAS u32x4*)(L + a_w1) = ra1;
#pragma unroll
        for (int i = 0; i < 4; ++i) { u32x2 w; w.x = pk2(rb[i][0], rb[i][1]); w.y = pk2(rb[i][2], rb[i][3]); *(LAS u32x2*)(L + b_w + i * 8 * 320) = w; }
        __syncthreads();
        if (kt + 1 < nk) {
            ra0 = *(const u32x4*)(ap0 + (kt + 1) * 32); ra1 = *(const u32x4*)(ap1 + (kt + 1) * 32);
#pragma unroll
            for (int i = 0; i < 4; ++i) rb[i] = *(const f32x4*)(bp + (long)((kt + 1) * 32 + 8 * i) * ldw);
        }
#if NAIVE_CORE
#pragma unroll
        for (int mi = 0; mi < 2; ++mi)
#pragma unroll
            for (int ni = 0; ni < 2; ++ni) {
                const int m = 64 * wm + 32 * mi + l31; const int nb = nb_of<NBMODE>(wn, ni);
                for (int k = 0; k < 32; ++k) {
                    const float xv = bf2f(*(LAS bf16_t*)(L + m * 64 + 16 * ((k >> 3) ^ ((m >> 2) & 3)) + 2 * (k & 7)));
#pragma unroll
                    for (int r = 0; r < 16; ++r) acc[mi][ni][r] += xv * bf2f(*(LAS bf16_t*)(L + 8192 + k * 320 + 2 * (nb + crow(r, hi))));
                }
            }
#else
#pragma unroll
        for (int ks = 0; ks < 2; ++ks) {
            bf16x8 xf[2], wf[2];
#pragma unroll
            for (int mi = 0; mi < 2; ++mi) xf[mi] = *(LAS bf16x8*)(L + xoff + mi * 2048 + 16 * ((2 * ks + hi) ^ sw));
#pragma unroll
            for (int ni = 0; ni < 2; ++ni) {
                LAS char* p = L + woff + ks * 16 * 320 + 2 * nb_of<NBMODE>(wn, ni);
                const s16x4 lo = tr_read(p), h4 = tr_read(p + 4 * 320);
                wf[ni] = (bf16x8){lo[0], lo[1], lo[2], lo[3], h4[0], h4[1], h4[2], h4[3]};
            }
#pragma unroll
            for (int mi = 0; mi < 2; ++mi)
#pragma unroll
                for (int ni = 0; ni < 2; ++ni) acc[mi][ni] = MFMA32(wf[ni], xf[mi], acc[mi][ni]);
        }
#endif
        __syncthreads();
    }
    epi(acc);
}

__device__ __forceinline__ void phase_mod(const Params& p, LAS char* L, int v, int G) {
    const int tid = threadIdx.x;
    const float* c = p.in[1]; const float* w_ada = p.in[3]; const float* b_ada = p.in[4];
    float* mod = (float*)(p.ws + WS_MOD);
    LAS float* sc = (LAS float*)L;
    LAS float* red = (LAS float*)(L + 32768);
    bool filled = false;
    for (int item = v; item < 384; item += G) {
        if (!filled) {
            for (int i = tid; i < 8 * 1024; i += 256) sc[i] = silu_f(c[i]);
            __syncthreads(); filled = true;
        }
        const int cx = tid & 15, kl = tid >> 4, col = item * 16 + cx;
        float a[8];
#pragma unroll
        for (int b = 0; b < 8; ++b) a[b] = 0.f;
#pragma unroll 4
        for (int k = kl; k < 1024; k += 16) {
            const float w = w_ada[(size_t)k * 6144 + col];
#pragma unroll
            for (int b = 0; b < 8; ++b) a[b] += sc[b * 1024 + k] * w;
        }
#pragma unroll
        for (int b = 0; b < 8; ++b) red[(b * 16 + kl) * 16 + cx] = a[b];
        __syncthreads();
        if (tid < 128) {
            const int b = tid >> 4, cc = tid & 15; float s = 0.f;
#pragma unroll
            for (int k = 0; k < 16; ++k) s += red[(b * 16 + k) * 16 + cc];
            mod[b * 6144 + item * 16 + cc] = s + b_ada[item * 16 + cc];
        }
        __syncthreads();
    }
}

__device__ __forceinline__ void phase_h1(const Params& p, int v, int G) {
    const int lane = threadIdx.x & 63, wave = threadIdx.x >> 6;
    const float* x = p.in[0]; const int* positions = (const int*)p.in[2]; const float* g = p.in[5];
    const float* mod = (const float*)(p.ws + WS_MOD);
    bf16_t* h1 = (bf16_t*)(p.ws + WS_H1);
    f32x2* rope = (f32x2*)(p.ws + WS_ROPE);
    for (int t = v * 4 + wave; t < T; t += G * 4) {
        const int b = t / SEQ;
        const f32x4* xr = (const f32x4*)(x + (size_t)t * Dm);
        f32x4 xv[4]; float ss = 0.f;
#pragma unroll
        for (int j = 0; j < 4; ++j) { xv[j] = xr[lane + 64 * j]; ss += xv[j][0] * xv[j][0] + xv[j][1] * xv[j][1] + xv[j][2] * xv[j][2] + xv[j][3] * xv[j][3]; }
        ss = wave_sum(ss);
        const float rstd = rsqrtf(ss * (1.f / Dm) + 1e-6f);
        const float* sh = mod + b * 6144; const float* scl = sh + 1024;
#pragma unroll
        for (int j = 0; j < 4; ++j) {
            const int col = 4 * (lane + 64 * j);
            const f32x4 gv = *(const f32x4*)(g + col), sv = *(const f32x4*)(scl + col), hv = *(const f32x4*)(sh + col);
            float o[4];
#pragma unroll
            for (int e = 0; e < 4; ++e) o[e] = (xv[j][e] * rstd * gv[e]) * (1.f + sv[e]) + hv[e];
            u32x2 w; w.x = pk2(o[0], o[1]); w.y = pk2(o[2], o[3]);
            *(u32x2*)(h1 + (size_t)t * Dm + col) = w;
        }
        if (lane < 16) {
            const double inv = exp2(-(double)lane * (13.287712379549449 / 16.0));
            const double rev = (double)positions[t] * inv * 0.15915494309189535;
            const float fr = (float)(rev - rint(rev));
            f32x2 cs; cs.x = __builtin_amdgcn_cosf(fr); cs.y = __builtin_amdgcn_sinf(fr);
            rope[(size_t)t * 16 + lane] = cs;
        }
    }
}

__device__ __forceinline__ void phase_proj(const Params& p, LAS char* L, int v, int G) {
    const bf16_t* h1 = (const bf16_t*)(p.ws + WS_H1);
    const float* w_in = p.in[7];
    bf16_t* proj = (bf16_t*)(p.ws + WS_PROJ);
    for (int u = v; u < 128 * 16; u += G) {
        const int mt = u >> 4, nt = u & 15, m0 = mt * 128, n0 = nt * 128;
        auto arow = [&](int r) { return h1 + (size_t)(m0 + r) * Dm; };
        auto bcol = [&](int c) { int col = n0 + c; if (col > NIN - 4) col = NIN - 4; return w_in + col; };
        auto epi = [&](f32x16 (&acc)[2][2]) {
            const int lane = threadIdx.x & 63, wave = threadIdx.x >> 6, wm = wave & 1, wn = wave >> 1, l31 = lane & 31, hi = lane >> 5;
#pragma unroll
            for (int mi = 0; mi < 2; ++mi) {
                const int m = m0 + 64 * wm + 32 * mi + l31;
#pragma unroll
                for (int ni = 0; ni < 2; ++ni) {
                    const int nbg = n0 + nb_of<0>(wn, ni);
                    if (nbg < NIN) {
                        const float sc = (nbg >= C_DQ && nbg < C_DK) ? 0.125f * LOG2E : 1.f;
#pragma unroll
                        for (int gq = 0; gq < 4; ++gq) {
                            u32x2 w; w.x = pk2(acc[mi][ni][4 * gq] * sc, acc[mi][ni][4 * gq + 1] * sc); w.y = pk2(acc[mi][ni][4 * gq + 2] * sc, acc[mi][ni][4 * gq + 3] * sc);
                            *(u32x2*)(proj + (size_t)m * NIN + nbg + 8 * gq + 4 * hi) = w;
                        }
                    }
                }
            }
        };
        gemm_tile<0>(L, Dm / 32, NIN, arow, bcol, epi);
    }
}

__device__ __forceinline__ void phase_norms(const Params& p, int v, int G) {
    const int lane = threadIdx.x & 63, wave = threadIdx.x >> 6;
    const bf16_t* proj = (const bf16_t*)(p.ws + WS_PROJ);
    const float* qg = p.in[8]; const float* kvg = p.in[9];
    bf16_t* cqn = (bf16_t*)(p.ws + WS_CQN); bf16_t* ckvn = (bf16_t*)(p.ws + WS_CKVN); bf16_t* kf = (bf16_t*)(p.ws + WS_KF);
    const f32x2* rope = (const f32x2*)(p.ws + WS_ROPE);
    for (int t = v * 4 + wave; t < T; t += G * 4) {
        const bf16_t* pr = proj + (size_t)t * NIN;
        {
            const u32x2 raw = *(const u32x2*)(pr + C_CQ + 4 * lane);
            float a[4] = {bflo(raw.x), bfhi(raw.x), bflo(raw.y), bfhi(raw.y)};
            float ss = wave_sum(a[0] * a[0] + a[1] * a[1] + a[2] * a[2] + a[3] * a[3]);
            const float rstd = rsqrtf(ss * (1.f / 256.f) + 1e-6f);
            const f32x4 gv = *(const f32x4*)(qg + 4 * lane);
            u32x2 w; w.x = pk2(a[0] * rstd * gv[0], a[1] * rstd * gv[1]); w.y = pk2(a[2] * rstd * gv[2], a[3] * rstd * gv[3]);
            *(u32x2*)(cqn + (size_t)t * 256 + 4 * lane) = w;
        }
        {
            const unsigned raw = *(const unsigned*)(pr + C_CKV + 2 * lane);
            const float a0 = bflo(raw), a1 = bfhi(raw);
            float ss = wave_sum(a0 * a0 + a1 * a1);
            const float rstd = rsqrtf(ss * (1.f / 128.f) + 1e-6f);
            *(unsigned*)(ckvn + (size_t)t * 128 + 2 * lane) = pk2(a0 * rstd * kvg[2 * lane], a1 * rstd * kvg[2 * lane + 1]);
        }
        if (lane < 16) {
            const float x1 = bf2f(pr[C_KR + lane]), x2 = bf2f(pr[C_KR + 16 + lane]);
            const f32x2 cs = rope[(size_t)t * 16 + lane];
            const bf16_t y1 = f2bf(x1 * cs.x - x2 * cs.y), y2 = f2bf(x2 * cs.x + x1 * cs.y);
#pragma unroll
            for (int h = 0; h < 8; ++h) { kf[(size_t)t * 768 + h * 96 + 64 + lane] = y1; kf[(size_t)t * 768 + h * 96 + 80 + lane] = y2; }
        }
    }
}

__device__ __forceinline__ void phase_qkv(const Params& p, LAS char* L, int v, int G) {
    const bf16_t* cqn = (const bf16_t*)(p.ws + WS_CQN); const bf16_t* ckvn = (const bf16_t*)(p.ws + WS_CKVN);
    const float* w_uq = p.in[10]; const float* w_ukv = p.in[11];
    bf16_t* qm = (bf16_t*)(p.ws + WS_QM); bf16_t* kf = (bf16_t*)(p.ws + WS_KF); bf16_t* vm = (bf16_t*)(p.ws + WS_VM);
    const f32x2* rope = (const f32x2*)(p.ws + WS_ROPE);
    const float qscale = LOG2E * 0.10206207261596575f;
    for (int u = v; u < 128 * 14; u += G) {
        const int mt = u / 14, j = u % 14, m0 = mt * 128;
        if (j < 6) {
            const int n0 = j * 128;
            auto arow = [&](int r) { return cqn + (size_t)(m0 + r) * 256; };
            auto bcol = [&](int c) { return w_uq + n0 + c; };
            auto epi = [&](f32x16 (&acc)[2][2]) {
                const int lane = threadIdx.x & 63, wave = threadIdx.x >> 6, wm = wave & 1, wn = wave >> 1, l31 = lane & 31, hi = lane >> 5;
#pragma unroll
                for (int mi = 0; mi < 2; ++mi) {
                    const int m = m0 + 64 * wm + 32 * mi + l31;
#pragma unroll
                    for (int ni = 0; ni < 2; ++ni) {
                        const int nbg = n0 + nb_of<0>(wn, ni);
                        f32x16 a = acc[mi][ni];
                        if ((nbg % 96) == 64) {
#pragma unroll
                            for (int r = 0; r < 8; ++r) {
                                const f32x2 cs = rope[(size_t)m * 16 + crow(r, hi)];
                                const float x1 = a[r], x2 = a[r + 8];
                                a[r] = x1 * cs.x - x2 * cs.y; a[r + 8] = x2 * cs.x + x1 * cs.y;
                            }
                        }
#pragma unroll
                        for (int gq = 0; gq < 4; ++gq) {
                            u32x2 w; w.x = pk2(a[4 * gq] * qscale, a[4 * gq + 1] * qscale); w.y = pk2(a[4 * gq + 2] * qscale, a[4 * gq + 3] * qscale);
                            *(u32x2*)(qm + (size_t)m * 768 + nbg + 8 * gq + 4 * hi) = w;
                        }
                    }
                }
            };
            gemm_tile<0>(L, 256 / 32, 768, arow, bcol, epi);
        } else {
            const int n0 = (j - 6) * 128;
            auto arow = [&](int r) { return ckvn + (size_t)(m0 + r) * 128; };
            auto bcol = [&](int c) { return w_ukv + n0 + c; };
            auto epi = [&](f32x16 (&acc)[2][2]) {
                const int lane = threadIdx.x & 63, wave = threadIdx.x >> 6, wm = wave & 1, wn = wave >> 1, l31 = lane & 31, hi = lane >> 5;
#pragma unroll
                for (int mi = 0; mi < 2; ++mi) {
                    const int m = m0 + 64 * wm + 32 * mi + l31;
#pragma unroll
                    for (int ni = 0; ni < 2; ++ni) {
                        const int nbg = n0 + nb_of<0>(wn, ni);
                        const int h = nbg >> 7, d = nbg & 127;
                        bf16_t* dst = (d < 64) ? (kf + (size_t)m * 768 + h * 96 + d) : (vm + (size_t)m * 512 + h * 64 + (d - 64));
#pragma unroll
                        for (int gq = 0; gq < 4; ++gq) {
                            u32x2 w; w.x = pk2(acc[mi][ni][4 * gq], acc[mi][ni][4 * gq + 1]); w.y = pk2(acc[mi][ni][4 * gq + 2], acc[mi][ni][4 * gq + 3]);
                            *(u32x2*)(dst + 8 * gq + 4 * hi) = w;
                        }
                    }
                }
            };
            gemm_tile<0>(L, 128 / 32, 1024, arow, bcol, epi);
        }
    }
}

template <int DQK, int DV, bool ALIBI>
__device__ __forceinline__ void attn_map(LAS char* L, const bf16_t* Q, int ldq, const bf16_t* K, int ldk, const bf16_t* V, int ldv,
                                         const int* posrow, float slope2, int q0, f32x16 (&o)[DV / 32]) {
    constexpr int KSTR = DQK * 2 + 16, VSTR = DV * 2 + 64, KS = DQK / 16, ND = DV / 32;
    constexpr int K_OFF = 0, V_OFF = 64 * KSTR, P_OFF = V_OFF + 64 * VSTR;
    constexpr int KCH = DQK / 8, VCH = DV / 8;
    const int tid = threadIdx.x, lane = tid & 63, wave = tid >> 6, l31 = lane & 31, hi = lane >> 5;
    const int qrow = q0 + 32 * wave + l31;
    bf16x8 qf[KS];
#pragma unroll
    for (int s = 0; s < KS; ++s) qf[s] = *(const bf16x8*)(Q + (size_t)qrow * ldq + 16 * s + 8 * hi);
    const float posq = ALIBI ? (float)posrow[qrow] : 0.f;
#pragma unroll
    for (int d = 0; d < ND; ++d)
#pragma unroll
        for (int r = 0; r < 16; ++r) o[d][r] = 0.f;
    float m_run = -1e30f, l_run = 0.f;
    const int ntile = (q0 + 128) / 64;
    const int qmin = q0 + 32 * wave, qmax = qmin + 31;
    const int vbase = V_OFF + (4 * hi + ((lane & 15) >> 2)) * VSTR + 2 * (16 * ((lane >> 4) & 1) + 4 * (lane & 3));
    for (int tl = 0; tl < ntile; ++tl) {
        const int kb = tl * 64;
        __syncthreads();
#pragma unroll
        for (int i = 0; i < (64 * KCH) / 256; ++i) {
            const int c = tid + 256 * i, row = c / KCH, ch = c % KCH;
            *(LAS u32x4*)(L + K_OFF + row * KSTR + ch * 16) = *(const u32x4*)(K + (size_t)(kb + row) * ldk + ch * 8);
        }
#pragma unroll
        for (int i = 0; i < (64 * VCH) / 256; ++i) {
            const int c = tid + 256 * i, row = c / VCH, ch = c % VCH;
            *(LAS u32x4*)(L + V_OFF + row * VSTR + ch * 16) = *(const u32x4*)(V + (size_t)(kb + row) * ldv + ch * 8);
        }
        if (ALIBI && tid < 64) *(LAS float*)(L + P_OFF + 4 * tid) = (float)posrow[kb + tid];
        __syncthreads();
        if (kb <= qmax) {
            f32x16 s0, s1;
#pragma unroll
            for (int r = 0; r < 16; ++r) { s0[r] = 0.f; s1[r] = 0.f; }
#pragma unroll
            for (int s = 0; s < KS; ++s) {
                const bf16x8 k0 = *(LAS bf16x8*)(L + K_OFF + l31 * KSTR + 32 * s + 16 * hi);
                const bf16x8 k1 = *(LAS bf16x8*)(L + K_OFF + (32 + l31) * KSTR + 32 * s + 16 * hi);
                s0 = MFMA32(k0, qf[s], s0); s1 = MFMA32(k1, qf[s], s1);
            }
            if (ALIBI) {
#pragma unroll
                for (int r = 0; r < 16; ++r) {
                    const float pk0 = *(LAS float*)(L + P_OFF + 4 * crow(r, hi)), pk1 = *(LAS float*)(L + P_OFF + 4 * (32 + crow(r, hi)));
                    s0[r] -= slope2 * fabsf(posq - pk0); s1[r] -= slope2 * fabsf(posq - pk1);
                }
            }
            if (kb + 63 > qmin) {
#pragma unroll
                for (int r = 0; r < 16; ++r) {
                    const int key = kb + crow(r, hi);
                    if (key > qrow) s0[r] = -INFINITY;
                    if (key + 32 > qrow) s1[r] = -INFINITY;
                }
            }
            float mx = s0[0];
#pragma unroll
            for (int r = 1; r < 16; ++r) mx = fmaxf(mx, s0[r]);
#pragma unroll
            for (int r = 0; r < 16; ++r) mx = fmaxf(mx, s1[r]);
            mx = fmaxf(mx, __shfl_xor(mx, 32));
            const float m_new = fmaxf(m_run, mx);
            const float alpha = __builtin_amdgcn_exp2f(m_run - m_new);
            m_run = m_new;
            float ls = 0.f;
#pragma unroll
            for (int r = 0; r < 16; ++r) { s0[r] = __builtin_amdgcn_exp2f(s0[r] - m_new); s1[r] = __builtin_amdgcn_exp2f(s1[r] - m_new); ls += s0[r] + s1[r]; }
            l_run = l_run * alpha + ls;
#pragma unroll
            for (int d = 0; d < ND; ++d)
#pragma unroll
                for (int r = 0; r < 16; ++r) o[d][r] *= alpha;
            u32x4 pw[4];
#pragma unroll
            for (int j = 0; j < 4; ++j) {
                pw[0][j] = pk2(s0[2 * j], s0[2 * j + 1]); pw[1][j] = pk2(s0[8 + 2 * j], s0[8 + 2 * j + 1]);
                pw[2][j] = pk2(s1[2 * j], s1[2 * j + 1]); pw[3][j] = pk2(s1[8 + 2 * j], s1[8 + 2 * j + 1]);
            }
#pragma unroll
            for (int s = 0; s < 4; ++s) {
                const bf16x8 pf = __builtin_bit_cast(bf16x8, pw[s]);
#pragma unroll
                for (int d = 0; d < ND; ++d) {
                    LAS char* vp = L + vbase + 16 * s * VSTR + 64 * d;
                    const s16x4 lo = tr_read(vp), h4 = tr_read(vp + 8 * VSTR);
                    const bf16x8 vf = (bf16x8){lo[0], lo[1], lo[2], lo[3], h4[0], h4[1], h4[2], h4[3]};
                    o[d] = MFMA32(vf, pf, o[d]);
                }
            }
        }
    }
    const float lt = l_run + __shfl_xor(l_run, 32);
    const float inv = 1.f / lt;
#pragma unroll
    for (int d = 0; d < ND; ++d)
#pragma unroll
        for (int r = 0; r < 16; ++r) o[d][r] *= inv;
}

#if NAIVE_ATTN
template <int DQK, int DV, bool ALIBI>
__device__ __forceinline__ void naive_attn_row(LAS float* sc, const bf16_t* Qrow, const bf16_t* K, int ldk, const bf16_t* V, int ldv,
                                               const int* posrow, float slope2, int q, float& o0, float& o1) {
    const int lane = threadIdx.x & 63;
    float mx = -1e30f;
    for (int k = lane; k <= q; k += 64) {
        float s = 0.f;
        for (int d = 0; d < DQK; ++d) s += bf2f(Qrow[d]) * bf2f(K[(size_t)k * ldk + d]);
        if (ALIBI) s -= slope2 * fabsf((float)posrow[q] - (float)posrow[k]);
        sc[k] = s; mx = fmaxf(mx, s);
    }
    mx = wave_max(mx);
    float sum = 0.f;
    for (int k = lane; k <= q; k += 64) { const float pv = __builtin_amdgcn_exp2f(sc[k] - mx); sc[k] = pv; sum += pv; }
    sum = wave_sum(sum);
    asm volatile("s_waitcnt lgkmcnt(0)" ::: "memory");
    float a0 = 0.f, a1 = 0.f;
    for (int k = 0; k <= q; ++k) {
        const float pv = bf2f(f2bf(sc[k]));
        a0 += pv * bf2f(V[(size_t)k * ldv + lane]);
        if (DV == 128) a1 += pv * bf2f(V[(size_t)k * ldv + 64 + lane]);
    }
    o0 = a0 / sum; o1 = a1 / sum;
}
#endif

__device__ __forceinline__ void phase_attn(const Params& p, LAS char* L, int v, int G) {
    const int tid = threadIdx.x, lane = tid & 63, wave = tid >> 6, l31 = lane & 31, hi = lane >> 5;
    const int* positions = (const int*)p.in[2];
    const bf16_t* proj = (const bf16_t*)(p.ws + WS_PROJ);
    const bf16_t* qm = (const bf16_t*)(p.ws + WS_QM); const bf16_t* kf = (const bf16_t*)(p.ws + WS_KF); const bf16_t* vm = (const bf16_t*)(p.ws + WS_VM);
    bf16_t* att = (bf16_t*)(p.ws + WS_ATT);
    float* od0 = (float*)(p.ws + WS_OD0);
    const float* subg = p.in[16];
    float lam;
    {
        const float a = p.in[12][lane] * p.in[13][lane], b = p.in[14][lane] * p.in[15][lane];
        lam = __expf(wave_sum(a)) - __expf(wave_sum(b)) + LAMBDA_INIT;
    }
#if NAIVE_ATTN
    LAS float* sc = (LAS float*)L + wave * SEQ;
    for (int it = v * 4 + wave; it < NB * 12 * SEQ; it += G * 4) {
        const int q = it % SEQ, bh = it / SEQ, b = bh / 12, hh = bh % 12;
        const size_t t = (size_t)b * SEQ + q; const size_t tb = (size_t)b * SEQ;
        if (hh < 8) {
            float o0, o1;
            naive_attn_row<96, 64, false>(sc, qm + t * 768 + hh * 96, kf + tb * 768 + hh * 96, 768, vm + tb * 512 + hh * 64, 512, positions + tb, 0.f, q, o0, o1);
            att[t * 1024 + hh * 64 + lane] = f2bf(o0);
        } else {
            const int h = hh - 8; const float slope2 = exp2f(-2.f * (h + 1)) * LOG2E;
            float a0, a1, b0, b1;
            naive_attn_row<64, 128, true>(sc, proj + t * NIN + C_DQ + h * 128, proj + tb * NIN + C_DK + h * 128, NIN, proj + tb * NIN + C_DV + h * 128, NIN, positions + tb, slope2, q, a0, a1);
            naive_attn_row<64, 128, true>(sc, proj + t * NIN + C_DQ + h * 128 + 64, proj + tb * NIN + C_DK + h * 128 + 64, NIN, proj + tb * NIN + C_DV + h * 128, NIN, positions + tb, slope2, q, b0, b1);
            const float c0 = a0 - lam * b0, c1 = a1 - lam * b1;
            const float ss = wave_sum(c0 * c0 + c1 * c1);
            const float rstd = rsqrtf(ss * (1.f / 128.f) + 1e-5f) * (1.f - LAMBDA_INIT);
            att[t * 1024 + 512 + h * 128 + lane] = f2bf(c0 * rstd * subg[lane]);
            att[t * 1024 + 512 + h * 128 + 64 + lane] = f2bf(c1 * rstd * subg[64 + lane]);
        }
    }
#else
    for (int it = v; it < 16 * 96; it += G) {
        const int qb = 15 - it / 96, r = it % 96, q0 = qb * 128;
        if (r < 64) {
            const int b = r >> 3, h = r & 7; const size_t tb = (size_t)b * SEQ;
            f32x16 o[2];
            attn_map<96, 64, false>(L, qm + tb * 768 + h * 96, 768, kf + tb * 768 + h * 96, 768, vm + tb * 512 + h * 64, 512, positions + tb, 0.f, q0, o);
            const size_t t = tb + q0 + 32 * wave + l31;
#pragma unroll
            for (int d = 0; d < 2; ++d)
#pragma unroll
                for (int gq = 0; gq < 4; ++gq) {
                    u32x2 w; w.x = pk2(o[d][4 * gq], o[d][4 * gq + 1]); w.y = pk2(o[d][4 * gq + 2], o[d][4 * gq + 3]);
                    *(u32x2*)(att + t * 1024 + h * 64 + 32 * d + 8 * gq + 4 * hi) = w;
                }
        } else {
            const int b = (r - 64) >> 2, h = (r - 64) & 3; const size_t tb = (size_t)b * SEQ;
            const float slope2 = exp2f(-2.f * (h + 1)) * LOG2E;
            const size_t t = tb + q0 + 32 * wave + l31;
            f32x16 o[4];
            attn_map<64, 128, true>(L, proj + tb * NIN + C_DQ + h * 128, NIN, proj + tb * NIN + C_DK + h * 128, NIN, proj + tb * NIN + C_DV + h * 128, NIN, positions + tb, slope2, q0, o);
#pragma unroll
            for (int d = 0; d < 4; ++d)
#pragma unroll
                for (int gq = 0; gq < 4; ++gq) {
                    f32x4 w = {o[d][4 * gq], o[d][4 * gq + 1], o[d][4 * gq + 2], o[d][4 * gq + 3]};
                    *(f32x4*)(od0 + t * 512 + h * 128 + 32 * d + 8 * gq + 4 * hi) = w;
                }
            attn_map<64, 128, true>(L, proj + tb * NIN + C_DQ + h * 128 + 64, NIN, proj + tb * NIN + C_DK + h * 128 + 64, NIN, proj + tb * NIN + C_DV + h * 128, NIN, positions + tb, slope2, q0, o);
            float ss = 0.f;
#pragma unroll
            for (int d = 0; d < 4; ++d)
#pragma unroll
                for (int gq = 0; gq < 4; ++gq) {
                    const f32x4 w = *(const f32x4*)(od0 + t * 512 + h * 128 + 32 * d + 8 * gq + 4 * hi);
#pragma unroll
                    for (int e = 0; e < 4; ++e) { const float c = w[e] - lam * o[d][4 * gq + e]; o[d][4 * gq + e] = c; ss += c * c; }
                }
            ss += __shfl_xor(ss, 32);
            const float rstd = rsqrtf(ss * (1.f / 128.f) + 1e-5f) * (1.f - LAMBDA_INIT);
#pragma unroll
            for (int d = 0; d < 4; ++d)
#pragma unroll
                for (int gq = 0; gq < 4; ++gq) {
                    const int dv = 32 * d + 8 * gq + 4 * hi;
                    const f32x4 gv = *(const f32x4*)(subg + dv);
                    u32x2 w; w.x = pk2(o[d][4 * gq] * rstd * gv[0], o[d][4 * gq + 1] * rstd * gv[1]); w.y = pk2(o[d][4 * gq + 2] * rstd * gv[2], o[d][4 * gq + 3] * rstd * gv[3]);
                    *(u32x2*)(att + t * 1024 + 512 + h * 128 + dv) = w;
                }
        }
    }
#endif
}

__device__ __forceinline__ void phase_oproj(const Params& p, LAS char* L, int v, int G) {
    const bf16_t* att = (const bf16_t*)(p.ws + WS_ATT);
    const float* w_o = p.in[17];
    float* y1 = (float*)(p.ws + WS_Y1);
    for (int u = v; u < 128 * 8; u += G) {
        const int mt = u >> 3, nt = u & 7, m0 = mt * 128, n0 = nt * 128;
        auto arow = [&](int r) { return att + (size_t)(m0 + r) * Dm; };
        auto bcol = [&](int c) { return w_o + n0 + c; };
        auto epi = [&](f32x16 (&acc)[2][2]) {
            const int lane = threadIdx.x & 63, wave = threadIdx.x >> 6, wm = wave & 1, wn = wave >> 1, l31 = lane & 31, hi = lane >> 5;
#pragma unroll
            for (int mi = 0; mi < 2; ++mi) {
                const int m = m0 + 64 * wm + 32 * mi + l31;
#pragma unroll
                for (int ni = 0; ni < 2; ++ni) {
                    const int nbg = n0 + nb_of<0>(wn, ni);
#pragma unroll
                    for (int gq = 0; gq < 4; ++gq) {
                        f32x4 w = {acc[mi][ni][4 * gq], acc[mi][ni][4 * gq + 1], acc[mi][ni][4 * gq + 2], acc[mi][ni][4 * gq + 3]};
                        *(f32x4*)(y1 + (size_t)m * Dm + nbg + 8 * gq + 4 * hi) = w;
                    }
                }
            }
        };
        gemm_tile<0>(L, Dm / 32, Dm, arow, bcol, epi);
    }
}

__device__ __forceinline__ void phase_post_attn(const Params& p, int v, int G) {
    const int lane = threadIdx.x & 63, wave = threadIdx.x >> 6;
    const float* x = p.in[0]; const float* pg = p.in[6]; const float* fg = p.in[18];
    const float* mod = (const float*)(p.ws + WS_MOD);
    const float* y1 = (const float*)(p.ws + WS_Y1);
    bf16_t* h2 = (bf16_t*)(p.ws + WS_H2);
    for (int t = v * 4 + wave; t < T; t += G * 4) {
        const int b = t / SEQ;
        const float* mb = mod + b * 6144;
        f32x4 yv[4], xv[4]; float ss = 0.f;
#pragma unroll
        for (int j = 0; j < 4; ++j) {
            yv[j] = *(const f32x4*)(y1 + (size_t)t * Dm + 4 * (lane + 64 * j));
            xv[j] = *(const f32x4*)(x + (size_t)t * Dm + 4 * (lane + 64 * j));
            ss += yv[j][0] * yv[j][0] + yv[j][1] * yv[j][1] + yv[j][2] * yv[j][2] + yv[j][3] * yv[j][3];
        }
        ss = wave_sum(ss);
        const float rstd = rsqrtf(ss * (1.f / Dm) + 1e-6f);
        float ss2 = 0.f;
#pragma unroll
        for (int j = 0; j < 4; ++j) {
            const int col = 4 * (lane + 64 * j);
            const f32x4 gv = *(const f32x4*)(pg + col), ga = *(const f32x4*)(mb + 2048 + col);
#pragma unroll
            for (int e = 0; e < 4; ++e) { xv[j][e] = xv[j][e] + ga[e] * (yv[j][e] * rstd * gv[e]); ss2 += xv[j][e] * xv[j][e]; }
            *(f32x4*)(p.out + (size_t)t * Dm + col) = xv[j];
        }
        ss2 = wave_sum(ss2);
        const float rstd2 = rsqrtf(ss2 * (1.f / Dm) + 1e-6f);
#pragma unroll
        for (int j = 0; j < 4; ++j) {
            const int col = 4 * (lane + 64 * j);
            const f32x4 gv = *(const f32x4*)(fg + col), sv = *(const f32x4*)(mb + 4096 + col), hv = *(const f32x4*)(mb + 3072 + col);
            float o[4];
#pragma unroll
            for (int e = 0; e < 4; ++e) o[e] = (xv[j][e] * rstd2 * gv[e]) * (1.f + sv[e]) + hv[e];
            u32x2 w; w.x = pk2(o[0], o[1]); w.y = pk2(o[2], o[3]);
            *(u32x2*)(h2 + (size_t)t * Dm + col) = w;
        }
    }
}

__device__ __forceinline__ void phase_router(const Params& p, LAS char* L, int v, int G) {
    const bf16_t* h2 = (const bf16_t*)(p.ws + WS_H2);
    const float* rw = p.in[20];
    float* lg = (float*)(p.ws + WS_LOG);
    for (int u = v; u < 128 * 2; u += G) {
        const int mt = u >> 1, nt = u & 1, m0 = mt * 128, n0 = nt * 128;
        auto arow = [&](int r) { return h2 + (size_t)(m0 + r) * Dm; };
        auto bcol = [&](int c) { return rw + n0 + c; };
        auto epi = [&](f32x16 (&acc)[2][2]) {
            const int lane = threadIdx.x & 63, wave = threadIdx.x >> 6, wm = wave & 1, wn = wave >> 1, l31 = lane & 31, hi = lane >> 5;
#pragma unroll
            for (int mi = 0; mi < 2; ++mi) {
                const int m = m0 + 64 * wm + 32 * mi + l31;
#pragma unroll
                for (int ni = 0; ni < 2; ++ni) {
                    const int nbg = n0 + nb_of<0>(wn, ni);
#pragma unroll
                    for (int gq = 0; gq < 4; ++gq) {
                        f32x4 w = {acc[mi][ni][4 * gq], acc[mi][ni][4 * gq + 1], acc[mi][ni][4 * gq + 2], acc[mi][ni][4 * gq + 3]};
                        *(f32x4*)(lg + (size_t)m * NE + nbg + 8 * gq + 4 * hi) = w;
                    }
                }
            }
        };
        gemm_tile<0>(L, Dm / 32, NE, arow, bcol, epi);
    }
}

__device__ __forceinline__ void phase_route(const Params& p, int v, int G) {
    const int lane = threadIdx.x & 63, wave = threadIdx.x >> 6;
    const float* lg = (const float*)(p.ws + WS_LOG);
    const float* rb = p.in[21];
    int* cnt = (int*)(p.ws + WS_CTL);
    int* la = (int*)(p.ws + WS_LA); float* lw = (float*)(p.ws + WS_LW);
    const f32x4 bias = *(const f32x4*)(rb + 4 * lane);
    const int grp = lane >> 3;
    for (int t = v * 4 + wave; t < T; t += G * 4) {
        const f32x4 lgv = *(const f32x4*)(lg + (size_t)t * NE + 4 * lane);
        float s0 = 1.f / (1.f + __expf(-lgv[0])), s1 = 1.f / (1.f + __expf(-lgv[1])), s2 = 1.f / (1.f + __expf(-lgv[2])), s3 = 1.f / (1.f + __expf(-lgv[3]));
        float v0 = s0 + bias[0], v1 = s1 + bias[1], v2 = s2 + bias[2], v3 = s3 + bias[3];
        float t1 = fmaxf(v0, v1), t2 = fminf(v0, v1);
        { const float a = fmaxf(v2, v3), bq = fminf(v2, v3); const float n1 = fmaxf(t1, a), n2 = fmaxf(fminf(t1, a), fmaxf(t2, bq)); t1 = n1; t2 = n2; }
#pragma unroll
        for (int off = 1; off <= 4; off <<= 1) {
            const float o1 = __shfl_xor(t1, off), o2 = __shfl_xor(t2, off);
            const float n1 = fmaxf(t1, o1), n2 = fmaxf(fminf(t1, o1), fmaxf(t2, o2)); t1 = n1; t2 = n2;
        }
        const float gs = t1 + t2;
        int rank = 0;
#pragma unroll
        for (int gg = 0; gg < 8; ++gg) { const float og = __shfl(gs, gg * 8); rank += (og > gs || (og == gs && gg < grp)) ? 1 : 0; }
        if (rank >= 4) { v0 = -INFINITY; v1 = -INFINITY; v2 = -INFINITY; v3 = -INFINITY; }
        float wsum = 0.f, myw = 0.f; int mye = 0;
#pragma unroll
        for (int it = 0; it < TOPK; ++it) {
            float bv = v0; int bi = 0;
            if (v1 > bv) { bv = v1; bi = 1; }
            if (v2 > bv) { bv = v2; bi = 2; }
            if (v3 > bv) { bv = v3; bi = 3; }
            int idx = 4 * lane + bi;
#pragma unroll
            for (int off = 32; off >= 1; off >>= 1) {
                const float ov = __shfl_xor(bv, off); const int oi = __shfl_xor(idx, off);
                if (ov > bv || (ov == bv && oi < idx)) { bv = ov; idx = oi; }
            }
            const int jj = idx & 3, owner = idx >> 2;
            const float mys = jj == 0 ? s0 : (jj == 1 ? s1 : (jj == 2 ? s2 : s3));
            const float scv = __shfl(mys, owner);
            if (lane == owner) { if (jj == 0) v0 = -INFINITY; else if (jj == 1) v1 = -INFINITY; else if (jj == 2) v2 = -INFINITY; else v3 = -INFINITY; }
            wsum += scv;
            if (lane == it) { myw = scv; mye = idx; }
        }
        if (lane < TOPK) {
            const float w = myw / wsum * 2.5f;
            const int pos = atomicAdd(cnt + mye, 1);
            if (pos < LISTCAP) { la[(size_t)mye * LISTCAP + pos] = t * TOPK + lane; lw[(size_t)mye * LISTCAP + pos] = w; }
        }
    }
}

__device__ __forceinline__ void moe_prefix(const Params& p, LAS char* L) {
    const int tid = threadIdx.x;
    const int* cnt = (const int*)(p.ws + WS_CTL);
    LAS int* pre = (LAS int*)(L + 36864);
    LAS int* tl = (LAS int*)(L + 36864 + 1088);
    __syncthreads();
    for (int i = tid; i < 257; i += 256) { int c = (i < 256) ? cnt[i] : T; if (c > LISTCAP) c = LISTCAP; tl[i] = (c + 127) >> 7; }
    __syncthreads();
    if (tid == 0) { int s = 0; for (int i = 0; i < 257; ++i) { pre[i] = s; s += tl[i]; } pre[257] = s; }
    __syncthreads();
}
__device__ __forceinline__ int moe_find(LAS int* pre, int g) {
    int lo = 0, hi = 256;
    while (lo < hi) { const int mid = (lo + hi + 1) >> 1; if (pre[mid] <= g) lo = mid; else hi = mid - 1; }
    return lo;
}

__device__ __forceinline__ void phase_moe1(const Params& p, LAS char* L, int v, int G) {
    const bf16_t* h2 = (const bf16_t*)(p.ws + WS_H2);
    const int* cnt = (const int*)(p.ws + WS_CTL);
    const int* la = (const int*)(p.ws + WS_LA);
    bf16_t* hb = (bf16_t*)(p.ws + WS_HB);
    moe_prefix(p, L);
    LAS int* pre = (LAS int*)(L + 36864);
    const int total = pre[257] * 4;
    for (int u = v; u < total; u += G) {
        const int g = u >> 2, nt = u & 3, j0 = nt * 64;
        const int e = moe_find(pre, g), mt = g - pre[e];
        int c = (e < 256) ? cnt[e] : T; if (c > LISTCAP) c = LISTCAP;
        const int rows = min(128, c - mt * 128);
        const float* wg = (e < 256) ? p.in[22] + (size_t)e * Dm * 256 : p.in[25];
        const float* wu = (e < 256) ? p.in[23] + (size_t)e * Dm * 256 : p.in[26];
        const int* lst = la + (size_t)e * LISTCAP + mt * 128;
        auto aidx = [&](int r) -> int { const int rr = r < rows ? r : 0; return (e < 256) ? lst[rr] : (AR + mt * 128 + rr); };
        auto arow = [&](int r) { const int a = aidx(r); const int tok = (e < 256) ? (a >> 3) : (a - AR); return h2 + (size_t)tok * Dm; };
        auto bcol = [&](int c4) { return (c4 < 64) ? (wg + j0 + c4) : (wu + j0 + c4 - 64); };
        auto epi = [&](f32x16 (&acc)[2][2]) {
            const int lane = threadIdx.x & 63, wave = threadIdx.x >> 6, wm = wave & 1, wn = wave >> 1, l31 = lane & 31, hi = lane >> 5;
#pragma unroll
            for (int mi = 0; mi < 2; ++mi) {
                const int r = 64 * wm + 32 * mi + l31;
                if (r < rows) {
                    const int a = aidx(r);
                    bf16_t* dst = hb + (size_t)a * 256 + j0 + 32 * wn + 4 * hi;
#pragma unroll
                    for (int gq = 0; gq < 4; ++gq) {
                        float hv[4];
#pragma unroll
                        for (int e2 = 0; e2 < 4; ++e2) hv[e2] = silu_f(acc[mi][0][4 * gq + e2]) * acc[mi][1][4 * gq + e2];
                        u32x2 w; w.x = pk2(hv[0], hv[1]); w.y = pk2(hv[2], hv[3]);
                        *(u32x2*)(dst + 8 * gq) = w;
                    }
                }
            }
        };
        gemm_tile<1>(L, Dm / 32, 256, arow, bcol, epi);
    }
}

__device__ __forceinline__ void phase_moe2(const Params& p, LAS char* L, int v, int G) {
    const int* cnt = (const int*)(p.ws + WS_CTL);
    const int* la = (const int*)(p.ws + WS_LA); const float* lw = (const float*)(p.ws + WS_LW);
    const bf16_t* hb = (const bf16_t*)(p.ws + WS_HB);
    bf16_t* yb = (bf16_t*)(p.ws + WS_YB);
    moe_prefix(p, L);
    LAS int* pre = (LAS int*)(L + 36864);
    const int total = pre[257] * 8;
    for (int u = v; u < total; u += G) {
        const int g = u >> 3, nt = u & 7, n0 = nt * 128;
        const int e = moe_find(pre, g), mt = g - pre[e];
        int c = (e < 256) ? cnt[e] : T; if (c > LISTCAP) c = LISTCAP;
        const int rows = min(128, c - mt * 128);
        const float* wd = (e < 256) ? p.in[24] + (size_t)e * 256 * Dm : p.in[27];
        const int* lst = la + (size_t)e * LISTCAP + mt * 128;
        const float* lwt = lw + (size_t)e * LISTCAP + mt * 128;
        auto aidx = [&](int r) -> int { const int rr = r < rows ? r : 0; return (e < 256) ? lst[rr] : (AR + mt * 128 + rr); };
        auto arow = [&](int r) { return hb + (size_t)aidx(r) * 256; };
        auto bcol = [&](int c4) { return wd + n0 + c4; };
        auto epi = [&](f32x16 (&acc)[2][2]) {
            const int lane = threadIdx.x & 63, wave = threadIdx.x >> 6, wm = wave & 1, wn = wave >> 1, l31 = lane & 31, hi = lane >> 5;
#pragma unroll
            for (int mi = 0; mi < 2; ++mi) {
                const int r = 64 * wm + 32 * mi + l31;
                if (r < rows) {
                    const int a = aidx(r);
                    const float w = (e < 256) ? lwt[r] : 1.f;
#pragma unroll
                    for (int ni = 0; ni < 2; ++ni) {
                        bf16_t* dst = yb + (size_t)a * Dm + n0 + nb_of<0>(wn, ni) + 4 * hi;
#pragma unroll
                        for (int gq = 0; gq < 4; ++gq) {
                            u32x2 o; o.x = pk2(acc[mi][ni][4 * gq] * w, acc[mi][ni][4 * gq + 1] * w); o.y = pk2(acc[mi][ni][4 * gq + 2] * w, acc[mi][ni][4 * gq + 3] * w);
                            *(u32x2*)(dst + 8 * gq) = o;
                        }
                    }
                }
            }
        };
        gemm_tile<0>(L, 256 / 32, Dm, arow, bcol, epi);
    }
}

__device__ __forceinline__ void phase_final(const Params& p, int v, int G) {
    const int lane = threadIdx.x & 63, wave = threadIdx.x >> 6;
    const float* pg = p.in[19];
    const float* mod = (const float*)(p.ws + WS_MOD);
    const bf16_t* yb = (const bf16_t*)(p.ws + WS_YB);
    for (int t = v * 4 + wave; t < T; t += G * 4) {
        const int b = t / SEQ;
        const float* gf = mod + b * 6144 + 5120;
        float y[2][8];
#pragma unroll
        for (int j = 0; j < 2; ++j)
#pragma unroll
            for (int e = 0; e < 8; ++e) y[j][e] = 0.f;
#pragma unroll
        for (int k = 0; k < 9; ++k) {
            const size_t row = (k < 8) ? ((size_t)t * TOPK + k) : ((size_t)AR + t);
#pragma unroll
            for (int j = 0; j < 2; ++j) {
                const u32x4 raw = *(const u32x4*)(yb + row * Dm + 8 * (lane + 64 * j));
#pragma unroll
                for (int e = 0; e < 4; ++e) { y[j][2 * e] += bflo(raw[e]); y[j][2 * e + 1] += bfhi(raw[e]); }
            }
        }
        float ss = 0.f;
#pragma unroll
        for (int j = 0; j < 2; ++j)
#pragma unroll
            for (int e = 0; e < 8; ++e) ss += y[j][e] * y[j][e];
        ss = wave_sum(ss);
        const float rstd = rsqrtf(ss * (1.f / Dm) + 1e-6f);
#pragma unroll
        for (int j = 0; j < 2; ++j) {
            const int col = 8 * (lane + 64 * j);
#pragma unroll
            for (int hq = 0; hq < 2; ++hq) {
                f32x4 xo = *(const f32x4*)(p.out + (size_t)t * Dm + col + 4 * hq);
                const f32x4 gv = *(const f32x4*)(pg + col + 4 * hq), gg = *(const f32x4*)(gf + col + 4 * hq);
#pragma unroll
                for (int e = 0; e < 4; ++e) xo[e] += gg[e] * (y[j][4 * hq + e] * rstd * gv[e]);
                *(f32x4*)(p.out + (size_t)t * Dm + col + 4 * hq) = xo;
            }
        }
    }
}

__global__ void __launch_bounds__(256, 2) mega(Params p) {
    __shared__ __attribute__((aligned(16))) char smem[LDS_BYTES];
    LAS char* L = (LAS char*)smem;
    cg::grid_group grid = cg::this_grid();
    const int G = gridDim.x, bx = blockIdx.x;
    const int v = (G % 8 == 0) ? (bx % 8) * (G / 8) + bx / 8 : bx;
    phase_mod(p, L, v, G);
    grid.sync();
    phase_h1(p, v, G);
    grid.sync();
    phase_proj(p, L, v, G);
    grid.sync();
    phase_norms(p, v, G);
    grid.sync();
    phase_qkv(p, L, v, G);
    grid.sync();
    phase_attn(p, L, v, G);
    grid.sync();
    phase_oproj(p, L, v, G);
    grid.sync();
    phase_post_attn(p, v, G);
    grid.sync();
    phase_router(p, L, v, G);
    grid.sync();
    phase_route(p, v, G);
    grid.sync();
    phase_moe1(p, L, v, G);
    grid.sync();
    phase_moe2(p, L, v, G);
    grid.sync();
    phase_final(p, v, G);
}

extern "C" void kernel_launch(void* const* d_in, const int* in_sizes, int n_in, void* d_out, int out_size, void* d_ws, size_t ws_size, hipStream_t stream) {
    static int grid_blocks = 0;
    if (grid_blocks == 0) {
        if (n_in != 28 || out_size != T * Dm || ws_size < WS_END) {
            fprintf(stderr, "kernel_launch: unexpected problem (n_in %d, out %d, ws %zu); nothing launched\n", n_in, out_size, ws_size);
            grid_blocks = -1; return;
        }
        int dev = 0, cus = 0, per_cu = 0;
        hipGetDevice(&dev);
        hipDeviceGetAttribute(&cus, hipDeviceAttributeMultiprocessorCount, dev);
        hipOccupancyMaxActiveBlocksPerMultiprocessor(&per_cu, mega, 256, 0);
        if (per_cu > 2) per_cu = 2;
        if (per_cu < 1) per_cu = 1;
        grid_blocks = cus * per_cu;
        fprintf(stderr, "kernel_launch: %d CUs x %d blocks\n", cus, per_cu);
    }
    if (grid_blocks < 0) return;
    hipMemsetAsync((char*)d_ws + WS_CTL, 0, CTL_BYTES, stream);
    Params p{};
    for (int i = 0; i < 28; ++i) p.in[i] = (const float*)d_in[i];
    p.out = (float*)d_out; p.ws = (char*)d_ws;
    void* args[] = {&p};
    hipError_t e = hipLaunchCooperativeKernel((void*)mega, dim3(grid_blocks), dim3(256), args, 0, stream);
    if (e != hipSuccess) fprintf(stderr, "cooperative launch failed: %s (grid %d)\n", hipGetErrorString(e), grid_blocks);
}
```

```cpp
#include <hip/hip_runtime.h>
#include <hip/hip_cooperative_groups.h>
#include <cstdio>
#include <cstdint>
namespace cg = cooperative_groups;

#ifndef NAIVE_CORE
#define NAIVE_CORE 0
#endif
#ifndef NAIVE_ATTN
#define NAIVE_ATTN 0
#endif

typedef unsigned short bf16_t;
typedef short bf16x8 __attribute__((ext_vector_type(8)));
typedef short s16x4 __attribute__((ext_vector_type(4)));
typedef short v4i16_t __attribute__((ext_vector_type(4)));
typedef float f32x16 __attribute__((ext_vector_type(16)));
typedef float f32x4 __attribute__((ext_vector_type(4)));
typedef float f32x2 __attribute__((ext_vector_type(2)));
typedef unsigned u32x4 __attribute__((ext_vector_type(4)));
typedef unsigned u32x2 __attribute__((ext_vector_type(2)));
#define LAS __attribute__((address_space(3)))

constexpr int Dm = 1024, NB = 8, SEQ = 2048, T = NB * SEQ;
constexpr int NIN = 1952;
constexpr int C_CQ = 0, C_CKV = 256, C_KR = 384, C_DQ = 416, C_DK = 928, C_DV = 1440;
constexpr int NE = 256, TOPK = 8, AR = T * TOPK, HROWS = AR + T;
constexpr int LISTCAP = T;
constexpr float LOG2E = 1.4426950408889634f;
constexpr float LAMBDA_INIT = 0.2f;

constexpr size_t MiB = 1u << 20;
constexpr size_t WS_CTL = 0, CTL_BYTES = 65536;
constexpr size_t WS_MOD = 65536;
constexpr size_t WS_ROPE = 1 * MiB;
constexpr size_t WS_H1 = 4 * MiB;
constexpr size_t WS_PROJ = 36 * MiB;
constexpr size_t WS_CQN = 100 * MiB;
constexpr size_t WS_CKVN = 108 * MiB;
constexpr size_t WS_QM = 112 * MiB;
constexpr size_t WS_KF = 136 * MiB;
constexpr size_t WS_VM = 160 * MiB;
constexpr size_t WS_ATT = 176 * MiB;
constexpr size_t WS_OD0 = 208 * MiB;
constexpr size_t WS_Y1 = 240 * MiB;
constexpr size_t WS_H2 = 304 * MiB;
constexpr size_t WS_LOG = 336 * MiB;
constexpr size_t WS_LA = 352 * MiB;
constexpr size_t WS_LW = 368 * MiB;
constexpr size_t WS_HB = 384 * MiB;
constexpr size_t WS_YB = 456 * MiB;
constexpr size_t WS_END = 744 * MiB;

constexpr int LDS_BYTES = 41984;

struct Params {
    const float* in[28];
    float* out;
    char* ws;
};

__device__ __forceinline__ unsigned short f2bf(float f) { __bf16 b = (__bf16)f; return __builtin_bit_cast(unsigned short, b); }
__device__ __forceinline__ unsigned pk2(float lo, float hi) { return (unsigned)f2bf(lo) | ((unsigned)f2bf(hi) << 16); }
__device__ __forceinline__ float bf2f(unsigned short b) { return __uint_as_float(((unsigned)b) << 16); }
__device__ __forceinline__ float bflo(unsigned u) { return __uint_as_float(u << 16); }
__device__ __forceinline__ float bfhi(unsigned u) { return __uint_as_float(u & 0xffff0000u); }
__device__ __forceinline__ int crow(int r, int hi) { return (r & 3) + 8 * (r >> 2) + 4 * hi; }
__device__ __forceinline__ float wave_sum(float v) {
#pragma unroll
    for (int o = 32; o >= 1; o >>= 1) v += __shfl_xor(v, o);
    return v;
}
__device__ __forceinline__ float wave_max(float v) {
#pragma unroll
    for (int o = 32; o >= 1; o >>= 1) v = fmaxf(v, __shfl_xor(v, o));
    return v;
}
__device__ __forceinline__ float silu_f(float v) { return v / (1.f + __expf(-v)); }
__device__ __forceinline__ s16x4 tr_read(LAS char* p) {
    return __builtin_bit_cast(s16x4, __builtin_amdgcn_ds_read_tr16_b64_v4i16((LAS v4i16_t*)p));
}
#define MFMA32(a, b, c) __builtin_amdgcn_mfma_f32_32x32x16_bf16(a, b, c, 0, 0, 0)

template <int NBMODE> __device__ __forceinline__ int nb_of(int wn, int ni) { return NBMODE == 0 ? 64 * wn + 32 * ni : 32 * wn + 64 * ni; }

template <int NBMODE, class AF, class BF, class EF>
__device__ __forceinline__ void gemm_tile(LAS char* L, int nk, long ldw, AF arow, BF bcol, EF epi) {
    const int tid = threadIdx.x, lane = tid & 63, wave = tid >> 6;
    const int wm = wave & 1, wn = wave >> 1, l31 = lane & 31, hi = lane >> 5;
    const int a_chunk = tid & 3, a_row = tid >> 2;
    const bf16_t* ap0 = arow(a_row) + a_chunk * 8;
    const bf16_t* ap1 = arow(a_row + 64) + a_chunk * 8;
    const int a_w0 = a_row * 64 + 16 * (a_chunk ^ ((a_row >> 2) & 3));
    const int a_w1 = a_w0 + 4096;
    const int b_n4 = tid & 31, b_kr = tid >> 5;
    const float* bp = bcol(4 * b_n4) + (long)b_kr * ldw;
    const int b_w = 8192 + b_kr * 320 + 8 * b_n4;
    const int sw = (l31 >> 2) & 3;
    const int xoff = (64 * wm + l31) * 64;
    const int woff = 8192 + (8 * hi + ((lane & 15) >> 2)) * 320 + 2 * (16 * ((lane >> 4) & 1) + 4 * (lane & 3));
    f32x16 acc[2][2];
#pragma unroll
    for (int i = 0; i < 2; ++i)
#pragma unroll
        for (int j = 0; j < 2; ++j)
#pragma unroll
            for (int r = 0; r < 16; ++r) acc[i][j][r] = 0.f;
    u32x4 ra0, ra1; f32x4 rb[4];
    ra0 = *(const u32x4*)(ap0); ra1 = *(const u32x4*)(ap1);
#pragma unroll
    for (int i = 0; i < 4; ++i) rb[i] = *(const f32x4*)(bp + (long)(8 * i) * ldw);
    for (int kt = 0; kt < nk; ++kt) {
        *(LAS u32x4*)(L + a_w0) = ra0; *(LAS u32x4*)(L + a_w1) = ra1;
#pragma unroll
        for (int i = 0; i < 4; ++i) { u32x2 w; w.x = pk2(rb[i][0], rb[i][1]); w.y = pk2(rb[i][2], rb[i][3]); *(LAS u32x2*)(L + b_w + i * 8 * 320) = w; }
        __syncthreads();
        if (kt + 1 < nk) {
            ra0 = *(const u32x4*)(ap0 + (kt + 1) * 32); ra1 = *(const u32x4*)(ap1 + (kt + 1) * 32);
#pragma unroll
            for (int i = 0; i < 4; ++i) rb[i] = *(const f32x4*)(bp + (long)((kt + 1) * 32 + 8 * i) * ldw);
        }
#if NAIVE_CORE
#pragma unroll
        for (int mi = 0; mi < 2; ++mi)
#pragma unroll
            for (int ni = 0; ni < 2; ++ni) {
                const int m = 64 * wm + 32 * mi + l31; const int nb = nb_of<NBMODE>(wn, ni);
                for (int k = 0; k < 32; ++k) {
                    const float xv = bf2f(*(LAS bf16_t*)(L + m * 64 + 16 * ((k >> 3) ^ ((m >> 2) & 3)) + 2 * (k & 7)));
#pragma unroll
                    for (int r = 0; r < 16; ++r) acc[mi][ni][r] += xv * bf2f(*(LAS bf16_t*)(L + 8192 + k * 320 + 2 * (nb + crow(r, hi))));
                }
            }
#else
#pragma unroll
        for (int ks = 0; ks < 2; ++ks) {
            bf16x8 xf[2], wf[2];
#pragma unroll
            for (int mi = 0; mi < 2; ++mi) xf[mi] = *(LAS bf16x8*)(L + xoff + mi * 2048 + 16 * ((2 * ks + hi) ^ sw));
#pragma unroll
            for (int ni = 0; ni < 2; ++ni) {
                LAS char* p = L + woff + ks * 16 * 320 + 2 * nb_of<NBMODE>(wn, ni);
                const s16x4 lo = tr_read(p), h4 = tr_read(p + 4 * 320);
                wf[ni] = (bf16x8){lo[0], lo[1], lo[2], lo[3], h4[0], h4[1], h4[2], h4[3]};
            }
#pragma unroll
            for (int mi = 0; mi < 2; ++mi)
#pragma unroll
                for (int ni = 0; ni < 2; ++ni) acc[mi][ni] = MFMA32(wf[ni], xf[mi], acc[mi][ni]);
        }
#endif
        __syncthreads();
    }
    epi(acc);
}

__device__ __forceinline__ void phase_mod(const Params& p, LAS char* L, int v, int G) {
    const int tid = threadIdx.x;
    const float* c = p.in[1]; const float* w_ada = p.in[3]; const float* b_ada = p.in[4];
    float* mod = (float*)(p.ws + WS_MOD);
    LAS float* sc = (LAS float*)L;
    LAS float* red = (LAS float*)(L + 32768);
    bool filled = false;
    for (int item = v; item < 384; item += G) {
        if (!filled) {
            for (int i = tid; i < 8 * 1024; i += 256) sc[i] = silu_f(c[i]);
            __syncthreads(); filled = true;
        }
        const int cx = tid & 15, kl = tid >> 4, col = item * 16 + cx;
        float a[8];
#pragma unroll
        for (int b = 0; b < 8; ++b) a[b] = 0.f;
#pragma unroll 4
        for (int k = kl; k < 1024; k += 16) {
            const float w = w_ada[(size_t)k * 6144 + col];
#pragma unroll
            for (int b = 0; b < 8; ++b) a[b] += sc[b * 1024 + k] * w;
        }
#pragma unroll
        for (int b = 0; b < 8; ++b) red[(b * 16 + kl) * 16 + cx] = a[b];
        __syncthreads();
        if (tid < 128) {
            const int b = tid >> 4, cc = tid & 15; float s = 0.f;
#pragma unroll
            for (int k = 0; k < 16; ++k) s += red[(b * 16 + k) * 16 + cc];
            mod[b * 6144 + item * 16 + cc] = s + b_ada[item * 16 + cc];
        }
        __syncthreads();
    }
}

__device__ __forceinline__ void phase_h1(const Params& p, int v, int G) {
    const int lane = threadIdx.x & 63, wave = threadIdx.x >> 6;
    const float* x = p.in[0]; const int* positions = (const int*)p.in[2]; const float* g = p.in[5];
    const float* mod = (const float*)(p.ws + WS_MOD);
    bf16_t* h1 = (bf16_t*)(p.ws + WS_H1);
    f32x2* rope = (f32x2*)(p.ws + WS_ROPE);
    for (int t = v * 4 + wave; t < T; t += G * 4) {
        const int b = t / SEQ;
        const f32x4* xr = (const f32x4*)(x + (size_t)t * Dm);
        f32x4 xv[4]; float ss = 0.f;
#pragma unroll
        for (int j = 0; j < 4; ++j) { xv[j] = xr[lane + 64 * j]; ss += xv[j][0] * xv[j][0] + xv[j][1] * xv[j][1] + xv[j][2] * xv[j][2] + xv[j][3] * xv[j][3]; }
        ss = wave_sum(ss);
        const float rstd = rsqrtf(ss * (1.f / Dm) + 1e-6f);
        const float* sh = mod + b * 6144; const float* scl = sh + 1024;
#pragma unroll
        for (int j = 0; j < 4; ++j) {
            const int col = 4 * (lane + 64 * j);
            const f32x4 gv = *(const f32x4*)(g + col), sv = *(const f32x4*)(scl + col), hv = *(const f32x4*)(sh + col);
            float o[4];
#pragma unroll
            for (int e = 0; e < 4; ++e) o[e] = (xv[j][e] * rstd * gv[e]) * (1.f + sv[e]) + hv[e];
            u32x2 w; w.x = pk2(o[0], o[1]); w.y = pk2(o[2], o[3]);
            *(u32x2*)(h1 + (size_t)t * Dm + col) = w;
        }
        if (lane < 16) {
            const double inv = exp2(-(double)lane * (13.287712379549449 / 16.0));
            const double rev = (double)positions[t] * inv * 0.15915494309189535;
            const float fr = (float)(rev - rint(rev));
            f32x2 cs; cs.x = __builtin_amdgcn_cosf(fr); cs.y = __builtin_amdgcn_sinf(fr);
            rope[(size_t)t * 16 + lane] = cs;
        }
    }
}

__device__ __forceinline__ void phase_proj(const Params& p, LAS char* L, int v, int G) {
    const bf16_t* h1 = (const bf16_t*)(p.ws + WS_H1);
    const float* w_in = p.in[7];
    bf16_t* proj = (bf16_t*)(p.ws + WS_PROJ);
    for (int u = v; u < 128 * 16; u += G) {
        const int mt = u >> 4, nt = u & 15, m0 = mt * 128, n0 = nt * 128;
        auto arow = [&](int r) { return h1 + (size_t)(m0 + r) * Dm; };
        auto bcol = [&](int c) { int col = n0 + c; if (col > NIN - 4) col = NIN - 4; return w_in + col; };
        auto epi = [&](f32x16 (&acc)[2][2]) {
            const int lane = threadIdx.x & 63, wave = threadIdx.x >> 6, wm = wave & 1, wn = wave >> 1, l31 = lane & 31, hi = lane >> 5;
#pragma unroll
            for (int mi = 0; mi < 2; ++mi) {
                const int m = m0 + 64 * wm + 32 * mi + l31;
#pragma unroll
                for (int ni = 0; ni < 2; ++ni) {
                    const int nbg = n0 + nb_of<0>(wn, ni);
                    if (nbg < NIN) {
                        const float sc = (nbg >= C_DQ && nbg < C_DK) ? 0.125f * LOG2E : 1.f;
#pragma unroll
                        for (int gq = 0; gq < 4; ++gq) {
                            u32x2 w; w.x = pk2(acc[mi][ni][4 * gq] * sc, acc[mi][ni][4 * gq + 1] * sc); w.y = pk2(acc[mi][ni][4 * gq + 2] * sc, acc[mi][ni][4 * gq + 3] * sc);
                            *(u32x2*)(proj + (size_t)m * NIN + nbg + 8 * gq + 4 * hi) = w;
                        }
                    }
                }
            }
        };
        gemm_tile<0>(L, Dm / 32, NIN, arow, bcol, epi);
    }
}

__device__ __forceinline__ void phase_norms(const Params& p, int v, int G) {
    const int lane = threadIdx.x & 63, wave = threadIdx.x >> 6;
    const bf16_t* proj = (const bf16_t*)(p.ws + WS_PROJ);
    const float* qg = p.in[8]; const float* kvg = p.in[9];
    bf16_t* cqn = (bf16_t*)(p.ws + WS_CQN); bf16_t* ckvn = (bf16_t*)(p.ws + WS_CKVN); bf16_t* kf = (bf16_t*)(p.ws + WS_KF);
    const f32x2* rope = (const f32x2*)(p.ws + WS_ROPE);
    for (int t = v * 4 + wave; t < T; t += G * 4) {
        const bf16_t* pr = proj + (size_t)t * NIN;
        {
            const u32x2 raw = *(const u32x2*)(pr + C_CQ + 4 * lane);
            float a[4] = {bflo(raw.x), bfhi(raw.x), bflo(raw.y), bfhi(raw.y)};
            float ss = wave_sum(a[0] * a[0] + a[1] * a[1] + a[2] * a[2] + a[3] * a[3]);
            const float rstd = rsqrtf(ss * (1.f / 256.f) + 1e-6f);
            const f32x4 gv = *(const f32x4*)(qg + 4 * lane);
            u32x2 w; w.x = pk2(a[0] * rstd * gv[0], a[1] * rstd * gv[1]); w.y = pk2(a[2] * rstd * gv[2], a[3] * rstd * gv[3]);
            *(u32x2*)(cqn + (size_t)t * 256 + 4 * lane) = w;
        }
        {
            const unsigned raw = *(const unsigned*)(pr + C_CKV + 2 * lane);
            const float a0 = bflo(raw), a1 = bfhi(raw);
            float ss = wave_sum(a0 * a0 + a1 * a1);
            const float rstd = rsqrtf(ss * (1.f / 128.f) + 1e-6f);
            *(unsigned*)(ckvn + (size_t)t * 128 + 2 * lane) = pk2(a0 * rstd * kvg[2 * lane], a1 * rstd * kvg[2 * lane + 1]);
        }
        if (lane < 16) {
            const float x1 = bf2f(pr[C_KR + lane]), x2 = bf2f(pr[C_KR + 16 + lane]);
            const f32x2 cs = rope[(size_t)t * 16 + lane];
            const bf16_t y1 = f2bf(x1 * cs.x - x2 * cs.y), y2 = f2bf(x2 * cs.x + x1 * cs.y);
#pragma unroll
            for (int h = 0; h < 8; ++h) { kf[(size_t)t * 768 + h * 96 + 64 + lane] = y1; kf[(size_t)t * 768 + h * 96 + 80 + lane] = y2; }
        }
    }
}

__device__ __forceinline__ void phase_qkv(const Params& p, LAS char* L, int v, int G) {
    const bf16_t* cqn = (const bf16_t*)(p.ws + WS_CQN); const bf16_t* ckvn = (const bf16_t*)(p.ws + WS_CKVN);
    const float* w_uq = p.in[10]; const float* w_ukv = p.in[11];
    bf16_t* qm = (bf16_t*)(p.ws + WS_QM); bf16_t* kf = (bf16_t*)(p.ws + WS_KF); bf16_t* vm = (bf16_t*)(p.ws + WS_VM);
    const f32x2* rope = (const f32x2*)(p.ws + WS_ROPE);
    const float qscale = LOG2E * 0.10206207261596575f;
    for (int u = v; u < 128 * 14; u += G) {
        const int mt = u / 14, j = u % 14, m0 = mt * 128;
        if (j < 6) {
            const int n0 = j * 128;
            auto arow = [&](int r) { return cqn + (size_t)(m0 + r) * 256; };
            auto bcol = [&](int c) { return w_uq + n0 + c; };
            auto epi = [&](f32x16 (&acc)[2][2]) {
                const int lane = threadIdx.x & 63, wave = threadIdx.x >> 6, wm = wave & 1, wn = wave >> 1, l31 = lane & 31, hi = lane >> 5;
#pragma unroll
                for (int mi = 0; mi < 2; ++mi) {
                    const int m = m0 + 64 * wm + 32 * mi + l31;
#pragma unroll
                    for (int ni = 0; ni < 2; ++ni) {
                        const int nbg = n0 + nb_of<0>(wn, ni);
                        f32x16 a = acc[mi][ni];
                        if ((nbg % 96) == 64) {
#pragma unroll
                            for (int r = 0; r < 8; ++r) {
                                const f32x2 cs = rope[(size_t)m * 16 + crow(r, hi)];
                                const float x1 = a[r], x2 = a[r + 8];
                                a[r] = x1 * cs.x - x2 * cs.y; a[r + 8] = x2 * cs.x + x1 * cs.y;
                            }
                        }
#pragma unroll
                        for (int gq = 0; gq < 4; ++gq) {
                            u32x2 w; w.x = pk2(a[4 * gq] * qscale, a[4 * gq + 1] * qscale); w.y = pk2(a[4 * gq + 2] * qscale, a[4 * gq + 3] * qscale);
                            *(u32x2*)(qm + (size_t)m * 768 + nbg + 8 * gq + 4 * hi) = w;
                        }
                    }
                }
            };
            gemm_tile<0>(L, 256 / 32, 768, arow, bcol, epi);
        } else {
            const int n0 = (j - 6) * 128;
            auto arow = [&](int r) { return ckvn + (size_t)(m0 + r) * 128; };
            auto bcol = [&](int c) { return w_ukv + n0 + c; };
            auto epi = [&](f32x16 (&acc)[2][2]) {
                const int lane = threadIdx.x & 63, wave = threadIdx.x >> 6, wm = wave & 1, wn = wave >> 1, l31 = lane & 31, hi = lane >> 5;
#pragma unroll
                for (int mi = 0; mi < 2; ++mi) {
                    const int m = m0 + 64 * wm + 32 * mi + l31;
#pragma unroll
                    for (int ni = 0; ni < 2; ++ni) {
                        const int nbg = n0 + nb_of<0>(wn, ni);
                        const int h = nbg >> 7, d = nbg & 127;
                        bf16_t* dst = (d < 64) ? (kf + (size_t)m * 768 + h * 96 + d) : (vm + (size_t)m * 512 + h * 64 + (d - 64));
#pragma unroll
                        for (int gq = 0; gq < 4; ++gq) {
                            u32x2 w; w.x = pk2(acc[mi][ni][4 * gq], acc[mi][ni][4 * gq + 1]); w.y = pk2(acc[mi][ni][4 * gq + 2], acc[mi][ni][4 * gq + 3]);
                            *(u32x2*)(dst + 8 * gq + 4 * hi) = w;
                        }
                    }
                }
            };
            gemm_tile<0>(L, 128 / 32, 1024, arow, bcol, epi);
        }
    }
}

template <int DQK, int DV, bool ALIBI>
__device__ __forceinline__ void attn_map(LAS char* L, const bf16_t* Q, int ldq, const bf16_t* K, int ldk, const bf16_t* V, int ldv,
                                         const int* posrow, float slope2, int q0, f32x16 (&o)[DV / 32]) {
    constexpr int KSTR = DQK * 2 + 16, VSTR = DV * 2 + 64, KS = DQK / 16, ND = DV / 32;
    constexpr int K_OFF = 0, V_OFF = 64 * KSTR, P_OFF = V_OFF + 64 * VSTR;
    constexpr int KCH = DQK / 8, VCH = DV / 8;
    const int tid = threadIdx.x, lane = tid & 63, wave = tid >> 6, l31 = lane & 31, hi = lane >> 5;
    const int qrow = q0 + 32 * wave + l31;
    bf16x8 qf[KS];
#pragma unroll
    for (int s = 0; s < KS; ++s) qf[s] = *(const bf16x8*)(Q + (size_t)qrow * ldq + 16 * s + 8 * hi);
    const float posq = ALIBI ? (float)posrow[qrow] : 0.f;
#pragma unroll
    for (int d = 0; d < ND; ++d)
#pragma unroll
        for (int r = 0; r < 16; ++r) o[d][r] = 0.f;
    float m_run = -1e30f, l_run = 0.f;
    const int ntile = (q0 + 128) / 64;
    const int qmin = q0 + 32 * wave, qmax = qmin + 31;
    const int vbase = V_OFF + (4 * hi + ((lane & 15) >> 2)) * VSTR + 2 * (16 * ((lane >> 4) & 1) + 4 * (lane & 3));
    for (int tl = 0; tl < ntile; ++tl) {
        const int kb = tl * 64;
        __syncthreads();
#pragma unroll
        for (int i = 0; i < (64 * KCH) / 256; ++i) {
            const int c = tid + 256 * i, row = c / KCH, ch = c % KCH;
            *(LAS u32x4*)(L + K_OFF + row * KSTR + ch * 16) = *(const u32x4*)(K + (size_t)(kb + row) * ldk + ch * 8);
        }
#pragma unroll
        for (int i = 0; i < (64 * VCH) / 256; ++i) {
            const int c = tid + 256 * i, row = c / VCH, ch = c % VCH;
            *(LAS u32x4*)(L + V_OFF + row * VSTR + ch * 16) = *(const u32x4*)(V + (size_t)(kb + row) * ldv + ch * 8);
        }
        if (ALIBI && tid < 64) *(LAS float*)(L + P_OFF + 4 * tid) = (float)posrow[kb + tid];
        __syncthreads();
        if (kb <= qmax) {
            f32x16 s0, s1;
#pragma unroll
            for (int r = 0; r < 16; ++r) { s0[r] = 0.f; s1[r] = 0.f; }
#pragma unroll
            for (int s = 0; s < KS; ++s) {
                const bf16x8 k0 = *(LAS bf16x8*)(L + K_OFF + l31 * KSTR + 32 * s + 16 * hi);
                const bf16x8 k1 = *(LAS bf16x8*)(L + K_OFF + (32 + l31) * KSTR + 32 * s + 16 * hi);
                s0 = MFMA32(k0, qf[s], s0); s1 = MFMA32(k1, qf[s], s1);
            }
            if (ALIBI) {
#pragma unroll
                for (int r = 0; r < 16; ++r) {
                    const float pk0 = *(LAS float*)(L + P_OFF + 4 * crow(r, hi)), pk1 = *(LAS float*)(L + P_OFF + 4 * (32 + crow(r, hi)));
                    s0[r] -= slope2 * fabsf(posq - pk0); s1[r] -= slope2 * fabsf(posq - pk1);
                }
            }
            if (kb + 63 > qmin) {
#pragma unroll
                for (int r = 0; r < 16; ++r) {
                    const int key = kb + crow(r, hi);
                    if (key > qrow) s0[r] = -INFINITY;
                    if (key + 32 > qrow) s1[r] = -INFINITY;
                }
            }
            float mx = s0[0];
#pragma unroll
            for (int r = 1; r < 16; ++r) mx = fmaxf(mx, s0[r]);
#pragma unroll
            for (int r = 0; r < 16; ++r) mx = fmaxf(mx, s1[r]);
            mx = fmaxf(mx, __shfl_xor(mx, 32));
            const float m_new = fmaxf(m_run, mx);
            const float alpha = __builtin_amdgcn_exp2f(m_run - m_new);
            m_run = m_new;
            float ls = 0.f;
#pragma unroll
            for (int r = 0; r < 16; ++r) { s0[r] = __builtin_amdgcn_exp2f(s0[r] - m_new); s1[r] = __builtin_amdgcn_exp2f(s1[r] - m_new); ls += s0[r] + s1[r]; }
            l_run = l_run * alpha + ls;
#pragma unroll
            for (int d = 0; d < ND; ++d)
#pragma unroll
                for (int r = 0; r < 16; ++r) o[d][r] *= alpha;
            u32x4 pw[4];
#pragma unroll
            for (int j = 0; j < 4; ++j) {
                pw[0][j] = pk2(s0[2 * j], s0[2 * j + 1]); pw[1][j] = pk2(s0[8 + 2 * j], s0[8 + 2 * j + 1]);
                pw[2][j] = pk2(s1[2 * j], s1[2 * j + 1]); pw[3][j] = pk2(s1[8 + 2 * j], s1[8 + 2 * j + 1]);
            }
#pragma unroll
            for (int s = 0; s < 4; ++s) {
                const bf16x8 pf = __builtin_bit_cast(bf16x8, pw[s]);
#pragma unroll
                for (int d = 0; d < ND; ++d) {
                    LAS char* vp = L + vbase + 16 * s * VSTR + 64 * d;
                    const s16x4 lo = tr_read(vp), h4 = tr_read(vp + 8 * VSTR);
                    const bf16x8 vf = (bf16x8){lo[0], lo[1], lo[2], lo[3], h4[0], h4[1], h4[2], h4[3]};
                    o[d] = MFMA32(vf, pf, o[d]);
                }
            }
        }
    }
    const float lt = l_run + __shfl_xor(l_run, 32);
    const float inv = 1.f / lt;
#pragma unroll
    for (int d = 0; d < ND; ++d)
#pragma unroll
        for (int r = 0; r < 16; ++r) o[d][r] *= inv;
}

#if NAIVE_ATTN
template <int DQK, int DV, bool ALIBI>
__device__ __forceinline__ void naive_attn_row(LAS float* sc, const bf16_t* Qrow, const bf16_t* K, int ldk, const bf16_t* V, int ldv,
                                               const int* posrow, float slope2, int q, float& o0, float& o1) {
    const int lane = threadIdx.x & 63;
    float mx = -1e30f;
    for (int k = lane; k <= q; k += 64) {
        float s = 0.f;
        for (int d = 0; d < DQK; ++d) s += bf2f(Qrow[d]) * bf2f(K[(size_t)k * ldk + d]);
        if (ALIBI) s -= slope2 * fabsf((float)posrow[q] - (float)posrow[k]);
        sc[k] = s; mx = fmaxf(mx, s);
    }
    mx = wave_max(mx);
    float sum = 0.f;
    for (int k = lane; k <= q; k += 64) { const float pv = __builtin_amdgcn_exp2f(sc[k] - mx); sc[k] = pv; sum += pv; }
    sum = wave_sum(sum);
    asm volatile("s_waitcnt lgkmcnt(0)" ::: "memory");
    float a0 = 0.f, a1 = 0.f;
    for (int k = 0; k <= q; ++k) {
        const float pv = bf2f(f2bf(sc[k]));
        a0 += pv * bf2f(V[(size_t)k * ldv + lane]);
        if (DV == 128) a1 += pv * bf2f(V[(size_t)k * ldv + 64 + lane]);
    }
    o0 = a0 / sum; o1 = a1 / sum;
}
#endif

__device__ __forceinline__ void phase_attn(const Params& p, LAS char* L, int v, int G) {
    const int tid = threadIdx.x, lane = tid & 63, wave = tid >> 6, l31 = lane & 31, hi = lane >> 5;
    const int* positions = (const int*)p.in[2];
    const bf16_t* proj = (const bf16_t*)(p.ws + WS_PROJ);
    const bf16_t* qm = (const bf16_t*)(p.ws + WS_QM); const bf16_t* kf = (const bf16_t*)(p.ws + WS_KF); const bf16_t* vm = (const bf16_t*)(p.ws + WS_VM);
    bf16_t* att = (bf16_t*)(p.ws + WS_ATT);
    float* od0 = (float*)(p.ws + WS_OD0);
    const float* subg = p.in[16];
    float lam;
    {
        const float a = p.in[12][lane] * p.in[13][lane], b = p.in[14][lane] * p.in[15][lane];
        lam = __expf(wave_sum(a)) - __expf(wave_sum(b)) + LAMBDA_INIT;
    }
#if NAIVE_ATTN
    LAS float* sc = (LAS float*)L + wave * SEQ;
    for (int it = v * 4 + wave; it < NB * 12 * SEQ; it += G * 4) {
        const int q = it % SEQ, bh = it / SEQ, b = bh / 12, hh = bh % 12;
        const size_t t = (size_t)b * SEQ + q; const size_t tb = (size_t)b * SEQ;
        if (hh < 8) {
            float o0, o1;
            naive_attn_row<96, 64, false>(sc, qm + t * 768 + hh * 96, kf + tb * 768 + hh * 96, 768, vm + tb * 512 + hh * 64, 512, positions + tb, 0.f, q, o0, o1);
            att[t * 1024 + hh * 64 + lane] = f2bf(o0);
        } else {
            const int h = hh - 8; const float slope2 = exp2f(-2.f * (h + 1)) * LOG2E;
            float a0, a1, b0, b1;
            naive_attn_row<64, 128, true>(sc, proj + t * NIN + C_DQ + h * 128, proj + tb * NIN + C_DK + h * 128, NIN, proj + tb * NIN + C_DV + h * 128, NIN, positions + tb, slope2, q, a0, a1);
            naive_attn_row<64, 128, true>(sc, proj + t * NIN + C_DQ + h * 128 + 64, proj + tb * NIN + C_DK + h * 128 + 64, NIN, proj + tb * NIN + C_DV + h * 128, NIN, positions + tb, slope2, q, b0, b1);
            const float c0 = a0 - lam * b0, c1 = a1 - lam * b1;
            const float ss = wave_sum(c0 * c0 + c1 * c1);
            const float rstd = rsqrtf(ss * (1.f / 128.f) + 1e-5f) * (1.f - LAMBDA_INIT);
            att[t * 1024 + 512 + h * 128 + lane] = f2bf(c0 * rstd * subg[lane]);
            att[t * 1024 + 512 + h * 128 + 64 + lane] = f2bf(c1 * rstd * subg[64 + lane]);
        }
    }
#else
    for (int it = v; it < 16 * 96; it += G) {
        const int qb = 15 - it / 96, r = it % 96, q0 = qb * 128;
        if (r < 64) {
            const int b = r >> 3, h = r & 7; const size_t tb = (size_t)b * SEQ;
            f32x16 o[2];
            attn_map<96, 64, false>(L, qm + tb * 768 + h * 96, 768, kf + tb * 768 + h * 96, 768, vm + tb * 512 + h * 64, 512, positions + tb, 0.f, q0, o);
            const size_t t = tb + q0 + 32 * wave + l31;
#pragma unroll
            for (int d = 0; d < 2; ++d)
#pragma unroll
                for (int gq = 0; gq < 4; ++gq) {
                    u32x2 w; w.x = pk2(o[d][4 * gq], o[d][4 * gq + 1]); w.y = pk2(o[d][4 * gq + 2], o[d][4 * gq + 3]);
                    *(u32x2*)(att + t * 1024 + h * 64 + 32 * d + 8 * gq + 4 * hi) = w;
                }
        } else {
            const int b = (r - 64) >> 2, h = (r - 64) & 3; const size_t tb = (size_t)b * SEQ;
            const float slope2 = exp2f(-2.f * (h + 1)) * LOG2E;
            const size_t t = tb + q0 + 32 * wave + l31;
            f32x16 o[4];
            attn_map<64, 128, true>(L, proj + tb * NIN + C_DQ + h * 128, NIN, proj + tb * NIN + C_DK + h * 128, NIN, proj + tb * NIN + C_DV + h * 128, NIN, positions + tb, slope2, q0, o);
#pragma unroll
            for (int d = 0; d < 4; ++d)
#pragma unroll
                for (int gq = 0; gq < 4; ++gq) {
                    f32x4 w = {o[d][4 * gq], o[d][4 * gq + 1], o[d][4 * gq + 2], o[d][4 * gq + 3]};
                    *(f32x4*)(od0 + t * 512 + h * 128 + 32 * d + 8 * gq + 4 * hi) = w;
                }
            attn_map<64, 128, true>(L, proj + tb * NIN + C_DQ + h * 128 + 64, NIN, proj + tb * NIN + C_DK + h * 128 + 64, NIN, proj + tb * NIN + C_DV + h * 128, NIN, positions + tb, slope2, q0, o);
            float ss = 0.f;
#pragma unroll
            for (int d = 0; d < 4; ++d)
#pragma unroll
                for (int gq = 0; gq < 4; ++gq) {
                    const f32x4 w = *(const f32x4*)(od0 + t * 512 + h * 128 + 32 * d + 8 * gq + 4 * hi);
#pragma unroll
                    for (int e = 0; e < 4; ++e) { const float c = w[e] - lam * o[d][4 * gq + e]; o[d][4 * gq + e] = c; ss += c * c; }
                }
            ss += __shfl_xor(ss, 32);
            const float rstd = rsqrtf(ss * (1.f / 128.f) + 1e-5f) * (1.f - LAMBDA_INIT);
#pragma unroll
            for (int d = 0; d < 4; ++d)
#pragma unroll
                for (int gq = 0; gq < 4; ++gq) {
                    const int dv = 32 * d + 8 * gq + 4 * hi;
                    const f32x4 gv = *(const f32x4*)(subg + dv);
                    u32x2 w; w.x = pk2(o[d][4 * gq] * rstd * gv[0], o[d][4 * gq + 1] * rstd * gv[1]); w.y = pk2(o[d][4 * gq + 2] * rstd * gv[2], o[d][4 * gq + 3] * rstd * gv[3]);
                    *(u32x2*)(att + t * 1024 + 512 + h * 128 + dv) = w;
                }
        }
    }
#endif
}

__device__ __forceinline__ void phase_oproj(const Params& p, LAS char* L, int v, int G) {
    const bf16_t* att = (const bf16_t*)(p.ws + WS_ATT);
    const float* w_o = p.in[17];
    float* y1 = (float*)(p.ws + WS_Y1);
    for (int u = v; u < 128 * 8; u += G) {
        const int mt = u >> 3, nt = u & 7, m0 = mt * 128, n0 = nt * 128;
        auto arow = [&](int r) { return att + (size_t)(m0 + r) * Dm; };
        auto bcol = [&](int c) { return w_o + n0 + c; };
        auto epi = [&](f32x16 (&acc)[2][2]) {
            const int lane = threadIdx.x & 63, wave = threadIdx.x >> 6, wm = wave & 1, wn = wave >> 1, l31 = lane & 31, hi = lane >> 5;
#pragma unroll
            for (int mi = 0; mi < 2; ++mi) {
                const int m = m0 + 64 * wm + 32 * mi + l31;
#pragma unroll
                for (int ni = 0; ni < 2; ++ni) {
                    const int nbg = n0 + nb_of<0>(wn, ni);
#pragma unroll
                    for (int gq = 0; gq < 4; ++gq) {
                        f32x4 w = {acc[mi][ni][4 * gq], acc[mi][ni][4 * gq + 1], acc[mi][ni][4 * gq + 2], acc[mi][ni][4 * gq + 3]};
                        *(f32x4*)(y1 + (size_t)m * Dm + nbg + 8 * gq + 4 * hi) = w;
                    }
                }
            }
        };
        gemm_tile<0>(L, Dm / 32, Dm, arow, bcol, epi);
    }
}

__device__ __forceinline__ void phase_post_attn(const Params& p, int v, int G) {
    const int lane = threadIdx.x & 63, wave = threadIdx.x >> 6;
    const float* x = p.in[0]; const float* pg = p.in[6]; const float* fg = p.in[18];
    const float* mod = (const float*)(p.ws + WS_MOD);
    const float* y1 = (const float*)(p.ws + WS_Y1);
    bf16_t* h2 = (bf16_t*)(p.ws + WS_H2);
    for (int t = v * 4 + wave; t < T; t += G * 4) {
        const int b = t / SEQ;
        const float* mb = mod + b * 6144;
        f32x4 yv[4], xv[4]; float ss = 0.f;
#pragma unroll
        for (int j = 0; j < 4; ++j) {
            yv[j] = *(const f32x4*)(y1 + (size_t)t * Dm + 4 * (lane + 64 * j));
            xv[j] = *(const f32x4*)(x + (size_t)t * Dm + 4 * (lane + 64 * j));
            ss += yv[j][0] * yv[j][0] + yv[j][1] * yv[j][1] + yv[j][2] * yv[j][2] + yv[j][3] * yv[j][3];
        }
        ss = wave_sum(ss);
        const float rstd = rsqrtf(ss * (1.f / Dm) + 1e-6f);
        float ss2 = 0.f;
#pragma unroll
        for (int j = 0; j < 4; ++j) {
            const int col = 4 * (lane + 64 * j);
            const f32x4 gv = *(const f32x4*)(pg + col), ga = *(const f32x4*)(mb + 2048 + col);
#pragma unroll
            for (int e = 0; e < 4; ++e) { xv[j][e] = xv[j][e] + ga[e] * (yv[j][e] * rstd * gv[e]); ss2 += xv[j][e] * xv[j][e]; }
            *(f32x4*)(p.out + (size_t)t * Dm + col) = xv[j];
        }
        ss2 = wave_sum(ss2);
        const float rstd2 = rsqrtf(ss2 * (1.f / Dm) + 1e-6f);
#pragma unroll
        for (int j = 0; j < 4; ++j) {
            const int col = 4 * (lane + 64 * j);
            const f32x4 gv = *(const f32x4*)(fg + col), sv = *(const f32x4*)(mb + 4096 + col), hv = *(const f32x4*)(mb + 3072 + col);
            float o[4];
#pragma unroll
            for (int e = 0; e < 4; ++e) o[e] = (xv[j][e] * rstd2 * gv[e]) * (1.f + sv[e]) + hv[e];
            u32x2 w; w.x = pk2(o[0], o[1]); w.y = pk2(o[2], o[3]);
            *(u32x2*)(h2 + (size_t)t * Dm + col) = w;
        }
    }
}

__device__ __forceinline__ void phase_router(const Params& p, LAS char* L, int v, int G) {
    const bf16_t* h2 = (const bf16_t*)(p.ws + WS_H2);
    const float* rw = p.in[20];
    float* lg = (float*)(p.ws + WS_LOG);
    for (int u = v; u < 128 * 2; u += G) {
        const int mt = u >> 1, nt = u & 1, m0 = mt * 128, n0 = nt * 128;
        auto arow = [&](int r) { return h2 + (size_t)(m0 + r) * Dm; };
        auto bcol = [&](int c) { return rw + n0 + c; };
        auto epi = [&](f32x16 (&acc)[2][2]) {
            const int lane = threadIdx.x & 63, wave = threadIdx.x >> 6, wm = wave & 1, wn = wave >> 1, l31 = lane & 31, hi = lane >> 5;
#pragma unroll
            for (int mi = 0; mi < 2; ++mi) {
                const int m = m0 + 64 * wm + 32 * mi + l31;
#pragma unroll
                for (int ni = 0; ni < 2; ++ni) {
                    const int nbg = n0 + nb_of<0>(wn, ni);
#pragma unroll
                    for (int gq = 0; gq < 4; ++gq) {
                        f32x4 w = {acc[mi][ni][4 * gq], acc[mi][ni][4 * gq + 1], acc[mi][ni][4 * gq + 2], acc[mi][ni][4 * gq + 3]};
                        *(f32x4*)(lg + (size_t)m * NE + nbg + 8 * gq + 4 * hi) = w;
                    }
                }
            }
        };
        gemm_tile<0>(L, Dm / 32, NE, arow, bcol, epi);
    }
}

__device__ __forceinline__ void phase_route(const Params& p, int v, int G) {
    const int lane = threadIdx.x & 63, wave = threadIdx.x >> 6;
    const float* lg = (const float*)(p.ws + WS_LOG);
    const float* rb = p.in[21];
    int* cnt = (int*)(p.ws + WS_CTL);
    int* la = (int*)(p.ws + WS_LA); float* lw = (float*)(p.ws + WS_LW);
    const f32x4 bias = *(const f32x4*)(rb + 4 * lane);
    const int grp = lane >> 3;
    for (int t = v * 4 + wave; t < T; t += G * 4) {
        const f32x4 lgv = *(const f32x4*)(lg + (size_t)t * NE + 4 * lane);
        float s0 = 1.f / (1.f + __expf(-lgv[0])), s1 = 1.f / (1.f + __expf(-lgv[1])), s2 = 1.f / (1.f + __expf(-lgv[2])), s3 = 1.f / (1.f + __expf(-lgv[3]));
        float v0 = s0 + bias[0], v1 = s1 + bias[1], v2 = s2 + bias[2], v3 = s3 + bias[3];
        float t1 = fmaxf(v0, v1), t2 = fminf(v0, v1);
        { const float a = fmaxf(v2, v3), bq = fminf(v2, v3); const float n1 = fmaxf(t1, a), n2 = fmaxf(fminf(t1, a), fmaxf(t2, bq)); t1 = n1; t2 = n2; }
#pragma unroll
        for (int off = 1; off <= 4; off <<= 1) {
            const float o1 = __shfl_xor(t1, off), o2 = __shfl_xor(t2, off);
            const float n1 = fmaxf(t1, o1), n2 = fmaxf(fminf(t1, o1), fmaxf(t2, o2)); t1 = n1; t2 = n2;
        }
        const float gs = t1 + t2;
        int rank = 0;
#pragma unroll
        for (int gg = 0; gg < 8; ++gg) { const float og = __shfl(gs, gg * 8); rank += (og > gs || (og == gs && gg < grp)) ? 1 : 0; }
        if (rank >= 4) { v0 = -INFINITY; v1 = -INFINITY; v2 = -INFINITY; v3 = -INFINITY; }
        float wsum = 0.f, myw = 0.f; int mye = 0;
#pragma unroll
        for (int it = 0; it < TOPK; ++it) {
            float bv = v0; int bi = 0;
            if (v1 > bv) { bv = v1; bi = 1; }
            if (v2 > bv) { bv = v2; bi = 2; }
            if (v3 > bv) { bv = v3; bi = 3; }
            int idx = 4 * lane + bi;
#pragma unroll
            for (int off = 32; off >= 1; off >>= 1) {
                const float ov = __shfl_xor(bv, off); const int oi = __shfl_xor(idx, off);
                if (ov > bv || (ov == bv && oi < idx)) { bv = ov; idx = oi; }
            }
            const int jj = idx & 3, owner = idx >> 2;
            const float mys = jj == 0 ? s0 : (jj == 1 ? s1 : (jj == 2 ? s2 : s3));
            const float scv = __shfl(mys, owner);
            if (lane == owner) { if (jj == 0) v0 = -INFINITY; else if (jj == 1) v1 = -INFINITY; else if (jj == 2) v2 = -INFINITY; else v3 = -INFINITY; }
            wsum += scv;
            if (lane == it) { myw = scv; mye = idx; }
        }
        if (lane < TOPK) {
            const float w = myw / wsum * 2.5f;
            const int pos = atomicAdd(cnt + mye, 1);
            if (pos < LISTCAP) { la[(size_t)mye * LISTCAP + pos] = t * TOPK + lane; lw[(size_t)mye * LISTCAP + pos] = w; }
        }
    }
}

__device__ __forceinline__ void moe_prefix(const Params& p, LAS char* L) {
    const int tid = threadIdx.x;
    const int* cnt = (const int*)(p.ws + WS_CTL);
    LAS int* pre = (LAS int*)(L + 36864);
    LAS int* tl = (LAS int*)(L + 36864 + 1088);
    __syncthreads();
    for (int i = tid; i < 257; i += 256) { int c = (i < 256) ? cnt[i] : T; if (c > LISTCAP) c = LISTCAP; tl[i] = (c + 127) >> 7; }
    __syncthreads();
    if (tid == 0) { int s = 0; for (int i = 0; i < 257; ++i) { pre[i] = s; s += tl[i]; } pre[257] = s; }
    __syncthreads();
}
__device__ __forceinline__ int moe_find(LAS int* pre, int g) {
    int lo = 0, hi = 256;
    while (lo < hi) { const int mid = (lo + hi + 1) >> 1; if (pre[mid] <= g) lo = mid; else hi = mid - 1; }
    return lo;
}

__device__ __forceinline__ void phase_moe1(const Params& p, LAS char* L, int v, int G) {
    const bf16_t* h2 = (const bf16_t*)(p.ws + WS_H2);
    const int* cnt = (const int*)(p.ws + WS_CTL);
    const int* la = (const int*)(p.ws + WS_LA);
    bf16_t* hb = (bf16_t*)(p.ws + WS_HB);
    moe_prefix(p, L);
    LAS int* pre = (LAS int*)(L + 36864);
    const int total = pre[257] * 4;
    for (int u = v; u < total; u += G) {
        const int g = u >> 2, nt = u & 3, j0 = nt * 64;
        const int e = moe_find(pre, g), mt = g - pre[e];
        int c = (e < 256) ? cnt[e] : T; if (c > LISTCAP) c = LISTCAP;
        const int rows = min(128, c - mt * 128);
        const float* wg = (e < 256) ? p.in[22] + (size_t)e * Dm * 256 : p.in[25];
        const float* wu = (e < 256) ? p.in[23] + (size_t)e * Dm * 256 : p.in[26];
        const int* lst = la + (size_t)e * LISTCAP + mt * 128;
        auto aidx = [&](int r) -> int { const int rr = r < rows ? r : 0; return (e < 256) ? lst[rr] : (AR + mt * 128 + rr); };
        auto arow = [&](int r) { const int a = aidx(r); const int tok = (e < 256) ? (a >> 3) : (a - AR); return h2 + (size_t)tok * Dm; };
        auto bcol = [&](int c4) { return (c4 < 64) ? (wg + j0 + c4) : (wu + j0 + c4 - 64); };
        auto epi = [&](f32x16 (&acc)[2][2]) {
            const int lane = threadIdx.x & 63, wave = threadIdx.x >> 6, wm = wave & 1, wn = wave >> 1, l31 = lane & 31, hi = lane >> 5;
#pragma unroll
            for (int mi = 0; mi < 2; ++mi) {
                const int r = 64 * wm + 32 * mi + l31;
                if (r < rows) {
                    const int a = aidx(r);
                    bf16_t* dst = hb + (size_t)a * 256 + j0 + 32 * wn + 4 * hi;
#pragma unroll
                    for (int gq = 0; gq < 4; ++gq) {
                        float hv[4];
#pragma unroll
                        for (int e2 = 0; e2 < 4; ++e2) hv[e2] = silu_f(acc[mi][0][4 * gq + e2]) * acc[mi][1][4 * gq + e2];
                        u32x2 w; w.x = pk2(hv[0], hv[1]); w.y = pk2(hv[2], hv[3]);
                        *(u32x2*)(dst + 8 * gq) = w;
                    }
                }
            }
        };
        gemm_tile<1>(L, Dm / 32, 256, arow, bcol, epi);
    }
}

__device__ __forceinline__ void phase_moe2(const Params& p, LAS char* L, int v, int G) {
    const int* cnt = (const int*)(p.ws + WS_CTL);
    const int* la = (const int*)(p.ws + WS_LA); const float* lw = (const float*)(p.ws + WS_LW);
    const bf16_t* hb = (const bf16_t*)(p.ws + WS_HB);
    bf16_t* yb = (bf16_t*)(p.ws + WS_YB);
    moe_prefix(p, L);
    LAS int* pre = (LAS int*)(L + 36864);
    const int total = pre[257] * 8;
    for (int u = v; u < total; u += G) {
        const int g = u >> 3, nt = u & 7, n0 = nt * 128;
        const int e = moe_find(pre, g), mt = g - pre[e];
        int c = (e < 256) ? cnt[e] : T; if (c > LISTCAP) c = LISTCAP;
        const int rows = min(128, c - mt * 128);
        const float* wd = (e < 256) ? p.in[24] + (size_t)e * 256 * Dm : p.in[27];
        const int* lst = la + (size_t)e * LISTCAP + mt * 128;
        const float* lwt = lw + (size_t)e * LISTCAP + mt * 128;
        auto aidx = [&](int r) -> int { const int rr = r < rows ? r : 0; return (e < 256) ? lst[rr] : (AR + mt * 128 + rr); };
        auto arow = [&](int r) { return hb + (size_t)aidx(r) * 256; };
        auto bcol = [&](int c4) { return wd + n0 + c4; };
        auto epi = [&](f32x16 (&acc)[2][2]) {
            const int lane = threadIdx.x & 63, wave = threadIdx.x >> 6, wm = wave & 1, wn = wave >> 1, l31 = lane & 31, hi = lane >> 5;
#pragma unroll
            for (int mi = 0; mi < 2; ++mi) {
                const int r = 64 * wm + 32 * mi + l31;
                if (r < rows) {
                    const int a = aidx(r);
                    const float w = (e < 256) ? lwt[r] : 1.f;
#pragma unroll
                    for (int ni = 0; ni < 2; ++ni) {
                        bf16_t* dst = yb + (size_t)a * Dm + n0 + nb_of<0>(wn, ni) + 4 * hi;
#pragma unroll
                        for (int gq = 0; gq < 4; ++gq) {
                            u32x2 o; o.x = pk2(acc[mi][ni][4 * gq] * w, acc[mi][ni][4 * gq + 1] * w); o.y = pk2(acc[mi][ni][4 * gq + 2] * w, acc[mi][ni][4 * gq + 3] * w);
                            *(u32x2*)(dst + 8 * gq) = o;
                        }
                    }
                }
            }
        };
        gemm_tile<0>(L, 256 / 32, Dm, arow, bcol, epi);
    }
}

__device__ __forceinline__ void phase_final(const Params& p, int v, int G) {
    const int lane = threadIdx.x & 63, wave = threadIdx.x >> 6;
    const float* pg = p.in[19];
    const float* mod = (const float*)(p.ws + WS_MOD);
    const bf16_t* yb = (const bf16_t*)(p.ws + WS_YB);
    for (int t = v * 4 + wave; t < T; t += G * 4) {
        const int b = t / SEQ;
        const float* gf = mod + b * 6144 + 5120;
        float y[2][8];
#pragma unroll
        for (int j = 0; j < 2; ++j)
#pragma unroll
            for (int e = 0; e < 8; ++e) y[j][e] = 0.f;
#pragma unroll
        for (int k = 0; k < 9; ++k) {
            const size_t row = (k < 8) ? ((size_t)t * TOPK + k) : ((size_t)AR + t);
#pragma unroll
            for (int j = 0; j < 2; ++j) {
                const u32x4 raw = *(const u32x4*)(yb + row * Dm + 8 * (lane + 64 * j));
#pragma unroll
                for (int e = 0; e < 4; ++e) { y[j][2 * e] += bflo(raw[e]); y[j][2 * e + 1] += bfhi(raw[e]); }
            }
        }
        float ss = 0.f;
#pragma unroll
        for (int j = 0; j < 2; ++j)
#pragma unroll
            for (int e = 0; e < 8; ++e) ss += y[j][e] * y[j][e];
        ss = wave_sum(ss);
        const float rstd = rsqrtf(ss * (1.f / Dm) + 1e-6f);
#pragma unroll
        for (int j = 0; j < 2; ++j) {
            const int col = 8 * (lane + 64 * j);
#pragma unroll
            for (int hq = 0; hq < 2; ++hq) {
                f32x4 xo = *(const f32x4*)(p.out + (size_t)t * Dm + col + 4 * hq);
                const f32x4 gv = *(const f32x4*)(pg + col + 4 * hq), gg = *(const f32x4*)(gf + col + 4 * hq);
#pragma unroll
                for (int e = 0; e < 4; ++e) xo[e] += gg[e] * (y[j][4 * hq + e] * rstd * gv[e]);
                *(f32x4*)(p.out + (size_t)t * Dm + col + 4 * hq) = xo;
            }
        }
    }
}


#define XB_TMO      128
#define XB_XCNT(j)  (256  + 64 * (j))
#define XB_XSUB(j)  (1280 + 64 * (j))
#define XB_XGEN(j)  (2304 + 64 * (j))
#define XB_TOP      3328
#define XB_TOPGEN   3392
#define XCD_BAR_WORDS 3456
#define XB_SPIN_CAP (1u << 18)
__device__ __forceinline__ unsigned xb_ld(unsigned* p)              { return __hip_atomic_load(p, __ATOMIC_RELAXED, __HIP_MEMORY_SCOPE_AGENT); }
__device__ __forceinline__ unsigned xb_add(unsigned* p, unsigned v) { return __hip_atomic_fetch_add(p, v, __ATOMIC_RELAXED, __HIP_MEMORY_SCOPE_AGENT); }
__device__ __forceinline__ unsigned xb_xcc_id() { return (unsigned)__builtin_amdgcn_s_getreg((3 << 11) | 20) & 0xFu; }
#define XB_SPIN(cond, bar) do { unsigned _sp = 0; while (cond) { __builtin_amdgcn_s_sleep(1); \
    if ((++_sp & 255u) == 0u) { if (xb_ld(&(bar)[XB_TMO])) break; if (_sp > XB_SPIN_CAP) { atomicAdd(&(bar)[XB_TMO], 1u); break; } } } } while (0)
struct XcdBarrier { unsigned* bar; unsigned x; volatile LAS unsigned* st; };
__device__ __forceinline__ XcdBarrier xcd_barrier_post(unsigned* bar, volatile LAS unsigned* st) {
    XcdBarrier b; b.bar = bar; b.x = xb_xcc_id(); b.st = st;
    if (threadIdx.x == 0) (void)xb_add(&bar[XB_XCNT(b.x)], 1u);
    return b;
}
__device__ __forceinline__ void xcd_barrier_complete(unsigned* bar, unsigned x, unsigned& nloc, unsigned& nx) {
    const unsigned G = gridDim.x * gridDim.y * gridDim.z;
    unsigned sum, cnt, mine, sp = 0u;
    for (;;) {
        sum = 0u; cnt = 0u; mine = 0u;
#pragma unroll
        for (unsigned j = 0; j < 16; ++j) { const unsigned c = xb_ld(&bar[XB_XCNT(j)]); sum += c; cnt += (c > 0u) ? 1u : 0u; mine = (j == x) ? c : mine; }
        if (sum == G) break;
        __builtin_amdgcn_s_sleep(1);
        if ((++sp & 255u) == 0u) { if (xb_ld(&bar[XB_TMO])) break; if (sp > XB_SPIN_CAP) { atomicAdd(&bar[XB_TMO], 1u); break; } }
    }
    nloc = mine > 0u ? mine : 1u; nx = cnt > 0u ? cnt : 1u;
}
__device__ __forceinline__ void xcd_barrier(const XcdBarrier& b) {
    asm volatile("s_waitcnt vmcnt(0)" ::: "memory");
    __syncthreads();
    if (threadIdx.x == 0) {
        unsigned* bar = b.bar;
        __builtin_amdgcn_s_waitcnt(0);
        unsigned nloc = b.st[0], nx = b.st[1];
        if (nloc == 0u) { xcd_barrier_complete(bar, b.x, nloc, nx); b.st[0] = nloc; b.st[1] = nx; }
        const unsigned old = xb_add(&bar[XB_XSUB(b.x)], 1u);
        const unsigned gen = old / nloc;
        if (old + 1u == (gen + 1u) * nloc) {
            __builtin_amdgcn_fence(__ATOMIC_RELEASE, "agent");
            asm volatile("s_waitcnt vmcnt(0)" ::: "memory");
            const unsigned og = xb_add(&bar[XB_TOP], 1u);
            const unsigned tg = og / nx;
            if (og + 1u == (tg + 1u) * nx) xb_add(&bar[XB_TOPGEN], 1u);
            else XB_SPIN(xb_ld(&bar[XB_TOPGEN]) == tg, bar);
            __builtin_amdgcn_fence(__ATOMIC_ACQUIRE, "agent");
            xb_add(&bar[XB_XGEN(b.x)], 1u);
            asm volatile("s_waitcnt vmcnt(0)" ::: "memory");
        } else {
            XB_SPIN(xb_ld(&bar[XB_XGEN(b.x)]) == gen, bar);
            __builtin_amdgcn_fence(__ATOMIC_ACQUIRE, "agent");
            asm volatile("s_waitcnt vmcnt(0)" ::: "memory");
        }
    }
    __syncthreads();
}

__global__ void __launch_bounds__(256, 2) mega(Params p) {
    __shared__ __attribute__((aligned(16))) char smem[LDS_BYTES];
    LAS char* L = (LAS char*)smem;
    if (threadIdx.x < 4) ((LAS unsigned*)(L + 40960))[threadIdx.x] = 0u;
    __syncthreads();
    const XcdBarrier gbar = xcd_barrier_post((unsigned*)(p.ws + WS_CTL + 4096), (volatile LAS unsigned*)(L + 40960));
    const int G = gridDim.x, bx = blockIdx.x;
    const int v = (G % 8 == 0) ? (bx % 8) * (G / 8) + bx / 8 : bx;
    phase_mod(p, L, v, G);
    xcd_barrier(gbar);
    phase_h1(p, v, G);
    xcd_barrier(gbar);
    phase_proj(p, L, v, G);
    xcd_barrier(gbar);
    phase_norms(p, v, G);
    xcd_barrier(gbar);
    phase_qkv(p, L, v, G);
    xcd_barrier(gbar);
    phase_attn(p, L, v, G);
    xcd_barrier(gbar);
    phase_oproj(p, L, v, G);
    xcd_barrier(gbar);
    phase_post_attn(p, v, G);
    xcd_barrier(gbar);
    phase_router(p, L, v, G);
    xcd_barrier(gbar);
    phase_route(p, v, G);
    xcd_barrier(gbar);
    phase_moe1(p, L, v, G);
    xcd_barrier(gbar);
    phase_moe2(p, L, v, G);
    xcd_barrier(gbar);
    phase_final(p, v, G);
}

extern "C" void kernel_launch(void* const* d_in, const int* in_sizes, int n_in, void* d_out, int out_size, void* d_ws, size_t ws_size, hipStream_t stream) {
    static int grid_blocks = 0;
    if (grid_blocks == 0) {
        if (n_in != 28 || out_size != T * Dm || ws_size < WS_END) {
            fprintf(stderr, "kernel_launch: unexpected problem (n_in %d, out %d, ws %zu); nothing launched\n", n_in, out_size, ws_size);
            grid_blocks = -1; return;
        }
        int dev = 0, cus = 0, per_cu = 0;
        hipGetDevice(&dev);
        hipDeviceGetAttribute(&cus, hipDeviceAttributeMultiprocessorCount, dev);
        hipOccupancyMaxActiveBlocksPerMultiprocessor(&per_cu, mega, 256, 0);
        if (per_cu > 2) per_cu = 2;
        if (per_cu < 1) per_cu = 1;
        grid_blocks = cus * per_cu;
        fprintf(stderr, "kernel_launch: %d CUs x %d blocks\n", cus, per_cu);
    }
    if (grid_blocks < 0) return;
    hipMemsetAsync((char*)d_ws + WS_CTL, 0, CTL_BYTES, stream);
    Params p{};
    for (int i = 0; i < 28; ++i) p.in[i] = (const float*)d_in[i];
    p.out = (float*)d_out; p.ws = (char*)d_ws;
    void* args[] = {&p};
    hipError_t e = hipLaunchCooperativeKernel((void*)mega, dim3(grid_blocks), dim3(256), args, 0, stream);
    if (e != hipSuccess) fprintf(stderr, "cooperative launch failed: %s (grid %d)\n", hipGetErrorString(e), grid_blocks);
}
```

```cpp
#include <hip/hip_runtime.h>
#include <cstdio>
#include <cstdint>

#ifndef REP_PROJ
#define REP_PROJ 1
#endif
#ifndef REP_ATTN
#define REP_ATTN 1
#endif
#ifndef REP_MOE1
#define REP_MOE1 1
#endif
#ifndef REP_MOE2
#define REP_MOE2 1
#endif
#ifndef REP_SMALL
#define REP_SMALL 1
#endif

typedef unsigned short bf16_t;
typedef short bf16x8 __attribute__((ext_vector_type(8)));
typedef short s16x4 __attribute__((ext_vector_type(4)));
typedef short v4i16_t __attribute__((ext_vector_type(4)));
typedef float f32x16 __attribute__((ext_vector_type(16)));
typedef float f32x4 __attribute__((ext_vector_type(4)));
typedef float f32x2 __attribute__((ext_vector_type(2)));
typedef unsigned u32x4 __attribute__((ext_vector_type(4)));
typedef unsigned u32x2 __attribute__((ext_vector_type(2)));
#define LAS __attribute__((address_space(3)))

constexpr int NT = 512, NW = 8;
constexpr int Dm = 1024, NB = 8, SEQ = 2048, T = NB * SEQ;
constexpr int NIN = 1952;
constexpr int C_CQ = 0, C_CKV = 256, C_KR = 384, C_DQ = 416, C_DK = 928, C_DV = 1440;
constexpr int NE = 256, TOPK = 8, AR = T * TOPK, HROWS = AR + T;
constexpr int LISTCAP = T;
constexpr float LOG2E = 1.4426950408889634f;
constexpr float LAMBDA_INIT = 0.2f;

constexpr size_t MiB = 1u << 20;
constexpr size_t WS_CTL = 0, CTL_BYTES = 65536;
constexpr size_t WS_MOD = 65536;
constexpr size_t WS_ROPE = 1 * MiB;
constexpr size_t WS_H1 = 4 * MiB;
constexpr size_t WS_PROJ = 36 * MiB;
constexpr size_t WS_CQN = 100 * MiB;
constexpr size_t WS_CKVN = 108 * MiB;
constexpr size_t WS_QM = 112 * MiB;
constexpr size_t WS_KF = 136 * MiB;
constexpr size_t WS_VM = 160 * MiB;
constexpr size_t WS_ATT = 176 * MiB;
constexpr size_t WS_OD0 = 208 * MiB;
constexpr size_t WS_Y1 = 240 * MiB;
constexpr size_t WS_H2 = 304 * MiB;
constexpr size_t WS_LOG = 336 * MiB;
constexpr size_t WS_LA = 352 * MiB;
constexpr size_t WS_LW = 368 * MiB;
constexpr size_t WS_HB = 384 * MiB;
constexpr size_t WS_YB = 456 * MiB;
constexpr size_t WS_END = 744 * MiB;

constexpr int G_XB = 32768, G_WB = 36864, G_BUF = G_XB + G_WB, G_LDS = 2 * G_BUF;
constexpr int OFF_MISC = G_LDS, OFF_PRE = OFF_MISC + 64, OFF_TL = OFF_PRE + 1088;
constexpr int OFF_ROW = OFF_TL + 1088, OFF_RW = OFF_ROW + 1024;
constexpr int LDS_BYTES = G_LDS + 4352;

struct Params {
    const float* in[28];
    float* out;
    char* ws;
};

__device__ __forceinline__ unsigned short f2bf(float f) { __bf16 b = (__bf16)f; return __builtin_bit_cast(unsigned short, b); }
__device__ __forceinline__ unsigned pk2(float lo, float hi) { return (unsigned)f2bf(lo) | ((unsigned)f2bf(hi) << 16); }
__device__ __forceinline__ float bf2f(unsigned short b) { return __uint_as_float(((unsigned)b) << 16); }
__device__ __forceinline__ float bflo(unsigned u) { return __uint_as_float(u << 16); }
__device__ __forceinline__ float bfhi(unsigned u) { return __uint_as_float(u & 0xffff0000u); }
__device__ __forceinline__ int crow(int r, int hi) { return (r & 3) + 8 * (r >> 2) + 4 * hi; }
__device__ __forceinline__ float wave_sum(float v) {
#pragma unroll
    for (int o = 32; o >= 1; o >>= 1) v += __shfl_xor(v, o);
    return v;
}
__device__ __forceinline__ float silu_f(float v) { return v / (1.f + __expf(-v)); }
__device__ __forceinline__ s16x4 tr_read(LAS char* p) {
    return __builtin_bit_cast(s16x4, __builtin_amdgcn_ds_read_tr16_b64_v4i16((LAS v4i16_t*)p));
}
__device__ __forceinline__ int otid() { int t = threadIdx.x; asm volatile("" : "+v"(t)); return t; }
__device__ __forceinline__ int grid_g() { return gridDim.x; }
__device__ __forceinline__ int vcu() { const int G = gridDim.x, bx = blockIdx.x; return (G % 8 == 0) ? (bx % 8) * (G / 8) + bx / 8 : bx; }
#define MFMA32(a, b, c) __builtin_amdgcn_mfma_f32_32x32x16_bf16(a, b, c, 0, 0, 0)

template <int NBMODE> __device__ __forceinline__ int nb_of(int wn, int ni) { return NBMODE == 0 ? 64 * wn + 32 * ni : 32 * wn + 128 * ni; }

template <int MI, int NBMODE, class AF, class BF, class EF>
__device__ __forceinline__ void gemm_tile(LAS char* L, int nk, long ldw, AF arow, BF bcol, EF epi) {
    const int tid = otid(), lane = tid & 63, wave = tid >> 6;
    const int wm = wave & 1, wn = wave >> 1, l31 = lane & 31, hi = lane >> 5;
    const int a_chunk = tid & 7, a_row = tid >> 3;
    const bf16_t* ap[MI];
#pragma unroll
    for (int i = 0; i < MI; ++i) ap[i] = arow(a_row + 64 * i) + a_chunk * 8;
    const int a_w = a_row * 128 + 16 * (a_chunk ^ ((a_row >> 1) & 7));
    const int b_n4 = tid & 63, b_kr = tid >> 6;
    const float* bp = bcol(4 * b_n4) + (long)b_kr * ldw;
    const int b_w = G_XB + b_kr * 576 + 8 * b_n4;
    const int sw = (l31 >> 1) & 7;
    const int xoff = (32 * MI * wm + l31) * 128;
    const int woff = G_XB + (8 * hi + ((lane & 15) >> 2)) * 576 + 2 * (16 * ((lane >> 4) & 1) + 4 * (lane & 3));
    f32x16 acc[MI][2];
#pragma unroll
    for (int i = 0; i < MI; ++i)
#pragma unroll
        for (int j = 0; j < 2; ++j)
#pragma unroll
            for (int r = 0; r < 16; ++r) acc[i][j][r] = 0.f;
    u32x4 ra[MI]; f32x4 rb[8];
#pragma unroll
    for (int i = 0; i < MI; ++i) ra[i] = *(const u32x4*)(ap[i]);
#pragma unroll
    for (int i = 0; i < 8; ++i) rb[i] = *(const f32x4*)(bp + (long)(8 * i) * ldw);
#pragma unroll
    for (int i = 0; i < MI; ++i) *(LAS u32x4*)(L + a_w + i * 8192) = ra[i];
#pragma unroll
    for (int i = 0; i < 8; ++i) { u32x2 w; w.x = pk2(rb[i][0], rb[i][1]); w.y = pk2(rb[i][2], rb[i][3]); *(LAS u32x2*)(L + b_w + i * 8 * 576) = w; }
    __syncthreads();
    for (int kt = 0; kt < nk; ++kt) {
        LAS char* Lb = L + (kt & 1) * G_BUF;
        LAS char* Ln = L + ((kt + 1) & 1) * G_BUF;
        const bool more = kt + 1 < nk;
        if (more) {
#pragma unroll
            for (int i = 0; i < MI; ++i) ra[i] = *(const u32x4*)(ap[i] + (kt + 1) * 64);
#pragma unroll
            for (int i = 0; i < 8; ++i) rb[i] = *(const f32x4*)(bp + (long)((kt + 1) * 64 + 8 * i) * ldw);
        }
#pragma unroll
        for (int ks = 0; ks < 4; ++ks) {
            bf16x8 xf[MI], wf[2];
#pragma unroll
            for (int mi = 0; mi < MI; ++mi) xf[mi] = *(LAS bf16x8*)(Lb + xoff + mi * 4096 + 16 * ((2 * ks + hi) ^ sw));
#pragma unroll
            for (int ni = 0; ni < 2; ++ni) {
                LAS char* pp = Lb + woff + ks * 16 * 576 + 2 * nb_of<NBMODE>(wn, ni);
                const s16x4 lo = tr_read(pp), h4 = tr_read(pp + 4 * 576);
                wf[ni] = (bf16x8){lo[0], lo[1], lo[2], lo[3], h4[0], h4[1], h4[2], h4[3]};
            }
#pragma unroll
            for (int mi = 0; mi < MI; ++mi)
#pragma unroll
                for (int ni = 0; ni < 2; ++ni) acc[mi][ni] = MFMA32(wf[ni], xf[mi], acc[mi][ni]);
            if (MI == 4) __builtin_amdgcn_sched_barrier(0);
        }
        if (more) {
#pragma unroll
            for (int i = 0; i < MI; ++i) *(LAS u32x4*)(Ln + a_w + i * 8192) = ra[i];
#pragma unroll
            for (int i = 0; i < 8; ++i) { u32x2 w; w.x = pk2(rb[i][0], rb[i][1]); w.y = pk2(rb[i][2], rb[i][3]); *(LAS u32x2*)(Ln + b_w + i * 8 * 576) = w; }
        }
        __syncthreads();
    }
    epi(acc);
}

template <int MI, int NC, class DF>
__device__ __forceinline__ void store_tile_bf16(LAS char* L, const f32x16 (&acc)[MI][2], DF dst) {
    constexpr int STR = NC * 2 + 16, CPR = NC / 8, BM = 64 * MI;
    const int tid = otid(), lane = tid & 63, wave = tid >> 6, wm = wave & 1, wn = wave >> 1, l31 = lane & 31, hi = lane >> 5;
#pragma unroll
    for (int mi = 0; mi < MI; ++mi)
#pragma unroll
        for (int ni = 0; ni < (NC == 256 ? 2 : 1); ++ni) {
            const int row = 32 * MI * wm + 32 * mi + l31, col = (NC == 256) ? nb_of<0>(wn, ni) : 32 * wn;
#pragma unroll
            for (int gq = 0; gq < 4; ++gq) {
                u32x2 w; w.x = pk2(acc[mi][ni][4 * gq], acc[mi][ni][4 * gq + 1]); w.y = pk2(acc[mi][ni][4 * gq + 2], acc[mi][ni][4 * gq + 3]);
                *(LAS u32x2*)(L + row * STR + 2 * (col + 8 * gq + 4 * hi)) = w;
            }
        }
    __syncthreads();
#pragma unroll
    for (int i = 0; i < (BM * CPR) / NT; ++i) {
        const int id = tid + NT * i, row = id / CPR, c = id % CPR;
        bf16_t* d = dst(row, c);
        if (d) *(u32x4*)d = *(LAS u32x4*)(L + row * STR + 16 * c);
    }
    __syncthreads();
}

__device__ __forceinline__ void phase_mod(const Params& p, LAS char* L) {
    const int v = vcu(), G = grid_g();
    const int tid = otid();
    const float* c = p.in[1]; const float* w_ada = p.in[3]; const float* b_ada = p.in[4];
    float* mod = (float*)(p.ws + WS_MOD);
    LAS float* sc = (LAS float*)L;
    LAS float* red = (LAS float*)(L + 32768);
    bool filled = false;
    for (int item = v; item < 384; item += G) {
        if (!filled) {
            for (int i = tid; i < 8 * 1024; i += NT) sc[i] = silu_f(c[i]);
            __syncthreads(); filled = true;
        }
        const int cx = tid & 15, kl = tid >> 4, col = item * 16 + cx;
        float a[8];
#pragma unroll
        for (int b = 0; b < 8; ++b) a[b] = 0.f;
#pragma unroll 4
        for (int k = kl; k < 1024; k += 32) {
            const float w = w_ada[(size_t)k * 6144 + col];
#pragma unroll
            for (int b = 0; b < 8; ++b) a[b] += sc[b * 1024 + k] * w;
        }
#pragma unroll
        for (int b = 0; b < 8; ++b) red[(b * 32 + kl) * 16 + cx] = a[b];
        __syncthreads();
        if (tid < 128) {
            const int b = tid >> 4, cc = tid & 15; float s = 0.f;
#pragma unroll
            for (int k = 0; k < 32; ++k) s += red[(b * 32 + k) * 16 + cc];
            mod[b * 6144 + item * 16 + cc] = s + b_ada[item * 16 + cc];
        }
        __syncthreads();
    }
}

__device__ __forceinline__ void phase_h1(const Params& p) {
    const int v = vcu(), G = grid_g();
    const int tid = otid(), lane = tid & 63, wave = tid >> 6;
    const float* x = p.in[0]; const int* positions = (const int*)p.in[2]; const float* g = p.in[5];
    const float* mod = (const float*)(p.ws + WS_MOD);
    bf16_t* h1 = (bf16_t*)(p.ws + WS_H1);
    f32x2* rope = (f32x2*)(p.ws + WS_ROPE);
    for (int t = v * NW + wave; t < T; t += G * NW) {
        const int b = t / SEQ;
        const f32x4* xr = (const f32x4*)(x + (size_t)t * Dm);
        f32x4 xv[4]; float ss = 0.f;
#pragma unroll
        for (int j = 0; j < 4; ++j) { xv[j] = xr[lane + 64 * j]; ss += xv[j][0] * xv[j][0] + xv[j][1] * xv[j][1] + xv[j][2] * xv[j][2] + xv[j][3] * xv[j][3]; }
        ss = wave_sum(ss);
        const float rstd = rsqrtf(ss * (1.f / Dm) + 1e-6f);
        const float* sh = mod + b * 6144; const float* scl = sh + 1024;
#pragma unroll
        for (int j = 0; j < 4; ++j) {
            const int col = 4 * (lane + 64 * j);
            const f32x4 gv = *(const f32x4*)(g + col), sv = *(const f32x4*)(scl + col), hv = *(const f32x4*)(sh + col);
            float o[4];
#pragma unroll
            for (int e = 0; e < 4; ++e) o[e] = (xv[j][e] * rstd * gv[e]) * (1.f + sv[e]) + hv[e];
            u32x2 w; w.x = pk2(o[0], o[1]); w.y = pk2(o[2], o[3]);
            *(u32x2*)(h1 + (size_t)t * Dm + col) = w;
        }
        if (lane < 16) {
            const double inv = exp2(-(double)lane * (13.287712379549449 / 16.0));
            const double rev = (double)positions[t] * inv * 0.15915494309189535;
            const float fr = (float)(rev - rint(rev));
            f32x2 cs; cs.x = __builtin_amdgcn_cosf(fr); cs.y = __builtin_amdgcn_sinf(fr);
            rope[(size_t)t * 16 + lane] = cs;
        }
    }
}

__device__ __forceinline__ void phase_proj(const Params& p, LAS char* L) {
    const int v = vcu(), G = grid_g();
    const bf16_t* h1 = (const bf16_t*)(p.ws + WS_H1);
    const float* w_in = p.in[7];
    bf16_t* proj = (bf16_t*)(p.ws + WS_PROJ);
    for (int u = v; u < 64 * 8; u += G) {
        const int mt = u >> 3, nt = u & 7, m0 = mt * 256, n0 = nt * 256;
        auto arow = [&](int r) { return h1 + (size_t)(m0 + r) * Dm; };
        auto bcol = [&](int c) { int col = n0 + c; if (col > NIN - 4) col = NIN - 4; return w_in + col; };
        auto epi = [&](f32x16 (&acc)[4][2]) {
            const int wave = otid() >> 6, wn = wave >> 1;
#pragma unroll
            for (int ni = 0; ni < 2; ++ni) {
                const int nbg = n0 + nb_of<0>(wn, ni);
                if (nbg >= C_DQ && nbg < C_DK) {
#pragma unroll
                    for (int mi = 0; mi < 4; ++mi)
#pragma unroll
                        for (int r = 0; r < 16; ++r) acc[mi][ni][r] *= 0.125f * LOG2E;
                }
            }
            store_tile_bf16<4, 256>(L, acc, [&](int row, int c) -> bf16_t* { const int col = n0 + 8 * c; return col < NIN ? proj + (size_t)(m0 + row) * NIN + col : nullptr; });
        };
        gemm_tile<4, 0>(L, Dm / 64, NIN, arow, bcol, epi);
    }
}

__device__ __forceinline__ void phase_norms(const Params& p) {
    const int v = vcu(), G = grid_g();
    const int tid = otid(), lane = tid & 63, wave = tid >> 6;
    const bf16_t* proj = (const bf16_t*)(p.ws + WS_PROJ);
    const float* qg = p.in[8]; const float* kvg = p.in[9];
    bf16_t* cqn = (bf16_t*)(p.ws + WS_CQN); bf16_t* ckvn = (bf16_t*)(p.ws + WS_CKVN); bf16_t* kf = (bf16_t*)(p.ws + WS_KF);
    const f32x2* rope = (const f32x2*)(p.ws + WS_ROPE);
    for (int t = v * NW + wave; t < T; t += G * NW) {
        const bf16_t* pr = proj + (size_t)t * NIN;
        {
            const u32x2 raw = *(const u32x2*)(pr + C_CQ + 4 * lane);
            float a[4] = {bflo(raw.x), bfhi(raw.x), bflo(raw.y), bfhi(raw.y)};
            float ss = wave_sum(a[0] * a[0] + a[1] * a[1] + a[2] * a[2] + a[3] * a[3]);
            const float rstd = rsqrtf(ss * (1.f / 256.f) + 1e-6f);
            const f32x4 gv = *(const f32x4*)(qg + 4 * lane);
            u32x2 w; w.x = pk2(a[0] * rstd * gv[0], a[1] * rstd * gv[1]); w.y = pk2(a[2] * rstd * gv[2], a[3] * rstd * gv[3]);
            *(u32x2*)(cqn + (size_t)t * 256 + 4 * lane) = w;
        }
        {
            const unsigned raw = *(const unsigned*)(pr + C_CKV + 2 * lane);
            const float a0 = bflo(raw), a1 = bfhi(raw);
            float ss = wave_sum(a0 * a0 + a1 * a1);
            const float rstd = rsqrtf(ss * (1.f / 128.f) + 1e-6f);
            *(unsigned*)(ckvn + (size_t)t * 128 + 2 * lane) = pk2(a0 * rstd * kvg[2 * lane], a1 * rstd * kvg[2 * lane + 1]);
        }
        if (lane < 16) {
            const float x1 = bf2f(pr[C_KR + lane]), x2 = bf2f(pr[C_KR + 16 + lane]);
            const f32x2 cs = rope[(size_t)t * 16 + lane];
            const bf16_t y1 = f2bf(x1 * cs.x - x2 * cs.y), y2 = f2bf(x2 * cs.x + x1 * cs.y);
#pragma unroll
            for (int h = 0; h < 8; ++h) { kf[(size_t)t * 768 + h * 96 + 64 + lane] = y1; kf[(size_t)t * 768 + h * 96 + 80 + lane] = y2; }
        }
    }
}

__device__ __forceinline__ void phase_qkv(const Params& p, LAS char* L) {
    const int v = vcu(), G = grid_g();
    const bf16_t* cqn = (const bf16_t*)(p.ws + WS_CQN); const bf16_t* ckvn = (const bf16_t*)(p.ws + WS_CKVN);
    const float* w_uq = p.in[10]; const float* w_ukv = p.in[11];
    bf16_t* qm = (bf16_t*)(p.ws + WS_QM); bf16_t* kf = (bf16_t*)(p.ws + WS_KF); bf16_t* vm = (bf16_t*)(p.ws + WS_VM);
    const f32x2* rope = (const f32x2*)(p.ws + WS_ROPE);
    const float qscale = LOG2E * 0.10206207261596575f;
    for (int u = v; u < 64 * 7; u += G) {
        const int mt = u / 7, j = u % 7, m0 = mt * 256;
        if (j < 3) {
            const int n0 = j * 256;
            auto arow = [&](int r) { return cqn + (size_t)(m0 + r) * 256; };
            auto bcol = [&](int c) { return w_uq + n0 + c; };
            auto epi = [&](f32x16 (&acc)[4][2]) {
                const int tid_ = otid(), lane = tid_ & 63, wave = tid_ >> 6, wm = wave & 1, wn = wave >> 1, l31 = lane & 31, hi = lane >> 5;
#pragma unroll
                for (int mi = 0; mi < 4; ++mi) {
                    const int m = m0 + 128 * wm + 32 * mi + l31;
#pragma unroll
                    for (int ni = 0; ni < 2; ++ni) {
                        const int nbg = n0 + nb_of<0>(wn, ni);
                        if ((nbg % 96) == 64) {
#pragma unroll
                            for (int r = 0; r < 8; ++r) {
                                const f32x2 cs = rope[(size_t)m * 16 + crow(r, hi)];
                                const float x1 = acc[mi][ni][r], x2 = acc[mi][ni][r + 8];
                                acc[mi][ni][r] = x1 * cs.x - x2 * cs.y; acc[mi][ni][r + 8] = x2 * cs.x + x1 * cs.y;
                            }
                        }
#pragma unroll
                        for (int r = 0; r < 16; ++r) acc[mi][ni][r] *= qscale;
                    }
                }
                store_tile_bf16<4, 256>(L, acc, [&](int row, int c) -> bf16_t* { return qm + (size_t)(m0 + row) * 768 + n0 + 8 * c; });
            };
            gemm_tile<4, 0>(L, 256 / 64, 768, arow, bcol, epi);
        } else {
            const int n0 = (j - 3) * 256;
            auto arow = [&](int r) { return ckvn + (size_t)(m0 + r) * 128; };
            auto bcol = [&](int c) { return w_ukv + n0 + c; };
            auto epi = [&](f32x16 (&acc)[4][2]) {
                store_tile_bf16<4, 256>(L, acc, [&](int row, int c) -> bf16_t* {
                    const int h = (n0 >> 7) + (c >> 4), cc = c & 15;
                    return cc < 8 ? kf + (size_t)(m0 + row) * 768 + h * 96 + 8 * cc : vm + (size_t)(m0 + row) * 512 + h * 64 + 8 * (cc - 8); });
            };
            gemm_tile<4, 0>(L, 128 / 64, 1024, arow, bcol, epi);
        }
    }
}

template <int DQK, int DV, bool ALIBI>
__device__ __forceinline__ void attn_map(LAS char* L, const bf16_t* Q, int ldq, const bf16_t* K, int ldk, const bf16_t* V, int ldv,
                                         const int* posrow, float slope2, int q0, f32x16 (&o)[DV / 32]) {
    constexpr int KSTR = DQK * 2 + 16, VSTR = DV * 2 + 64, KS = DQK / 16, ND = DV / 32;
    constexpr int K_OFF = 0, V_OFF = 64 * KSTR, P_OFF = V_OFF + 64 * VSTR, ABUF = P_OFF + 256;
    constexpr int KCH = DQK / 8, VCH = DV / 8;
    constexpr int NKI = (64 * KCH + NT - 1) / NT, NVI = (64 * VCH + NT - 1) / NT;
    const int tid = otid();
    const int lane = tid & 63, wave = tid >> 6, l31 = lane & 31, hi = lane >> 5;
    const int qrow = q0 + 32 * wave + l31;
    unsigned kgo[NKI], klo[NKI], vgo[NVI], vlo[NVI];
#pragma unroll
    for (int i = 0; i < NKI; ++i) { int c = tid + NT * i; if (c >= 64 * KCH) c = 64 * KCH - 1; const int row = c / KCH, ch = c % KCH; kgo[i] = (unsigned)(row * ldk + ch * 8) * 2u; klo[i] = K_OFF + row * KSTR + ch * 16; }
#pragma unroll
    for (int i = 0; i < NVI; ++i) { int c = tid + NT * i; if (c >= 64 * VCH) c = 64 * VCH - 1; const int row = c / VCH, ch = c % VCH; vgo[i] = (unsigned)(row * ldv + ch * 8) * 2u; vlo[i] = V_OFF + row * VSTR + ch * 16; }
    bf16x8 qf[KS];
#pragma unroll
    for (int s = 0; s < KS; ++s) qf[s] = *(const bf16x8*)(Q + (size_t)qrow * ldq + 16 * s + 8 * hi);
    const float posq = ALIBI ? (float)posrow[qrow] : 0.f;
#pragma unroll
    for (int d = 0; d < ND; ++d)
#pragma unroll
        for (int r = 0; r < 16; ++r) o[d][r] = 0.f;
    float m_run = -1e30f, l_run = 0.f;
    const int ntile = (q0 + 256) / 64;
    const int qmin = q0 + 32 * wave, qmax = qmin + 31;
    const int vrd = V_OFF + (4 * hi + ((lane & 15) >> 2)) * VSTR + 2 * (16 * ((lane >> 4) & 1) + 4 * (lane & 3));
    u32x4 rk[NKI], rv[NVI]; float rp = 0.f;
#pragma unroll
    for (int i = 0; i < NKI; ++i) rk[i] = *(const u32x4*)((const char*)K + kgo[i]);
#pragma unroll
    for (int i = 0; i < NVI; ++i) rv[i] = *(const u32x4*)((const char*)V + vgo[i]);
    if (ALIBI && tid < 64) rp = (float)posrow[tid];
    __syncthreads();
#pragma unroll
    for (int i = 0; i < NKI; ++i) if (tid + NT * i < 64 * KCH) *(LAS u32x4*)(L + klo[i]) = rk[i];
#pragma unroll
    for (int i = 0; i < NVI; ++i) if (tid + NT * i < 64 * VCH) *(LAS u32x4*)(L + vlo[i]) = rv[i];
    if (ALIBI && tid < 64) *(LAS float*)(L + P_OFF + 4 * tid) = rp;
    __syncthreads();
    for (int tl = 0; tl < ntile; ++tl) {
        const int kb = tl * 64;
        LAS char* Lb = L + (tl & 1) * ABUF;
        LAS char* Ln = L + ((tl + 1) & 1) * ABUF;
        const bool more = tl + 1 < ntile;
        if (more) {
            const char* kbase = (const char*)(K + (size_t)(kb + 64) * ldk);
            const char* vbase = (const char*)(V + (size_t)(kb + 64) * ldv);
#pragma unroll
            for (int i = 0; i < NKI; ++i) rk[i] = *(const u32x4*)(kbase + kgo[i]);
#pragma unroll
            for (int i = 0; i < NVI; ++i) rv[i] = *(const u32x4*)(vbase + vgo[i]);
            if (ALIBI && tid < 64) rp = (float)posrow[kb + 64 + tid];
        }
        if (kb <= qmax) {
            f32x16 s0, s1;
#pragma unroll
            for (int r = 0; r < 16; ++r) { s0[r] = 0.f; s1[r] = 0.f; }
#pragma unroll
            for (int s = 0; s < KS; ++s) {
                const bf16x8 k0 = *(LAS bf16x8*)(Lb + K_OFF + l31 * KSTR + 32 * s + 16 * hi);
                const bf16x8 k1 = *(LAS bf16x8*)(Lb + K_OFF + (32 + l31) * KSTR + 32 * s + 16 * hi);
                s0 = MFMA32(k0, qf[s], s0); s1 = MFMA32(k1, qf[s], s1);
            }
            if (ALIBI) {
#pragma unroll
                for (int r = 0; r < 16; ++r) {
                    const float pk0 = *(LAS float*)(Lb + P_OFF + 4 * crow(r, hi)), pk1 = *(LAS float*)(Lb + P_OFF + 4 * (32 + crow(r, hi)));
                    s0[r] -= slope2 * fabsf(posq - pk0); s1[r] -= slope2 * fabsf(posq - pk1);
                }
            }
            if (kb + 63 > qmin) {
#pragma unroll
                for (int r = 0; r < 16; ++r) {
                    const int key = kb + crow(r, hi);
                    if (key > qrow) s0[r] = -INFINITY;
                    if (key + 32 > qrow) s1[r] = -INFINITY;
                }
            }
            float mx = s0[0];
#pragma unroll
            for (int r = 1; r < 16; ++r) mx = fmaxf(mx, s0[r]);
#pragma unroll
            for (int r = 0; r < 16; ++r) mx = fmaxf(mx, s1[r]);
            mx = fmaxf(mx, __shfl_xor(mx, 32));
            const float m_new = fmaxf(m_run, mx);
            const float alpha = __builtin_amdgcn_exp2f(m_run - m_new);
            m_run = m_new;
            float ls = 0.f;
#pragma unroll
            for (int r = 0; r < 16; ++r) { s0[r] = __builtin_amdgcn_exp2f(s0[r] - m_new); s1[r] = __builtin_amdgcn_exp2f(s1[r] - m_new); ls += s0[r] + s1[r]; }
            l_run = l_run * alpha + ls;
#pragma unroll
            for (int d = 0; d < ND; ++d)
#pragma unroll
                for (int r = 0; r < 16; ++r) o[d][r] *= alpha;
            u32x4 pw[4];
#pragma unroll
            for (int j = 0; j < 4; ++j) {
                pw[0][j] = pk2(s0[2 * j], s0[2 * j + 1]); pw[1][j] = pk2(s0[8 + 2 * j], s0[8 + 2 * j + 1]);
                pw[2][j] = pk2(s1[2 * j], s1[2 * j + 1]); pw[3][j] = pk2(s1[8 + 2 * j], s1[8 + 2 * j + 1]);
            }
#pragma unroll
            for (int s = 0; s < 4; ++s) {
                const bf16x8 pf = __builtin_bit_cast(bf16x8, pw[s]);
#pragma unroll
                for (int d = 0; d < ND; ++d) {
                    LAS char* vp = Lb + vrd + 16 * s * VSTR + 64 * d;
                    const s16x4 lo = tr_read(vp), h4 = tr_read(vp + 8 * VSTR);
                    const bf16x8 vf = (bf16x8){lo[0], lo[1], lo[2], lo[3], h4[0], h4[1], h4[2], h4[3]};
                    o[d] = MFMA32(vf, pf, o[d]);
                }
                __builtin_amdgcn_sched_barrier(0);
            }
        }
        if (more) {
#pragma unroll
            for (int i = 0; i < NKI; ++i) if (tid + NT * i < 64 * KCH) *(LAS u32x4*)(Ln + klo[i]) = rk[i];
#pragma unroll
            for (int i = 0; i < NVI; ++i) if (tid + NT * i < 64 * VCH) *(LAS u32x4*)(Ln + vlo[i]) = rv[i];
            if (ALIBI && tid < 64) *(LAS float*)(Ln + P_OFF + 4 * tid) = rp;
        }
        __syncthreads();
    }
    const float lt = l_run + __shfl_xor(l_run, 32);
    const float inv = 1.f / lt;
#pragma unroll
    for (int d = 0; d < ND; ++d)
#pragma unroll
        for (int r = 0; r < 16; ++r) o[d][r] *= inv;
}

__device__ __forceinline__ void attn_decode(int it, int& kind, int& qb, int& idx) {
    const int seg_kind[16] = {1, 1, 1, 1, 1, 0, 1, 0, 0, 0, 1, 0, 0, 1, 0, 0};
    const int seg_qb[16]   = {7, 6, 5, 4, 3, 7, 2, 6, 5, 4, 1, 3, 2, 0, 1, 0};
    int base = 0; kind = 0; qb = 0; idx = 0;
#pragma unroll
    for (int s = 0; s < 16; ++s) {
        const int n = seg_kind[s] ? 32 : 64;
        if (it >= base && it < base + n) { kind = seg_kind[s]; qb = seg_qb[s]; idx = it - base; }
        base += n;
    }
}

__device__ __forceinline__ void phase_attn(const Params& p, LAS char* L) {
    const int v = vcu(), G = grid_g();
    const int tid = otid(), lane = tid & 63, wave = tid >> 6, l31 = lane & 31, hi = lane >> 5;
    const int* positions = (const int*)p.in[2];
    const bf16_t* proj = (const bf16_t*)(p.ws + WS_PROJ);
    const bf16_t* qm = (const bf16_t*)(p.ws + WS_QM); const bf16_t* kf = (const bf16_t*)(p.ws + WS_KF); const bf16_t* vm = (const bf16_t*)(p.ws + WS_VM);
    bf16_t* att = (bf16_t*)(p.ws + WS_ATT);
    float* od0 = (float*)(p.ws + WS_OD0);
    const float* subg = p.in[16];
    unsigned* qctr = (unsigned*)(p.ws + WS_CTL + 2048);
    LAS unsigned* qslot = (LAS unsigned*)(L + OFF_MISC + 16);
    float lam;
    {
        const float a = p.in[12][lane] * p.in[13][lane], b = p.in[14][lane] * p.in[15][lane];
        lam = __expf(wave_sum(a)) - __expf(wave_sum(b)) + LAMBDA_INIT;
    }
    for (;;) {
        if (tid == 0) *qslot = __hip_atomic_fetch_add(qctr, 1u, __ATOMIC_RELAXED, __HIP_MEMORY_SCOPE_AGENT);
        __syncthreads();
        const int it = (int)*qslot;
        __syncthreads();
        if (it >= 768) break;
        int kind, qb, idx;
        attn_decode(it, kind, qb, idx);
        const int q0 = qb * 256;
        if (kind == 0) {
            const int b = idx >> 3, h = idx & 7; const size_t tb = (size_t)b * SEQ;
            f32x16 o[2];
            attn_map<96, 64, false>(L, qm + tb * 768 + h * 96, 768, kf + tb * 768 + h * 96, 768, vm + tb * 512 + h * 64, 512, positions + tb, 0.f, q0, o);
            const size_t t = tb + q0 + 32 * wave + l31;
#pragma unroll
            for (int d = 0; d < 2; ++d)
#pragma unroll
                for (int gq = 0; gq < 4; ++gq) {
                    u32x2 w; w.x = pk2(o[d][4 * gq], o[d][4 * gq + 1]); w.y = pk2(o[d][4 * gq + 2], o[d][4 * gq + 3]);
                    *(u32x2*)(att + t * 1024 + h * 64 + 32 * d + 8 * gq + 4 * hi) = w;
                }
        } else {
            const int b = idx >> 2, h = idx & 3; const size_t tb = (size_t)b * SEQ;
            const float slope2 = exp2f(-2.f * (h + 1)) * LOG2E;
            const size_t t = tb + q0 + 32 * wave + l31;
            f32x16 o[4];
            attn_map<64, 128, true>(L, proj + tb * NIN + C_DQ + h * 128, NIN, proj + tb * NIN + C_DK + h * 128, NIN, proj + tb * NIN + C_DV + h * 128, NIN, positions + tb, slope2, q0, o);
#pragma unroll
            for (int d = 0; d < 4; ++d)
#pragma unroll
                for (int gq = 0; gq < 4; ++gq) {
                    f32x4 w = {o[d][4 * gq], o[d][4 * gq + 1], o[d][4 * gq + 2], o[d][4 * gq + 3]};
                    *(f32x4*)(od0 + t * 512 + h * 128 + 32 * d + 8 * gq + 4 * hi) = w;
                }
            attn_map<64, 128, true>(L, proj + tb * NIN + C_DQ + h * 128 + 64, NIN, proj + tb * NIN + C_DK + h * 128 + 64, NIN, proj + tb * NIN + C_DV + h * 128, NIN, positions + tb, slope2, q0, o);
            float ss = 0.f;
#pragma unroll
            for (int d = 0; d < 4; ++d)
#pragma unroll
                for (int gq = 0; gq < 4; ++gq) {
                    const f32x4 w = *(const f32x4*)(od0 + t * 512 + h * 128 + 32 * d + 8 * gq + 4 * hi);
#pragma unroll
                    for (int e = 0; e < 4; ++e) { const float c = w[e] - lam * o[d][4 * gq + e]; o[d][4 * gq + e] = c; ss += c * c; }
                }
            ss += __shfl_xor(ss, 32);
            const float rstd = rsqrtf(ss * (1.f / 128.f) + 1e-5f) * (1.f - LAMBDA_INIT);
#pragma unroll
            for (int d = 0; d < 4; ++d)
#pragma unroll
                for (int gq = 0; gq < 4; ++gq) {
                    const int dv = 32 * d + 8 * gq + 4 * hi;
                    const f32x4 gv = *(const f32x4*)(subg + dv);
                    u32x2 w; w.x = pk2(o[d][4 * gq] * rstd * gv[0], o[d][4 * gq + 1] * rstd * gv[1]); w.y = pk2(o[d][4 * gq + 2] * rstd * gv[2], o[d][4 * gq + 3] * rstd * gv[3]);
                    *(u32x2*)(att + t * 1024 + 512 + h * 128 + dv) = w;
                }
        }
    }
}

__device__ __forceinline__ void phase_oproj(const Params& p, LAS char* L) {
    const int v = vcu(), G = grid_g();
    const bf16_t* att = (const bf16_t*)(p.ws + WS_ATT);
    const float* w_o = p.in[17];
    bf16_t* y1 = (bf16_t*)(p.ws + WS_Y1);
    for (int u = v; u < 64 * 4; u += G) {
        const int mt = u >> 2, nt = u & 3, m0 = mt * 256, n0 = nt * 256;
        auto arow = [&](int r) { return att + (size_t)(m0 + r) * Dm; };
        auto bcol = [&](int c) { return w_o + n0 + c; };
        auto epi = [&](f32x16 (&acc)[4][2]) {
            store_tile_bf16<4, 256>(L, acc, [&](int row, int c) -> bf16_t* { return y1 + (size_t)(m0 + row) * Dm + n0 + 8 * c; });
        };
        gemm_tile<4, 0>(L, Dm / 64, Dm, arow, bcol, epi);
    }
}

__device__ __forceinline__ void phase_post_attn(const Params& p) {
    const int v = vcu(), G = grid_g();
    const int tid = otid(), lane = tid & 63, wave = tid >> 6;
    const float* x = p.in[0]; const float* pg = p.in[6]; const float* fg = p.in[18];
    const float* mod = (const float*)(p.ws + WS_MOD);
    const bf16_t* y1 = (const bf16_t*)(p.ws + WS_Y1);
    bf16_t* h2 = (bf16_t*)(p.ws + WS_H2);
    for (int t = v * NW + wave; t < T; t += G * NW) {
        const int b = t / SEQ;
        const float* mb = mod + b * 6144;
        f32x4 yv[4], xv[4]; float ss = 0.f;
#pragma unroll
        for (int j = 0; j < 4; ++j) {
            const u32x2 raw = *(const u32x2*)(y1 + (size_t)t * Dm + 4 * (lane + 64 * j));
            yv[j] = (f32x4){bflo(raw.x), bfhi(raw.x), bflo(raw.y), bfhi(raw.y)};
            xv[j] = *(const f32x4*)(x + (size_t)t * Dm + 4 * (lane + 64 * j));
            ss += yv[j][0] * yv[j][0] + yv[j][1] * yv[j][1] + yv[j][2] * yv[j][2] + yv[j][3] * yv[j][3];
        }
        ss = wave_sum(ss);
        const float rstd = rsqrtf(ss * (1.f / Dm) + 1e-6f);
        float ss2 = 0.f;
#pragma unroll
        for (int j = 0; j < 4; ++j) {
            const int col = 4 * (lane + 64 * j);
            const f32x4 gv = *(const f32x4*)(pg + col), ga = *(const f32x4*)(mb + 2048 + col);
#pragma unroll
            for (int e = 0; e < 4; ++e) { xv[j][e] = xv[j][e] + ga[e] * (yv[j][e] * rstd * gv[e]); ss2 += xv[j][e] * xv[j][e]; }
            *(f32x4*)(p.out + (size_t)t * Dm + col) = xv[j];
        }
        ss2 = wave_sum(ss2);
        const float rstd2 = rsqrtf(ss2 * (1.f / Dm) + 1e-6f);
#pragma unroll
        for (int j = 0; j < 4; ++j) {
            const int col = 4 * (lane + 64 * j);
            const f32x4 gv = *(const f32x4*)(fg + col), sv = *(const f32x4*)(mb + 4096 + col), hv = *(const f32x4*)(mb + 3072 + col);
            float o[4];
#pragma unroll
            for (int e = 0; e < 4; ++e) o[e] = (xv[j][e] * rstd2 * gv[e]) * (1.f + sv[e]) + hv[e];
            u32x2 w; w.x = pk2(o[0], o[1]); w.y = pk2(o[2], o[3]);
            *(u32x2*)(h2 + (size_t)t * Dm + col) = w;
        }
    }
}

__device__ __forceinline__ void phase_router(const Params& p, LAS char* L) {
    const int v = vcu(), G = grid_g();
    const bf16_t* h2 = (const bf16_t*)(p.ws + WS_H2);
    const float* rw = p.in[20];
    float* lg = (float*)(p.ws + WS_LOG);
    for (int u = v; u < 128; u += G) {
        const int m0 = u * 128;
        auto arow = [&](int r) { return h2 + (size_t)(m0 + r) * Dm; };
        auto bcol = [&](int c) { return rw + c; };
        auto epi = [&](f32x16 (&acc)[2][2]) {
            const int tid_ = otid(), lane = tid_ & 63, wave = tid_ >> 6, wm = wave & 1, wn = wave >> 1, l31 = lane & 31, hi = lane >> 5;
#pragma unroll
            for (int mi = 0; mi < 2; ++mi) {
                const int m = m0 + 64 * wm + 32 * mi + l31;
#pragma unroll
                for (int ni = 0; ni < 2; ++ni) {
                    const int nbg = nb_of<0>(wn, ni);
#pragma unroll
                    for (int gq = 0; gq < 4; ++gq) {
                        f32x4 w = {acc[mi][ni][4 * gq], acc[mi][ni][4 * gq + 1], acc[mi][ni][4 * gq + 2], acc[mi][ni][4 * gq + 3]};
                        *(f32x4*)(lg + (size_t)m * NE + nbg + 8 * gq + 4 * hi) = w;
                    }
                }
            }
        };
        gemm_tile<2, 0>(L, Dm / 64, NE, arow, bcol, epi);
    }
}

__device__ __forceinline__ void phase_route(const Params& p) {
    const int v = vcu(), G = grid_g();
    const int tid = otid(), lane = tid & 63, wave = tid >> 6;
    const float* lg = (const float*)(p.ws + WS_LOG);
    const float* rb = p.in[21];
    int* cnt = (int*)(p.ws + WS_CTL);
    int* la = (int*)(p.ws + WS_LA); float* lw = (float*)(p.ws + WS_LW);
    const f32x4 bias = *(const f32x4*)(rb + 4 * lane);
    const int grp = lane >> 3;
    for (int t = v * NW + wave; t < T; t += G * NW) {
        const f32x4 lgv = *(const f32x4*)(lg + (size_t)t * NE + 4 * lane);
        float s0 = 1.f / (1.f + __expf(-lgv[0])), s1 = 1.f / (1.f + __expf(-lgv[1])), s2 = 1.f / (1.f + __expf(-lgv[2])), s3 = 1.f / (1.f + __expf(-lgv[3]));
        float v0 = s0 + bias[0], v1 = s1 + bias[1], v2 = s2 + bias[2], v3 = s3 + bias[3];
        float t1 = fmaxf(v0, v1), t2 = fminf(v0, v1);
        { const float a = fmaxf(v2, v3), bq = fminf(v2, v3); const float n1 = fmaxf(t1, a), n2 = fmaxf(fminf(t1, a), fmaxf(t2, bq)); t1 = n1; t2 = n2; }
#pragma unroll
        for (int off = 1; off <= 4; off <<= 1) {
            const float o1 = __shfl_xor(t1, off), o2 = __shfl_xor(t2, off);
            const float n1 = fmaxf(t1, o1), n2 = fmaxf(fminf(t1, o1), fmaxf(t2, o2)); t1 = n1; t2 = n2;
        }
        const float gs = t1 + t2;
        int rank = 0;
#pragma unroll
        for (int gg = 0; gg < 8; ++gg) { const float og = __shfl(gs, gg * 8); rank += (og > gs || (og == gs && gg < grp)) ? 1 : 0; }
        if (rank >= 4) { v0 = -INFINITY; v1 = -INFINITY; v2 = -INFINITY; v3 = -INFINITY; }
        float wsum = 0.f, myw = 0.f; int mye = 0;
#pragma unroll
        for (int it = 0; it < TOPK; ++it) {
            float bv = v0; int bi = 0;
            if (v1 > bv) { bv = v1; bi = 1; }
            if (v2 > bv) { bv = v2; bi = 2; }
            if (v3 > bv) { bv = v3; bi = 3; }
            int idx = 4 * lane + bi;
#pragma unroll
            for (int off = 32; off >= 1; off >>= 1) {
                const float ov = __shfl_xor(bv, off); const int oi = __shfl_xor(idx, off);
                if (ov > bv || (ov == bv && oi < idx)) { bv = ov; idx = oi; }
            }
            const int jj = idx & 3, owner = idx >> 2;
            const float mys = jj == 0 ? s0 : (jj == 1 ? s1 : (jj == 2 ? s2 : s3));
            const float scv = __shfl(mys, owner);
            if (lane == owner) { if (jj == 0) v0 = -INFINITY; else if (jj == 1) v1 = -INFINITY; else if (jj == 2) v2 = -INFINITY; else v3 = -INFINITY; }
            wsum += scv;
            if (lane == it) { myw = scv; mye = idx; }
        }
        if (lane < TOPK) {
            const float w = myw / wsum * 2.5f;
            const int pos = atomicAdd(cnt + mye, 1);
            if (pos < LISTCAP) { la[(size_t)mye * LISTCAP + pos] = t * TOPK + lane; lw[(size_t)mye * LISTCAP + pos] = w; }
        }
    }
}

__device__ __forceinline__ int moe_cnt(const int* cnt, int e) { int c = (e < 256) ? cnt[e] : T; return c > LISTCAP ? LISTCAP : c; }
__device__ __forceinline__ void moe_prefix(const Params& p, LAS char* L) {
    const int tid = otid();
    const int* cnt = (const int*)(p.ws + WS_CTL);
    LAS int* pre = (LAS int*)(L + OFF_PRE);
    LAS int* tl = (LAS int*)(L + OFF_TL);
    __syncthreads();
    for (int i = tid; i < 257; i += NT) { const int c = moe_cnt(cnt, i); tl[i] = (c + 255) >> 8; }
    __syncthreads();
    if (tid == 0) { int s = 0; for (int i = 0; i < 257; ++i) { pre[i] = s; s += tl[i]; } pre[257] = s; }
    __syncthreads();
}
__device__ __forceinline__ int moe_find(LAS int* pre, int g) {
    int lo = 0, hi = 256;
    while (lo < hi) { const int mid = (lo + hi + 1) >> 1; if (pre[mid] <= g) lo = mid; else hi = mid - 1; }
    return lo;
}

template <int MI>
__device__ __forceinline__ void moe1_unit(const Params& p, LAS char* L, int e, int r0, int rows, int j0) {
    const bf16_t* h2 = (const bf16_t*)(p.ws + WS_H2);
    const int* la = (const int*)(p.ws + WS_LA);
    bf16_t* hb = (bf16_t*)(p.ws + WS_HB);
    const float* wg = (e < 256) ? p.in[22] + (size_t)e * Dm * 256 : p.in[25];
    const float* wu = (e < 256) ? p.in[23] + (size_t)e * Dm * 256 : p.in[26];
    LAS int* rowid = (LAS int*)(L + OFF_ROW);
    {
        const int tid = otid();
        if (tid < 64 * MI) { const int rr = tid < rows ? tid : 0; rowid[tid] = (e < 256) ? la[(size_t)e * LISTCAP + r0 + rr] : (AR + r0 + rr); }
        __syncthreads();
    }
    auto arow = [&](int r) { const int a = rowid[r]; const int tok = (e < 256) ? (a >> 3) : (a - AR); return h2 + (size_t)tok * Dm; };
    auto bcol = [&](int c4) { return (c4 < 128) ? (wg + j0 + c4) : (wu + j0 + c4 - 128); };
    auto epi = [&](f32x16 (&acc)[MI][2]) {
#pragma unroll
        for (int mi = 0; mi < MI; ++mi)
#pragma unroll
            for (int r = 0; r < 16; ++r) acc[mi][0][r] = silu_f(acc[mi][0][r]) * acc[mi][1][r];
        store_tile_bf16<MI, 128>(L, acc, [&](int row, int c) -> bf16_t* { return row < rows ? hb + (size_t)rowid[row] * 256 + j0 + 8 * c : nullptr; });
    };
    gemm_tile<MI, 1>(L, Dm / 64, 256, arow, bcol, epi);
}
__device__ __forceinline__ void phase_moe1(const Params& p, LAS char* L) {
    const int v = vcu(), G = grid_g();
    const int* cnt = (const int*)(p.ws + WS_CTL);
    moe_prefix(p, L);
    LAS int* pre = (LAS int*)(L + OFF_PRE);
    const int total = pre[257] * 2;
    for (int u = v; u < total; u += G) {
        const int g = u >> 1, j0 = (u & 1) * 128;
        const int e = moe_find(pre, g), mt = g - pre[e];
        const int rows = moe_cnt(cnt, e) - mt * 256;
        if (rows > 128) moe1_unit<4>(p, L, e, mt * 256, rows < 256 ? rows : 256, j0);
        else moe1_unit<2>(p, L, e, mt * 256, rows, j0);
    }
}

template <int MI>
__device__ __forceinline__ void moe2_unit(const Params& p, LAS char* L, int e, int r0, int rows, int n0) {
    const int* la = (const int*)(p.ws + WS_LA); const float* lw = (const float*)(p.ws + WS_LW);
    const bf16_t* hb = (const bf16_t*)(p.ws + WS_HB);
    bf16_t* yb = (bf16_t*)(p.ws + WS_YB);
    const float* wd = (e < 256) ? p.in[24] + (size_t)e * 256 * Dm : p.in[27];
    LAS int* rowid = (LAS int*)(L + OFF_ROW);
    LAS float* roww = (LAS float*)(L + OFF_RW);
    {
        const int tid = otid();
        if (tid < 64 * MI) {
            const int rr = tid < rows ? tid : 0;
            rowid[tid] = (e < 256) ? la[(size_t)e * LISTCAP + r0 + rr] : (AR + r0 + rr);
            roww[tid] = (e < 256) ? lw[(size_t)e * LISTCAP + r0 + rr] : 1.f;
        }
        __syncthreads();
    }
    auto arow = [&](int r) { return hb + (size_t)rowid[r] * 256; };
    auto bcol = [&](int c4) { return wd + n0 + c4; };
    auto epi = [&](f32x16 (&acc)[MI][2]) {
        const int tid_ = otid(), lane = tid_ & 63, wave = tid_ >> 6, wm = wave & 1, l31 = lane & 31;
#pragma unroll
        for (int mi = 0; mi < MI; ++mi) {
            const float w = roww[32 * MI * wm + 32 * mi + l31];
#pragma unroll
            for (int ni = 0; ni < 2; ++ni)
#pragma unroll
                for (int q = 0; q < 16; ++q) acc[mi][ni][q] *= w;
        }
        store_tile_bf16<MI, 256>(L, acc, [&](int row, int c) -> bf16_t* { return row < rows ? yb + (size_t)rowid[row] * Dm + n0 + 8 * c : nullptr; });
    };
    gemm_tile<MI, 0>(L, 256 / 64, Dm, arow, bcol, epi);
}
__device__ __forceinline__ void phase_moe2(const Params& p, LAS char* L) {
    const int v = vcu(), G = grid_g();
    const int* cnt = (const int*)(p.ws + WS_CTL);
    moe_prefix(p, L);
    LAS int* pre = (LAS int*)(L + OFF_PRE);
    const int total = pre[257] * 4;
    for (int u = v; u < total; u += G) {
        const int g = u >> 2, n0 = (u & 3) * 256;
        const int e = moe_find(pre, g), mt = g - pre[e];
        const int rows = moe_cnt(cnt, e) - mt * 256;
        if (rows > 128) moe2_unit<4>(p, L, e, mt * 256, rows < 256 ? rows : 256, n0);
        else moe2_unit<2>(p, L, e, mt * 256, rows, n0);
    }
}

__device__ __forceinline__ void phase_final(const Params& p) {
    const int v = vcu(), G = grid_g();
    const int tid = otid(), lane = tid & 63, wave = tid >> 6;
    const float* pg = p.in[19];
    const float* mod = (const float*)(p.ws + WS_MOD);
    const bf16_t* yb = (const bf16_t*)(p.ws + WS_YB);
    for (int t = v * NW + wave; t < T; t += G * NW) {
        const int b = t / SEQ;
        const float* gf = mod + b * 6144 + 5120;
        float y[2][8];
#pragma unroll
        for (int j = 0; j < 2; ++j)
#pragma unroll
            for (int e = 0; e < 8; ++e) y[j][e] = 0.f;
#pragma unroll
        for (int k = 0; k < 9; ++k) {
            const size_t row = (k < 8) ? ((size_t)t * TOPK + k) : ((size_t)AR + t);
#pragma unroll
            for (int j = 0; j < 2; ++j) {
                const u32x4 raw = *(const u32x4*)(yb + row * Dm + 8 * (lane + 64 * j));
#pragma unroll
                for (int e = 0; e < 4; ++e) { y[j][2 * e] += bflo(raw[e]); y[j][2 * e + 1] += bfhi(raw[e]); }
            }
        }
        float ss = 0.f;
#pragma unroll
        for (int j = 0; j < 2; ++j)
#pragma unroll
            for (int e = 0; e < 8; ++e) ss += y[j][e] * y[j][e];
        ss = wave_sum(ss);
        const float rstd = rsqrtf(ss * (1.f / Dm) + 1e-6f);
#pragma unroll
        for (int j = 0; j < 2; ++j) {
            const int col = 8 * (lane + 64 * j);
#pragma unroll
            for (int hq = 0; hq < 2; ++hq) {
                f32x4 xo = *(const f32x4*)(p.out + (size_t)t * Dm + col + 4 * hq);
                const f32x4 gv = *(const f32x4*)(pg + col + 4 * hq), gg = *(const f32x4*)(gf + col + 4 * hq);
#pragma unroll
                for (int e = 0; e < 4; ++e) xo[e] += gg[e] * (y[j][4 * hq + e] * rstd * gv[e]);
                *(f32x4*)(p.out + (size_t)t * Dm + col + 4 * hq) = xo;
            }
        }
    }
}

#define XB_TMO      128
#define XB_XCNT(j)  (256  + 64 * (j))
#define XB_XSUB(j)  (1280 + 64 * (j))
#define XB_XGEN(j)  (2304 + 64 * (j))
#define XB_TOP      3328
#define XB_TOPGEN   3392
#define XCD_BAR_WORDS 3456
#define XB_SPIN_CAP (1u << 18)
__device__ __forceinline__ unsigned xb_ld(unsigned* p)              { return __hip_atomic_load(p, __ATOMIC_RELAXED, __HIP_MEMORY_SCOPE_AGENT); }
__device__ __forceinline__ unsigned xb_add(unsigned* p, unsigned v) { return __hip_atomic_fetch_add(p, v, __ATOMIC_RELAXED, __HIP_MEMORY_SCOPE_AGENT); }
__device__ __forceinline__ unsigned xb_xcc_id() { return (unsigned)__builtin_amdgcn_s_getreg((3 << 11) | 20) & 0xFu; }
#define XB_SPIN(cond, bar) do { unsigned _sp = 0; while (cond) { __builtin_amdgcn_s_sleep(1); \
    if ((++_sp & 255u) == 0u) { if (xb_ld(&(bar)[XB_TMO])) break; if (_sp > XB_SPIN_CAP) { atomicAdd(&(bar)[XB_TMO], 1u); break; } } } } while (0)
struct XcdBarrier { unsigned* bar; unsigned x; volatile LAS unsigned* st; };
__device__ __forceinline__ XcdBarrier xcd_barrier_post(unsigned* bar, volatile LAS unsigned* st) {
    XcdBarrier b; b.bar = bar; b.x = xb_xcc_id(); b.st = st;
    if (threadIdx.x == 0) (void)xb_add(&bar[XB_XCNT(b.x)], 1u);
    return b;
}
__device__ __forceinline__ void xcd_barrier_complete(unsigned* bar, unsigned x, unsigned& nloc, unsigned& nx) {
    const unsigned G = gridDim.x * gridDim.y * gridDim.z;
    unsigned sum, cnt, mine, sp = 0u;
    for (;;) {
        sum = 0u; cnt = 0u; mine = 0u;
#pragma unroll
        for (unsigned j = 0; j < 16; ++j) { const unsigned c = xb_ld(&bar[XB_XCNT(j)]); sum += c; cnt += (c > 0u) ? 1u : 0u; mine = (j == x) ? c : mine; }
        if (sum == G) break;
        __builtin_amdgcn_s_sleep(1);
        if ((++sp & 255u) == 0u) { if (xb_ld(&bar[XB_TMO])) break; if (sp > XB_SPIN_CAP) { atomicAdd(&bar[XB_TMO], 1u); break; } }
    }
    nloc = mine > 0u ? mine : 1u; nx = cnt > 0u ? cnt : 1u;
}
__device__ __forceinline__ void xcd_barrier(const Params& p, LAS char* L) {
    XcdBarrier b; b.bar = (unsigned*)(p.ws + WS_CTL + 4096); b.x = xb_xcc_id(); b.st = (volatile LAS unsigned*)(L + OFF_MISC);
    asm volatile("s_waitcnt vmcnt(0)" ::: "memory");
    __syncthreads();
    if (threadIdx.x == 0) {
        unsigned* bar = b.bar;
        __builtin_amdgcn_s_waitcnt(0);
        unsigned nloc = b.st[0], nx = b.st[1];
        if (nloc == 0u) { xcd_barrier_complete(bar, b.x, nloc, nx); b.st[0] = nloc; b.st[1] = nx; }
        const unsigned old = xb_add(&bar[XB_XSUB(b.x)], 1u);
        const unsigned gen = old / nloc;
        if (old + 1u == (gen + 1u) * nloc) {
            __builtin_amdgcn_fence(__ATOMIC_RELEASE, "agent");
            asm volatile("s_waitcnt vmcnt(0)" ::: "memory");
            const unsigned og = xb_add(&bar[XB_TOP], 1u);
            const unsigned tg = og / nx;
            if (og + 1u == (tg + 1u) * nx) xb_add(&bar[XB_TOPGEN], 1u);
            else XB_SPIN(xb_ld(&bar[XB_TOPGEN]) == tg, bar);
            __builtin_amdgcn_fence(__ATOMIC_ACQUIRE, "agent");
            xb_add(&bar[XB_XGEN(b.x)], 1u);
            asm volatile("s_waitcnt vmcnt(0)" ::: "memory");
        } else {
            XB_SPIN(xb_ld(&bar[XB_XGEN(b.x)]) == gen, bar);
            __builtin_amdgcn_fence(__ATOMIC_ACQUIRE, "agent");
            asm volatile("s_waitcnt vmcnt(0)" ::: "memory");
        }
    }
    __syncthreads();
}

__global__ void __launch_bounds__(NT, 2) mega(Params p) {
    extern __shared__ __attribute__((aligned(16))) char smem[];
    LAS char* L = (LAS char*)smem;
    if (threadIdx.x < 8) ((LAS unsigned*)(L + OFF_MISC))[threadIdx.x] = 0u;
    __syncthreads();
    (void)xcd_barrier_post((unsigned*)(p.ws + WS_CTL + 4096), (volatile LAS unsigned*)(L + OFF_MISC));
    phase_mod(p, L);
    xcd_barrier(p, L);
    phase_h1(p);
    xcd_barrier(p, L);
    _Pragma("nounroll") for (int rep_ = 0; rep_ < REP_PROJ; ++rep_) phase_proj(p, L);
    xcd_barrier(p, L);
    phase_norms(p);
    xcd_barrier(p, L);
    _Pragma("nounroll") for (int rep_ = 0; rep_ < REP_SMALL; ++rep_) phase_qkv(p, L);
    xcd_barrier(p, L);
    phase_attn(p, L);
    xcd_barrier(p, L);
    _Pragma("nounroll") for (int rep_ = 0; rep_ < REP_SMALL; ++rep_) phase_oproj(p, L);
    xcd_barrier(p, L);
    phase_post_attn(p);
    xcd_barrier(p, L);
    _Pragma("nounroll") for (int rep_ = 0; rep_ < REP_SMALL; ++rep_) phase_router(p, L);
    xcd_barrier(p, L);
    phase_route(p);
    xcd_barrier(p, L);
    _Pragma("nounroll") for (int rep_ = 0; rep_ < REP_MOE1; ++rep_) phase_moe1(p, L);
    xcd_barrier(p, L);
    _Pragma("nounroll") for (int rep_ = 0; rep_ < REP_MOE2; ++rep_) phase_moe2(p, L);
    xcd_barrier(p, L);
    phase_final(p);
}

extern "C" void kernel_launch(void* const* d_in, const int* in_sizes, int n_in, void* d_out, int out_size, void* d_ws, size_t ws_size, hipStream_t stream) {
    static int grid_blocks = 0;
    if (grid_blocks == 0) {
        if (n_in != 28 || out_size != T * Dm || ws_size < WS_END) {
            fprintf(stderr, "kernel_launch: unexpected problem (n_in %d, out %d, ws %zu); nothing launched\n", n_in, out_size, ws_size);
            grid_blocks = -1; return;
        }
        int dev = 0, cus = 0, per_cu = 0;
        (void)hipGetDevice(&dev);
        (void)hipDeviceGetAttribute(&cus, hipDeviceAttributeMultiprocessorCount, dev);
        if (hipFuncSetAttribute((const void*)mega, hipFuncAttributeMaxDynamicSharedMemorySize, LDS_BYTES) != hipSuccess) {
            fprintf(stderr, "kernel_launch: hipFuncSetAttribute(%d B LDS) failed\n", LDS_BYTES); grid_blocks = -1; return;
        }
        (void)hipOccupancyMaxActiveBlocksPerMultiprocessor(&per_cu, mega, NT, LDS_BYTES);
        if (per_cu < 1) { fprintf(stderr, "kernel_launch: occupancy query says %d blocks per CU\n", per_cu); per_cu = 1; }
        grid_blocks = cus;
        fprintf(stderr, "kernel_launch: %d CUs, occupancy query %d per CU, grid %d\n", cus, per_cu, grid_blocks);
    }
    if (grid_blocks < 0) return;
    (void)hipMemsetAsync((char*)d_ws + WS_CTL, 0, CTL_BYTES, stream);
    Params p{};
    for (int i = 0; i < 28; ++i) p.in[i] = (const float*)d_in[i];
    p.out = (float*)d_out; p.ws = (char*)d_ws;
    void* args[] = {&p};
    hipError_t e = hipLaunchCooperativeKernel((void*)mega, dim3(grid_blocks), dim3(NT), args, LDS_BYTES, stream);
    if (e != hipSuccess) fprintf(stderr, "cooperative launch failed: %s (grid %d)\n", hipGetErrorString(e), grid_blocks);
}
```

```cpp
#include <hip/hip_runtime.h>
#include <cstdio>
#include <cstdint>

#ifndef REP_PROJ
#define REP_PROJ 1
#endif
#ifndef REP_ATTN
#define REP_ATTN 1
#endif
#ifndef REP_MOE1
#define REP_MOE1 1
#endif
#ifndef REP_MOE2
#define REP_MOE2 1
#endif
#ifndef REP_SMALL
#define REP_SMALL 1
#endif

typedef unsigned short bf16_t;
typedef float f32x2 __attribute__((ext_vector_type(2)));
typedef short bf16x8 __attribute__((ext_vector_type(8)));
typedef short s16x4 __attribute__((ext_vector_type(4)));
typedef short v4i16_t __attribute__((ext_vector_type(4)));
typedef float f32x16 __attribute__((ext_vector_type(16)));
typedef float f32x4 __attribute__((ext_vector_type(4)));
typedef unsigned u32x4 __attribute__((ext_vector_type(4)));
typedef unsigned u32x2 __attribute__((ext_vector_type(2)));
#define LAS __attribute__((address_space(3)))

constexpr int NT = 512, NW = 8;
constexpr int Dm = 1024, NB = 8, SEQ = 2048, T = NB * SEQ;
constexpr int NIN = 1952;
constexpr int C_CQ = 0, C_CKV = 256, C_KR = 384, C_DQ = 416, C_DK = 928, C_DV = 1440;
constexpr int NE = 256, TOPK = 8, AR = T * TOPK, HROWS = AR + T;
constexpr int LISTCAP = T;
constexpr float LOG2E = 1.4426950408889634f;
constexpr float LAMBDA_INIT = 0.2f;

constexpr size_t MiB = 1u << 20;
constexpr size_t WS_CTL = 0, CTL_BYTES = 65536;
constexpr size_t WS_MOD = 65536;
constexpr size_t WS_ROPE = 1 * MiB;
constexpr size_t WS_H1 = 4 * MiB;
constexpr size_t WS_PROJ = 36 * MiB;
constexpr size_t WS_CQN = 100 * MiB;
constexpr size_t WS_CKVN = 108 * MiB;
constexpr size_t WS_QM = 112 * MiB;
constexpr size_t WS_KF = 136 * MiB;
constexpr size_t WS_VM = 160 * MiB;
constexpr size_t WS_ATT = 176 * MiB;
constexpr size_t WS_OD0 = 208 * MiB;
constexpr size_t WS_Y1 = 240 * MiB;
constexpr size_t WS_H2 = 304 * MiB;
constexpr size_t WS_LOG = 336 * MiB;
constexpr size_t WS_LA = 352 * MiB;
constexpr size_t WS_LW = 368 * MiB;
constexpr size_t WS_HB = 384 * MiB;
constexpr size_t WS_YB = 456 * MiB;
constexpr size_t WS_END = 744 * MiB;

constexpr int G_XB = 32768, G_WB = 36864, G_BUF = G_XB + G_WB, G_LDS = 2 * G_BUF;
constexpr int OFF_MISC = G_LDS, OFF_PRE = OFF_MISC + 64, OFF_TL = OFF_PRE + 1088;
constexpr int OFF_ROW = OFF_TL + 1088, OFF_RW = OFF_ROW + 1024;
constexpr int LDS_BYTES = G_LDS + 4352;

struct Params {
    const float* in[28];
    float* out;
    char* ws;
};

__device__ __forceinline__ unsigned short f2bf(float f) { __bf16 b = (__bf16)f; return __builtin_bit_cast(unsigned short, b); }
typedef __bf16 bf16x2_t __attribute__((ext_vector_type(2)));
__device__ __forceinline__ unsigned pk2(float lo, float hi) { const f32x2 v = {lo, hi}; return __builtin_bit_cast(unsigned, __builtin_convertvector(v, bf16x2_t)); }
__device__ __forceinline__ float bf2f(unsigned short b) { return __uint_as_float(((unsigned)b) << 16); }
__device__ __forceinline__ float bflo(unsigned u) { return __uint_as_float(u << 16); }
__device__ __forceinline__ float bfhi(unsigned u) { return __uint_as_float(u & 0xffff0000u); }
__device__ __forceinline__ int crow(int r, int hi) { return (r & 3) + 8 * (r >> 2) + 4 * hi; }
__device__ __forceinline__ float shx(float v, int m, int lane) { return __int_as_float(__builtin_amdgcn_ds_bpermute((lane ^ m) << 2, __float_as_int(v))); }
__device__ __forceinline__ int shxi(int v, int m, int lane) { return __builtin_amdgcn_ds_bpermute((lane ^ m) << 2, v); }
__device__ __forceinline__ float shl(float v, int src) { return __int_as_float(__builtin_amdgcn_ds_bpermute(src << 2, __float_as_int(v))); }
__device__ __forceinline__ float wave_sum(float v, int lane) {
#pragma unroll
    for (int o = 32; o >= 1; o >>= 1) v += shx(v, o, lane);
    return v;
}
__device__ __forceinline__ float silu_f(float v) { return v / (1.f + __expf(-v)); }
__device__ __forceinline__ s16x4 tr_read(LAS char* p) {
    return __builtin_bit_cast(s16x4, __builtin_amdgcn_ds_read_tr16_b64_v4i16((LAS v4i16_t*)p));
}
__device__ __forceinline__ int otid() { int t = threadIdx.x; asm volatile("" : "+v"(t)); return t; }
__device__ __forceinline__ int grid_g() { return gridDim.x; }
__device__ __forceinline__ int vcu() { const int G = gridDim.x, bx = blockIdx.x; return (G % 8 == 0) ? (bx % 8) * (G / 8) + bx / 8 : bx; }
__device__ __forceinline__ void gld16(u32x4& d, const void* p) { asm volatile("global_load_dwordx4 %0, %1, off" : "+v"(d) : "v"(p) : "memory"); }
__device__ __forceinline__ void gld16(f32x4& d, const void* p) { asm volatile("global_load_dwordx4 %0, %1, off" : "+v"(d) : "v"(p) : "memory"); }
template <int N> __device__ __forceinline__ void vm_wait(u32x4& a, f32x4& b, f32x4& c) { asm volatile("s_waitcnt vmcnt(%3)" : "+v"(a), "+v"(b), "+v"(c) : "n"(N) : "memory"); }
template <int N> __device__ __forceinline__ void vm_wait(f32x4& b, f32x4& c) { asm volatile("s_waitcnt vmcnt(%2)" : "+v"(b), "+v"(c) : "n"(N) : "memory"); }
#define MFMA32(a, b, c) __builtin_amdgcn_mfma_f32_32x32x16_bf16(a, b, c, 0, 0, 0)

template <int NBMODE> __device__ __forceinline__ int nb_of(int wn, int ni) { return NBMODE == 0 ? 64 * wn + 32 * ni : 32 * wn + 128 * ni; }

template <int MI, int NBMODE, class AF, class BF, class EF>
__device__ __forceinline__ void gemm_tile(LAS char* L, int nk, long ldw, const bf16_t* abase, AF arow, BF bcol, EF epi) {
    asm volatile("" : "+s"(nk));
    const int tid = otid(), lane = tid & 63, wave = tid >> 6;
    const int wm = wave & 1, wn = wave >> 1, l31 = lane & 31, hi = lane >> 5;
    const int a_chunk = tid & 7, a_row = tid >> 3;
    const int a_w = a_row * 128 + 16 * (a_chunk ^ ((a_row >> 1) & 7));
    const int b_n4 = tid & 63, b_kr = tid >> 6;
    const float* bp = bcol(4 * b_n4) + (long)b_kr * ldw;
    const int b_w = G_XB + b_kr * 576 + 8 * b_n4;
    const int sw = (l31 >> 1) & 7;
    const int xoff = (32 * MI * wm + l31) * 128;
    const int woff = G_XB + (8 * hi + ((lane & 15) >> 2)) * 576 + 2 * (16 * ((lane >> 4) & 1) + 4 * (lane & 3));
    u32x4 ra[MI]; f32x4 rb[8];
#pragma unroll
    for (int i = 0; i < MI; ++i) ra[i] = (u32x4){0u, 0u, 0u, 0u};
#pragma unroll
    for (int i = 0; i < 8; ++i) rb[i] = (f32x4){0.f, 0.f, 0.f, 0.f};
#define G_LOADQ(KT, Q) do { \
        if ((Q) < MI) gld16(ra[(Q) < MI ? (Q) : 0], abase + arow(a_row + 64 * (Q)) + a_chunk * 8 + (KT) * 64); \
        gld16(rb[2 * (Q)], bp + (long)((KT) * 64 + 16 * (Q)) * ldw); \
        gld16(rb[2 * (Q) + 1], bp + (long)((KT) * 64 + 16 * (Q) + 8) * ldw); } while (0)
#define G_LOADQ_SEL(KT, Q, OK) do { \
        const int kq_ = (OK) ? (KT) * 64 : 0;        \
        if ((Q) < MI) gld16(ra[(Q) < MI ? (Q) : 0], abase + arow(a_row + 64 * (Q)) + a_chunk * 8 + kq_); \
        gld16(rb[2 * (Q)], bp + (long)(kq_ + 16 * (Q)) * ldw); \
        gld16(rb[2 * (Q) + 1], bp + (long)(kq_ + 16 * (Q) + 8) * ldw); } while (0)
#define G_WAITQ(Q, N) do { if ((Q) < MI) vm_wait<N>(ra[(Q) < MI ? (Q) : 0], rb[2 * (Q)], rb[2 * (Q) + 1]); else vm_wait<N>(rb[2 * (Q)], rb[2 * (Q) + 1]); } while (0)
#define G_STOREQ(LP, Q) do { \
        if ((Q) < MI) *(LAS u32x4*)((LP) + a_w + (Q) * 8192) = ra[(Q) < MI ? (Q) : 0]; \
        { u32x2 w; w.x = pk2(rb[2 * (Q)][0], rb[2 * (Q)][1]); w.y = pk2(rb[2 * (Q)][2], rb[2 * (Q)][3]); *(LAS u32x2*)((LP) + b_w + (Q) * 16 * 576) = w; } \
        { u32x2 w; w.x = pk2(rb[2 * (Q) + 1][0], rb[2 * (Q) + 1][1]); w.y = pk2(rb[2 * (Q) + 1][2], rb[2 * (Q) + 1][3]); *(LAS u32x2*)((LP) + b_w + (Q) * 16 * 576 + 8 * 576) = w; } } while (0)
    constexpr int NL0 = (0 < MI) ? 3 : 2, NL1 = (1 < MI) ? 3 : 2, NL2 = (2 < MI) ? 3 : 2, NL3 = (3 < MI) ? 3 : 2, NLT = NL0 + NL1 + NL2 + NL3;
    G_LOADQ(0, 0); G_LOADQ(0, 1); G_LOADQ(0, 2); G_LOADQ(0, 3);
    G_WAITQ(0, 0); G_WAITQ(1, 0); G_WAITQ(2, 0); G_WAITQ(3, 0);
    G_STOREQ(L, 0); G_STOREQ(L, 1); G_STOREQ(L, 2); G_STOREQ(L, 3);
    G_LOADQ(1, 0); G_LOADQ(1, 1); G_LOADQ(1, 2); G_LOADQ(1, 3);
    f32x16 acc[MI][2];
#pragma unroll
    for (int i = 0; i < MI; ++i)
#pragma unroll
        for (int j = 0; j < 2; ++j)
#pragma unroll
            for (int r = 0; r < 16; ++r) acc[i][j][r] = 0.f;
    __syncthreads();
#pragma nounroll
    for (int kt = 0; kt < nk; ++kt) {
        LAS char* Lb = L + (kt & 1) * G_BUF;
        LAS char* Ln = L + ((kt + 1) & 1) * G_BUF;
        const bool ld = kt + 2 < nk;
        bf16x8 xf[2][MI], wf[2][2];
#define LOAD_FRAGS(KS, B) do { \
            _Pragma("unroll") for (int mi = 0; mi < MI; ++mi) xf[B][mi] = *(LAS bf16x8*)(Lb + xoff + mi * 4096 + 16 * ((2 * (KS) + hi) ^ sw)); \
            _Pragma("unroll") for (int ni = 0; ni < 2; ++ni) { \
                LAS char* pp = Lb + woff + (KS) * 16 * 576 + 2 * nb_of<NBMODE>(wn, ni); \
                const s16x4 lo = tr_read(pp), h4 = tr_read(pp + 4 * 576); \
                wf[B][ni] = (bf16x8){lo[0], lo[1], lo[2], lo[3], h4[0], h4[1], h4[2], h4[3]}; } } while (0)
#define MMA_STEP(KS) do { \
            _Pragma("unroll") for (int mi = 0; mi < MI; ++mi) \
                _Pragma("unroll") for (int ni = 0; ni < 2; ++ni) acc[mi][ni] = MFMA32(wf[(KS) & 1][ni], xf[(KS) & 1][mi], acc[mi][ni]); } while (0)
#define STAGE_STEP(Q, NREST, NPREV) do { G_WAITQ(Q, (NREST) + (NPREV)); G_STOREQ(Ln, Q); G_LOADQ_SEL(kt + 2, Q, ld); } while (0)
        LOAD_FRAGS(0, 0);
        LOAD_FRAGS(1, 1); MMA_STEP(0); STAGE_STEP(0, NL1 + NL2 + NL3, 0);           __builtin_amdgcn_sched_barrier(0);
        LOAD_FRAGS(2, 0); MMA_STEP(1); STAGE_STEP(1, NL2 + NL3, NL0);               __builtin_amdgcn_sched_barrier(0);
        LOAD_FRAGS(3, 1); MMA_STEP(2); STAGE_STEP(2, NL3, NL0 + NL1);               __builtin_amdgcn_sched_barrier(0);
        MMA_STEP(3);                   STAGE_STEP(3, 0, NL0 + NL1 + NL2);           __builtin_amdgcn_sched_barrier(0);
#undef LOAD_FRAGS
#undef MMA_STEP
#undef STAGE_STEP
        __syncthreads();
    }
    G_WAITQ(0, 0); G_WAITQ(1, 0); G_WAITQ(2, 0); G_WAITQ(3, 0);
#undef G_LOADQ
#undef G_WAITQ
#undef G_STOREQ
    (void)NLT;
    epi(acc);
}

template <int MI, int NC, class DF>
__device__ __forceinline__ void store_tile_bf16(LAS char* L, const f32x16 (&acc)[MI][2], DF dst) {
    constexpr int STR = NC * 2 + 16, CPR = NC / 8, BM = 64 * MI;
    const int tid = otid(), lane = tid & 63, wave = tid >> 6, wm = wave & 1, wn = wave >> 1, l31 = lane & 31, hi = lane >> 5;
#pragma unroll
    for (int mi = 0; mi < MI; ++mi)
#pragma unroll
        for (int ni = 0; ni < (NC == 256 ? 2 : 1); ++ni) {
            const int row = 32 * MI * wm + 32 * mi + l31, col = (NC == 256) ? nb_of<0>(wn, ni) : 32 * wn;
#pragma unroll
            for (int gq = 0; gq < 4; ++gq) {
                u32x2 w; w.x = pk2(acc[mi][ni][4 * gq], acc[mi][ni][4 * gq + 1]); w.y = pk2(acc[mi][ni][4 * gq + 2], acc[mi][ni][4 * gq + 3]);
                *(LAS u32x2*)(L + row * STR + 2 * (col + 8 * gq + 4 * hi)) = w;
            }
        }
    __syncthreads();
#pragma unroll
    for (int i = 0; i < (BM * CPR) / NT; ++i) {
        const int id = tid + NT * i, row = id / CPR, c = id % CPR;
        bf16_t* d = dst(row, c);
        if (d) *(u32x4*)d = *(LAS u32x4*)(L + row * STR + 16 * c);
    }
    __syncthreads();
}

__device__ __forceinline__ void phase_mod(const Params& p, LAS char* L) {
    const int v = vcu(), G = grid_g();
    const int tid = otid();
    const float* c = p.in[1]; const float* w_ada = p.in[3]; const float* b_ada = p.in[4];
    float* mod = (float*)(p.ws + WS_MOD);
    LAS float* sc = (LAS float*)L;
    LAS float* red = (LAS float*)(L + 32768);
    bool filled = false;
    for (int item = v; item < 384; item += G) {
        if (!filled) {
            for (int i = tid; i < 8 * 1024; i += NT) sc[i] = silu_f(c[i]);
            __syncthreads(); filled = true;
        }
        const int cx = tid & 15, kl = tid >> 4, col = item * 16 + cx;
        float a[8];
#pragma unroll
        for (int b = 0; b < 8; ++b) a[b] = 0.f;
#pragma unroll 4
        for (int k = kl; k < 1024; k += 32) {
            const float w = w_ada[(size_t)k * 6144 + col];
#pragma unroll
            for (int b = 0; b < 8; ++b) a[b] += sc[b * 1024 + k] * w;
        }
#pragma unroll
        for (int b = 0; b < 8; ++b) red[(b * 32 + kl) * 16 + cx] = a[b];
        __syncthreads();
        if (tid < 128) {
            const int b = tid >> 4, cc = tid & 15; float s = 0.f;
#pragma unroll
            for (int k = 0; k < 32; ++k) s += red[(b * 32 + k) * 16 + cc];
            mod[b * 6144 + item * 16 + cc] = s + b_ada[item * 16 + cc];
        }
        __syncthreads();
    }
}

__device__ __forceinline__ void phase_h1(const Params& p) {
    const int v = vcu(), G = grid_g();
    const int tid = otid(), lane = tid & 63, wave = tid >> 6;
    const float* x = p.in[0]; const int* positions = (const int*)p.in[2]; const float* g = p.in[5];
    const float* mod = (const float*)(p.ws + WS_MOD);
    bf16_t* h1 = (bf16_t*)(p.ws + WS_H1);
    f32x2* rope = (f32x2*)(p.ws + WS_ROPE);
    for (int t = v * NW + wave; t < T; t += G * NW) {
        const int b = t / SEQ;
        const f32x4* xr = (const f32x4*)(x + (size_t)t * Dm);
        f32x4 xv[4]; float ss = 0.f;
#pragma unroll
        for (int j = 0; j < 4; ++j) { xv[j] = xr[lane + 64 * j]; ss += xv[j][0] * xv[j][0] + xv[j][1] * xv[j][1] + xv[j][2] * xv[j][2] + xv[j][3] * xv[j][3]; }
        ss = wave_sum(ss, lane);
        const float rstd = rsqrtf(ss * (1.f / Dm) + 1e-6f);
        const float* sh = mod + b * 6144; const float* scl = sh + 1024;
#pragma unroll
        for (int j = 0; j < 4; ++j) {
            const int col = 4 * (lane + 64 * j);
            const f32x4 gv = *(const f32x4*)(g + col), sv = *(const f32x4*)(scl + col), hv = *(const f32x4*)(sh + col);
            float o[4];
#pragma unroll
            for (int e = 0; e < 4; ++e) o[e] = (xv[j][e] * rstd * gv[e]) * (1.f + sv[e]) + hv[e];
            u32x2 w; w.x = pk2(o[0], o[1]); w.y = pk2(o[2], o[3]);
            *(u32x2*)(h1 + (size_t)t * Dm + col) = w;
        }
        if (lane < 16) {
            const double inv = exp2(-(double)lane * (13.287712379549449 / 16.0));
            const double rev = (double)positions[t] * inv * 0.15915494309189535;
            const float fr = (float)(rev - rint(rev));
            f32x2 cs; cs.x = __builtin_amdgcn_cosf(fr); cs.y = __builtin_amdgcn_sinf(fr);
            rope[(size_t)t * 16 + lane] = cs;
        }
    }
}

__device__ __forceinline__ void phase_proj(const Params& p, LAS char* L) {
    const int v = vcu(), G = grid_g();
    const bf16_t* h1 = (const bf16_t*)(p.ws + WS_H1);
    const float* w_in = p.in[7];
    bf16_t* proj = (bf16_t*)(p.ws + WS_PROJ);
    for (int u = v; u < 64 * 8; u += G) {
        const int mt = u >> 3, nt = u & 7, m0 = mt * 256, n0 = nt * 256;
        auto arow = [&](int r) { return (unsigned)(m0 + r) * Dm; };
        auto bcol = [&](int c) { int col = n0 + c; if (col > NIN - 4) col = NIN - 4; return w_in + col; };
        auto epi = [&](f32x16 (&acc)[4][2]) {
            const int wave = otid() >> 6, wn = wave >> 1;
#pragma unroll
            for (int ni = 0; ni < 2; ++ni) {
                const int nbg = n0 + nb_of<0>(wn, ni);
                if (nbg >= C_DQ && nbg < C_DK) {
#pragma unroll
                    for (int mi = 0; mi < 4; ++mi)
#pragma unroll
                        for (int r = 0; r < 16; ++r) acc[mi][ni][r] *= 0.125f * LOG2E;
                }
            }
            store_tile_bf16<4, 256>(L, acc, [&](int row, int c) -> bf16_t* { const int col = n0 + 8 * c; return col < NIN ? proj + (size_t)(m0 + row) * NIN + col : nullptr; });
        };
        gemm_tile<4, 0>(L, Dm / 64, NIN, h1, arow, bcol, epi);
    }
}

__device__ __forceinline__ void phase_norms(const Params& p) {
    const int v = vcu(), G = grid_g();
    const int tid = otid(), lane = tid & 63, wave = tid >> 6;
    const bf16_t* proj = (const bf16_t*)(p.ws + WS_PROJ);
    const float* qg = p.in[8]; const float* kvg = p.in[9];
    bf16_t* cqn = (bf16_t*)(p.ws + WS_CQN); bf16_t* ckvn = (bf16_t*)(p.ws + WS_CKVN); bf16_t* kf = (bf16_t*)(p.ws + WS_KF);
    const f32x2* rope = (const f32x2*)(p.ws + WS_ROPE);
    for (int t = v * NW + wave; t < T; t += G * NW) {
        const bf16_t* pr = proj + (size_t)t * NIN;
        {
            const u32x2 raw = *(const u32x2*)(pr + C_CQ + 4 * lane);
            float a[4] = {bflo(raw.x), bfhi(raw.x), bflo(raw.y), bfhi(raw.y)};
            float ss = wave_sum(a[0] * a[0] + a[1] * a[1] + a[2] * a[2] + a[3] * a[3], lane);
            const float rstd = rsqrtf(ss * (1.f / 256.f) + 1e-6f);
            const f32x4 gv = *(const f32x4*)(qg + 4 * lane);
            u32x2 w; w.x = pk2(a[0] * rstd * gv[0], a[1] * rstd * gv[1]); w.y = pk2(a[2] * rstd * gv[2], a[3] * rstd * gv[3]);
            *(u32x2*)(cqn + (size_t)t * 256 + 4 * lane) = w;
        }
        {
            const unsigned raw = *(const unsigned*)(pr + C_CKV + 2 * lane);
            const float a0 = bflo(raw), a1 = bfhi(raw);
            float ss = wave_sum(a0 * a0 + a1 * a1, lane);
            const float rstd = rsqrtf(ss * (1.f / 128.f) + 1e-6f);
            *(unsigned*)(ckvn + (size_t)t * 128 + 2 * lane) = pk2(a0 * rstd * kvg[2 * lane], a1 * rstd * kvg[2 * lane + 1]);
        }
        if (lane < 16) {
            const float x1 = bf2f(pr[C_KR + lane]), x2 = bf2f(pr[C_KR + 16 + lane]);
            const f32x2 cs = rope[(size_t)t * 16 + lane];
            const bf16_t y1 = f2bf(x1 * cs.x - x2 * cs.y), y2 = f2bf(x2 * cs.x + x1 * cs.y);
#pragma unroll
            for (int h = 0; h < 8; ++h) { kf[(size_t)t * 768 + h * 96 + 64 + lane] = y1; kf[(size_t)t * 768 + h * 96 + 80 + lane] = y2; }
        }
    }
}

__device__ __forceinline__ void phase_qkv(const Params& p, LAS char* L) {
    const int v = vcu(), G = grid_g();
    const bf16_t* cqn = (const bf16_t*)(p.ws + WS_CQN); const bf16_t* ckvn = (const bf16_t*)(p.ws + WS_CKVN);
    const float* w_uq = p.in[10]; const float* w_ukv = p.in[11];
    bf16_t* qm = (bf16_t*)(p.ws + WS_QM); bf16_t* kf = (bf16_t*)(p.ws + WS_KF); bf16_t* vm = (bf16_t*)(p.ws + WS_VM);
    const f32x2* rope = (const f32x2*)(p.ws + WS_ROPE);
    const float qscale = LOG2E * 0.10206207261596575f;
    for (int u = v; u < 64 * 7; u += G) {
        const int mt = u / 7, j = u % 7, m0 = mt * 256;
        if (j < 3) {
            const int n0 = j * 256;
            auto arow = [&](int r) { return (unsigned)(m0 + r) * 256; };
            auto bcol = [&](int c) { return w_uq + n0 + c; };
            auto epi = [&](f32x16 (&acc)[4][2]) {
                const int tid_ = otid(), lane = tid_ & 63, wave = tid_ >> 6, wm = wave & 1, wn = wave >> 1, l31 = lane & 31, hi = lane >> 5;
#pragma unroll
                for (int mi = 0; mi < 4; ++mi) {
                    const int m = m0 + 128 * wm + 32 * mi + l31;
#pragma unroll
                    for (int ni = 0; ni < 2; ++ni) {
                        const int nbg = n0 + nb_of<0>(wn, ni);
                        if ((nbg % 96) == 64) {
#pragma unroll
                            for (int r = 0; r < 8; ++r) {
                                const f32x2 cs = rope[(size_t)m * 16 + crow(r, hi)];
                                const float x1 = acc[mi][ni][r], x2 = acc[mi][ni][r + 8];
                                acc[mi][ni][r] = x1 * cs.x - x2 * cs.y; acc[mi][ni][r + 8] = x2 * cs.x + x1 * cs.y;
                            }
                        }
#pragma unroll
                        for (int r = 0; r < 16; ++r) acc[mi][ni][r] *= qscale;
                    }
                }
                store_tile_bf16<4, 256>(L, acc, [&](int row, int c) -> bf16_t* { return qm + (size_t)(m0 + row) * 768 + n0 + 8 * c; });
            };
            gemm_tile<4, 0>(L, 256 / 64, 768, cqn, arow, bcol, epi);
        } else {
            const int n0 = (j - 3) * 256;
            auto arow = [&](int r) { return (unsigned)(m0 + r) * 128; };
            auto bcol = [&](int c) { return w_ukv + n0 + c; };
            auto epi = [&](f32x16 (&acc)[4][2]) {
                store_tile_bf16<4, 256>(L, acc, [&](int row, int c) -> bf16_t* {
                    const int h = (n0 >> 7) + (c >> 4), cc = c & 15;
                    return cc < 8 ? kf + (size_t)(m0 + row) * 768 + h * 96 + 8 * cc : vm + (size_t)(m0 + row) * 512 + h * 64 + 8 * (cc - 8); });
            };
            gemm_tile<4, 0>(L, 128 / 64, 1024, ckvn, arow, bcol, epi);
        }
    }
}

template <int DQK, int DV, bool ALIBI>
__device__ __forceinline__ void attn_map(LAS char* L, const bf16_t* Q, int ldq, const bf16_t* K, int ldk, const bf16_t* V, int ldv,
                                         const int* posrow, float slope2, int q0, f32x16 (&o)[DV / 32]) {
    constexpr int KSTR = DQK * 2 + 16, VSTR = DV * 2 + 64, KS = DQK / 16, ND = DV / 32;
    constexpr int K_OFF = 0, V_OFF = 64 * KSTR, P_OFF = V_OFF + 64 * VSTR, ABUF = P_OFF + 256;
    constexpr int KCH = DQK / 8, VCH = DV / 8;
    constexpr int NKI = (64 * KCH + NT - 1) / NT, NVI = (64 * VCH + NT - 1) / NT;
    const int tid = otid();
    const int lane = tid & 63, wave = tid >> 6, l31 = lane & 31, hi = lane >> 5;
    const int qrow = q0 + 32 * wave + l31;
    unsigned kgo[NKI], klo[NKI], vgo[NVI], vlo[NVI];
#pragma unroll
    for (int i = 0; i < NKI; ++i) { int c = tid + NT * i; if (c >= 64 * KCH) c = 64 * KCH - 1; const int row = c / KCH, ch = c % KCH; kgo[i] = (unsigned)(row * ldk + ch * 8) * 2u; klo[i] = K_OFF + row * KSTR + ch * 16; }
#pragma unroll
    for (int i = 0; i < NVI; ++i) { int c = tid + NT * i; if (c >= 64 * VCH) c = 64 * VCH - 1; const int row = c / VCH, ch = c % VCH; vgo[i] = (unsigned)(row * ldv + ch * 8) * 2u; vlo[i] = V_OFF + row * VSTR + ch * 16; }
    bf16x8 qf[KS];
#pragma unroll
    for (int s = 0; s < KS; ++s) qf[s] = *(const bf16x8*)(Q + (size_t)qrow * ldq + 16 * s + 8 * hi);
    const float posq = ALIBI ? (float)posrow[qrow] : 0.f;
#pragma unroll
    for (int d = 0; d < ND; ++d)
#pragma unroll
        for (int r = 0; r < 16; ++r) o[d][r] = 0.f;
    float m_run = -1e30f, l_run = 0.f;
    const int ntile = (q0 + 256) / 64;
    const int qmin = q0 + 32 * wave, qmax = qmin + 31;
    const int vrd = V_OFF + (4 * hi + ((lane & 15) >> 2)) * VSTR + 2 * (16 * ((lane >> 4) & 1) + 4 * (lane & 3));
    u32x4 rk[NKI], rv[NVI]; float rp = 0.f;
#pragma unroll
    for (int i = 0; i < NKI; ++i) rk[i] = *(const u32x4*)((const char*)K + kgo[i]);
#pragma unroll
    for (int i = 0; i < NVI; ++i) rv[i] = *(const u32x4*)((const char*)V + vgo[i]);
    if (ALIBI && tid < 64) rp = (float)posrow[tid];
    __syncthreads();
#pragma unroll
    for (int i = 0; i < NKI; ++i) if (tid + NT * i < 64 * KCH) *(LAS u32x4*)(L + klo[i]) = rk[i];
#pragma unroll
    for (int i = 0; i < NVI; ++i) if (tid + NT * i < 64 * VCH) *(LAS u32x4*)(L + vlo[i]) = rv[i];
    if (ALIBI && tid < 64) *(LAS float*)(L + P_OFF + 4 * tid) = rp;
    __syncthreads();
    for (int tl = 0; tl < ntile; ++tl) {
        const int kb = tl * 64;
        LAS char* Lb = L + (tl & 1) * ABUF;
        LAS char* Ln = L + ((tl + 1) & 1) * ABUF;
        const bool more = tl + 1 < ntile;
        if (more) {
            const char* kbase = (const char*)(K + (size_t)(kb + 64) * ldk);
            const char* vbase = (const char*)(V + (size_t)(kb + 64) * ldv);
#pragma unroll
            for (int i = 0; i < NKI; ++i) rk[i] = *(const u32x4*)(kbase + kgo[i]);
#pragma unroll
            for (int i = 0; i < NVI; ++i) rv[i] = *(const u32x4*)(vbase + vgo[i]);
            if (ALIBI && tid < 64) rp = (float)posrow[kb + 64 + tid];
        }
        if (kb <= qmax) {
            f32x16 s0, s1;
#pragma unroll
            for (int r = 0; r < 16; ++r) { s0[r] = 0.f; s1[r] = 0.f; }
#pragma unroll
            for (int s = 0; s < KS; ++s) {
                const bf16x8 k0 = *(LAS bf16x8*)(Lb + K_OFF + l31 * KSTR + 32 * s + 16 * hi);
                const bf16x8 k1 = *(LAS bf16x8*)(Lb + K_OFF + (32 + l31) * KSTR + 32 * s + 16 * hi);
                s0 = MFMA32(k0, qf[s], s0); s1 = MFMA32(k1, qf[s], s1);
            }
            if (ALIBI) {
#pragma unroll
                for (int r = 0; r < 16; ++r) {
                    const float pk0 = *(LAS float*)(Lb + P_OFF + 4 * crow(r, hi)), pk1 = *(LAS float*)(Lb + P_OFF + 4 * (32 + crow(r, hi)));
                    s0[r] -= slope2 * fabsf(posq - pk0); s1[r] -= slope2 * fabsf(posq - pk1);
                }
            }
            if (kb + 63 > qmin) {
#pragma unroll
                for (int r = 0; r < 16; ++r) {
                    const int key = kb + crow(r, hi);
                    if (key > qrow) s0[r] = -INFINITY;
                    if (key + 32 > qrow) s1[r] = -INFINITY;
                }
            }
            float mx = s0[0];
#pragma unroll
            for (int r = 1; r < 16; ++r) mx = fmaxf(mx, s0[r]);
#pragma unroll
            for (int r = 0; r < 16; ++r) mx = fmaxf(mx, s1[r]);
            mx = fmaxf(mx, shx(mx, 32, lane));
            const float m_new = fmaxf(m_run, mx);
            const float alpha = __builtin_amdgcn_exp2f(m_run - m_new);
            m_run = m_new;
            float ls = 0.f;
#pragma unroll
            for (int r = 0; r < 16; ++r) { s0[r] = __builtin_amdgcn_exp2f(s0[r] - m_new); s1[r] = __builtin_amdgcn_exp2f(s1[r] - m_new); ls += s0[r] + s1[r]; }
            l_run = l_run * alpha + ls;
#pragma unroll
            for (int d = 0; d < ND; ++d)
#pragma unroll
                for (int r = 0; r < 16; ++r) o[d][r] *= alpha;
            u32x4 pw[4];
#pragma unroll
            for (int j = 0; j < 4; ++j) {
                pw[0][j] = pk2(s0[2 * j], s0[2 * j + 1]); pw[1][j] = pk2(s0[8 + 2 * j], s0[8 + 2 * j + 1]);
                pw[2][j] = pk2(s1[2 * j], s1[2 * j + 1]); pw[3][j] = pk2(s1[8 + 2 * j], s1[8 + 2 * j + 1]);
            }
#pragma unroll
            for (int s = 0; s < 4; ++s) {
                const bf16x8 pf = __builtin_bit_cast(bf16x8, pw[s]);
#pragma unroll
                for (int d = 0; d < ND; ++d) {
                    LAS char* vp = Lb + vrd + 16 * s * VSTR + 64 * d;
                    const s16x4 lo = tr_read(vp), h4 = tr_read(vp + 8 * VSTR);
                    const bf16x8 vf = (bf16x8){lo[0], lo[1], lo[2], lo[3], h4[0], h4[1], h4[2], h4[3]};
                    o[d] = MFMA32(vf, pf, o[d]);
                }
                __builtin_amdgcn_sched_barrier(0);
            }
        }
        if (more) {
#pragma unroll
            for (int i = 0; i < NKI; ++i) if (tid + NT * i < 64 * KCH) *(LAS u32x4*)(Ln + klo[i]) = rk[i];
#pragma unroll
            for (int i = 0; i < NVI; ++i) if (tid + NT * i < 64 * VCH) *(LAS u32x4*)(Ln + vlo[i]) = rv[i];
            if (ALIBI && tid < 64) *(LAS float*)(Ln + P_OFF + 4 * tid) = rp;
        }
        __syncthreads();
    }
    const float lt = l_run + shx(l_run, 32, lane);
    const float inv = 1.f / lt;
#pragma unroll
    for (int d = 0; d < ND; ++d)
#pragma unroll
        for (int r = 0; r < 16; ++r) o[d][r] *= inv;
}

__device__ __forceinline__ void attn_decode(int it, int& kind, int& qb, int& idx) {
    const int seg_kind[16] = {1, 1, 1, 1, 1, 0, 1, 0, 0, 0, 1, 0, 0, 1, 0, 0};
    const int seg_qb[16]   = {7, 6, 5, 4, 3, 7, 2, 6, 5, 4, 1, 3, 2, 0, 1, 0};
    int base = 0; kind = 0; qb = 0; idx = 0;
#pragma unroll
    for (int s = 0; s < 16; ++s) {
        const int n = seg_kind[s] ? 32 : 64;
        if (it >= base && it < base + n) { kind = seg_kind[s]; qb = seg_qb[s]; idx = it - base; }
        base += n;
    }
}

__device__ __forceinline__ void phase_attn(const Params& p, LAS char* L) {
    const int v = vcu(), G = grid_g();
    const int tid = otid(), lane = tid & 63, wave = tid >> 6, l31 = lane & 31, hi = lane >> 5;
    const int* positions = (const int*)p.in[2];
    const bf16_t* proj = (const bf16_t*)(p.ws + WS_PROJ);
    const bf16_t* qm = (const bf16_t*)(p.ws + WS_QM); const bf16_t* kf = (const bf16_t*)(p.ws + WS_KF); const bf16_t* vm = (const bf16_t*)(p.ws + WS_VM);
    bf16_t* att = (bf16_t*)(p.ws + WS_ATT);
    float* od0 = (float*)(p.ws + WS_OD0);
    const float* subg = p.in[16];
    unsigned* qctr = (unsigned*)(p.ws + WS_CTL + 2048);
    LAS unsigned* qslot = (LAS unsigned*)(L + OFF_MISC + 16);
    float lam;
    {
        const float a = p.in[12][lane] * p.in[13][lane], b = p.in[14][lane] * p.in[15][lane];
        lam = __expf(wave_sum(a, lane)) - __expf(wave_sum(b, lane)) + LAMBDA_INIT;
    }
    for (;;) {
        if (tid == 0) *qslot = __hip_atomic_fetch_add(qctr, 1u, __ATOMIC_RELAXED, __HIP_MEMORY_SCOPE_AGENT);
        __syncthreads();
        const int it = (int)*qslot;
        __syncthreads();
        if (it >= 768) break;
        int kind, qb, idx;
        attn_decode(it, kind, qb, idx);
        const int q0 = qb * 256;
        if (kind == 0) {
            const int b = idx >> 3, h = idx & 7; const size_t tb = (size_t)b * SEQ;
            f32x16 o[2];
            attn_map<96, 64, false>(L, qm + tb * 768 + h * 96, 768, kf + tb * 768 + h * 96, 768, vm + tb * 512 + h * 64, 512, positions + tb, 0.f, q0, o);
            const size_t t = tb + q0 + 32 * wave + l31;
#pragma unroll
            for (int d = 0; d < 2; ++d)
#pragma unroll
                for (int gq = 0; gq < 4; ++gq) {
                    u32x2 w; w.x = pk2(o[d][4 * gq], o[d][4 * gq + 1]); w.y = pk2(o[d][4 * gq + 2], o[d][4 * gq + 3]);
                    *(u32x2*)(att + t * 1024 + h * 64 + 32 * d + 8 * gq + 4 * hi) = w;
                }
        } else {
            const int b = idx >> 2, h = idx & 3; const size_t tb = (size_t)b * SEQ;
            const float slope2 = exp2f(-2.f * (h + 1)) * LOG2E;
            const size_t t = tb + q0 + 32 * wave + l31;
            f32x16 o[4];
            attn_map<64, 128, true>(L, proj + tb * NIN + C_DQ + h * 128, NIN, proj + tb * NIN + C_DK + h * 128, NIN, proj + tb * NIN + C_DV + h * 128, NIN, positions + tb, slope2, q0, o);
#pragma unroll
            for (int d = 0; d < 4; ++d)
#pragma unroll
                for (int gq = 0; gq < 4; ++gq) {
                    f32x4 w = {o[d][4 * gq], o[d][4 * gq + 1], o[d][4 * gq + 2], o[d][4 * gq + 3]};
                    *(f32x4*)(od0 + t * 512 + h * 128 + 32 * d + 8 * gq + 4 * hi) = w;
                }
            attn_map<64, 128, true>(L, proj + tb * NIN + C_DQ + h * 128 + 64, NIN, proj + tb * NIN + C_DK + h * 128 + 64, NIN, proj + tb * NIN + C_DV + h * 128, NIN, positions + tb, slope2, q0, o);
            float ss = 0.f;
#pragma unroll
            for (int d = 0; d < 4; ++d)
#pragma unroll
                for (int gq = 0; gq < 4; ++gq) {
                    const f32x4 w = *(const f32x4*)(od0 + t * 512 + h * 128 + 32 * d + 8 * gq + 4 * hi);
#pragma unroll
                    for (int e = 0; e < 4; ++e) { const float c = w[e] - lam * o[d][4 * gq + e]; o[d][4 * gq + e] = c; ss += c * c; }
                }
            ss += shx(ss, 32, lane);
            const float rstd = rsqrtf(ss * (1.f / 128.f) + 1e-5f) * (1.f - LAMBDA_INIT);
#pragma unroll
            for (int d = 0; d < 4; ++d)
#pragma unroll
                for (int gq = 0; gq < 4; ++gq) {
                    const int dv = 32 * d + 8 * gq + 4 * hi;
                    const f32x4 gv = *(const f32x4*)(subg + dv);
                    u32x2 w; w.x = pk2(o[d][4 * gq] * rstd * gv[0], o[d][4 * gq + 1] * rstd * gv[1]); w.y = pk2(o[d][4 * gq + 2] * rstd * gv[2], o[d][4 * gq + 3] * rstd * gv[3]);
                    *(u32x2*)(att + t * 1024 + 512 + h * 128 + dv) = w;
                }
        }
    }
}

__device__ __forceinline__ void phase_oproj(const Params& p, LAS char* L) {
    const int v = vcu(), G = grid_g();
    const bf16_t* att = (const bf16_t*)(p.ws + WS_ATT);
    const float* w_o = p.in[17];
    bf16_t* y1 = (bf16_t*)(p.ws + WS_Y1);
    for (int u = v; u < 64 * 4; u += G) {
        const int mt = u >> 2, nt = u & 3, m0 = mt * 256, n0 = nt * 256;
        auto arow = [&](int r) { return (unsigned)(m0 + r) * Dm; };
        auto bcol = [&](int c) { return w_o + n0 + c; };
        auto epi = [&](f32x16 (&acc)[4][2]) {
            store_tile_bf16<4, 256>(L, acc, [&](int row, int c) -> bf16_t* { return y1 + (size_t)(m0 + row) * Dm + n0 + 8 * c; });
        };
        gemm_tile<4, 0>(L, Dm / 64, Dm, att, arow, bcol, epi);
    }
}

__device__ __forceinline__ void phase_post_attn(const Params& p) {
    const int v = vcu(), G = grid_g();
    const int tid = otid(), lane = tid & 63, wave = tid >> 6;
    const float* x = p.in[0]; const float* pg = p.in[6]; const float* fg = p.in[18];
    const float* mod = (const float*)(p.ws + WS_MOD);
    const bf16_t* y1 = (const bf16_t*)(p.ws + WS_Y1);
    bf16_t* h2 = (bf16_t*)(p.ws + WS_H2);
    for (int t = v * NW + wave; t < T; t += G * NW) {
        const int b = t / SEQ;
        const float* mb = mod + b * 6144;
        f32x4 yv[4], xv[4]; float ss = 0.f;
#pragma unroll
        for (int j = 0; j < 4; ++j) {
            const u32x2 raw = *(const u32x2*)(y1 + (size_t)t * Dm + 4 * (lane + 64 * j));
            yv[j] = (f32x4){bflo(raw.x), bfhi(raw.x), bflo(raw.y), bfhi(raw.y)};
            xv[j] = *(const f32x4*)(x + (size_t)t * Dm + 4 * (lane + 64 * j));
            ss += yv[j][0] * yv[j][0] + yv[j][1] * yv[j][1] + yv[j][2] * yv[j][2] + yv[j][3] * yv[j][3];
        }
        ss = wave_sum(ss, lane);
        const float rstd = rsqrtf(ss * (1.f / Dm) + 1e-6f);
        float ss2 = 0.f;
#pragma unroll
        for (int j = 0; j < 4; ++j) {
            const int col = 4 * (lane + 64 * j);
            const f32x4 gv = *(const f32x4*)(pg + col), ga = *(const f32x4*)(mb + 2048 + col);
#pragma unroll
            for (int e = 0; e < 4; ++e) { xv[j][e] = xv[j][e] + ga[e] * (yv[j][e] * rstd * gv[e]); ss2 += xv[j][e] * xv[j][e]; }
            *(f32x4*)(p.out + (size_t)t * Dm + col) = xv[j];
        }
        ss2 = wave_sum(ss2, lane);
        const float rstd2 = rsqrtf(ss2 * (1.f / Dm) + 1e-6f);
#pragma unroll
        for (int j = 0; j < 4; ++j) {
            const int col = 4 * (lane + 64 * j);
            const f32x4 gv = *(const f32x4*)(fg + col), sv = *(const f32x4*)(mb + 4096 + col), hv = *(const f32x4*)(mb + 3072 + col);
            float o[4];
#pragma unroll
            for (int e = 0; e < 4; ++e) o[e] = (xv[j][e] * rstd2 * gv[e]) * (1.f + sv[e]) + hv[e];
            u32x2 w; w.x = pk2(o[0], o[1]); w.y = pk2(o[2], o[3]);
            *(u32x2*)(h2 + (size_t)t * Dm + col) = w;
        }
    }
}

__device__ __forceinline__ void phase_router(const Params& p, LAS char* L) {
    const int v = vcu(), G = grid_g();
    const bf16_t* h2 = (const bf16_t*)(p.ws + WS_H2);
    const float* rw = p.in[20];
    float* lg = (float*)(p.ws + WS_LOG);
    for (int u = v; u < 128; u += G) {
        const int m0 = u * 128;
        auto arow = [&](int r) { return (unsigned)(m0 + r) * Dm; };
        auto bcol = [&](int c) { return rw + c; };
        auto epi = [&](f32x16 (&acc)[2][2]) {
            const int tid_ = otid(), lane = tid_ & 63, wave = tid_ >> 6, wm = wave & 1, wn = wave >> 1, l31 = lane & 31, hi = lane >> 5;
#pragma unroll
            for (int mi = 0; mi < 2; ++mi) {
                const int m = m0 + 64 * wm + 32 * mi + l31;
#pragma unroll
                for (int ni = 0; ni < 2; ++ni) {
                    const int nbg = nb_of<0>(wn, ni);
#pragma unroll
                    for (int gq = 0; gq < 4; ++gq) {
                        f32x4 w = {acc[mi][ni][4 * gq], acc[mi][ni][4 * gq + 1], acc[mi][ni][4 * gq + 2], acc[mi][ni][4 * gq + 3]};
                        *(f32x4*)(lg + (size_t)m * NE + nbg + 8 * gq + 4 * hi) = w;
                    }
                }
            }
        };
        gemm_tile<2, 0>(L, Dm / 64, NE, h2, arow, bcol, epi);
    }
}

__device__ __forceinline__ void phase_route(const Params& p) {
    const int v = vcu(), G = grid_g();
    const int tid = otid(), lane = tid & 63, wave = tid >> 6;
    const float* lg = (const float*)(p.ws + WS_LOG);
    const float* rb = p.in[21];
    int* cnt = (int*)(p.ws + WS_CTL);
    int* la = (int*)(p.ws + WS_LA); float* lw = (float*)(p.ws + WS_LW);
    const f32x4 bias = *(const f32x4*)(rb + 4 * lane);
    const int grp = lane >> 3;
    for (int t = v * NW + wave; t < T; t += G * NW) {
        const f32x4 lgv = *(const f32x4*)(lg + (size_t)t * NE + 4 * lane);
        float s0 = 1.f / (1.f + __expf(-lgv[0])), s1 = 1.f / (1.f + __expf(-lgv[1])), s2 = 1.f / (1.f + __expf(-lgv[2])), s3 = 1.f / (1.f + __expf(-lgv[3]));
        float v0 = s0 + bias[0], v1 = s1 + bias[1], v2 = s2 + bias[2], v3 = s3 + bias[3];
        float t1 = fmaxf(v0, v1), t2 = fminf(v0, v1);
        { const float a = fmaxf(v2, v3), bq = fminf(v2, v3); const float n1 = fmaxf(t1, a), n2 = fmaxf(fminf(t1, a), fmaxf(t2, bq)); t1 = n1; t2 = n2; }
#pragma unroll
        for (int off = 1; off <= 4; off <<= 1) {
            const float o1 = shx(t1, off, lane), o2 = shx(t2, off, lane);
            const float n1 = fmaxf(t1, o1), n2 = fmaxf(fminf(t1, o1), fmaxf(t2, o2)); t1 = n1; t2 = n2;
        }
        const float gs = t1 + t2;
        int rank = 0;
#pragma unroll
        for (int gg = 0; gg < 8; ++gg) { const float og = shl(gs, gg * 8); rank += (og > gs || (og == gs && gg < grp)) ? 1 : 0; }
        if (rank >= 4) { v0 = -INFINITY; v1 = -INFINITY; v2 = -INFINITY; v3 = -INFINITY; }
        float wsum = 0.f, myw = 0.f; int mye = 0;
#pragma unroll
        for (int it = 0; it < TOPK; ++it) {
            float bv = v0; int bi = 0;
            if (v1 > bv) { bv = v1; bi = 1; }
            if (v2 > bv) { bv = v2; bi = 2; }
            if (v3 > bv) { bv = v3; bi = 3; }
            int idx = 4 * lane + bi;
#pragma unroll
            for (int off = 32; off >= 1; off >>= 1) {
                const float ov = shx(bv, off, lane); const int oi = shxi(idx, off, lane);
                if (ov > bv || (ov == bv && oi < idx)) { bv = ov; idx = oi; }
            }
            const int jj = idx & 3, owner = idx >> 2;
            const float mys = jj == 0 ? s0 : (jj == 1 ? s1 : (jj == 2 ? s2 : s3));
            const float scv = shl(mys, owner);
            if (lane == owner) { if (jj == 0) v0 = -INFINITY; else if (jj == 1) v1 = -INFINITY; else if (jj == 2) v2 = -INFINITY; else v3 = -INFINITY; }
            wsum += scv;
            if (lane == it) { myw = scv; mye = idx; }
        }
        if (lane < TOPK) {
            const float w = myw / wsum * 2.5f;
            const int pos = atomicAdd(cnt + mye, 1);
            if (pos < LISTCAP) { la[(size_t)mye * LISTCAP + pos] = t * TOPK + lane; lw[(size_t)mye * LISTCAP + pos] = w; }
        }
    }
}

__device__ __forceinline__ int moe_cnt(const int* cnt, int e) { int c = (e < 256) ? cnt[e] : T; return c > LISTCAP ? LISTCAP : c; }
__device__ __forceinline__ void moe_prefix(const Params& p, LAS char* L) {
    const int tid = otid();
    const int* cnt = (const int*)(p.ws + WS_CTL);
    LAS int* pre = (LAS int*)(L + OFF_PRE);
    LAS int* tl = (LAS int*)(L + OFF_TL);
    __syncthreads();
    for (int i = tid; i < 257; i += NT) { const int c = moe_cnt(cnt, i); tl[i] = (c + 255) >> 8; }
    __syncthreads();
    if (tid == 0) { int s = 0; for (int i = 0; i < 257; ++i) { pre[i] = s; s += tl[i]; } pre[257] = s; }
    __syncthreads();
}
__device__ __forceinline__ int moe_find(LAS int* pre, int g) {
    int lo = 0, hi = 256;
    while (lo < hi) { const int mid = (lo + hi + 1) >> 1; if (pre[mid] <= g) lo = mid; else hi = mid - 1; }
    return lo;
}

template <int MI>
__device__ __forceinline__ void moe1_unit(const Params& p, LAS char* L, int e, int r0, int rows, int j0) {
    const bf16_t* h2 = (const bf16_t*)(p.ws + WS_H2);
    const int* la = (const int*)(p.ws + WS_LA);
    bf16_t* hb = (bf16_t*)(p.ws + WS_HB);
    const float* wg = (e < 256) ? p.in[22] + (size_t)e * Dm * 256 : p.in[25];
    const float* wu = (e < 256) ? p.in[23] + (size_t)e * Dm * 256 : p.in[26];
    LAS int* rowid = (LAS int*)(L + OFF_ROW);
    {
        const int tid = otid();
        if (tid < 64 * MI) { const int rr = tid < rows ? tid : 0; rowid[tid] = (e < 256) ? la[(size_t)e * LISTCAP + r0 + rr] : (AR + r0 + rr); }
        __syncthreads();
    }
    auto arow = [&](int r) { const int a = rowid[r]; const int tok = (e < 256) ? (a >> 3) : (a - AR); return (unsigned)tok * Dm; };
    auto bcol = [&](int c4) { return (c4 < 128) ? (wg + j0 + c4) : (wu + j0 + c4 - 128); };
    auto epi = [&](f32x16 (&acc)[MI][2]) {
#pragma unroll
        for (int mi = 0; mi < MI; ++mi)
#pragma unroll
            for (int r = 0; r < 16; ++r) acc[mi][0][r] = silu_f(acc[mi][0][r]) * acc[mi][1][r];
        store_tile_bf16<MI, 128>(L, acc, [&](int row, int c) -> bf16_t* { return row < rows ? hb + (size_t)rowid[row] * 256 + j0 + 8 * c : nullptr; });
    };
    gemm_tile<MI, 1>(L, Dm / 64, 256, h2, arow, bcol, epi);
}
__device__ __forceinline__ void phase_moe1(const Params& p, LAS char* L) {
    const int v = vcu(), G = grid_g();
    const int* cnt = (const int*)(p.ws + WS_CTL);
    moe_prefix(p, L);
    LAS int* pre = (LAS int*)(L + OFF_PRE);
    const int total = __builtin_amdgcn_readfirstlane(pre[257]) * 2;
    for (int u = v; u < total; u += G) {
        const int g = u >> 1, j0 = (u & 1) * 128;
        const int e = __builtin_amdgcn_readfirstlane(moe_find(pre, g)), mt = g - __builtin_amdgcn_readfirstlane(pre[e]);
        const int rows = __builtin_amdgcn_readfirstlane(moe_cnt(cnt, e)) - mt * 256;
        if (rows > 128) moe1_unit<4>(p, L, e, mt * 256, rows < 256 ? rows : 256, j0);
        else moe1_unit<2>(p, L, e, mt * 256, rows, j0);
    }
}

template <int MI>
__device__ __forceinline__ void moe2_unit(const Params& p, LAS char* L, int e, int r0, int rows, int n0) {
    const int* la = (const int*)(p.ws + WS_LA); const float* lw = (const float*)(p.ws + WS_LW);
    const bf16_t* hb = (const bf16_t*)(p.ws + WS_HB);
    bf16_t* yb = (bf16_t*)(p.ws + WS_YB);
    const float* wd = (e < 256) ? p.in[24] + (size_t)e * 256 * Dm : p.in[27];
    LAS int* rowid = (LAS int*)(L + OFF_ROW);
    LAS float* roww = (LAS float*)(L + OFF_RW);
    {
        const int tid = otid();
        if (tid < 64 * MI) {
            const int rr = tid < rows ? tid : 0;
            rowid[tid] = (e < 256) ? la[(size_t)e * LISTCAP + r0 + rr] : (AR + r0 + rr);
            roww[tid] = (e < 256) ? lw[(size_t)e * LISTCAP + r0 + rr] : 1.f;
        }
        __syncthreads();
    }
    auto arow = [&](int r) { return (unsigned)rowid[r] * 256; };
    auto bcol = [&](int c4) { return wd + n0 + c4; };
    auto epi = [&](f32x16 (&acc)[MI][2]) {
        const int tid_ = otid(), lane = tid_ & 63, wave = tid_ >> 6, wm = wave & 1, l31 = lane & 31;
#pragma unroll
        for (int mi = 0; mi < MI; ++mi) {
            const float w = roww[32 * MI * wm + 32 * mi + l31];
#pragma unroll
            for (int ni = 0; ni < 2; ++ni)
#pragma unroll
                for (int q = 0; q < 16; ++q) acc[mi][ni][q] *= w;
        }
        store_tile_bf16<MI, 256>(L, acc, [&](int row, int c) -> bf16_t* { return row < rows ? yb + (size_t)rowid[row] * Dm + n0 + 8 * c : nullptr; });
    };
    gemm_tile<MI, 0>(L, 256 / 64, Dm, hb, arow, bcol, epi);
}
__device__ __forceinline__ void phase_moe2(const Params& p, LAS char* L) {
    const int v = vcu(), G = grid_g();
    const int* cnt = (const int*)(p.ws + WS_CTL);
    moe_prefix(p, L);
    LAS int* pre = (LAS int*)(L + OFF_PRE);
    const int total = __builtin_amdgcn_readfirstlane(pre[257]) * 4;
    for (int u = v; u < total; u += G) {
        const int g = u >> 2, n0 = (u & 3) * 256;
        const int e = __builtin_amdgcn_readfirstlane(moe_find(pre, g)), mt = g - __builtin_amdgcn_readfirstlane(pre[e]);
        const int rows = __builtin_amdgcn_readfirstlane(moe_cnt(cnt, e)) - mt * 256;
        if (rows > 128) moe2_unit<4>(p, L, e, mt * 256, rows < 256 ? rows : 256, n0);
        else moe2_unit<2>(p, L, e, mt * 256, rows, n0);
    }
}

__device__ __forceinline__ void phase_final(const Params& p) {
    const int v = vcu(), G = grid_g();
    const int tid = otid(), lane = tid & 63, wave = tid >> 6;
    const float* pg = p.in[19];
    const float* mod = (const float*)(p.ws + WS_MOD);
    const bf16_t* yb = (const bf16_t*)(p.ws + WS_YB);
    for (int t = v * NW + wave; t < T; t += G * NW) {
        const int b = t / SEQ;
        const float* gf = mod + b * 6144 + 5120;
        float y[2][8];
#pragma unroll
        for (int j = 0; j < 2; ++j)
#pragma unroll
            for (int e = 0; e < 8; ++e) y[j][e] = 0.f;
#pragma unroll
        for (int k = 0; k < 9; ++k) {
            const size_t row = (k < 8) ? ((size_t)t * TOPK + k) : ((size_t)AR + t);
#pragma unroll
            for (int j = 0; j < 2; ++j) {
                const u32x4 raw = *(const u32x4*)(yb + row * Dm + 8 * (lane + 64 * j));
#pragma unroll
                for (int e = 0; e < 4; ++e) { y[j][2 * e] += bflo(raw[e]); y[j][2 * e + 1] += bfhi(raw[e]); }
            }
        }
        float ss = 0.f;
#pragma unroll
        for (int j = 0; j < 2; ++j)
#pragma unroll
            for (int e = 0; e < 8; ++e) ss += y[j][e] * y[j][e];
        ss = wave_sum(ss, lane);
        const float rstd = rsqrtf(ss * (1.f / Dm) + 1e-6f);
#pragma unroll
        for (int j = 0; j < 2; ++j) {
            const int col = 8 * (lane + 64 * j);
#pragma unroll
            for (int hq = 0; hq < 2; ++hq) {
                f32x4 xo = *(const f32x4*)(p.out + (size_t)t * Dm + col + 4 * hq);
                const f32x4 gv = *(const f32x4*)(pg + col + 4 * hq), gg = *(const f32x4*)(gf + col + 4 * hq);
#pragma unroll
                for (int e = 0; e < 4; ++e) xo[e] += gg[e] * (y[j][4 * hq + e] * rstd * gv[e]);
                *(f32x4*)(p.out + (size_t)t * Dm + col + 4 * hq) = xo;
            }
        }
    }
}

#define XB_TMO      128
#define XB_XCNT(j)  (256  + 64 * (j))
#define XB_XSUB(j)  (1280 + 64 * (j))
#define XB_XGEN(j)  (2304 + 64 * (j))
#define XB_TOP      3328
#define XB_TOPGEN   3392
#define XCD_BAR_WORDS 3456
#define XB_SPIN_CAP (1u << 18)
__device__ __forceinline__ unsigned xb_ld(unsigned* p)              { return __hip_atomic_load(p, __ATOMIC_RELAXED, __HIP_MEMORY_SCOPE_AGENT); }
__device__ __forceinline__ unsigned xb_add(unsigned* p, unsigned v) { return __hip_atomic_fetch_add(p, v, __ATOMIC_RELAXED, __HIP_MEMORY_SCOPE_AGENT); }
__device__ __forceinline__ unsigned xb_xcc_id() { return (unsigned)__builtin_amdgcn_s_getreg((3 << 11) | 20) & 0xFu; }
#define XB_SPIN(cond, bar) do { unsigned _sp = 0; while (cond) { __builtin_amdgcn_s_sleep(1); \
    if ((++_sp & 255u) == 0u) { if (xb_ld(&(bar)[XB_TMO])) break; if (_sp > XB_SPIN_CAP) { atomicAdd(&(bar)[XB_TMO], 1u); break; } } } } while (0)
struct XcdBarrier { unsigned* bar; unsigned x; volatile LAS unsigned* st; };
__device__ __forceinline__ XcdBarrier xcd_barrier_post(unsigned* bar, volatile LAS unsigned* st) {
    XcdBarrier b; b.bar = bar; b.x = xb_xcc_id(); b.st = st;
    if (threadIdx.x == 0) (void)xb_add(&bar[XB_XCNT(b.x)], 1u);
    return b;
}
__device__ __forceinline__ void xcd_barrier_complete(unsigned* bar, unsigned x, unsigned& nloc, unsigned& nx) {
    const unsigned G = gridDim.x * gridDim.y * gridDim.z;
    unsigned sum, cnt, mine, sp = 0u;
    for (;;) {
        sum = 0u; cnt = 0u; mine = 0u;
#pragma unroll
        for (unsigned j = 0; j < 16; ++j) { const unsigned c = xb_ld(&bar[XB_XCNT(j)]); sum += c; cnt += (c > 0u) ? 1u : 0u; mine = (j == x) ? c : mine; }
        if (sum == G) break;
        __builtin_amdgcn_s_sleep(1);
        if ((++sp & 255u) == 0u) { if (xb_ld(&bar[XB_TMO])) break; if (sp > XB_SPIN_CAP) { atomicAdd(&bar[XB_TMO], 1u); break; } }
    }
    nloc = mine > 0u ? mine : 1u; nx = cnt > 0u ? cnt : 1u;
}
__device__ __forceinline__ void xcd_barrier(const Params& p, LAS char* L) {
    XcdBarrier b; b.bar = (unsigned*)(p.ws + WS_CTL + 4096); b.x = xb_xcc_id(); b.st = (volatile LAS unsigned*)(L + OFF_MISC);
    asm volatile("s_waitcnt vmcnt(0)" ::: "memory");
    __syncthreads();
    if (threadIdx.x == 0) {
        unsigned* bar = b.bar;
        __builtin_amdgcn_s_waitcnt(0);
        unsigned nloc = b.st[0], nx = b.st[1];
        if (nloc == 0u) { xcd_barrier_complete(bar, b.x, nloc, nx); b.st[0] = nloc; b.st[1] = nx; }
        const unsigned old = xb_add(&bar[XB_XSUB(b.x)], 1u);
        const unsigned gen = old / nloc;
        if (old + 1u == (gen + 1u) * nloc) {
            __builtin_amdgcn_fence(__ATOMIC_RELEASE, "agent");
            asm volatile("s_waitcnt vmcnt(0)" ::: "memory");
            const unsigned og = xb_add(&bar[XB_TOP], 1u);
            const unsigned tg = og / nx;
            if (og + 1u == (tg + 1u) * nx) xb_add(&bar[XB_TOPGEN], 1u);
            else XB_SPIN(xb_ld(&bar[XB_TOPGEN]) == tg, bar);
            __builtin_amdgcn_fence(__ATOMIC_ACQUIRE, "agent");
            xb_add(&bar[XB_XGEN(b.x)], 1u);
            asm volatile("s_waitcnt vmcnt(0)" ::: "memory");
        } else {
            XB_SPIN(xb_ld(&bar[XB_XGEN(b.x)]) == gen, bar);
            __builtin_amdgcn_fence(__ATOMIC_ACQUIRE, "agent");
            asm volatile("s_waitcnt vmcnt(0)" ::: "memory");
        }
    }
    __syncthreads();
}

__global__ void __launch_bounds__(NT, 2) mega(Params p) {
    extern __shared__ __attribute__((aligned(16))) char smem[];
    LAS char* L = (LAS char*)smem;
    if (threadIdx.x < 8) ((LAS unsigned*)(L + OFF_MISC))[threadIdx.x] = 0u;
    __syncthreads();
    (void)xcd_barrier_post((unsigned*)(p.ws + WS_CTL + 4096), (volatile LAS unsigned*)(L + OFF_MISC));
    phase_mod(p, L);
    xcd_barrier(p, L);
    phase_h1(p);
    xcd_barrier(p, L);
    _Pragma("nounroll") for (int rep_ = 0; rep_ < REP_PROJ; ++rep_) phase_proj(p, L);
    xcd_barrier(p, L);
    phase_norms(p);
    xcd_barrier(p, L);
    _Pragma("nounroll") for (int rep_ = 0; rep_ < REP_SMALL; ++rep_) phase_qkv(p, L);
    xcd_barrier(p, L);
    phase_attn(p, L);
    xcd_barrier(p, L);
    _Pragma("nounroll") for (int rep_ = 0; rep_ < REP_SMALL; ++rep_) phase_oproj(p, L);
    xcd_barrier(p, L);
    phase_post_attn(p);
    xcd_barrier(p, L);
    _Pragma("nounroll") for (int rep_ = 0; rep_ < REP_SMALL; ++rep_) phase_router(p, L);
    xcd_barrier(p, L);
    phase_route(p);
    xcd_barrier(p, L);
    _Pragma("nounroll") for (int rep_ = 0; rep_ < REP_MOE1; ++rep_) phase_moe1(p, L);
    xcd_barrier(p, L);
    _Pragma("nounroll") for (int rep_ = 0; rep_ < REP_MOE2; ++rep_) phase_moe2(p, L);
    xcd_barrier(p, L);
    phase_final(p);
}

extern "C" void kernel_launch(void* const* d_in, const int* in_sizes, int n_in, void* d_out, int out_size, void* d_ws, size_t ws_size, hipStream_t stream) {
    static int grid_blocks = 0;
    if (grid_blocks == 0) {
        if (n_in != 28 || out_size != T * Dm || ws_size < WS_END) {
            fprintf(stderr, "kernel_launch: unexpected problem (n_in %d, out %d, ws %zu); nothing launched\n", n_in, out_size, ws_size);
            grid_blocks = -1; return;
        }
        int dev = 0, cus = 0, per_cu = 0;
        (void)hipGetDevice(&dev);
        (void)hipDeviceGetAttribute(&cus, hipDeviceAttributeMultiprocessorCount, dev);
        if (hipFuncSetAttribute((const void*)mega, hipFuncAttributeMaxDynamicSharedMemorySize, LDS_BYTES) != hipSuccess) {
            fprintf(stderr, "kernel_launch: hipFuncSetAttribute(%d B LDS) failed\n", LDS_BYTES); grid_blocks = -1; return;
        }
        (void)hipOccupancyMaxActiveBlocksPerMultiprocessor(&per_cu, mega, NT, LDS_BYTES);
        if (per_cu < 1) { fprintf(stderr, "kernel_launch: occupancy query says %d blocks per CU\n", per_cu); per_cu = 1; }
        grid_blocks = cus;
        fprintf(stderr, "kernel_launch: %d CUs, occupancy query %d per CU, grid %d\n", cus, per_cu, grid_blocks);
    }
    if (grid_blocks < 0) return;
    (void)hipMemsetAsync((char*)d_ws + WS_CTL, 0, CTL_BYTES, stream);
    Params p{};
    for (int i = 0; i < 28; ++i) p.in[i] = (const float*)d_in[i];
    p.out = (float*)d_out; p.ws = (char*)d_ws;
    void* args[] = {&p};
    hipError_t e = hipLaunchCooperativeKernel((void*)mega, dim3(grid_blocks), dim3(NT), args, LDS_BYTES, stream);
    if (e != hipSuccess) fprintf(stderr, "cooperative launch failed: %s (grid %d)\n", hipGetErrorString(e), grid_blocks);
}
```

```cpp
#include <hip/hip_runtime.h>
#include <cstdio>
#include <cstdint>

#ifndef REP_PROJ
#define REP_PROJ 1
#endif
#ifndef REP_ATTN
#define REP_ATTN 1
#endif
#ifndef REP_MOE1
#define REP_MOE1 1
#endif
#ifndef REP_MOE2
#define REP_MOE2 1
#endif
#ifndef REP_SMALL
#define REP_SMALL 1
#endif

typedef unsigned short bf16_t;
typedef float f32x2 __attribute__((ext_vector_type(2)));
typedef short bf16x8 __attribute__((ext_vector_type(8)));
typedef short s16x4 __attribute__((ext_vector_type(4)));
typedef short v4i16_t __attribute__((ext_vector_type(4)));
typedef float f32x16 __attribute__((ext_vector_type(16)));
typedef float f32x4 __attribute__((ext_vector_type(4)));
typedef unsigned u32x4 __attribute__((ext_vector_type(4)));
typedef unsigned u32x2 __attribute__((ext_vector_type(2)));
#define LAS __attribute__((address_space(3)))

constexpr int NT = 512, NW = 8;
constexpr int Dm = 1024, NB = 8, SEQ = 2048, T = NB * SEQ;
constexpr int NIN = 1952;
constexpr int C_CQ = 0, C_CKV = 256, C_KR = 384, C_DQ = 416, C_DK = 928, C_DV = 1440;
constexpr int NE = 256, TOPK = 8, AR = T * TOPK, HROWS = AR + T;
constexpr int LISTCAP = T;
constexpr float LOG2E = 1.4426950408889634f;
constexpr float YSCALE = 32.f;
constexpr float LAMBDA_INIT = 0.2f;

constexpr size_t MiB = 1u << 20;
constexpr size_t WS_CTL = 0, CTL_BYTES = 65536;
constexpr size_t WS_MOD = 65536;
constexpr size_t WS_ROPE = 1 * MiB;
constexpr size_t WS_H1 = 4 * MiB;
constexpr size_t WS_PROJ = 36 * MiB;
constexpr size_t WS_CQN = 100 * MiB;
constexpr size_t WS_CKVN = 108 * MiB;
constexpr size_t WS_QM = 112 * MiB;
constexpr size_t WS_KF = 136 * MiB;
constexpr size_t WS_VM = 160 * MiB;
constexpr size_t WS_ATT = 176 * MiB;
constexpr size_t WS_OD0 = 208 * MiB;
constexpr size_t WS_Y1 = 240 * MiB;
constexpr size_t WS_H2 = 304 * MiB;
constexpr size_t WS_LOG = 336 * MiB;
constexpr size_t WS_LA = 352 * MiB;
constexpr size_t WS_LW = 368 * MiB;
constexpr size_t WS_HB = 384 * MiB;
constexpr size_t WS_YB = 456 * MiB;
constexpr size_t WS_WB = 744 * MiB;
constexpr size_t WB_IN = 0, WB_UQ = WB_IN + (size_t)1024 * 1952, WB_UKV = WB_UQ + 256 * 768, WB_O = WB_UKV + 128 * 1024, WB_R = WB_O + 1024 * 1024, WB_END = WB_R + 1024 * 256;
constexpr size_t WS_END = 760 * MiB;

constexpr int G_XB = 32768, G_WB = 36864, G_BUF = G_XB + G_WB, G_LDS = 2 * G_BUF;
constexpr int OFF_MISC = G_LDS, OFF_PRE = OFF_MISC + 64, OFF_TL = OFF_PRE + 1088;
constexpr int OFF_ROW = OFF_TL + 1088, OFF_RW = OFF_ROW + 1024;
constexpr int OFF_SS = OFF_RW + 1024;
constexpr int LDS_BYTES = G_LDS + 4352 + 4096;

struct Params {
    const float* in[28];
    float* out;
    char* ws;
};

__device__ __forceinline__ unsigned short f2bf(float f) { __bf16 b = (__bf16)f; return __builtin_bit_cast(unsigned short, b); }
typedef __bf16 bf16x2_t __attribute__((ext_vector_type(2)));
__device__ __forceinline__ unsigned pk2(float lo, float hi) { const f32x2 v = {lo, hi}; return __builtin_bit_cast(unsigned, __builtin_convertvector(v, bf16x2_t)); }
__device__ __forceinline__ float bf2f(unsigned short b) { return __uint_as_float(((unsigned)b) << 16); }
__device__ __forceinline__ float bflo(unsigned u) { return __uint_as_float(u << 16); }
__device__ __forceinline__ float bfhi(unsigned u) { return __uint_as_float(u & 0xffff0000u); }
__device__ __forceinline__ int crow(int r, int hi) { return (r & 3) + 8 * (r >> 2) + 4 * hi; }
__device__ __forceinline__ float shx(float v, int m, int lane) { return __int_as_float(__builtin_amdgcn_ds_bpermute((lane ^ m) << 2, __float_as_int(v))); }
__device__ __forceinline__ int shxi(int v, int m, int lane) { return __builtin_amdgcn_ds_bpermute((lane ^ m) << 2, v); }
__device__ __forceinline__ float shl(float v, int src) { return __int_as_float(__builtin_amdgcn_ds_bpermute(src << 2, __float_as_int(v))); }
__device__ __forceinline__ float wave_sum(float v, int lane) {
#pragma unroll
    for (int o = 32; o >= 1; o >>= 1) v += shx(v, o, lane);
    return v;
}
__device__ __forceinline__ float silu_f(float v) { return v / (1.f + __expf(-v)); }
__device__ __forceinline__ s16x4 tr_read(LAS char* p) {
    return __builtin_bit_cast(s16x4, __builtin_amdgcn_ds_read_tr16_b64_v4i16((LAS v4i16_t*)p));
}
__device__ __forceinline__ int otid() { int t = threadIdx.x; asm volatile("" : "+v"(t)); return t; }
__device__ __forceinline__ int grid_g() { return gridDim.x; }
__device__ __forceinline__ int vcu() { const int G = gridDim.x, bx = blockIdx.x; return (G % 8 == 0) ? (bx % 8) * (G / 8) + bx / 8 : bx; }
__device__ __forceinline__ void gld16(u32x4& d, const void* p) { asm volatile("global_load_dwordx4 %0, %1, off" : "+v"(d) : "v"(p) : "memory"); }
__device__ __forceinline__ void gld16(f32x4& d, const void* p) { asm volatile("global_load_dwordx4 %0, %1, off" : "+v"(d) : "v"(p) : "memory"); }
template <int N> __device__ __forceinline__ void vm_wait(u32x4& a, f32x4& b, f32x4& c) { asm volatile("s_waitcnt vmcnt(%3)" : "+v"(a), "+v"(b), "+v"(c) : "n"(N) : "memory"); }
template <int N> __device__ __forceinline__ void vm_wait(f32x4& b, f32x4& c) { asm volatile("s_waitcnt vmcnt(%2)" : "+v"(b), "+v"(c) : "n"(N) : "memory"); }
template <int N> __device__ __forceinline__ void vm_wait(u32x4& a, u32x4& b) { asm volatile("s_waitcnt vmcnt(%2)" : "+v"(a), "+v"(b) : "n"(N) : "memory"); }
template <int N> __device__ __forceinline__ void vm_wait(u32x4& b) { asm volatile("s_waitcnt vmcnt(%1)" : "+v"(b) : "n"(N) : "memory"); }
#define MFMA32(a, b, c) __builtin_amdgcn_mfma_f32_32x32x16_bf16(a, b, c, 0, 0, 0)

template <int NBMODE> __device__ __forceinline__ int nb_of(int wn, int ni) { return NBMODE == 0 ? 64 * wn + 32 * ni : 32 * wn + 128 * ni; }

template <int MI, int NBMODE, bool WBF = false, class AF, class BF, class EF>
__device__ __forceinline__ void gemm_tile(LAS char* L, int nk, long ldw, const bf16_t* abase, AF arow, BF bcol, EF epi) {
    asm volatile("" : "+s"(nk));
    const int tid = otid(), lane = tid & 63, wave = tid >> 6;
    const int wm = wave & 1, wn = wave >> 1, l31 = lane & 31, hi = lane >> 5;
    const int a_chunk = tid & 7, a_row = tid >> 3;
    const int a_w = a_row * 128 + 16 * (a_chunk ^ ((a_row >> 1) & 7));
    const int b_n4 = WBF ? (tid & 31) : (tid & 63), b_kr = WBF ? (tid >> 5) : (tid >> 6);
    const auto bp = bcol((WBF ? 8 : 4) * b_n4) + (long)b_kr * ldw;
    const int b_w = G_XB + b_kr * 576 + (WBF ? 16 : 8) * b_n4;
    const int sw = (l31 >> 1) & 7;
    const int xoff = (32 * MI * wm + l31) * 128;
    const int woff = G_XB + (8 * hi + ((lane & 15) >> 2)) * 576 + 2 * (16 * ((lane >> 4) & 1) + 4 * (lane & 3));
    u32x4 ra[MI]; f32x4 rb[8]; u32x4 rw[4];
#pragma unroll
    for (int i = 0; i < MI; ++i) ra[i] = (u32x4){0u, 0u, 0u, 0u};
#pragma unroll
    for (int i = 0; i < 8; ++i) rb[i] = (f32x4){0.f, 0.f, 0.f, 0.f};
#pragma unroll
    for (int i = 0; i < 4; ++i) rw[i] = (u32x4){0u, 0u, 0u, 0u};
#define G_LOADW(KOFF, Q) do { \
        if (WBF) { gld16(rw[Q], bp + (long)((KOFF) + 16 * (Q)) * ldw); } \
        else { gld16(rb[2 * (Q)], bp + (long)((KOFF) + 16 * (Q)) * ldw); gld16(rb[2 * (Q) + 1], bp + (long)((KOFF) + 16 * (Q) + 8) * ldw); } } while (0)
#define G_LOADQ(KT, Q) do { \
        if ((Q) < MI) gld16(ra[(Q) < MI ? (Q) : 0], abase + arow(a_row + 64 * (Q)) + a_chunk * 8 + (KT) * 64); \
        G_LOADW((KT) * 64, Q); } while (0)
#define G_LOADQ_SEL(KT, Q, OK) do { \
        const int kq_ = (OK) ? (KT) * 64 : 0; \
        if ((Q) < MI) gld16(ra[(Q) < MI ? (Q) : 0], abase + arow(a_row + 64 * (Q)) + a_chunk * 8 + kq_); \
        G_LOADW(kq_, Q); } while (0)
#define G_WAITQ(Q, N) do { \
        if (WBF) { if ((Q) < MI) vm_wait<N>(ra[(Q) < MI ? (Q) : 0], rw[Q]); else vm_wait<N>(rw[Q]); } \
        else { if ((Q) < MI) vm_wait<N>(ra[(Q) < MI ? (Q) : 0], rb[2 * (Q)], rb[2 * (Q) + 1]); else vm_wait<N>(rb[2 * (Q)], rb[2 * (Q) + 1]); } } while (0)
#define G_STOREQ(LP, Q) do { \
        if ((Q) < MI) *(LAS u32x4*)((LP) + a_w + (Q) * 8192) = ra[(Q) < MI ? (Q) : 0]; \
        if (WBF) { *(LAS u32x4*)((LP) + b_w + (Q) * 16 * 576) = rw[Q]; } else { \
        { u32x2 w; w.x = pk2(rb[2 * (Q)][0], rb[2 * (Q)][1]); w.y = pk2(rb[2 * (Q)][2], rb[2 * (Q)][3]); *(LAS u32x2*)((LP) + b_w + (Q) * 16 * 576) = w; } \
        { u32x2 w; w.x = pk2(rb[2 * (Q) + 1][0], rb[2 * (Q) + 1][1]); w.y = pk2(rb[2 * (Q) + 1][2], rb[2 * (Q) + 1][3]); *(LAS u32x2*)((LP) + b_w + (Q) * 16 * 576 + 8 * 576) = w; } } } while (0)
    constexpr int NLW = WBF ? 1 : 2;
    constexpr int NL0 = NLW + ((0 < MI) ? 1 : 0), NL1 = NLW + ((1 < MI) ? 1 : 0), NL2 = NLW + ((2 < MI) ? 1 : 0), NL3 = NLW + ((3 < MI) ? 1 : 0), NLT = NL0 + NL1 + NL2 + NL3;
    G_LOADQ(0, 0); G_LOADQ(0, 1); G_LOADQ(0, 2); G_LOADQ(0, 3);
    G_WAITQ(0, 0); G_WAITQ(1, 0); G_WAITQ(2, 0); G_WAITQ(3, 0);
    G_STOREQ(L, 0); G_STOREQ(L, 1); G_STOREQ(L, 2); G_STOREQ(L, 3);
    G_LOADQ(1, 0); G_LOADQ(1, 1); G_LOADQ(1, 2); G_LOADQ(1, 3);
    f32x16 acc[MI][2];
#pragma unroll
    for (int i = 0; i < MI; ++i)
#pragma unroll
        for (int j = 0; j < 2; ++j)
#pragma unroll
            for (int r = 0; r < 16; ++r) acc[i][j][r] = 0.f;
    __syncthreads();
#pragma nounroll
    for (int kt = 0; kt < nk; ++kt) {
        LAS char* Lb = L + (kt & 1) * G_BUF;
        LAS char* Ln = L + ((kt + 1) & 1) * G_BUF;
        const bool ld = kt + 2 < nk;
        bf16x8 xf[2][MI], wf[2][2];
#define LOAD_FRAGS(KS, B) do { \
            _Pragma("unroll") for (int mi = 0; mi < MI; ++mi) xf[B][mi] = *(LAS bf16x8*)(Lb + xoff + mi * 4096 + 16 * ((2 * (KS) + hi) ^ sw)); \
            _Pragma("unroll") for (int ni = 0; ni < 2; ++ni) { \
                LAS char* pp = Lb + woff + (KS) * 16 * 576 + 2 * nb_of<NBMODE>(wn, ni); \
                const s16x4 lo = tr_read(pp), h4 = tr_read(pp + 4 * 576); \
                wf[B][ni] = (bf16x8){lo[0], lo[1], lo[2], lo[3], h4[0], h4[1], h4[2], h4[3]}; } } while (0)
#define MMA_STEP(KS) do { \
            _Pragma("unroll") for (int mi = 0; mi < MI; ++mi) \
                _Pragma("unroll") for (int ni = 0; ni < 2; ++ni) acc[mi][ni] = MFMA32(wf[(KS) & 1][ni], xf[(KS) & 1][mi], acc[mi][ni]); } while (0)
#define STAGE_STEP(Q, NREST, NPREV) do { G_WAITQ(Q, (NREST) + (NPREV)); G_STOREQ(Ln, Q); G_LOADQ_SEL(kt + 2, Q, ld); } while (0)
        LOAD_FRAGS(0, 0);
        LOAD_FRAGS(1, 1); MMA_STEP(0); STAGE_STEP(0, NL1 + NL2 + NL3, 0);           __builtin_amdgcn_sched_barrier(0);
        LOAD_FRAGS(2, 0); MMA_STEP(1); STAGE_STEP(1, NL2 + NL3, NL0);               __builtin_amdgcn_sched_barrier(0);
        LOAD_FRAGS(3, 1); MMA_STEP(2); STAGE_STEP(2, NL3, NL0 + NL1);               __builtin_amdgcn_sched_barrier(0);
        MMA_STEP(3);                   STAGE_STEP(3, 0, NL0 + NL1 + NL2);           __builtin_amdgcn_sched_barrier(0);
#undef LOAD_FRAGS
#undef MMA_STEP
#undef STAGE_STEP
        __syncthreads();
    }
    G_WAITQ(0, 0); G_WAITQ(1, 0); G_WAITQ(2, 0); G_WAITQ(3, 0);
#undef G_LOADQ
#undef G_LOADQ_SEL
#undef G_LOADW
#undef G_WAITQ
#undef G_STOREQ
    (void)NLT;
    epi(acc);
}

template <int MI, int NC, class DF>
__device__ __forceinline__ void store_tile_bf16(LAS char* L, const f32x16 (&acc)[MI][2], DF dst) {
    constexpr int STR = NC * 2 + 16, CPR = NC / 8, BM = 64 * MI;
    const int tid = otid(), lane = tid & 63, wave = tid >> 6, wm = wave & 1, wn = wave >> 1, l31 = lane & 31, hi = lane >> 5;
#pragma unroll
    for (int mi = 0; mi < MI; ++mi)
#pragma unroll
        for (int ni = 0; ni < (NC == 256 ? 2 : 1); ++ni) {
            const int row = 32 * MI * wm + 32 * mi + l31, col = (NC == 256) ? nb_of<0>(wn, ni) : 32 * wn;
#pragma unroll
            for (int gq = 0; gq < 4; ++gq) {
                u32x2 w; w.x = pk2(acc[mi][ni][4 * gq], acc[mi][ni][4 * gq + 1]); w.y = pk2(acc[mi][ni][4 * gq + 2], acc[mi][ni][4 * gq + 3]);
                *(LAS u32x2*)(L + row * STR + 2 * (col + 8 * gq + 4 * hi)) = w;
            }
        }
    __syncthreads();
#pragma unroll
    for (int i = 0; i < (BM * CPR) / NT; ++i) {
        const int id = tid + NT * i, row = id / CPR, c = id % CPR;
        bf16_t* d = dst(row, c);
        if (d) *(u32x4*)d = *(LAS u32x4*)(L + row * STR + 16 * c);
    }
    __syncthreads();
}

template <int MI, class DF>
__device__ __forceinline__ void store_tile_fp8(LAS char* L, const f32x16 (&acc)[MI][2], DF dst) {
    constexpr int STR = 256 + 16, BM = 64 * MI;
    const int tid = otid(), lane = tid & 63, wave = tid >> 6, wm = wave & 1, wn = wave >> 1, l31 = lane & 31, hi = lane >> 5;
#pragma unroll
    for (int mi = 0; mi < MI; ++mi)
#pragma unroll
        for (int ni = 0; ni < 2; ++ni) {
            const int row = 32 * MI * wm + 32 * mi + l31, col = nb_of<0>(wn, ni);
#pragma unroll
            for (int gq = 0; gq < 4; ++gq) {
                int w = 0;
                w = __builtin_amdgcn_cvt_pk_fp8_f32(acc[mi][ni][4 * gq], acc[mi][ni][4 * gq + 1], w, false);
                w = __builtin_amdgcn_cvt_pk_fp8_f32(acc[mi][ni][4 * gq + 2], acc[mi][ni][4 * gq + 3], w, true);
                *(LAS int*)(L + row * STR + (col + 8 * gq + 4 * hi)) = w;
            }
        }
    __syncthreads();
#pragma unroll
    for (int i = 0; i < (BM * 16) / NT; ++i) {
        const int id = tid + NT * i, row = id >> 4, c = id & 15;
        unsigned char* d = dst(row, c);
        if (d) *(u32x4*)d = *(LAS u32x4*)(L + row * STR + 16 * c);
    }
    __syncthreads();
}

__device__ __forceinline__ void phase_mod(const Params& p, LAS char* L) {
    const int v = vcu(), G = grid_g();
    const int tid = otid();
    const float* c = p.in[1]; const float* w_ada = p.in[3]; const float* b_ada = p.in[4];
    float* mod = (float*)(p.ws + WS_MOD);
    LAS float* sc = (LAS float*)L;
    LAS float* red = (LAS float*)(L + 32768);
    bool filled = false;
    for (int item = v; item < 384; item += G) {
        if (!filled) {
            for (int i = tid; i < 8 * 1024; i += NT) sc[i] = silu_f(c[i]);
            __syncthreads(); filled = true;
        }
        const int cx = tid & 15, kl = tid >> 4, col = item * 16 + cx;
        float a[8];
#pragma unroll
        for (int b = 0; b < 8; ++b) a[b] = 0.f;
#pragma unroll 4
        for (int k = kl; k < 1024; k += 32) {
            const float w = w_ada[(size_t)k * 6144 + col];
#pragma unroll
            for (int b = 0; b < 8; ++b) a[b] += sc[b * 1024 + k] * w;
        }
#pragma unroll
        for (int b = 0; b < 8; ++b) red[(b * 32 + kl) * 16 + cx] = a[b];
        __syncthreads();
        if (tid < 128) {
            const int b = tid >> 4, cc = tid & 15; float s = 0.f;
#pragma unroll
            for (int k = 0; k < 32; ++k) s += red[(b * 32 + k) * 16 + cc];
            mod[b * 6144 + item * 16 + cc] = s + b_ada[item * 16 + cc];
        }
        __syncthreads();
    }
    {
        bf16_t* wb = (bf16_t*)(p.ws + WS_WB);
        const size_t gt = (size_t)v * NT + tid, gs = (size_t)G * NT;
        auto conv = [&](const float* src, size_t off, size_t n) {
            for (size_t i = gt; i < n / 4; i += gs) { const f32x4 f = *(const f32x4*)(src + 4 * i); u32x2 w; w.x = pk2(f[0], f[1]); w.y = pk2(f[2], f[3]); *(u32x2*)(wb + off + 4 * i) = w; }
        };
        auto convg = [&](const float* src, size_t off, size_t n, int ncol, const float* gain) {
            for (size_t i = gt; i < n / 4; i += gs) { const float gk = gain[(4 * i) / ncol]; const f32x4 f = *(const f32x4*)(src + 4 * i); u32x2 w; w.x = pk2(f[0] * gk, f[1] * gk); w.y = pk2(f[2] * gk, f[3] * gk); *(u32x2*)(wb + off + 4 * i) = w; }
        };
        conv(p.in[7], WB_IN, (size_t)1024 * 1952); convg(p.in[10], WB_UQ, (size_t)256 * 768, 768, p.in[8]); convg(p.in[11], WB_UKV, (size_t)128 * 1024, 1024, p.in[9]);
        conv(p.in[17], WB_O, (size_t)1024 * 1024); conv(p.in[20], WB_R, (size_t)1024 * 256);
    }
}

__device__ __forceinline__ void phase_h1(const Params& p) {
    const int v = vcu(), G = grid_g();
    const int tid = otid(), lane = tid & 63, wave = tid >> 6;
    const float* x = p.in[0]; const int* positions = (const int*)p.in[2]; const float* g = p.in[5];
    const float* mod = (const float*)(p.ws + WS_MOD);
    bf16_t* h1 = (bf16_t*)(p.ws + WS_H1);
    f32x2* rope = (f32x2*)(p.ws + WS_ROPE);
    for (int t = v * NW + wave; t < T; t += G * NW) {
        const int b = t / SEQ;
        const f32x4* xr = (const f32x4*)(x + (size_t)t * Dm);
        f32x4 xv[4]; float ss = 0.f;
#pragma unroll
        for (int j = 0; j < 4; ++j) { xv[j] = xr[lane + 64 * j]; ss += xv[j][0] * xv[j][0] + xv[j][1] * xv[j][1] + xv[j][2] * xv[j][2] + xv[j][3] * xv[j][3]; }
        ss = wave_sum(ss, lane);
        const float rstd = rsqrtf(ss * (1.f / Dm) + 1e-6f);
        const float* sh = mod + b * 6144; const float* scl = sh + 1024;
#pragma unroll
        for (int j = 0; j < 4; ++j) {
            const int col = 4 * (lane + 64 * j);
            const f32x4 gv = *(const f32x4*)(g + col), sv = *(const f32x4*)(scl + col), hv = *(const f32x4*)(sh + col);
            float o[4];
#pragma unroll
            for (int e = 0; e < 4; ++e) o[e] = (xv[j][e] * rstd * gv[e]) * (1.f + sv[e]) + hv[e];
            u32x2 w; w.x = pk2(o[0], o[1]); w.y = pk2(o[2], o[3]);
            *(u32x2*)(h1 + (size_t)t * Dm + col) = w;
        }
        if (lane < 16) {
            const double inv = exp2(-(double)lane * (13.287712379549449 / 16.0));
            const double rev = (double)positions[t] * inv * 0.15915494309189535;
            const float fr = (float)(rev - rint(rev));
            f32x2 cs; cs.x = __builtin_amdgcn_cosf(fr); cs.y = __builtin_amdgcn_sinf(fr);
            rope[(size_t)t * 16 + lane] = cs;
        }
    }
}

__device__ __forceinline__ void phase_proj(const Params& p, LAS char* L) {
    const int v = vcu(), G = grid_g();
    const bf16_t* h1 = (const bf16_t*)(p.ws + WS_H1);
    const bf16_t* w_in = (const bf16_t*)(p.ws + WS_WB) + WB_IN;
    bf16_t* proj = (bf16_t*)(p.ws + WS_PROJ);
    const f32x2* rope = (const f32x2*)(p.ws + WS_ROPE);
    for (int u = v; u < 64 * 8; u += G) {
        const int mt = u >> 3, nt = u & 7, m0 = mt * 256, n0 = nt * 256;
        auto arow = [&](int r) { return (unsigned)(m0 + r) * Dm; };
        auto bcol = [&](int c) { int col = n0 + c; if (col > NIN - 8) col = NIN - 8; return w_in + col; };
        auto epi = [&](f32x16 (&acc)[4][2]) {
            const int tid_ = otid(), lane = tid_ & 63, wave = tid_ >> 6, wm = wave & 1, wn = wave >> 1, l31 = lane & 31, hi = lane >> 5;
            if (nt < 2) {
                LAS float* ssl = (LAS float*)(L + OFF_SS);
                const bool contrib = (nt == 0) || (wn < 2);
#pragma unroll
                for (int mi = 0; mi < 4; ++mi) {
                    float part = 0.f;
#pragma unroll
                    for (int ni = 0; ni < 2; ++ni)
#pragma unroll
                        for (int r = 0; r < 16; ++r) part += acc[mi][ni][r] * acc[mi][ni][r];
                    part += shx(part, 32, lane);
                    if (hi == 0) ssl[(128 * wm + 32 * mi + l31) * 4 + wn] = contrib ? part : 0.f;
                }
                __syncthreads();
                if (tid_ < 256) {
                    const f32x4 q4 = *(LAS f32x4*)(ssl + tid_ * 4);
                    const float ssum = (q4[0] + q4[1]) + (q4[2] + q4[3]);
                    float* rs = (float*)(p.ws + WS_CQN) + (nt == 0 ? 0 : (1 << 18));
                    rs[m0 + tid_] = rsqrtf(ssum * (nt == 0 ? 1.f / 256.f : 1.f / 128.f) + 1e-6f);
                }
            }
#pragma unroll
            for (int ni = 0; ni < 2; ++ni) {
                const int nbg = n0 + nb_of<0>(wn, ni);
                if (nbg == C_KR) {
#pragma unroll
                    for (int mi = 0; mi < 4; ++mi) {
                        const int m = m0 + 128 * wm + 32 * mi + l31;
#pragma unroll
                        for (int r = 0; r < 8; ++r) {
                            const f32x2 cs = rope[(size_t)m * 16 + crow(r, hi)];
                            const float x1 = acc[mi][ni][r], x2 = acc[mi][ni][r + 8];
                            acc[mi][ni][r] = x1 * cs.x - x2 * cs.y; acc[mi][ni][r + 8] = x2 * cs.x + x1 * cs.y;
                        }
                    }
                }
                if (nbg >= C_DQ && nbg < C_DK) {
#pragma unroll
                    for (int mi = 0; mi < 4; ++mi)
#pragma unroll
                        for (int r = 0; r < 16; ++r) acc[mi][ni][r] *= 0.125f * LOG2E;
                }
            }
            store_tile_bf16<4, 256>(L, acc, [&](int row, int c) -> bf16_t* { const int col = n0 + 8 * c; return col < NIN ? proj + (size_t)(m0 + row) * NIN + col : nullptr; });
        };
        gemm_tile<4, 0, true>(L, Dm / 64, NIN, h1, arow, bcol, epi);
    }
}

__device__ __forceinline__ void phase_norms(const Params& p) {
    const int v = vcu(), G = grid_g();
    const int tid = otid(), lane = tid & 63, wave = tid >> 6;
    const bf16_t* proj = (const bf16_t*)(p.ws + WS_PROJ);
    const float* qg = p.in[8]; const float* kvg = p.in[9];
    bf16_t* cqn = (bf16_t*)(p.ws + WS_CQN); bf16_t* ckvn = (bf16_t*)(p.ws + WS_CKVN); bf16_t* kf = (bf16_t*)(p.ws + WS_KF);
    const f32x2* rope = (const f32x2*)(p.ws + WS_ROPE);
    for (int t = v * NW + wave; t < T; t += G * NW) {
        const bf16_t* pr = proj + (size_t)t * NIN;
        {
            const u32x2 raw = *(const u32x2*)(pr + C_CQ + 4 * lane);
            float a[4] = {bflo(raw.x), bfhi(raw.x), bflo(raw.y), bfhi(raw.y)};
            float ss = wave_sum(a[0] * a[0] + a[1] * a[1] + a[2] * a[2] + a[3] * a[3], lane);
            const float rstd = rsqrtf(ss * (1.f / 256.f) + 1e-6f);
            const f32x4 gv = *(const f32x4*)(qg + 4 * lane);
            u32x2 w; w.x = pk2(a[0] * rstd * gv[0], a[1] * rstd * gv[1]); w.y = pk2(a[2] * rstd * gv[2], a[3] * rstd * gv[3]);
            *(u32x2*)(cqn + (size_t)t * 256 + 4 * lane) = w;
        }
        {
            const unsigned raw = *(const unsigned*)(pr + C_CKV + 2 * lane);
            const float a0 = bflo(raw), a1 = bfhi(raw);
            float ss = wave_sum(a0 * a0 + a1 * a1, lane);
            const float rstd = rsqrtf(ss * (1.f / 128.f) + 1e-6f);
            *(unsigned*)(ckvn + (size_t)t * 128 + 2 * lane) = pk2(a0 * rstd * kvg[2 * lane], a1 * rstd * kvg[2 * lane + 1]);
        }
        if (lane < 16) {
            const float x1 = bf2f(pr[C_KR + lane]), x2 = bf2f(pr[C_KR + 16 + lane]);
            const f32x2 cs = rope[(size_t)t * 16 + lane];
            const bf16_t y1 = f2bf(x1 * cs.x - x2 * cs.y), y2 = f2bf(x2 * cs.x + x1 * cs.y);
#pragma unroll
            for (int h = 0; h < 8; ++h) { kf[(size_t)t * 768 + h * 96 + 64 + lane] = y1; kf[(size_t)t * 768 + h * 96 + 80 + lane] = y2; }
        }
    }
}

__device__ __forceinline__ void phase_qkv(const Params& p, LAS char* L) {
    const int v = vcu(), G = grid_g();
    const bf16_t* proj = (const bf16_t*)(p.ws + WS_PROJ);
    const float* rstd_q = (const float*)(p.ws + WS_CQN); const float* rstd_kv = rstd_q + (1 << 18);
    const bf16_t* w_uq = (const bf16_t*)(p.ws + WS_WB) + WB_UQ; const bf16_t* w_ukv = (const bf16_t*)(p.ws + WS_WB) + WB_UKV;
    bf16_t* qm = (bf16_t*)(p.ws + WS_QM); bf16_t* kf = (bf16_t*)(p.ws + WS_KF); bf16_t* vm = (bf16_t*)(p.ws + WS_VM);
    const f32x2* rope = (const f32x2*)(p.ws + WS_ROPE);
    const float qscale = LOG2E * 0.10206207261596575f;
    for (int u = v; u < 64 * 7; u += G) {
        const int mt = u / 7, j = u % 7, m0 = mt * 256;
        if (j < 3) {
            const int n0 = j * 256;
            auto arow = [&](int r) { return (unsigned)(m0 + r) * NIN + C_CQ; };
            auto bcol = [&](int c) { return w_uq + n0 + c; };
            auto epi = [&](f32x16 (&acc)[4][2]) {
                const int tid_ = otid(), lane = tid_ & 63, wave = tid_ >> 6, wm = wave & 1, wn = wave >> 1, l31 = lane & 31, hi = lane >> 5;
#pragma unroll
                for (int mi = 0; mi < 4; ++mi) {
                    const int m = m0 + 128 * wm + 32 * mi + l31;
                    const float qs = qscale * rstd_q[m];
#pragma unroll
                    for (int ni = 0; ni < 2; ++ni) {
                        const int nbg = n0 + nb_of<0>(wn, ni);
                        if ((nbg % 96) == 64) {
#pragma unroll
                            for (int r = 0; r < 8; ++r) {
                                const f32x2 cs = rope[(size_t)m * 16 + crow(r, hi)];
                                const float x1 = acc[mi][ni][r], x2 = acc[mi][ni][r + 8];
                                acc[mi][ni][r] = x1 * cs.x - x2 * cs.y; acc[mi][ni][r + 8] = x2 * cs.x + x1 * cs.y;
                            }
                        }
#pragma unroll
                        for (int r = 0; r < 16; ++r) acc[mi][ni][r] *= qs;
                    }
                }
                store_tile_bf16<4, 256>(L, acc, [&](int row, int c) -> bf16_t* { return qm + (size_t)(m0 + row) * 768 + n0 + 8 * c; });
            };
            gemm_tile<4, 0, true>(L, 256 / 64, 768, proj, arow, bcol, epi);
        } else {
            const int n0 = (j - 3) * 256;
            auto arow = [&](int r) { return (unsigned)(m0 + r) * NIN + C_CKV; };
            auto bcol = [&](int c) { return w_ukv + n0 + c; };
            auto epi = [&](f32x16 (&acc)[4][2]) {
                {
                    const int tid_ = otid(), lane = tid_ & 63, wave = tid_ >> 6, wm = wave & 1, l31 = lane & 31;
#pragma unroll
                    for (int mi = 0; mi < 4; ++mi) {
                        const float rs = rstd_kv[m0 + 128 * wm + 32 * mi + l31];
#pragma unroll
                        for (int ni = 0; ni < 2; ++ni)
#pragma unroll
                            for (int r = 0; r < 16; ++r) acc[mi][ni][r] *= rs;
                    }
                }
                store_tile_bf16<4, 256>(L, acc, [&](int row, int c) -> bf16_t* {
                    const int h = (n0 >> 7) + (c >> 4), cc = c & 15;
                    return cc < 8 ? kf + (size_t)(m0 + row) * 768 + h * 96 + 8 * cc : vm + (size_t)(m0 + row) * 512 + h * 64 + 8 * (cc - 8); });
            };
            gemm_tile<4, 0, true>(L, 128 / 64, 1024, proj, arow, bcol, epi);
        }
    }
}

template <int DQK, int DV, bool ALIBI>
__device__ __forceinline__ void attn_map(LAS char* L, const bf16_t* Q, int ldq, const bf16_t* K, int ldk, const bf16_t* V, int ldv,
                                         const int* posrow, float slope2, int q0, f32x16 (&o)[DV / 32], const bf16_t* K2 = nullptr, int ldk2 = 0) {
    constexpr int KSTR = DQK * 2 + 16, VSTR = DV * 2 + 64, KS = DQK / 16, ND = DV / 32;
    constexpr int K_OFF = 0, V_OFF = 64 * KSTR, P_OFF = V_OFF + 64 * VSTR, ABUF = P_OFF + 256;
    constexpr int KCH = DQK / 8, VCH = DV / 8;
    constexpr int NKI = (64 * KCH + NT - 1) / NT, NVI = (64 * VCH + NT - 1) / NT;
    const int tid = otid();
    const int lane = tid & 63, wave = tid >> 6, l31 = lane & 31, hi = lane >> 5;
    const int qrow = q0 + 32 * wave + l31;
    unsigned kgo[NKI], klo[NKI], vgo[NVI], vlo[NVI];
    bool k2s[NKI];
#pragma unroll
    for (int i = 0; i < NKI; ++i) { int c = tid + NT * i; if (c >= 64 * KCH) c = 64 * KCH - 1; const int row = c / KCH, ch = c % KCH; k2s[i] = (DQK == 96) && (ch >= 8);
        kgo[i] = k2s[i] ? (unsigned)(row * ldk2 + (ch - 8) * 8) * 2u : (unsigned)(row * ldk + ch * 8) * 2u; klo[i] = K_OFF + row * KSTR + ch * 16; }
#pragma unroll
    for (int i = 0; i < NVI; ++i) { int c = tid + NT * i; if (c >= 64 * VCH) c = 64 * VCH - 1; const int row = c / VCH, ch = c % VCH; vgo[i] = (unsigned)(row * ldv + ch * 8) * 2u; vlo[i] = V_OFF + row * VSTR + ch * 16; }
    bf16x8 qf[KS];
#pragma unroll
    for (int s = 0; s < KS; ++s) qf[s] = *(const bf16x8*)(Q + (size_t)qrow * ldq + 16 * s + 8 * hi);
    const float posq = ALIBI ? (float)posrow[qrow] : 0.f;
#pragma unroll
    for (int d = 0; d < ND; ++d)
#pragma unroll
        for (int r = 0; r < 16; ++r) o[d][r] = 0.f;
    float m_run = -1e30f, l_run = 0.f;
    const int ntile = (q0 + 256) / 64;
    const int qmin = q0 + 32 * wave, qmax = qmin + 31;
    const int vrd = V_OFF + (4 * hi + ((lane & 15) >> 2)) * VSTR + 2 * (16 * ((lane >> 4) & 1) + 4 * (lane & 3));
    u32x4 rk[NKI], rv[NVI]; float rp = 0.f;
#pragma unroll
    for (int i = 0; i < NKI; ++i) rk[i] = *(const u32x4*)((k2s[i] ? (const char*)K2 : (const char*)K) + kgo[i]);
#pragma unroll
    for (int i = 0; i < NVI; ++i) rv[i] = *(const u32x4*)((const char*)V + vgo[i]);
    if (ALIBI && tid < 64) rp = (float)posrow[tid];
    __syncthreads();
#pragma unroll
    for (int i = 0; i < NKI; ++i) if (tid + NT * i < 64 * KCH) *(LAS u32x4*)(L + klo[i]) = rk[i];
#pragma unroll
    for (int i = 0; i < NVI; ++i) if (tid + NT * i < 64 * VCH) *(LAS u32x4*)(L + vlo[i]) = rv[i];
    if (ALIBI && tid < 64) *(LAS float*)(L + P_OFF + 4 * tid) = rp;
    __syncthreads();
    for (int tl = 0; tl < ntile; ++tl) {
        const int kb = tl * 64;
        LAS char* Lb = L + (tl & 1) * ABUF;
        LAS char* Ln = L + ((tl + 1) & 1) * ABUF;
        const bool more = tl + 1 < ntile;
        if (more) {
            const char* kbase = (const char*)(K + (size_t)(kb + 64) * ldk);
            const char* kbase2 = (const char*)(K2 + (size_t)(kb + 64) * ldk2);
            const char* vbase = (const char*)(V + (size_t)(kb + 64) * ldv);
#pragma unroll
            for (int i = 0; i < NKI; ++i) rk[i] = *(const u32x4*)((k2s[i] ? kbase2 : kbase) + kgo[i]);
#pragma unroll
            for (int i = 0; i < NVI; ++i) rv[i] = *(const u32x4*)(vbase + vgo[i]);
            if (ALIBI && tid < 64) rp = (float)posrow[kb + 64 + tid];
        }
        if (kb <= qmax) {
            f32x16 s0, s1;
#pragma unroll
            for (int r = 0; r < 16; ++r) { s0[r] = 0.f; s1[r] = 0.f; }
#pragma unroll
            for (int s = 0; s < KS; ++s) {
                const bf16x8 k0 = *(LAS bf16x8*)(Lb + K_OFF + l31 * KSTR + 32 * s + 16 * hi);
                const bf16x8 k1 = *(LAS bf16x8*)(Lb + K_OFF + (32 + l31) * KSTR + 32 * s + 16 * hi);
                s0 = MFMA32(k0, qf[s], s0); s1 = MFMA32(k1, qf[s], s1);
            }
            if (ALIBI) {
#pragma unroll
                for (int r = 0; r < 16; ++r) {
                    const float pk0 = *(LAS float*)(Lb + P_OFF + 4 * crow(r, hi)), pk1 = *(LAS float*)(Lb + P_OFF + 4 * (32 + crow(r, hi)));
                    s0[r] -= slope2 * fabsf(posq - pk0); s1[r] -= slope2 * fabsf(posq - pk1);
                }
            }
            if (kb + 63 > qmin) {
#pragma unroll
                for (int r = 0; r < 16; ++r) {
                    const int key = kb + crow(r, hi);
                    if (key > qrow) s0[r] = -INFINITY;
                    if (key + 32 > qrow) s1[r] = -INFINITY;
                }
            }
            float mx = s0[0];
#pragma unroll
            for (int r = 1; r < 16; ++r) mx = fmaxf(mx, s0[r]);
#pragma unroll
            for (int r = 0; r < 16; ++r) mx = fmaxf(mx, s1[r]);
            mx = fmaxf(mx, shx(mx, 32, lane));
            const float m_new = fmaxf(m_run, mx);
            const float alpha = __builtin_amdgcn_exp2f(m_run - m_new);
            m_run = m_new;
            float ls = 0.f;
#pragma unroll
            for (int r = 0; r < 16; ++r) { s0[r] = __builtin_amdgcn_exp2f(s0[r] - m_new); s1[r] = __builtin_amdgcn_exp2f(s1[r] - m_new); ls += s0[r] + s1[r]; }
            l_run = l_run * alpha + ls;
#pragma unroll
            for (int d = 0; d < ND; ++d)
#pragma unroll
                for (int r = 0; r < 16; ++r) o[d][r] *= alpha;
            u32x4 pw[4];
#pragma unroll
            for (int j = 0; j < 4; ++j) {
                pw[0][j] = pk2(s0[2 * j], s0[2 * j + 1]); pw[1][j] = pk2(s0[8 + 2 * j], s0[8 + 2 * j + 1]);
                pw[2][j] = pk2(s1[2 * j], s1[2 * j + 1]); pw[3][j] = pk2(s1[8 + 2 * j], s1[8 + 2 * j + 1]);
            }
#pragma unroll
            for (int s = 0; s < 4; ++s) {
                const bf16x8 pf = __builtin_bit_cast(bf16x8, pw[s]);
#pragma unroll
                for (int d = 0; d < ND; ++d) {
                    LAS char* vp = Lb + vrd + 16 * s * VSTR + 64 * d;
                    const s16x4 lo = tr_read(vp), h4 = tr_read(vp + 8 * VSTR);
                    const bf16x8 vf = (bf16x8){lo[0], lo[1], lo[2], lo[3], h4[0], h4[1], h4[2], h4[3]};
                    o[d] = MFMA32(vf, pf, o[d]);
                }
                __builtin_amdgcn_sched_barrier(0);
            }
        }
        if (more) {
#pragma unroll
            for (int i = 0; i < NKI; ++i) if (tid + NT * i < 64 * KCH) *(LAS u32x4*)(Ln + klo[i]) = rk[i];
#pragma unroll
            for (int i = 0; i < NVI; ++i) if (tid + NT * i < 64 * VCH) *(LAS u32x4*)(Ln + vlo[i]) = rv[i];
            if (ALIBI && tid < 64) *(LAS float*)(Ln + P_OFF + 4 * tid) = rp;
        }
        __syncthreads();
    }
    const float lt = l_run + shx(l_run, 32, lane);
    const float inv = 1.f / lt;
#pragma unroll
    for (int d = 0; d < ND; ++d)
#pragma unroll
        for (int r = 0; r < 16; ++r) o[d][r] *= inv;
}

__device__ __forceinline__ void attn_decode(int it, int& kind, int& qb, int& idx) {
    const int seg_kind[16] = {1, 1, 1, 1, 1, 0, 1, 0, 0, 0, 1, 0, 0, 1, 0, 0};
    const int seg_qb[16]   = {7, 6, 5, 4, 3, 7, 2, 6, 5, 4, 1, 3, 2, 0, 1, 0};
    int base = 0; kind = 0; qb = 0; idx = 0;
#pragma unroll
    for (int s = 0; s < 16; ++s) {
        const int n = seg_kind[s] ? 32 : 64;
        if (it >= base && it < base + n) { kind = seg_kind[s]; qb = seg_qb[s]; idx = it - base; }
        base += n;
    }
}

__device__ __forceinline__ void phase_attn(const Params& p, LAS char* L) {
    const int v = vcu(), G = grid_g();
    const int tid = otid(), lane = tid & 63, wave = tid >> 6, l31 = lane & 31, hi = lane >> 5;
    const int* positions = (const int*)p.in[2];
    const bf16_t* proj = (const bf16_t*)(p.ws + WS_PROJ);
    const bf16_t* qm = (const bf16_t*)(p.ws + WS_QM); const bf16_t* kf = (const bf16_t*)(p.ws + WS_KF); const bf16_t* vm = (const bf16_t*)(p.ws + WS_VM);
    bf16_t* att = (bf16_t*)(p.ws + WS_ATT);
    float* od0 = (float*)(p.ws + WS_OD0);
    const float* subg = p.in[16];
    unsigned* qctr = (unsigned*)(p.ws + WS_CTL + 2048);
    LAS unsigned* qslot = (LAS unsigned*)(L + OFF_MISC + 16);
    float lam;
    {
        const float a = p.in[12][lane] * p.in[13][lane], b = p.in[14][lane] * p.in[15][lane];
        lam = __expf(wave_sum(a, lane)) - __expf(wave_sum(b, lane)) + LAMBDA_INIT;
    }
    for (;;) {
        if (tid == 0) *qslot = __hip_atomic_fetch_add(qctr, 1u, __ATOMIC_RELAXED, __HIP_MEMORY_SCOPE_AGENT);
        __syncthreads();
        const int it = (int)*qslot;
        __syncthreads();
        if (it >= 768) break;
        int kind, qb, idx;
        attn_decode(it, kind, qb, idx);
        const int q0 = qb * 256;
        if (kind == 0) {
            const int b = idx >> 3, h = idx & 7; const size_t tb = (size_t)b * SEQ;
            f32x16 o[2];
            attn_map<96, 64, false>(L, qm + tb * 768 + h * 96, 768, kf + tb * 768 + h * 96, 768, vm + tb * 512 + h * 64, 512, positions + tb, 0.f, q0, o, proj + tb * NIN + C_KR, NIN);
            const size_t t = tb + q0 + 32 * wave + l31;
#pragma unroll
            for (int d = 0; d < 2; ++d)
#pragma unroll
                for (int gq = 0; gq < 4; ++gq) {
                    u32x2 w; w.x = pk2(o[d][4 * gq], o[d][4 * gq + 1]); w.y = pk2(o[d][4 * gq + 2], o[d][4 * gq + 3]);
                    *(u32x2*)(att + t * 1024 + h * 64 + 32 * d + 8 * gq + 4 * hi) = w;
                }
        } else {
            const int b = idx >> 2, h = idx & 3; const size_t tb = (size_t)b * SEQ;
            const float slope2 = exp2f(-2.f * (h + 1)) * LOG2E;
            const size_t t = tb + q0 + 32 * wave + l31;
            f32x16 o[4];
            attn_map<64, 128, true>(L, proj + tb * NIN + C_DQ + h * 128, NIN, proj + tb * NIN + C_DK + h * 128, NIN, proj + tb * NIN + C_DV + h * 128, NIN, positions + tb, slope2, q0, o);
#pragma unroll
            for (int d = 0; d < 4; ++d)
#pragma unroll
                for (int gq = 0; gq < 4; ++gq) {
                    f32x4 w = {o[d][4 * gq], o[d][4 * gq + 1], o[d][4 * gq + 2], o[d][4 * gq + 3]};
                    *(f32x4*)(od0 + t * 512 + h * 128 + 32 * d + 8 * gq + 4 * hi) = w;
                }
            attn_map<64, 128, true>(L, proj + tb * NIN + C_DQ + h * 128 + 64, NIN, proj + tb * NIN + C_DK + h * 128 + 64, NIN, proj + tb * NIN + C_DV + h * 128, NIN, positions + tb, slope2, q0, o);
            float ss = 0.f;
#pragma unroll
            for (int d = 0; d < 4; ++d)
#pragma unroll
                for (int gq = 0; gq < 4; ++gq) {
                    const f32x4 w = *(const f32x4*)(od0 + t * 512 + h * 128 + 32 * d + 8 * gq + 4 * hi);
#pragma unroll
                    for (int e = 0; e < 4; ++e) { const float c = w[e] - lam * o[d][4 * gq + e]; o[d][4 * gq + e] = c; ss += c * c; }
                }
            ss += shx(ss, 32, lane);
            const float rstd = rsqrtf(ss * (1.f / 128.f) + 1e-5f) * (1.f - LAMBDA_INIT);
#pragma unroll
            for (int d = 0; d < 4; ++d)
#pragma unroll
                for (int gq = 0; gq < 4; ++gq) {
                    const int dv = 32 * d + 8 * gq + 4 * hi;
                    const f32x4 gv = *(const f32x4*)(subg + dv);
                    u32x2 w; w.x = pk2(o[d][4 * gq] * rstd * gv[0], o[d][4 * gq + 1] * rstd * gv[1]); w.y = pk2(o[d][4 * gq + 2] * rstd * gv[2], o[d][4 * gq + 3] * rstd * gv[3]);
                    *(u32x2*)(att + t * 1024 + 512 + h * 128 + dv) = w;
                }
        }
    }
}

__device__ __forceinline__ void phase_oproj(const Params& p, LAS char* L) {
    const int v = vcu(), G = grid_g();
    const bf16_t* att = (const bf16_t*)(p.ws + WS_ATT);
    const bf16_t* w_o = (const bf16_t*)(p.ws + WS_WB) + WB_O;
    bf16_t* y1 = (bf16_t*)(p.ws + WS_Y1);
    for (int u = v; u < 64 * 4; u += G) {
        const int mt = u >> 2, nt = u & 3, m0 = mt * 256, n0 = nt * 256;
        auto arow = [&](int r) { return (unsigned)(m0 + r) * Dm; };
        auto bcol = [&](int c) { return w_o + n0 + c; };
        auto epi = [&](f32x16 (&acc)[4][2]) {
            store_tile_bf16<4, 256>(L, acc, [&](int row, int c) -> bf16_t* { return y1 + (size_t)(m0 + row) * Dm + n0 + 8 * c; });
        };
        gemm_tile<4, 0, true>(L, Dm / 64, Dm, att, arow, bcol, epi);
    }
}

__device__ __forceinline__ void phase_post_attn(const Params& p) {
    const int v = vcu(), G = grid_g();
    const int tid = otid(), lane = tid & 63, wave = tid >> 6;
    const float* x = p.in[0]; const float* pg = p.in[6]; const float* fg = p.in[18];
    const float* mod = (const float*)(p.ws + WS_MOD);
    const bf16_t* y1 = (const bf16_t*)(p.ws + WS_Y1);
    bf16_t* h2 = (bf16_t*)(p.ws + WS_H2);
    for (int t = v * NW + wave; t < T; t += G * NW) {
        const int b = t / SEQ;
        const float* mb = mod + b * 6144;
        f32x4 yv[4], xv[4]; float ss = 0.f;
#pragma unroll
        for (int j = 0; j < 4; ++j) {
            const u32x2 raw = *(const u32x2*)(y1 + (size_t)t * Dm + 4 * (lane + 64 * j));
            yv[j] = (f32x4){bflo(raw.x), bfhi(raw.x), bflo(raw.y), bfhi(raw.y)};
            xv[j] = *(const f32x4*)(x + (size_t)t * Dm + 4 * (lane + 64 * j));
            ss += yv[j][0] * yv[j][0] + yv[j][1] * yv[j][1] + yv[j][2] * yv[j][2] + yv[j][3] * yv[j][3];
        }
        ss = wave_sum(ss, lane);
        const float rstd = rsqrtf(ss * (1.f / Dm) + 1e-6f);
        float ss2 = 0.f;
#pragma unroll
        for (int j = 0; j < 4; ++j) {
            const int col = 4 * (lane + 64 * j);
            const f32x4 gv = *(const f32x4*)(pg + col), ga = *(const f32x4*)(mb + 2048 + col);
#pragma unroll
            for (int e = 0; e < 4; ++e) { xv[j][e] = xv[j][e] + ga[e] * (yv[j][e] * rstd * gv[e]); ss2 += xv[j][e] * xv[j][e]; }
            *(f32x4*)(p.out + (size_t)t * Dm + col) = xv[j];
        }
        ss2 = wave_sum(ss2, lane);
        const float rstd2 = rsqrtf(ss2 * (1.f / Dm) + 1e-6f);
#pragma unroll
        for (int j = 0; j < 4; ++j) {
            const int col = 4 * (lane + 64 * j);
            const f32x4 gv = *(const f32x4*)(fg + col), sv = *(const f32x4*)(mb + 4096 + col), hv = *(const f32x4*)(mb + 3072 + col);
            float o[4];
#pragma unroll
            for (int e = 0; e < 4; ++e) o[e] = (xv[j][e] * rstd2 * gv[e]) * (1.f + sv[e]) + hv[e];
            u32x2 w; w.x = pk2(o[0], o[1]); w.y = pk2(o[2], o[3]);
            *(u32x2*)(h2 + (size_t)t * Dm + col) = w;
        }
    }
}

__device__ __forceinline__ void phase_router(const Params& p, LAS char* L) {
    const int v = vcu(), G = grid_g();
    const bf16_t* h2 = (const bf16_t*)(p.ws + WS_H2);
    const bf16_t* rw = (const bf16_t*)(p.ws + WS_WB) + WB_R;
    float* lg = (float*)(p.ws + WS_LOG);
    for (int u = v; u < 128; u += G) {
        const int m0 = u * 128;
        auto arow = [&](int r) { return (unsigned)(m0 + r) * Dm; };
        auto bcol = [&](int c) { return rw + c; };
        auto epi = [&](f32x16 (&acc)[2][2]) {
            const int tid_ = otid(), lane = tid_ & 63, wave = tid_ >> 6, wm = wave & 1, wn = wave >> 1, l31 = lane & 31, hi = lane >> 5;
#pragma unroll
            for (int mi = 0; mi < 2; ++mi) {
                const int m = m0 + 64 * wm + 32 * mi + l31;
#pragma unroll
                for (int ni = 0; ni < 2; ++ni) {
                    const int nbg = nb_of<0>(wn, ni);
#pragma unroll
                    for (int gq = 0; gq < 4; ++gq) {
                        f32x4 w = {acc[mi][ni][4 * gq], acc[mi][ni][4 * gq + 1], acc[mi][ni][4 * gq + 2], acc[mi][ni][4 * gq + 3]};
                        *(f32x4*)(lg + (size_t)m * NE + nbg + 8 * gq + 4 * hi) = w;
                    }
                }
            }
        };
        gemm_tile<2, 0, true>(L, Dm / 64, NE, h2, arow, bcol, epi);
    }
}

__device__ __forceinline__ void phase_route(const Params& p) {
    const int v = vcu(), G = grid_g();
    const int tid = otid(), lane = tid & 63, wave = tid >> 6;
    const float* lg = (const float*)(p.ws + WS_LOG);
    const float* rb = p.in[21];
    int* cnt = (int*)(p.ws + WS_CTL);
    int* la = (int*)(p.ws + WS_LA); float* lw = (float*)(p.ws + WS_LW);
    const f32x4 bias = *(const f32x4*)(rb + 4 * lane);
    const int grp = lane >> 3;
    for (int t = v * NW + wave; t < T; t += G * NW) {
        const f32x4 lgv = *(const f32x4*)(lg + (size_t)t * NE + 4 * lane);
        float s0 = 1.f / (1.f + __expf(-lgv[0])), s1 = 1.f / (1.f + __expf(-lgv[1])), s2 = 1.f / (1.f + __expf(-lgv[2])), s3 = 1.f / (1.f + __expf(-lgv[3]));
        float v0 = s0 + bias[0], v1 = s1 + bias[1], v2 = s2 + bias[2], v3 = s3 + bias[3];
        float t1 = fmaxf(v0, v1), t2 = fminf(v0, v1);
        { const float a = fmaxf(v2, v3), bq = fminf(v2, v3); const float n1 = fmaxf(t1, a), n2 = fmaxf(fminf(t1, a), fmaxf(t2, bq)); t1 = n1; t2 = n2; }
#pragma unroll
        for (int off = 1; off <= 4; off <<= 1) {
            const float o1 = shx(t1, off, lane), o2 = shx(t2, off, lane);
            const float n1 = fmaxf(t1, o1), n2 = fmaxf(fminf(t1, o1), fmaxf(t2, o2)); t1 = n1; t2 = n2;
        }
        const float gs = t1 + t2;
        int rank = 0;
#pragma unroll
        for (int gg = 0; gg < 8; ++gg) { const float og = shl(gs, gg * 8); rank += (og > gs || (og == gs && gg < grp)) ? 1 : 0; }
        if (rank >= 4) { v0 = -INFINITY; v1 = -INFINITY; v2 = -INFINITY; v3 = -INFINITY; }
        float wsum = 0.f, myw = 0.f; int mye = 0;
#pragma unroll
        for (int it = 0; it < TOPK; ++it) {
            float bv = v0; int bi = 0;
            if (v1 > bv) { bv = v1; bi = 1; }
            if (v2 > bv) { bv = v2; bi = 2; }
            if (v3 > bv) { bv = v3; bi = 3; }
            int idx = 4 * lane + bi;
#pragma unroll
            for (int off = 32; off >= 1; off >>= 1) {
                const float ov = shx(bv, off, lane); const int oi = shxi(idx, off, lane);
                if (ov > bv || (ov == bv && oi < idx)) { bv = ov; idx = oi; }
            }
            const int jj = idx & 3, owner = idx >> 2;
            const float mys = jj == 0 ? s0 : (jj == 1 ? s1 : (jj == 2 ? s2 : s3));
            const float scv = shl(mys, owner);
            if (lane == owner) { if (jj == 0) v0 = -INFINITY; else if (jj == 1) v1 = -INFINITY; else if (jj == 2) v2 = -INFINITY; else v3 = -INFINITY; }
            wsum += scv;
            if (lane == it) { myw = scv; mye = idx; }
        }
        if (lane < TOPK) {
            const float w = myw / wsum * 2.5f;
            const int pos = atomicAdd(cnt + mye, 1);
            if (pos < LISTCAP) { la[(size_t)mye * LISTCAP + pos] = t * TOPK + lane; lw[(size_t)mye * LISTCAP + pos] = w; }
        }
    }
}

__device__ __forceinline__ int moe_cnt(const int* cnt, int e) { int c = (e < 256) ? cnt[e] : T; return c > LISTCAP ? LISTCAP : c; }
__device__ __forceinline__ void moe_prefix(const Params& p, LAS char* L) {
    const int tid = otid();
    const int* cnt = (const int*)(p.ws + WS_CTL);
    LAS int* pre = (LAS int*)(L + OFF_PRE);
    LAS int* tl = (LAS int*)(L + OFF_TL);
    __syncthreads();
    for (int i = tid; i < 257; i += NT) { const int c = moe_cnt(cnt, i); tl[i] = (c + 255) >> 8; }
    __syncthreads();
    if (tid == 0) { int s = 0; for (int i = 0; i < 257; ++i) { pre[i] = s; s += tl[i]; } pre[257] = s; }
    __syncthreads();
}
__device__ __forceinline__ int moe_find(LAS int* pre, int g) {
    int lo = 0, hi = 256;
    while (lo < hi) { const int mid = (lo + hi + 1) >> 1; if (pre[mid] <= g) lo = mid; else hi = mid - 1; }
    return lo;
}

template <int MI>
__device__ __forceinline__ void moe1_unit(const Params& p, LAS char* L, int e, int r0, int rows, int j0) {
    const bf16_t* h2 = (const bf16_t*)(p.ws + WS_H2);
    const int* la = (const int*)(p.ws + WS_LA);
    bf16_t* hb = (bf16_t*)(p.ws + WS_HB);
    const float* wg = (e < 256) ? p.in[22] + (size_t)e * Dm * 256 : p.in[25];
    const float* wu = (e < 256) ? p.in[23] + (size_t)e * Dm * 256 : p.in[26];
    LAS int* rowid = (LAS int*)(L + OFF_ROW);
    {
        const int tid = otid();
        if (tid < 64 * MI) { const int rr = tid < rows ? tid : 0; rowid[tid] = (e < 256) ? la[(size_t)e * LISTCAP + r0 + rr] : (AR + r0 + rr); }
        __syncthreads();
    }
    auto arow = [&](int r) { const int a = rowid[r]; const int tok = (e < 256) ? (a >> 3) : (a - AR); return (unsigned)tok * Dm; };
    auto bcol = [&](int c4) { return (c4 < 128) ? (wg + j0 + c4) : (wu + j0 + c4 - 128); };
    auto epi = [&](f32x16 (&acc)[MI][2]) {
#pragma unroll
        for (int mi = 0; mi < MI; ++mi)
#pragma unroll
            for (int r = 0; r < 16; ++r) acc[mi][0][r] = silu_f(acc[mi][0][r]) * acc[mi][1][r];
        store_tile_bf16<MI, 128>(L, acc, [&](int row, int c) -> bf16_t* { return row < rows ? hb + (size_t)rowid[row] * 256 + j0 + 8 * c : nullptr; });
    };
    gemm_tile<MI, 1>(L, Dm / 64, 256, h2, arow, bcol, epi);
}
__device__ __forceinline__ void phase_moe1(const Params& p, LAS char* L) {
    const int v = vcu(), G = grid_g();
    const int* cnt = (const int*)(p.ws + WS_CTL);
    moe_prefix(p, L);
    LAS int* pre = (LAS int*)(L + OFF_PRE);
    const int total = __builtin_amdgcn_readfirstlane(pre[257]) * 2;
    for (int u = v; u < total; u += G) {
        const int g = u >> 1, j0 = (u & 1) * 128;
        const int e = __builtin_amdgcn_readfirstlane(moe_find(pre, g)), mt = g - __builtin_amdgcn_readfirstlane(pre[e]);
        const int rows = __builtin_amdgcn_readfirstlane(moe_cnt(cnt, e)) - mt * 256;
        if (rows > 128) moe1_unit<4>(p, L, e, mt * 256, rows < 256 ? rows : 256, j0);
        else moe1_unit<2>(p, L, e, mt * 256, rows, j0);
    }
}

template <int MI>
__device__ __forceinline__ void moe2_unit(const Params& p, LAS char* L, int e, int r0, int rows, int n0) {
    const int* la = (const int*)(p.ws + WS_LA); const float* lw = (const float*)(p.ws + WS_LW);
    const bf16_t* hb = (const bf16_t*)(p.ws + WS_HB);
    unsigned char* yb = (unsigned char*)(p.ws + WS_YB);
    const float* wd = (e < 256) ? p.in[24] + (size_t)e * 256 * Dm : p.in[27];
    LAS int* rowid = (LAS int*)(L + OFF_ROW);
    LAS float* roww = (LAS float*)(L + OFF_RW);
    {
        const int tid = otid();
        if (tid < 64 * MI) {
            const int rr = tid < rows ? tid : 0;
            rowid[tid] = (e < 256) ? la[(size_t)e * LISTCAP + r0 + rr] : (AR + r0 + rr);
            roww[tid] = (e < 256) ? lw[(size_t)e * LISTCAP + r0 + rr] : 1.f;
        }
        __syncthreads();
    }
    auto arow = [&](int r) { return (unsigned)rowid[r] * 256; };
    auto bcol = [&](int c4) { return wd + n0 + c4; };
    auto epi = [&](f32x16 (&acc)[MI][2]) {
        const int tid_ = otid(), lane = tid_ & 63, wave = tid_ >> 6, wm = wave & 1, l31 = lane & 31;
#pragma unroll
        for (int mi = 0; mi < MI; ++mi) {
            const float w = roww[32 * MI * wm + 32 * mi + l31] * YSCALE;
#pragma unroll
            for (int ni = 0; ni < 2; ++ni)
#pragma unroll
                for (int q = 0; q < 16; ++q) acc[mi][ni][q] = __builtin_amdgcn_fmed3f(acc[mi][ni][q] * w, -448.f, 448.f);
        }
        store_tile_fp8<MI>(L, acc, [&](int row, int c) -> unsigned char* { return row < rows ? yb + (size_t)rowid[row] * Dm + n0 + 16 * c : nullptr; });
    };
    gemm_tile<MI, 0>(L, 256 / 64, Dm, hb, arow, bcol, epi);
}
__device__ __forceinline__ void phase_moe2(const Params& p, LAS char* L) {
    const int v = vcu(), G = grid_g();
    const int* cnt = (const int*)(p.ws + WS_CTL);
    moe_prefix(p, L);
    LAS int* pre = (LAS int*)(L + OFF_PRE);
    const int total = __builtin_amdgcn_readfirstlane(pre[257]) * 4;
    for (int u = v; u < total; u += G) {
        const int g = u >> 2, n0 = (u & 3) * 256;
        const int e = __builtin_amdgcn_readfirstlane(moe_find(pre, g)), mt = g - __builtin_amdgcn_readfirstlane(pre[e]);
        const int rows = __builtin_amdgcn_readfirstlane(moe_cnt(cnt, e)) - mt * 256;
        if (rows > 128) moe2_unit<4>(p, L, e, mt * 256, rows < 256 ? rows : 256, n0);
        else moe2_unit<2>(p, L, e, mt * 256, rows, n0);
    }
}

__device__ __forceinline__ void phase_final(const Params& p) {
    const int v = vcu(), G = grid_g();
    const int tid = otid(), lane = tid & 63, wave = tid >> 6;
    const float* pg = p.in[19];
    const float* mod = (const float*)(p.ws + WS_MOD);
    const unsigned char* yb = (const unsigned char*)(p.ws + WS_YB);
    for (int t = v * NW + wave; t < T; t += G * NW) {
        const int b = t / SEQ;
        const float* gf = mod + b * 6144 + 5120;
        float y[16];
#pragma unroll
        for (int e = 0; e < 16; ++e) y[e] = 0.f;
#pragma unroll
        for (int k = 0; k < 9; ++k) {
            const size_t row = (k < 8) ? ((size_t)t * TOPK + k) : ((size_t)AR + t);
            const u32x4 raw = *(const u32x4*)(yb + row * Dm + 16 * lane);
#pragma unroll
            for (int e = 0; e < 4; ++e) {
                const f32x2 a = __builtin_amdgcn_cvt_pk_f32_fp8((int)raw[e], false), c = __builtin_amdgcn_cvt_pk_f32_fp8((int)raw[e], true);
                y[4 * e] += a.x; y[4 * e + 1] += a.y; y[4 * e + 2] += c.x; y[4 * e + 3] += c.y;
            }
        }
        float ss = 0.f;
#pragma unroll
        for (int e = 0; e < 16; ++e) { y[e] *= (1.f / YSCALE); ss += y[e] * y[e]; }
        ss = wave_sum(ss, lane);
        const float rstd = rsqrtf(ss * (1.f / Dm) + 1e-6f);
        const int col = 16 * lane;
#pragma unroll
        for (int hq = 0; hq < 4; ++hq) {
            f32x4 xo = *(const f32x4*)(p.out + (size_t)t * Dm + col + 4 * hq);
            const f32x4 gv = *(const f32x4*)(pg + col + 4 * hq), gg = *(const f32x4*)(gf + col + 4 * hq);
#pragma unroll
            for (int e = 0; e < 4; ++e) xo[e] += gg[e] * (y[4 * hq + e] * rstd * gv[e]);
            *(f32x4*)(p.out + (size_t)t * Dm + col + 4 * hq) = xo;
        }
    }
}

#define XB_TMO      128
#define XB_XCNT(j)  (256  + 64 * (j))
#define XB_XSUB(j)  (1280 + 64 * (j))
#define XB_XGEN(j)  (2304 + 64 * (j))
#define XB_TOP      3328
#define XB_TOPGEN   3392
#define XCD_BAR_WORDS 3456
#define XB_SPIN_CAP (1u << 18)
__device__ __forceinline__ unsigned xb_ld(unsigned* p)              { return __hip_atomic_load(p, __ATOMIC_RELAXED, __HIP_MEMORY_SCOPE_AGENT); }
__device__ __forceinline__ unsigned xb_add(unsigned* p, unsigned v) { return __hip_atomic_fetch_add(p, v, __ATOMIC_RELAXED, __HIP_MEMORY_SCOPE_AGENT); }
__device__ __forceinline__ unsigned xb_xcc_id() { return (unsigned)__builtin_amdgcn_s_getreg((3 << 11) | 20) & 0xFu; }
#define XB_SPIN(cond, bar) do { unsigned _sp = 0; while (cond) { __builtin_amdgcn_s_sleep(1); \
    if ((++_sp & 255u) == 0u) { if (xb_ld(&(bar)[XB_TMO])) break; if (_sp > XB_SPIN_CAP) { atomicAdd(&(bar)[XB_TMO], 1u); break; } } } } while (0)
struct XcdBarrier { unsigned* bar; unsigned x; volatile LAS unsigned* st; };
__device__ __forceinline__ XcdBarrier xcd_barrier_post(unsigned* bar, volatile LAS unsigned* st) {
    XcdBarrier b; b.bar = bar; b.x = xb_xcc_id(); b.st = st;
    if (threadIdx.x == 0) (void)xb_add(&bar[XB_XCNT(b.x)], 1u);
    return b;
}
__device__ __forceinline__ void xcd_barrier_complete(unsigned* bar, unsigned x, unsigned& nloc, unsigned& nx) {
    const unsigned G = gridDim.x * gridDim.y * gridDim.z;
    unsigned sum, cnt, mine, sp = 0u;
    for (;;) {
        sum = 0u; cnt = 0u; mine = 0u;
#pragma unroll
        for (unsigned j = 0; j < 16; ++j) { const unsigned c = xb_ld(&bar[XB_XCNT(j)]); sum += c; cnt += (c > 0u) ? 1u : 0u; mine = (j == x) ? c : mine; }
        if (sum == G) break;
        __builtin_amdgcn_s_sleep(1);
        if ((++sp & 255u) == 0u) { if (xb_ld(&bar[XB_TMO])) break; if (sp > XB_SPIN_CAP) { atomicAdd(&bar[XB_TMO], 1u); break; } }
    }
    nloc = mine > 0u ? mine : 1u; nx = cnt > 0u ? cnt : 1u;
}
__device__ __forceinline__ void xcd_barrier(const Params& p, LAS char* L) {
    XcdBarrier b; b.bar = (unsigned*)(p.ws + WS_CTL + 4096); b.x = xb_xcc_id(); b.st = (volatile LAS unsigned*)(L + OFF_MISC);
    asm volatile("s_waitcnt vmcnt(0)" ::: "memory");
    __syncthreads();
    if (threadIdx.x == 0) {
        unsigned* bar = b.bar;
        __builtin_amdgcn_s_waitcnt(0);
        unsigned nloc = b.st[0], nx = b.st[1];
        if (nloc == 0u) { xcd_barrier_complete(bar, b.x, nloc, nx); b.st[0] = nloc; b.st[1] = nx; }
        const unsigned old = xb_add(&bar[XB_XSUB(b.x)], 1u);
        const unsigned gen = old / nloc;
        if (old + 1u == (gen + 1u) * nloc) {
            __builtin_amdgcn_fence(__ATOMIC_RELEASE, "agent");
            asm volatile("s_waitcnt vmcnt(0)" ::: "memory");
            const unsigned og = xb_add(&bar[XB_TOP], 1u);
            const unsigned tg = og / nx;
            if (og + 1u == (tg + 1u) * nx) xb_add(&bar[XB_TOPGEN], 1u);
            else XB_SPIN(xb_ld(&bar[XB_TOPGEN]) == tg, bar);
            __builtin_amdgcn_fence(__ATOMIC_ACQUIRE, "agent");
            xb_add(&bar[XB_XGEN(b.x)], 1u);
            asm volatile("s_waitcnt vmcnt(0)" ::: "memory");
        } else {
            XB_SPIN(xb_ld(&bar[XB_XGEN(b.x)]) == gen, bar);
            __builtin_amdgcn_fence(__ATOMIC_ACQUIRE, "agent");
            asm volatile("s_waitcnt vmcnt(0)" ::: "memory");
        }
    }
    __syncthreads();
}

__global__ void __launch_bounds__(NT, 2) mega(Params p) {
    extern __shared__ __attribute__((aligned(16))) char smem[];
    LAS char* L = (LAS char*)smem;
    if (threadIdx.x < 8) ((LAS unsigned*)(L + OFF_MISC))[threadIdx.x] = 0u;
    __syncthreads();
    (void)xcd_barrier_post((unsigned*)(p.ws + WS_CTL + 4096), (volatile LAS unsigned*)(L + OFF_MISC));
    phase_mod(p, L);
    xcd_barrier(p, L);
    phase_h1(p);
    xcd_barrier(p, L);
    _Pragma("nounroll") for (int rep_ = 0; rep_ < REP_PROJ; ++rep_) phase_proj(p, L);
    xcd_barrier(p, L);
    _Pragma("nounroll") for (int rep_ = 0; rep_ < REP_SMALL; ++rep_) phase_qkv(p, L);
    xcd_barrier(p, L);
    phase_attn(p, L);
    xcd_barrier(p, L);
    _Pragma("nounroll") for (int rep_ = 0; rep_ < REP_SMALL; ++rep_) phase_oproj(p, L);
    xcd_barrier(p, L);
    phase_post_attn(p);
    xcd_barrier(p, L);
    _Pragma("nounroll") for (int rep_ = 0; rep_ < REP_SMALL; ++rep_) phase_router(p, L);
    xcd_barrier(p, L);
    phase_route(p);
    xcd_barrier(p, L);
    _Pragma("nounroll") for (int rep_ = 0; rep_ < REP_MOE1; ++rep_) phase_moe1(p, L);
    xcd_barrier(p, L);
    _Pragma("nounroll") for (int rep_ = 0; rep_ < REP_MOE2; ++rep_) phase_moe2(p, L);
    xcd_barrier(p, L);
    phase_final(p);
}

extern "C" void kernel_launch(void* const* d_in, const int* in_sizes, int n_in, void* d_out, int out_size, void* d_ws, size_t ws_size, hipStream_t stream) {
    static int grid_blocks = 0;
    if (grid_blocks == 0) {
        if (n_in != 28 || out_size != T * Dm || ws_size < WS_END) {
            fprintf(stderr, "kernel_launch: unexpected problem (n_in %d, out %d, ws %zu); nothing launched\n", n_in, out_size, ws_size);
            grid_blocks = -1; return;
        }
        int dev = 0, cus = 0, per_cu = 0;
        (void)hipGetDevice(&dev);
        (void)hipDeviceGetAttribute(&cus, hipDeviceAttributeMultiprocessorCount, dev);
        if (hipFuncSetAttribute((const void*)mega, hipFuncAttributeMaxDynamicSharedMemorySize, LDS_BYTES) != hipSuccess) {
            fprintf(stderr, "kernel_launch: hipFuncSetAttribute(%d B LDS) failed\n", LDS_BYTES); grid_blocks = -1; return;
        }
        (void)hipOccupancyMaxActiveBlocksPerMultiprocessor(&per_cu, mega, NT, LDS_BYTES);
        if (per_cu < 1) { fprintf(stderr, "kernel_launch: occupancy query says %d blocks per CU\n", per_cu); per_cu = 1; }
        grid_blocks = cus;
        fprintf(stderr, "kernel_launch: %d CUs, occupancy query %d per CU, grid %d\n", cus, per_cu, grid_blocks);
    }
    if (grid_blocks < 0) return;
    (void)hipMemsetAsync((char*)d_ws + WS_CTL, 0, CTL_BYTES, stream);
    Params p{};
    for (int i = 0; i < 28; ++i) p.in[i] = (const float*)d_in[i];
    p.out = (float*)d_out; p.ws = (char*)d_ws;
    void* args[] = {&p};
    hipError_t e = hipLaunchCooperativeKernel((void*)mega, dim3(grid_blocks), dim3(NT), args, LDS_BYTES, stream);
    if (e != hipSuccess) fprintf(stderr, "cooperative launch failed: %s (grid %d)\n", hipGetErrorString(e), grid_blocks);
}
```

```cpp
#include <hip/hip_runtime.h>
#include <cstdio>
#include <cstdint>

#ifndef REP_PROJ
#define REP_PROJ 1
#endif
#ifndef REP_ATTN
#define REP_ATTN 1
#endif
#ifndef REP_MOE1
#define REP_MOE1 1
#endif
#ifndef REP_MOE2
#define REP_MOE2 1
#endif
#ifndef REP_SMALL
#define REP_SMALL 1
#endif

typedef unsigned short bf16_t;
typedef float f32x2 __attribute__((ext_vector_type(2)));
typedef short bf16x8 __attribute__((ext_vector_type(8)));
typedef short s16x4 __attribute__((ext_vector_type(4)));
typedef short v4i16_t __attribute__((ext_vector_type(4)));
typedef float f32x16 __attribute__((ext_vector_type(16)));
typedef float f32x4 __attribute__((ext_vector_type(4)));
typedef unsigned u32x4 __attribute__((ext_vector_type(4)));
typedef unsigned u32x2 __attribute__((ext_vector_type(2)));
#define LAS __attribute__((address_space(3)))

constexpr int NT = 512, NW = 8;
constexpr int Dm = 1024, NB = 8, SEQ = 2048, T = NB * SEQ;
constexpr int NIN = 1952;
constexpr int C_CQ = 0, C_CKV = 256, C_KR = 384, C_DQ = 416, C_DK = 928, C_DV = 1440;
constexpr int NE = 256, TOPK = 8, AR = T * TOPK, HROWS = AR + T;
constexpr int LISTCAP = T;
constexpr float LOG2E = 1.4426950408889634f;
constexpr float YSCALE = 32.f;
constexpr float LAMBDA_INIT = 0.2f;

constexpr size_t MiB = 1u << 20;
constexpr size_t WS_CTL = 0, CTL_BYTES = 65536;
constexpr size_t WS_MOD = 65536;
constexpr size_t WS_ROPE = 1 * MiB;
constexpr size_t WS_H1 = 4 * MiB;
constexpr size_t WS_PROJ = 36 * MiB;
constexpr size_t WS_CQN = 100 * MiB;
constexpr size_t WS_CKVN = 108 * MiB;
constexpr size_t WS_QM = 112 * MiB;
constexpr size_t WS_KF = 136 * MiB;
constexpr size_t WS_VM = 160 * MiB;
constexpr size_t WS_ATT = 176 * MiB;
constexpr size_t WS_OD0 = 208 * MiB;
constexpr size_t WS_Y1 = 240 * MiB;
constexpr size_t WS_H2 = 304 * MiB;
constexpr size_t WS_LOG = 336 * MiB;
constexpr size_t WS_LA = 352 * MiB;
constexpr size_t WS_LW = 368 * MiB;
constexpr size_t WS_HB = 384 * MiB;
constexpr size_t WS_YB = 456 * MiB;
constexpr size_t WS_WB = 744 * MiB;
constexpr size_t WB_IN = 0, WB_UQ = WB_IN + (size_t)1024 * 1952, WB_UKV = WB_UQ + 256 * 768, WB_O = WB_UKV + 128 * 1024, WB_R = WB_O + 1024 * 1024, WB_END = WB_R + 1024 * 256;
constexpr size_t WS_END = 760 * MiB;

constexpr int G_XB = 32768, G_WB = 36864, G_BUF = G_XB + G_WB, G_LDS = 2 * G_BUF;
constexpr int OFF_MISC = G_LDS, OFF_PRE = OFF_MISC + 64, OFF_TL = OFF_PRE + 1088;
constexpr int OFF_ROW = OFF_TL + 1088, OFF_RW = OFF_ROW + 1024;
constexpr int OFF_SS = OFF_RW + 1024;
constexpr int LDS_BYTES = G_LDS + 4352 + 4096;

struct Params {
    const float* in[28];
    float* out;
    char* ws;
};

__device__ __forceinline__ unsigned short f2bf(float f) { __bf16 b = (__bf16)f; return __builtin_bit_cast(unsigned short, b); }
typedef __bf16 bf16x2_t __attribute__((ext_vector_type(2)));
__device__ __forceinline__ unsigned pk2(float lo, float hi) { const f32x2 v = {lo, hi}; return __builtin_bit_cast(unsigned, __builtin_convertvector(v, bf16x2_t)); }
__device__ __forceinline__ float bf2f(unsigned short b) { return __uint_as_float(((unsigned)b) << 16); }
__device__ __forceinline__ float bflo(unsigned u) { return __uint_as_float(u << 16); }
__device__ __forceinline__ float bfhi(unsigned u) { return __uint_as_float(u & 0xffff0000u); }
__device__ __forceinline__ int crow(int r, int hi) { return (r & 3) + 8 * (r >> 2) + 4 * hi; }
__device__ __forceinline__ float shx(float v, int m, int lane) { return __int_as_float(__builtin_amdgcn_ds_bpermute((lane ^ m) << 2, __float_as_int(v))); }
__device__ __forceinline__ int shxi(int v, int m, int lane) { return __builtin_amdgcn_ds_bpermute((lane ^ m) << 2, v); }
__device__ __forceinline__ float shl(float v, int src) { return __int_as_float(__builtin_amdgcn_ds_bpermute(src << 2, __float_as_int(v))); }
__device__ __forceinline__ float wave_sum(float v, int lane) {
#pragma unroll
    for (int o = 32; o >= 1; o >>= 1) v += shx(v, o, lane);
    return v;
}
__device__ __forceinline__ float silu_f(float v) { return v / (1.f + __expf(-v)); }
__device__ __forceinline__ s16x4 tr_read(LAS char* p) {
    return __builtin_bit_cast(s16x4, __builtin_amdgcn_ds_read_tr16_b64_v4i16((LAS v4i16_t*)p));
}
__device__ __forceinline__ int otid() { int t = threadIdx.x; asm volatile("" : "+v"(t)); return t; }
__device__ __forceinline__ int grid_g() { return gridDim.x; }
__device__ __forceinline__ int vcu() { const int G = gridDim.x, bx = blockIdx.x; return (G % 8 == 0) ? (bx % 8) * (G / 8) + bx / 8 : bx; }
__device__ __forceinline__ void gld16(u32x4& d, const void* p) { asm volatile("global_load_dwordx4 %0, %1, off" : "+v"(d) : "v"(p) : "memory"); }
__device__ __forceinline__ void gld16(f32x4& d, const void* p) { asm volatile("global_load_dwordx4 %0, %1, off" : "+v"(d) : "v"(p) : "memory"); }
template <int N> __device__ __forceinline__ void vm_wait(u32x4& a, f32x4& b, f32x4& c) { asm volatile("s_waitcnt vmcnt(%3)" : "+v"(a), "+v"(b), "+v"(c) : "n"(N) : "memory"); }
template <int N> __device__ __forceinline__ void vm_wait(f32x4& b, f32x4& c) { asm volatile("s_waitcnt vmcnt(%2)" : "+v"(b), "+v"(c) : "n"(N) : "memory"); }
template <int N> __device__ __forceinline__ void vm_wait(u32x4& a, u32x4& b) { asm volatile("s_waitcnt vmcnt(%2)" : "+v"(a), "+v"(b) : "n"(N) : "memory"); }
template <int N> __device__ __forceinline__ void vm_wait(u32x4& b) { asm volatile("s_waitcnt vmcnt(%1)" : "+v"(b) : "n"(N) : "memory"); }
#define MFMA32(a, b, c) __builtin_amdgcn_mfma_f32_32x32x16_bf16(a, b, c, 0, 0, 0)

template <int NBMODE> __device__ __forceinline__ int nb_of(int wn, int ni) { return NBMODE == 0 ? 64 * wn + 32 * ni : 32 * wn + 128 * ni; }

template <int MI, int NBMODE, bool WBF = false, class AF, class BF, class EF>
__device__ __forceinline__ void gemm_tile(LAS char* L, int nk, long ldw, const bf16_t* abase, AF arow, BF bcol, EF epi) {
    asm volatile("" : "+s"(nk));
    const int tid = otid(), lane = tid & 63, wave = tid >> 6;
    const int wm = wave & 1, wn = wave >> 1, l31 = lane & 31, hi = lane >> 5;
    const int a_chunk = tid & 7, a_row = tid >> 3;
    const int a_w = a_row * 128 + 16 * (a_chunk ^ ((a_row >> 1) & 7));
    const int b_n4 = WBF ? (tid & 31) : (tid & 63), b_kr = WBF ? (tid >> 5) : (tid >> 6);
    const auto bp = bcol((WBF ? 8 : 4) * b_n4) + (long)b_kr * ldw;
    const int b_w = G_XB + b_kr * 576 + (WBF ? 16 : 8) * b_n4;
    const int sw = (l31 >> 1) & 7;
    const int xoff = (32 * MI * wm + l31) * 128;
    const int woff = G_XB + (8 * hi + ((lane & 15) >> 2)) * 576 + 2 * (16 * ((lane >> 4) & 1) + 4 * (lane & 3));
    u32x4 ra[MI]; f32x4 rb[8]; u32x4 rw[4];
#pragma unroll
    for (int i = 0; i < MI; ++i) ra[i] = (u32x4){0u, 0u, 0u, 0u};
#pragma unroll
    for (int i = 0; i < 8; ++i) rb[i] = (f32x4){0.f, 0.f, 0.f, 0.f};
#pragma unroll
    for (int i = 0; i < 4; ++i) rw[i] = (u32x4){0u, 0u, 0u, 0u};
#define G_LOADW(KOFF, Q) do { \
        if (WBF) { gld16(rw[Q], bp + (long)((KOFF) + 16 * (Q)) * ldw); } \
        else { gld16(rb[2 * (Q)], bp + (long)((KOFF) + 16 * (Q)) * ldw); gld16(rb[2 * (Q) + 1], bp + (long)((KOFF) + 16 * (Q) + 8) * ldw); } } while (0)
#define G_LOADQ(KT, Q) do { \
        if ((Q) < MI) gld16(ra[(Q) < MI ? (Q) : 0], abase + arow(a_row + 64 * (Q)) + a_chunk * 8 + (KT) * 64); \
        G_LOADW((KT) * 64, Q); } while (0)
#define G_LOADQ_SEL(KT, Q, OK) do { \
        const int kq_ = (OK) ? (KT) * 64 : 0; \
        if ((Q) < MI) gld16(ra[(Q) < MI ? (Q) : 0], abase + arow(a_row + 64 * (Q)) + a_chunk * 8 + kq_); \
        G_LOADW(kq_, Q); } while (0)
#define G_WAITQ(Q, N) do { \
        if (WBF) { if ((Q) < MI) vm_wait<N>(ra[(Q) < MI ? (Q) : 0], rw[Q]); else vm_wait<N>(rw[Q]); } \
        else { if ((Q) < MI) vm_wait<N>(ra[(Q) < MI ? (Q) : 0], rb[2 * (Q)], rb[2 * (Q) + 1]); else vm_wait<N>(rb[2 * (Q)], rb[2 * (Q) + 1]); } } while (0)
#define G_STOREQ(LP, Q) do { \
        if ((Q) < MI) *(LAS u32x4*)((LP) + a_w + (Q) * 8192) = ra[(Q) < MI ? (Q) : 0]; \
        if (WBF) { *(LAS u32x4*)((LP) + b_w + (Q) * 16 * 576) = rw[Q]; } else { \
        { u32x2 w; w.x = pk2(rb[2 * (Q)][0], rb[2 * (Q)][1]); w.y = pk2(rb[2 * (Q)][2], rb[2 * (Q)][3]); *(LAS u32x2*)((LP) + b_w + (Q) * 16 * 576) = w; } \
        { u32x2 w; w.x = pk2(rb[2 * (Q) + 1][0], rb[2 * (Q) + 1][1]); w.y = pk2(rb[2 * (Q) + 1][2], rb[2 * (Q) + 1][3]); *(LAS u32x2*)((LP) + b_w + (Q) * 16 * 576 + 8 * 576) = w; } } } while (0)
    constexpr int NLW = WBF ? 1 : 2;
    constexpr int NL0 = NLW + ((0 < MI) ? 1 : 0), NL1 = NLW + ((1 < MI) ? 1 : 0), NL2 = NLW + ((2 < MI) ? 1 : 0), NL3 = NLW + ((3 < MI) ? 1 : 0), NLT = NL0 + NL1 + NL2 + NL3;
    G_LOADQ(0, 0); G_LOADQ(0, 1); G_LOADQ(0, 2); G_LOADQ(0, 3);
    G_WAITQ(0, 0); G_WAITQ(1, 0); G_WAITQ(2, 0); G_WAITQ(3, 0);
    G_STOREQ(L, 0); G_STOREQ(L, 1); G_STOREQ(L, 2); G_STOREQ(L, 3);
    G_LOADQ(1, 0); G_LOADQ(1, 1); G_LOADQ(1, 2); G_LOADQ(1, 3);
    f32x16 acc[MI][2];
#pragma unroll
    for (int i = 0; i < MI; ++i)
#pragma unroll
        for (int j = 0; j < 2; ++j)
#pragma unroll
            for (int r = 0; r < 16; ++r) acc[i][j][r] = 0.f;
    __syncthreads();
#pragma nounroll
    for (int kt = 0; kt < nk; ++kt) {
        LAS char* Lb = L + (kt & 1) * G_BUF;
        LAS char* Ln = L + ((kt + 1) & 1) * G_BUF;
        const bool ld = kt + 2 < nk;
        bf16x8 xf[2][MI], wf[2][2];
#define LOAD_FRAGS(KS, B) do { \
            _Pragma("unroll") for (int mi = 0; mi < MI; ++mi) xf[B][mi] = *(LAS bf16x8*)(Lb + xoff + mi * 4096 + 16 * ((2 * (KS) + hi) ^ sw)); \
            _Pragma("unroll") for (int ni = 0; ni < 2; ++ni) { \
                LAS char* pp = Lb + woff + (KS) * 16 * 576 + 2 * nb_of<NBMODE>(wn, ni); \
                const s16x4 lo = tr_read(pp), h4 = tr_read(pp + 4 * 576); \
                wf[B][ni] = (bf16x8){lo[0], lo[1], lo[2], lo[3], h4[0], h4[1], h4[2], h4[3]}; } } while (0)
#define MMA_STEP(KS) do { \
            _Pragma("unroll") for (int mi = 0; mi < MI; ++mi) \
                _Pragma("unroll") for (int ni = 0; ni < 2; ++ni) acc[mi][ni] = MFMA32(wf[(KS) & 1][ni], xf[(KS) & 1][mi], acc[mi][ni]); } while (0)
#define STAGE_STEP(Q, NREST, NPREV) do { G_WAITQ(Q, (NREST) + (NPREV)); G_STOREQ(Ln, Q); G_LOADQ_SEL(kt + 2, Q, ld); } while (0)
        LOAD_FRAGS(0, 0);
        LOAD_FRAGS(1, 1); MMA_STEP(0); STAGE_STEP(0, NL1 + NL2 + NL3, 0);           __builtin_amdgcn_sched_barrier(0);
        LOAD_FRAGS(2, 0); MMA_STEP(1); STAGE_STEP(1, NL2 + NL3, NL0);               __builtin_amdgcn_sched_barrier(0);
        LOAD_FRAGS(3, 1); MMA_STEP(2); STAGE_STEP(2, NL3, NL0 + NL1);               __builtin_amdgcn_sched_barrier(0);
        MMA_STEP(3);                   STAGE_STEP(3, 0, NL0 + NL1 + NL2);           __builtin_amdgcn_sched_barrier(0);
#undef LOAD_FRAGS
#undef MMA_STEP
#undef STAGE_STEP
        __syncthreads();
    }
    G_WAITQ(0, 0); G_WAITQ(1, 0); G_WAITQ(2, 0); G_WAITQ(3, 0);
#undef G_LOADQ
#undef G_LOADQ_SEL
#undef G_LOADW
#undef G_WAITQ
#undef G_STOREQ
    (void)NLT;
    epi(acc);
}

template <int MI, int NC, class DF>
__device__ __forceinline__ void store_tile_bf16(LAS char* L, const f32x16 (&acc)[MI][2], DF dst) {
    constexpr int STR = NC * 2 + 16, CPR = NC / 8, BM = 64 * MI;
    const int tid = otid(), lane = tid & 63, wave = tid >> 6, wm = wave & 1, wn = wave >> 1, l31 = lane & 31, hi = lane >> 5;
#pragma unroll
    for (int mi = 0; mi < MI; ++mi)
#pragma unroll
        for (int ni = 0; ni < (NC == 256 ? 2 : 1); ++ni) {
            const int row = 32 * MI * wm + 32 * mi + l31, col = (NC == 256) ? nb_of<0>(wn, ni) : 32 * wn;
#pragma unroll
            for (int gq = 0; gq < 4; ++gq) {
                u32x2 w; w.x = pk2(acc[mi][ni][4 * gq], acc[mi][ni][4 * gq + 1]); w.y = pk2(acc[mi][ni][4 * gq + 2], acc[mi][ni][4 * gq + 3]);
                *(LAS u32x2*)(L + row * STR + 2 * (col + 8 * gq + 4 * hi)) = w;
            }
        }
    __syncthreads();
#pragma unroll
    for (int i = 0; i < (BM * CPR) / NT; ++i) {
        const int id = tid + NT * i, row = id / CPR, c = id % CPR;
        bf16_t* d = dst(row, c);
        if (d) *(u32x4*)d = *(LAS u32x4*)(L + row * STR + 16 * c);
    }
    __syncthreads();
}

template <int MI, class DF>
__device__ __forceinline__ void store_tile_fp8(LAS char* L, const f32x16 (&acc)[MI][2], DF dst) {
    constexpr int STR = 256 + 16, BM = 64 * MI;
    const int tid = otid(), lane = tid & 63, wave = tid >> 6, wm = wave & 1, wn = wave >> 1, l31 = lane & 31, hi = lane >> 5;
#pragma unroll
    for (int mi = 0; mi < MI; ++mi)
#pragma unroll
        for (int ni = 0; ni < 2; ++ni) {
            const int row = 32 * MI * wm + 32 * mi + l31, col = nb_of<0>(wn, ni);
#pragma unroll
            for (int gq = 0; gq < 4; ++gq) {
                int w = 0;
                w = __builtin_amdgcn_cvt_pk_fp8_f32(acc[mi][ni][4 * gq], acc[mi][ni][4 * gq + 1], w, false);
                w = __builtin_amdgcn_cvt_pk_fp8_f32(acc[mi][ni][4 * gq + 2], acc[mi][ni][4 * gq + 3], w, true);
                *(LAS int*)(L + row * STR + (col + 8 * gq + 4 * hi)) = w;
            }
        }
    __syncthreads();
#pragma unroll
    for (int i = 0; i < (BM * 16) / NT; ++i) {
        const int id = tid + NT * i, row = id >> 4, c = id & 15;
        unsigned char* d = dst(row, c);
        if (d) *(u32x4*)d = *(LAS u32x4*)(L + row * STR + 16 * c);
    }
    __syncthreads();
}

__device__ __forceinline__ void phase_mod(const Params& p, LAS char* L) {
    const int v = vcu(), G = grid_g();
    const int tid = otid();
    const float* c = p.in[1]; const float* w_ada = p.in[3]; const float* b_ada = p.in[4];
    float* mod = (float*)(p.ws + WS_MOD);
    LAS float* sc = (LAS float*)L;
    LAS float* red = (LAS float*)(L + 32768);
    bool filled = false;
    for (int item = v; item < 384; item += G) {
        if (!filled) {
            for (int i = tid; i < 8 * 1024; i += NT) sc[i] = silu_f(c[i]);
            __syncthreads(); filled = true;
        }
        const int cx = tid & 15, kl = tid >> 4, col = item * 16 + cx;
        float a[8];
#pragma unroll
        for (int b = 0; b < 8; ++b) a[b] = 0.f;
#pragma unroll 4
        for (int k = kl; k < 1024; k += 32) {
            const float w = w_ada[(size_t)k * 6144 + col];
#pragma unroll
            for (int b = 0; b < 8; ++b) a[b] += sc[b * 1024 + k] * w;
        }
#pragma unroll
        for (int b = 0; b < 8; ++b) red[(b * 32 + kl) * 16 + cx] = a[b];
        __syncthreads();
        if (tid < 128) {
            const int b = tid >> 4, cc = tid & 15; float s = 0.f;
#pragma unroll
            for (int k = 0; k < 32; ++k) s += red[(b * 32 + k) * 16 + cc];
            mod[b * 6144 + item * 16 + cc] = s + b_ada[item * 16 + cc];
        }
        __syncthreads();
    }
    {
        bf16_t* wb = (bf16_t*)(p.ws + WS_WB);
        const size_t gt = (size_t)v * NT + tid, gs = (size_t)G * NT;
        auto conv = [&](const float* src, size_t off, size_t n) {
            for (size_t i = gt; i < n / 4; i += gs) { const f32x4 f = *(const f32x4*)(src + 4 * i); u32x2 w; w.x = pk2(f[0], f[1]); w.y = pk2(f[2], f[3]); *(u32x2*)(wb + off + 4 * i) = w; }
        };
        auto convg = [&](const float* src, size_t off, size_t n, int ncol, const float* gain) {
            for (size_t i = gt; i < n / 4; i += gs) { const float gk = gain[(4 * i) / ncol]; const f32x4 f = *(const f32x4*)(src + 4 * i); u32x2 w; w.x = pk2(f[0] * gk, f[1] * gk); w.y = pk2(f[2] * gk, f[3] * gk); *(u32x2*)(wb + off + 4 * i) = w; }
        };
        conv(p.in[7], WB_IN, (size_t)1024 * 1952); convg(p.in[10], WB_UQ, (size_t)256 * 768, 768, p.in[8]); convg(p.in[11], WB_UKV, (size_t)128 * 1024, 1024, p.in[9]);
        conv(p.in[17], WB_O, (size_t)1024 * 1024); conv(p.in[20], WB_R, (size_t)1024 * 256);
    }
}

__device__ __forceinline__ void phase_h1(const Params& p) {
    const int v = vcu(), G = grid_g();
    const int tid = otid(), lane = tid & 63, wave = tid >> 6;
    const float* x = p.in[0]; const int* positions = (const int*)p.in[2]; const float* g = p.in[5];
    const float* mod = (const float*)(p.ws + WS_MOD);
    bf16_t* h1 = (bf16_t*)(p.ws + WS_H1);
    f32x2* rope = (f32x2*)(p.ws + WS_ROPE);
    for (int t = v * NW + wave; t < T; t += G * NW) {
        const int b = t / SEQ;
        const f32x4* xr = (const f32x4*)(x + (size_t)t * Dm);
        f32x4 xv[4]; float ss = 0.f;
#pragma unroll
        for (int j = 0; j < 4; ++j) { xv[j] = xr[lane + 64 * j]; ss += xv[j][0] * xv[j][0] + xv[j][1] * xv[j][1] + xv[j][2] * xv[j][2] + xv[j][3] * xv[j][3]; }
        ss = wave_sum(ss, lane);
        const float rstd = rsqrtf(ss * (1.f / Dm) + 1e-6f);
        const float* sh = mod + b * 6144; const float* scl = sh + 1024;
#pragma unroll
        for (int j = 0; j < 4; ++j) {
            const int col = 4 * (lane + 64 * j);
            const f32x4 gv = *(const f32x4*)(g + col), sv = *(const f32x4*)(scl + col), hv = *(const f32x4*)(sh + col);
            float o[4];
#pragma unroll
            for (int e = 0; e < 4; ++e) o[e] = (xv[j][e] * rstd * gv[e]) * (1.f + sv[e]) + hv[e];
            u32x2 w; w.x = pk2(o[0], o[1]); w.y = pk2(o[2], o[3]);
            *(u32x2*)(h1 + (size_t)t * Dm + col) = w;
        }
        if (lane < 16) {
            const double inv = exp2(-(double)lane * (13.287712379549449 / 16.0));
            const double rev = (double)positions[t] * inv * 0.15915494309189535;
            const float fr = (float)(rev - rint(rev));
            f32x2 cs; cs.x = __builtin_amdgcn_cosf(fr); cs.y = __builtin_amdgcn_sinf(fr);
            rope[(size_t)t * 16 + lane] = cs;
        }
    }
}

__device__ __forceinline__ void phase_proj(const Params& p, LAS char* L) {
    const int v = vcu(), G = grid_g();
    const bf16_t* h1 = (const bf16_t*)(p.ws + WS_H1);
    const bf16_t* w_in = (const bf16_t*)(p.ws + WS_WB) + WB_IN;
    bf16_t* proj = (bf16_t*)(p.ws + WS_PROJ);
    const f32x2* rope = (const f32x2*)(p.ws + WS_ROPE);
    for (int u = v; u < 64 * 8; u += G) {
        const int mt = u >> 3, nt = u & 7, m0 = mt * 256, n0 = nt * 256;
        auto arow = [&](int r) { return (unsigned)(m0 + r) * Dm; };
        auto bcol = [&](int c) { int col = n0 + c; if (col > NIN - 8) col = NIN - 8; return w_in + col; };
        auto epi = [&](f32x16 (&acc)[4][2]) {
            const int tid_ = otid(), lane = tid_ & 63, wave = tid_ >> 6, wm = wave & 1, wn = wave >> 1, l31 = lane & 31, hi = lane >> 5;
            if (nt < 2) {
                LAS float* ssl = (LAS float*)(L + OFF_SS);
                const bool contrib = (nt == 0) || (wn < 2);
#pragma unroll
                for (int mi = 0; mi < 4; ++mi) {
                    float part = 0.f;
#pragma unroll
                    for (int ni = 0; ni < 2; ++ni)
#pragma unroll
                        for (int r = 0; r < 16; ++r) part += acc[mi][ni][r] * acc[mi][ni][r];
                    part += shx(part, 32, lane);
                    if (hi == 0) ssl[(128 * wm + 32 * mi + l31) * 4 + wn] = contrib ? part : 0.f;
                }
                __syncthreads();
                if (tid_ < 256) {
                    const f32x4 q4 = *(LAS f32x4*)(ssl + tid_ * 4);
                    const float ssum = (q4[0] + q4[1]) + (q4[2] + q4[3]);
                    float* rs = (float*)(p.ws + WS_CQN) + (nt == 0 ? 0 : (1 << 18));
                    rs[m0 + tid_] = rsqrtf(ssum * (nt == 0 ? 1.f / 256.f : 1.f / 128.f) + 1e-6f);
                }
            }
#pragma unroll
            for (int ni = 0; ni < 2; ++ni) {
                const int nbg = n0 + nb_of<0>(wn, ni);
                if (nbg == C_KR) {
#pragma unroll
                    for (int mi = 0; mi < 4; ++mi) {
                        const int m = m0 + 128 * wm + 32 * mi + l31;
#pragma unroll
                        for (int r = 0; r < 8; ++r) {
                            const f32x2 cs = rope[(size_t)m * 16 + crow(r, hi)];
                            const float x1 = acc[mi][ni][r], x2 = acc[mi][ni][r + 8];
                            acc[mi][ni][r] = x1 * cs.x - x2 * cs.y; acc[mi][ni][r + 8] = x2 * cs.x + x1 * cs.y;
                        }
                    }
                }
                if (nbg >= C_DQ && nbg < C_DK) {
#pragma unroll
                    for (int mi = 0; mi < 4; ++mi)
#pragma unroll
                        for (int r = 0; r < 16; ++r) acc[mi][ni][r] *= 0.125f * LOG2E;
                }
            }
            store_tile_bf16<4, 256>(L, acc, [&](int row, int c) -> bf16_t* { const int col = n0 + 8 * c; return col < NIN ? proj + (size_t)(m0 + row) * NIN + col : nullptr; });
        };
        gemm_tile<4, 0, true>(L, Dm / 64, NIN, h1, arow, bcol, epi);
    }
}

__device__ __forceinline__ void phase_norms(const Params& p) {
    const int v = vcu(), G = grid_g();
    const int tid = otid(), lane = tid & 63, wave = tid >> 6;
    const bf16_t* proj = (const bf16_t*)(p.ws + WS_PROJ);
    const float* qg = p.in[8]; const float* kvg = p.in[9];
    bf16_t* cqn = (bf16_t*)(p.ws + WS_CQN); bf16_t* ckvn = (bf16_t*)(p.ws + WS_CKVN); bf16_t* kf = (bf16_t*)(p.ws + WS_KF);
    const f32x2* rope = (const f32x2*)(p.ws + WS_ROPE);
    for (int t = v * NW + wave; t < T; t += G * NW) {
        const bf16_t* pr = proj + (size_t)t * NIN;
        {
            const u32x2 raw = *(const u32x2*)(pr + C_CQ + 4 * lane);
            float a[4] = {bflo(raw.x), bfhi(raw.x), bflo(raw.y), bfhi(raw.y)};
            float ss = wave_sum(a[0] * a[0] + a[1] * a[1] + a[2] * a[2] + a[3] * a[3], lane);
            const float rstd = rsqrtf(ss * (1.f / 256.f) + 1e-6f);
            const f32x4 gv = *(const f32x4*)(qg + 4 * lane);
            u32x2 w; w.x = pk2(a[0] * rstd * gv[0], a[1] * rstd * gv[1]); w.y = pk2(a[2] * rstd * gv[2], a[3] * rstd * gv[3]);
            *(u32x2*)(cqn + (size_t)t * 256 + 4 * lane) = w;
        }
        {
            const unsigned raw = *(const unsigned*)(pr + C_CKV + 2 * lane);
            const float a0 = bflo(raw), a1 = bfhi(raw);
            float ss = wave_sum(a0 * a0 + a1 * a1, lane);
            const float rstd = rsqrtf(ss * (1.f / 128.f) + 1e-6f);
            *(unsigned*)(ckvn + (size_t)t * 128 + 2 * lane) = pk2(a0 * rstd * kvg[2 * lane], a1 * rstd * kvg[2 * lane + 1]);
        }
        if (lane < 16) {
            const float x1 = bf2f(pr[C_KR + lane]), x2 = bf2f(pr[C_KR + 16 + lane]);
            const f32x2 cs = rope[(size_t)t * 16 + lane];
            const bf16_t y1 = f2bf(x1 * cs.x - x2 * cs.y), y2 = f2bf(x2 * cs.x + x1 * cs.y);
#pragma unroll
            for (int h = 0; h < 8; ++h) { kf[(size_t)t * 768 + h * 96 + 64 + lane] = y1; kf[(size_t)t * 768 + h * 96 + 80 + lane] = y2; }
        }
    }
}

__device__ __forceinline__ void phase_qkv(const Params& p, LAS char* L) {
    const int v = vcu(), G = grid_g();
    const bf16_t* proj = (const bf16_t*)(p.ws + WS_PROJ);
    const float* rstd_q = (const float*)(p.ws + WS_CQN); const float* rstd_kv = rstd_q + (1 << 18);
    const bf16_t* w_uq = (const bf16_t*)(p.ws + WS_WB) + WB_UQ; const bf16_t* w_ukv = (const bf16_t*)(p.ws + WS_WB) + WB_UKV;
    bf16_t* qm = (bf16_t*)(p.ws + WS_QM); bf16_t* kf = (bf16_t*)(p.ws + WS_KF); bf16_t* vm = (bf16_t*)(p.ws + WS_VM);
    const f32x2* rope = (const f32x2*)(p.ws + WS_ROPE);
    const float qscale = LOG2E * 0.10206207261596575f;
    for (int u = v; u < 64 * 7; u += G) {
        const int mt = u / 7, j = u % 7, m0 = mt * 256;
        if (j < 3) {
            const int n0 = j * 256;
            auto arow = [&](int r) { return (unsigned)(m0 + r) * NIN + C_CQ; };
            auto bcol = [&](int c) { return w_uq + n0 + c; };
            auto epi = [&](f32x16 (&acc)[4][2]) {
                const int tid_ = otid(), lane = tid_ & 63, wave = tid_ >> 6, wm = wave & 1, wn = wave >> 1, l31 = lane & 31, hi = lane >> 5;
#pragma unroll
                for (int mi = 0; mi < 4; ++mi) {
                    const int m = m0 + 128 * wm + 32 * mi + l31;
                    const float qs = qscale * rstd_q[m];
#pragma unroll
                    for (int ni = 0; ni < 2; ++ni) {
                        const int nbg = n0 + nb_of<0>(wn, ni);
                        if ((nbg % 96) == 64) {
#pragma unroll
                            for (int r = 0; r < 8; ++r) {
                                const f32x2 cs = rope[(size_t)m * 16 + crow(r, hi)];
                                const float x1 = acc[mi][ni][r], x2 = acc[mi][ni][r + 8];
                                acc[mi][ni][r] = x1 * cs.x - x2 * cs.y; acc[mi][ni][r + 8] = x2 * cs.x + x1 * cs.y;
                            }
                        }
#pragma unroll
                        for (int r = 0; r < 16; ++r) acc[mi][ni][r] *= qs;
                    }
                }
                store_tile_bf16<4, 256>(L, acc, [&](int row, int c) -> bf16_t* { return qm + (size_t)(m0 + row) * 768 + n0 + 8 * c; });
            };
            gemm_tile<4, 0, true>(L, 256 / 64, 768, proj, arow, bcol, epi);
        } else {
            const int n0 = (j - 3) * 256;
            auto arow = [&](int r) { return (unsigned)(m0 + r) * NIN + C_CKV; };
            auto bcol = [&](int c) { return w_ukv + n0 + c; };
            auto epi = [&](f32x16 (&acc)[4][2]) {
                {
                    const int tid_ = otid(), lane = tid_ & 63, wave = tid_ >> 6, wm = wave & 1, l31 = lane & 31;
#pragma unroll
                    for (int mi = 0; mi < 4; ++mi) {
                        const float rs = rstd_kv[m0 + 128 * wm + 32 * mi + l31];
#pragma unroll
                        for (int ni = 0; ni < 2; ++ni)
#pragma unroll
                            for (int r = 0; r < 16; ++r) acc[mi][ni][r] *= rs;
                    }
                }
                store_tile_bf16<4, 256>(L, acc, [&](int row, int c) -> bf16_t* {
                    const int h = (n0 >> 7) + (c >> 4), cc = c & 15;
                    return cc < 8 ? kf + (size_t)(m0 + row) * 768 + h * 96 + 8 * cc : vm + (size_t)(m0 + row) * 512 + h * 64 + 8 * (cc - 8); });
            };
            gemm_tile<4, 0, true>(L, 128 / 64, 1024, proj, arow, bcol, epi);
        }
    }
}

template <int DQK, int DV, bool ALIBI>
__device__ __forceinline__ void attn_map(LAS char* L, const bf16_t* Q, int ldq, const bf16_t* K, int ldk, const bf16_t* V, int ldv,
                                         const int* posrow, float slope2, int q0, f32x16 (&o)[DV / 32], const bf16_t* K2 = nullptr, int ldk2 = 0) {
    constexpr int KSTR = DQK * 2 + 16, VSTR = DV * 2 + 64, KS = DQK / 16, ND = DV / 32;
    constexpr int K_OFF = 0, V_OFF = 64 * KSTR, P_OFF = V_OFF + 64 * VSTR, ABUF = P_OFF + 256;
    constexpr int KCH = DQK / 8, VCH = DV / 8;
    constexpr int NKI = (64 * KCH + NT - 1) / NT, NVI = (64 * VCH + NT - 1) / NT;
    const int tid = otid();
    const int lane = tid & 63, wave = tid >> 6, l31 = lane & 31, hi = lane >> 5;
    const int qrow = q0 + 32 * wave + l31;
    unsigned kgo[NKI], klo[NKI], vgo[NVI], vlo[NVI];
    bool k2s[NKI];
#pragma unroll
    for (int i = 0; i < NKI; ++i) { int c = tid + NT * i; if (c >= 64 * KCH) c = 64 * KCH - 1; const int row = c / KCH, ch = c % KCH; k2s[i] = (DQK == 96) && (ch >= 8);
        kgo[i] = k2s[i] ? (unsigned)(row * ldk2 + (ch - 8) * 8) * 2u : (unsigned)(row * ldk + ch * 8) * 2u; klo[i] = K_OFF + row * KSTR + ch * 16; }
#pragma unroll
    for (int i = 0; i < NVI; ++i) { int c = tid + NT * i; if (c >= 64 * VCH) c = 64 * VCH - 1; const int row = c / VCH, ch = c % VCH; vgo[i] = (unsigned)(row * ldv + ch * 8) * 2u; vlo[i] = V_OFF + row * VSTR + ch * 16; }
    bf16x8 qf[KS];
#pragma unroll
    for (int s = 0; s < KS; ++s) qf[s] = *(const bf16x8*)(Q + (size_t)qrow * ldq + 16 * s + 8 * hi);
    const float posq = ALIBI ? (float)posrow[qrow] : 0.f;
#pragma unroll
    for (int d = 0; d < ND; ++d)
#pragma unroll
        for (int r = 0; r < 16; ++r) o[d][r] = 0.f;
    float m_run = -1e30f, l_run = 0.f;
    const int ntile = (q0 + 256) / 64;
    const int qmin = q0 + 32 * wave, qmax = qmin + 31;
    const int vrd = V_OFF + (4 * hi + ((lane & 15) >> 2)) * VSTR + 2 * (16 * ((lane >> 4) & 1) + 4 * (lane & 3));
    u32x4 rk[NKI], rv[NVI]; float rp = 0.f;
#pragma unroll
    for (int i = 0; i < NKI; ++i) rk[i] = *(const u32x4*)((k2s[i] ? (const char*)K2 : (const char*)K) + kgo[i]);
#pragma unroll
    for (int i = 0; i < NVI; ++i) rv[i] = *(const u32x4*)((const char*)V + vgo[i]);
    if (ALIBI && tid < 64) rp = (float)posrow[tid];
    __syncthreads();
#pragma unroll
    for (int i = 0; i < NKI; ++i) if (tid + NT * i < 64 * KCH) *(LAS u32x4*)(L + klo[i]) = rk[i];
#pragma unroll
    for (int i = 0; i < NVI; ++i) if (tid + NT * i < 64 * VCH) *(LAS u32x4*)(L + vlo[i]) = rv[i];
    if (ALIBI && tid < 64) *(LAS float*)(L + P_OFF + 4 * tid) = rp;
    __syncthreads();
    for (int tl = 0; tl < ntile; ++tl) {
        const int kb = tl * 64;
        LAS char* Lb = L + (tl & 1) * ABUF;
        LAS char* Ln = L + ((tl + 1) & 1) * ABUF;
        const bool more = tl + 1 < ntile;
        if (more) {
            const char* kbase = (const char*)(K + (size_t)(kb + 64) * ldk);
            const char* kbase2 = (const char*)(K2 + (size_t)(kb + 64) * ldk2);
            const char* vbase = (const char*)(V + (size_t)(kb + 64) * ldv);
#pragma unroll
            for (int i = 0; i < NKI; ++i) rk[i] = *(const u32x4*)((k2s[i] ? kbase2 : kbase) + kgo[i]);
#pragma unroll
            for (int i = 0; i < NVI; ++i) rv[i] = *(const u32x4*)(vbase + vgo[i]);
            if (ALIBI && tid < 64) rp = (float)posrow[kb + 64 + tid];
        }
        if (kb <= qmax) {
            f32x16 s0, s1;
#pragma unroll
            for (int r = 0; r < 16; ++r) { s0[r] = 0.f; s1[r] = 0.f; }
#pragma unroll
            for (int s = 0; s < KS; ++s) {
                const bf16x8 k0 = *(LAS bf16x8*)(Lb + K_OFF + l31 * KSTR + 32 * s + 16 * hi);
                const bf16x8 k1 = *(LAS bf16x8*)(Lb + K_OFF + (32 + l31) * KSTR + 32 * s + 16 * hi);
                s0 = MFMA32(k0, qf[s], s0); s1 = MFMA32(k1, qf[s], s1);
            }
            if (ALIBI) {
#pragma unroll
                for (int r = 0; r < 16; ++r) {
                    const float pk0 = *(LAS float*)(Lb + P_OFF + 4 * crow(r, hi)), pk1 = *(LAS float*)(Lb + P_OFF + 4 * (32 + crow(r, hi)));
                    s0[r] -= slope2 * fabsf(posq - pk0); s1[r] -= slope2 * fabsf(posq - pk1);
                }
            }
            if (kb + 63 > qmin) {
#pragma unroll
                for (int r = 0; r < 16; ++r) {
                    const int key = kb + crow(r, hi);
                    if (key > qrow) s0[r] = -INFINITY;
                    if (key + 32 > qrow) s1[r] = -INFINITY;
                }
            }
            float mx = s0[0];
#pragma unroll
            for (int r = 1; r < 16; ++r) mx = fmaxf(mx, s0[r]);
#pragma unroll
            for (int r = 0; r < 16; ++r) mx = fmaxf(mx, s1[r]);
            mx = fmaxf(mx, shx(mx, 32, lane));
            const float m_new = fmaxf(m_run, mx);
            const float alpha = __builtin_amdgcn_exp2f(m_run - m_new);
            m_run = m_new;
            float ls = 0.f;
#pragma unroll
            for (int r = 0; r < 16; ++r) { s0[r] = __builtin_amdgcn_exp2f(s0[r] - m_new); s1[r] = __builtin_amdgcn_exp2f(s1[r] - m_new); ls += s0[r] + s1[r]; }
            l_run = l_run * alpha + ls;
#pragma unroll
            for (int d = 0; d < ND; ++d)
#pragma unroll
                for (int r = 0; r < 16; ++r) o[d][r] *= alpha;
            u32x4 pw[4];
#pragma unroll
            for (int j = 0; j < 4; ++j) {
                pw[0][j] = pk2(s0[2 * j], s0[2 * j + 1]); pw[1][j] = pk2(s0[8 + 2 * j], s0[8 + 2 * j + 1]);
                pw[2][j] = pk2(s1[2 * j], s1[2 * j + 1]); pw[3][j] = pk2(s1[8 + 2 * j], s1[8 + 2 * j + 1]);
            }
#pragma unroll
            for (int s = 0; s < 4; ++s) {
                const bf16x8 pf = __builtin_bit_cast(bf16x8, pw[s]);
#pragma unroll
                for (int d = 0; d < ND; ++d) {
                    LAS char* vp = Lb + vrd + 16 * s * VSTR + 64 * d;
                    const s16x4 lo = tr_read(vp), h4 = tr_read(vp + 8 * VSTR);
                    const bf16x8 vf = (bf16x8){lo[0], lo[1], lo[2], lo[3], h4[0], h4[1], h4[2], h4[3]};
                    o[d] = MFMA32(vf, pf, o[d]);
                }
                __builtin_amdgcn_sched_barrier(0);
            }
        }
        if (more) {
#pragma unroll
            for (int i = 0; i < NKI; ++i) if (tid + NT * i < 64 * KCH) *(LAS u32x4*)(Ln + klo[i]) = rk[i];
#pragma unroll
            for (int i = 0; i < NVI; ++i) if (tid + NT * i < 64 * VCH) *(LAS u32x4*)(Ln + vlo[i]) = rv[i];
            if (ALIBI && tid < 64) *(LAS float*)(Ln + P_OFF + 4 * tid) = rp;
        }
        __syncthreads();
    }
    const float lt = l_run + shx(l_run, 32, lane);
    const float inv = 1.f / lt;
#pragma unroll
    for (int d = 0; d < ND; ++d)
#pragma unroll
        for (int r = 0; r < 16; ++r) o[d][r] *= inv;
}

__device__ __forceinline__ void attn_decode(int it, int& kind, int& qb, int& idx) {
    const int seg_kind[16] = {1, 1, 1, 1, 1, 0, 1, 0, 0, 0, 1, 0, 0, 1, 0, 0};
    const int seg_qb[16]   = {7, 6, 5, 4, 3, 7, 2, 6, 5, 4, 1, 3, 2, 0, 1, 0};
    int base = 0; kind = 0; qb = 0; idx = 0;
#pragma unroll
    for (int s = 0; s < 16; ++s) {
        const int n = seg_kind[s] ? 32 : 64;
        if (it >= base && it < base + n) { kind = seg_kind[s]; qb = seg_qb[s]; idx = it - base; }
        base += n;
    }
}

__device__ __forceinline__ void phase_attn(const Params& p, LAS char* L) {
    const int v = vcu(), G = grid_g();
    const int tid = otid(), lane = tid & 63, wave = tid >> 6, l31 = lane & 31, hi = lane >> 5;
    const int* positions = (const int*)p.in[2];
    const bf16_t* proj = (const bf16_t*)(p.ws + WS_PROJ);
    const bf16_t* qm = (const bf16_t*)(p.ws + WS_QM); const bf16_t* kf = (const bf16_t*)(p.ws + WS_KF); const bf16_t* vm = (const bf16_t*)(p.ws + WS_VM);
    bf16_t* att = (bf16_t*)(p.ws + WS_ATT);
    float* od0 = (float*)(p.ws + WS_OD0);
    const float* subg = p.in[16];
    unsigned* qctr = (unsigned*)(p.ws + WS_CTL + 2048);
    LAS unsigned* qslot = (LAS unsigned*)(L + OFF_MISC + 16);
    float lam;
    {
        const float a = p.in[12][lane] * p.in[13][lane], b = p.in[14][lane] * p.in[15][lane];
        lam = __expf(wave_sum(a, lane)) - __expf(wave_sum(b, lane)) + LAMBDA_INIT;
    }
    for (;;) {
        if (tid == 0) *qslot = __hip_atomic_fetch_add(qctr, 1u, __ATOMIC_RELAXED, __HIP_MEMORY_SCOPE_AGENT);
        __syncthreads();
        const int it = (int)*qslot;
        __syncthreads();
        if (it >= 768) break;
        int kind, qb, idx;
        attn_decode(it, kind, qb, idx);
        const int q0 = qb * 256;
        if (kind == 0) {
            const int b = idx >> 3, h = idx & 7; const size_t tb = (size_t)b * SEQ;
            f32x16 o[2];
            attn_map<96, 64, false>(L, qm + tb * 768 + h * 96, 768, kf + tb * 768 + h * 96, 768, vm + tb * 512 + h * 64, 512, positions + tb, 0.f, q0, o, proj + tb * NIN + C_KR, NIN);
            const size_t t = tb + q0 + 32 * wave + l31;
#pragma unroll
            for (int d = 0; d < 2; ++d)
#pragma unroll
                for (int gq = 0; gq < 4; ++gq) {
                    u32x2 w; w.x = pk2(o[d][4 * gq], o[d][4 * gq + 1]); w.y = pk2(o[d][4 * gq + 2], o[d][4 * gq + 3]);
                    *(u32x2*)(att + t * 1024 + h * 64 + 32 * d + 8 * gq + 4 * hi) = w;
                }
        } else {
            const int b = idx >> 2, h = idx & 3; const size_t tb = (size_t)b * SEQ;
            const float slope2 = exp2f(-2.f * (h + 1)) * LOG2E;
            const size_t t = tb + q0 + 32 * wave + l31;
            f32x16 o[4];
            attn_map<64, 128, true>(L, proj + tb * NIN + C_DQ + h * 128, NIN, proj + tb * NIN + C_DK + h * 128, NIN, proj + tb * NIN + C_DV + h * 128, NIN, positions + tb, slope2, q0, o);
#pragma unroll
            for (int d = 0; d < 4; ++d)
#pragma unroll
                for (int gq = 0; gq < 4; ++gq) {
                    f32x4 w = {o[d][4 * gq], o[d][4 * gq + 1], o[d][4 * gq + 2], o[d][4 * gq + 3]};
                    *(f32x4*)(od0 + t * 512 + h * 128 + 32 * d + 8 * gq + 4 * hi) = w;
                }
            attn_map<64, 128, true>(L, proj + tb * NIN + C_DQ + h * 128 + 64, NIN, proj + tb * NIN + C_DK + h * 128 + 64, NIN, proj + tb * NIN + C_DV + h * 128, NIN, positions + tb, slope2, q0, o);
            float ss = 0.f;
#pragma unroll
            for (int d = 0; d < 4; ++d)
#pragma unroll
                for (int gq = 0; gq < 4; ++gq) {
                    const f32x4 w = *(const f32x4*)(od0 + t * 512 + h * 128 + 32 * d + 8 * gq + 4 * hi);
#pragma unroll
                    for (int e = 0; e < 4; ++e) { const float c = w[e] - lam * o[d][4 * gq + e]; o[d][4 * gq + e] = c; ss += c * c; }
                }
            ss += shx(ss, 32, lane);
            const float rstd = rsqrtf(ss * (1.f / 128.f) + 1e-5f) * (1.f - LAMBDA_INIT);
#pragma unroll
            for (int d = 0; d < 4; ++d)
#pragma unroll
                for (int gq = 0; gq < 4; ++gq) {
                    const int dv = 32 * d + 8 * gq + 4 * hi;
                    const f32x4 gv = *(const f32x4*)(subg + dv);
                    u32x2 w; w.x = pk2(o[d][4 * gq] * rstd * gv[0], o[d][4 * gq + 1] * rstd * gv[1]); w.y = pk2(o[d][4 * gq + 2] * rstd * gv[2], o[d][4 * gq + 3] * rstd * gv[3]);
                    *(u32x2*)(att + t * 1024 + 512 + h * 128 + dv) = w;
                }
        }
    }
}

__device__ __forceinline__ void phase_oproj(const Params& p, LAS char* L) {
    const int v = vcu(), G = grid_g();
    const bf16_t* att = (const bf16_t*)(p.ws + WS_ATT);
    const bf16_t* w_o = (const bf16_t*)(p.ws + WS_WB) + WB_O;
    bf16_t* y1 = (bf16_t*)(p.ws + WS_Y1);
    for (int u = v; u < 64 * 4; u += G) {
        const int mt = u >> 2, nt = u & 3, m0 = mt * 256, n0 = nt * 256;
        auto arow = [&](int r) { return (unsigned)(m0 + r) * Dm; };
        auto bcol = [&](int c) { return w_o + n0 + c; };
        auto epi = [&](f32x16 (&acc)[4][2]) {
            store_tile_bf16<4, 256>(L, acc, [&](int row, int c) -> bf16_t* { return y1 + (size_t)(m0 + row) * Dm + n0 + 8 * c; });
        };
        gemm_tile<4, 0, true>(L, Dm / 64, Dm, att, arow, bcol, epi);
    }
}

__device__ __forceinline__ void phase_post_attn(const Params& p) {
    const int v = vcu(), G = grid_g();
    const int tid = otid(), lane = tid & 63, wave = tid >> 6;
    const float* x = p.in[0]; const float* pg = p.in[6]; const float* fg = p.in[18];
    const float* mod = (const float*)(p.ws + WS_MOD);
    const bf16_t* y1 = (const bf16_t*)(p.ws + WS_Y1);
    bf16_t* h2 = (bf16_t*)(p.ws + WS_H2);
    for (int t = v * NW + wave; t < T; t += G * NW) {
        const int b = t / SEQ;
        const float* mb = mod + b * 6144;
        f32x4 yv[4], xv[4]; float ss = 0.f;
#pragma unroll
        for (int j = 0; j < 4; ++j) {
            const u32x2 raw = *(const u32x2*)(y1 + (size_t)t * Dm + 4 * (lane + 64 * j));
            yv[j] = (f32x4){bflo(raw.x), bfhi(raw.x), bflo(raw.y), bfhi(raw.y)};
            xv[j] = *(const f32x4*)(x + (size_t)t * Dm + 4 * (lane + 64 * j));
            ss += yv[j][0] * yv[j][0] + yv[j][1] * yv[j][1] + yv[j][2] * yv[j][2] + yv[j][3] * yv[j][3];
        }
        ss = wave_sum(ss, lane);
        const float rstd = rsqrtf(ss * (1.f / Dm) + 1e-6f);
        float ss2 = 0.f;
#pragma unroll
        for (int j = 0; j < 4; ++j) {
            const int col = 4 * (lane + 64 * j);
            const f32x4 gv = *(const f32x4*)(pg + col), ga = *(const f32x4*)(mb + 2048 + col);
#pragma unroll
            for (int e = 0; e < 4; ++e) { xv[j][e] = xv[j][e] + ga[e] * (yv[j][e] * rstd * gv[e]); ss2 += xv[j][e] * xv[j][e]; }
            *(f32x4*)(p.out + (size_t)t * Dm + col) = xv[j];
        }
        ss2 = wave_sum(ss2, lane);
        const float rstd2 = rsqrtf(ss2 * (1.f / Dm) + 1e-6f);
#pragma unroll
        for (int j = 0; j < 4; ++j) {
            const int col = 4 * (lane + 64 * j);
            const f32x4 gv = *(const f32x4*)(fg + col), sv = *(const f32x4*)(mb + 4096 + col), hv = *(const f32x4*)(mb + 3072 + col);
            float o[4];
#pragma unroll
            for (int e = 0; e < 4; ++e) o[e] = (xv[j][e] * rstd2 * gv[e]) * (1.f + sv[e]) + hv[e];
            u32x2 w; w.x = pk2(o[0], o[1]); w.y = pk2(o[2], o[3]);
            *(u32x2*)(h2 + (size_t)t * Dm + col) = w;
        }
    }
}

__device__ __forceinline__ void phase_router(const Params& p, LAS char* L) {
    const int v = vcu(), G = grid_g();
    const bf16_t* h2 = (const bf16_t*)(p.ws + WS_H2);
    const bf16_t* rw = (const bf16_t*)(p.ws + WS_WB) + WB_R;
    float* lg = (float*)(p.ws + WS_LOG);
    for (int u = v; u < 128; u += G) {
        const int m0 = u * 128;
        auto arow = [&](int r) { return (unsigned)(m0 + r) * Dm; };
        auto bcol = [&](int c) { return rw + c; };
        auto epi = [&](f32x16 (&acc)[2][2]) {
            const int tid_ = otid(), lane = tid_ & 63, wave = tid_ >> 6, wm = wave & 1, wn = wave >> 1, l31 = lane & 31, hi = lane >> 5;
#pragma unroll
            for (int mi = 0; mi < 2; ++mi) {
                const int m = m0 + 64 * wm + 32 * mi + l31;
#pragma unroll
                for (int ni = 0; ni < 2; ++ni) {
                    const int nbg = nb_of<0>(wn, ni);
#pragma unroll
                    for (int gq = 0; gq < 4; ++gq) {
                        f32x4 w = {acc[mi][ni][4 * gq], acc[mi][ni][4 * gq + 1], acc[mi][ni][4 * gq + 2], acc[mi][ni][4 * gq + 3]};
                        *(f32x4*)(lg + (size_t)m * NE + nbg + 8 * gq + 4 * hi) = w;
                    }
                }
            }
        };
        gemm_tile<2, 0, true>(L, Dm / 64, NE, h2, arow, bcol, epi);
    }
}

__device__ __forceinline__ unsigned fkey(float f) { const unsigned u = __float_as_uint(f); return (u & 0x80000000u) ? ~u : (u | 0x80000000u); }
template <int CTRL, int RM> __device__ __forceinline__ unsigned dppu(unsigned old, unsigned src) { return (unsigned)__builtin_amdgcn_update_dpp((int)old, (int)src, CTRL, RM, 0xf, false); }
template <int CTRL, int RM> __device__ __forceinline__ float dppf(float old, float src) { return __int_as_float(__builtin_amdgcn_update_dpp(__float_as_int(old), __float_as_int(src), CTRL, RM, 0xf, false)); }
__device__ __forceinline__ unsigned wave_umax(unsigned v) {
    v = max(v, dppu<0x111, 0xf>(v, v)); v = max(v, dppu<0x112, 0xf>(v, v)); v = max(v, dppu<0x114, 0xf>(v, v)); v = max(v, dppu<0x118, 0xf>(v, v));
    v = max(v, dppu<0x142, 0xa>(v, v)); v = max(v, dppu<0x143, 0xc>(v, v));
    return (unsigned)__builtin_amdgcn_readlane((int)v, 63);
}
__device__ __forceinline__ float wave_fsum_dpp(float v) {
    v += dppf<0x111, 0xf>(0.f, v); v += dppf<0x112, 0xf>(0.f, v); v += dppf<0x114, 0xf>(0.f, v); v += dppf<0x118, 0xf>(0.f, v);
    v += dppf<0x142, 0xa>(0.f, v); v += dppf<0x143, 0xc>(0.f, v);
    return __int_as_float(__builtin_amdgcn_readlane(__float_as_int(v), 63));
}
__device__ __forceinline__ void phase_route(const Params& p, LAS char* Lw) {
    const int v = vcu(), G = grid_g();
    const int tid = otid(), lane = tid & 63, wave = tid >> 6;
    const float* lg = (const float*)(p.ws + WS_LOG);
    const float* rb = p.in[21];
    int* cnt = (int*)(p.ws + WS_CTL);
    int* la = (int*)(p.ws + WS_LA); float* lw = (float*)(p.ws + WS_LW);
    const f32x4 bias = *(const f32x4*)(rb + 4 * lane);
    const int grp = lane >> 3;
    for (int t = v * NW + wave; t < T; t += G * NW) {
        const f32x4 lgv = *(const f32x4*)(lg + (size_t)t * NE + 4 * lane);
        const float s0 = 1.f / (1.f + __expf(-lgv[0])), s1 = 1.f / (1.f + __expf(-lgv[1])), s2 = 1.f / (1.f + __expf(-lgv[2])), s3 = 1.f / (1.f + __expf(-lgv[3]));
        float v0 = s0 + bias[0], v1 = s1 + bias[1], v2 = s2 + bias[2], v3 = s3 + bias[3];
        float t1 = fmaxf(v0, v1), t2 = fminf(v0, v1);
        { const float a = fmaxf(v2, v3), bq = fminf(v2, v3); const float n1 = fmaxf(t1, a), n2 = fmaxf(fminf(t1, a), fmaxf(t2, bq)); t1 = n1; t2 = n2; }
        { const float o1 = dppf<0xB1, 0xf>(t1, t1), o2 = dppf<0xB1, 0xf>(t2, t2); const float n1 = fmaxf(t1, o1), n2 = fmaxf(fminf(t1, o1), fmaxf(t2, o2)); t1 = n1; t2 = n2; }
        { const float o1 = dppf<0x4E, 0xf>(t1, t1), o2 = dppf<0x4E, 0xf>(t2, t2); const float n1 = fmaxf(t1, o1), n2 = fmaxf(fminf(t1, o1), fmaxf(t2, o2)); t1 = n1; t2 = n2; }
        { const float o1 = shx(t1, 4, lane), o2 = shx(t2, 4, lane); const float n1 = fmaxf(t1, o1), n2 = fmaxf(fminf(t1, o1), fmaxf(t2, o2)); t1 = n1; t2 = n2; }
        const float gs = t1 + t2;
        int rank = 0;
#pragma unroll
        for (int gg = 0; gg < 8; ++gg) { const float og = __int_as_float(__builtin_amdgcn_readlane(__float_as_int(gs), gg * 8)); rank += (og > gs || (og == gs && gg < grp)) ? 1 : 0; }
        if (rank >= 4) { v0 = -INFINITY; v1 = -INFINITY; v2 = -INFINITY; v3 = -INFINITY; }
        unsigned k0 = fkey(v0), k1 = fkey(v1), k2 = fkey(v2), k3 = fkey(v3);
        bool c0 = false, c1 = false, c2 = false, c3 = false;
#pragma unroll
        for (int it = 0; it < TOPK; ++it) {
            const unsigned lb = max(max(k0, k1), max(k2, k3));
            const unsigned m = wave_umax(lb);
            const unsigned long long bal = __ballot(lb == m);
            const int owner = __builtin_ctzll(bal);
            if (lane == owner) {
                if (k0 == m) { k0 = 0u; c0 = true; } else if (k1 == m) { k1 = 0u; c1 = true; } else if (k2 == m) { k2 = 0u; c2 = true; } else { k3 = 0u; c3 = true; }
            }
        }
        const float wsum = wave_fsum_dpp((c0 ? s0 : 0.f) + (c1 ? s1 : 0.f) + (c2 ? s2 : 0.f) + (c3 ? s3 : 0.f));
        const float wnorm = 2.5f / wsum;
        const unsigned long long m0 = __ballot(c0), m1 = __ballot(c1), m2 = __ballot(c2), m3 = __ballot(c3);
        const unsigned long long lm = (1ull << lane) - 1ull;
        const int q0 = __builtin_popcountll(m0 & lm), b1 = __builtin_popcountll(m0);
        const int q1 = b1 + __builtin_popcountll(m1 & lm), b2 = b1 + __builtin_popcountll(m1);
        const int q2 = b2 + __builtin_popcountll(m2 & lm), b3 = b2 + __builtin_popcountll(m2);
        const int q3 = b3 + __builtin_popcountll(m3 & lm);
        LAS int* slot = (LAS int*)(Lw + 64 * wave);
        if (c0) { slot[2 * q0] = 4 * lane + 0; slot[2 * q0 + 1] = __float_as_int(s0); }
        if (c1) { slot[2 * q1] = 4 * lane + 1; slot[2 * q1 + 1] = __float_as_int(s1); }
        if (c2) { slot[2 * q2] = 4 * lane + 2; slot[2 * q2 + 1] = __float_as_int(s2); }
        if (c3) { slot[2 * q3] = 4 * lane + 3; slot[2 * q3 + 1] = __float_as_int(s3); }
        asm volatile("s_waitcnt lgkmcnt(0)" ::: "memory");
        if (lane < TOPK) {
            const int e_ = slot[2 * lane]; const float sc = __int_as_float(slot[2 * lane + 1]);
            const int pos = atomicAdd(cnt + e_, 1);
            if (pos < LISTCAP) { la[(size_t)e_ * LISTCAP + pos] = t * TOPK + lane; lw[(size_t)e_ * LISTCAP + pos] = sc * wnorm; }
        }
    }
}

__device__ __forceinline__ void phase_router_route(const Params& p, LAS char* L) {
    const int v = vcu(), G = grid_g();
    const bf16_t* h2 = (const bf16_t*)(p.ws + WS_H2);
    const bf16_t* rw = (const bf16_t*)(p.ws + WS_WB) + WB_R;
    const float* rb = p.in[21];
    int* cnt = (int*)(p.ws + WS_CTL);
    int* la = (int*)(p.ws + WS_LA); float* lw = (float*)(p.ws + WS_LW);
    constexpr int LSTR = 1040;
    LAS int* pe = (LAS int*)(L + 69632);
    LAS float* pw = (LAS float*)(L + 69632 + 2048);
    LAS int* hist = (LAS int*)(L + 69632 + 4096);
    LAS int* basep = (LAS int*)(L + 69632 + 5120);
    for (int u = v; u < T / 64; u += G) {
        const int m0 = u * 64;
        auto arow = [&](int r) { return (unsigned)(m0 + r) * Dm; };
        auto bcol = [&](int c) { return rw + c; };
        auto epi = [&](f32x16 (&acc)[1][2]) {
            const int tid_ = otid(), lane = tid_ & 63, wave = tid_ >> 6, wm = wave & 1, wn = wave >> 1, l31 = lane & 31, hi = lane >> 5;
            const int row = 32 * wm + l31;
#pragma unroll
            for (int ni = 0; ni < 2; ++ni)
#pragma unroll
                for (int gq = 0; gq < 4; ++gq) {
                    f32x4 w = {acc[0][ni][4 * gq], acc[0][ni][4 * gq + 1], acc[0][ni][4 * gq + 2], acc[0][ni][4 * gq + 3]};
                    *(LAS f32x4*)(L + row * LSTR + 4 * (nb_of<0>(wn, ni) + 8 * gq + 4 * hi)) = w;
                }
        };
        gemm_tile<1, 0, true>(L, Dm / 64, NE, h2, arow, bcol, epi);
        const int tid = otid(), lane = tid & 63, wave = tid >> 6;
        if (tid < 256) hist[tid] = 0;
        __syncthreads();
        const f32x4 bias = *(const f32x4*)(rb + 4 * lane);
        const int grp = lane >> 3;
#pragma unroll 1
        for (int tt = 0; tt < 8; ++tt) {
            const int tok = 8 * wave + tt;
            const f32x4 lgv = *(LAS f32x4*)(L + tok * LSTR + 16 * lane);
            const float s0 = 1.f / (1.f + __expf(-lgv[0])), s1 = 1.f / (1.f + __expf(-lgv[1])), s2 = 1.f / (1.f + __expf(-lgv[2])), s3 = 1.f / (1.f + __expf(-lgv[3]));
            float v0 = s0 + bias[0], v1 = s1 + bias[1], v2 = s2 + bias[2], v3 = s3 + bias[3];
            float t1 = fmaxf(v0, v1), t2 = fminf(v0, v1);
            { const float a = fmaxf(v2, v3), bq = fminf(v2, v3); const float n1 = fmaxf(t1, a), n2 = fmaxf(fminf(t1, a), fmaxf(t2, bq)); t1 = n1; t2 = n2; }
            { const float o1 = dppf<0xB1, 0xf>(t1, t1), o2 = dppf<0xB1, 0xf>(t2, t2); const float n1 = fmaxf(t1, o1), n2 = fmaxf(fminf(t1, o1), fmaxf(t2, o2)); t1 = n1; t2 = n2; }
            { const float o1 = dppf<0x4E, 0xf>(t1, t1), o2 = dppf<0x4E, 0xf>(t2, t2); const float n1 = fmaxf(t1, o1), n2 = fmaxf(fminf(t1, o1), fmaxf(t2, o2)); t1 = n1; t2 = n2; }
            { const float o1 = shx(t1, 4, lane), o2 = shx(t2, 4, lane); const float n1 = fmaxf(t1, o1), n2 = fmaxf(fminf(t1, o1), fmaxf(t2, o2)); t1 = n1; t2 = n2; }
            const float gs = t1 + t2;
            int rank = 0;
#pragma unroll
            for (int gg = 0; gg < 8; ++gg) { const float og = __int_as_float(__builtin_amdgcn_readlane(__float_as_int(gs), gg * 8)); rank += (og > gs || (og == gs && gg < grp)) ? 1 : 0; }
            if (rank >= 4) { v0 = -INFINITY; v1 = -INFINITY; v2 = -INFINITY; v3 = -INFINITY; }
            unsigned k0 = fkey(v0), k1 = fkey(v1), k2 = fkey(v2), k3 = fkey(v3);
            bool c0 = false, c1 = false, c2 = false, c3 = false;
#pragma unroll
            for (int it = 0; it < TOPK; ++it) {
                const unsigned lb = max(max(k0, k1), max(k2, k3));
                const unsigned m = wave_umax(lb);
                const unsigned long long bal = __ballot(lb == m);
                const int owner = __builtin_ctzll(bal);
                if (lane == owner) {
                    if (k0 == m) { k0 = 0u; c0 = true; } else if (k1 == m) { k1 = 0u; c1 = true; } else if (k2 == m) { k2 = 0u; c2 = true; } else { k3 = 0u; c3 = true; }
                }
            }
            const float wsum = wave_fsum_dpp((c0 ? s0 : 0.f) + (c1 ? s1 : 0.f) + (c2 ? s2 : 0.f) + (c3 ? s3 : 0.f));
            const float wnorm = 2.5f / wsum;
            const unsigned long long b0 = __ballot(c0), b1 = __ballot(c1), b2 = __ballot(c2), b3 = __ballot(c3);
            const unsigned long long lm = (1ull << lane) - 1ull;
            const int q0 = __builtin_popcountll(b0 & lm), a1 = __builtin_popcountll(b0);
            const int q1 = a1 + __builtin_popcountll(b1 & lm), a2 = a1 + __builtin_popcountll(b1);
            const int q2 = a2 + __builtin_popcountll(b2 & lm), a3 = a2 + __builtin_popcountll(b2);
            const int q3 = a3 + __builtin_popcountll(b3 & lm);
            if (c0) { pe[8 * tok + q0] = 4 * lane + 0; pw[8 * tok + q0] = s0 * wnorm; }
            if (c1) { pe[8 * tok + q1] = 4 * lane + 1; pw[8 * tok + q1] = s1 * wnorm; }
            if (c2) { pe[8 * tok + q2] = 4 * lane + 2; pw[8 * tok + q2] = s2 * wnorm; }
            if (c3) { pe[8 * tok + q3] = 4 * lane + 3; pw[8 * tok + q3] = s3 * wnorm; }
        }
        __syncthreads();
        const int my_e = pe[tid];
        const int my_rank = __hip_atomic_fetch_add(hist + my_e, 1, __ATOMIC_RELAXED, __HIP_MEMORY_SCOPE_WORKGROUP);
        __syncthreads();
        if (tid < 256) { const int n = hist[tid]; basep[tid] = n > 0 ? atomicAdd(cnt + tid, n) : 0; }
        __syncthreads();
        {
            const int pos = basep[my_e] + my_rank;
            if (pos < LISTCAP) { la[(size_t)my_e * LISTCAP + pos] = (m0 + (tid >> 3)) * TOPK + (tid & 7); lw[(size_t)my_e * LISTCAP + pos] = pw[tid]; }
        }
        __syncthreads();
    }
}

__device__ __forceinline__ int moe_cnt(const int* cnt, int e) { int c = (e < 256) ? cnt[e] : T; return c > LISTCAP ? LISTCAP : c; }
__device__ __forceinline__ void moe_prefix(const Params& p, LAS char* L) {
    const int tid = otid();
    const int* cnt = (const int*)(p.ws + WS_CTL);
    LAS int* pre = (LAS int*)(L + OFF_PRE);
    LAS int* tl = (LAS int*)(L + OFF_TL);
    __syncthreads();
    for (int i = tid; i < 257; i += NT) { const int c = moe_cnt(cnt, i); tl[i] = (c + 255) >> 8; }
    __syncthreads();
    if (tid == 0) { int s = 0; for (int i = 0; i < 257; ++i) { pre[i] = s; s += tl[i]; } pre[257] = s; }
    __syncthreads();
}
__device__ __forceinline__ int moe_find(LAS int* pre, int g) {
    int lo = 0, hi = 256;
    while (lo < hi) { const int mid = (lo + hi + 1) >> 1; if (pre[mid] <= g) lo = mid; else hi = mid - 1; }
    return lo;
}

template <int MI>
__device__ __forceinline__ void moe1_unit(const Params& p, LAS char* L, int e, int r0, int rows, int j0) {
    const bf16_t* h2 = (const bf16_t*)(p.ws + WS_H2);
    const int* la = (const int*)(p.ws + WS_LA);
    bf16_t* hb = (bf16_t*)(p.ws + WS_HB);
    const float* wg = (e < 256) ? p.in[22] + (size_t)e * Dm * 256 : p.in[25];
    const float* wu = (e < 256) ? p.in[23] + (size_t)e * Dm * 256 : p.in[26];
    LAS int* rowid = (LAS int*)(L + OFF_ROW);
    {
        const int tid = otid();
        if (tid < 64 * MI) { const int rr = tid < rows ? tid : 0; rowid[tid] = (e < 256) ? la[(size_t)e * LISTCAP + r0 + rr] : (AR + r0 + rr); }
        __syncthreads();
    }
    auto arow = [&](int r) { const int a = rowid[r]; const int tok = (e < 256) ? (a >> 3) : (a - AR); return (unsigned)tok * Dm; };
    auto bcol = [&](int c4) { return (c4 < 128) ? (wg + j0 + c4) : (wu + j0 + c4 - 128); };
    auto epi = [&](f32x16 (&acc)[MI][2]) {
#pragma unroll
        for (int mi = 0; mi < MI; ++mi)
#pragma unroll
            for (int r = 0; r < 16; ++r) acc[mi][0][r] = silu_f(acc[mi][0][r]) * acc[mi][1][r];
        store_tile_bf16<MI, 128>(L, acc, [&](int row, int c) -> bf16_t* { return row < rows ? hb + (size_t)rowid[row] * 256 + j0 + 8 * c : nullptr; });
    };
    gemm_tile<MI, 1>(L, Dm / 64, 256, h2, arow, bcol, epi);
}
__device__ __forceinline__ void phase_moe1(const Params& p, LAS char* L) {
    const int v = vcu(), G = grid_g();
    const int* cnt = (const int*)(p.ws + WS_CTL);
    moe_prefix(p, L);
    LAS int* pre = (LAS int*)(L + OFF_PRE);
    const int total = __builtin_amdgcn_readfirstlane(pre[257]) * 2;
    for (int u = v; u < total; u += G) {
        const int g = u >> 1, j0 = (u & 1) * 128;
        const int e = __builtin_amdgcn_readfirstlane(moe_find(pre, g)), mt = g - __builtin_amdgcn_readfirstlane(pre[e]);
        const int rows = __builtin_amdgcn_readfirstlane(moe_cnt(cnt, e)) - mt * 256;
        if (rows > 128) moe1_unit<4>(p, L, e, mt * 256, rows < 256 ? rows : 256, j0);
        else moe1_unit<2>(p, L, e, mt * 256, rows, j0);
    }
}

template <int MI>
__device__ __forceinline__ void moe2_unit(const Params& p, LAS char* L, int e, int r0, int rows, int n0) {
    const int* la = (const int*)(p.ws + WS_LA); const float* lw = (const float*)(p.ws + WS_LW);
    const bf16_t* hb = (const bf16_t*)(p.ws + WS_HB);
    unsigned char* yb = (unsigned char*)(p.ws + WS_YB);
    const float* wd = (e < 256) ? p.in[24] + (size_t)e * 256 * Dm : p.in[27];
    LAS int* rowid = (LAS int*)(L + OFF_ROW);
    LAS float* roww = (LAS float*)(L + OFF_RW);
    {
        const int tid = otid();
        if (tid < 64 * MI) {
            const int rr = tid < rows ? tid : 0;
            rowid[tid] = (e < 256) ? la[(size_t)e * LISTCAP + r0 + rr] : (AR + r0 + rr);
            roww[tid] = (e < 256) ? lw[(size_t)e * LISTCAP + r0 + rr] : 1.f;
        }
        __syncthreads();
    }
    auto arow = [&](int r) { return (unsigned)rowid[r] * 256; };
    auto bcol = [&](int c4) { return wd + n0 + c4; };
    auto epi = [&](f32x16 (&acc)[MI][2]) {
        const int tid_ = otid(), lane = tid_ & 63, wave = tid_ >> 6, wm = wave & 1, l31 = lane & 31;
#pragma unroll
        for (int mi = 0; mi < MI; ++mi) {
            const float w = roww[32 * MI * wm + 32 * mi + l31] * YSCALE;
#pragma unroll
            for (int ni = 0; ni < 2; ++ni)
#pragma unroll
                for (int q = 0; q < 16; ++q) acc[mi][ni][q] = __builtin_amdgcn_fmed3f(acc[mi][ni][q] * w, -448.f, 448.f);
        }
        store_tile_fp8<MI>(L, acc, [&](int row, int c) -> unsigned char* { return row < rows ? yb + (size_t)rowid[row] * Dm + n0 + 16 * c : nullptr; });
    };
    gemm_tile<MI, 0>(L, 256 / 64, Dm, hb, arow, bcol, epi);
}
__device__ __forceinline__ void phase_moe2(const Params& p, LAS char* L) {
    const int v = vcu(), G = grid_g();
    const int* cnt = (const int*)(p.ws + WS_CTL);
    moe_prefix(p, L);
    LAS int* pre = (LAS int*)(L + OFF_PRE);
    const int total = __builtin_amdgcn_readfirstlane(pre[257]) * 4;
    for (int u = v; u < total; u += G) {
        const int g = u >> 2, n0 = (u & 3) * 256;
        const int e = __builtin_amdgcn_readfirstlane(moe_find(pre, g)), mt = g - __builtin_amdgcn_readfirstlane(pre[e]);
        const int rows = __builtin_amdgcn_readfirstlane(moe_cnt(cnt, e)) - mt * 256;
        if (rows > 128) moe2_unit<4>(p, L, e, mt * 256, rows < 256 ? rows : 256, n0);
        else moe2_unit<2>(p, L, e, mt * 256, rows, n0);
    }
}

__device__ __forceinline__ void phase_final(const Params& p) {
    const int v = vcu(), G = grid_g();
    const int tid = otid(), lane = tid & 63, wave = tid >> 6;
    const float* pg = p.in[19];
    const float* mod = (const float*)(p.ws + WS_MOD);
    const unsigned char* yb = (const unsigned char*)(p.ws + WS_YB);
    for (int t = v * NW + wave; t < T; t += G * NW) {
        const int b = t / SEQ;
        const float* gf = mod + b * 6144 + 5120;
        float y[16];
#pragma unroll
        for (int e = 0; e < 16; ++e) y[e] = 0.f;
#pragma unroll
        for (int k = 0; k < 9; ++k) {
            const size_t row = (k < 8) ? ((size_t)t * TOPK + k) : ((size_t)AR + t);
            const u32x4 raw = *(const u32x4*)(yb + row * Dm + 16 * lane);
#pragma unroll
            for (int e = 0; e < 4; ++e) {
                const f32x2 a = __builtin_amdgcn_cvt_pk_f32_fp8((int)raw[e], false), c = __builtin_amdgcn_cvt_pk_f32_fp8((int)raw[e], true);
                y[4 * e] += a.x; y[4 * e + 1] += a.y; y[4 * e + 2] += c.x; y[4 * e + 3] += c.y;
            }
        }
        float ss = 0.f;
#pragma unroll
        for (int e = 0; e < 16; ++e) { y[e] *= (1.f / YSCALE); ss += y[e] * y[e]; }
        ss = wave_sum(ss, lane);
        const float rstd = rsqrtf(ss * (1.f / Dm) + 1e-6f);
        const int col = 16 * lane;
#pragma unroll
        for (int hq = 0; hq < 4; ++hq) {
            f32x4 xo = *(const f32x4*)(p.out + (size_t)t * Dm + col + 4 * hq);
            const f32x4 gv = *(const f32x4*)(pg + col + 4 * hq), gg = *(const f32x4*)(gf + col + 4 * hq);
#pragma unroll
            for (int e = 0; e < 4; ++e) xo[e] += gg[e] * (y[4 * hq + e] * rstd * gv[e]);
            *(f32x4*)(p.out + (size_t)t * Dm + col + 4 * hq) = xo;
        }
    }
}

#define XB_TMO      128
#define XB_XCNT(j)  (256  + 64 * (j))
#define XB_XSUB(j)  (1280 + 64 * (j))
#define XB_XGEN(j)  (2304 + 64 * (j))
#define XB_TOP      3328
#define XB_TOPGEN   3392
#define XCD_BAR_WORDS 3456
#define XB_SPIN_CAP (1u << 18)
__device__ __forceinline__ unsigned xb_ld(unsigned* p)              { return __hip_atomic_load(p, __ATOMIC_RELAXED, __HIP_MEMORY_SCOPE_AGENT); }
__device__ __forceinline__ unsigned xb_add(unsigned* p, unsigned v) { return __hip_atomic_fetch_add(p, v, __ATOMIC_RELAXED, __HIP_MEMORY_SCOPE_AGENT); }
__device__ __forceinline__ unsigned xb_xcc_id() { return (unsigned)__builtin_amdgcn_s_getreg((3 << 11) | 20) & 0xFu; }
#define XB_SPIN(cond, bar) do { unsigned _sp = 0; while (cond) { __builtin_amdgcn_s_sleep(1); \
    if ((++_sp & 255u) == 0u) { if (xb_ld(&(bar)[XB_TMO])) break; if (_sp > XB_SPIN_CAP) { atomicAdd(&(bar)[XB_TMO], 1u); break; } } } } while (0)
struct XcdBarrier { unsigned* bar; unsigned x; volatile LAS unsigned* st; };
__device__ __forceinline__ XcdBarrier xcd_barrier_post(unsigned* bar, volatile LAS unsigned* st) {
    XcdBarrier b; b.bar = bar; b.x = xb_xcc_id(); b.st = st;
    if (threadIdx.x == 0) (void)xb_add(&bar[XB_XCNT(b.x)], 1u);
    return b;
}
__device__ __forceinline__ void xcd_barrier_complete(unsigned* bar, unsigned x, unsigned& nloc, unsigned& nx) {
    const unsigned G = gridDim.x * gridDim.y * gridDim.z;
    unsigned sum, cnt, mine, sp = 0u;
    for (;;) {
        sum = 0u; cnt = 0u; mine = 0u;
#pragma unroll
        for (unsigned j = 0; j < 16; ++j) { const unsigned c = xb_ld(&bar[XB_XCNT(j)]); sum += c; cnt += (c > 0u) ? 1u : 0u; mine = (j == x) ? c : mine; }
        if (sum == G) break;
        __builtin_amdgcn_s_sleep(1);
        if ((++sp & 255u) == 0u) { if (xb_ld(&bar[XB_TMO])) break; if (sp > XB_SPIN_CAP) { atomicAdd(&bar[XB_TMO], 1u); break; } }
    }
    nloc = mine > 0u ? mine : 1u; nx = cnt > 0u ? cnt : 1u;
}
__device__ __forceinline__ void xcd_barrier(const Params& p, LAS char* L) {
    XcdBarrier b; b.bar = (unsigned*)(p.ws + WS_CTL + 4096); b.x = xb_xcc_id(); b.st = (volatile LAS unsigned*)(L + OFF_MISC);
    asm volatile("s_waitcnt vmcnt(0)" ::: "memory");
    __syncthreads();
    if (threadIdx.x == 0) {
        unsigned* bar = b.bar;
        __builtin_amdgcn_s_waitcnt(0);
        unsigned nloc = b.st[0], nx = b.st[1];
        if (nloc == 0u) { xcd_barrier_complete(bar, b.x, nloc, nx); b.st[0] = nloc; b.st[1] = nx; }
        const unsigned old = xb_add(&bar[XB_XSUB(b.x)], 1u);
        const unsigned gen = old / nloc;
        if (old + 1u == (gen + 1u) * nloc) {
            __builtin_amdgcn_fence(__ATOMIC_RELEASE, "agent");
            asm volatile("s_waitcnt vmcnt(0)" ::: "memory");
            const unsigned og = xb_add(&bar[XB_TOP], 1u);
            const unsigned tg = og / nx;
            if (og + 1u == (tg + 1u) * nx) xb_add(&bar[XB_TOPGEN], 1u);
            else XB_SPIN(xb_ld(&bar[XB_TOPGEN]) == tg, bar);
            __builtin_amdgcn_fence(__ATOMIC_ACQUIRE, "agent");
            xb_add(&bar[XB_XGEN(b.x)], 1u);
            asm volatile("s_waitcnt vmcnt(0)" ::: "memory");
        } else {
            XB_SPIN(xb_ld(&bar[XB_XGEN(b.x)]) == gen, bar);
            __builtin_amdgcn_fence(__ATOMIC_ACQUIRE, "agent");
            asm volatile("s_waitcnt vmcnt(0)" ::: "memory");
        }
    }
    __syncthreads();
}

__global__ void __launch_bounds__(NT, 2) mega(Params p) {
    extern __shared__ __attribute__((aligned(16))) char smem[];
    LAS char* L = (LAS char*)smem;
    if (threadIdx.x < 8) ((LAS unsigned*)(L + OFF_MISC))[threadIdx.x] = 0u;
    __syncthreads();
    (void)xcd_barrier_post((unsigned*)(p.ws + WS_CTL + 4096), (volatile LAS unsigned*)(L + OFF_MISC));
    phase_mod(p, L);
    xcd_barrier(p, L);
    phase_h1(p);
    xcd_barrier(p, L);
    _Pragma("nounroll") for (int rep_ = 0; rep_ < REP_PROJ; ++rep_) phase_proj(p, L);
    xcd_barrier(p, L);
    _Pragma("nounroll") for (int rep_ = 0; rep_ < REP_SMALL; ++rep_) phase_qkv(p, L);
    xcd_barrier(p, L);
    phase_attn(p, L);
    xcd_barrier(p, L);
    _Pragma("nounroll") for (int rep_ = 0; rep_ < REP_SMALL; ++rep_) phase_oproj(p, L);
    xcd_barrier(p, L);
    phase_post_attn(p);
    xcd_barrier(p, L);
    phase_router_route(p, L);
    xcd_barrier(p, L);
    _Pragma("nounroll") for (int rep_ = 0; rep_ < REP_MOE1; ++rep_) phase_moe1(p, L);
    xcd_barrier(p, L);
    _Pragma("nounroll") for (int rep_ = 0; rep_ < REP_MOE2; ++rep_) phase_moe2(p, L);
    xcd_barrier(p, L);
    phase_final(p);
}

extern "C" void kernel_launch(void* const* d_in, const int* in_sizes, int n_in, void* d_out, int out_size, void* d_ws, size_t ws_size, hipStream_t stream) {
    static int grid_blocks = 0;
    if (grid_blocks == 0) {
        if (n_in != 28 || out_size != T * Dm || ws_size < WS_END) {
            fprintf(stderr, "kernel_launch: unexpected problem (n_in %d, out %d, ws %zu); nothing launched\n", n_in, out_size, ws_size);
            grid_blocks = -1; return;
        }
        int dev = 0, cus = 0, per_cu = 0;
        (void)hipGetDevice(&dev);
        (void)hipDeviceGetAttribute(&cus, hipDeviceAttributeMultiprocessorCount, dev);
        if (hipFuncSetAttribute((const void*)mega, hipFuncAttributeMaxDynamicSharedMemorySize, LDS_BYTES) != hipSuccess) {
            fprintf(stderr, "kernel_launch: hipFuncSetAttribute(%d B LDS) failed\n", LDS_BYTES); grid_blocks = -1; return;
        }
        (void)hipOccupancyMaxActiveBlocksPerMultiprocessor(&per_cu, mega, NT, LDS_BYTES);
        if (per_cu < 1) { fprintf(stderr, "kernel_launch: occupancy query says %d blocks per CU\n", per_cu); per_cu = 1; }
        grid_blocks = cus;
        fprintf(stderr, "kernel_launch: %d CUs, occupancy query %d per CU, grid %d\n", cus, per_cu, grid_blocks);
    }
    if (grid_blocks < 0) return;
    (void)hipMemsetAsync((char*)d_ws + WS_CTL, 0, CTL_BYTES, stream);
    Params p{};
    for (int i = 0; i < 28; ++i) p.in[i] = (const float*)d_in[i];
    p.out = (float*)d_out; p.ws = (char*)d_ws;
    void* args[] = {&p};
    hipError_t e = hipLaunchCooperativeKernel((void*)mega, dim3(grid_blocks), dim3(NT), args, LDS_BYTES, stream);
    if (e != hipSuccess) fprintf(stderr, "cooperative launch failed: %s (grid %d)\n", hipGetErrorString(e), grid_blocks);
}
```

```cpp
#include <hip/hip_runtime.h>
#include <cstdio>
#include <cstdint>

#ifndef REP_PROJ
#define REP_PROJ 1
#endif
#ifndef REP_ATTN
#define REP_ATTN 1
#endif
#ifndef REP_MOE1
#define REP_MOE1 1
#endif
#ifndef REP_MOE2
#define REP_MOE2 1
#endif
#ifndef REP_SMALL
#define REP_SMALL 1
#endif

typedef unsigned short bf16_t;
typedef float f32x2 __attribute__((ext_vector_type(2)));
typedef short bf16x8 __attribute__((ext_vector_type(8)));
typedef short s16x4 __attribute__((ext_vector_type(4)));
typedef short v4i16_t __attribute__((ext_vector_type(4)));
typedef float f32x16 __attribute__((ext_vector_type(16)));
typedef float f32x4 __attribute__((ext_vector_type(4)));
typedef unsigned u32x4 __attribute__((ext_vector_type(4)));
typedef unsigned u32x2 __attribute__((ext_vector_type(2)));
#define LAS __attribute__((address_space(3)))

constexpr int NT = 512, NW = 8;
constexpr int Dm = 1024, NB = 8, SEQ = 2048, T = NB * SEQ;
constexpr int NIN = 1952;
constexpr int C_CQ = 0, C_CKV = 256, C_KR = 384, C_DQ = 416, C_DK = 928, C_DV = 1440;
constexpr int NE = 256, TOPK = 8, AR = T * TOPK, HROWS = AR + T;
constexpr int LISTCAP = T;
constexpr float LOG2E = 1.4426950408889634f;
constexpr float YSCALE = 32.f;
constexpr float LAMBDA_INIT = 0.2f;

constexpr size_t MiB = 1u << 20;
constexpr size_t WS_CTL = 0, CTL_BYTES = 65536;
constexpr size_t WS_MOD = 65536;
constexpr size_t WS_ROPE = 1 * MiB;
constexpr size_t WS_H1 = 4 * MiB;
constexpr size_t WS_PROJ = 36 * MiB;
constexpr size_t WS_CQN = 100 * MiB;
constexpr size_t WS_CKVN = 108 * MiB;
constexpr size_t WS_QM = 112 * MiB;
constexpr size_t WS_KF = 136 * MiB;
constexpr size_t WS_VM = 160 * MiB;
constexpr size_t WS_ATT = 176 * MiB;
constexpr size_t WS_OD0 = 208 * MiB;
constexpr size_t WS_Y1 = 240 * MiB;
constexpr size_t WS_H2 = 304 * MiB;
constexpr size_t WS_LOG = 336 * MiB;
constexpr size_t WS_LA = 352 * MiB;
constexpr size_t WS_LW = 368 * MiB;
constexpr size_t WS_HB = 384 * MiB;
constexpr size_t WS_YB = 456 * MiB;
constexpr size_t WS_WB = 744 * MiB;
constexpr size_t WB_IN = 0, WB_UQ = WB_IN + (size_t)1024 * 1952, WB_UKV = WB_UQ + 256 * 768, WB_O = WB_UKV + 128 * 1024, WB_R = WB_O + 1024 * 1024, WB_END = WB_R + 1024 * 256;
constexpr size_t WS_END = 760 * MiB;

constexpr int G_XB = 32768, G_WB = 36864, G_BUF = G_XB + G_WB, G_LDS = 2 * G_BUF;
constexpr int OFF_MISC = G_LDS, OFF_PRE = OFF_MISC + 64, OFF_TL = OFF_PRE + 1088;
constexpr int OFF_ROW = OFF_TL + 1088, OFF_RW = OFF_ROW + 1024;
constexpr int OFF_SS = OFF_RW + 1024;
constexpr int LDS_BYTES = G_LDS + 4352 + 4096;

struct Params {
    const float* in[28];
    float* out;
    char* ws;
};

__device__ __forceinline__ unsigned short f2bf(float f) { __bf16 b = (__bf16)f; return __builtin_bit_cast(unsigned short, b); }
typedef __bf16 bf16x2_t __attribute__((ext_vector_type(2)));
__device__ __forceinline__ unsigned pk2(float lo, float hi) { const f32x2 v = {lo, hi}; return __builtin_bit_cast(unsigned, __builtin_convertvector(v, bf16x2_t)); }
__device__ __forceinline__ float bf2f(unsigned short b) { return __uint_as_float(((unsigned)b) << 16); }
__device__ __forceinline__ float bflo(unsigned u) { return __uint_as_float(u << 16); }
__device__ __forceinline__ float bfhi(unsigned u) { return __uint_as_float(u & 0xffff0000u); }
__device__ __forceinline__ int crow(int r, int hi) { return (r & 3) + 8 * (r >> 2) + 4 * hi; }
__device__ __forceinline__ float shx(float v, int m, int lane) { return __int_as_float(__builtin_amdgcn_ds_bpermute((lane ^ m) << 2, __float_as_int(v))); }
__device__ __forceinline__ int shxi(int v, int m, int lane) { return __builtin_amdgcn_ds_bpermute((lane ^ m) << 2, v); }
__device__ __forceinline__ float shl(float v, int src) { return __int_as_float(__builtin_amdgcn_ds_bpermute(src << 2, __float_as_int(v))); }
__device__ __forceinline__ float wave_sum(float v, int lane) {
#pragma unroll
    for (int o = 32; o >= 1; o >>= 1) v += shx(v, o, lane);
    return v;
}
__device__ __forceinline__ float silu_f(float v) { return v / (1.f + __expf(-v)); }
__device__ __forceinline__ s16x4 tr_read(LAS char* p) {
    return __builtin_bit_cast(s16x4, __builtin_amdgcn_ds_read_tr16_b64_v4i16((LAS v4i16_t*)p));
}
__device__ __forceinline__ int otid() { int t = threadIdx.x; asm volatile("" : "+v"(t)); return t; }
__device__ __forceinline__ int grid_g() { return gridDim.x; }
__device__ __forceinline__ int vcu() { const int G = gridDim.x, bx = blockIdx.x; return (G % 8 == 0) ? (bx % 8) * (G / 8) + bx / 8 : bx; }
__device__ __forceinline__ void gld16(u32x4& d, const void* p) { asm volatile("global_load_dwordx4 %0, %1, off" : "+v"(d) : "v"(p) : "memory"); }
__device__ __forceinline__ void gld16(f32x4& d, const void* p) { asm volatile("global_load_dwordx4 %0, %1, off" : "+v"(d) : "v"(p) : "memory"); }
template <int N> __device__ __forceinline__ void vm_wait(u32x4& a, f32x4& b, f32x4& c) { asm volatile("s_waitcnt vmcnt(%3)" : "+v"(a), "+v"(b), "+v"(c) : "n"(N) : "memory"); }
template <int N> __device__ __forceinline__ void vm_wait(f32x4& b, f32x4& c) { asm volatile("s_waitcnt vmcnt(%2)" : "+v"(b), "+v"(c) : "n"(N) : "memory"); }
template <int N> __device__ __forceinline__ void vm_wait(u32x4& a, u32x4& b) { asm volatile("s_waitcnt vmcnt(%2)" : "+v"(a), "+v"(b) : "n"(N) : "memory"); }
template <int N> __device__ __forceinline__ void vm_wait(u32x4& b) { asm volatile("s_waitcnt vmcnt(%1)" : "+v"(b) : "n"(N) : "memory"); }
#define MFMA32(a, b, c) __builtin_amdgcn_mfma_f32_32x32x16_bf16(a, b, c, 0, 0, 0)

template <int NBMODE> __device__ __forceinline__ int nb_of(int wn, int ni) { return NBMODE == 0 ? 64 * wn + 32 * ni : 32 * wn + 128 * ni; }

template <int MI, int NBMODE, bool WBF = false, int NSEG = 1, class AF, class BF, class EF>
__device__ __forceinline__ void gemm_tile(LAS char* L, int nk, long ldw, const bf16_t* abase, AF arow, BF bcol, EF epi) {
    asm volatile("" : "+s"(nk));
    const int tid = otid(), lane = tid & 63, wave = tid >> 6;
    const int wm = wave & 1, wn = wave >> 1, l31 = lane & 31, hi = lane >> 5;
    const int a_chunk = tid & 7, a_row = tid >> 3;
    const int a_w = a_row * 128 + 16 * (a_chunk ^ ((a_row >> 1) & 7));
    const int b_n4 = WBF ? (tid & 31) : (tid & 63), b_kr = WBF ? (tid >> 5) : (tid >> 6);
    const auto bp = bcol((WBF ? 8 : 4) * b_n4) + (long)b_kr * ldw;
    const int b_w = G_XB + b_kr * 576 + (WBF ? 16 : 8) * b_n4;
    const int sw = (l31 >> 1) & 7;
    const int xoff = (32 * MI * wm + l31) * 128;
    const int woff = G_XB + (8 * hi + ((lane & 15) >> 2)) * 576 + 2 * (16 * ((lane >> 4) & 1) + 4 * (lane & 3));
    u32x4 ra[MI]; f32x4 rb[8]; u32x4 rw[4];
#pragma unroll
    for (int i = 0; i < MI; ++i) ra[i] = (u32x4){0u, 0u, 0u, 0u};
#pragma unroll
    for (int i = 0; i < 8; ++i) rb[i] = (f32x4){0.f, 0.f, 0.f, 0.f};
#pragma unroll
    for (int i = 0; i < 4; ++i) rw[i] = (u32x4){0u, 0u, 0u, 0u};
#define G_LOADW(KOFF, Q, SEGC) do { \
        if (WBF) { gld16(rw[Q], bp + (long)((KOFF) + 16 * (Q)) * ldw + (SEGC)); } \
        else { gld16(rb[2 * (Q)], bp + (long)((KOFF) + 16 * (Q)) * ldw + (SEGC)); gld16(rb[2 * (Q) + 1], bp + (long)((KOFF) + 16 * (Q) + 8) * ldw + (SEGC)); } } while (0)
#define G_LOADQ(KT, Q) do { \
        if ((Q) < MI) gld16(ra[(Q) < MI ? (Q) : 0], abase + arow(a_row + 64 * (Q)) + a_chunk * 8 + (KT) * 64); \
        G_LOADW((KT) * 64, Q, 0); } while (0)
#define G_LOADQ_SEL(KT, SEG, Q, OK) do { \
        const int kq_ = (OK) ? (KT) * 64 : 0; const int sc_ = (OK) ? (SEG) * 256 : 0; \
        if ((Q) < MI) gld16(ra[(Q) < MI ? (Q) : 0], abase + arow(a_row + 64 * (Q)) + a_chunk * 8 + kq_); \
        G_LOADW(kq_, Q, sc_); } while (0)
#define G_WAITQ(Q, N) do { \
        if (WBF) { if ((Q) < MI) vm_wait<N>(ra[(Q) < MI ? (Q) : 0], rw[Q]); else vm_wait<N>(rw[Q]); } \
        else { if ((Q) < MI) vm_wait<N>(ra[(Q) < MI ? (Q) : 0], rb[2 * (Q)], rb[2 * (Q) + 1]); else vm_wait<N>(rb[2 * (Q)], rb[2 * (Q) + 1]); } } while (0)
#define G_STOREQ(LP, Q) do { \
        if ((Q) < MI) *(LAS u32x4*)((LP) + a_w + (Q) * 8192) = ra[(Q) < MI ? (Q) : 0]; \
        if (WBF) { *(LAS u32x4*)((LP) + b_w + (Q) * 16 * 576) = rw[Q]; } else { \
        { u32x2 w; w.x = pk2(rb[2 * (Q)][0], rb[2 * (Q)][1]); w.y = pk2(rb[2 * (Q)][2], rb[2 * (Q)][3]); *(LAS u32x2*)((LP) + b_w + (Q) * 16 * 576) = w; } \
        { u32x2 w; w.x = pk2(rb[2 * (Q) + 1][0], rb[2 * (Q) + 1][1]); w.y = pk2(rb[2 * (Q) + 1][2], rb[2 * (Q) + 1][3]); *(LAS u32x2*)((LP) + b_w + (Q) * 16 * 576 + 8 * 576) = w; } } } while (0)
    constexpr int NLW = WBF ? 1 : 2;
    constexpr int NL0 = NLW + ((0 < MI) ? 1 : 0), NL1 = NLW + ((1 < MI) ? 1 : 0), NL2 = NLW + ((2 < MI) ? 1 : 0), NL3 = NLW + ((3 < MI) ? 1 : 0), NLT = NL0 + NL1 + NL2 + NL3;
    G_LOADQ(0, 0); G_LOADQ(0, 1); G_LOADQ(0, 2); G_LOADQ(0, 3);
    G_WAITQ(0, 0); G_WAITQ(1, 0); G_WAITQ(2, 0); G_WAITQ(3, 0);
    G_STOREQ(L, 0); G_STOREQ(L, 1); G_STOREQ(L, 2); G_STOREQ(L, 3);
    G_LOADQ(1, 0); G_LOADQ(1, 1); G_LOADQ(1, 2); G_LOADQ(1, 3);
    f32x16 acc[MI][2];
#pragma unroll
    for (int i = 0; i < MI; ++i)
#pragma unroll
        for (int j = 0; j < 2; ++j)
#pragma unroll
            for (int r = 0; r < 16; ++r) acc[i][j][r] = 0.f;
    __syncthreads();
    const int nt_all = nk * NSEG;
    int lk = (nk == 2) ? 0 : 2, lseg = (nk == 2) ? 1 : 0;
    int ck = 0, cseg = 0;
#pragma nounroll
    for (int kt = 0; kt < nt_all; ++kt) {
        LAS char* Lb = L + (kt & 1) * G_BUF;
        LAS char* Ln = L + ((kt + 1) & 1) * G_BUF;
        const bool ld = kt + 2 < nt_all;
        bf16x8 xf[2][MI], wf[2][2];
#define LOAD_FRAGS(KS, B) do { \
            _Pragma("unroll") for (int mi = 0; mi < MI; ++mi) xf[B][mi] = *(LAS bf16x8*)(Lb + xoff + mi * 4096 + 16 * ((2 * (KS) + hi) ^ sw)); \
            _Pragma("unroll") for (int ni = 0; ni < 2; ++ni) { \
                LAS char* pp = Lb + woff + (KS) * 16 * 576 + 2 * nb_of<NBMODE>(wn, ni); \
                const s16x4 lo = tr_read(pp), h4 = tr_read(pp + 4 * 576); \
                wf[B][ni] = (bf16x8){lo[0], lo[1], lo[2], lo[3], h4[0], h4[1], h4[2], h4[3]}; } } while (0)
#define MMA_STEP(KS) do { \
            _Pragma("unroll") for (int mi = 0; mi < MI; ++mi) \
                _Pragma("unroll") for (int ni = 0; ni < 2; ++ni) acc[mi][ni] = MFMA32(wf[(KS) & 1][ni], xf[(KS) & 1][mi], acc[mi][ni]); } while (0)
#define STAGE_STEP(Q, NREST, NPREV) do { G_WAITQ(Q, (NREST) + (NPREV)); G_STOREQ(Ln, Q); G_LOADQ_SEL(lk, lseg, Q, ld); } while (0)
        LOAD_FRAGS(0, 0);
        LOAD_FRAGS(1, 1); MMA_STEP(0); STAGE_STEP(0, NL1 + NL2 + NL3, 0);           __builtin_amdgcn_sched_barrier(0);
        LOAD_FRAGS(2, 0); MMA_STEP(1); STAGE_STEP(1, NL2 + NL3, NL0);               __builtin_amdgcn_sched_barrier(0);
        LOAD_FRAGS(3, 1); MMA_STEP(2); STAGE_STEP(2, NL3, NL0 + NL1);               __builtin_amdgcn_sched_barrier(0);
        MMA_STEP(3);                   STAGE_STEP(3, 0, NL0 + NL1 + NL2);           __builtin_amdgcn_sched_barrier(0);
#undef LOAD_FRAGS
#undef MMA_STEP
#undef STAGE_STEP
        __syncthreads();
        if (++lk == nk) { lk = 0; ++lseg; }
        if (NSEG > 1) {
            if (++ck == nk) {
                ck = 0;
                if (cseg + 1 < NSEG) {
                    epi(acc, cseg, L + (kt & 1) * G_BUF);
#pragma unroll
                    for (int i = 0; i < MI; ++i)
#pragma unroll
                        for (int j = 0; j < 2; ++j)
#pragma unroll
                            for (int r = 0; r < 16; ++r) acc[i][j][r] = 0.f;
                }
                ++cseg;
            }
        }
    }
    G_WAITQ(0, 0); G_WAITQ(1, 0); G_WAITQ(2, 0); G_WAITQ(3, 0);
#undef G_LOADQ
#undef G_LOADQ_SEL
#undef G_LOADW
#undef G_WAITQ
#undef G_STOREQ
    (void)NLT;
    epi(acc, NSEG - 1, L);
}

template <int MI, int NC, class DF>
__device__ __forceinline__ void store_tile_bf16(LAS char* L, const f32x16 (&acc)[MI][2], DF dst) {
    constexpr int STR = NC * 2 + 16, CPR = NC / 8, BM = 64 * MI;
    const int tid = otid(), lane = tid & 63, wave = tid >> 6, wm = wave & 1, wn = wave >> 1, l31 = lane & 31, hi = lane >> 5;
#pragma unroll
    for (int mi = 0; mi < MI; ++mi)
#pragma unroll
        for (int ni = 0; ni < (NC == 256 ? 2 : 1); ++ni) {
            const int row = 32 * MI * wm + 32 * mi + l31, col = (NC == 256) ? nb_of<0>(wn, ni) : 32 * wn;
#pragma unroll
            for (int gq = 0; gq < 4; ++gq) {
                u32x2 w; w.x = pk2(acc[mi][ni][4 * gq], acc[mi][ni][4 * gq + 1]); w.y = pk2(acc[mi][ni][4 * gq + 2], acc[mi][ni][4 * gq + 3]);
                *(LAS u32x2*)(L + row * STR + 2 * (col + 8 * gq + 4 * hi)) = w;
            }
        }
    __syncthreads();
#pragma unroll
    for (int i = 0; i < (BM * CPR) / NT; ++i) {
        const int id = tid + NT * i, row = id / CPR, c = id % CPR;
        bf16_t* d = dst(row, c);
        if (d) *(u32x4*)d = *(LAS u32x4*)(L + row * STR + 16 * c);
    }
    __syncthreads();
}

template <int MI, class DF>
__device__ __forceinline__ void store_tile_fp8(LAS char* L, const f32x16 (&acc)[MI][2], DF dst) {
    constexpr int STR = 256 + 16, BM = 64 * MI;
    const int tid = otid(), lane = tid & 63, wave = tid >> 6, wm = wave & 1, wn = wave >> 1, l31 = lane & 31, hi = lane >> 5;
#pragma unroll
    for (int mi = 0; mi < MI; ++mi)
#pragma unroll
        for (int ni = 0; ni < 2; ++ni) {
            const int row = 32 * MI * wm + 32 * mi + l31, col = nb_of<0>(wn, ni);
#pragma unroll
            for (int gq = 0; gq < 4; ++gq) {
                int w = 0;
                w = __builtin_amdgcn_cvt_pk_fp8_f32(acc[mi][ni][4 * gq], acc[mi][ni][4 * gq + 1], w, false);
                w = __builtin_amdgcn_cvt_pk_fp8_f32(acc[mi][ni][4 * gq + 2], acc[mi][ni][4 * gq + 3], w, true);
                *(LAS int*)(L + row * STR + (col + 8 * gq + 4 * hi)) = w;
            }
        }
    __syncthreads();
#pragma unroll
    for (int i = 0; i < (BM * 16) / NT; ++i) {
        const int id = tid + NT * i, row = id >> 4, c = id & 15;
        unsigned char* d = dst(row, c);
        if (d) *(u32x4*)d = *(LAS u32x4*)(L + row * STR + 16 * c);
    }
    __syncthreads();
}

__device__ __forceinline__ void phase_mod(const Params& p, LAS char* L) {
    const int v = vcu(), G = grid_g();
    const int tid = otid();
    const float* c = p.in[1]; const float* w_ada = p.in[3]; const float* b_ada = p.in[4];
    float* mod = (float*)(p.ws + WS_MOD);
    LAS float* sc = (LAS float*)L;
    LAS float* red = (LAS float*)(L + 32768);
    bool filled = false;
    for (int item = v; item < 384; item += G) {
        if (!filled) {
            for (int i = tid; i < 8 * 1024; i += NT) sc[i] = silu_f(c[i]);
            __syncthreads(); filled = true;
        }
        const int cx = tid & 15, kl = tid >> 4, col = item * 16 + cx;
        float a[8];
#pragma unroll
        for (int b = 0; b < 8; ++b) a[b] = 0.f;
#pragma unroll 4
        for (int k = kl; k < 1024; k += 32) {
            const float w = w_ada[(size_t)k * 6144 + col];
#pragma unroll
            for (int b = 0; b < 8; ++b) a[b] += sc[b * 1024 + k] * w;
        }
#pragma unroll
        for (int b = 0; b < 8; ++b) red[(b * 32 + kl) * 16 + cx] = a[b];
        __syncthreads();
        if (tid < 128) {
            const int b = tid >> 4, cc = tid & 15; float s = 0.f;
#pragma unroll
            for (int k = 0; k < 32; ++k) s += red[(b * 32 + k) * 16 + cc];
            mod[b * 6144 + item * 16 + cc] = s + b_ada[item * 16 + cc];
        }
        __syncthreads();
    }
    {
        bf16_t* wb = (bf16_t*)(p.ws + WS_WB);
        const size_t gt = (size_t)v * NT + tid, gs = (size_t)G * NT;
        auto conv = [&](const float* src, size_t off, size_t n) {
            for (size_t i = gt; i < n / 4; i += gs) { const f32x4 f = *(const f32x4*)(src + 4 * i); u32x2 w; w.x = pk2(f[0], f[1]); w.y = pk2(f[2], f[3]); *(u32x2*)(wb + off + 4 * i) = w; }
        };
        auto convg = [&](const float* src, size_t off, size_t n, int ncol, const float* gain) {
            for (size_t i = gt; i < n / 4; i += gs) { const float gk = gain[(4 * i) / ncol]; const f32x4 f = *(const f32x4*)(src + 4 * i); u32x2 w; w.x = pk2(f[0] * gk, f[1] * gk); w.y = pk2(f[2] * gk, f[3] * gk); *(u32x2*)(wb + off + 4 * i) = w; }
        };
        conv(p.in[7], WB_IN, (size_t)1024 * 1952); convg(p.in[10], WB_UQ, (size_t)256 * 768, 768, p.in[8]); convg(p.in[11], WB_UKV, (size_t)128 * 1024, 1024, p.in[9]);
        conv(p.in[17], WB_O, (size_t)1024 * 1024); conv(p.in[20], WB_R, (size_t)1024 * 256);
    }
}

__device__ __forceinline__ void phase_h1(const Params& p) {
    const int v = vcu(), G = grid_g();
    const int tid = otid(), lane = tid & 63, wave = tid >> 6;
    const float* x = p.in[0]; const int* positions = (const int*)p.in[2]; const float* g = p.in[5];
    const float* mod = (const float*)(p.ws + WS_MOD);
    bf16_t* h1 = (bf16_t*)(p.ws + WS_H1);
    f32x2* rope = (f32x2*)(p.ws + WS_ROPE);
    for (int t = v * NW + wave; t < T; t += G * NW) {
        const int b = t / SEQ;
        const f32x4* xr = (const f32x4*)(x + (size_t)t * Dm);
        f32x4 xv[4]; float ss = 0.f;
#pragma unroll
        for (int j = 0; j < 4; ++j) { xv[j] = xr[lane + 64 * j]; ss += xv[j][0] * xv[j][0] + xv[j][1] * xv[j][1] + xv[j][2] * xv[j][2] + xv[j][3] * xv[j][3]; }
        ss = wave_sum(ss, lane);
        const float rstd = rsqrtf(ss * (1.f / Dm) + 1e-6f);
        const float* sh = mod + b * 6144; const float* scl = sh + 1024;
#pragma unroll
        for (int j = 0; j < 4; ++j) {
            const int col = 4 * (lane + 64 * j);
            const f32x4 gv = *(const f32x4*)(g + col), sv = *(const f32x4*)(scl + col), hv = *(const f32x4*)(sh + col);
            float o[4];
#pragma unroll
            for (int e = 0; e < 4; ++e) o[e] = (xv[j][e] * rstd * gv[e]) * (1.f + sv[e]) + hv[e];
            u32x2 w; w.x = pk2(o[0], o[1]); w.y = pk2(o[2], o[3]);
            *(u32x2*)(h1 + (size_t)t * Dm + col) = w;
        }
        if (lane < 16) {
            const double inv = exp2(-(double)lane * (13.287712379549449 / 16.0));
            const double rev = (double)positions[t] * inv * 0.15915494309189535;
            const float fr = (float)(rev - rint(rev));
            f32x2 cs; cs.x = __builtin_amdgcn_cosf(fr); cs.y = __builtin_amdgcn_sinf(fr);
            rope[(size_t)t * 16 + lane] = cs;
        }
    }
}

__device__ __forceinline__ void phase_proj(const Params& p, LAS char* L) {
    const int v = vcu(), G = grid_g();
    const bf16_t* h1 = (const bf16_t*)(p.ws + WS_H1);
    const bf16_t* w_in = (const bf16_t*)(p.ws + WS_WB) + WB_IN;
    bf16_t* proj = (bf16_t*)(p.ws + WS_PROJ);
    const f32x2* rope = (const f32x2*)(p.ws + WS_ROPE);
    for (int u = v; u < 64 * 8; u += G) {
        const int mt = u >> 3, nt = u & 7, m0 = mt * 256, n0 = nt * 256;
        auto arow = [&](int r) { return (unsigned)(m0 + r) * Dm; };
        auto bcol = [&](int c) { int col = n0 + c; if (col > NIN - 8) col = NIN - 8; return w_in + col; };
        auto epi = [&](f32x16 (&acc)[4][2], int seg, LAS char* Ls) {
            const int tid_ = otid(), lane = tid_ & 63, wave = tid_ >> 6, wm = wave & 1, wn = wave >> 1, l31 = lane & 31, hi = lane >> 5;
            if (nt < 2) {
                LAS float* ssl = (LAS float*)(L + OFF_SS);
                const bool contrib = (nt == 0) || (wn < 2);
#pragma unroll
                for (int mi = 0; mi < 4; ++mi) {
                    float part = 0.f;
#pragma unroll
                    for (int ni = 0; ni < 2; ++ni)
#pragma unroll
                        for (int r = 0; r < 16; ++r) part += acc[mi][ni][r] * acc[mi][ni][r];
                    part += shx(part, 32, lane);
                    if (hi == 0) ssl[(128 * wm + 32 * mi + l31) * 4 + wn] = contrib ? part : 0.f;
                }
                __syncthreads();
                if (tid_ < 256) {
                    const f32x4 q4 = *(LAS f32x4*)(ssl + tid_ * 4);
                    const float ssum = (q4[0] + q4[1]) + (q4[2] + q4[3]);
                    float* rs = (float*)(p.ws + WS_CQN) + (nt == 0 ? 0 : (1 << 18));
                    rs[m0 + tid_] = rsqrtf(ssum * (nt == 0 ? 1.f / 256.f : 1.f / 128.f) + 1e-6f);
                }
            }
#pragma unroll
            for (int ni = 0; ni < 2; ++ni) {
                const int nbg = n0 + nb_of<0>(wn, ni);
                if (nbg == C_KR) {
#pragma unroll
                    for (int mi = 0; mi < 4; ++mi) {
                        const int m = m0 + 128 * wm + 32 * mi + l31;
#pragma unroll
                        for (int r = 0; r < 8; ++r) {
                            const f32x2 cs = rope[(size_t)m * 16 + crow(r, hi)];
                            const float x1 = acc[mi][ni][r], x2 = acc[mi][ni][r + 8];
                            acc[mi][ni][r] = x1 * cs.x - x2 * cs.y; acc[mi][ni][r + 8] = x2 * cs.x + x1 * cs.y;
                        }
                    }
                }
                if (nbg >= C_DQ && nbg < C_DK) {
#pragma unroll
                    for (int mi = 0; mi < 4; ++mi)
#pragma unroll
                        for (int r = 0; r < 16; ++r) acc[mi][ni][r] *= 0.125f * LOG2E;
                }
            }
            store_tile_bf16<4, 256>(Ls, acc, [&](int row, int c) -> bf16_t* { const int col = n0 + 8 * c; return col < NIN ? proj + (size_t)(m0 + row) * NIN + col : nullptr; });
        };
        gemm_tile<4, 0, true>(L, Dm / 64, NIN, h1, arow, bcol, epi);
    }
}

__device__ __forceinline__ void phase_norms(const Params& p) {
    const int v = vcu(), G = grid_g();
    const int tid = otid(), lane = tid & 63, wave = tid >> 6;
    const bf16_t* proj = (const bf16_t*)(p.ws + WS_PROJ);
    const float* qg = p.in[8]; const float* kvg = p.in[9];
    bf16_t* cqn = (bf16_t*)(p.ws + WS_CQN); bf16_t* ckvn = (bf16_t*)(p.ws + WS_CKVN); bf16_t* kf = (bf16_t*)(p.ws + WS_KF);
    const f32x2* rope = (const f32x2*)(p.ws + WS_ROPE);
    for (int t = v * NW + wave; t < T; t += G * NW) {
        const bf16_t* pr = proj + (size_t)t * NIN;
        {
            const u32x2 raw = *(const u32x2*)(pr + C_CQ + 4 * lane);
            float a[4] = {bflo(raw.x), bfhi(raw.x), bflo(raw.y), bfhi(raw.y)};
            float ss = wave_sum(a[0] * a[0] + a[1] * a[1] + a[2] * a[2] + a[3] * a[3], lane);
            const float rstd = rsqrtf(ss * (1.f / 256.f) + 1e-6f);
            const f32x4 gv = *(const f32x4*)(qg + 4 * lane);
            u32x2 w; w.x = pk2(a[0] * rstd * gv[0], a[1] * rstd * gv[1]); w.y = pk2(a[2] * rstd * gv[2], a[3] * rstd * gv[3]);
            *(u32x2*)(cqn + (size_t)t * 256 + 4 * lane) = w;
        }
        {
            const unsigned raw = *(const unsigned*)(pr + C_CKV + 2 * lane);
            const float a0 = bflo(raw), a1 = bfhi(raw);
            float ss = wave_sum(a0 * a0 + a1 * a1, lane);
            const float rstd = rsqrtf(ss * (1.f / 128.f) + 1e-6f);
            *(unsigned*)(ckvn + (size_t)t * 128 + 2 * lane) = pk2(a0 * rstd * kvg[2 * lane], a1 * rstd * kvg[2 * lane + 1]);
        }
        if (lane < 16) {
            const float x1 = bf2f(pr[C_KR + lane]), x2 = bf2f(pr[C_KR + 16 + lane]);
            const f32x2 cs = rope[(size_t)t * 16 + lane];
            const bf16_t y1 = f2bf(x1 * cs.x - x2 * cs.y), y2 = f2bf(x2 * cs.x + x1 * cs.y);
#pragma unroll
            for (int h = 0; h < 8; ++h) { kf[(size_t)t * 768 + h * 96 + 64 + lane] = y1; kf[(size_t)t * 768 + h * 96 + 80 + lane] = y2; }
        }
    }
}

__device__ __forceinline__ void phase_qkv(const Params& p, LAS char* L) {
    const int v = vcu(), G = grid_g();
    const bf16_t* proj = (const bf16_t*)(p.ws + WS_PROJ);
    const float* rstd_q = (const float*)(p.ws + WS_CQN); const float* rstd_kv = rstd_q + (1 << 18);
    const bf16_t* w_uq = (const bf16_t*)(p.ws + WS_WB) + WB_UQ; const bf16_t* w_ukv = (const bf16_t*)(p.ws + WS_WB) + WB_UKV;
    bf16_t* qm = (bf16_t*)(p.ws + WS_QM); bf16_t* kf = (bf16_t*)(p.ws + WS_KF); bf16_t* vm = (bf16_t*)(p.ws + WS_VM);
    const f32x2* rope = (const f32x2*)(p.ws + WS_ROPE);
    const float qscale = LOG2E * 0.10206207261596575f;
    for (int u = v; u < 64 * 7; u += G) {
        const int mt = u / 7, j = u % 7, m0 = mt * 256;
        if (j < 3) {
            const int n0 = j * 256;
            auto arow = [&](int r) { return (unsigned)(m0 + r) * NIN + C_CQ; };
            auto bcol = [&](int c) { return w_uq + n0 + c; };
            auto epi = [&](f32x16 (&acc)[4][2], int seg, LAS char* Ls) {
                const int tid_ = otid(), lane = tid_ & 63, wave = tid_ >> 6, wm = wave & 1, wn = wave >> 1, l31 = lane & 31, hi = lane >> 5;
#pragma unroll
                for (int mi = 0; mi < 4; ++mi) {
                    const int m = m0 + 128 * wm + 32 * mi + l31;
                    const float qs = qscale * rstd_q[m];
#pragma unroll
                    for (int ni = 0; ni < 2; ++ni) {
                        const int nbg = n0 + nb_of<0>(wn, ni);
                        if ((nbg % 96) == 64) {
#pragma unroll
                            for (int r = 0; r < 8; ++r) {
                                const f32x2 cs = rope[(size_t)m * 16 + crow(r, hi)];
                                const float x1 = acc[mi][ni][r], x2 = acc[mi][ni][r + 8];
                                acc[mi][ni][r] = x1 * cs.x - x2 * cs.y; acc[mi][ni][r + 8] = x2 * cs.x + x1 * cs.y;
                            }
                        }
#pragma unroll
                        for (int r = 0; r < 16; ++r) acc[mi][ni][r] *= qs;
                    }
                }
                store_tile_bf16<4, 256>(Ls, acc, [&](int row, int c) -> bf16_t* { return qm + (size_t)(m0 + row) * 768 + n0 + 8 * c; });
            };
            gemm_tile<4, 0, true>(L, 256 / 64, 768, proj, arow, bcol, epi);
        } else {
            const int n0 = (j - 3) * 256;
            auto arow = [&](int r) { return (unsigned)(m0 + r) * NIN + C_CKV; };
            auto bcol = [&](int c) { return w_ukv + n0 + c; };
            auto epi = [&](f32x16 (&acc)[4][2], int seg, LAS char* Ls) {
                {
                    const int tid_ = otid(), lane = tid_ & 63, wave = tid_ >> 6, wm = wave & 1, l31 = lane & 31;
#pragma unroll
                    for (int mi = 0; mi < 4; ++mi) {
                        const float rs = rstd_kv[m0 + 128 * wm + 32 * mi + l31];
#pragma unroll
                        for (int ni = 0; ni < 2; ++ni)
#pragma unroll
                            for (int r = 0; r < 16; ++r) acc[mi][ni][r] *= rs;
                    }
                }
                store_tile_bf16<4, 256>(Ls, acc, [&](int row, int c) -> bf16_t* {
                    const int h = (n0 >> 7) + (c >> 4), cc = c & 15;
                    return cc < 8 ? kf + (size_t)(m0 + row) * 768 + h * 96 + 8 * cc : vm + (size_t)(m0 + row) * 512 + h * 64 + 8 * (cc - 8); });
            };
            gemm_tile<4, 0, true>(L, 128 / 64, 1024, proj, arow, bcol, epi);
        }
    }
}

template <int DQK, int DV, bool ALIBI>
__device__ __forceinline__ void attn_map(LAS char* L, const bf16_t* Q, int ldq, const bf16_t* K, int ldk, const bf16_t* V, int ldv,
                                         const int* posrow, float slope2, int q0, f32x16 (&o)[DV / 32], const bf16_t* K2 = nullptr, int ldk2 = 0) {
    constexpr int KSTR = DQK * 2 + 16, VSTR = DV * 2 + 64, KS = DQK / 16, ND = DV / 32;
    constexpr int K_OFF = 0, V_OFF = 64 * KSTR, P_OFF = V_OFF + 64 * VSTR, ABUF = P_OFF + 256;
    constexpr int KCH = DQK / 8, VCH = DV / 8;
    constexpr int NKI = (64 * KCH + NT - 1) / NT, NVI = (64 * VCH + NT - 1) / NT;
    static_assert(3 * ABUF <= G_LDS, "attention ring");
    const int tid = otid();
    const int lane = tid & 63, wave = tid >> 6, l31 = lane & 31, hi = lane >> 5;
    const int qrow = q0 + 32 * wave + l31;
    unsigned kgo[NKI], klo[NKI], vgo[NVI], vlo[NVI];
    bool k2s[NKI];
#pragma unroll
    for (int i = 0; i < NKI; ++i) { int c = tid + NT * i; if (c >= 64 * KCH) c = 64 * KCH - 1; const int row = c / KCH, ch = c % KCH; k2s[i] = (DQK == 96) && (ch >= 8);
        kgo[i] = k2s[i] ? (unsigned)(row * ldk2 + (ch - 8) * 8) * 2u : (unsigned)(row * ldk + ch * 8) * 2u; klo[i] = K_OFF + row * KSTR + ch * 16; }
#pragma unroll
    for (int i = 0; i < NVI; ++i) { int c = tid + NT * i; if (c >= 64 * VCH) c = 64 * VCH - 1; const int row = c / VCH, ch = c % VCH; vgo[i] = (unsigned)(row * ldv + ch * 8) * 2u; vlo[i] = V_OFF + row * VSTR + ch * 16; }
    bf16x8 qf[KS];
#pragma unroll
    for (int s = 0; s < KS; ++s) qf[s] = *(const bf16x8*)(Q + (size_t)qrow * ldq + 16 * s + 8 * hi);
    const float posq = ALIBI ? (float)posrow[qrow] : 0.f;
#pragma unroll
    for (int d = 0; d < ND; ++d)
#pragma unroll
        for (int r = 0; r < 16; ++r) o[d][r] = 0.f;
    float m_run = -1e30f, l_run = 0.f;
    const int ntile = (q0 + 256) / 64;
    const int qmin = q0 + 32 * wave, qmax = qmin + 31;
    const int vrd = V_OFF + (4 * hi + ((lane & 15) >> 2)) * VSTR + 2 * (16 * ((lane >> 4) & 1) + 4 * (lane & 3));
    u32x4 rk[NKI], rv[NVI]; float rp = 0.f;
#define A_LOAD(T) do { \
        const char* kbase_ = (const char*)(K + (size_t)(T) * 64 * ldk); const char* kbase2_ = (const char*)(K2 + (size_t)(T) * 64 * ldk2); \
        const char* vbase_ = (const char*)(V + (size_t)(T) * 64 * ldv); \
        _Pragma("unroll") for (int i = 0; i < NKI; ++i) rk[i] = *(const u32x4*)((k2s[i] ? kbase2_ : kbase_) + kgo[i]); \
        _Pragma("unroll") for (int i = 0; i < NVI; ++i) rv[i] = *(const u32x4*)(vbase_ + vgo[i]); \
        if (ALIBI && tid < 64) rp = (float)posrow[(T) * 64 + tid]; } while (0)
#define A_STORE(LP) do { \
        _Pragma("unroll") for (int i = 0; i < NKI; ++i) if (tid + NT * i < 64 * KCH) *(LAS u32x4*)((LP) + klo[i]) = rk[i]; \
        _Pragma("unroll") for (int i = 0; i < NVI; ++i) if (tid + NT * i < 64 * VCH) *(LAS u32x4*)((LP) + vlo[i]) = rv[i]; \
        if (ALIBI && tid < 64) *(LAS float*)((LP) + P_OFF + 4 * tid) = rp; } while (0)
#define A_KFRAG(DST, LP, S_) do { DST[0] = *(LAS bf16x8*)((LP) + K_OFF + l31 * KSTR + 32 * (S_) + 16 * hi); DST[1] = *(LAS bf16x8*)((LP) + K_OFF + (32 + l31) * KSTR + 32 * (S_) + 16 * hi); } while (0)
#define A_SCORES(S0, S1, LP, KB) do { \
        _Pragma("unroll") for (int r = 0; r < 16; ++r) { S0[r] = 0.f; S1[r] = 0.f; } \
        bf16x8 kfa_[2], kfb_[2]; \
        A_KFRAG(kfa_, LP, 0); \
        _Pragma("unroll") for (int s = 0; s < KS; s += 2) {        \
            if (s + 1 < KS) A_KFRAG(kfb_, LP, s + 1); \
            S0 = MFMA32(kfa_[0], qf[s], S0); S1 = MFMA32(kfa_[1], qf[s], S1); \
            __builtin_amdgcn_sched_barrier(0); \
            if (s + 1 < KS) { \
                if (s + 2 < KS) A_KFRAG(kfa_, LP, s + 2); \
                S0 = MFMA32(kfb_[0], qf[s + 1], S0); S1 = MFMA32(kfb_[1], qf[s + 1], S1); \
                __builtin_amdgcn_sched_barrier(0); } } \
        if (ALIBI) { \
            _Pragma("unroll") for (int g4 = 0; g4 < 4; ++g4) { \
                const f32x4 pk0_ = *(LAS f32x4*)((LP) + P_OFF + 4 * (8 * g4 + 4 * hi)), pk1_ = *(LAS f32x4*)((LP) + P_OFF + 4 * (32 + 8 * g4 + 4 * hi)); \
                _Pragma("unroll") for (int e = 0; e < 4; ++e) { S0[4 * g4 + e] -= slope2 * fabsf(posq - pk0_[e]); S1[4 * g4 + e] -= slope2 * fabsf(posq - pk1_[e]); } } } \
        if ((KB) + 63 > qmin) { \
            _Pragma("unroll") for (int r = 0; r < 16; ++r) { const int key_ = (KB) + crow(r, hi); if (key_ > qrow) S0[r] = -INFINITY; if (key_ + 32 > qrow) S1[r] = -INFINITY; } } } while (0)
#define A_VFRAG(DST, LP, S_) do { _Pragma("unroll") for (int d = 0; d < ND; ++d) { \
            LAS char* vp_ = (LP) + vrd + 16 * (S_) * VSTR + 64 * d; const s16x4 lo_ = tr_read(vp_), h4_ = tr_read(vp_ + 8 * VSTR); \
            DST[d] = (bf16x8){lo_[0], lo_[1], lo_[2], lo_[3], h4_[0], h4_[1], h4_[2], h4_[3]}; } } while (0)
#define A_SOFTMAX_PV(S0, S1, LP) do { \
        bf16x8 vfa_[ND], vfb_[ND]; \
        A_VFRAG(vfa_, LP, 0);                                       \
        float mx_ = S0[0]; \
        _Pragma("unroll") for (int r = 1; r < 16; ++r) mx_ = fmaxf(mx_, S0[r]); \
        _Pragma("unroll") for (int r = 0; r < 16; ++r) mx_ = fmaxf(mx_, S1[r]); \
        mx_ = fmaxf(mx_, shx(mx_, 32, lane)); \
        if (__any(mx_ > m_run + 8.f)) { \
            const float m_new_ = fmaxf(m_run, mx_); const float alpha_ = __builtin_amdgcn_exp2f(m_run - m_new_); m_run = m_new_; l_run *= alpha_; \
            _Pragma("unroll") for (int d = 0; d < ND; ++d) _Pragma("unroll") for (int r = 0; r < 16; ++r) o[d][r] *= alpha_; } \
        float ls_ = 0.f; \
        _Pragma("unroll") for (int r = 0; r < 16; ++r) { S0[r] = __builtin_amdgcn_exp2f(S0[r] - m_run); S1[r] = __builtin_amdgcn_exp2f(S1[r] - m_run); ls_ += S0[r] + S1[r]; } \
        l_run += ls_; \
        u32x4 pw_[4]; \
        _Pragma("unroll") for (int j = 0; j < 4; ++j) { \
            pw_[0][j] = pk2(S0[2 * j], S0[2 * j + 1]); pw_[1][j] = pk2(S0[8 + 2 * j], S0[8 + 2 * j + 1]); \
            pw_[2][j] = pk2(S1[2 * j], S1[2 * j + 1]); pw_[3][j] = pk2(S1[8 + 2 * j], S1[8 + 2 * j + 1]); } \
        __builtin_amdgcn_sched_barrier(0); \
        A_VFRAG(vfb_, LP, 1); \
        _Pragma("unroll") for (int d = 0; d < ND; ++d) o[d] = MFMA32(vfa_[d], __builtin_bit_cast(bf16x8, pw_[0]), o[d]); \
        __builtin_amdgcn_sched_barrier(0); \
        A_VFRAG(vfa_, LP, 2); \
        _Pragma("unroll") for (int d = 0; d < ND; ++d) o[d] = MFMA32(vfb_[d], __builtin_bit_cast(bf16x8, pw_[1]), o[d]); \
        __builtin_amdgcn_sched_barrier(0); \
        A_VFRAG(vfb_, LP, 3); \
        _Pragma("unroll") for (int d = 0; d < ND; ++d) o[d] = MFMA32(vfa_[d], __builtin_bit_cast(bf16x8, pw_[2]), o[d]); \
        __builtin_amdgcn_sched_barrier(0); \
        _Pragma("unroll") for (int d = 0; d < ND; ++d) o[d] = MFMA32(vfb_[d], __builtin_bit_cast(bf16x8, pw_[3]), o[d]); \
        __builtin_amdgcn_sched_barrier(0); } while (0)
    A_LOAD(0);
    __syncthreads();
    A_STORE(L);
    A_LOAD(1);
    A_STORE(L + ABUF);
    __syncthreads();
    f32x16 sa0, sa1, sb0, sb1;
    A_SCORES(sa0, sa1, L, 0);
    int bc = 0;
    for (int tl = 0; tl < ntile; ++tl) {
        const int kb = tl * 64;
        const int bn = (bc == 2) ? 0 : bc + 1, bnn = (bn == 2) ? 0 : bn + 1;
        LAS char* Lc = L + bc * ABUF; LAS char* Ln = L + bn * ABUF; LAS char* Lnn = L + bnn * ABUF;
        const bool more2 = tl + 2 < ntile;
        if (more2) A_LOAD(tl + 2);
        const bool act_c = kb <= qmax, act_n = (tl + 1 < ntile) && (kb + 64 <= qmax);
        if (act_n) {
            A_SCORES(sb0, sb1, Ln, kb + 64);
            A_SOFTMAX_PV(sa0, sa1, Lc);
            sa0 = sb0; sa1 = sb1;
        } else if (act_c) {
            A_SOFTMAX_PV(sa0, sa1, Lc);
        }
        if (more2) A_STORE(Lnn);
        __syncthreads();
        bc = bn;
    }
#undef A_LOAD
#undef A_STORE
#undef A_SCORES
#undef A_SOFTMAX_PV
#undef A_KFRAG
#undef A_VFRAG
    const float lt = l_run + shx(l_run, 32, lane);
    const float inv = 1.f / lt;
#pragma unroll
    for (int d = 0; d < ND; ++d)
#pragma unroll
        for (int r = 0; r < 16; ++r) o[d][r] *= inv;
}

__device__ __forceinline__ void attn_decode(int it, int& kind, int& qb, int& idx) {
    const int seg_kind[16] = {1, 1, 1, 1, 1, 0, 1, 0, 0, 0, 1, 0, 0, 1, 0, 0};
    const int seg_qb[16]   = {7, 6, 5, 4, 3, 7, 2, 6, 5, 4, 1, 3, 2, 0, 1, 0};
    int base = 0; kind = 0; qb = 0; idx = 0;
#pragma unroll
    for (int s = 0; s < 16; ++s) {
        const int n = seg_kind[s] ? 32 : 64;
        if (it >= base && it < base + n) { kind = seg_kind[s]; qb = seg_qb[s]; idx = it - base; }
        base += n;
    }
}

__device__ __forceinline__ void phase_attn(const Params& p, LAS char* L) {
    const int v = vcu(), G = grid_g();
    const int tid = otid(), lane = tid & 63, wave = tid >> 6, l31 = lane & 31, hi = lane >> 5;
    const int* positions = (const int*)p.in[2];
    const bf16_t* proj = (const bf16_t*)(p.ws + WS_PROJ);
    const bf16_t* qm = (const bf16_t*)(p.ws + WS_QM); const bf16_t* kf = (const bf16_t*)(p.ws + WS_KF); const bf16_t* vm = (const bf16_t*)(p.ws + WS_VM);
    bf16_t* att = (bf16_t*)(p.ws + WS_ATT);
    float* od0 = (float*)(p.ws + WS_OD0);
    const float* subg = p.in[16];
    unsigned* qctr = (unsigned*)(p.ws + WS_CTL + 2048);
    LAS unsigned* qslot = (LAS unsigned*)(L + OFF_MISC + 16);
    float lam;
    {
        const float a = p.in[12][lane] * p.in[13][lane], b = p.in[14][lane] * p.in[15][lane];
        lam = __expf(wave_sum(a, lane)) - __expf(wave_sum(b, lane)) + LAMBDA_INIT;
    }
    for (;;) {
        if (tid == 0) *qslot = __hip_atomic_fetch_add(qctr, 1u, __ATOMIC_RELAXED, __HIP_MEMORY_SCOPE_AGENT);
        __syncthreads();
        const int it = (int)*qslot;
        __syncthreads();
        if (it >= 768) break;
        int kind, qb, idx;
        attn_decode(it, kind, qb, idx);
        const int q0 = qb * 256;
        if (kind == 0) {
            const int b = idx >> 3, h = idx & 7; const size_t tb = (size_t)b * SEQ;
            f32x16 o[2];
            attn_map<96, 64, false>(L, qm + tb * 768 + h * 96, 768, kf + tb * 768 + h * 96, 768, vm + tb * 512 + h * 64, 512, positions + tb, 0.f, q0, o, proj + tb * NIN + C_KR, NIN);
            const size_t t = tb + q0 + 32 * wave + l31;
#pragma unroll
            for (int d = 0; d < 2; ++d)
#pragma unroll
                for (int gq = 0; gq < 4; ++gq) {
                    u32x2 w; w.x = pk2(o[d][4 * gq], o[d][4 * gq + 1]); w.y = pk2(o[d][4 * gq + 2], o[d][4 * gq + 3]);
                    *(u32x2*)(att + t * 1024 + h * 64 + 32 * d + 8 * gq + 4 * hi) = w;
                }
        } else {
            const int b = idx >> 2, h = idx & 3; const size_t tb = (size_t)b * SEQ;
            const float slope2 = exp2f(-2.f * (h + 1)) * LOG2E;
            const size_t t = tb + q0 + 32 * wave + l31;
            f32x16 o[4];
            attn_map<64, 128, true>(L, proj + tb * NIN + C_DQ + h * 128, NIN, proj + tb * NIN + C_DK + h * 128, NIN, proj + tb * NIN + C_DV + h * 128, NIN, positions + tb, slope2, q0, o);
#pragma unroll
            for (int d = 0; d < 4; ++d)
#pragma unroll
                for (int gq = 0; gq < 4; ++gq) {
                    f32x4 w = {o[d][4 * gq], o[d][4 * gq + 1], o[d][4 * gq + 2], o[d][4 * gq + 3]};
                    *(f32x4*)(od0 + t * 512 + h * 128 + 32 * d + 8 * gq + 4 * hi) = w;
                }
            attn_map<64, 128, true>(L, proj + tb * NIN + C_DQ + h * 128 + 64, NIN, proj + tb * NIN + C_DK + h * 128 + 64, NIN, proj + tb * NIN + C_DV + h * 128, NIN, positions + tb, slope2, q0, o);
            float ss = 0.f;
#pragma unroll
            for (int d = 0; d < 4; ++d)
#pragma unroll
                for (int gq = 0; gq < 4; ++gq) {
                    const f32x4 w = *(const f32x4*)(od0 + t * 512 + h * 128 + 32 * d + 8 * gq + 4 * hi);
#pragma unroll
                    for (int e = 0; e < 4; ++e) { const float c = w[e] - lam * o[d][4 * gq + e]; o[d][4 * gq + e] = c; ss += c * c; }
                }
            ss += shx(ss, 32, lane);
            const float rstd = rsqrtf(ss * (1.f / 128.f) + 1e-5f) * (1.f - LAMBDA_INIT);
#pragma unroll
            for (int d = 0; d < 4; ++d)
#pragma unroll
                for (int gq = 0; gq < 4; ++gq) {
                    const int dv = 32 * d + 8 * gq + 4 * hi;
                    const f32x4 gv = *(const f32x4*)(subg + dv);
                    u32x2 w; w.x = pk2(o[d][4 * gq] * rstd * gv[0], o[d][4 * gq + 1] * rstd * gv[1]); w.y = pk2(o[d][4 * gq + 2] * rstd * gv[2], o[d][4 * gq + 3] * rstd * gv[3]);
                    *(u32x2*)(att + t * 1024 + 512 + h * 128 + dv) = w;
                }
        }
    }
}

__device__ __forceinline__ void phase_oproj(const Params& p, LAS char* L) {
    const int v = vcu(), G = grid_g();
    const bf16_t* att = (const bf16_t*)(p.ws + WS_ATT);
    const bf16_t* w_o = (const bf16_t*)(p.ws + WS_WB) + WB_O;
    bf16_t* y1 = (bf16_t*)(p.ws + WS_Y1);
    for (int u = v; u < 64 * 4; u += G) {
        const int mt = u >> 2, nt = u & 3, m0 = mt * 256, n0 = nt * 256;
        auto arow = [&](int r) { return (unsigned)(m0 + r) * Dm; };
        auto bcol = [&](int c) { return w_o + n0 + c; };
        auto epi = [&](f32x16 (&acc)[4][2], int seg, LAS char* Ls) {
            store_tile_bf16<4, 256>(Ls, acc, [&](int row, int c) -> bf16_t* { return y1 + (size_t)(m0 + row) * Dm + n0 + 8 * c; });
        };
        gemm_tile<4, 0, true>(L, Dm / 64, Dm, att, arow, bcol, epi);
    }
}

__device__ __forceinline__ void phase_post_attn(const Params& p) {
    const int v = vcu(), G = grid_g();
    const int tid = otid(), lane = tid & 63, wave = tid >> 6;
    const float* x = p.in[0]; const float* pg = p.in[6]; const float* fg = p.in[18];
    const float* mod = (const float*)(p.ws + WS_MOD);
    const bf16_t* y1 = (const bf16_t*)(p.ws + WS_Y1);
    bf16_t* h2 = (bf16_t*)(p.ws + WS_H2);
    for (int t = v * NW + wave; t < T; t += G * NW) {
        const int b = t / SEQ;
        const float* mb = mod + b * 6144;
        f32x4 yv[4], xv[4]; float ss = 0.f;
#pragma unroll
        for (int j = 0; j < 4; ++j) {
            const u32x2 raw = *(const u32x2*)(y1 + (size_t)t * Dm + 4 * (lane + 64 * j));
            yv[j] = (f32x4){bflo(raw.x), bfhi(raw.x), bflo(raw.y), bfhi(raw.y)};
            xv[j] = *(const f32x4*)(x + (size_t)t * Dm + 4 * (lane + 64 * j));
            ss += yv[j][0] * yv[j][0] + yv[j][1] * yv[j][1] + yv[j][2] * yv[j][2] + yv[j][3] * yv[j][3];
        }
        ss = wave_sum(ss, lane);
        const float rstd = rsqrtf(ss * (1.f / Dm) + 1e-6f);
        float ss2 = 0.f;
#pragma unroll
        for (int j = 0; j < 4; ++j) {
            const int col = 4 * (lane + 64 * j);
            const f32x4 gv = *(const f32x4*)(pg + col), ga = *(const f32x4*)(mb + 2048 + col);
#pragma unroll
            for (int e = 0; e < 4; ++e) { xv[j][e] = xv[j][e] + ga[e] * (yv[j][e] * rstd * gv[e]); ss2 += xv[j][e] * xv[j][e]; }
            *(f32x4*)(p.out + (size_t)t * Dm + col) = xv[j];
        }
        ss2 = wave_sum(ss2, lane);
        const float rstd2 = rsqrtf(ss2 * (1.f / Dm) + 1e-6f);
#pragma unroll
        for (int j = 0; j < 4; ++j) {
            const int col = 4 * (lane + 64 * j);
            const f32x4 gv = *(const f32x4*)(fg + col), sv = *(const f32x4*)(mb + 4096 + col), hv = *(const f32x4*)(mb + 3072 + col);
            float o[4];
#pragma unroll
            for (int e = 0; e < 4; ++e) o[e] = (xv[j][e] * rstd2 * gv[e]) * (1.f + sv[e]) + hv[e];
            u32x2 w; w.x = pk2(o[0], o[1]); w.y = pk2(o[2], o[3]);
            *(u32x2*)(h2 + (size_t)t * Dm + col) = w;
        }
    }
}

__device__ __forceinline__ void phase_router(const Params& p, LAS char* L) {
    const int v = vcu(), G = grid_g();
    const bf16_t* h2 = (const bf16_t*)(p.ws + WS_H2);
    const bf16_t* rw = (const bf16_t*)(p.ws + WS_WB) + WB_R;
    float* lg = (float*)(p.ws + WS_LOG);
    for (int u = v; u < 128; u += G) {
        const int m0 = u * 128;
        auto arow = [&](int r) { return (unsigned)(m0 + r) * Dm; };
        auto bcol = [&](int c) { return rw + c; };
        auto epi = [&](f32x16 (&acc)[2][2], int seg, LAS char* Ls) {
            const int tid_ = otid(), lane = tid_ & 63, wave = tid_ >> 6, wm = wave & 1, wn = wave >> 1, l31 = lane & 31, hi = lane >> 5;
#pragma unroll
            for (int mi = 0; mi < 2; ++mi) {
                const int m = m0 + 64 * wm + 32 * mi + l31;
#pragma unroll
                for (int ni = 0; ni < 2; ++ni) {
                    const int nbg = nb_of<0>(wn, ni);
#pragma unroll
                    for (int gq = 0; gq < 4; ++gq) {
                        f32x4 w = {acc[mi][ni][4 * gq], acc[mi][ni][4 * gq + 1], acc[mi][ni][4 * gq + 2], acc[mi][ni][4 * gq + 3]};
                        *(f32x4*)(lg + (size_t)m * NE + nbg + 8 * gq + 4 * hi) = w;
                    }
                }
            }
        };
        gemm_tile<2, 0, true>(L, Dm / 64, NE, h2, arow, bcol, epi);
    }
}

__device__ __forceinline__ unsigned fkey(float f) { const unsigned u = __float_as_uint(f); return (u & 0x80000000u) ? ~u : (u | 0x80000000u); }
template <int CTRL, int RM> __device__ __forceinline__ unsigned dppu(unsigned old, unsigned src) { return (unsigned)__builtin_amdgcn_update_dpp((int)old, (int)src, CTRL, RM, 0xf, false); }
template <int CTRL, int RM> __device__ __forceinline__ float dppf(float old, float src) { return __int_as_float(__builtin_amdgcn_update_dpp(__float_as_int(old), __float_as_int(src), CTRL, RM, 0xf, false)); }
__device__ __forceinline__ unsigned wave_umax(unsigned v) {
    v = max(v, dppu<0x111, 0xf>(v, v)); v = max(v, dppu<0x112, 0xf>(v, v)); v = max(v, dppu<0x114, 0xf>(v, v)); v = max(v, dppu<0x118, 0xf>(v, v));
    v = max(v, dppu<0x142, 0xa>(v, v)); v = max(v, dppu<0x143, 0xc>(v, v));
    return (unsigned)__builtin_amdgcn_readlane((int)v, 63);
}
__device__ __forceinline__ float wave_fsum_dpp(float v) {
    v += dppf<0x111, 0xf>(0.f, v); v += dppf<0x112, 0xf>(0.f, v); v += dppf<0x114, 0xf>(0.f, v); v += dppf<0x118, 0xf>(0.f, v);
    v += dppf<0x142, 0xa>(0.f, v); v += dppf<0x143, 0xc>(0.f, v);
    return __int_as_float(__builtin_amdgcn_readlane(__float_as_int(v), 63));
}
__device__ __forceinline__ void phase_route(const Params& p, LAS char* Lw) {
    const int v = vcu(), G = grid_g();
    const int tid = otid(), lane = tid & 63, wave = tid >> 6;
    const float* lg = (const float*)(p.ws + WS_LOG);
    const float* rb = p.in[21];
    int* cnt = (int*)(p.ws + WS_CTL);
    int* la = (int*)(p.ws + WS_LA); float* lw = (float*)(p.ws + WS_LW);
    const f32x4 bias = *(const f32x4*)(rb + 4 * lane);
    const int grp = lane >> 3;
    for (int t = v * NW + wave; t < T; t += G * NW) {
        const f32x4 lgv = *(const f32x4*)(lg + (size_t)t * NE + 4 * lane);
        const float s0 = 1.f / (1.f + __expf(-lgv[0])), s1 = 1.f / (1.f + __expf(-lgv[1])), s2 = 1.f / (1.f + __expf(-lgv[2])), s3 = 1.f / (1.f + __expf(-lgv[3]));
        float v0 = s0 + bias[0], v1 = s1 + bias[1], v2 = s2 + bias[2], v3 = s3 + bias[3];
        float t1 = fmaxf(v0, v1), t2 = fminf(v0, v1);
        { const float a = fmaxf(v2, v3), bq = fminf(v2, v3); const float n1 = fmaxf(t1, a), n2 = fmaxf(fminf(t1, a), fmaxf(t2, bq)); t1 = n1; t2 = n2; }
        { const float o1 = dppf<0xB1, 0xf>(t1, t1), o2 = dppf<0xB1, 0xf>(t2, t2); const float n1 = fmaxf(t1, o1), n2 = fmaxf(fminf(t1, o1), fmaxf(t2, o2)); t1 = n1; t2 = n2; }
        { const float o1 = dppf<0x4E, 0xf>(t1, t1), o2 = dppf<0x4E, 0xf>(t2, t2); const float n1 = fmaxf(t1, o1), n2 = fmaxf(fminf(t1, o1), fmaxf(t2, o2)); t1 = n1; t2 = n2; }
        { const float o1 = shx(t1, 4, lane), o2 = shx(t2, 4, lane); const float n1 = fmaxf(t1, o1), n2 = fmaxf(fminf(t1, o1), fmaxf(t2, o2)); t1 = n1; t2 = n2; }
        const float gs = t1 + t2;
        int rank = 0;
#pragma unroll
        for (int gg = 0; gg < 8; ++gg) { const float og = __int_as_float(__builtin_amdgcn_readlane(__float_as_int(gs), gg * 8)); rank += (og > gs || (og == gs && gg < grp)) ? 1 : 0; }
        if (rank >= 4) { v0 = -INFINITY; v1 = -INFINITY; v2 = -INFINITY; v3 = -INFINITY; }
        unsigned k0 = fkey(v0), k1 = fkey(v1), k2 = fkey(v2), k3 = fkey(v3);
        bool c0 = false, c1 = false, c2 = false, c3 = false;
#pragma unroll
        for (int it = 0; it < TOPK; ++it) {
            const unsigned lb = max(max(k0, k1), max(k2, k3));
            const unsigned m = wave_umax(lb);
            const unsigned long long bal = __ballot(lb == m);
            const int owner = __builtin_ctzll(bal);
            if (lane == owner) {
                if (k0 == m) { k0 = 0u; c0 = true; } else if (k1 == m) { k1 = 0u; c1 = true; } else if (k2 == m) { k2 = 0u; c2 = true; } else { k3 = 0u; c3 = true; }
            }
        }
        const float wsum = wave_fsum_dpp((c0 ? s0 : 0.f) + (c1 ? s1 : 0.f) + (c2 ? s2 : 0.f) + (c3 ? s3 : 0.f));
        const float wnorm = 2.5f / wsum;
        const unsigned long long m0 = __ballot(c0), m1 = __ballot(c1), m2 = __ballot(c2), m3 = __ballot(c3);
        const unsigned long long lm = (1ull << lane) - 1ull;
        const int q0 = __builtin_popcountll(m0 & lm), b1 = __builtin_popcountll(m0);
        const int q1 = b1 + __builtin_popcountll(m1 & lm), b2 = b1 + __builtin_popcountll(m1);
        const int q2 = b2 + __builtin_popcountll(m2 & lm), b3 = b2 + __builtin_popcountll(m2);
        const int q3 = b3 + __builtin_popcountll(m3 & lm);
        LAS int* slot = (LAS int*)(Lw + 64 * wave);
        if (c0) { slot[2 * q0] = 4 * lane + 0; slot[2 * q0 + 1] = __float_as_int(s0); }
        if (c1) { slot[2 * q1] = 4 * lane + 1; slot[2 * q1 + 1] = __float_as_int(s1); }
        if (c2) { slot[2 * q2] = 4 * lane + 2; slot[2 * q2 + 1] = __float_as_int(s2); }
        if (c3) { slot[2 * q3] = 4 * lane + 3; slot[2 * q3 + 1] = __float_as_int(s3); }
        asm volatile("s_waitcnt lgkmcnt(0)" ::: "memory");
        if (lane < TOPK) {
            const int e_ = slot[2 * lane]; const float sc = __int_as_float(slot[2 * lane + 1]);
            const int pos = atomicAdd(cnt + e_, 1);
            if (pos < LISTCAP) { la[(size_t)e_ * LISTCAP + pos] = t * TOPK + lane; lw[(size_t)e_ * LISTCAP + pos] = sc * wnorm; }
        }
    }
}

__device__ __forceinline__ void phase_router_route(const Params& p, LAS char* L) {
    const int v = vcu(), G = grid_g();
    const bf16_t* h2 = (const bf16_t*)(p.ws + WS_H2);
    const bf16_t* rw = (const bf16_t*)(p.ws + WS_WB) + WB_R;
    const float* rb = p.in[21];
    int* cnt = (int*)(p.ws + WS_CTL);
    int* la = (int*)(p.ws + WS_LA); float* lw = (float*)(p.ws + WS_LW);
    constexpr int LSTR = 1040;
    LAS int* pe = (LAS int*)(L + 69632);
    LAS float* pw = (LAS float*)(L + 69632 + 2048);
    LAS int* hist = (LAS int*)(L + 69632 + 4096);
    LAS int* basep = (LAS int*)(L + 69632 + 5120);
    for (int u = v; u < T / 64; u += G) {
        const int m0 = u * 64;
        auto arow = [&](int r) { return (unsigned)(m0 + r) * Dm; };
        auto bcol = [&](int c) { return rw + c; };
        auto epi = [&](f32x16 (&acc)[1][2], int seg, LAS char* Ls) {
            const int tid_ = otid(), lane = tid_ & 63, wave = tid_ >> 6, wm = wave & 1, wn = wave >> 1, l31 = lane & 31, hi = lane >> 5;
            const int row = 32 * wm + l31;
#pragma unroll
            for (int ni = 0; ni < 2; ++ni)
#pragma unroll
                for (int gq = 0; gq < 4; ++gq) {
                    f32x4 w = {acc[0][ni][4 * gq], acc[0][ni][4 * gq + 1], acc[0][ni][4 * gq + 2], acc[0][ni][4 * gq + 3]};
                    *(LAS f32x4*)(L + row * LSTR + 4 * (nb_of<0>(wn, ni) + 8 * gq + 4 * hi)) = w;
                }
        };
        gemm_tile<1, 0, true>(L, Dm / 64, NE, h2, arow, bcol, epi);
        const int tid = otid(), lane = tid & 63, wave = tid >> 6;
        if (tid < 256) hist[tid] = 0;
        __syncthreads();
        const f32x4 bias = *(const f32x4*)(rb + 4 * lane);
        const int grp = lane >> 3;
#pragma unroll 1
        for (int tt = 0; tt < 8; ++tt) {
            const int tok = 8 * wave + tt;
            const f32x4 lgv = *(LAS f32x4*)(L + tok * LSTR + 16 * lane);
            const float s0 = 1.f / (1.f + __expf(-lgv[0])), s1 = 1.f / (1.f + __expf(-lgv[1])), s2 = 1.f / (1.f + __expf(-lgv[2])), s3 = 1.f / (1.f + __expf(-lgv[3]));
            float v0 = s0 + bias[0], v1 = s1 + bias[1], v2 = s2 + bias[2], v3 = s3 + bias[3];
            float t1 = fmaxf(v0, v1), t2 = fminf(v0, v1);
            { const float a = fmaxf(v2, v3), bq = fminf(v2, v3); const float n1 = fmaxf(t1, a), n2 = fmaxf(fminf(t1, a), fmaxf(t2, bq)); t1 = n1; t2 = n2; }
            { const float o1 = dppf<0xB1, 0xf>(t1, t1), o2 = dppf<0xB1, 0xf>(t2, t2); const float n1 = fmaxf(t1, o1), n2 = fmaxf(fminf(t1, o1), fmaxf(t2, o2)); t1 = n1; t2 = n2; }
            { const float o1 = dppf<0x4E, 0xf>(t1, t1), o2 = dppf<0x4E, 0xf>(t2, t2); const float n1 = fmaxf(t1, o1), n2 = fmaxf(fminf(t1, o1), fmaxf(t2, o2)); t1 = n1; t2 = n2; }
            { const float o1 = shx(t1, 4, lane), o2 = shx(t2, 4, lane); const float n1 = fmaxf(t1, o1), n2 = fmaxf(fminf(t1, o1), fmaxf(t2, o2)); t1 = n1; t2 = n2; }
            const float gs = t1 + t2;
            int rank = 0;
#pragma unroll
            for (int gg = 0; gg < 8; ++gg) { const float og = __int_as_float(__builtin_amdgcn_readlane(__float_as_int(gs), gg * 8)); rank += (og > gs || (og == gs && gg < grp)) ? 1 : 0; }
            if (rank >= 4) { v0 = -INFINITY; v1 = -INFINITY; v2 = -INFINITY; v3 = -INFINITY; }
            unsigned k0 = fkey(v0), k1 = fkey(v1), k2 = fkey(v2), k3 = fkey(v3);
            bool c0 = false, c1 = false, c2 = false, c3 = false;
#pragma unroll
            for (int it = 0; it < TOPK; ++it) {
                const unsigned lb = max(max(k0, k1), max(k2, k3));
                const unsigned m = wave_umax(lb);
                const unsigned long long bal = __ballot(lb == m);
                const int owner = __builtin_ctzll(bal);
                if (lane == owner) {
                    if (k0 == m) { k0 = 0u; c0 = true; } else if (k1 == m) { k1 = 0u; c1 = true; } else if (k2 == m) { k2 = 0u; c2 = true; } else { k3 = 0u; c3 = true; }
                }
            }
            const float wsum = wave_fsum_dpp((c0 ? s0 : 0.f) + (c1 ? s1 : 0.f) + (c2 ? s2 : 0.f) + (c3 ? s3 : 0.f));
            const float wnorm = 2.5f / wsum;
            const unsigned long long b0 = __ballot(c0), b1 = __ballot(c1), b2 = __ballot(c2), b3 = __ballot(c3);
            const unsigned long long lm = (1ull << lane) - 1ull;
            const int q0 = __builtin_popcountll(b0 & lm), a1 = __builtin_popcountll(b0);
            const int q1 = a1 + __builtin_popcountll(b1 & lm), a2 = a1 + __builtin_popcountll(b1);
            const int q2 = a2 + __builtin_popcountll(b2 & lm), a3 = a2 + __builtin_popcountll(b2);
            const int q3 = a3 + __builtin_popcountll(b3 & lm);
            if (c0) { pe[8 * tok + q0] = 4 * lane + 0; pw[8 * tok + q0] = s0 * wnorm; }
            if (c1) { pe[8 * tok + q1] = 4 * lane + 1; pw[8 * tok + q1] = s1 * wnorm; }
            if (c2) { pe[8 * tok + q2] = 4 * lane + 2; pw[8 * tok + q2] = s2 * wnorm; }
            if (c3) { pe[8 * tok + q3] = 4 * lane + 3; pw[8 * tok + q3] = s3 * wnorm; }
        }
        __syncthreads();
        const int my_e = pe[tid];
        const int my_rank = __hip_atomic_fetch_add(hist + my_e, 1, __ATOMIC_RELAXED, __HIP_MEMORY_SCOPE_WORKGROUP);
        __syncthreads();
        if (tid < 256) { const int n = hist[tid]; basep[tid] = n > 0 ? atomicAdd(cnt + tid, n) : 0; }
        __syncthreads();
        {
            const int pos = basep[my_e] + my_rank;
            if (pos < LISTCAP) { la[(size_t)my_e * LISTCAP + pos] = (m0 + (tid >> 3)) * TOPK + (tid & 7); lw[(size_t)my_e * LISTCAP + pos] = pw[tid]; }
        }
        __syncthreads();
    }
}

__device__ __forceinline__ int moe_cnt(const int* cnt, int e) { int c = (e < 256) ? cnt[e] : T; return c > LISTCAP ? LISTCAP : c; }
__device__ __forceinline__ void moe_prefix(const Params& p, LAS char* L) {
    const int tid = otid();
    const int* cnt = (const int*)(p.ws + WS_CTL);
    LAS int* pre = (LAS int*)(L + OFF_PRE);
    LAS int* tl = (LAS int*)(L + OFF_TL);
    __syncthreads();
    for (int i = tid; i < 257; i += NT) { const int c = moe_cnt(cnt, i); tl[i] = (c + 255) >> 8; }
    __syncthreads();
    if (tid == 0) { int s = 0; for (int i = 0; i < 257; ++i) { pre[i] = s; s += tl[i]; } pre[257] = s; }
    __syncthreads();
}
__device__ __forceinline__ int moe_find(LAS int* pre, int g) {
    int lo = 0, hi = 256;
    while (lo < hi) { const int mid = (lo + hi + 1) >> 1; if (pre[mid] <= g) lo = mid; else hi = mid - 1; }
    return lo;
}

template <int MI>
__device__ __forceinline__ void moe1_unit(const Params& p, LAS char* L, int e, int r0, int rows, int j0) {
    const bf16_t* h2 = (const bf16_t*)(p.ws + WS_H2);
    const int* la = (const int*)(p.ws + WS_LA);
    bf16_t* hb = (bf16_t*)(p.ws + WS_HB);
    const float* wg = (e < 256) ? p.in[22] + (size_t)e * Dm * 256 : p.in[25];
    const float* wu = (e < 256) ? p.in[23] + (size_t)e * Dm * 256 : p.in[26];
    LAS int* rowid = (LAS int*)(L + OFF_ROW);
    {
        const int tid = otid();
        if (tid < 64 * MI) { const int rr = tid < rows ? tid : 0; rowid[tid] = (e < 256) ? la[(size_t)e * LISTCAP + r0 + rr] : (AR + r0 + rr); }
        __syncthreads();
    }
    auto arow = [&](int r) { const int a = rowid[r]; const int tok = (e < 256) ? (a >> 3) : (a - AR); return (unsigned)tok * Dm; };
    auto bcol = [&](int c4) { return (c4 < 128) ? (wg + j0 + c4) : (wu + j0 + c4 - 128); };
    auto epi = [&](f32x16 (&acc)[MI][2], int seg, LAS char* Ls) {
#pragma unroll
        for (int mi = 0; mi < MI; ++mi)
#pragma unroll
            for (int r = 0; r < 16; ++r) acc[mi][0][r] = silu_f(acc[mi][0][r]) * acc[mi][1][r];
        store_tile_bf16<MI, 128>(Ls, acc, [&](int row, int c) -> bf16_t* { return row < rows ? hb + (size_t)rowid[row] * 256 + j0 + 8 * c : nullptr; });
    };
    gemm_tile<MI, 1>(L, Dm / 64, 256, h2, arow, bcol, epi);
}
__device__ __forceinline__ void phase_moe1(const Params& p, LAS char* L) {
    const int v = vcu(), G = grid_g();
    const int* cnt = (const int*)(p.ws + WS_CTL);
    moe_prefix(p, L);
    LAS int* pre = (LAS int*)(L + OFF_PRE);
    const int total = __builtin_amdgcn_readfirstlane(pre[257]) * 2;
    for (int u = v; u < total; u += G) {
        const int g = u >> 1, j0 = (u & 1) * 128;
        const int e = __builtin_amdgcn_readfirstlane(moe_find(pre, g)), mt = g - __builtin_amdgcn_readfirstlane(pre[e]);
        const int rows = __builtin_amdgcn_readfirstlane(moe_cnt(cnt, e)) - mt * 256;
        if (rows > 128) moe1_unit<4>(p, L, e, mt * 256, rows < 256 ? rows : 256, j0);
        else moe1_unit<2>(p, L, e, mt * 256, rows, j0);
    }
}

template <int MI>
__device__ __forceinline__ void moe2_unit(const Params& p, LAS char* L, int e, int r0, int rows, int n0) {
    const int* la = (const int*)(p.ws + WS_LA); const float* lw = (const float*)(p.ws + WS_LW);
    const bf16_t* hb = (const bf16_t*)(p.ws + WS_HB);
    unsigned char* yb = (unsigned char*)(p.ws + WS_YB);
    const float* wd = (e < 256) ? p.in[24] + (size_t)e * 256 * Dm : p.in[27];
    LAS int* rowid = (LAS int*)(L + OFF_ROW);
    LAS float* roww = (LAS float*)(L + OFF_RW);
    {
        const int tid = otid();
        if (tid < 64 * MI) {
            const int rr = tid < rows ? tid : 0;
            rowid[tid] = (e < 256) ? la[(size_t)e * LISTCAP + r0 + rr] : (AR + r0 + rr);
            roww[tid] = (e < 256) ? lw[(size_t)e * LISTCAP + r0 + rr] : 1.f;
        }
        __syncthreads();
    }
    auto arow = [&](int r) { return (unsigned)rowid[r] * 256; };
    auto bcol = [&](int c4) { return wd + n0 + c4; };
    auto epi = [&](f32x16 (&acc)[MI][2], int seg, LAS char* Ls) {
        const int tid_ = otid(), lane = tid_ & 63, wave = tid_ >> 6, wm = wave & 1, l31 = lane & 31;
#pragma unroll
        for (int mi = 0; mi < MI; ++mi) {
            const float w = roww[32 * MI * wm + 32 * mi + l31] * YSCALE;
#pragma unroll
            for (int ni = 0; ni < 2; ++ni)
#pragma unroll
                for (int q = 0; q < 16; ++q) acc[mi][ni][q] = __builtin_amdgcn_fmed3f(acc[mi][ni][q] * w, -448.f, 448.f);
        }
        store_tile_fp8<MI>(Ls, acc, [&](int row, int c) -> unsigned char* { return row < rows ? yb + (size_t)rowid[row] * Dm + n0 + seg * 256 + 16 * c : nullptr; });
    };
    gemm_tile<MI, 0, false, 2>(L, 256 / 64, Dm, hb, arow, bcol, epi);
}
__device__ __forceinline__ void phase_moe2(const Params& p, LAS char* L) {
    const int v = vcu(), G = grid_g();
    const int* cnt = (const int*)(p.ws + WS_CTL);
    moe_prefix(p, L);
    LAS int* pre = (LAS int*)(L + OFF_PRE);
    const int total = __builtin_amdgcn_readfirstlane(pre[257]) * 2;
    for (int u = v; u < total; u += G) {
        const int g = u >> 1, n0 = (u & 1) * 512;
        const int e = __builtin_amdgcn_readfirstlane(moe_find(pre, g)), mt = g - __builtin_amdgcn_readfirstlane(pre[e]);
        const int rows = __builtin_amdgcn_readfirstlane(moe_cnt(cnt, e)) - mt * 256;
        if (rows > 128) moe2_unit<4>(p, L, e, mt * 256, rows < 256 ? rows : 256, n0);
        else moe2_unit<2>(p, L, e, mt * 256, rows, n0);
    }
}

__device__ __forceinline__ void phase_final(const Params& p) {
    const int v = vcu(), G = grid_g();
    const int tid = otid(), lane = tid & 63, wave = tid >> 6;
    const float* pg = p.in[19];
    const float* mod = (const float*)(p.ws + WS_MOD);
    const unsigned char* yb = (const unsigned char*)(p.ws + WS_YB);
    for (int t = v * NW + wave; t < T; t += G * NW) {
        const int b = t / SEQ;
        const float* gf = mod + b * 6144 + 5120;
        float y[16];
#pragma unroll
        for (int e = 0; e < 16; ++e) y[e] = 0.f;
#pragma unroll
        for (int k = 0; k < 9; ++k) {
            const size_t row = (k < 8) ? ((size_t)t * TOPK + k) : ((size_t)AR + t);
            const u32x4 raw = *(const u32x4*)(yb + row * Dm + 16 * lane);
#pragma unroll
            for (int e = 0; e < 4; ++e) {
                const f32x2 a = __builtin_amdgcn_cvt_pk_f32_fp8((int)raw[e], false), c = __builtin_amdgcn_cvt_pk_f32_fp8((int)raw[e], true);
                y[4 * e] += a.x; y[4 * e + 1] += a.y; y[4 * e + 2] += c.x; y[4 * e + 3] += c.y;
            }
        }
        float ss = 0.f;
#pragma unroll
        for (int e = 0; e < 16; ++e) { y[e] *= (1.f / YSCALE); ss += y[e] * y[e]; }
        ss = wave_sum(ss, lane);
        const float rstd = rsqrtf(ss * (1.f / Dm) + 1e-6f);
        const int col = 16 * lane;
#pragma unroll
        for (int hq = 0; hq < 4; ++hq) {
            f32x4 xo = *(const f32x4*)(p.out + (size_t)t * Dm + col + 4 * hq);
            const f32x4 gv = *(const f32x4*)(pg + col + 4 * hq), gg = *(const f32x4*)(gf + col + 4 * hq);
#pragma unroll
            for (int e = 0; e < 4; ++e) xo[e] += gg[e] * (y[4 * hq + e] * rstd * gv[e]);
            *(f32x4*)(p.out + (size_t)t * Dm + col + 4 * hq) = xo;
        }
    }
}

#define XB_TMO      128
#define XB_XCNT(j)  (256  + 64 * (j))
#define XB_XSUB(j)  (1280 + 64 * (j))
#define XB_XGEN(j)  (2304 + 64 * (j))
#define XB_TOP      3328
#define XB_TOPGEN   3392
#define XCD_BAR_WORDS 3456
#define XB_SPIN_CAP (1u << 18)
__device__ __forceinline__ unsigned xb_ld(unsigned* p)              { return __hip_atomic_load(p, __ATOMIC_RELAXED, __HIP_MEMORY_SCOPE_AGENT); }
__device__ __forceinline__ unsigned xb_add(unsigned* p, unsigned v) { return __hip_atomic_fetch_add(p, v, __ATOMIC_RELAXED, __HIP_MEMORY_SCOPE_AGENT); }
__device__ __forceinline__ unsigned xb_xcc_id() { return (unsigned)__builtin_amdgcn_s_getreg((3 << 11) | 20) & 0xFu; }
#define XB_SPIN(cond, bar) do { unsigned _sp = 0; while (cond) { __builtin_amdgcn_s_sleep(1); \
    if ((++_sp & 255u) == 0u) { if (xb_ld(&(bar)[XB_TMO])) break; if (_sp > XB_SPIN_CAP) { atomicAdd(&(bar)[XB_TMO], 1u); break; } } } } while (0)
struct XcdBarrier { unsigned* bar; unsigned x; volatile LAS unsigned* st; };
__device__ __forceinline__ XcdBarrier xcd_barrier_post(unsigned* bar, volatile LAS unsigned* st) {
    XcdBarrier b; b.bar = bar; b.x = xb_xcc_id(); b.st = st;
    if (threadIdx.x == 0) (void)xb_add(&bar[XB_XCNT(b.x)], 1u);
    return b;
}
__device__ __forceinline__ void xcd_barrier_complete(unsigned* bar, unsigned x, unsigned& nloc, unsigned& nx) {
    const unsigned G = gridDim.x * gridDim.y * gridDim.z;
    unsigned sum, cnt, mine, sp = 0u;
    for (;;) {
        sum = 0u; cnt = 0u; mine = 0u;
#pragma unroll
        for (unsigned j = 0; j < 16; ++j) { const unsigned c = xb_ld(&bar[XB_XCNT(j)]); sum += c; cnt += (c > 0u) ? 1u : 0u; mine = (j == x) ? c : mine; }
        if (sum == G) break;
        __builtin_amdgcn_s_sleep(1);
        if ((++sp & 255u) == 0u) { if (xb_ld(&bar[XB_TMO])) break; if (sp > XB_SPIN_CAP) { atomicAdd(&bar[XB_TMO], 1u); break; } }
    }
    nloc = mine > 0u ? mine : 1u; nx = cnt > 0u ? cnt : 1u;
}
__device__ __forceinline__ void xcd_barrier(const Params& p, LAS char* L) {
    XcdBarrier b; b.bar = (unsigned*)(p.ws + WS_CTL + 4096); b.x = xb_xcc_id(); b.st = (volatile LAS unsigned*)(L + OFF_MISC);
    asm volatile("s_waitcnt vmcnt(0)" ::: "memory");
    __syncthreads();
    if (threadIdx.x == 0) {
        unsigned* bar = b.bar;
        __builtin_amdgcn_s_waitcnt(0);
        unsigned nloc = b.st[0], nx = b.st[1];
        if (nloc == 0u) { xcd_barrier_complete(bar, b.x, nloc, nx); b.st[0] = nloc; b.st[1] = nx; }
        const unsigned old = xb_add(&bar[XB_XSUB(b.x)], 1u);
        const unsigned gen = old / nloc;
        if (old + 1u == (gen + 1u) * nloc) {
            __builtin_amdgcn_fence(__ATOMIC_RELEASE, "agent");
            asm volatile("s_waitcnt vmcnt(0)" ::: "memory");
            const unsigned og = xb_add(&bar[XB_TOP], 1u);
            const unsigned tg = og / nx;
            if (og + 1u == (tg + 1u) * nx) xb_add(&bar[XB_TOPGEN], 1u);
            else XB_SPIN(xb_ld(&bar[XB_TOPGEN]) == tg, bar);
            __builtin_amdgcn_fence(__ATOMIC_ACQUIRE, "agent");
            xb_add(&bar[XB_XGEN(b.x)], 1u);
            asm volatile("s_waitcnt vmcnt(0)" ::: "memory");
        } else {
            XB_SPIN(xb_ld(&bar[XB_XGEN(b.x)]) == gen, bar);
            __builtin_amdgcn_fence(__ATOMIC_ACQUIRE, "agent");
            asm volatile("s_waitcnt vmcnt(0)" ::: "memory");
        }
    }
    __syncthreads();
}

__global__ void __launch_bounds__(NT, 2) mega(Params p) {
    extern __shared__ __attribute__((aligned(16))) char smem[];
    LAS char* L = (LAS char*)smem;
    if (threadIdx.x < 8) ((LAS unsigned*)(L + OFF_MISC))[threadIdx.x] = 0u;
    __syncthreads();
    (void)xcd_barrier_post((unsigned*)(p.ws + WS_CTL + 4096), (volatile LAS unsigned*)(L + OFF_MISC));
    phase_mod(p, L);
    xcd_barrier(p, L);
    phase_h1(p);
    xcd_barrier(p, L);
    _Pragma("nounroll") for (int rep_ = 0; rep_ < REP_PROJ; ++rep_) phase_proj(p, L);
    xcd_barrier(p, L);
    _Pragma("nounroll") for (int rep_ = 0; rep_ < REP_SMALL; ++rep_) phase_qkv(p, L);
    xcd_barrier(p, L);
    phase_attn(p, L);
    xcd_barrier(p, L);
    _Pragma("nounroll") for (int rep_ = 0; rep_ < REP_SMALL; ++rep_) phase_oproj(p, L);
    xcd_barrier(p, L);
    phase_post_attn(p);
    xcd_barrier(p, L);
    phase_router_route(p, L);
    xcd_barrier(p, L);
    _Pragma("nounroll") for (int rep_ = 0; rep_ < REP_MOE1; ++rep_) phase_moe1(p, L);
    xcd_barrier(p, L);
    _Pragma("nounroll") for (int rep_ = 0; rep_ < REP_MOE2; ++rep_) phase_moe2(p, L);
    xcd_barrier(p, L);
    phase_final(p);
}

extern "C" void kernel_launch(void* const* d_in, const int* in_sizes, int n_in, void* d_out, int out_size, void* d_ws, size_t ws_size, hipStream_t stream) {
    static int grid_blocks = 0;
    if (grid_blocks == 0) {
        if (n_in != 28 || out_size != T * Dm || ws_size < WS_END) {
            fprintf(stderr, "kernel_launch: unexpected problem (n_in %d, out %d, ws %zu); nothing launched\n", n_in, out_size, ws_size);
            grid_blocks = -1; return;
        }
        int dev = 0, cus = 0, per_cu = 0;
        (void)hipGetDevice(&dev);
        (void)hipDeviceGetAttribute(&cus, hipDeviceAttributeMultiprocessorCount, dev);
        if (hipFuncSetAttribute((const void*)mega, hipFuncAttributeMaxDynamicSharedMemorySize, LDS_BYTES) != hipSuccess) {
            fprintf(stderr, "kernel_launch: hipFuncSetAttribute(%d B LDS) failed\n", LDS_BYTES); grid_blocks = -1; return;
        }
        (void)hipOccupancyMaxActiveBlocksPerMultiprocessor(&per_cu, mega, NT, LDS_BYTES);
        if (per_cu < 1) { fprintf(stderr, "kernel_launch: occupancy query says %d blocks per CU\n", per_cu); per_cu = 1; }
        grid_blocks = cus;
        fprintf(stderr, "kernel_launch: %d CUs, occupancy query %d per CU, grid %d\n", cus, per_cu, grid_blocks);
    }
    if (grid_blocks < 0) return;
    (void)hipMemsetAsync((char*)d_ws + WS_CTL, 0, CTL_BYTES, stream);
    Params p{};
    for (int i = 0; i < 28; ++i) p.in[i] = (const float*)d_in[i];
    p.out = (float*)d_out; p.ws = (char*)d_ws;
    void* args[] = {&p};
    hipError_t e = hipLaunchCooperativeKernel((void*)mega, dim3(grid_blocks), dim3(NT), args, LDS_BYTES, stream);
    if (e != hipSuccess) fprintf(stderr, "cooperative launch failed: %s (grid %d)\n", hipGetErrorString(e), grid_blocks);
}
```

```cpp
#include <hip/hip_runtime.h>
#include <cstdio>
#include <cstdint>


typedef unsigned short bf16_t;
typedef float f32x2 __attribute__((ext_vector_type(2)));
typedef short bf16x8 __attribute__((ext_vector_type(8)));
typedef short s16x4 __attribute__((ext_vector_type(4)));
typedef short v4i16_t __attribute__((ext_vector_type(4)));
typedef float f32x16 __attribute__((ext_vector_type(16)));
typedef float f32x4 __attribute__((ext_vector_type(4)));
typedef unsigned u32x4 __attribute__((ext_vector_type(4)));
typedef unsigned u32x2 __attribute__((ext_vector_type(2)));
#define LAS __attribute__((address_space(3)))

constexpr int NT = 512, NW = 8;
constexpr int Dm = 1024, NB = 8, SEQ = 2048, T = NB * SEQ;
constexpr int NIN = 1952;
constexpr int C_CQ = 0, C_CKV = 256, C_KR = 384, C_DQ = 416, C_DK = 928, C_DV = 1440;
constexpr int NE = 256, TOPK = 8, AR = T * TOPK, HROWS = AR + T;
constexpr int LISTCAP = T;
constexpr float LOG2E = 1.4426950408889634f;
constexpr float YSCALE = 32.f;
constexpr float LAMBDA_INIT = 0.2f;

constexpr size_t MiB = 1u << 20;
constexpr size_t WS_CTL = 0, CTL_BYTES = 65536;
constexpr size_t WS_MOD = 65536;
constexpr size_t WS_ROPE = 1 * MiB;
constexpr size_t WS_H1 = 4 * MiB;
constexpr size_t WS_PROJ = 36 * MiB;
constexpr size_t WS_CQN = 100 * MiB;
constexpr size_t WS_CKVN = 108 * MiB;
constexpr size_t WS_QM = 112 * MiB;
constexpr size_t WS_KF = 136 * MiB;
constexpr size_t WS_VM = 160 * MiB;
constexpr size_t WS_ATT = 176 * MiB;
constexpr size_t WS_OD0 = 208 * MiB;
constexpr size_t WS_Y1 = 240 * MiB;
constexpr size_t WS_H2 = 304 * MiB;
constexpr size_t WS_LOG = 336 * MiB;
constexpr size_t WS_LA = 352 * MiB;
constexpr size_t WS_LW = 368 * MiB;
constexpr size_t WS_HB = 384 * MiB;
constexpr size_t WS_YB = 456 * MiB;
constexpr size_t WS_WB = 744 * MiB;
constexpr size_t WB_IN = 0, WB_UQ = WB_IN + (size_t)1024 * 1952, WB_UKV = WB_UQ + 256 * 768, WB_O = WB_UKV + 128 * 1024, WB_R = WB_O + 1024 * 1024, WB_END = WB_R + 1024 * 256;
constexpr size_t WS_END = 760 * MiB;

constexpr int G_XB = 32768, G_WB = 36864, G_BUF = G_XB + G_WB, G_LDS = 2 * G_BUF;
constexpr int OFF_MISC = G_LDS, OFF_PRE = OFF_MISC + 64, OFF_TL = OFF_PRE + 1088;
constexpr int OFF_ROW = OFF_TL + 1088, OFF_RW = OFF_ROW + 1024;
constexpr int OFF_SS = OFF_RW + 1024;
constexpr int LDS_BYTES = G_LDS + 4352 + 4096;

struct Params {
    const float* in[28];
    float* out;
    char* ws;
};

__device__ __forceinline__ unsigned short f2bf(float f) { __bf16 b = (__bf16)f; return __builtin_bit_cast(unsigned short, b); }
typedef __bf16 bf16x2_t __attribute__((ext_vector_type(2)));
__device__ __forceinline__ unsigned pk2(float lo, float hi) { const f32x2 v = {lo, hi}; return __builtin_bit_cast(unsigned, __builtin_convertvector(v, bf16x2_t)); }
__device__ __forceinline__ float bf2f(unsigned short b) { return __uint_as_float(((unsigned)b) << 16); }
__device__ __forceinline__ float bflo(unsigned u) { return __uint_as_float(u << 16); }
__device__ __forceinline__ float bfhi(unsigned u) { return __uint_as_float(u & 0xffff0000u); }
__device__ __forceinline__ int crow(int r, int hi) { return (r & 3) + 8 * (r >> 2) + 4 * hi; }
__device__ __forceinline__ float shx(float v, int m, int lane) { return __int_as_float(__builtin_amdgcn_ds_bpermute((lane ^ m) << 2, __float_as_int(v))); }
__device__ __forceinline__ int shxi(int v, int m, int lane) { return __builtin_amdgcn_ds_bpermute((lane ^ m) << 2, v); }
__device__ __forceinline__ float shl(float v, int src) { return __int_as_float(__builtin_amdgcn_ds_bpermute(src << 2, __float_as_int(v))); }
__device__ __forceinline__ float wave_sum(float v, int lane) {
#pragma unroll
    for (int o = 32; o >= 1; o >>= 1) v += shx(v, o, lane);
    return v;
}
__device__ __forceinline__ float silu_f(float v) { return v / (1.f + __expf(-v)); }
__device__ __forceinline__ s16x4 tr_read(LAS char* p) {
    return __builtin_bit_cast(s16x4, __builtin_amdgcn_ds_read_tr16_b64_v4i16((LAS v4i16_t*)p));
}
__device__ __forceinline__ int otid() { int t = threadIdx.x; asm volatile("" : "+v"(t)); return t; }
__device__ __forceinline__ int grid_g() { return gridDim.x; }
__device__ __forceinline__ int vcu() { const int G = gridDim.x, bx = blockIdx.x; return (G % 8 == 0) ? (bx % 8) * (G / 8) + bx / 8 : bx; }
__device__ __forceinline__ void gld16(u32x4& d, const void* p) { asm volatile("global_load_dwordx4 %0, %1, off" : "+v"(d) : "v"(p) : "memory"); }
__device__ __forceinline__ void gld16(f32x4& d, const void* p) { asm volatile("global_load_dwordx4 %0, %1, off" : "+v"(d) : "v"(p) : "memory"); }
template <int N> __device__ __forceinline__ void vm_wait(u32x4& a, f32x4& b, f32x4& c) { asm volatile("s_waitcnt vmcnt(%3)" : "+v"(a), "+v"(b), "+v"(c) : "n"(N) : "memory"); }
template <int N> __device__ __forceinline__ void vm_wait(f32x4& b, f32x4& c) { asm volatile("s_waitcnt vmcnt(%2)" : "+v"(b), "+v"(c) : "n"(N) : "memory"); }
template <int N> __device__ __forceinline__ void vm_wait(u32x4& a, u32x4& b) { asm volatile("s_waitcnt vmcnt(%2)" : "+v"(a), "+v"(b) : "n"(N) : "memory"); }
template <int N> __device__ __forceinline__ void vm_wait(u32x4& b) { asm volatile("s_waitcnt vmcnt(%1)" : "+v"(b) : "n"(N) : "memory"); }
#define MFMA32(a, b, c) __builtin_amdgcn_mfma_f32_32x32x16_bf16(a, b, c, 0, 0, 0)

template <int NBMODE> __device__ __forceinline__ int nb_of(int wn, int ni) { return NBMODE == 0 ? 64 * wn + 32 * ni : 32 * wn + 128 * ni; }

template <int MI, int NBMODE, bool WBF = false, int NSEG = 1, class AF, class BF, class EF>
__device__ __forceinline__ void gemm_tile(LAS char* L, int nk, long ldw, const bf16_t* abase, AF arow, BF bcol, EF epi) {
    asm volatile("" : "+s"(nk));
    const int tid = otid(), lane = tid & 63, wave = tid >> 6;
    const int wm = wave & 1, wn = wave >> 1, l31 = lane & 31, hi = lane >> 5;
    const int a_chunk = tid & 7, a_row = tid >> 3;
    const int a_w = a_row * 128 + 16 * (a_chunk ^ ((a_row >> 1) & 7));
    const int b_n4 = WBF ? (tid & 31) : (tid & 63), b_kr = WBF ? (tid >> 5) : (tid >> 6);
    const auto bp = bcol((WBF ? 8 : 4) * b_n4) + (long)b_kr * ldw;
    const int b_w = G_XB + b_kr * 576 + (WBF ? 16 : 8) * b_n4;
    const int sw = (l31 >> 1) & 7;
    const int xoff = (32 * MI * wm + l31) * 128;
    const int woff = G_XB + (8 * hi + ((lane & 15) >> 2)) * 576 + 2 * (16 * ((lane >> 4) & 1) + 4 * (lane & 3));
    u32x4 ra[MI]; f32x4 rb[8]; u32x4 rw[4];
#pragma unroll
    for (int i = 0; i < MI; ++i) ra[i] = (u32x4){0u, 0u, 0u, 0u};
#pragma unroll
    for (int i = 0; i < 8; ++i) rb[i] = (f32x4){0.f, 0.f, 0.f, 0.f};
#pragma unroll
    for (int i = 0; i < 4; ++i) rw[i] = (u32x4){0u, 0u, 0u, 0u};
#define G_LOADW(KOFF, Q, SEGC) do { \
        if (WBF) { gld16(rw[Q], bp + (long)((KOFF) + 16 * (Q)) * ldw + (SEGC)); } \
        else { gld16(rb[2 * (Q)], bp + (long)((KOFF) + 16 * (Q)) * ldw + (SEGC)); gld16(rb[2 * (Q) + 1], bp + (long)((KOFF) + 16 * (Q) + 8) * ldw + (SEGC)); } } while (0)
#define G_LOADQ(KT, Q) do { \
        if ((Q) < MI) gld16(ra[(Q) < MI ? (Q) : 0], abase + arow(a_row + 64 * (Q)) + a_chunk * 8 + (KT) * 64); \
        G_LOADW((KT) * 64, Q, 0); } while (0)
#define G_LOADQ_SEL(KT, SEG, Q, OK) do { \
        const int kq_ = (OK) ? (KT) * 64 : 0; const int sc_ = (OK) ? (SEG) * 256 : 0; \
        if ((Q) < MI) gld16(ra[(Q) < MI ? (Q) : 0], abase + arow(a_row + 64 * (Q)) + a_chunk * 8 + kq_); \
        G_LOADW(kq_, Q, sc_); } while (0)
#define G_WAITQ(Q, N) do { \
        if (WBF) { if ((Q) < MI) vm_wait<N>(ra[(Q) < MI ? (Q) : 0], rw[Q]); else vm_wait<N>(rw[Q]); } \
        else { if ((Q) < MI) vm_wait<N>(ra[(Q) < MI ? (Q) : 0], rb[2 * (Q)], rb[2 * (Q) + 1]); else vm_wait<N>(rb[2 * (Q)], rb[2 * (Q) + 1]); } } while (0)
#define G_STOREQ(LP, Q) do { \
        if ((Q) < MI) *(LAS u32x4*)((LP) + a_w + (Q) * 8192) = ra[(Q) < MI ? (Q) : 0]; \
        if (WBF) { *(LAS u32x4*)((LP) + b_w + (Q) * 16 * 576) = rw[Q]; } else { \
        { u32x2 w; w.x = pk2(rb[2 * (Q)][0], rb[2 * (Q)][1]); w.y = pk2(rb[2 * (Q)][2], rb[2 * (Q)][3]); *(LAS u32x2*)((LP) + b_w + (Q) * 16 * 576) = w; } \
        { u32x2 w; w.x = pk2(rb[2 * (Q) + 1][0], rb[2 * (Q) + 1][1]); w.y = pk2(rb[2 * (Q) + 1][2], rb[2 * (Q) + 1][3]); *(LAS u32x2*)((LP) + b_w + (Q) * 16 * 576 + 8 * 576) = w; } } } while (0)
    constexpr int NLW = WBF ? 1 : 2;
    constexpr int NL0 = NLW + ((0 < MI) ? 1 : 0), NL1 = NLW + ((1 < MI) ? 1 : 0), NL2 = NLW + ((2 < MI) ? 1 : 0), NL3 = NLW + ((3 < MI) ? 1 : 0), NLT = NL0 + NL1 + NL2 + NL3;
    G_LOADQ(0, 0); G_LOADQ(0, 1); G_LOADQ(0, 2); G_LOADQ(0, 3);
    G_WAITQ(0, 0); G_WAITQ(1, 0); G_WAITQ(2, 0); G_WAITQ(3, 0);
    G_STOREQ(L, 0); G_STOREQ(L, 1); G_STOREQ(L, 2); G_STOREQ(L, 3);
    G_LOADQ(1, 0); G_LOADQ(1, 1); G_LOADQ(1, 2); G_LOADQ(1, 3);
    f32x16 acc[MI][2];
#pragma unroll
    for (int i = 0; i < MI; ++i)
#pragma unroll
        for (int j = 0; j < 2; ++j)
#pragma unroll
            for (int r = 0; r < 16; ++r) acc[i][j][r] = 0.f;
    __syncthreads();
    const int nt_all = nk * NSEG;
    int lk = (nk == 2) ? 0 : 2, lseg = (nk == 2) ? 1 : 0;
    int ck = 0, cseg = 0;
#pragma nounroll
    for (int kt = 0; kt < nt_all; ++kt) {
        LAS char* Lb = L + (kt & 1) * G_BUF;
        LAS char* Ln = L + ((kt + 1) & 1) * G_BUF;
        const bool ld = kt + 2 < nt_all;
        bf16x8 xf[2][MI], wf[2][2];
#define LOAD_FRAGS(KS, B) do { \
            _Pragma("unroll") for (int mi = 0; mi < MI; ++mi) xf[B][mi] = *(LAS bf16x8*)(Lb + xoff + mi * 4096 + 16 * ((2 * (KS) + hi) ^ sw)); \
            _Pragma("unroll") for (int ni = 0; ni < 2; ++ni) { \
                LAS char* pp = Lb + woff + (KS) * 16 * 576 + 2 * nb_of<NBMODE>(wn, ni); \
                const s16x4 lo = tr_read(pp), h4 = tr_read(pp + 4 * 576); \
                wf[B][ni] = (bf16x8){lo[0], lo[1], lo[2], lo[3], h4[0], h4[1], h4[2], h4[3]}; } } while (0)
#define MMA_STEP(KS) do { \
            _Pragma("unroll") for (int mi = 0; mi < MI; ++mi) \
                _Pragma("unroll") for (int ni = 0; ni < 2; ++ni) acc[mi][ni] = MFMA32(wf[(KS) & 1][ni], xf[(KS) & 1][mi], acc[mi][ni]); } while (0)
#define STAGE_STEP(Q, NREST, NPREV) do { G_WAITQ(Q, (NREST) + (NPREV)); G_STOREQ(Ln, Q); G_LOADQ_SEL(lk, lseg, Q, ld); } while (0)
        LOAD_FRAGS(0, 0);
        LOAD_FRAGS(1, 1); MMA_STEP(0); STAGE_STEP(0, NL1 + NL2 + NL3, 0);           __builtin_amdgcn_sched_barrier(0);
        LOAD_FRAGS(2, 0); MMA_STEP(1); STAGE_STEP(1, NL2 + NL3, NL0);               __builtin_amdgcn_sched_barrier(0);
        LOAD_FRAGS(3, 1); MMA_STEP(2); STAGE_STEP(2, NL3, NL0 + NL1);               __builtin_amdgcn_sched_barrier(0);
        MMA_STEP(3);                   STAGE_STEP(3, 0, NL0 + NL1 + NL2);           __builtin_amdgcn_sched_barrier(0);
#undef LOAD_FRAGS
#undef MMA_STEP
#undef STAGE_STEP
        __syncthreads();
        if (++lk == nk) { lk = 0; ++lseg; }
        if (NSEG > 1) {
            if (++ck == nk) {
                ck = 0;
                if (cseg + 1 < NSEG) {
                    epi(acc, cseg, L + (kt & 1) * G_BUF);
#pragma unroll
                    for (int i = 0; i < MI; ++i)
#pragma unroll
                        for (int j = 0; j < 2; ++j)
#pragma unroll
                            for (int r = 0; r < 16; ++r) acc[i][j][r] = 0.f;
                }
                ++cseg;
            }
        }
    }
    G_WAITQ(0, 0); G_WAITQ(1, 0); G_WAITQ(2, 0); G_WAITQ(3, 0);
#undef G_LOADQ
#undef G_LOADQ_SEL
#undef G_LOADW
#undef G_WAITQ
#undef G_STOREQ
    (void)NLT;
    epi(acc, NSEG - 1, L);
}

template <int MI, int NC, class DF>
__device__ __forceinline__ void store_tile_bf16(LAS char* L, const f32x16 (&acc)[MI][2], DF dst) {
    constexpr int STR = NC * 2 + 16, CPR = NC / 8, BM = 64 * MI;
    const int tid = otid(), lane = tid & 63, wave = tid >> 6, wm = wave & 1, wn = wave >> 1, l31 = lane & 31, hi = lane >> 5;
#pragma unroll
    for (int mi = 0; mi < MI; ++mi)
#pragma unroll
        for (int ni = 0; ni < (NC == 256 ? 2 : 1); ++ni) {
            const int row = 32 * MI * wm + 32 * mi + l31, col = (NC == 256) ? nb_of<0>(wn, ni) : 32 * wn;
#pragma unroll
            for (int gq = 0; gq < 4; ++gq) {
                u32x2 w; w.x = pk2(acc[mi][ni][4 * gq], acc[mi][ni][4 * gq + 1]); w.y = pk2(acc[mi][ni][4 * gq + 2], acc[mi][ni][4 * gq + 3]);
                *(LAS u32x2*)(L + row * STR + 2 * (col + 8 * gq + 4 * hi)) = w;
            }
        }
    __syncthreads();
#pragma unroll
    for (int i = 0; i < (BM * CPR) / NT; ++i) {
        const int id = tid + NT * i, row = id / CPR, c = id % CPR;
        bf16_t* d = dst(row, c);
        if (d) *(u32x4*)d = *(LAS u32x4*)(L + row * STR + 16 * c);
    }
    __syncthreads();
}

template <int MI, class DF>
__device__ __forceinline__ void store_tile_fp8(LAS char* L, const f32x16 (&acc)[MI][2], DF dst) {
    constexpr int STR = 256 + 16, BM = 64 * MI;
    const int tid = otid(), lane = tid & 63, wave = tid >> 6, wm = wave & 1, wn = wave >> 1, l31 = lane & 31, hi = lane >> 5;
#pragma unroll
    for (int mi = 0; mi < MI; ++mi)
#pragma unroll
        for (int ni = 0; ni < 2; ++ni) {
            const int row = 32 * MI * wm + 32 * mi + l31, col = nb_of<0>(wn, ni);
#pragma unroll
            for (int gq = 0; gq < 4; ++gq) {
                int w = 0;
                w = __builtin_amdgcn_cvt_pk_fp8_f32(acc[mi][ni][4 * gq], acc[mi][ni][4 * gq + 1], w, false);
                w = __builtin_amdgcn_cvt_pk_fp8_f32(acc[mi][ni][4 * gq + 2], acc[mi][ni][4 * gq + 3], w, true);
                *(LAS int*)(L + row * STR + (col + 8 * gq + 4 * hi)) = w;
            }
        }
    __syncthreads();
#pragma unroll
    for (int i = 0; i < (BM * 16) / NT; ++i) {
        const int id = tid + NT * i, row = id >> 4, c = id & 15;
        unsigned char* d = dst(row, c);
        if (d) *(u32x4*)d = *(LAS u32x4*)(L + row * STR + 16 * c);
    }
    __syncthreads();
}

__device__ __forceinline__ void phase_mod(const Params& p, LAS char* L) {
    const int v = vcu(), G = grid_g();
    const int tid = otid();
    const float* c = p.in[1]; const float* w_ada = p.in[3]; const float* b_ada = p.in[4];
    float* mod = (float*)(p.ws + WS_MOD);
    LAS float* sc = (LAS float*)L;
    LAS float* red = (LAS float*)(L + 32768);
    bool filled = false;
    for (int item = v; item < 384; item += G) {
        if (!filled) {
            for (int i = tid; i < 8 * 1024; i += NT) sc[i] = silu_f(c[i]);
            __syncthreads(); filled = true;
        }
        const int cx = tid & 15, kl = tid >> 4, col = item * 16 + cx;
        float a[8];
#pragma unroll
        for (int b = 0; b < 8; ++b) a[b] = 0.f;
#pragma unroll 4
        for (int k = kl; k < 1024; k += 32) {
            const float w = w_ada[(size_t)k * 6144 + col];
#pragma unroll
            for (int b = 0; b < 8; ++b) a[b] += sc[b * 1024 + k] * w;
        }
#pragma unroll
        for (int b = 0; b < 8; ++b) red[(b * 32 + kl) * 16 + cx] = a[b];
        __syncthreads();
        if (tid < 128) {
            const int b = tid >> 4, cc = tid & 15; float s = 0.f;
#pragma unroll
            for (int k = 0; k < 32; ++k) s += red[(b * 32 + k) * 16 + cc];
            mod[b * 6144 + item * 16 + cc] = s + b_ada[item * 16 + cc];
        }
        __syncthreads();
    }
    {
        bf16_t* wb = (bf16_t*)(p.ws + WS_WB);
        const size_t gt = (size_t)v * NT + tid, gs = (size_t)G * NT;
        auto conv = [&](const float* src, size_t off, size_t n) {
            for (size_t i = gt; i < n / 4; i += gs) { const f32x4 f = *(const f32x4*)(src + 4 * i); u32x2 w; w.x = pk2(f[0], f[1]); w.y = pk2(f[2], f[3]); *(u32x2*)(wb + off + 4 * i) = w; }
        };
        auto convg = [&](const float* src, size_t off, size_t n, int ncol, const float* gain) {
            for (size_t i = gt; i < n / 4; i += gs) { const float gk = gain[(4 * i) / ncol]; const f32x4 f = *(const f32x4*)(src + 4 * i); u32x2 w; w.x = pk2(f[0] * gk, f[1] * gk); w.y = pk2(f[2] * gk, f[3] * gk); *(u32x2*)(wb + off + 4 * i) = w; }
        };
        conv(p.in[7], WB_IN, (size_t)1024 * 1952); convg(p.in[10], WB_UQ, (size_t)256 * 768, 768, p.in[8]); convg(p.in[11], WB_UKV, (size_t)128 * 1024, 1024, p.in[9]);
        conv(p.in[17], WB_O, (size_t)1024 * 1024); conv(p.in[20], WB_R, (size_t)1024 * 256);
    }
}

__device__ __forceinline__ void phase_h1(const Params& p) {
    const int v = vcu(), G = grid_g();
    const int tid = otid(), lane = tid & 63, wave = tid >> 6;
    const float* x = p.in[0]; const int* positions = (const int*)p.in[2]; const float* g = p.in[5];
    const float* mod = (const float*)(p.ws + WS_MOD);
    bf16_t* h1 = (bf16_t*)(p.ws + WS_H1);
    f32x2* rope = (f32x2*)(p.ws + WS_ROPE);
    for (int t = v * NW + wave; t < T; t += G * NW) {
        const int b = t / SEQ;
        const f32x4* xr = (const f32x4*)(x + (size_t)t * Dm);
        f32x4 xv[4]; float ss = 0.f;
#pragma unroll
        for (int j = 0; j < 4; ++j) { xv[j] = xr[lane + 64 * j]; ss += xv[j][0] * xv[j][0] + xv[j][1] * xv[j][1] + xv[j][2] * xv[j][2] + xv[j][3] * xv[j][3]; }
        ss = wave_sum(ss, lane);
        const float rstd = rsqrtf(ss * (1.f / Dm) + 1e-6f);
        const float* sh = mod + b * 6144; const float* scl = sh + 1024;
#pragma unroll
        for (int j = 0; j < 4; ++j) {
            const int col = 4 * (lane + 64 * j);
            const f32x4 gv = *(const f32x4*)(g + col), sv = *(const f32x4*)(scl + col), hv = *(const f32x4*)(sh + col);
            float o[4];
#pragma unroll
            for (int e = 0; e < 4; ++e) o[e] = (xv[j][e] * rstd * gv[e]) * (1.f + sv[e]) + hv[e];
            u32x2 w; w.x = pk2(o[0], o[1]); w.y = pk2(o[2], o[3]);
            *(u32x2*)(h1 + (size_t)t * Dm + col) = w;
        }
        if (lane < 16) {
            const double inv = exp2(-(double)lane * (13.287712379549449 / 16.0));
            const double rev = (double)positions[t] * inv * 0.15915494309189535;
            const float fr = (float)(rev - rint(rev));
            f32x2 cs; cs.x = __builtin_amdgcn_cosf(fr); cs.y = __builtin_amdgcn_sinf(fr);
            rope[(size_t)t * 16 + lane] = cs;
        }
    }
}

__device__ __forceinline__ void phase_proj(const Params& p, LAS char* L) {
    const int v = vcu(), G = grid_g();
    const bf16_t* h1 = (const bf16_t*)(p.ws + WS_H1);
    const bf16_t* w_in = (const bf16_t*)(p.ws + WS_WB) + WB_IN;
    bf16_t* proj = (bf16_t*)(p.ws + WS_PROJ);
    const f32x2* rope = (const f32x2*)(p.ws + WS_ROPE);
    for (int u = v; u < 64 * 8; u += G) {
        const int mt = u >> 3, nt = u & 7, m0 = mt * 256, n0 = nt * 256;
        auto arow = [&](int r) { return (unsigned)(m0 + r) * Dm; };
        auto bcol = [&](int c) { int col = n0 + c; if (col > NIN - 8) col = NIN - 8; return w_in + col; };
        auto epi = [&](f32x16 (&acc)[4][2], int seg, LAS char* Ls) {
            const int tid_ = otid(), lane = tid_ & 63, wave = tid_ >> 6, wm = wave & 1, wn = wave >> 1, l31 = lane & 31, hi = lane >> 5;
            if (nt < 2) {
                LAS float* ssl = (LAS float*)(L + OFF_SS);
                const bool contrib = (nt == 0) || (wn < 2);
#pragma unroll
                for (int mi = 0; mi < 4; ++mi) {
                    float part = 0.f;
#pragma unroll
                    for (int ni = 0; ni < 2; ++ni)
#pragma unroll
                        for (int r = 0; r < 16; ++r) part += acc[mi][ni][r] * acc[mi][ni][r];
                    part += shx(part, 32, lane);
                    if (hi == 0) ssl[(128 * wm + 32 * mi + l31) * 4 + wn] = contrib ? part : 0.f;
                }
                __syncthreads();
                if (tid_ < 256) {
                    const f32x4 q4 = *(LAS f32x4*)(ssl + tid_ * 4);
                    const float ssum = (q4[0] + q4[1]) + (q4[2] + q4[3]);
                    float* rs = (float*)(p.ws + WS_CQN) + (nt == 0 ? 0 : (1 << 18));
                    rs[m0 + tid_] = rsqrtf(ssum * (nt == 0 ? 1.f / 256.f : 1.f / 128.f) + 1e-6f);
                }
            }
#pragma unroll
            for (int ni = 0; ni < 2; ++ni) {
                const int nbg = n0 + nb_of<0>(wn, ni);
                if (nbg == C_KR) {
#pragma unroll
                    for (int mi = 0; mi < 4; ++mi) {
                        const int m = m0 + 128 * wm + 32 * mi + l31;
#pragma unroll
                        for (int r = 0; r < 8; ++r) {
                            const f32x2 cs = rope[(size_t)m * 16 + crow(r, hi)];
                            const float x1 = acc[mi][ni][r], x2 = acc[mi][ni][r + 8];
                            acc[mi][ni][r] = x1 * cs.x - x2 * cs.y; acc[mi][ni][r + 8] = x2 * cs.x + x1 * cs.y;
                        }
                    }
                }
                if (nbg >= C_DQ && nbg < C_DK) {
#pragma unroll
                    for (int mi = 0; mi < 4; ++mi)
#pragma unroll
                        for (int r = 0; r < 16; ++r) acc[mi][ni][r] *= 0.125f * LOG2E;
                }
            }
            store_tile_bf16<4, 256>(Ls, acc, [&](int row, int c) -> bf16_t* { const int col = n0 + 8 * c; return col < NIN ? proj + (size_t)(m0 + row) * NIN + col : nullptr; });
        };
        gemm_tile<4, 0, true>(L, Dm / 64, NIN, h1, arow, bcol, epi);
    }
}

__device__ __forceinline__ void phase_qkv(const Params& p, LAS char* L) {
    const int v = vcu(), G = grid_g();
    const bf16_t* proj = (const bf16_t*)(p.ws + WS_PROJ);
    const float* rstd_q = (const float*)(p.ws + WS_CQN); const float* rstd_kv = rstd_q + (1 << 18);
    const bf16_t* w_uq = (const bf16_t*)(p.ws + WS_WB) + WB_UQ; const bf16_t* w_ukv = (const bf16_t*)(p.ws + WS_WB) + WB_UKV;
    bf16_t* qm = (bf16_t*)(p.ws + WS_QM); bf16_t* kf = (bf16_t*)(p.ws + WS_KF); bf16_t* vm = (bf16_t*)(p.ws + WS_VM);
    const f32x2* rope = (const f32x2*)(p.ws + WS_ROPE);
    const float qscale = LOG2E * 0.10206207261596575f;
    for (int u = v; u < 64 * 7; u += G) {
        const int mt = u / 7, j = u % 7, m0 = mt * 256;
        if (j < 3) {
            const int n0 = j * 256;
            auto arow = [&](int r) { return (unsigned)(m0 + r) * NIN + C_CQ; };
            auto bcol = [&](int c) { return w_uq + n0 + c; };
            auto epi = [&](f32x16 (&acc)[4][2], int seg, LAS char* Ls) {
                const int tid_ = otid(), lane = tid_ & 63, wave = tid_ >> 6, wm = wave & 1, wn = wave >> 1, l31 = lane & 31, hi = lane >> 5;
#pragma unroll
                for (int mi = 0; mi < 4; ++mi) {
                    const int m = m0 + 128 * wm + 32 * mi + l31;
                    const float qs = qscale * rstd_q[m];
#pragma unroll
                    for (int ni = 0; ni < 2; ++ni) {
                        const int nbg = n0 + nb_of<0>(wn, ni);
                        if ((nbg % 96) == 64) {
#pragma unroll
                            for (int r = 0; r < 8; ++r) {
                                const f32x2 cs = rope[(size_t)m * 16 + crow(r, hi)];
                                const float x1 = acc[mi][ni][r], x2 = acc[mi][ni][r + 8];
                                acc[mi][ni][r] = x1 * cs.x - x2 * cs.y; acc[mi][ni][r + 8] = x2 * cs.x + x1 * cs.y;
                            }
                        }
#pragma unroll
                        for (int r = 0; r < 16; ++r) acc[mi][ni][r] *= qs;
                    }
                }
                store_tile_bf16<4, 256>(Ls, acc, [&](int row, int c) -> bf16_t* { return qm + (size_t)(m0 + row) * 768 + n0 + 8 * c; });
            };
            gemm_tile<4, 0, true>(L, 256 / 64, 768, proj, arow, bcol, epi);
        } else {
            const int n0 = (j - 3) * 256;
            auto arow = [&](int r) { return (unsigned)(m0 + r) * NIN + C_CKV; };
            auto bcol = [&](int c) { return w_ukv + n0 + c; };
            auto epi = [&](f32x16 (&acc)[4][2], int seg, LAS char* Ls) {
                {
                    const int tid_ = otid(), lane = tid_ & 63, wave = tid_ >> 6, wm = wave & 1, l31 = lane & 31;
#pragma unroll
                    for (int mi = 0; mi < 4; ++mi) {
                        const float rs = rstd_kv[m0 + 128 * wm + 32 * mi + l31];
#pragma unroll
                        for (int ni = 0; ni < 2; ++ni)
#pragma unroll
                            for (int r = 0; r < 16; ++r) acc[mi][ni][r] *= rs;
                    }
                }
                store_tile_bf16<4, 256>(Ls, acc, [&](int row, int c) -> bf16_t* {
                    const int h = (n0 >> 7) + (c >> 4), cc = c & 15;
                    return cc < 8 ? kf + (size_t)(m0 + row) * 768 + h * 96 + 8 * cc : vm + (size_t)(m0 + row) * 512 + h * 64 + 8 * (cc - 8); });
            };
            gemm_tile<4, 0, true>(L, 128 / 64, 1024, proj, arow, bcol, epi);
        }
    }
}

template <int DQK, int DV, bool ALIBI>
__device__ __forceinline__ void attn_map(LAS char* L, const bf16_t* Q, int ldq, const bf16_t* K, int ldk, const bf16_t* V, int ldv,
                                         const int* posrow, float slope2, int q0, f32x16 (&o)[DV / 32], const bf16_t* K2 = nullptr, int ldk2 = 0) {
    constexpr int KSTR = DQK * 2 + 16, VSTR = DV * 2 + 64, KS = DQK / 16, ND = DV / 32;
    constexpr int K_OFF = 0, V_OFF = 64 * KSTR, P_OFF = V_OFF + 64 * VSTR, ABUF = P_OFF + 256;
    constexpr int KCH = DQK / 8, VCH = DV / 8;
    constexpr int NKI = (64 * KCH + NT - 1) / NT, NVI = (64 * VCH + NT - 1) / NT;
    static_assert(3 * ABUF <= G_LDS, "attention ring");
    const int tid = otid();
    const int lane = tid & 63, wave = tid >> 6, l31 = lane & 31, hi = lane >> 5;
    const int qrow = q0 + 32 * wave + l31;
    unsigned kgo[NKI], klo[NKI], vgo[NVI], vlo[NVI];
    bool k2s[NKI];
#pragma unroll
    for (int i = 0; i < NKI; ++i) { int c = tid + NT * i; if (c >= 64 * KCH) c = 64 * KCH - 1; const int row = c / KCH, ch = c % KCH; k2s[i] = (DQK == 96) && (ch >= 8);
        kgo[i] = k2s[i] ? (unsigned)(row * ldk2 + (ch - 8) * 8) * 2u : (unsigned)(row * ldk + ch * 8) * 2u; klo[i] = K_OFF + row * KSTR + ch * 16; }
#pragma unroll
    for (int i = 0; i < NVI; ++i) { int c = tid + NT * i; if (c >= 64 * VCH) c = 64 * VCH - 1; const int row = c / VCH, ch = c % VCH; vgo[i] = (unsigned)(row * ldv + ch * 8) * 2u; vlo[i] = V_OFF + row * VSTR + ch * 16; }
    bf16x8 qf[KS];
#pragma unroll
    for (int s = 0; s < KS; ++s) qf[s] = *(const bf16x8*)(Q + (size_t)qrow * ldq + 16 * s + 8 * hi);
    const float posq = ALIBI ? (float)posrow[qrow] : 0.f;
#pragma unroll
    for (int d = 0; d < ND; ++d)
#pragma unroll
        for (int r = 0; r < 16; ++r) o[d][r] = 0.f;
    float m_run = -1e30f, l_run = 0.f;
    const int ntile = (q0 + 256) / 64;
    const int qmin = q0 + 32 * wave, qmax = qmin + 31;
    const int vrd = V_OFF + (4 * hi + ((lane & 15) >> 2)) * VSTR + 2 * (16 * ((lane >> 4) & 1) + 4 * (lane & 3));
    u32x4 rk[NKI], rv[NVI]; float rp = 0.f;
#define A_LOAD(T) do { \
        const char* kbase_ = (const char*)(K + (size_t)(T) * 64 * ldk); const char* kbase2_ = (const char*)(K2 + (size_t)(T) * 64 * ldk2); \
        const char* vbase_ = (const char*)(V + (size_t)(T) * 64 * ldv); \
        _Pragma("unroll") for (int i = 0; i < NKI; ++i) rk[i] = *(const u32x4*)((k2s[i] ? kbase2_ : kbase_) + kgo[i]); \
        _Pragma("unroll") for (int i = 0; i < NVI; ++i) rv[i] = *(const u32x4*)(vbase_ + vgo[i]); \
        if (ALIBI && tid < 64) rp = (float)posrow[(T) * 64 + tid]; } while (0)
#define A_STORE(LP) do { \
        _Pragma("unroll") for (int i = 0; i < NKI; ++i) if (tid + NT * i < 64 * KCH) *(LAS u32x4*)((LP) + klo[i]) = rk[i]; \
        _Pragma("unroll") for (int i = 0; i < NVI; ++i) if (tid + NT * i < 64 * VCH) *(LAS u32x4*)((LP) + vlo[i]) = rv[i]; \
        if (ALIBI && tid < 64) *(LAS float*)((LP) + P_OFF + 4 * tid) = rp; } while (0)
#define A_KFRAG(DST, LP, S_) do { DST[0] = *(LAS bf16x8*)((LP) + K_OFF + l31 * KSTR + 32 * (S_) + 16 * hi); DST[1] = *(LAS bf16x8*)((LP) + K_OFF + (32 + l31) * KSTR + 32 * (S_) + 16 * hi); } while (0)
#define A_SCORES(S0, S1, LP, KB) do { \
        _Pragma("unroll") for (int r = 0; r < 16; ++r) { S0[r] = 0.f; S1[r] = 0.f; } \
        bf16x8 kfa_[2], kfb_[2]; \
        A_KFRAG(kfa_, LP, 0); \
        _Pragma("unroll") for (int s = 0; s < KS; s += 2) {        \
            if (s + 1 < KS) A_KFRAG(kfb_, LP, s + 1); \
            S0 = MFMA32(kfa_[0], qf[s], S0); S1 = MFMA32(kfa_[1], qf[s], S1); \
            __builtin_amdgcn_sched_barrier(0); \
            if (s + 1 < KS) { \
                if (s + 2 < KS) A_KFRAG(kfa_, LP, s + 2); \
                S0 = MFMA32(kfb_[0], qf[s + 1], S0); S1 = MFMA32(kfb_[1], qf[s + 1], S1); \
                __builtin_amdgcn_sched_barrier(0); } } \
        if (ALIBI) { \
            _Pragma("unroll") for (int g4 = 0; g4 < 4; ++g4) { \
                const f32x4 pk0_ = *(LAS f32x4*)((LP) + P_OFF + 4 * (8 * g4 + 4 * hi)), pk1_ = *(LAS f32x4*)((LP) + P_OFF + 4 * (32 + 8 * g4 + 4 * hi)); \
                _Pragma("unroll") for (int e = 0; e < 4; ++e) { S0[4 * g4 + e] -= slope2 * fabsf(posq - pk0_[e]); S1[4 * g4 + e] -= slope2 * fabsf(posq - pk1_[e]); } } } \
        if ((KB) + 63 > qmin) { \
            _Pragma("unroll") for (int r = 0; r < 16; ++r) { const int key_ = (KB) + crow(r, hi); if (key_ > qrow) S0[r] = -INFINITY; if (key_ + 32 > qrow) S1[r] = -INFINITY; } } } while (0)
#define A_VFRAG(DST, LP, S_) do { _Pragma("unroll") for (int d = 0; d < ND; ++d) { \
            LAS char* vp_ = (LP) + vrd + 16 * (S_) * VSTR + 64 * d; const s16x4 lo_ = tr_read(vp_), h4_ = tr_read(vp_ + 8 * VSTR); \
            DST[d] = (bf16x8){lo_[0], lo_[1], lo_[2], lo_[3], h4_[0], h4_[1], h4_[2], h4_[3]}; } } while (0)
#define A_SOFTMAX_PV(S0, S1, LP) do { \
        bf16x8 vfa_[ND], vfb_[ND]; \
        A_VFRAG(vfa_, LP, 0);                                       \
        float mx_ = S0[0]; \
        _Pragma("unroll") for (int r = 1; r < 16; ++r) mx_ = fmaxf(mx_, S0[r]); \
        _Pragma("unroll") for (int r = 0; r < 16; ++r) mx_ = fmaxf(mx_, S1[r]); \
        mx_ = fmaxf(mx_, shx(mx_, 32, lane)); \
        if (__any(mx_ > m_run + 8.f)) { \
            const float m_new_ = fmaxf(m_run, mx_); const float alpha_ = __builtin_amdgcn_exp2f(m_run - m_new_); m_run = m_new_; l_run *= alpha_; \
            _Pragma("unroll") for (int d = 0; d < ND; ++d) _Pragma("unroll") for (int r = 0; r < 16; ++r) o[d][r] *= alpha_; } \
        float ls_ = 0.f; \
        _Pragma("unroll") for (int r = 0; r < 16; ++r) { S0[r] = __builtin_amdgcn_exp2f(S0[r] - m_run); S1[r] = __builtin_amdgcn_exp2f(S1[r] - m_run); ls_ += S0[r] + S1[r]; } \
        l_run += ls_; \
        u32x4 pw_[4]; \
        _Pragma("unroll") for (int j = 0; j < 4; ++j) { \
            pw_[0][j] = pk2(S0[2 * j], S0[2 * j + 1]); pw_[1][j] = pk2(S0[8 + 2 * j], S0[8 + 2 * j + 1]); \
            pw_[2][j] = pk2(S1[2 * j], S1[2 * j + 1]); pw_[3][j] = pk2(S1[8 + 2 * j], S1[8 + 2 * j + 1]); } \
        __builtin_amdgcn_sched_barrier(0); \
        A_VFRAG(vfb_, LP, 1); \
        _Pragma("unroll") for (int d = 0; d < ND; ++d) o[d] = MFMA32(vfa_[d], __builtin_bit_cast(bf16x8, pw_[0]), o[d]); \
        __builtin_amdgcn_sched_barrier(0); \
        A_VFRAG(vfa_, LP, 2); \
        _Pragma("unroll") for (int d = 0; d < ND; ++d) o[d] = MFMA32(vfb_[d], __builtin_bit_cast(bf16x8, pw_[1]), o[d]); \
        __builtin_amdgcn_sched_barrier(0); \
        A_VFRAG(vfb_, LP, 3); \
        _Pragma("unroll") for (int d = 0; d < ND; ++d) o[d] = MFMA32(vfa_[d], __builtin_bit_cast(bf16x8, pw_[2]), o[d]); \
        __builtin_amdgcn_sched_barrier(0); \
        _Pragma("unroll") for (int d = 0; d < ND; ++d) o[d] = MFMA32(vfb_[d], __builtin_bit_cast(bf16x8, pw_[3]), o[d]); \
        __builtin_amdgcn_sched_barrier(0); } while (0)
    A_LOAD(0);
    __syncthreads();
    A_STORE(L);
    A_LOAD(1);
    A_STORE(L + ABUF);
    __syncthreads();
    f32x16 sa0, sa1, sb0, sb1;
    A_SCORES(sa0, sa1, L, 0);
    int bc = 0;
    for (int tl = 0; tl < ntile; ++tl) {
        const int kb = tl * 64;
        const int bn = (bc == 2) ? 0 : bc + 1, bnn = (bn == 2) ? 0 : bn + 1;
        LAS char* Lc = L + bc * ABUF; LAS char* Ln = L + bn * ABUF; LAS char* Lnn = L + bnn * ABUF;
        const bool more2 = tl + 2 < ntile;
        if (more2) A_LOAD(tl + 2);
        const bool act_c = kb <= qmax, act_n = (tl + 1 < ntile) && (kb + 64 <= qmax);
        if (act_n) {
            A_SCORES(sb0, sb1, Ln, kb + 64);
            A_SOFTMAX_PV(sa0, sa1, Lc);
            sa0 = sb0; sa1 = sb1;
        } else if (act_c) {
            A_SOFTMAX_PV(sa0, sa1, Lc);
        }
        if (more2) A_STORE(Lnn);
        __syncthreads();
        bc = bn;
    }
#undef A_LOAD
#undef A_STORE
#undef A_SCORES
#undef A_SOFTMAX_PV
#undef A_KFRAG
#undef A_VFRAG
    const float lt = l_run + shx(l_run, 32, lane);
    const float inv = 1.f / lt;
#pragma unroll
    for (int d = 0; d < ND; ++d)
#pragma unroll
        for (int r = 0; r < 16; ++r) o[d][r] *= inv;
}

__device__ __forceinline__ void attn_decode(int it, int& kind, int& qb, int& idx) {
    const int seg_kind[16] = {1, 1, 1, 1, 1, 0, 1, 0, 0, 0, 1, 0, 0, 1, 0, 0};
    const int seg_qb[16]   = {7, 6, 5, 4, 3, 7, 2, 6, 5, 4, 1, 3, 2, 0, 1, 0};
    int base = 0; kind = 0; qb = 0; idx = 0;
#pragma unroll
    for (int s = 0; s < 16; ++s) {
        const int n = seg_kind[s] ? 32 : 64;
        if (it >= base && it < base + n) { kind = seg_kind[s]; qb = seg_qb[s]; idx = it - base; }
        base += n;
    }
}

__device__ __forceinline__ void phase_attn(const Params& p, LAS char* L) {
    const int v = vcu(), G = grid_g();
    const int tid = otid(), lane = tid & 63, wave = tid >> 6, l31 = lane & 31, hi = lane >> 5;
    const int* positions = (const int*)p.in[2];
    const bf16_t* proj = (const bf16_t*)(p.ws + WS_PROJ);
    const bf16_t* qm = (const bf16_t*)(p.ws + WS_QM); const bf16_t* kf = (const bf16_t*)(p.ws + WS_KF); const bf16_t* vm = (const bf16_t*)(p.ws + WS_VM);
    bf16_t* att = (bf16_t*)(p.ws + WS_ATT);
    float* od0 = (float*)(p.ws + WS_OD0);
    const float* subg = p.in[16];
    unsigned* qctr = (unsigned*)(p.ws + WS_CTL + 2048);
    LAS unsigned* qslot = (LAS unsigned*)(L + OFF_MISC + 16);
    float lam;
    {
        const float a = p.in[12][lane] * p.in[13][lane], b = p.in[14][lane] * p.in[15][lane];
        lam = __expf(wave_sum(a, lane)) - __expf(wave_sum(b, lane)) + LAMBDA_INIT;
    }
    for (;;) {
        if (tid == 0) *qslot = __hip_atomic_fetch_add(qctr, 1u, __ATOMIC_RELAXED, __HIP_MEMORY_SCOPE_AGENT);
        __syncthreads();
        const int it = (int)*qslot;
        __syncthreads();
        if (it >= 768) break;
        int kind, qb, idx;
        attn_decode(it, kind, qb, idx);
        const int q0 = qb * 256;
        if (kind == 0) {
            const int b = idx >> 3, h = idx & 7; const size_t tb = (size_t)b * SEQ;
            f32x16 o[2];
            attn_map<96, 64, false>(L, qm + tb * 768 + h * 96, 768, kf + tb * 768 + h * 96, 768, vm + tb * 512 + h * 64, 512, positions + tb, 0.f, q0, o, proj + tb * NIN + C_KR, NIN);
            const size_t t = tb + q0 + 32 * wave + l31;
#pragma unroll
            for (int d = 0; d < 2; ++d)
#pragma unroll
                for (int gq = 0; gq < 4; ++gq) {
                    u32x2 w; w.x = pk2(o[d][4 * gq], o[d][4 * gq + 1]); w.y = pk2(o[d][4 * gq + 2], o[d][4 * gq + 3]);
                    *(u32x2*)(att + t * 1024 + h * 64 + 32 * d + 8 * gq + 4 * hi) = w;
                }
        } else {
            const int b = idx >> 2, h = idx & 3; const size_t tb = (size_t)b * SEQ;
            const float slope2 = exp2f(-2.f * (h + 1)) * LOG2E;
            const size_t t = tb + q0 + 32 * wave + l31;
            f32x16 o[4];
            attn_map<64, 128, true>(L, proj + tb * NIN + C_DQ + h * 128, NIN, proj + tb * NIN + C_DK + h * 128, NIN, proj + tb * NIN + C_DV + h * 128, NIN, positions + tb, slope2, q0, o);
#pragma unroll
            for (int d = 0; d < 4; ++d)
#pragma unroll
                for (int gq = 0; gq < 4; ++gq) {
                    f32x4 w = {o[d][4 * gq], o[d][4 * gq + 1], o[d][4 * gq + 2], o[d][4 * gq + 3]};
                    *(f32x4*)(od0 + t * 512 + h * 128 + 32 * d + 8 * gq + 4 * hi) = w;
                }
            attn_map<64, 128, true>(L, proj + tb * NIN + C_DQ + h * 128 + 64, NIN, proj + tb * NIN + C_DK + h * 128 + 64, NIN, proj + tb * NIN + C_DV + h * 128, NIN, positions + tb, slope2, q0, o);
            float ss = 0.f;
#pragma unroll
            for (int d = 0; d < 4; ++d)
#pragma unroll
                for (int gq = 0; gq < 4; ++gq) {
                    const f32x4 w = *(const f32x4*)(od0 + t * 512 + h * 128 + 32 * d + 8 * gq + 4 * hi);
#pragma unroll
                    for (int e = 0; e < 4; ++e) { const float c = w[e] - lam * o[d][4 * gq + e]; o[d][4 * gq + e] = c; ss += c * c; }
                }
            ss += shx(ss, 32, lane);
            const float rstd = rsqrtf(ss * (1.f / 128.f) + 1e-5f) * (1.f - LAMBDA_INIT);
#pragma unroll
            for (int d = 0; d < 4; ++d)
#pragma unroll
                for (int gq = 0; gq < 4; ++gq) {
                    const int dv = 32 * d + 8 * gq + 4 * hi;
                    const f32x4 gv = *(const f32x4*)(subg + dv);
                    u32x2 w; w.x = pk2(o[d][4 * gq] * rstd * gv[0], o[d][4 * gq + 1] * rstd * gv[1]); w.y = pk2(o[d][4 * gq + 2] * rstd * gv[2], o[d][4 * gq + 3] * rstd * gv[3]);
                    *(u32x2*)(att + t * 1024 + 512 + h * 128 + dv) = w;
                }
        }
    }
}

__device__ __forceinline__ void phase_oproj(const Params& p, LAS char* L) {
    const int v = vcu(), G = grid_g();
    const bf16_t* att = (const bf16_t*)(p.ws + WS_ATT);
    const bf16_t* w_o = (const bf16_t*)(p.ws + WS_WB) + WB_O;
    bf16_t* y1 = (bf16_t*)(p.ws + WS_Y1);
    for (int u = v; u < 64 * 4; u += G) {
        const int mt = u >> 2, nt = u & 3, m0 = mt * 256, n0 = nt * 256;
        auto arow = [&](int r) { return (unsigned)(m0 + r) * Dm; };
        auto bcol = [&](int c) { return w_o + n0 + c; };
        auto epi = [&](f32x16 (&acc)[4][2], int seg, LAS char* Ls) {
            store_tile_bf16<4, 256>(Ls, acc, [&](int row, int c) -> bf16_t* { return y1 + (size_t)(m0 + row) * Dm + n0 + 8 * c; });
        };
        gemm_tile<4, 0, true>(L, Dm / 64, Dm, att, arow, bcol, epi);
    }
}

__device__ __forceinline__ void post_attn_tokens(const Params& p, int t0, int nper) {
    const int tid = otid(), lane = tid & 63, wave = tid >> 6;
    const float* x = p.in[0]; const float* pg = p.in[6]; const float* fg = p.in[18];
    const float* mod = (const float*)(p.ws + WS_MOD);
    const bf16_t* y1 = (const bf16_t*)(p.ws + WS_Y1);
    bf16_t* h2 = (bf16_t*)(p.ws + WS_H2);
    for (int i_ = 0; i_ < nper; ++i_) {
        const int t = t0 + wave + NW * i_;
        const int b = t / SEQ;
        const float* mb = mod + b * 6144;
        f32x4 yv[4], xv[4]; float ss = 0.f;
#pragma unroll
        for (int j = 0; j < 4; ++j) {
            const u32x2 raw = *(const u32x2*)(y1 + (size_t)t * Dm + 4 * (lane + 64 * j));
            yv[j] = (f32x4){bflo(raw.x), bfhi(raw.x), bflo(raw.y), bfhi(raw.y)};
            xv[j] = *(const f32x4*)(x + (size_t)t * Dm + 4 * (lane + 64 * j));
            ss += yv[j][0] * yv[j][0] + yv[j][1] * yv[j][1] + yv[j][2] * yv[j][2] + yv[j][3] * yv[j][3];
        }
        ss = wave_sum(ss, lane);
        const float rstd = rsqrtf(ss * (1.f / Dm) + 1e-6f);
        float ss2 = 0.f;
#pragma unroll
        for (int j = 0; j < 4; ++j) {
            const int col = 4 * (lane + 64 * j);
            const f32x4 gv = *(const f32x4*)(pg + col), ga = *(const f32x4*)(mb + 2048 + col);
#pragma unroll
            for (int e = 0; e < 4; ++e) { xv[j][e] = xv[j][e] + ga[e] * (yv[j][e] * rstd * gv[e]); ss2 += xv[j][e] * xv[j][e]; }
            *(f32x4*)(p.out + (size_t)t * Dm + col) = xv[j];
        }
        ss2 = wave_sum(ss2, lane);
        const float rstd2 = rsqrtf(ss2 * (1.f / Dm) + 1e-6f);
#pragma unroll
        for (int j = 0; j < 4; ++j) {
            const int col = 4 * (lane + 64 * j);
            const f32x4 gv = *(const f32x4*)(fg + col), sv = *(const f32x4*)(mb + 4096 + col), hv = *(const f32x4*)(mb + 3072 + col);
            float o[4];
#pragma unroll
            for (int e = 0; e < 4; ++e) o[e] = (xv[j][e] * rstd2 * gv[e]) * (1.f + sv[e]) + hv[e];
            u32x2 w; w.x = pk2(o[0], o[1]); w.y = pk2(o[2], o[3]);
            *(u32x2*)(h2 + (size_t)t * Dm + col) = w;
        }
    }
}

__device__ __forceinline__ unsigned fkey(float f) { const unsigned u = __float_as_uint(f); return (u & 0x80000000u) ? ~u : (u | 0x80000000u); }
template <int CTRL, int RM> __device__ __forceinline__ unsigned dppu(unsigned old, unsigned src) { return (unsigned)__builtin_amdgcn_update_dpp((int)old, (int)src, CTRL, RM, 0xf, false); }
template <int CTRL, int RM> __device__ __forceinline__ float dppf(float old, float src) { return __int_as_float(__builtin_amdgcn_update_dpp(__float_as_int(old), __float_as_int(src), CTRL, RM, 0xf, false)); }
__device__ __forceinline__ unsigned wave_umax(unsigned v) {
    v = max(v, dppu<0x111, 0xf>(v, v)); v = max(v, dppu<0x112, 0xf>(v, v)); v = max(v, dppu<0x114, 0xf>(v, v)); v = max(v, dppu<0x118, 0xf>(v, v));
    v = max(v, dppu<0x142, 0xa>(v, v)); v = max(v, dppu<0x143, 0xc>(v, v));
    return (unsigned)__builtin_amdgcn_readlane((int)v, 63);
}
__device__ __forceinline__ float wave_fsum_dpp(float v) {
    v += dppf<0x111, 0xf>(0.f, v); v += dppf<0x112, 0xf>(0.f, v); v += dppf<0x114, 0xf>(0.f, v); v += dppf<0x118, 0xf>(0.f, v);
    v += dppf<0x142, 0xa>(0.f, v); v += dppf<0x143, 0xc>(0.f, v);
    return __int_as_float(__builtin_amdgcn_readlane(__float_as_int(v), 63));
}
__device__ __forceinline__ void phase_router_route(const Params& p, LAS char* L) {
    const int v = vcu(), G = grid_g();
    const bf16_t* h2 = (const bf16_t*)(p.ws + WS_H2);
    const bf16_t* rw = (const bf16_t*)(p.ws + WS_WB) + WB_R;
    const float* rb = p.in[21];
    int* cnt = (int*)(p.ws + WS_CTL);
    int* la = (int*)(p.ws + WS_LA); float* lw = (float*)(p.ws + WS_LW);
    constexpr int LSTR = 1040;
    LAS int* pe = (LAS int*)(L + 69632);
    LAS float* pw = (LAS float*)(L + 69632 + 2048);
    LAS int* hist = (LAS int*)(L + 69632 + 4096);
    LAS int* basep = (LAS int*)(L + 69632 + 5120);
    for (int u = v; u < T / 64; u += G) {
        const int m0 = u * 64;
        post_attn_tokens(p, m0, 8);
        asm volatile("s_waitcnt vmcnt(0)" ::: "memory");
        __syncthreads();
        auto arow = [&](int r) { return (unsigned)(m0 + r) * Dm; };
        auto bcol = [&](int c) { return rw + c; };
        auto epi = [&](f32x16 (&acc)[1][2], int seg, LAS char* Ls) {
            const int tid_ = otid(), lane = tid_ & 63, wave = tid_ >> 6, wm = wave & 1, wn = wave >> 1, l31 = lane & 31, hi = lane >> 5;
            const int row = 32 * wm + l31;
#pragma unroll
            for (int ni = 0; ni < 2; ++ni)
#pragma unroll
                for (int gq = 0; gq < 4; ++gq) {
                    f32x4 w = {acc[0][ni][4 * gq], acc[0][ni][4 * gq + 1], acc[0][ni][4 * gq + 2], acc[0][ni][4 * gq + 3]};
                    *(LAS f32x4*)(L + row * LSTR + 4 * (nb_of<0>(wn, ni) + 8 * gq + 4 * hi)) = w;
                }
        };
        gemm_tile<1, 0, true>(L, Dm / 64, NE, h2, arow, bcol, epi);
        const int tid = otid(), lane = tid & 63, wave = tid >> 6;
        if (tid < 256) hist[tid] = 0;
        __syncthreads();
        const f32x4 bias = *(const f32x4*)(rb + 4 * lane);
        const int grp = lane >> 3;
#pragma unroll 1
        for (int tt = 0; tt < 8; ++tt) {
            const int tok = 8 * wave + tt;
            const f32x4 lgv = *(LAS f32x4*)(L + tok * LSTR + 16 * lane);
            const float s0 = 1.f / (1.f + __expf(-lgv[0])), s1 = 1.f / (1.f + __expf(-lgv[1])), s2 = 1.f / (1.f + __expf(-lgv[2])), s3 = 1.f / (1.f + __expf(-lgv[3]));
            float v0 = s0 + bias[0], v1 = s1 + bias[1], v2 = s2 + bias[2], v3 = s3 + bias[3];
            float t1 = fmaxf(v0, v1), t2 = fminf(v0, v1);
            { const float a = fmaxf(v2, v3), bq = fminf(v2, v3); const float n1 = fmaxf(t1, a), n2 = fmaxf(fminf(t1, a), fmaxf(t2, bq)); t1 = n1; t2 = n2; }
            { const float o1 = dppf<0xB1, 0xf>(t1, t1), o2 = dppf<0xB1, 0xf>(t2, t2); const float n1 = fmaxf(t1, o1), n2 = fmaxf(fminf(t1, o1), fmaxf(t2, o2)); t1 = n1; t2 = n2; }
            { const float o1 = dppf<0x4E, 0xf>(t1, t1), o2 = dppf<0x4E, 0xf>(t2, t2); const float n1 = fmaxf(t1, o1), n2 = fmaxf(fminf(t1, o1), fmaxf(t2, o2)); t1 = n1; t2 = n2; }
            { const float o1 = shx(t1, 4, lane), o2 = shx(t2, 4, lane); const float n1 = fmaxf(t1, o1), n2 = fmaxf(fminf(t1, o1), fmaxf(t2, o2)); t1 = n1; t2 = n2; }
            const float gs = t1 + t2;
            int rank = 0;
#pragma unroll
            for (int gg = 0; gg < 8; ++gg) { const float og = __int_as_float(__builtin_amdgcn_readlane(__float_as_int(gs), gg * 8)); rank += (og > gs || (og == gs && gg < grp)) ? 1 : 0; }
            if (rank >= 4) { v0 = -INFINITY; v1 = -INFINITY; v2 = -INFINITY; v3 = -INFINITY; }
            unsigned k0 = fkey(v0), k1 = fkey(v1), k2 = fkey(v2), k3 = fkey(v3);
            bool c0 = false, c1 = false, c2 = false, c3 = false;
#pragma unroll
            for (int it = 0; it < TOPK; ++it) {
                const unsigned lb = max(max(k0, k1), max(k2, k3));
                const unsigned m = wave_umax(lb);
                const unsigned long long bal = __ballot(lb == m);
                const int owner = __builtin_ctzll(bal);
                if (lane == owner) {
                    if (k0 == m) { k0 = 0u; c0 = true; } else if (k1 == m) { k1 = 0u; c1 = true; } else if (k2 == m) { k2 = 0u; c2 = true; } else { k3 = 0u; c3 = true; }
                }
            }
            const float wsum = wave_fsum_dpp((c0 ? s0 : 0.f) + (c1 ? s1 : 0.f) + (c2 ? s2 : 0.f) + (c3 ? s3 : 0.f));
            const float wnorm = 2.5f / wsum;
            const unsigned long long b0 = __ballot(c0), b1 = __ballot(c1), b2 = __ballot(c2), b3 = __ballot(c3);
            const unsigned long long lm = (1ull << lane) - 1ull;
            const int q0 = __builtin_popcountll(b0 & lm), a1 = __builtin_popcountll(b0);
            const int q1 = a1 + __builtin_popcountll(b1 & lm), a2 = a1 + __builtin_popcountll(b1);
            const int q2 = a2 + __builtin_popcountll(b2 & lm), a3 = a2 + __builtin_popcountll(b2);
            const int q3 = a3 + __builtin_popcountll(b3 & lm);
            if (c0) { pe[8 * tok + q0] = 4 * lane + 0; pw[8 * tok + q0] = s0 * wnorm; }
            if (c1) { pe[8 * tok + q1] = 4 * lane + 1; pw[8 * tok + q1] = s1 * wnorm; }
            if (c2) { pe[8 * tok + q2] = 4 * lane + 2; pw[8 * tok + q2] = s2 * wnorm; }
            if (c3) { pe[8 * tok + q3] = 4 * lane + 3; pw[8 * tok + q3] = s3 * wnorm; }
        }
        __syncthreads();
        const int my_e = pe[tid];
        const int my_rank = __hip_atomic_fetch_add(hist + my_e, 1, __ATOMIC_RELAXED, __HIP_MEMORY_SCOPE_WORKGROUP);
        __syncthreads();
        if (tid < 256) { const int n = hist[tid]; basep[tid] = n > 0 ? atomicAdd(cnt + tid, n) : 0; }
        __syncthreads();
        {
            const int pos = basep[my_e] + my_rank;
            if (pos < LISTCAP) { la[(size_t)my_e * LISTCAP + pos] = (m0 + (tid >> 3)) * TOPK + (tid & 7); lw[(size_t)my_e * LISTCAP + pos] = pw[tid]; }
        }
        __syncthreads();
    }
}

__device__ __forceinline__ int moe_cnt(const int* cnt, int e) { int c = (e < 256) ? cnt[e] : T; return c > LISTCAP ? LISTCAP : c; }
__device__ __forceinline__ void moe_prefix(const Params& p, LAS char* L) {
    const int tid = otid();
    const int* cnt = (const int*)(p.ws + WS_CTL);
    LAS int* pre = (LAS int*)(L + OFF_PRE);
    LAS int* tl = (LAS int*)(L + OFF_TL);
    __syncthreads();
    for (int i = tid; i < 257; i += NT) { const int c = moe_cnt(cnt, i); tl[i] = (c + 255) >> 8; }
    __syncthreads();
    if (tid == 0) { int s = 0; for (int i = 0; i < 257; ++i) { pre[i] = s; s += tl[i]; } pre[257] = s; }
    __syncthreads();
}
__device__ __forceinline__ int moe_find(LAS int* pre, int g) {
    int lo = 0, hi = 256;
    while (lo < hi) { const int mid = (lo + hi + 1) >> 1; if (pre[mid] <= g) lo = mid; else hi = mid - 1; }
    return lo;
}

template <int MI>
__device__ __forceinline__ void moe1_unit(const Params& p, LAS char* L, int e, int r0, int rows, int j0) {
    const bf16_t* h2 = (const bf16_t*)(p.ws + WS_H2);
    const int* la = (const int*)(p.ws + WS_LA);
    bf16_t* hb = (bf16_t*)(p.ws + WS_HB);
    const float* wg = (e < 256) ? p.in[22] + (size_t)e * Dm * 256 : p.in[25];
    const float* wu = (e < 256) ? p.in[23] + (size_t)e * Dm * 256 : p.in[26];
    LAS int* rowid = (LAS int*)(L + OFF_ROW);
    {
        const int tid = otid();
        if (tid < 64 * MI) { const int rr = tid < rows ? tid : 0; rowid[tid] = (e < 256) ? la[(size_t)e * LISTCAP + r0 + rr] : (AR + r0 + rr); }
        __syncthreads();
    }
    auto arow = [&](int r) { const int a = rowid[r]; const int tok = (e < 256) ? (a >> 3) : (a - AR); return (unsigned)tok * Dm; };
    auto bcol = [&](int c4) { return (c4 < 128) ? (wg + j0 + c4) : (wu + j0 + c4 - 128); };
    auto epi = [&](f32x16 (&acc)[MI][2], int seg, LAS char* Ls) {
#pragma unroll
        for (int mi = 0; mi < MI; ++mi)
#pragma unroll
            for (int r = 0; r < 16; ++r) acc[mi][0][r] = silu_f(acc[mi][0][r]) * acc[mi][1][r];
        store_tile_bf16<MI, 128>(Ls, acc, [&](int row, int c) -> bf16_t* { return row < rows ? hb + (size_t)rowid[row] * 256 + j0 + 8 * c : nullptr; });
    };
    gemm_tile<MI, 1>(L, Dm / 64, 256, h2, arow, bcol, epi);
}
__device__ __forceinline__ void phase_moe1(const Params& p, LAS char* L) {
    const int v = vcu(), G = grid_g();
    const int* cnt = (const int*)(p.ws + WS_CTL);
    moe_prefix(p, L);
    LAS int* pre = (LAS int*)(L + OFF_PRE);
    const int total = __builtin_amdgcn_readfirstlane(pre[257]) * 2;
    for (int u = v; u < total; u += G) {
        const int g = u >> 1, j0 = (u & 1) * 128;
        const int e = __builtin_amdgcn_readfirstlane(moe_find(pre, g)), mt = g - __builtin_amdgcn_readfirstlane(pre[e]);
        const int rows = __builtin_amdgcn_readfirstlane(moe_cnt(cnt, e)) - mt * 256;
        if (rows > 128) moe1_unit<4>(p, L, e, mt * 256, rows < 256 ? rows : 256, j0);
        else moe1_unit<2>(p, L, e, mt * 256, rows, j0);
    }
}

template <int MI>
__device__ __forceinline__ void moe2_unit(const Params& p, LAS char* L, int e, int r0, int rows, int n0) {
    const int* la = (const int*)(p.ws + WS_LA); const float* lw = (const float*)(p.ws + WS_LW);
    const bf16_t* hb = (const bf16_t*)(p.ws + WS_HB);
    unsigned char* yb = (unsigned char*)(p.ws + WS_YB);
    const float* wd = (e < 256) ? p.in[24] + (size_t)e * 256 * Dm : p.in[27];
    LAS int* rowid = (LAS int*)(L + OFF_ROW);
    LAS float* roww = (LAS float*)(L + OFF_RW);
    {
        const int tid = otid();
        if (tid < 64 * MI) {
            const int rr = tid < rows ? tid : 0;
            rowid[tid] = (e < 256) ? la[(size_t)e * LISTCAP + r0 + rr] : (AR + r0 + rr);
            roww[tid] = (e < 256) ? lw[(size_t)e * LISTCAP + r0 + rr] : 1.f;
        }
        __syncthreads();
    }
    auto arow = [&](int r) { return (unsigned)rowid[r] * 256; };
    auto bcol = [&](int c4) { return wd + n0 + c4; };
    auto epi = [&](f32x16 (&acc)[MI][2], int seg, LAS char* Ls) {
        const int tid_ = otid(), lane = tid_ & 63, wave = tid_ >> 6, wm = wave & 1, l31 = lane & 31;
#pragma unroll
        for (int mi = 0; mi < MI; ++mi) {
            const float w = roww[32 * MI * wm + 32 * mi + l31] * YSCALE;
#pragma unroll
            for (int ni = 0; ni < 2; ++ni)
#pragma unroll
                for (int q = 0; q < 16; ++q) acc[mi][ni][q] = __builtin_amdgcn_fmed3f(acc[mi][ni][q] * w, -448.f, 448.f);
        }
        store_tile_fp8<MI>(Ls, acc, [&](int row, int c) -> unsigned char* { return row < rows ? yb + (size_t)rowid[row] * Dm + n0 + seg * 256 + 16 * c : nullptr; });
    };
    gemm_tile<MI, 0, false, 2>(L, 256 / 64, Dm, hb, arow, bcol, epi);
}
__device__ __forceinline__ void phase_moe2(const Params& p, LAS char* L) {
    const int v = vcu(), G = grid_g();
    const int* cnt = (const int*)(p.ws + WS_CTL);
    moe_prefix(p, L);
    LAS int* pre = (LAS int*)(L + OFF_PRE);
    const int total = __builtin_amdgcn_readfirstlane(pre[257]) * 2;
    for (int u = v; u < total; u += G) {
        const int g = u >> 1, n0 = (u & 1) * 512;
        const int e = __builtin_amdgcn_readfirstlane(moe_find(pre, g)), mt = g - __builtin_amdgcn_readfirstlane(pre[e]);
        const int rows = __builtin_amdgcn_readfirstlane(moe_cnt(cnt, e)) - mt * 256;
        if (rows > 128) moe2_unit<4>(p, L, e, mt * 256, rows < 256 ? rows : 256, n0);
        else moe2_unit<2>(p, L, e, mt * 256, rows, n0);
    }
}

__device__ __forceinline__ void phase_final(const Params& p) {
    const int v = vcu(), G = grid_g();
    const int tid = otid(), lane = tid & 63, wave = tid >> 6;
    const float* pg = p.in[19];
    const float* mod = (const float*)(p.ws + WS_MOD);
    const unsigned char* yb = (const unsigned char*)(p.ws + WS_YB);
    for (int t = v * NW + wave; t < T; t += G * NW) {
        const int b = t / SEQ;
        const float* gf = mod + b * 6144 + 5120;
        float y[16];
#pragma unroll
        for (int e = 0; e < 16; ++e) y[e] = 0.f;
#pragma unroll
        for (int k = 0; k < 9; ++k) {
            const size_t row = (k < 8) ? ((size_t)t * TOPK + k) : ((size_t)AR + t);
            const u32x4 raw = *(const u32x4*)(yb + row * Dm + 16 * lane);
#pragma unroll
            for (int e = 0; e < 4; ++e) {
                const f32x2 a = __builtin_amdgcn_cvt_pk_f32_fp8((int)raw[e], false), c = __builtin_amdgcn_cvt_pk_f32_fp8((int)raw[e], true);
                y[4 * e] += a.x; y[4 * e + 1] += a.y; y[4 * e + 2] += c.x; y[4 * e + 3] += c.y;
            }
        }
        float ss = 0.f;
#pragma unroll
        for (int e = 0; e < 16; ++e) { y[e] *= (1.f / YSCALE); ss += y[e] * y[e]; }
        ss = wave_sum(ss, lane);
        const float rstd = rsqrtf(ss * (1.f / Dm) + 1e-6f);
        const int col = 16 * lane;
#pragma unroll
        for (int hq = 0; hq < 4; ++hq) {
            f32x4 xo = *(const f32x4*)(p.out + (size_t)t * Dm + col + 4 * hq);
            const f32x4 gv = *(const f32x4*)(pg + col + 4 * hq), gg = *(const f32x4*)(gf + col + 4 * hq);
#pragma unroll
            for (int e = 0; e < 4; ++e) xo[e] += gg[e] * (y[4 * hq + e] * rstd * gv[e]);
            *(f32x4*)(p.out + (size_t)t * Dm + col + 4 * hq) = xo;
        }
    }
}

#define XB_TMO      128
#define XB_XCNT(j)  (256  + 64 * (j))
#define XB_XSUB(j)  (1280 + 64 * (j))
#define XB_XGEN(j)  (2304 + 64 * (j))
#define XB_TOP      3328
#define XB_TOPGEN   3392
#define XCD_BAR_WORDS 3456
#define XB_SPIN_CAP (1u << 18)
__device__ __forceinline__ unsigned xb_ld(unsigned* p)              { return __hip_atomic_load(p, __ATOMIC_RELAXED, __HIP_MEMORY_SCOPE_AGENT); }
__device__ __forceinline__ unsigned xb_add(unsigned* p, unsigned v) { return __hip_atomic_fetch_add(p, v, __ATOMIC_RELAXED, __HIP_MEMORY_SCOPE_AGENT); }
__device__ __forceinline__ unsigned xb_xcc_id() { return (unsigned)__builtin_amdgcn_s_getreg((3 << 11) | 20) & 0xFu; }
#define XB_SPIN(cond, bar) do { unsigned _sp = 0; while (cond) { __builtin_amdgcn_s_sleep(1); \
    if ((++_sp & 255u) == 0u) { if (xb_ld(&(bar)[XB_TMO])) break; if (_sp > XB_SPIN_CAP) { atomicAdd(&(bar)[XB_TMO], 1u); break; } } } } while (0)
struct XcdBarrier { unsigned* bar; unsigned x; volatile LAS unsigned* st; };
__device__ __forceinline__ XcdBarrier xcd_barrier_post(unsigned* bar, volatile LAS unsigned* st) {
    XcdBarrier b; b.bar = bar; b.x = xb_xcc_id(); b.st = st;
    if (threadIdx.x == 0) (void)xb_add(&bar[XB_XCNT(b.x)], 1u);
    return b;
}
__device__ __forceinline__ void xcd_barrier_complete(unsigned* bar, unsigned x, unsigned& nloc, unsigned& nx) {
    const unsigned G = gridDim.x * gridDim.y * gridDim.z;
    unsigned sum, cnt, mine, sp = 0u;
    for (;;) {
        sum = 0u; cnt = 0u; mine = 0u;
#pragma unroll
        for (unsigned j = 0; j < 16; ++j) { const unsigned c = xb_ld(&bar[XB_XCNT(j)]); sum += c; cnt += (c > 0u) ? 1u : 0u; mine = (j == x) ? c : mine; }
        if (sum == G) break;
        __builtin_amdgcn_s_sleep(1);
        if ((++sp & 255u) == 0u) { if (xb_ld(&bar[XB_TMO])) break; if (sp > XB_SPIN_CAP) { atomicAdd(&bar[XB_TMO], 1u); break; } }
    }
    nloc = mine > 0u ? mine : 1u; nx = cnt > 0u ? cnt : 1u;
}
__device__ __forceinline__ void xcd_barrier(const Params& p, LAS char* L) {
    XcdBarrier b; b.bar = (unsigned*)(p.ws + WS_CTL + 4096); b.x = xb_xcc_id(); b.st = (volatile LAS unsigned*)(L + OFF_MISC);
    asm volatile("s_waitcnt vmcnt(0)" ::: "memory");
    __syncthreads();
    if (threadIdx.x == 0) {
        unsigned* bar = b.bar;
        __builtin_amdgcn_s_waitcnt(0);
        unsigned nloc = b.st[0], nx = b.st[1];
        if (nloc == 0u) { xcd_barrier_complete(bar, b.x, nloc, nx); b.st[0] = nloc; b.st[1] = nx; }
        const unsigned old = xb_add(&bar[XB_XSUB(b.x)], 1u);
        const unsigned gen = old / nloc;
        if (old + 1u == (gen + 1u) * nloc) {
            __builtin_amdgcn_fence(__ATOMIC_RELEASE, "agent");
            asm volatile("s_waitcnt vmcnt(0)" ::: "memory");
            const unsigned og = xb_add(&bar[XB_TOP], 1u);
            const unsigned tg = og / nx;
            if (og + 1u == (tg + 1u) * nx) xb_add(&bar[XB_TOPGEN], 1u);
            else XB_SPIN(xb_ld(&bar[XB_TOPGEN]) == tg, bar);
            __builtin_amdgcn_fence(__ATOMIC_ACQUIRE, "agent");
            xb_add(&bar[XB_XGEN(b.x)], 1u);
            asm volatile("s_waitcnt vmcnt(0)" ::: "memory");
        } else {
            XB_SPIN(xb_ld(&bar[XB_XGEN(b.x)]) == gen, bar);
            __builtin_amdgcn_fence(__ATOMIC_ACQUIRE, "agent");
            asm volatile("s_waitcnt vmcnt(0)" ::: "memory");
        }
    }
    __syncthreads();
}

__global__ void __launch_bounds__(NT, 2) mega(Params p) {
    extern __shared__ __attribute__((aligned(16))) char smem[];
    LAS char* L = (LAS char*)smem;
    if (threadIdx.x < 8) ((LAS unsigned*)(L + OFF_MISC))[threadIdx.x] = 0u;
    __syncthreads();
    (void)xcd_barrier_post((unsigned*)(p.ws + WS_CTL + 4096), (volatile LAS unsigned*)(L + OFF_MISC));
    phase_mod(p, L);
    xcd_barrier(p, L);
    phase_h1(p);
    xcd_barrier(p, L);
    phase_proj(p, L);
    xcd_barrier(p, L);
    phase_qkv(p, L);
    xcd_barrier(p, L);
    phase_attn(p, L);
    xcd_barrier(p, L);
    phase_oproj(p, L);
    xcd_barrier(p, L);
    phase_router_route(p, L);
    xcd_barrier(p, L);
    phase_moe1(p, L);
    xcd_barrier(p, L);
    phase_moe2(p, L);
    xcd_barrier(p, L);
    phase_final(p);
}

extern "C" void kernel_launch(void* const* d_in, const int* in_sizes, int n_in, void* d_out, int out_size, void* d_ws, size_t ws_size, hipStream_t stream) {
    static int grid_blocks = 0;
    if (grid_blocks == 0) {
        if (n_in != 28 || out_size != T * Dm || ws_size < WS_END) {
            fprintf(stderr, "kernel_launch: unexpected problem (n_in %d, out %d, ws %zu); nothing launched\n", n_in, out_size, ws_size);
            grid_blocks = -1; return;
        }
        int dev = 0, cus = 0, per_cu = 0;
        (void)hipGetDevice(&dev);
        (void)hipDeviceGetAttribute(&cus, hipDeviceAttributeMultiprocessorCount, dev);
        if (hipFuncSetAttribute((const void*)mega, hipFuncAttributeMaxDynamicSharedMemorySize, LDS_BYTES) != hipSuccess) {
            fprintf(stderr, "kernel_launch: hipFuncSetAttribute(%d B LDS) failed\n", LDS_BYTES); grid_blocks = -1; return;
        }
        (void)hipOccupancyMaxActiveBlocksPerMultiprocessor(&per_cu, mega, NT, LDS_BYTES);
        if (per_cu < 1) { fprintf(stderr, "kernel_launch: occupancy query says %d blocks per CU\n", per_cu); per_cu = 1; }
        grid_blocks = cus;
        fprintf(stderr, "kernel_launch: %d CUs, occupancy query %d per CU, grid %d\n", cus, per_cu, grid_blocks);
    }
    if (grid_blocks < 0) return;
    (void)hipMemsetAsync((char*)d_ws + WS_CTL, 0, CTL_BYTES, stream);
    Params p{};
    for (int i = 0; i < 28; ++i) p.in[i] = (const float*)d_in[i];
    p.out = (float*)d_out; p.ws = (char*)d_ws;
    void* args[] = {&p};
    hipError_t e = hipLaunchCooperativeKernel((void*)mega, dim3(grid_blocks), dim3(NT), args, LDS_BYTES, stream);
    if (e != hipSuccess) fprintf(stderr, "cooperative launch failed: %s (grid %d)\n", hipGetErrorString(e), grid_blocks);
}
```

```cpp
#include <hip/hip_runtime.h>
#include <cstdio>
#include <cstdint>


typedef unsigned short bf16_t;
typedef float f32x2 __attribute__((ext_vector_type(2)));
typedef short bf16x8 __attribute__((ext_vector_type(8)));
typedef short s16x4 __attribute__((ext_vector_type(4)));
typedef short v4i16_t __attribute__((ext_vector_type(4)));
typedef float f32x16 __attribute__((ext_vector_type(16)));
typedef float f32x4 __attribute__((ext_vector_type(4)));
typedef unsigned u32x4 __attribute__((ext_vector_type(4)));
typedef unsigned u32x2 __attribute__((ext_vector_type(2)));
#define LAS __attribute__((address_space(3)))

constexpr int NT = 512, NW = 8;
constexpr int Dm = 1024, NB = 8, SEQ = 2048, T = NB * SEQ;
constexpr int NIN = 1952;
constexpr int C_CQ = 0, C_CKV = 256, C_KR = 384, C_DQ = 416, C_DK = 928, C_DV = 1440;
constexpr int NE = 256, TOPK = 8, AR = T * TOPK, HROWS = AR + T;
constexpr int LISTCAP = T;
constexpr float LOG2E = 1.4426950408889634f;
constexpr float YSCALE = 32.f;
constexpr float LAMBDA_INIT = 0.2f;

constexpr size_t MiB = 1u << 20;
constexpr size_t WS_CTL = 0, CTL_BYTES = 65536;
constexpr size_t WS_MOD = 65536;
constexpr size_t WS_ROPE = 1 * MiB;
constexpr size_t WS_H1 = 4 * MiB;
constexpr size_t WS_PROJ = 36 * MiB;
constexpr size_t WS_CQN = 100 * MiB;
constexpr size_t WS_CKVN = 108 * MiB;
constexpr size_t WS_QM = 112 * MiB;
constexpr size_t WS_KF = 136 * MiB;
constexpr size_t WS_VM = 160 * MiB;
constexpr size_t WS_ATT = 176 * MiB;
constexpr size_t WS_OD0 = 208 * MiB;
constexpr size_t WS_Y1 = 240 * MiB;
constexpr size_t WS_H2 = 304 * MiB;
constexpr size_t WS_LOG = 336 * MiB;
constexpr size_t WS_LA = 352 * MiB;
constexpr size_t WS_LW = 368 * MiB;
constexpr size_t WS_HB = 384 * MiB;
constexpr size_t WS_YB = 456 * MiB;
constexpr size_t WS_WB = 744 * MiB;
constexpr size_t WB_IN = 0, WB_UQ = WB_IN + (size_t)1024 * 1952, WB_UKV = WB_UQ + 256 * 768, WB_O = WB_UKV + 128 * 1024, WB_R = WB_O + 1024 * 1024, WB_END = WB_R + 1024 * 256;
constexpr size_t WS_END = 760 * MiB;

constexpr int G_XB = 32768, G_WB = 36864, G_BUF = G_XB + G_WB, G_LDS = 2 * G_BUF;
constexpr int OFF_MISC = G_LDS, OFF_PRE = OFF_MISC + 64, OFF_TL = OFF_PRE + 1088;
constexpr int OFF_ROW = OFF_TL + 1088, OFF_RW = OFF_ROW + 1024;
constexpr int OFF_SS = OFF_RW + 1024;
constexpr int LDS_BYTES = G_LDS + 4352 + 4096;

struct Params {
    const float* in[28];
    float* out;
    char* ws;
};

__device__ __forceinline__ unsigned short f2bf(float f) { __bf16 b = (__bf16)f; return __builtin_bit_cast(unsigned short, b); }
typedef __bf16 bf16x2_t __attribute__((ext_vector_type(2)));
__device__ __forceinline__ unsigned pk2(float lo, float hi) { const f32x2 v = {lo, hi}; return __builtin_bit_cast(unsigned, __builtin_convertvector(v, bf16x2_t)); }
__device__ __forceinline__ float bf2f(unsigned short b) { return __uint_as_float(((unsigned)b) << 16); }
__device__ __forceinline__ float bflo(unsigned u) { return __uint_as_float(u << 16); }
__device__ __forceinline__ float bfhi(unsigned u) { return __uint_as_float(u & 0xffff0000u); }
__device__ __forceinline__ int crow(int r, int hi) { return (r & 3) + 8 * (r >> 2) + 4 * hi; }
__device__ __forceinline__ float shx(float v, int m, int lane) { return __int_as_float(__builtin_amdgcn_ds_bpermute((lane ^ m) << 2, __float_as_int(v))); }
__device__ __forceinline__ int shxi(int v, int m, int lane) { return __builtin_amdgcn_ds_bpermute((lane ^ m) << 2, v); }
__device__ __forceinline__ float shl(float v, int src) { return __int_as_float(__builtin_amdgcn_ds_bpermute(src << 2, __float_as_int(v))); }
__device__ __forceinline__ float wave_sum(float v, int lane) {
#pragma unroll
    for (int o = 32; o >= 1; o >>= 1) v += shx(v, o, lane);
    return v;
}
__device__ __forceinline__ float silu_f(float v) { return v / (1.f + __expf(-v)); }
__device__ __forceinline__ s16x4 tr_read(LAS char* p) {
    return __builtin_bit_cast(s16x4, __builtin_amdgcn_ds_read_tr16_b64_v4i16((LAS v4i16_t*)p));
}
__device__ __forceinline__ int otid() { int t = threadIdx.x; asm volatile("" : "+v"(t)); return t; }
__device__ __forceinline__ int grid_g() { return gridDim.x; }
__device__ __forceinline__ int vcu() { const int G = gridDim.x, bx = blockIdx.x; return (G % 8 == 0) ? (bx % 8) * (G / 8) + bx / 8 : bx; }
__device__ __forceinline__ void gld16(u32x4& d, const void* p) { asm volatile("global_load_dwordx4 %0, %1, off" : "+v"(d) : "v"(p) : "memory"); }
__device__ __forceinline__ void gld16(f32x4& d, const void* p) { asm volatile("global_load_dwordx4 %0, %1, off" : "+v"(d) : "v"(p) : "memory"); }
template <int N> __device__ __forceinline__ void vm_wait(u32x4& a, f32x4& b, f32x4& c) { asm volatile("s_waitcnt vmcnt(%3)" : "+v"(a), "+v"(b), "+v"(c) : "n"(N) : "memory"); }
template <int N> __device__ __forceinline__ void vm_wait(f32x4& b, f32x4& c) { asm volatile("s_waitcnt vmcnt(%2)" : "+v"(b), "+v"(c) : "n"(N) : "memory"); }
template <int N> __device__ __forceinline__ void vm_wait(u32x4& a, u32x4& b) { asm volatile("s_waitcnt vmcnt(%2)" : "+v"(a), "+v"(b) : "n"(N) : "memory"); }
template <int N> __device__ __forceinline__ void vm_wait(u32x4& b) { asm volatile("s_waitcnt vmcnt(%1)" : "+v"(b) : "n"(N) : "memory"); }
#define MFMA32(a, b, c) __builtin_amdgcn_mfma_f32_32x32x16_bf16(a, b, c, 0, 0, 0)

template <int NBMODE> __device__ __forceinline__ int nb_of(int wn, int ni) { return NBMODE == 0 ? 64 * wn + 32 * ni : 32 * wn + 128 * ni; }

template <int MI, int NBMODE, bool WBF = false, int NSEG = 1, class AF, class BF, class EF>
__device__ __forceinline__ void gemm_tile(LAS char* L, int nk, long ldw, const bf16_t* abase, AF arow, BF bcol, EF epi) {
    asm volatile("" : "+s"(nk));
    const int tid = otid(), lane = tid & 63, wave = tid >> 6;
    const int wm = wave & 1, wn = wave >> 1, l31 = lane & 31, hi = lane >> 5;
    const int a_chunk = tid & 7, a_row = tid >> 3;
    const int a_w = a_row * 128 + 16 * (a_chunk ^ ((a_row >> 1) & 7));
    const int b_n4 = WBF ? (tid & 31) : (tid & 63), b_kr = WBF ? (tid >> 5) : (tid >> 6);
    const auto bp = bcol((WBF ? 8 : 4) * b_n4) + (long)b_kr * ldw;
    const int b_w = G_XB + b_kr * 576 + (WBF ? 16 : 8) * b_n4;
    const int sw = (l31 >> 1) & 7;
    const int xoff = (32 * MI * wm + l31) * 128;
    const int woff = G_XB + (8 * hi + ((lane & 15) >> 2)) * 576 + 2 * (16 * ((lane >> 4) & 1) + 4 * (lane & 3));
    u32x4 ra[MI]; f32x4 rb[8]; u32x4 rw[4];
#pragma unroll
    for (int i = 0; i < MI; ++i) ra[i] = (u32x4){0u, 0u, 0u, 0u};
#pragma unroll
    for (int i = 0; i < 8; ++i) rb[i] = (f32x4){0.f, 0.f, 0.f, 0.f};
#pragma unroll
    for (int i = 0; i < 4; ++i) rw[i] = (u32x4){0u, 0u, 0u, 0u};
#define G_LOADW(KOFF, Q, SEGC) do { \
        if (WBF) { gld16(rw[Q], bp + (long)((KOFF) + 16 * (Q)) * ldw + (SEGC)); } \
        else { gld16(rb[2 * (Q)], bp + (long)((KOFF) + 16 * (Q)) * ldw + (SEGC)); gld16(rb[2 * (Q) + 1], bp + (long)((KOFF) + 16 * (Q) + 8) * ldw + (SEGC)); } } while (0)
#define G_LOADQ(KT, Q) do { \
        if ((Q) < MI) gld16(ra[(Q) < MI ? (Q) : 0], abase + arow(a_row + 64 * (Q)) + a_chunk * 8 + (KT) * 64); \
        G_LOADW((KT) * 64, Q, 0); } while (0)
#define G_LOADQ_SEL(KT, SEG, Q, OK) do { \
        const int kq_ = (OK) ? (KT) * 64 : 0; const int sc_ = (OK) ? (SEG) * 256 : 0; \
        if ((Q) < MI) gld16(ra[(Q) < MI ? (Q) : 0], abase + arow(a_row + 64 * (Q)) + a_chunk * 8 + kq_); \
        G_LOADW(kq_, Q, sc_); } while (0)
#define G_WAITQ(Q, N) do { \
        if (WBF) { if ((Q) < MI) vm_wait<N>(ra[(Q) < MI ? (Q) : 0], rw[Q]); else vm_wait<N>(rw[Q]); } \
        else { if ((Q) < MI) vm_wait<N>(ra[(Q) < MI ? (Q) : 0], rb[2 * (Q)], rb[2 * (Q) + 1]); else vm_wait<N>(rb[2 * (Q)], rb[2 * (Q) + 1]); } } while (0)
#define G_STOREQ(LP, Q) do { \
        if ((Q) < MI) *(LAS u32x4*)((LP) + a_w + (Q) * 8192) = ra[(Q) < MI ? (Q) : 0]; \
        if (WBF) { *(LAS u32x4*)((LP) + b_w + (Q) * 16 * 576) = rw[Q]; } else { \
        { u32x2 w; w.x = pk2(rb[2 * (Q)][0], rb[2 * (Q)][1]); w.y = pk2(rb[2 * (Q)][2], rb[2 * (Q)][3]); *(LAS u32x2*)((LP) + b_w + (Q) * 16 * 576) = w; } \
        { u32x2 w; w.x = pk2(rb[2 * (Q) + 1][0], rb[2 * (Q) + 1][1]); w.y = pk2(rb[2 * (Q) + 1][2], rb[2 * (Q) + 1][3]); *(LAS u32x2*)((LP) + b_w + (Q) * 16 * 576 + 8 * 576) = w; } } } while (0)
    constexpr int NLW = WBF ? 1 : 2;
    constexpr int NL0 = NLW + ((0 < MI) ? 1 : 0), NL1 = NLW + ((1 < MI) ? 1 : 0), NL2 = NLW + ((2 < MI) ? 1 : 0), NL3 = NLW + ((3 < MI) ? 1 : 0), NLT = NL0 + NL1 + NL2 + NL3;
    G_LOADQ(0, 0); G_LOADQ(0, 1); G_LOADQ(0, 2); G_LOADQ(0, 3);
    G_WAITQ(0, 0); G_WAITQ(1, 0); G_WAITQ(2, 0); G_WAITQ(3, 0);
    G_STOREQ(L, 0); G_STOREQ(L, 1); G_STOREQ(L, 2); G_STOREQ(L, 3);
    G_LOADQ(1, 0); G_LOADQ(1, 1); G_LOADQ(1, 2); G_LOADQ(1, 3);
    f32x16 acc[MI][2];
#pragma unroll
    for (int i = 0; i < MI; ++i)
#pragma unroll
        for (int j = 0; j < 2; ++j)
#pragma unroll
            for (int r = 0; r < 16; ++r) acc[i][j][r] = 0.f;
    __syncthreads();
    const int nt_all = nk * NSEG;
    int lk = (nk == 2) ? 0 : 2, lseg = (nk == 2) ? 1 : 0;
    int ck = 0, cseg = 0;
#pragma nounroll
    for (int kt = 0; kt < nt_all; ++kt) {
        LAS char* Lb = L + (kt & 1) * G_BUF;
        LAS char* Ln = L + ((kt + 1) & 1) * G_BUF;
        const bool ld = kt + 2 < nt_all;
        bf16x8 xf[2][MI], wf[2][2];
#define LOAD_FRAGS(KS, B) do { \
            _Pragma("unroll") for (int mi = 0; mi < MI; ++mi) xf[B][mi] = *(LAS bf16x8*)(Lb + xoff + mi * 4096 + 16 * ((2 * (KS) + hi) ^ sw)); \
            _Pragma("unroll") for (int ni = 0; ni < 2; ++ni) { \
                LAS char* pp = Lb + woff + (KS) * 16 * 576 + 2 * nb_of<NBMODE>(wn, ni); \
                const s16x4 lo = tr_read(pp), h4 = tr_read(pp + 4 * 576); \
                wf[B][ni] = (bf16x8){lo[0], lo[1], lo[2], lo[3], h4[0], h4[1], h4[2], h4[3]}; } } while (0)
#define MMA_STEP(KS) do { \
            _Pragma("unroll") for (int mi = 0; mi < MI; ++mi) \
                _Pragma("unroll") for (int ni = 0; ni < 2; ++ni) acc[mi][ni] = MFMA32(wf[(KS) & 1][ni], xf[(KS) & 1][mi], acc[mi][ni]); } while (0)
#define STAGE_STEP(Q, NREST, NPREV) do { G_WAITQ(Q, (NREST) + (NPREV)); G_STOREQ(Ln, Q); G_LOADQ_SEL(lk, lseg, Q, ld); } while (0)
        LOAD_FRAGS(0, 0);
        LOAD_FRAGS(1, 1); MMA_STEP(0); STAGE_STEP(0, NL1 + NL2 + NL3, 0);           __builtin_amdgcn_sched_barrier(0);
        LOAD_FRAGS(2, 0); MMA_STEP(1); STAGE_STEP(1, NL2 + NL3, NL0);               __builtin_amdgcn_sched_barrier(0);
        LOAD_FRAGS(3, 1); MMA_STEP(2); STAGE_STEP(2, NL3, NL0 + NL1);               __builtin_amdgcn_sched_barrier(0);
        MMA_STEP(3);                   STAGE_STEP(3, 0, NL0 + NL1 + NL2);           __builtin_amdgcn_sched_barrier(0);
#undef LOAD_FRAGS
#undef MMA_STEP
#undef STAGE_STEP
        __syncthreads();
        if (++lk == nk) { lk = 0; ++lseg; }
        if (NSEG > 1) {
            if (++ck == nk) {
                ck = 0;
                if (cseg + 1 < NSEG) {
                    epi(acc, cseg, L + (kt & 1) * G_BUF);
#pragma unroll
                    for (int i = 0; i < MI; ++i)
#pragma unroll
                        for (int j = 0; j < 2; ++j)
#pragma unroll
                            for (int r = 0; r < 16; ++r) acc[i][j][r] = 0.f;
                }
                ++cseg;
            }
        }
    }
    G_WAITQ(0, 0); G_WAITQ(1, 0); G_WAITQ(2, 0); G_WAITQ(3, 0);
#undef G_LOADQ
#undef G_LOADQ_SEL
#undef G_LOADW
#undef G_WAITQ
#undef G_STOREQ
    (void)NLT;
    epi(acc, NSEG - 1, L);
}

template <int MI, int NC, class DF>
__device__ __forceinline__ void store_tile_bf16(LAS char* L, const f32x16 (&acc)[MI][2], DF dst) {
    constexpr int STR = NC * 2 + 16, CPR = NC / 8, BM = 64 * MI;
    const int tid = otid(), lane = tid & 63, wave = tid >> 6, wm = wave & 1, wn = wave >> 1, l31 = lane & 31, hi = lane >> 5;
#pragma unroll
    for (int mi = 0; mi < MI; ++mi)
#pragma unroll
        for (int ni = 0; ni < (NC == 256 ? 2 : 1); ++ni) {
            const int row = 32 * MI * wm + 32 * mi + l31, col = (NC == 256) ? nb_of<0>(wn, ni) : 32 * wn;
#pragma unroll
            for (int gq = 0; gq < 4; ++gq) {
                u32x2 w; w.x = pk2(acc[mi][ni][4 * gq], acc[mi][ni][4 * gq + 1]); w.y = pk2(acc[mi][ni][4 * gq + 2], acc[mi][ni][4 * gq + 3]);
                *(LAS u32x2*)(L + row * STR + 2 * (col + 8 * gq + 4 * hi)) = w;
            }
        }
    __syncthreads();
#pragma unroll
    for (int i = 0; i < (BM * CPR) / NT; ++i) {
        const int id = tid + NT * i, row = id / CPR, c = id % CPR;
        bf16_t* d = dst(row, c);
        if (d) *(u32x4*)d = *(LAS u32x4*)(L + row * STR + 16 * c);
    }
    __syncthreads();
}

template <int MI, class DF>
__device__ __forceinline__ void store_tile_fp8(LAS char* L, const f32x16 (&acc)[MI][2], DF dst) {
    constexpr int STR = 256 + 16, BM = 64 * MI;
    const int tid = otid(), lane = tid & 63, wave = tid >> 6, wm = wave & 1, wn = wave >> 1, l31 = lane & 31, hi = lane >> 5;
#pragma unroll
    for (int mi = 0; mi < MI; ++mi)
#pragma unroll
        for (int ni = 0; ni < 2; ++ni) {
            const int row = 32 * MI * wm + 32 * mi + l31, col = nb_of<0>(wn, ni);
#pragma unroll
            for (int gq = 0; gq < 4; ++gq) {
                int w = 0;
                w = __builtin_amdgcn_cvt_pk_fp8_f32(acc[mi][ni][4 * gq], acc[mi][ni][4 * gq + 1], w, false);
                w = __builtin_amdgcn_cvt_pk_fp8_f32(acc[mi][ni][4 * gq + 2], acc[mi][ni][4 * gq + 3], w, true);
                *(LAS int*)(L + row * STR + (col + 8 * gq + 4 * hi)) = w;
            }
        }
    __syncthreads();
#pragma unroll
    for (int i = 0; i < (BM * 16) / NT; ++i) {
        const int id = tid + NT * i, row = id >> 4, c = id & 15;
        unsigned char* d = dst(row, c);
        if (d) *(u32x4*)d = *(LAS u32x4*)(L + row * STR + 16 * c);
    }
    __syncthreads();
}

__device__ __forceinline__ void phase_mod(const Params& p, LAS char* L) {
    const int v = vcu(), G = grid_g();
    const int tid = otid();
    const float* c = p.in[1]; const float* w_ada = p.in[3]; const float* b_ada = p.in[4];
    float* mod = (float*)(p.ws + WS_MOD);
    LAS float* sc = (LAS float*)L;
    LAS float* red = (LAS float*)(L + 32768);
    bool filled = false;
    for (int item = v; item < 384; item += G) {
        if (!filled) {
            for (int i = tid; i < 8 * 1024; i += NT) sc[i] = silu_f(c[i]);
            __syncthreads(); filled = true;
        }
        const int cx = tid & 15, kl = tid >> 4, col = item * 16 + cx;
        float a[8];
#pragma unroll
        for (int b = 0; b < 8; ++b) a[b] = 0.f;
#pragma unroll 4
        for (int k = kl; k < 1024; k += 32) {
            const float w = w_ada[(size_t)k * 6144 + col];
#pragma unroll
            for (int b = 0; b < 8; ++b) a[b] += sc[b * 1024 + k] * w;
        }
#pragma unroll
        for (int b = 0; b < 8; ++b) red[(b * 32 + kl) * 16 + cx] = a[b];
        __syncthreads();
        if (tid < 128) {
            const int b = tid >> 4, cc = tid & 15; float s = 0.f;
#pragma unroll
            for (int k = 0; k < 32; ++k) s += red[(b * 32 + k) * 16 + cc];
            mod[b * 6144 + item * 16 + cc] = s + b_ada[item * 16 + cc];
        }
        __syncthreads();
    }
    {
        bf16_t* wb = (bf16_t*)(p.ws + WS_WB);
        const size_t gt = (size_t)v * NT + tid, gs = (size_t)G * NT;
        auto conv = [&](const float* src, size_t off, size_t n) {
            for (size_t i = gt; i < n / 4; i += gs) { const f32x4 f = *(const f32x4*)(src + 4 * i); u32x2 w; w.x = pk2(f[0], f[1]); w.y = pk2(f[2], f[3]); *(u32x2*)(wb + off + 4 * i) = w; }
        };
        auto convg = [&](const float* src, size_t off, size_t n, int ncol, const float* gain) {
            for (size_t i = gt; i < n / 4; i += gs) { const float gk = gain[(4 * i) / ncol]; const f32x4 f = *(const f32x4*)(src + 4 * i); u32x2 w; w.x = pk2(f[0] * gk, f[1] * gk); w.y = pk2(f[2] * gk, f[3] * gk); *(u32x2*)(wb + off + 4 * i) = w; }
        };
        conv(p.in[7], WB_IN, (size_t)1024 * 1952); convg(p.in[10], WB_UQ, (size_t)256 * 768, 768, p.in[8]); convg(p.in[11], WB_UKV, (size_t)128 * 1024, 1024, p.in[9]);
        conv(p.in[17], WB_O, (size_t)1024 * 1024); conv(p.in[20], WB_R, (size_t)1024 * 256);
    }
}

__device__ __forceinline__ void phase_h1(const Params& p) {
    const int v = vcu(), G = grid_g();
    const int tid = otid(), lane = tid & 63, wave = tid >> 6;
    const float* x = p.in[0]; const int* positions = (const int*)p.in[2]; const float* g = p.in[5];
    const float* mod = (const float*)(p.ws + WS_MOD);
    bf16_t* h1 = (bf16_t*)(p.ws + WS_H1);
    f32x2* rope = (f32x2*)(p.ws + WS_ROPE);
    for (int t = v * NW + wave; t < T; t += G * NW) {
        const int b = t / SEQ;
        const f32x4* xr = (const f32x4*)(x + (size_t)t * Dm);
        f32x4 xv[4]; float ss = 0.f;
#pragma unroll
        for (int j = 0; j < 4; ++j) { xv[j] = xr[lane + 64 * j]; ss += xv[j][0] * xv[j][0] + xv[j][1] * xv[j][1] + xv[j][2] * xv[j][2] + xv[j][3] * xv[j][3]; }
        ss = wave_sum(ss, lane);
        const float rstd = rsqrtf(ss * (1.f / Dm) + 1e-6f);
        const float* sh = mod + b * 6144; const float* scl = sh + 1024;
#pragma unroll
        for (int j = 0; j < 4; ++j) {
            const int col = 4 * (lane + 64 * j);
            const f32x4 gv = *(const f32x4*)(g + col), sv = *(const f32x4*)(scl + col), hv = *(const f32x4*)(sh + col);
            float o[4];
#pragma unroll
            for (int e = 0; e < 4; ++e) o[e] = (xv[j][e] * rstd * gv[e]) * (1.f + sv[e]) + hv[e];
            u32x2 w; w.x = pk2(o[0], o[1]); w.y = pk2(o[2], o[3]);
            *(u32x2*)(h1 + (size_t)t * Dm + col) = w;
        }
        if (lane < 16) {
            const double inv = exp2(-(double)lane * (13.287712379549449 / 16.0));
            const double rev = (double)positions[t] * inv * 0.15915494309189535;
            const float fr = (float)(rev - rint(rev));
            f32x2 cs; cs.x = __builtin_amdgcn_cosf(fr); cs.y = __builtin_amdgcn_sinf(fr);
            rope[(size_t)t * 16 + lane] = cs;
        }
    }
}

__device__ __forceinline__ void phase_proj(const Params& p, LAS char* L) {
    const int v = vcu(), G = grid_g();
    const bf16_t* h1 = (const bf16_t*)(p.ws + WS_H1);
    const bf16_t* w_in = (const bf16_t*)(p.ws + WS_WB) + WB_IN;
    bf16_t* proj = (bf16_t*)(p.ws + WS_PROJ);
    const f32x2* rope = (const f32x2*)(p.ws + WS_ROPE);
    for (int u = v; u < 64 * 8; u += G) {
        const int mt = u >> 3, nt = u & 7, m0 = mt * 256, n0 = nt * 256;
        auto arow = [&](int r) { return (unsigned)(m0 + r) * Dm; };
        auto bcol = [&](int c) { int col = n0 + c; if (col > NIN - 8) col = NIN - 8; return w_in + col; };
        auto epi = [&](f32x16 (&acc)[4][2], int seg, LAS char* Ls) {
            const int tid_ = otid(), lane = tid_ & 63, wave = tid_ >> 6, wm = wave & 1, wn = wave >> 1, l31 = lane & 31, hi = lane >> 5;
            if (nt < 2) {
                LAS float* ssl = (LAS float*)(L + OFF_SS);
                const bool contrib = (nt == 0) || (wn < 2);
#pragma unroll
                for (int mi = 0; mi < 4; ++mi) {
                    float part = 0.f;
#pragma unroll
                    for (int ni = 0; ni < 2; ++ni)
#pragma unroll
                        for (int r = 0; r < 16; ++r) part += acc[mi][ni][r] * acc[mi][ni][r];
                    part += shx(part, 32, lane);
                    if (hi == 0) ssl[(128 * wm + 32 * mi + l31) * 4 + wn] = contrib ? part : 0.f;
                }
                __syncthreads();
                if (tid_ < 256) {
                    const f32x4 q4 = *(LAS f32x4*)(ssl + tid_ * 4);
                    const float ssum = (q4[0] + q4[1]) + (q4[2] + q4[3]);
                    float* rs = (float*)(p.ws + WS_CQN) + (nt == 0 ? 0 : (1 << 18));
                    rs[m0 + tid_] = rsqrtf(ssum * (nt == 0 ? 1.f / 256.f : 1.f / 128.f) + 1e-6f);
                }
            }
#pragma unroll
            for (int ni = 0; ni < 2; ++ni) {
                const int nbg = n0 + nb_of<0>(wn, ni);
                if (nbg == C_KR) {
#pragma unroll
                    for (int mi = 0; mi < 4; ++mi) {
                        const int m = m0 + 128 * wm + 32 * mi + l31;
#pragma unroll
                        for (int r = 0; r < 8; ++r) {
                            const f32x2 cs = rope[(size_t)m * 16 + crow(r, hi)];
                            const float x1 = acc[mi][ni][r], x2 = acc[mi][ni][r + 8];
                            acc[mi][ni][r] = x1 * cs.x - x2 * cs.y; acc[mi][ni][r + 8] = x2 * cs.x + x1 * cs.y;
                        }
                    }
                }
                if (nbg >= C_DQ && nbg < C_DK) {
#pragma unroll
                    for (int mi = 0; mi < 4; ++mi)
#pragma unroll
                        for (int r = 0; r < 16; ++r) acc[mi][ni][r] *= 0.125f * LOG2E;
                }
            }
            store_tile_bf16<4, 256>(Ls, acc, [&](int row, int c) -> bf16_t* { const int col = n0 + 8 * c; return col < NIN ? proj + (size_t)(m0 + row) * NIN + col : nullptr; });
        };
        gemm_tile<4, 0, true>(L, Dm / 64, NIN, h1, arow, bcol, epi);
    }
}

__device__ __forceinline__ void phase_qkv(const Params& p, LAS char* L) {
    const int v = vcu(), G = grid_g();
    const bf16_t* proj = (const bf16_t*)(p.ws + WS_PROJ);
    const float* rstd_q = (const float*)(p.ws + WS_CQN); const float* rstd_kv = rstd_q + (1 << 18);
    const bf16_t* w_uq = (const bf16_t*)(p.ws + WS_WB) + WB_UQ; const bf16_t* w_ukv = (const bf16_t*)(p.ws + WS_WB) + WB_UKV;
    bf16_t* qm = (bf16_t*)(p.ws + WS_QM); bf16_t* kf = (bf16_t*)(p.ws + WS_KF); bf16_t* vm = (bf16_t*)(p.ws + WS_VM);
    const f32x2* rope = (const f32x2*)(p.ws + WS_ROPE);
    const float qscale = LOG2E * 0.10206207261596575f;
    for (int u = v; u < 64 * 7; u += G) {
        const int mt = u / 7, j = u % 7, m0 = mt * 256;
        if (j < 3) {
            const int n0 = j * 256;
            auto arow = [&](int r) { return (unsigned)(m0 + r) * NIN + C_CQ; };
            auto bcol = [&](int c) { return w_uq + n0 + c; };
            auto epi = [&](f32x16 (&acc)[4][2], int seg, LAS char* Ls) {
                const int tid_ = otid(), lane = tid_ & 63, wave = tid_ >> 6, wm = wave & 1, wn = wave >> 1, l31 = lane & 31, hi = lane >> 5;
#pragma unroll
                for (int mi = 0; mi < 4; ++mi) {
                    const int m = m0 + 128 * wm + 32 * mi + l31;
                    const float qs = qscale * rstd_q[m];
#pragma unroll
                    for (int ni = 0; ni < 2; ++ni) {
                        const int nbg = n0 + nb_of<0>(wn, ni);
                        if ((nbg % 96) == 64) {
#pragma unroll
                            for (int r = 0; r < 8; ++r) {
                                const f32x2 cs = rope[(size_t)m * 16 + crow(r, hi)];
                                const float x1 = acc[mi][ni][r], x2 = acc[mi][ni][r + 8];
                                acc[mi][ni][r] = x1 * cs.x - x2 * cs.y; acc[mi][ni][r + 8] = x2 * cs.x + x1 * cs.y;
                            }
                        }
#pragma unroll
                        for (int r = 0; r < 16; ++r) acc[mi][ni][r] *= qs;
                    }
                }
                store_tile_bf16<4, 256>(Ls, acc, [&](int row, int c) -> bf16_t* { return qm + (size_t)(m0 + row) * 768 + n0 + 8 * c; });
            };
            gemm_tile<4, 0, true>(L, 256 / 64, 768, proj, arow, bcol, epi);
        } else {
            const int n0 = (j - 3) * 256;
            auto arow = [&](int r) { return (unsigned)(m0 + r) * NIN + C_CKV; };
            auto bcol = [&](int c) { return w_ukv + n0 + c; };
            auto epi = [&](f32x16 (&acc)[4][2], int seg, LAS char* Ls) {
                {
                    const int tid_ = otid(), lane = tid_ & 63, wave = tid_ >> 6, wm = wave & 1, l31 = lane & 31;
#pragma unroll
                    for (int mi = 0; mi < 4; ++mi) {
                        const float rs = rstd_kv[m0 + 128 * wm + 32 * mi + l31];
#pragma unroll
                        for (int ni = 0; ni < 2; ++ni)
#pragma unroll
                            for (int r = 0; r < 16; ++r) acc[mi][ni][r] *= rs;
                    }
                }
                store_tile_bf16<4, 256>(Ls, acc, [&](int row, int c) -> bf16_t* {
                    const int h = (n0 >> 7) + (c >> 4), cc = c & 15;
                    return cc < 8 ? kf + (size_t)(m0 + row) * 768 + h * 96 + 8 * cc : vm + (size_t)(m0 + row) * 512 + h * 64 + 8 * (cc - 8); });
            };
            gemm_tile<4, 0, true>(L, 128 / 64, 1024, proj, arow, bcol, epi);
        }
    }
}

template <int DQK, int DV, bool ALIBI>
__device__ __forceinline__ void attn_map(LAS char* L, const bf16_t* Q, int ldq, const bf16_t* K, int ldk, const bf16_t* V, int ldv,
                                         const int* posrow, float slope2, int q0, f32x16 (&o)[DV / 32], const bf16_t* K2 = nullptr, int ldk2 = 0) {
    constexpr int KSTR = DQK * 2 + 16, VSTR = DV * 2 + 64, KS = DQK / 16, ND = DV / 32;
    constexpr int K_OFF = 0, V_OFF = 64 * KSTR, P_OFF = V_OFF + 64 * VSTR, ABUF = P_OFF + 256;
    constexpr int KCH = DQK / 8, VCH = DV / 8;
    constexpr int NKI = (64 * KCH + NT - 1) / NT, NVI = (64 * VCH + NT - 1) / NT;
    static_assert(3 * ABUF <= G_LDS, "attention ring");
    const int tid = otid();
    const int lane = tid & 63, wave = tid >> 6, l31 = lane & 31, hi = lane >> 5;
    const int qrow = q0 + 32 * wave + l31;
    unsigned kgo[NKI], klo[NKI], vgo[NVI], vlo[NVI];
    bool k2s[NKI];
#pragma unroll
    for (int i = 0; i < NKI; ++i) { int c = tid + NT * i; if (c >= 64 * KCH) c = 64 * KCH - 1; const int row = c / KCH, ch = c % KCH; k2s[i] = (DQK == 96) && (ch >= 8);
        kgo[i] = k2s[i] ? (unsigned)(row * ldk2 + (ch - 8) * 8) * 2u : (unsigned)(row * ldk + ch * 8) * 2u; klo[i] = K_OFF + row * KSTR + ch * 16; }
#pragma unroll
    for (int i = 0; i < NVI; ++i) { int c = tid + NT * i; if (c >= 64 * VCH) c = 64 * VCH - 1; const int row = c / VCH, ch = c % VCH; vgo[i] = (unsigned)(row * ldv + ch * 8) * 2u; vlo[i] = V_OFF + row * VSTR + ch * 16; }
    bf16x8 qf[KS];
#pragma unroll
    for (int s = 0; s < KS; ++s) qf[s] = *(const bf16x8*)(Q + (size_t)qrow * ldq + 16 * s + 8 * hi);
    const float posq = ALIBI ? (float)posrow[qrow] : 0.f;
#pragma unroll
    for (int d = 0; d < ND; ++d)
#pragma unroll
        for (int r = 0; r < 16; ++r) o[d][r] = 0.f;
    float m_run = -1e30f, l_run = 0.f;
    const int ntile = (q0 + 256) / 64;
    const int qmin = q0 + 32 * wave, qmax = qmin + 31;
    const int vrd = V_OFF + (4 * hi + ((lane & 15) >> 2)) * VSTR + 2 * (16 * ((lane >> 4) & 1) + 4 * (lane & 3));
    u32x4 rk[NKI], rv[NVI]; float rp = 0.f;
#define A_LOAD(T) do { \
        const char* kbase_ = (const char*)(K + (size_t)(T) * 64 * ldk); const char* kbase2_ = (const char*)(K2 + (size_t)(T) * 64 * ldk2); \
        const char* vbase_ = (const char*)(V + (size_t)(T) * 64 * ldv); \
        _Pragma("unroll") for (int i = 0; i < NKI; ++i) rk[i] = *(const u32x4*)((k2s[i] ? kbase2_ : kbase_) + kgo[i]); \
        _Pragma("unroll") for (int i = 0; i < NVI; ++i) rv[i] = *(const u32x4*)(vbase_ + vgo[i]); \
        if (ALIBI && tid < 64) rp = (float)posrow[(T) * 64 + tid]; } while (0)
#define A_STORE(LP) do { \
        _Pragma("unroll") for (int i = 0; i < NKI; ++i) if (tid + NT * i < 64 * KCH) *(LAS u32x4*)((LP) + klo[i]) = rk[i]; \
        _Pragma("unroll") for (int i = 0; i < NVI; ++i) if (tid + NT * i < 64 * VCH) *(LAS u32x4*)((LP) + vlo[i]) = rv[i]; \
        if (ALIBI && tid < 64) *(LAS float*)((LP) + P_OFF + 4 * tid) = rp; } while (0)
#define A_KFRAG(DST, LP, S_) do { DST[0] = *(LAS bf16x8*)((LP) + K_OFF + l31 * KSTR + 32 * (S_) + 16 * hi); DST[1] = *(LAS bf16x8*)((LP) + K_OFF + (32 + l31) * KSTR + 32 * (S_) + 16 * hi); } while (0)
#define A_SCORES(S0, S1, LP, KB) do { \
        _Pragma("unroll") for (int r = 0; r < 16; ++r) { S0[r] = 0.f; S1[r] = 0.f; } \
        bf16x8 kfa_[2], kfb_[2]; \
        A_KFRAG(kfa_, LP, 0); \
        _Pragma("unroll") for (int s = 0; s < KS; s += 2) {        \
            if (s + 1 < KS) A_KFRAG(kfb_, LP, s + 1); \
            S0 = MFMA32(kfa_[0], qf[s], S0); S1 = MFMA32(kfa_[1], qf[s], S1); \
            __builtin_amdgcn_sched_barrier(0); \
            if (s + 1 < KS) { \
                if (s + 2 < KS) A_KFRAG(kfa_, LP, s + 2); \
                S0 = MFMA32(kfb_[0], qf[s + 1], S0); S1 = MFMA32(kfb_[1], qf[s + 1], S1); \
                __builtin_amdgcn_sched_barrier(0); } } \
        if (ALIBI) { \
            _Pragma("unroll") for (int g4 = 0; g4 < 4; ++g4) { \
                const f32x4 pk0_ = *(LAS f32x4*)((LP) + P_OFF + 4 * (8 * g4 + 4 * hi)), pk1_ = *(LAS f32x4*)((LP) + P_OFF + 4 * (32 + 8 * g4 + 4 * hi)); \
                _Pragma("unroll") for (int e = 0; e < 4; ++e) { S0[4 * g4 + e] -= slope2 * fabsf(posq - pk0_[e]); S1[4 * g4 + e] -= slope2 * fabsf(posq - pk1_[e]); } } } \
        if ((KB) + 63 > qmin) { \
            _Pragma("unroll") for (int r = 0; r < 16; ++r) { const int key_ = (KB) + crow(r, hi); if (key_ > qrow) S0[r] = -INFINITY; if (key_ + 32 > qrow) S1[r] = -INFINITY; } } } while (0)
#define A_VFRAG(DST, LP, S_) do { _Pragma("unroll") for (int d = 0; d < ND; ++d) { \
            LAS char* vp_ = (LP) + vrd + 16 * (S_) * VSTR + 64 * d; const s16x4 lo_ = tr_read(vp_), h4_ = tr_read(vp_ + 8 * VSTR); \
            DST[d] = (bf16x8){lo_[0], lo_[1], lo_[2], lo_[3], h4_[0], h4_[1], h4_[2], h4_[3]}; } } while (0)
#define A_SOFTMAX_PV(S0, S1, LP) do { \
        bf16x8 vfa_[ND], vfb_[ND]; \
        A_VFRAG(vfa_, LP, 0);                                       \
        float mx_ = S0[0]; \
        _Pragma("unroll") for (int r = 1; r < 16; ++r) mx_ = fmaxf(mx_, S0[r]); \
        _Pragma("unroll") for (int r = 0; r < 16; ++r) mx_ = fmaxf(mx_, S1[r]); \
        { const auto rr_ = __builtin_amdgcn_permlane32_swap(__float_as_uint(mx_), __float_as_uint(mx_), false, false); mx_ = fmaxf(__uint_as_float(rr_[0]), __uint_as_float(rr_[1])); }     \
        if (__any(mx_ > m_run + 8.f)) { \
            const float m_new_ = fmaxf(m_run, mx_); const float alpha_ = __builtin_amdgcn_exp2f(m_run - m_new_); m_run = m_new_; l_run *= alpha_; \
            _Pragma("unroll") for (int d = 0; d < ND; ++d) _Pragma("unroll") for (int r = 0; r < 16; ++r) o[d][r] *= alpha_; } \
        float ls_ = 0.f; \
        _Pragma("unroll") for (int r = 0; r < 16; ++r) { S0[r] = __builtin_amdgcn_exp2f(S0[r] - m_run); S1[r] = __builtin_amdgcn_exp2f(S1[r] - m_run); ls_ += S0[r] + S1[r]; } \
        l_run += ls_; \
        u32x4 pw_[4]; \
        _Pragma("unroll") for (int j = 0; j < 4; ++j) { \
            pw_[0][j] = pk2(S0[2 * j], S0[2 * j + 1]); pw_[1][j] = pk2(S0[8 + 2 * j], S0[8 + 2 * j + 1]); \
            pw_[2][j] = pk2(S1[2 * j], S1[2 * j + 1]); pw_[3][j] = pk2(S1[8 + 2 * j], S1[8 + 2 * j + 1]); } \
        __builtin_amdgcn_sched_barrier(0); \
        A_VFRAG(vfb_, LP, 1); \
        _Pragma("unroll") for (int d = 0; d < ND; ++d) o[d] = MFMA32(vfa_[d], __builtin_bit_cast(bf16x8, pw_[0]), o[d]); \
        __builtin_amdgcn_sched_barrier(0); \
        A_VFRAG(vfa_, LP, 2); \
        _Pragma("unroll") for (int d = 0; d < ND; ++d) o[d] = MFMA32(vfb_[d], __builtin_bit_cast(bf16x8, pw_[1]), o[d]); \
        __builtin_amdgcn_sched_barrier(0); \
        A_VFRAG(vfb_, LP, 3); \
        _Pragma("unroll") for (int d = 0; d < ND; ++d) o[d] = MFMA32(vfa_[d], __builtin_bit_cast(bf16x8, pw_[2]), o[d]); \
        __builtin_amdgcn_sched_barrier(0); \
        _Pragma("unroll") for (int d = 0; d < ND; ++d) o[d] = MFMA32(vfb_[d], __builtin_bit_cast(bf16x8, pw_[3]), o[d]); \
        __builtin_amdgcn_sched_barrier(0); } while (0)
    A_LOAD(0);
    __syncthreads();
    A_STORE(L);
    A_LOAD(1);
    A_STORE(L + ABUF);
    __syncthreads();
    f32x16 sa0, sa1, sb0, sb1;
    A_SCORES(sa0, sa1, L, 0);
    int bc = 0;
    for (int tl = 0; tl < ntile; ++tl) {
        const int kb = tl * 64;
        const int bn = (bc == 2) ? 0 : bc + 1, bnn = (bn == 2) ? 0 : bn + 1;
        LAS char* Lc = L + bc * ABUF; LAS char* Ln = L + bn * ABUF; LAS char* Lnn = L + bnn * ABUF;
        const bool more2 = tl + 2 < ntile;
        if (more2) A_LOAD(tl + 2);
        const bool act_c = kb <= qmax, act_n = (tl + 1 < ntile) && (kb + 64 <= qmax);
        if (act_n) {
            A_SCORES(sb0, sb1, Ln, kb + 64);
            A_SOFTMAX_PV(sa0, sa1, Lc);
            sa0 = sb0; sa1 = sb1;
        } else if (act_c) {
            A_SOFTMAX_PV(sa0, sa1, Lc);
        }
        if (more2) A_STORE(Lnn);
        __syncthreads();
        bc = bn;
    }
#undef A_LOAD
#undef A_STORE
#undef A_SCORES
#undef A_SOFTMAX_PV
#undef A_KFRAG
#undef A_VFRAG
    const float lt = l_run + shx(l_run, 32, lane);
    const float inv = 1.f / lt;
#pragma unroll
    for (int d = 0; d < ND; ++d)
#pragma unroll
        for (int r = 0; r < 16; ++r) o[d][r] *= inv;
}

__device__ __forceinline__ void attn_decode(int it, int& kind, int& qb, int& idx) {
    const int seg_kind[16] = {1, 1, 1, 1, 1, 0, 1, 0, 0, 0, 1, 0, 0, 1, 0, 0};
    const int seg_qb[16]   = {7, 6, 5, 4, 3, 7, 2, 6, 5, 4, 1, 3, 2, 0, 1, 0};
    int base = 0; kind = 0; qb = 0; idx = 0;
#pragma unroll
    for (int s = 0; s < 16; ++s) {
        const int n = seg_kind[s] ? 32 : 64;
        if (it >= base && it < base + n) { kind = seg_kind[s]; qb = seg_qb[s]; idx = it - base; }
        base += n;
    }
}

__device__ __forceinline__ void phase_attn(const Params& p, LAS char* L) {
    const int v = vcu(), G = grid_g();
    const int tid = otid(), lane = tid & 63, wave = tid >> 6, l31 = lane & 31, hi = lane >> 5;
    const int* positions = (const int*)p.in[2];
    const bf16_t* proj = (const bf16_t*)(p.ws + WS_PROJ);
    const bf16_t* qm = (const bf16_t*)(p.ws + WS_QM); const bf16_t* kf = (const bf16_t*)(p.ws + WS_KF); const bf16_t* vm = (const bf16_t*)(p.ws + WS_VM);
    bf16_t* att = (bf16_t*)(p.ws + WS_ATT);
    float* od0 = (float*)(p.ws + WS_OD0);
    const float* subg = p.in[16];
    unsigned* qctr = (unsigned*)(p.ws + WS_CTL + 2048);
    LAS unsigned* qslot = (LAS unsigned*)(L + OFF_MISC + 16);
    float lam;
    {
        const float a = p.in[12][lane] * p.in[13][lane], b = p.in[14][lane] * p.in[15][lane];
        lam = __expf(wave_sum(a, lane)) - __expf(wave_sum(b, lane)) + LAMBDA_INIT;
    }
    for (;;) {
        if (tid == 0) *qslot = __hip_atomic_fetch_add(qctr, 1u, __ATOMIC_RELAXED, __HIP_MEMORY_SCOPE_AGENT);
        __syncthreads();
        const int it = (int)*qslot;
        __syncthreads();
        if (it >= 768) break;
        int kind, qb, idx;
        attn_decode(it, kind, qb, idx);
        const int q0 = qb * 256;
        if (kind == 0) {
            const int b = idx >> 3, h = idx & 7; const size_t tb = (size_t)b * SEQ;
            f32x16 o[2];
            attn_map<96, 64, false>(L, qm + tb * 768 + h * 96, 768, kf + tb * 768 + h * 96, 768, vm + tb * 512 + h * 64, 512, positions + tb, 0.f, q0, o, proj + tb * NIN + C_KR, NIN);
            const size_t t = tb + q0 + 32 * wave + l31;
#pragma unroll
            for (int d = 0; d < 2; ++d)
#pragma unroll
                for (int gq = 0; gq < 4; ++gq) {
                    u32x2 w; w.x = pk2(o[d][4 * gq], o[d][4 * gq + 1]); w.y = pk2(o[d][4 * gq + 2], o[d][4 * gq + 3]);
                    *(u32x2*)(att + t * 1024 + h * 64 + 32 * d + 8 * gq + 4 * hi) = w;
                }
        } else {
            const int b = idx >> 2, h = idx & 3; const size_t tb = (size_t)b * SEQ;
            const float slope2 = exp2f(-2.f * (h + 1)) * LOG2E;
            const size_t t = tb + q0 + 32 * wave + l31;
            f32x16 o[4];
            attn_map<64, 128, true>(L, proj + tb * NIN + C_DQ + h * 128, NIN, proj + tb * NIN + C_DK + h * 128, NIN, proj + tb * NIN + C_DV + h * 128, NIN, positions + tb, slope2, q0, o);
#pragma unroll
            for (int d = 0; d < 4; ++d)
#pragma unroll
                for (int gq = 0; gq < 4; ++gq) {
                    f32x4 w = {o[d][4 * gq], o[d][4 * gq + 1], o[d][4 * gq + 2], o[d][4 * gq + 3]};
                    *(f32x4*)(od0 + t * 512 + h * 128 + 32 * d + 8 * gq + 4 * hi) = w;
                }
            attn_map<64, 128, true>(L, proj + tb * NIN + C_DQ + h * 128 + 64, NIN, proj + tb * NIN + C_DK + h * 128 + 64, NIN, proj + tb * NIN + C_DV + h * 128, NIN, positions + tb, slope2, q0, o);
            float ss = 0.f;
#pragma unroll
            for (int d = 0; d < 4; ++d)
#pragma unroll
                for (int gq = 0; gq < 4; ++gq) {
                    const f32x4 w = *(const f32x4*)(od0 + t * 512 + h * 128 + 32 * d + 8 * gq + 4 * hi);
#pragma unroll
                    for (int e = 0; e < 4; ++e) { const float c = w[e] - lam * o[d][4 * gq + e]; o[d][4 * gq + e] = c; ss += c * c; }
                }
            ss += shx(ss, 32, lane);
            const float rstd = rsqrtf(ss * (1.f / 128.f) + 1e-5f) * (1.f - LAMBDA_INIT);
#pragma unroll
            for (int d = 0; d < 4; ++d)
#pragma unroll
                for (int gq = 0; gq < 4; ++gq) {
                    const int dv = 32 * d + 8 * gq + 4 * hi;
                    const f32x4 gv = *(const f32x4*)(subg + dv);
                    u32x2 w; w.x = pk2(o[d][4 * gq] * rstd * gv[0], o[d][4 * gq + 1] * rstd * gv[1]); w.y = pk2(o[d][4 * gq + 2] * rstd * gv[2], o[d][4 * gq + 3] * rstd * gv[3]);
                    *(u32x2*)(att + t * 1024 + 512 + h * 128 + dv) = w;
                }
        }
    }
}

__device__ __forceinline__ void phase_oproj(const Params& p, LAS char* L) {
    const int v = vcu(), G = grid_g();
    const bf16_t* att = (const bf16_t*)(p.ws + WS_ATT);
    const bf16_t* w_o = (const bf16_t*)(p.ws + WS_WB) + WB_O;
    bf16_t* y1 = (bf16_t*)(p.ws + WS_Y1);
    for (int u = v; u < 64 * 4; u += G) {
        const int mt = u >> 2, nt = u & 3, m0 = mt * 256, n0 = nt * 256;
        auto arow = [&](int r) { return (unsigned)(m0 + r) * Dm; };
        auto bcol = [&](int c) { return w_o + n0 + c; };
        auto epi = [&](f32x16 (&acc)[4][2], int seg, LAS char* Ls) {
            store_tile_bf16<4, 256>(Ls, acc, [&](int row, int c) -> bf16_t* { return y1 + (size_t)(m0 + row) * Dm + n0 + 8 * c; });
        };
        gemm_tile<4, 0, true>(L, Dm / 64, Dm, att, arow, bcol, epi);
    }
}

__device__ __forceinline__ void post_attn_tokens(const Params& p, int t0, int nper) {
    const int tid = otid(), lane = tid & 63, wave = tid >> 6;
    const float* x = p.in[0]; const float* pg = p.in[6]; const float* fg = p.in[18];
    const float* mod = (const float*)(p.ws + WS_MOD);
    const bf16_t* y1 = (const bf16_t*)(p.ws + WS_Y1);
    bf16_t* h2 = (bf16_t*)(p.ws + WS_H2);
    for (int i_ = 0; i_ < nper; ++i_) {
        const int t = t0 + wave + NW * i_;
        const int b = t / SEQ;
        const float* mb = mod + b * 6144;
        f32x4 yv[4], xv[4]; float ss = 0.f;
#pragma unroll
        for (int j = 0; j < 4; ++j) {
            const u32x2 raw = *(const u32x2*)(y1 + (size_t)t * Dm + 4 * (lane + 64 * j));
            yv[j] = (f32x4){bflo(raw.x), bfhi(raw.x), bflo(raw.y), bfhi(raw.y)};
            xv[j] = *(const f32x4*)(x + (size_t)t * Dm + 4 * (lane + 64 * j));
            ss += yv[j][0] * yv[j][0] + yv[j][1] * yv[j][1] + yv[j][2] * yv[j][2] + yv[j][3] * yv[j][3];
        }
        ss = wave_sum(ss, lane);
        const float rstd = rsqrtf(ss * (1.f / Dm) + 1e-6f);
        float ss2 = 0.f;
#pragma unroll
        for (int j = 0; j < 4; ++j) {
            const int col = 4 * (lane + 64 * j);
            const f32x4 gv = *(const f32x4*)(pg + col), ga = *(const f32x4*)(mb + 2048 + col);
#pragma unroll
            for (int e = 0; e < 4; ++e) { xv[j][e] = xv[j][e] + ga[e] * (yv[j][e] * rstd * gv[e]); ss2 += xv[j][e] * xv[j][e]; }
            *(f32x4*)(p.out + (size_t)t * Dm + col) = xv[j];
        }
        ss2 = wave_sum(ss2, lane);
        const float rstd2 = rsqrtf(ss2 * (1.f / Dm) + 1e-6f);
#pragma unroll
        for (int j = 0; j < 4; ++j) {
            const int col = 4 * (lane + 64 * j);
            const f32x4 gv = *(const f32x4*)(fg + col), sv = *(const f32x4*)(mb + 4096 + col), hv = *(const f32x4*)(mb + 3072 + col);
            float o[4];
#pragma unroll
            for (int e = 0; e < 4; ++e) o[e] = (xv[j][e] * rstd2 * gv[e]) * (1.f + sv[e]) + hv[e];
            u32x2 w; w.x = pk2(o[0], o[1]); w.y = pk2(o[2], o[3]);
            *(u32x2*)(h2 + (size_t)t * Dm + col) = w;
        }
    }
}

__device__ __forceinline__ unsigned fkey(float f) { const unsigned u = __float_as_uint(f); return (u & 0x80000000u) ? ~u : (u | 0x80000000u); }
template <int CTRL, int RM> __device__ __forceinline__ unsigned dppu(unsigned old, unsigned src) { return (unsigned)__builtin_amdgcn_update_dpp((int)old, (int)src, CTRL, RM, 0xf, false); }
template <int CTRL, int RM> __device__ __forceinline__ float dppf(float old, float src) { return __int_as_float(__builtin_amdgcn_update_dpp(__float_as_int(old), __float_as_int(src), CTRL, RM, 0xf, false)); }
__device__ __forceinline__ unsigned wave_umax(unsigned v) {
    v = max(v, dppu<0x111, 0xf>(v, v)); v = max(v, dppu<0x112, 0xf>(v, v)); v = max(v, dppu<0x114, 0xf>(v, v)); v = max(v, dppu<0x118, 0xf>(v, v));
    v = max(v, dppu<0x142, 0xa>(v, v)); v = max(v, dppu<0x143, 0xc>(v, v));
    return (unsigned)__builtin_amdgcn_readlane((int)v, 63);
}
__device__ __forceinline__ float wave_fsum_dpp(float v) {
    v += dppf<0x111, 0xf>(0.f, v); v += dppf<0x112, 0xf>(0.f, v); v += dppf<0x114, 0xf>(0.f, v); v += dppf<0x118, 0xf>(0.f, v);
    v += dppf<0x142, 0xa>(0.f, v); v += dppf<0x143, 0xc>(0.f, v);
    return __int_as_float(__builtin_amdgcn_readlane(__float_as_int(v), 63));
}
__device__ __forceinline__ void phase_router_route(const Params& p, LAS char* L) {
    const int v = vcu(), G = grid_g();
    const bf16_t* h2 = (const bf16_t*)(p.ws + WS_H2);
    const bf16_t* rw = (const bf16_t*)(p.ws + WS_WB) + WB_R;
    const float* rb = p.in[21];
    int* cnt = (int*)(p.ws + WS_CTL);
    int* la = (int*)(p.ws + WS_LA); float* lw = (float*)(p.ws + WS_LW);
    constexpr int LSTR = 1040;
    LAS int* pe = (LAS int*)(L + 69632);
    LAS float* pw = (LAS float*)(L + 69632 + 2048);
    LAS int* hist = (LAS int*)(L + 69632 + 4096);
    LAS int* basep = (LAS int*)(L + 69632 + 5120);
    for (int u = v; u < T / 64; u += G) {
        const int m0 = u * 64;
        post_attn_tokens(p, m0, 8);
        asm volatile("s_waitcnt vmcnt(0)" ::: "memory");
        __syncthreads();
        auto arow = [&](int r) { return (unsigned)(m0 + r) * Dm; };
        auto bcol = [&](int c) { return rw + c; };
        auto epi = [&](f32x16 (&acc)[1][2], int seg, LAS char* Ls) {
            const int tid_ = otid(), lane = tid_ & 63, wave = tid_ >> 6, wm = wave & 1, wn = wave >> 1, l31 = lane & 31, hi = lane >> 5;
            const int row = 32 * wm + l31;
#pragma unroll
            for (int ni = 0; ni < 2; ++ni)
#pragma unroll
                for (int gq = 0; gq < 4; ++gq) {
                    f32x4 w = {acc[0][ni][4 * gq], acc[0][ni][4 * gq + 1], acc[0][ni][4 * gq + 2], acc[0][ni][4 * gq + 3]};
                    *(LAS f32x4*)(L + row * LSTR + 4 * (nb_of<0>(wn, ni) + 8 * gq + 4 * hi)) = w;
                }
        };
        gemm_tile<1, 0, true>(L, Dm / 64, NE, h2, arow, bcol, epi);
        const int tid = otid(), lane = tid & 63, wave = tid >> 6;
        if (tid < 256) hist[tid] = 0;
        __syncthreads();
        const f32x4 bias = *(const f32x4*)(rb + 4 * lane);
        const int grp = lane >> 3;
#pragma unroll 1
        for (int tt = 0; tt < 8; ++tt) {
            const int tok = 8 * wave + tt;
            const f32x4 lgv = *(LAS f32x4*)(L + tok * LSTR + 16 * lane);
            const float s0 = 1.f / (1.f + __expf(-lgv[0])), s1 = 1.f / (1.f + __expf(-lgv[1])), s2 = 1.f / (1.f + __expf(-lgv[2])), s3 = 1.f / (1.f + __expf(-lgv[3]));
            float v0 = s0 + bias[0], v1 = s1 + bias[1], v2 = s2 + bias[2], v3 = s3 + bias[3];
            float t1 = fmaxf(v0, v1), t2 = fminf(v0, v1);
            { const float a = fmaxf(v2, v3), bq = fminf(v2, v3); const float n1 = fmaxf(t1, a), n2 = fmaxf(fminf(t1, a), fmaxf(t2, bq)); t1 = n1; t2 = n2; }
            { const float o1 = dppf<0xB1, 0xf>(t1, t1), o2 = dppf<0xB1, 0xf>(t2, t2); const float n1 = fmaxf(t1, o1), n2 = fmaxf(fminf(t1, o1), fmaxf(t2, o2)); t1 = n1; t2 = n2; }
            { const float o1 = dppf<0x4E, 0xf>(t1, t1), o2 = dppf<0x4E, 0xf>(t2, t2); const float n1 = fmaxf(t1, o1), n2 = fmaxf(fminf(t1, o1), fmaxf(t2, o2)); t1 = n1; t2 = n2; }
            { const float o1 = shx(t1, 4, lane), o2 = shx(t2, 4, lane); const float n1 = fmaxf(t1, o1), n2 = fmaxf(fminf(t1, o1), fmaxf(t2, o2)); t1 = n1; t2 = n2; }
            const float gs = t1 + t2;
            int rank = 0;
#pragma unroll
            for (int gg = 0; gg < 8; ++gg) { const float og = __int_as_float(__builtin_amdgcn_readlane(__float_as_int(gs), gg * 8)); rank += (og > gs || (og == gs && gg < grp)) ? 1 : 0; }
            if (rank >= 4) { v0 = -INFINITY; v1 = -INFINITY; v2 = -INFINITY; v3 = -INFINITY; }
            unsigned k0 = fkey(v0), k1 = fkey(v1), k2 = fkey(v2), k3 = fkey(v3);
            bool c0 = false, c1 = false, c2 = false, c3 = false;
#pragma unroll
            for (int it = 0; it < TOPK; ++it) {
                const unsigned lb = max(max(k0, k1), max(k2, k3));
                const unsigned m = wave_umax(lb);
                const unsigned long long bal = __ballot(lb == m);
                const int owner = __builtin_ctzll(bal);
                if (lane == owner) {
                    if (k0 == m) { k0 = 0u; c0 = true; } else if (k1 == m) { k1 = 0u; c1 = true; } else if (k2 == m) { k2 = 0u; c2 = true; } else { k3 = 0u; c3 = true; }
                }
            }
            const float wsum = wave_fsum_dpp((c0 ? s0 : 0.f) + (c1 ? s1 : 0.f) + (c2 ? s2 : 0.f) + (c3 ? s3 : 0.f));
            const float wnorm = 2.5f / wsum;
            const unsigned long long b0 = __ballot(c0), b1 = __ballot(c1), b2 = __ballot(c2), b3 = __ballot(c3);
            const unsigned long long lm = (1ull << lane) - 1ull;
            const int q0 = __builtin_popcountll(b0 & lm), a1 = __builtin_popcountll(b0);
            const int q1 = a1 + __builtin_popcountll(b1 & lm), a2 = a1 + __builtin_popcountll(b1);
            const int q2 = a2 + __builtin_popcountll(b2 & lm), a3 = a2 + __builtin_popcountll(b2);
            const int q3 = a3 + __builtin_popcountll(b3 & lm);
            if (c0) { pe[8 * tok + q0] = 4 * lane + 0; pw[8 * tok + q0] = s0 * wnorm; }
            if (c1) { pe[8 * tok + q1] = 4 * lane + 1; pw[8 * tok + q1] = s1 * wnorm; }
            if (c2) { pe[8 * tok + q2] = 4 * lane + 2; pw[8 * tok + q2] = s2 * wnorm; }
            if (c3) { pe[8 * tok + q3] = 4 * lane + 3; pw[8 * tok + q3] = s3 * wnorm; }
        }
        __syncthreads();
        const int my_e = pe[tid];
        const int my_rank = __hip_atomic_fetch_add(hist + my_e, 1, __ATOMIC_RELAXED, __HIP_MEMORY_SCOPE_WORKGROUP);
        __syncthreads();
        if (tid < 256) { const int n = hist[tid]; basep[tid] = n > 0 ? atomicAdd(cnt + tid, n) : 0; }
        __syncthreads();
        {
            const int pos = basep[my_e] + my_rank;
            if (pos < LISTCAP) { la[(size_t)my_e * LISTCAP + pos] = (m0 + (tid >> 3)) * TOPK + (tid & 7); lw[(size_t)my_e * LISTCAP + pos] = pw[tid]; }
        }
        __syncthreads();
    }
}

__device__ __forceinline__ int moe_cnt(const int* cnt, int e) { int c = (e < 256) ? cnt[e] : T; return c > LISTCAP ? LISTCAP : c; }
__device__ __forceinline__ void moe_prefix(const Params& p, LAS char* L) {
    const int tid = otid();
    const int* cnt = (const int*)(p.ws + WS_CTL);
    LAS int* pre = (LAS int*)(L + OFF_PRE);
    LAS int* tl = (LAS int*)(L + OFF_TL);
    __syncthreads();
    for (int i = tid; i < 257; i += NT) { const int c = moe_cnt(cnt, i); tl[i] = (c + 255) >> 8; }
    __syncthreads();
    if (tid == 0) { int s = 0; for (int i = 0; i < 257; ++i) { pre[i] = s; s += tl[i]; } pre[257] = s; }
    __syncthreads();
}
__device__ __forceinline__ int moe_find(LAS int* pre, int g) {
    int lo = 0, hi = 256;
    while (lo < hi) { const int mid = (lo + hi + 1) >> 1; if (pre[mid] <= g) lo = mid; else hi = mid - 1; }
    return lo;
}

template <int MI>
__device__ __forceinline__ void moe1_unit(const Params& p, LAS char* L, int e, int r0, int rows, int j0) {
    const bf16_t* h2 = (const bf16_t*)(p.ws + WS_H2);
    const int* la = (const int*)(p.ws + WS_LA);
    bf16_t* hb = (bf16_t*)(p.ws + WS_HB);
    const float* wg = (e < 256) ? p.in[22] + (size_t)e * Dm * 256 : p.in[25];
    const float* wu = (e < 256) ? p.in[23] + (size_t)e * Dm * 256 : p.in[26];
    LAS int* rowid = (LAS int*)(L + OFF_ROW);
    {
        const int tid = otid();
        if (tid < 64 * MI) { const int rr = tid < rows ? tid : 0; rowid[tid] = (e < 256) ? la[(size_t)e * LISTCAP + r0 + rr] : (AR + r0 + rr); }
        __syncthreads();
    }
    auto arow = [&](int r) { const int a = rowid[r]; const int tok = (e < 256) ? (a >> 3) : (a - AR); return (unsigned)tok * Dm; };
    auto bcol = [&](int c4) { return (c4 < 128) ? (wg + j0 + c4) : (wu + j0 + c4 - 128); };
    auto epi = [&](f32x16 (&acc)[MI][2], int seg, LAS char* Ls) {
#pragma unroll
        for (int mi = 0; mi < MI; ++mi)
#pragma unroll
            for (int r = 0; r < 16; ++r) acc[mi][0][r] = silu_f(acc[mi][0][r]) * acc[mi][1][r];
        store_tile_bf16<MI, 128>(Ls, acc, [&](int row, int c) -> bf16_t* { return row < rows ? hb + (size_t)rowid[row] * 256 + j0 + 8 * c : nullptr; });
    };
    gemm_tile<MI, 1>(L, Dm / 64, 256, h2, arow, bcol, epi);
}
__device__ __forceinline__ void phase_moe1(const Params& p, LAS char* L) {
    const int v = vcu(), G = grid_g();
    const int* cnt = (const int*)(p.ws + WS_CTL);
    moe_prefix(p, L);
    LAS int* pre = (LAS int*)(L + OFF_PRE);
    const int total = __builtin_amdgcn_readfirstlane(pre[257]) * 2;
    for (int u = v; u < total; u += G) {
        const int g = u >> 1, j0 = (u & 1) * 128;
        const int e = __builtin_amdgcn_readfirstlane(moe_find(pre, g)), mt = g - __builtin_amdgcn_readfirstlane(pre[e]);
        const int rows = __builtin_amdgcn_readfirstlane(moe_cnt(cnt, e)) - mt * 256;
        if (rows > 128) moe1_unit<4>(p, L, e, mt * 256, rows < 256 ? rows : 256, j0);
        else moe1_unit<2>(p, L, e, mt * 256, rows, j0);
    }
}

template <int MI>
__device__ __forceinline__ void moe2_unit(const Params& p, LAS char* L, int e, int r0, int rows, int n0) {
    const int* la = (const int*)(p.ws + WS_LA); const float* lw = (const float*)(p.ws + WS_LW);
    const bf16_t* hb = (const bf16_t*)(p.ws + WS_HB);
    unsigned char* yb = (unsigned char*)(p.ws + WS_YB);
    const float* wd = (e < 256) ? p.in[24] + (size_t)e * 256 * Dm : p.in[27];
    LAS int* rowid = (LAS int*)(L + OFF_ROW);
    LAS float* roww = (LAS float*)(L + OFF_RW);
    {
        const int tid = otid();
        if (tid < 64 * MI) {
            const int rr = tid < rows ? tid : 0;
            rowid[tid] = (e < 256) ? la[(size_t)e * LISTCAP + r0 + rr] : (AR + r0 + rr);
            roww[tid] = (e < 256) ? lw[(size_t)e * LISTCAP + r0 + rr] : 1.f;
        }
        __syncthreads();
    }
    auto arow = [&](int r) { return (unsigned)rowid[r] * 256; };
    auto bcol = [&](int c4) { return wd + n0 + c4; };
    auto epi = [&](f32x16 (&acc)[MI][2], int seg, LAS char* Ls) {
        const int tid_ = otid(), lane = tid_ & 63, wave = tid_ >> 6, wm = wave & 1, l31 = lane & 31;
#pragma unroll
        for (int mi = 0; mi < MI; ++mi) {
            const float w = roww[32 * MI * wm + 32 * mi + l31] * YSCALE;
#pragma unroll
            for (int ni = 0; ni < 2; ++ni)
#pragma unroll
                for (int q = 0; q < 16; ++q) acc[mi][ni][q] = __builtin_amdgcn_fmed3f(acc[mi][ni][q] * w, -448.f, 448.f);
        }
        store_tile_fp8<MI>(Ls, acc, [&](int row, int c) -> unsigned char* { return row < rows ? yb + (size_t)rowid[row] * Dm + n0 + seg * 256 + 16 * c : nullptr; });
    };
    gemm_tile<MI, 0, false, 2>(L, 256 / 64, Dm, hb, arow, bcol, epi);
}
__device__ __forceinline__ void phase_moe2(const Params& p, LAS char* L) {
    const int v = vcu(), G = grid_g();
    const int* cnt = (const int*)(p.ws + WS_CTL);
    moe_prefix(p, L);
    LAS int* pre = (LAS int*)(L + OFF_PRE);
    const int total = __builtin_amdgcn_readfirstlane(pre[257]) * 2;
    for (int u = v; u < total; u += G) {
        const int g = u >> 1, n0 = (u & 1) * 512;
        const int e = __builtin_amdgcn_readfirstlane(moe_find(pre, g)), mt = g - __builtin_amdgcn_readfirstlane(pre[e]);
        const int rows = __builtin_amdgcn_readfirstlane(moe_cnt(cnt, e)) - mt * 256;
        if (rows > 128) moe2_unit<4>(p, L, e, mt * 256, rows < 256 ? rows : 256, n0);
        else moe2_unit<2>(p, L, e, mt * 256, rows, n0);
    }
}

__device__ __forceinline__ void phase_final(const Params& p) {
    const int v = vcu(), G = grid_g();
    const int tid = otid(), lane = tid & 63, wave = tid >> 6;
    const float* pg = p.in[19];
    const float* mod = (const float*)(p.ws + WS_MOD);
    const unsigned char* yb = (const unsigned char*)(p.ws + WS_YB);
    for (int t = v * NW + wave; t < T; t += G * NW) {
        const int b = t / SEQ;
        const float* gf = mod + b * 6144 + 5120;
        float y[16];
#pragma unroll
        for (int e = 0; e < 16; ++e) y[e] = 0.f;
#pragma unroll
        for (int k = 0; k < 9; ++k) {
            const size_t row = (k < 8) ? ((size_t)t * TOPK + k) : ((size_t)AR + t);
            const u32x4 raw = *(const u32x4*)(yb + row * Dm + 16 * lane);
#pragma unroll
            for (int e = 0; e < 4; ++e) {
                const f32x2 a = __builtin_amdgcn_cvt_pk_f32_fp8((int)raw[e], false), c = __builtin_amdgcn_cvt_pk_f32_fp8((int)raw[e], true);
                y[4 * e] += a.x; y[4 * e + 1] += a.y; y[4 * e + 2] += c.x; y[4 * e + 3] += c.y;
            }
        }
        float ss = 0.f;
#pragma unroll
        for (int e = 0; e < 16; ++e) { y[e] *= (1.f / YSCALE); ss += y[e] * y[e]; }
        ss = wave_sum(ss, lane);
        const float rstd = rsqrtf(ss * (1.f / Dm) + 1e-6f);
        const int col = 16 * lane;
#pragma unroll
        for (int hq = 0; hq < 4; ++hq) {
            f32x4 xo = *(const f32x4*)(p.out + (size_t)t * Dm + col + 4 * hq);
            const f32x4 gv = *(const f32x4*)(pg + col + 4 * hq), gg = *(const f32x4*)(gf + col + 4 * hq);
#pragma unroll
            for (int e = 0; e < 4; ++e) xo[e] += gg[e] * (y[4 * hq + e] * rstd * gv[e]);
            *(f32x4*)(p.out + (size_t)t * Dm + col + 4 * hq) = xo;
        }
    }
}

#define XB_TMO      128
#define XB_XCNT(j)  (256  + 64 * (j))
#define XB_XSUB(j)  (1280 + 64 * (j))
#define XB_XGEN(j)  (2304 + 64 * (j))
#define XB_TOP      3328
#define XB_TOPGEN   3392
#define XCD_BAR_WORDS 3456
#define XB_SPIN_CAP (1u << 18)
__device__ __forceinline__ unsigned xb_ld(unsigned* p)              { return __hip_atomic_load(p, __ATOMIC_RELAXED, __HIP_MEMORY_SCOPE_AGENT); }
__device__ __forceinline__ unsigned xb_add(unsigned* p, unsigned v) { return __hip_atomic_fetch_add(p, v, __ATOMIC_RELAXED, __HIP_MEMORY_SCOPE_AGENT); }
__device__ __forceinline__ unsigned xb_xcc_id() { return (unsigned)__builtin_amdgcn_s_getreg((3 << 11) | 20) & 0xFu; }
#define XB_SPIN(cond, bar) do { unsigned _sp = 0; while (cond) { __builtin_amdgcn_s_sleep(1); \
    if ((++_sp & 255u) == 0u) { if (xb_ld(&(bar)[XB_TMO])) break; if (_sp > XB_SPIN_CAP) { atomicAdd(&(bar)[XB_TMO], 1u); break; } } } } while (0)
struct XcdBarrier { unsigned* bar; unsigned x; volatile LAS unsigned* st; };
__device__ __forceinline__ XcdBarrier xcd_barrier_post(unsigned* bar, volatile LAS unsigned* st) {
    XcdBarrier b; b.bar = bar; b.x = xb_xcc_id(); b.st = st;
    if (threadIdx.x == 0) (void)xb_add(&bar[XB_XCNT(b.x)], 1u);
    return b;
}
__device__ __forceinline__ void xcd_barrier_complete(unsigned* bar, unsigned x, unsigned& nloc, unsigned& nx) {
    const unsigned G = gridDim.x * gridDim.y * gridDim.z;
    unsigned sum, cnt, mine, sp = 0u;
    for (;;) {
        sum = 0u; cnt = 0u; mine = 0u;
#pragma unroll
        for (unsigned j = 0; j < 16; ++j) { const unsigned c = xb_ld(&bar[XB_XCNT(j)]); sum += c; cnt += (c > 0u) ? 1u : 0u; mine = (j == x) ? c : mine; }
        if (sum == G) break;
        __builtin_amdgcn_s_sleep(1);
        if ((++sp & 255u) == 0u) { if (xb_ld(&bar[XB_TMO])) break; if (sp > XB_SPIN_CAP) { atomicAdd(&bar[XB_TMO], 1u); break; } }
    }
    nloc = mine > 0u ? mine : 1u; nx = cnt > 0u ? cnt : 1u;
}
__device__ __forceinline__ void xcd_barrier(const Params& p, LAS char* L) {
    XcdBarrier b; b.bar = (unsigned*)(p.ws + WS_CTL + 4096); b.x = xb_xcc_id(); b.st = (volatile LAS unsigned*)(L + OFF_MISC);
    asm volatile("s_waitcnt vmcnt(0)" ::: "memory");
    __syncthreads();
    if (threadIdx.x == 0) {
        unsigned* bar = b.bar;
        __builtin_amdgcn_s_waitcnt(0);
        unsigned nloc = b.st[0], nx = b.st[1];
        if (nloc == 0u) { xcd_barrier_complete(bar, b.x, nloc, nx); b.st[0] = nloc; b.st[1] = nx; }
        const unsigned old = xb_add(&bar[XB_XSUB(b.x)], 1u);
        const unsigned gen = old / nloc;
        if (old + 1u == (gen + 1u) * nloc) {
            __builtin_amdgcn_fence(__ATOMIC_RELEASE, "agent");
            asm volatile("s_waitcnt vmcnt(0)" ::: "memory");
            const unsigned og = xb_add(&bar[XB_TOP], 1u);
            const unsigned tg = og / nx;
            if (og + 1u == (tg + 1u) * nx) xb_add(&bar[XB_TOPGEN], 1u);
            else XB_SPIN(xb_ld(&bar[XB_TOPGEN]) == tg, bar);
            __builtin_amdgcn_fence(__ATOMIC_ACQUIRE, "agent");
            xb_add(&bar[XB_XGEN(b.x)], 1u);
            asm volatile("s_waitcnt vmcnt(0)" ::: "memory");
        } else {
            XB_SPIN(xb_ld(&bar[XB_XGEN(b.x)]) == gen, bar);
            __builtin_amdgcn_fence(__ATOMIC_ACQUIRE, "agent");
            asm volatile("s_waitcnt vmcnt(0)" ::: "memory");
        }
    }
    __syncthreads();
}

__global__ void __launch_bounds__(NT, 2) mega(Params p) {
    extern __shared__ __attribute__((aligned(16))) char smem[];
    LAS char* L = (LAS char*)smem;
    if (threadIdx.x < 8) ((LAS unsigned*)(L + OFF_MISC))[threadIdx.x] = 0u;
    __syncthreads();
    (void)xcd_barrier_post((unsigned*)(p.ws + WS_CTL + 4096), (volatile LAS unsigned*)(L + OFF_MISC));
    phase_mod(p, L);
    xcd_barrier(p, L);
    phase_h1(p);
    xcd_barrier(p, L);
    phase_proj(p, L);
    xcd_barrier(p, L);
    phase_qkv(p, L);
    xcd_barrier(p, L);
    phase_attn(p, L);
    xcd_barrier(p, L);
    phase_oproj(p, L);
    xcd_barrier(p, L);
    phase_router_route(p, L);
    xcd_barrier(p, L);
    phase_moe1(p, L);
    xcd_barrier(p, L);
    phase_moe2(p, L);
    xcd_barrier(p, L);
    phase_final(p);
}

extern "C" void kernel_launch(void* const* d_in, const int* in_sizes, int n_in, void* d_out, int out_size, void* d_ws, size_t ws_size, hipStream_t stream) {
    static int grid_blocks = 0;
    if (grid_blocks == 0) {
        if (n_in != 28 || out_size != T * Dm || ws_size < WS_END) {
            fprintf(stderr, "kernel_launch: unexpected problem (n_in %d, out %d, ws %zu); nothing launched\n", n_in, out_size, ws_size);
            grid_blocks = -1; return;
        }
        int dev = 0, cus = 0, per_cu = 0;
        (void)hipGetDevice(&dev);
        (void)hipDeviceGetAttribute(&cus, hipDeviceAttributeMultiprocessorCount, dev);
        if (hipFuncSetAttribute((const void*)mega, hipFuncAttributeMaxDynamicSharedMemorySize, LDS_BYTES) != hipSuccess) {
            fprintf(stderr, "kernel_launch: hipFuncSetAttribute(%d B LDS) failed\n", LDS_BYTES); grid_blocks = -1; return;
        }
        (void)hipOccupancyMaxActiveBlocksPerMultiprocessor(&per_cu, mega, NT, LDS_BYTES);
        if (per_cu < 1) { fprintf(stderr, "kernel_launch: occupancy query says %d blocks per CU\n", per_cu); per_cu = 1; }
        grid_blocks = cus;
        fprintf(stderr, "kernel_launch: %d CUs, occupancy query %d per CU, grid %d\n", cus, per_cu, grid_blocks);
    }
    if (grid_blocks < 0) return;
    (void)hipMemsetAsync((char*)d_ws + WS_CTL, 0, CTL_BYTES, stream);
    Params p{};
    for (int i = 0; i < 28; ++i) p.in[i] = (const float*)d_in[i];
    p.out = (float*)d_out; p.ws = (char*)d_ws;
    void* args[] = {&p};
    hipError_t e = hipLaunchCooperativeKernel((void*)mega, dim3(grid_blocks), dim3(NT), args, LDS_BYTES, stream);
    if (e != hipSuccess) fprintf(stderr, "cooperative launch failed: %s (grid %d)\n", hipGetErrorString(e), grid_blocks);
}
```

```cpp
#include <hip/hip_runtime.h>
#include <cstdio>
#include <cstdint>


typedef unsigned short bf16_t;
typedef float f32x2 __attribute__((ext_vector_type(2)));
typedef short bf16x8 __attribute__((ext_vector_type(8)));
typedef short s16x4 __attribute__((ext_vector_type(4)));
typedef short v4i16_t __attribute__((ext_vector_type(4)));
typedef float f32x16 __attribute__((ext_vector_type(16)));
typedef float f32x4 __attribute__((ext_vector_type(4)));
typedef unsigned u32x4 __attribute__((ext_vector_type(4)));
typedef unsigned u32x2 __attribute__((ext_vector_type(2)));
#define LAS __attribute__((address_space(3)))

constexpr int NT = 512, NW = 8;
constexpr int Dm = 1024, NB = 8, SEQ = 2048, T = NB * SEQ;
constexpr int NIN = 1952;
constexpr int C_CQ = 0, C_CKV = 256, C_KR = 384, C_DQ = 416, C_DK = 928, C_DV = 1440;
constexpr int NE = 256, TOPK = 8, AR = T * TOPK, HROWS = AR + T;
constexpr int LISTCAP = T;
constexpr float LOG2E = 1.4426950408889634f;
constexpr float YSCALE = 32.f;
constexpr float LAMBDA_INIT = 0.2f;

constexpr size_t MiB = 1u << 20;
constexpr size_t WS_CTL = 0, CTL_BYTES = 65536;
constexpr size_t WS_MOD = 65536;
constexpr size_t WS_ROPE = 1 * MiB;
constexpr size_t WS_H1 = 4 * MiB;
constexpr size_t WS_PROJ = 36 * MiB;
constexpr size_t WS_CQN = 100 * MiB;
constexpr size_t WS_CKVN = 108 * MiB;
constexpr size_t WS_QM = 112 * MiB;
constexpr size_t WS_KF = 136 * MiB;
constexpr size_t WS_VM = 160 * MiB;
constexpr size_t WS_ATT = 176 * MiB;
constexpr size_t WS_OD0 = 208 * MiB;
constexpr size_t WS_Y1 = 240 * MiB;
constexpr size_t WS_H2 = 304 * MiB;
constexpr size_t WS_LOG = 336 * MiB;
constexpr size_t WS_LA = 352 * MiB;
constexpr size_t WS_LW = 368 * MiB;
constexpr size_t WS_HB = 384 * MiB;
constexpr size_t WS_YB = 456 * MiB;
constexpr size_t WS_WB = 744 * MiB;
constexpr size_t WB_IN = 0, WB_UQ = WB_IN + (size_t)1024 * 1952, WB_UKV = WB_UQ + 256 * 768, WB_O = WB_UKV + 128 * 1024, WB_R = WB_O + 1024 * 1024, WB_END = WB_R + 1024 * 256;
constexpr size_t WS_END = 760 * MiB;

constexpr int G_XB = 32768, G_WB = 36864, G_BUF = G_XB + G_WB, G_LDS = 2 * G_BUF;
constexpr int OFF_MISC = G_LDS, OFF_PRE = OFF_MISC + 64, OFF_TL = OFF_PRE + 1088;
constexpr int OFF_ROW = OFF_TL + 1088, OFF_RW = OFF_ROW + 1024;
constexpr int OFF_SS = OFF_RW + 1024;
constexpr int LDS_BYTES = G_LDS + 4352 + 4096;

struct Params {
    const float* in[28];
    float* out;
    char* ws;
};

__device__ __forceinline__ unsigned short f2bf(float f) { __bf16 b = (__bf16)f; return __builtin_bit_cast(unsigned short, b); }
typedef __bf16 bf16x2_t __attribute__((ext_vector_type(2)));
__device__ __forceinline__ unsigned pk2(float lo, float hi) { const f32x2 v = {lo, hi}; return __builtin_bit_cast(unsigned, __builtin_convertvector(v, bf16x2_t)); }
__device__ __forceinline__ float bf2f(unsigned short b) { return __uint_as_float(((unsigned)b) << 16); }
__device__ __forceinline__ float bflo(unsigned u) { return __uint_as_float(u << 16); }
__device__ __forceinline__ float bfhi(unsigned u) { return __uint_as_float(u & 0xffff0000u); }
__device__ __forceinline__ int crow(int r, int hi) { return (r & 3) + 8 * (r >> 2) + 4 * hi; }
__device__ __forceinline__ float shx(float v, int m, int lane) { return __int_as_float(__builtin_amdgcn_ds_bpermute((lane ^ m) << 2, __float_as_int(v))); }
__device__ __forceinline__ int shxi(int v, int m, int lane) { return __builtin_amdgcn_ds_bpermute((lane ^ m) << 2, v); }
__device__ __forceinline__ float shl(float v, int src) { return __int_as_float(__builtin_amdgcn_ds_bpermute(src << 2, __float_as_int(v))); }
__device__ __forceinline__ float wave_sum(float v, int lane) {
#pragma unroll
    for (int o = 32; o >= 1; o >>= 1) v += shx(v, o, lane);
    return v;
}
__device__ __forceinline__ float silu_f(float v) { return v / (1.f + __expf(-v)); }
__device__ __forceinline__ s16x4 tr_read(LAS char* p) {
    return __builtin_bit_cast(s16x4, __builtin_amdgcn_ds_read_tr16_b64_v4i16((LAS v4i16_t*)p));
}
__device__ __forceinline__ int otid() { int t = threadIdx.x; asm volatile("" : "+v"(t)); return t; }
__device__ __forceinline__ int grid_g() { return gridDim.x; }
__device__ __forceinline__ int vcu() { const int G = gridDim.x, bx = blockIdx.x; return (G % 8 == 0) ? (bx % 8) * (G / 8) + bx / 8 : bx; }
__device__ __forceinline__ void gld16(u32x4& d, const void* p) { asm volatile("global_load_dwordx4 %0, %1, off" : "+v"(d) : "v"(p) : "memory"); }
__device__ __forceinline__ void gld16(f32x4& d, const void* p) { asm volatile("global_load_dwordx4 %0, %1, off" : "+v"(d) : "v"(p) : "memory"); }
template <int N> __device__ __forceinline__ void vm_wait(u32x4& a, f32x4& b, f32x4& c) { asm volatile("s_waitcnt vmcnt(%3)" : "+v"(a), "+v"(b), "+v"(c) : "n"(N) : "memory"); }
template <int N> __device__ __forceinline__ void vm_wait(f32x4& b, f32x4& c) { asm volatile("s_waitcnt vmcnt(%2)" : "+v"(b), "+v"(c) : "n"(N) : "memory"); }
template <int N> __device__ __forceinline__ void vm_wait(u32x4& a, u32x4& b) { asm volatile("s_waitcnt vmcnt(%2)" : "+v"(a), "+v"(b) : "n"(N) : "memory"); }
template <int N> __device__ __forceinline__ void vm_wait(u32x4& b) { asm volatile("s_waitcnt vmcnt(%1)" : "+v"(b) : "n"(N) : "memory"); }
#define MFMA32(a, b, c) __builtin_amdgcn_mfma_f32_32x32x16_bf16(a, b, c, 0, 0, 0)

template <int NBMODE> __device__ __forceinline__ int nb_of(int wn, int ni) { return NBMODE == 0 ? 64 * wn + 32 * ni : 32 * wn + 128 * ni; }

template <int MI, int NBMODE, bool WBF = false, int NSEG = 1, class AF, class BF, class EF>
__device__ __forceinline__ void gemm_tile(LAS char* L, int nk, long ldw, const bf16_t* abase, AF arow, BF bcol, EF epi) {
    asm volatile("" : "+s"(nk));
    const int tid = otid(), lane = tid & 63, wave = tid >> 6;
    const int wm = wave & 1, wn = wave >> 1, l31 = lane & 31, hi = lane >> 5;
    const int a_chunk = tid & 7, a_row = tid >> 3;
    const int a_w = a_row * 128 + 16 * (a_chunk ^ ((a_row >> 1) & 7));
    const int b_n4 = WBF ? (tid & 31) : (tid & 63), b_kr = WBF ? (tid >> 5) : (tid >> 6);
    const auto bp = bcol((WBF ? 8 : 4) * b_n4) + (long)b_kr * ldw;
    const int b_w = G_XB + b_kr * 576 + (WBF ? 16 : 8) * b_n4;
    const int sw = (l31 >> 1) & 7;
    const int xoff = (32 * MI * wm + l31) * 128;
    const int woff = G_XB + (8 * hi + ((lane & 15) >> 2)) * 576 + 2 * (16 * ((lane >> 4) & 1) + 4 * (lane & 3));
    u32x4 ra[MI]; f32x4 rb[8]; u32x4 rw[4];
#pragma unroll
    for (int i = 0; i < MI; ++i) ra[i] = (u32x4){0u, 0u, 0u, 0u};
#pragma unroll
    for (int i = 0; i < 8; ++i) rb[i] = (f32x4){0.f, 0.f, 0.f, 0.f};
#pragma unroll
    for (int i = 0; i < 4; ++i) rw[i] = (u32x4){0u, 0u, 0u, 0u};
#define G_LOADW(KOFF, Q, SEGC) do { \
        if (WBF) { gld16(rw[Q], bp + (long)((KOFF) + 16 * (Q)) * ldw + (SEGC)); } \
        else { gld16(rb[2 * (Q)], bp + (long)((KOFF) + 16 * (Q)) * ldw + (SEGC)); gld16(rb[2 * (Q) + 1], bp + (long)((KOFF) + 16 * (Q) + 8) * ldw + (SEGC)); } } while (0)
#define G_LOADQ(KT, Q) do { \
        if ((Q) < MI) gld16(ra[(Q) < MI ? (Q) : 0], abase + arow(a_row + 64 * (Q)) + a_chunk * 8 + (KT) * 64); \
        G_LOADW((KT) * 64, Q, 0); } while (0)
#define G_LOADQ_SEL(KT, SEG, Q, OK) do { \
        const int kq_ = (OK) ? (KT) * 64 : 0; const int sc_ = (OK) ? (SEG) * 256 : 0; \
        if ((Q) < MI) gld16(ra[(Q) < MI ? (Q) : 0], abase + arow(a_row + 64 * (Q)) + a_chunk * 8 + kq_); \
        G_LOADW(kq_, Q, sc_); } while (0)
#define G_WAITQ(Q, N) do { \
        if (WBF) { if ((Q) < MI) vm_wait<N>(ra[(Q) < MI ? (Q) : 0], rw[Q]); else vm_wait<N>(rw[Q]); } \
        else { if ((Q) < MI) vm_wait<N>(ra[(Q) < MI ? (Q) : 0], rb[2 * (Q)], rb[2 * (Q) + 1]); else vm_wait<N>(rb[2 * (Q)], rb[2 * (Q) + 1]); } } while (0)
#define G_STOREQ(LP, Q) do { \
        if ((Q) < MI) *(LAS u32x4*)((LP) + a_w + (Q) * 8192) = ra[(Q) < MI ? (Q) : 0]; \
        if (WBF) { *(LAS u32x4*)((LP) + b_w + (Q) * 16 * 576) = rw[Q]; } else { \
        { u32x2 w; w.x = pk2(rb[2 * (Q)][0], rb[2 * (Q)][1]); w.y = pk2(rb[2 * (Q)][2], rb[2 * (Q)][3]); *(LAS u32x2*)((LP) + b_w + (Q) * 16 * 576) = w; } \
        { u32x2 w; w.x = pk2(rb[2 * (Q) + 1][0], rb[2 * (Q) + 1][1]); w.y = pk2(rb[2 * (Q) + 1][2], rb[2 * (Q) + 1][3]); *(LAS u32x2*)((LP) + b_w + (Q) * 16 * 576 + 8 * 576) = w; } } } while (0)
    constexpr int NLW = WBF ? 1 : 2;
    constexpr int NL0 = NLW + ((0 < MI) ? 1 : 0), NL1 = NLW + ((1 < MI) ? 1 : 0), NL2 = NLW + ((2 < MI) ? 1 : 0), NL3 = NLW + ((3 < MI) ? 1 : 0), NLT = NL0 + NL1 + NL2 + NL3;
    G_LOADQ(0, 0); G_LOADQ(0, 1); G_LOADQ(0, 2); G_LOADQ(0, 3);
    G_WAITQ(0, 0); G_WAITQ(1, 0); G_WAITQ(2, 0); G_WAITQ(3, 0);
    G_STOREQ(L, 0); G_STOREQ(L, 1); G_STOREQ(L, 2); G_STOREQ(L, 3);
    G_LOADQ(1, 0); G_LOADQ(1, 1); G_LOADQ(1, 2); G_LOADQ(1, 3);
    f32x16 acc[MI][2];
#pragma unroll
    for (int i = 0; i < MI; ++i)
#pragma unroll
        for (int j = 0; j < 2; ++j)
#pragma unroll
            for (int r = 0; r < 16; ++r) acc[i][j][r] = 0.f;
    __syncthreads();
    const int nt_all = nk * NSEG;
    int lk = (nk == 2) ? 0 : 2, lseg = (nk == 2) ? 1 : 0;
    int ck = 0, cseg = 0;
#pragma nounroll
    for (int kt = 0; kt < nt_all; ++kt) {
        LAS char* Lb = L + (kt & 1) * G_BUF;
        LAS char* Ln = L + ((kt + 1) & 1) * G_BUF;
        const bool ld = kt + 2 < nt_all;
        bf16x8 xf[2][MI], wf[2][2];
#define LOAD_FRAGS(KS, B) do { \
            _Pragma("unroll") for (int mi = 0; mi < MI; ++mi) xf[B][mi] = *(LAS bf16x8*)(Lb + xoff + mi * 4096 + 16 * ((2 * (KS) + hi) ^ sw)); \
            _Pragma("unroll") for (int ni = 0; ni < 2; ++ni) { \
                LAS char* pp = Lb + woff + (KS) * 16 * 576 + 2 * nb_of<NBMODE>(wn, ni); \
                const s16x4 lo = tr_read(pp), h4 = tr_read(pp + 4 * 576); \
                wf[B][ni] = (bf16x8){lo[0], lo[1], lo[2], lo[3], h4[0], h4[1], h4[2], h4[3]}; } } while (0)
#define MMA_STEP(KS) do { \
            _Pragma("unroll") for (int mi = 0; mi < MI; ++mi) \
                _Pragma("unroll") for (int ni = 0; ni < 2; ++ni) acc[mi][ni] = MFMA32(wf[(KS) & 1][ni], xf[(KS) & 1][mi], acc[mi][ni]); } while (0)
#define STAGE_STEP(Q, NREST, NPREV) do { G_WAITQ(Q, (NREST) + (NPREV)); G_STOREQ(Ln, Q); G_LOADQ_SEL(lk, lseg, Q, ld); } while (0)
        LOAD_FRAGS(0, 0);
        LOAD_FRAGS(1, 1); MMA_STEP(0); STAGE_STEP(0, NL1 + NL2 + NL3, 0);           __builtin_amdgcn_sched_barrier(0);
        LOAD_FRAGS(2, 0); MMA_STEP(1); STAGE_STEP(1, NL2 + NL3, NL0);               __builtin_amdgcn_sched_barrier(0);
        LOAD_FRAGS(3, 1); MMA_STEP(2); STAGE_STEP(2, NL3, NL0 + NL1);               __builtin_amdgcn_sched_barrier(0);
        MMA_STEP(3);                   STAGE_STEP(3, 0, NL0 + NL1 + NL2);           __builtin_amdgcn_sched_barrier(0);
#undef LOAD_FRAGS
#undef MMA_STEP
#undef STAGE_STEP
        __syncthreads();
        if (++lk == nk) { lk = 0; ++lseg; }
        if (NSEG > 1) {
            if (++ck == nk) {
                ck = 0;
                if (cseg + 1 < NSEG) {
                    epi(acc, cseg, L + (kt & 1) * G_BUF);
#pragma unroll
                    for (int i = 0; i < MI; ++i)
#pragma unroll
                        for (int j = 0; j < 2; ++j)
#pragma unroll
                            for (int r = 0; r < 16; ++r) acc[i][j][r] = 0.f;
                }
                ++cseg;
            }
        }
    }
    G_WAITQ(0, 0); G_WAITQ(1, 0); G_WAITQ(2, 0); G_WAITQ(3, 0);
#undef G_LOADQ
#undef G_LOADQ_SEL
#undef G_LOADW
#undef G_WAITQ
#undef G_STOREQ
    (void)NLT;
    epi(acc, NSEG - 1, L);
}

template <int MI, int NC, class DF>
__device__ __forceinline__ void store_tile_bf16(LAS char* L, const f32x16 (&acc)[MI][2], DF dst) {
    constexpr int STR = NC * 2 + 16, CPR = NC / 8, BM = 64 * MI;
    const int tid = otid(), lane = tid & 63, wave = tid >> 6, wm = wave & 1, wn = wave >> 1, l31 = lane & 31, hi = lane >> 5;
#pragma unroll
    for (int mi = 0; mi < MI; ++mi)
#pragma unroll
        for (int ni = 0; ni < (NC == 256 ? 2 : 1); ++ni) {
            const int row = 32 * MI * wm + 32 * mi + l31, col = (NC == 256) ? nb_of<0>(wn, ni) : 32 * wn;
#pragma unroll
            for (int gq = 0; gq < 4; ++gq) {
                u32x2 w; w.x = pk2(acc[mi][ni][4 * gq], acc[mi][ni][4 * gq + 1]); w.y = pk2(acc[mi][ni][4 * gq + 2], acc[mi][ni][4 * gq + 3]);
                *(LAS u32x2*)(L + row * STR + 2 * (col + 8 * gq + 4 * hi)) = w;
            }
        }
    __syncthreads();
#pragma unroll
    for (int i = 0; i < (BM * CPR) / NT; ++i) {
        const int id = tid + NT * i, row = id / CPR, c = id % CPR;
        bf16_t* d = dst(row, c);
        if (d) *(u32x4*)d = *(LAS u32x4*)(L + row * STR + 16 * c);
    }
    __syncthreads();
}

template <int MI, class DF>
__device__ __forceinline__ void store_tile_fp8(LAS char* L, const f32x16 (&acc)[MI][2], DF dst) {
    constexpr int STR = 256 + 16, BM = 64 * MI;
    const int tid = otid(), lane = tid & 63, wave = tid >> 6, wm = wave & 1, wn = wave >> 1, l31 = lane & 31, hi = lane >> 5;
#pragma unroll
    for (int mi = 0; mi < MI; ++mi)
#pragma unroll
        for (int ni = 0; ni < 2; ++ni) {
            const int row = 32 * MI * wm + 32 * mi + l31, col = nb_of<0>(wn, ni);
#pragma unroll
            for (int gq = 0; gq < 4; ++gq) {
                int w = 0;
                w = __builtin_amdgcn_cvt_pk_fp8_f32(acc[mi][ni][4 * gq], acc[mi][ni][4 * gq + 1], w, false);
                w = __builtin_amdgcn_cvt_pk_fp8_f32(acc[mi][ni][4 * gq + 2], acc[mi][ni][4 * gq + 3], w, true);
                *(LAS int*)(L + row * STR + (col + 8 * gq + 4 * hi)) = w;
            }
        }
    __syncthreads();
#pragma unroll
    for (int i = 0; i < (BM * 16) / NT; ++i) {
        const int id = tid + NT * i, row = id >> 4, c = id & 15;
        unsigned char* d = dst(row, c);
        if (d) *(u32x4*)d = *(LAS u32x4*)(L + row * STR + 16 * c);
    }
    __syncthreads();
}

__device__ __forceinline__ void phase_mod(const Params& p, LAS char* L) {
    const int v = vcu(), G = grid_g();
    const int tid = otid();
    const float* c = p.in[1]; const float* w_ada = p.in[3]; const float* b_ada = p.in[4];
    float* mod = (float*)(p.ws + WS_MOD);
    LAS float* sc = (LAS float*)L;
    LAS float* red = (LAS float*)(L + 32768);
    bool filled = false;
    for (int item = v; item < 384; item += G) {
        if (!filled) {
            for (int i = tid; i < 8 * 1024; i += NT) sc[i] = silu_f(c[i]);
            __syncthreads(); filled = true;
        }
        const int cx = tid & 15, kl = tid >> 4, col = item * 16 + cx;
        float a[8];
#pragma unroll
        for (int b = 0; b < 8; ++b) a[b] = 0.f;
#pragma unroll 4
        for (int k = kl; k < 1024; k += 32) {
            const float w = w_ada[(size_t)k * 6144 + col];
#pragma unroll
            for (int b = 0; b < 8; ++b) a[b] += sc[b * 1024 + k] * w;
        }
#pragma unroll
        for (int b = 0; b < 8; ++b) red[(b * 32 + kl) * 16 + cx] = a[b];
        __syncthreads();
        if (tid < 128) {
            const int b = tid >> 4, cc = tid & 15; float s = 0.f;
#pragma unroll
            for (int k = 0; k < 32; ++k) s += red[(b * 32 + k) * 16 + cc];
            mod[b * 6144 + item * 16 + cc] = s + b_ada[item * 16 + cc];
        }
        __syncthreads();
    }
    {
        bf16_t* wb = (bf16_t*)(p.ws + WS_WB);
        const size_t gt = (size_t)v * NT + tid, gs = (size_t)G * NT;
        auto conv = [&](const float* src, size_t off, size_t n) {
            for (size_t i = gt; i < n / 4; i += gs) { const f32x4 f = *(const f32x4*)(src + 4 * i); u32x2 w; w.x = pk2(f[0], f[1]); w.y = pk2(f[2], f[3]); *(u32x2*)(wb + off + 4 * i) = w; }
        };
        auto convg = [&](const float* src, size_t off, size_t n, int ncol, const float* gain) {
            for (size_t i = gt; i < n / 4; i += gs) { const float gk = gain[(4 * i) / ncol]; const f32x4 f = *(const f32x4*)(src + 4 * i); u32x2 w; w.x = pk2(f[0] * gk, f[1] * gk); w.y = pk2(f[2] * gk, f[3] * gk); *(u32x2*)(wb + off + 4 * i) = w; }
        };
        conv(p.in[7], WB_IN, (size_t)1024 * 1952); convg(p.in[10], WB_UQ, (size_t)256 * 768, 768, p.in[8]); convg(p.in[11], WB_UKV, (size_t)128 * 1024, 1024, p.in[9]);
        conv(p.in[17], WB_O, (size_t)1024 * 1024); conv(p.in[20], WB_R, (size_t)1024 * 256);
    }
}

__device__ __forceinline__ void phase_h1(const Params& p) {
    const int v = vcu(), G = grid_g();
    const int tid = otid(), lane = tid & 63, wave = tid >> 6;
    const float* x = p.in[0]; const int* positions = (const int*)p.in[2]; const float* g = p.in[5];
    const float* mod = (const float*)(p.ws + WS_MOD);
    bf16_t* h1 = (bf16_t*)(p.ws + WS_H1);
    f32x2* rope = (f32x2*)(p.ws + WS_ROPE);
    for (int t = v * NW + wave; t < T; t += G * NW) {
        const int b = t / SEQ;
        const f32x4* xr = (const f32x4*)(x + (size_t)t * Dm);
        f32x4 xv[4]; float ss = 0.f;
#pragma unroll
        for (int j = 0; j < 4; ++j) { xv[j] = xr[lane + 64 * j]; ss += xv[j][0] * xv[j][0] + xv[j][1] * xv[j][1] + xv[j][2] * xv[j][2] + xv[j][3] * xv[j][3]; }
        ss = wave_sum(ss, lane);
        const float rstd = rsqrtf(ss * (1.f / Dm) + 1e-6f);
        const float* sh = mod + b * 6144; const float* scl = sh + 1024;
#pragma unroll
        for (int j = 0; j < 4; ++j) {
            const int col = 4 * (lane + 64 * j);
            const f32x4 gv = *(const f32x4*)(g + col), sv = *(const f32x4*)(scl + col), hv = *(const f32x4*)(sh + col);
            float o[4];
#pragma unroll
            for (int e = 0; e < 4; ++e) o[e] = (xv[j][e] * rstd * gv[e]) * (1.f + sv[e]) + hv[e];
            u32x2 w; w.x = pk2(o[0], o[1]); w.y = pk2(o[2], o[3]);
            *(u32x2*)(h1 + (size_t)t * Dm + col) = w;
        }
        if (lane < 16) {
            const double inv = exp2(-(double)lane * (13.287712379549449 / 16.0));
            const double rev = (double)positions[t] * inv * 0.15915494309189535;
            const float fr = (float)(rev - rint(rev));
            f32x2 cs; cs.x = __builtin_amdgcn_cosf(fr); cs.y = __builtin_amdgcn_sinf(fr);
            rope[(size_t)t * 16 + lane] = cs;
        }
    }
}

__device__ __forceinline__ void phase_proj(const Params& p, LAS char* L) {
    const int v = vcu(), G = grid_g();
    const bf16_t* h1 = (const bf16_t*)(p.ws + WS_H1);
    const bf16_t* w_in = (const bf16_t*)(p.ws + WS_WB) + WB_IN;
    bf16_t* proj = (bf16_t*)(p.ws + WS_PROJ);
    const f32x2* rope = (const f32x2*)(p.ws + WS_ROPE);
    for (int u = v; u < 64 * 8; u += G) {
        const int mt = u >> 3, nt = u & 7, m0 = mt * 256, n0 = nt * 256;
        auto arow = [&](int r) { return (unsigned)(m0 + r) * Dm; };
        auto bcol = [&](int c) { int col = n0 + c; if (col > NIN - 8) col = NIN - 8; return w_in + col; };
        auto epi = [&](f32x16 (&acc)[4][2], int seg, LAS char* Ls) {
            const int tid_ = otid(), lane = tid_ & 63, wave = tid_ >> 6, wm = wave & 1, wn = wave >> 1, l31 = lane & 31, hi = lane >> 5;
            if (nt < 2) {
                LAS float* ssl = (LAS float*)(L + OFF_SS);
                const bool contrib = (nt == 0) || (wn < 2);
#pragma unroll
                for (int mi = 0; mi < 4; ++mi) {
                    float part = 0.f;
#pragma unroll
                    for (int ni = 0; ni < 2; ++ni)
#pragma unroll
                        for (int r = 0; r < 16; ++r) part += acc[mi][ni][r] * acc[mi][ni][r];
                    part += shx(part, 32, lane);
                    if (hi == 0) ssl[(128 * wm + 32 * mi + l31) * 4 + wn] = contrib ? part : 0.f;
                }
                __syncthreads();
                if (tid_ < 256) {
                    const f32x4 q4 = *(LAS f32x4*)(ssl + tid_ * 4);
                    const float ssum = (q4[0] + q4[1]) + (q4[2] + q4[3]);
                    float* rs = (float*)(p.ws + WS_CQN) + (nt == 0 ? 0 : (1 << 18));
                    rs[m0 + tid_] = rsqrtf(ssum * (nt == 0 ? 1.f / 256.f : 1.f / 128.f) + 1e-6f);
                }
            }
#pragma unroll
            for (int ni = 0; ni < 2; ++ni) {
                const int nbg = n0 + nb_of<0>(wn, ni);
                if (nbg == C_KR) {
#pragma unroll
                    for (int mi = 0; mi < 4; ++mi) {
                        const int m = m0 + 128 * wm + 32 * mi + l31;
#pragma unroll
                        for (int r = 0; r < 8; ++r) {
                            const f32x2 cs = rope[(size_t)m * 16 + crow(r, hi)];
                            const float x1 = acc[mi][ni][r], x2 = acc[mi][ni][r + 8];
                            acc[mi][ni][r] = x1 * cs.x - x2 * cs.y; acc[mi][ni][r + 8] = x2 * cs.x + x1 * cs.y;
                        }
                    }
                }
                if (nbg >= C_DQ && nbg < C_DK) {
#pragma unroll
                    for (int mi = 0; mi < 4; ++mi)
#pragma unroll
                        for (int r = 0; r < 16; ++r) acc[mi][ni][r] *= 0.125f * LOG2E;
                }
            }
            store_tile_bf16<4, 256>(Ls, acc, [&](int row, int c) -> bf16_t* { const int col = n0 + 8 * c; return col < NIN ? proj + (size_t)(m0 + row) * NIN + col : nullptr; });
        };
        gemm_tile<4, 0, true>(L, Dm / 64, NIN, h1, arow, bcol, epi);
    }
}

__device__ __forceinline__ void phase_qkv(const Params& p, LAS char* L) {
    const int v = vcu(), G = grid_g();
    const bf16_t* proj = (const bf16_t*)(p.ws + WS_PROJ);
    const float* rstd_q = (const float*)(p.ws + WS_CQN); const float* rstd_kv = rstd_q + (1 << 18);
    const bf16_t* w_uq = (const bf16_t*)(p.ws + WS_WB) + WB_UQ; const bf16_t* w_ukv = (const bf16_t*)(p.ws + WS_WB) + WB_UKV;
    bf16_t* qm = (bf16_t*)(p.ws + WS_QM); bf16_t* kf = (bf16_t*)(p.ws + WS_KF); bf16_t* vm = (bf16_t*)(p.ws + WS_VM);
    const f32x2* rope = (const f32x2*)(p.ws + WS_ROPE);
    const float qscale = LOG2E * 0.10206207261596575f;
    for (int u = v; u < 64 * 7; u += G) {
        const int mt = u / 7, j = u % 7, m0 = mt * 256;
        if (j < 3) {
            const int n0 = j * 256;
            auto arow = [&](int r) { return (unsigned)(m0 + r) * NIN + C_CQ; };
            auto bcol = [&](int c) { return w_uq + n0 + c; };
            auto epi = [&](f32x16 (&acc)[4][2], int seg, LAS char* Ls) {
                const int tid_ = otid(), lane = tid_ & 63, wave = tid_ >> 6, wm = wave & 1, wn = wave >> 1, l31 = lane & 31, hi = lane >> 5;
#pragma unroll
                for (int mi = 0; mi < 4; ++mi) {
                    const int m = m0 + 128 * wm + 32 * mi + l31;
                    const float qs = qscale * rstd_q[m];
#pragma unroll
                    for (int ni = 0; ni < 2; ++ni) {
                        const int nbg = n0 + nb_of<0>(wn, ni);
                        if ((nbg % 96) == 64) {
#pragma unroll
                            for (int r = 0; r < 8; ++r) {
                                const f32x2 cs = rope[(size_t)m * 16 + crow(r, hi)];
                                const float x1 = acc[mi][ni][r], x2 = acc[mi][ni][r + 8];
                                acc[mi][ni][r] = x1 * cs.x - x2 * cs.y; acc[mi][ni][r + 8] = x2 * cs.x + x1 * cs.y;
                            }
                        }
#pragma unroll
                        for (int r = 0; r < 16; ++r) acc[mi][ni][r] *= qs;
                    }
                }
                store_tile_bf16<4, 256>(Ls, acc, [&](int row, int c) -> bf16_t* { return qm + (size_t)(m0 + row) * 768 + n0 + 8 * c; });
            };
            gemm_tile<4, 0, true>(L, 256 / 64, 768, proj, arow, bcol, epi);
        } else {
            const int n0 = (j - 3) * 256;
            auto arow = [&](int r) { return (unsigned)(m0 + r) * NIN + C_CKV; };
            auto bcol = [&](int c) { return w_ukv + n0 + c; };
            auto epi = [&](f32x16 (&acc)[4][2], int seg, LAS char* Ls) {
                {
                    const int tid_ = otid(), lane = tid_ & 63, wave = tid_ >> 6, wm = wave & 1, l31 = lane & 31;
#pragma unroll
                    for (int mi = 0; mi < 4; ++mi) {
                        const float rs = rstd_kv[m0 + 128 * wm + 32 * mi + l31];
#pragma unroll
                        for (int ni = 0; ni < 2; ++ni)
#pragma unroll
                            for (int r = 0; r < 16; ++r) acc[mi][ni][r] *= rs;
                    }
                }
                store_tile_bf16<4, 256>(Ls, acc, [&](int row, int c) -> bf16_t* {
                    const int h = (n0 >> 7) + (c >> 4), cc = c & 15;
                    return cc < 8 ? kf + (size_t)(m0 + row) * 768 + h * 96 + 8 * cc : vm + (size_t)(m0 + row) * 512 + h * 64 + 8 * (cc - 8); });
            };
            gemm_tile<4, 0, true>(L, 128 / 64, 1024, proj, arow, bcol, epi);
        }
    }
}

template <int DQK, int DV, bool ALIBI>
__device__ __forceinline__ void attn_map(LAS char* L, const bf16_t* Q, int ldq, const bf16_t* K, int ldk, const bf16_t* V, int ldv,
                                         const int* posrow, float slope2, int q0, f32x16 (&o)[DV / 32], const bf16_t* K2 = nullptr, int ldk2 = 0) {
    constexpr int KSTR = DQK * 2 + 16, VSTR = DV * 2 + 64, KS = DQK / 16, ND = DV / 32;
    constexpr int K_OFF = 0, V_OFF = 64 * KSTR, P_OFF = V_OFF + 64 * VSTR, ABUF = P_OFF + 256;
    constexpr int KCH = DQK / 8, VCH = DV / 8;
    constexpr int NKI = (64 * KCH + NT - 1) / NT, NVI = (64 * VCH + NT - 1) / NT;
    static_assert(3 * ABUF <= G_LDS, "attention ring");
    const int tid = otid();
    const int lane = tid & 63, wave = tid >> 6, l31 = lane & 31, hi = lane >> 5;
    const int qrow = q0 + 32 * wave + l31;
    unsigned kgo[NKI], klo[NKI], vgo[NVI], vlo[NVI];
    bool k2s[NKI];
#pragma unroll
    for (int i = 0; i < NKI; ++i) { int c = tid + NT * i; if (c >= 64 * KCH) c = 64 * KCH - 1; const int row = c / KCH, ch = c % KCH; k2s[i] = (DQK == 96) && (ch >= 8);
        kgo[i] = k2s[i] ? (unsigned)(row * ldk2 + (ch - 8) * 8) * 2u : (unsigned)(row * ldk + ch * 8) * 2u; klo[i] = K_OFF + row * KSTR + ch * 16; }
#pragma unroll
    for (int i = 0; i < NVI; ++i) { int c = tid + NT * i; if (c >= 64 * VCH) c = 64 * VCH - 1; const int row = c / VCH, ch = c % VCH; vgo[i] = (unsigned)(row * ldv + ch * 8) * 2u; vlo[i] = V_OFF + row * VSTR + ch * 16; }
    bf16x8 qf[KS];
#pragma unroll
    for (int s = 0; s < KS; ++s) qf[s] = *(const bf16x8*)(Q + (size_t)qrow * ldq + 16 * s + 8 * hi);
    const float posq = ALIBI ? (float)posrow[qrow] : 0.f;
#pragma unroll
    for (int d = 0; d < ND; ++d)
#pragma unroll
        for (int r = 0; r < 16; ++r) o[d][r] = 0.f;
    float m_run = -1e30f, l_run = 0.f;
    const int ntile = (q0 + 256) / 64;
    const int qmin = q0 + 32 * wave, qmax = qmin + 31;
    const int vrd = V_OFF + (4 * hi + ((lane & 15) >> 2)) * VSTR + 2 * (16 * ((lane >> 4) & 1) + 4 * (lane & 3));
    u32x4 rk[NKI], rv[NVI]; float rp = 0.f;
#define A_LOAD(T) do { \
        const char* kbase_ = (const char*)(K + (size_t)(T) * 64 * ldk); const char* kbase2_ = (const char*)(K2 + (size_t)(T) * 64 * ldk2); \
        const char* vbase_ = (const char*)(V + (size_t)(T) * 64 * ldv); \
        _Pragma("unroll") for (int i = 0; i < NKI; ++i) rk[i] = *(const u32x4*)((k2s[i] ? kbase2_ : kbase_) + kgo[i]); \
        _Pragma("unroll") for (int i = 0; i < NVI; ++i) rv[i] = *(const u32x4*)(vbase_ + vgo[i]); \
        if (ALIBI && tid < 64) rp = (float)posrow[(T) * 64 + tid]; } while (0)
#define A_STORE(LP) do { \
        _Pragma("unroll") for (int i = 0; i < NKI; ++i) if (tid + NT * i < 64 * KCH) *(LAS u32x4*)((LP) + klo[i]) = rk[i]; \
        _Pragma("unroll") for (int i = 0; i < NVI; ++i) if (tid + NT * i < 64 * VCH) *(LAS u32x4*)((LP) + vlo[i]) = rv[i]; \
        if (ALIBI && tid < 64) *(LAS float*)((LP) + P_OFF + 4 * tid) = rp; } while (0)
#define A_KFRAG(DST, LP, S_) do { DST[0] = *(LAS bf16x8*)((LP) + K_OFF + l31 * KSTR + 32 * (S_) + 16 * hi); DST[1] = *(LAS bf16x8*)((LP) + K_OFF + (32 + l31) * KSTR + 32 * (S_) + 16 * hi); } while (0)
#define A_SCORES(S0, S1, LP, KB) do { \
        bf16x8 kfa_[2], kfb_[2]; \
        A_KFRAG(kfa_, LP, 0); \
        _Pragma("unroll") for (int s = 0; s < KS; s += 2) {        \
            if (s + 1 < KS) A_KFRAG(kfb_, LP, s + 1); \
            if (s == 0) { S0 = MFMA32(kfa_[0], qf[0], z16); S1 = MFMA32(kfa_[1], qf[0], z16); }         \
            else { S0 = MFMA32(kfa_[0], qf[s], S0); S1 = MFMA32(kfa_[1], qf[s], S1); } \
            __builtin_amdgcn_sched_barrier(0); \
            if (s + 1 < KS) { \
                if (s + 2 < KS) A_KFRAG(kfa_, LP, s + 2); \
                S0 = MFMA32(kfb_[0], qf[s + 1], S0); S1 = MFMA32(kfb_[1], qf[s + 1], S1); \
                __builtin_amdgcn_sched_barrier(0); } } \
        if (ALIBI) { \
            _Pragma("unroll") for (int g4 = 0; g4 < 4; ++g4) { \
                const f32x4 pk0_ = *(LAS f32x4*)((LP) + P_OFF + 4 * (8 * g4 + 4 * hi)), pk1_ = *(LAS f32x4*)((LP) + P_OFF + 4 * (32 + 8 * g4 + 4 * hi)); \
                _Pragma("unroll") for (int e = 0; e < 4; ++e) { S0[4 * g4 + e] -= slope2 * fabsf(posq - pk0_[e]); S1[4 * g4 + e] -= slope2 * fabsf(posq - pk1_[e]); } } } \
        if ((KB) + 63 > qmin) { \
            _Pragma("unroll") for (int r = 0; r < 16; ++r) { const int key_ = (KB) + crow(r, hi); if (key_ > qrow) S0[r] = -INFINITY; if (key_ + 32 > qrow) S1[r] = -INFINITY; } } } while (0)
#define A_VFRAG(DST, LP, S_) do { _Pragma("unroll") for (int d = 0; d < ND; ++d) { \
            LAS char* vp_ = (LP) + vrd + 16 * (S_) * VSTR + 64 * d; const s16x4 lo_ = tr_read(vp_), h4_ = tr_read(vp_ + 8 * VSTR); \
            DST[d] = (bf16x8){lo_[0], lo_[1], lo_[2], lo_[3], h4_[0], h4_[1], h4_[2], h4_[3]}; } } while (0)
#define A_SOFTMAX_PV(S0, S1, LP) do { \
        bf16x8 vfa_[ND], vfb_[ND]; \
        A_VFRAG(vfa_, LP, 0);                                       \
        float mxa_ = S0[0], mxb_ = S0[8], mxc_ = S1[0], mxd_ = S1[8];          \
        _Pragma("unroll") for (int r = 1; r < 8; ++r) { mxa_ = fmaxf(mxa_, S0[r]); mxb_ = fmaxf(mxb_, S0[8 + r]); mxc_ = fmaxf(mxc_, S1[r]); mxd_ = fmaxf(mxd_, S1[8 + r]); } \
        float mx_ = fmaxf(fmaxf(mxa_, mxb_), fmaxf(mxc_, mxd_)); \
        { const auto rr_ = __builtin_amdgcn_permlane32_swap(__float_as_uint(mx_), __float_as_uint(mx_), false, false); mx_ = fmaxf(__uint_as_float(rr_[0]), __uint_as_float(rr_[1])); }     \
        if (__any(mx_ > m_run + 8.f)) { \
            const float m_new_ = fmaxf(m_run, mx_); const float alpha_ = __builtin_amdgcn_exp2f(m_run - m_new_); m_run = m_new_; l_run *= alpha_; \
            _Pragma("unroll") for (int d = 0; d < ND; ++d) _Pragma("unroll") for (int r = 0; r < 16; ++r) o[d][r] *= alpha_; } \
        float lsa_ = 0.f, lsb_ = 0.f, lsc_ = 0.f, lsd_ = 0.f; \
        _Pragma("unroll") for (int r = 0; r < 16; ++r) { S0[r] = __builtin_amdgcn_exp2f(S0[r] - m_run); S1[r] = __builtin_amdgcn_exp2f(S1[r] - m_run); } \
        _Pragma("unroll") for (int r = 0; r < 8; ++r) { lsa_ += S0[r]; lsb_ += S0[8 + r]; lsc_ += S1[r]; lsd_ += S1[8 + r]; } \
        l_run += (lsa_ + lsb_) + (lsc_ + lsd_); \
        u32x4 pw_[4]; \
        _Pragma("unroll") for (int j = 0; j < 4; ++j) { \
            pw_[0][j] = pk2(S0[2 * j], S0[2 * j + 1]); pw_[1][j] = pk2(S0[8 + 2 * j], S0[8 + 2 * j + 1]); \
            pw_[2][j] = pk2(S1[2 * j], S1[2 * j + 1]); pw_[3][j] = pk2(S1[8 + 2 * j], S1[8 + 2 * j + 1]); } \
        __builtin_amdgcn_sched_barrier(0); \
        A_VFRAG(vfb_, LP, 1); \
        _Pragma("unroll") for (int d = 0; d < ND; ++d) o[d] = MFMA32(vfa_[d], __builtin_bit_cast(bf16x8, pw_[0]), o[d]); \
        __builtin_amdgcn_sched_barrier(0); \
        A_VFRAG(vfa_, LP, 2); \
        _Pragma("unroll") for (int d = 0; d < ND; ++d) o[d] = MFMA32(vfb_[d], __builtin_bit_cast(bf16x8, pw_[1]), o[d]); \
        __builtin_amdgcn_sched_barrier(0); \
        A_VFRAG(vfb_, LP, 3); \
        _Pragma("unroll") for (int d = 0; d < ND; ++d) o[d] = MFMA32(vfa_[d], __builtin_bit_cast(bf16x8, pw_[2]), o[d]); \
        __builtin_amdgcn_sched_barrier(0); \
        _Pragma("unroll") for (int d = 0; d < ND; ++d) o[d] = MFMA32(vfb_[d], __builtin_bit_cast(bf16x8, pw_[3]), o[d]); \
        __builtin_amdgcn_sched_barrier(0); } while (0)
    A_LOAD(0);
    __syncthreads();
    A_STORE(L);
    A_LOAD(1);
    A_STORE(L + ABUF);
    __syncthreads();
    const f32x16 z16 = {0.f, 0.f, 0.f, 0.f, 0.f, 0.f, 0.f, 0.f, 0.f, 0.f, 0.f, 0.f, 0.f, 0.f, 0.f, 0.f};
    f32x16 sa0, sa1, sb0, sb1;
    A_SCORES(sa0, sa1, L, 0);
    int bc = 0;
#define A_STEP(TL, C0, C1, N0, N1) do { \
        const int kb_ = (TL) * 64; \
        const int bn_ = (bc == 2) ? 0 : bc + 1, bnn_ = (bn_ == 2) ? 0 : bn_ + 1; \
        LAS char* Lc_ = L + bc * ABUF; LAS char* Ln_ = L + bn_ * ABUF; LAS char* Lnn_ = L + bnn_ * ABUF; \
        const bool more2_ = (TL) + 2 < ntile; \
        if (more2_) A_LOAD((TL) + 2); \
        const bool act_c_ = kb_ <= qmax, act_n_ = ((TL) + 1 < ntile) && (kb_ + 64 <= qmax); \
        if (act_n_) {                  \
            A_SCORES(N0, N1, Ln_, kb_ + 64); \
            A_SOFTMAX_PV(C0, C1, Lc_); \
        } else if (act_c_) { \
            A_SOFTMAX_PV(C0, C1, Lc_); \
        } \
        if (more2_) A_STORE(Lnn_); \
        __syncthreads(); \
        bc = bn_; } while (0)
    for (int tl = 0; tl < ntile; tl += 2) {
        A_STEP(tl, sa0, sa1, sb0, sb1);
        A_STEP(tl + 1, sb0, sb1, sa0, sa1);
    }
#undef A_STEP
#undef A_LOAD
#undef A_STORE
#undef A_SCORES
#undef A_SOFTMAX_PV
#undef A_KFRAG
#undef A_VFRAG
    const float lt = l_run + shx(l_run, 32, lane);
    const float inv = 1.f / lt;
#pragma unroll
    for (int d = 0; d < ND; ++d)
#pragma unroll
        for (int r = 0; r < 16; ++r) o[d][r] *= inv;
}

__device__ __forceinline__ void attn_decode(int it, int& kind, int& qb, int& idx) {
    const int seg_kind[16] = {1, 1, 1, 1, 1, 0, 1, 0, 0, 0, 1, 0, 0, 1, 0, 0};
    const int seg_qb[16]   = {7, 6, 5, 4, 3, 7, 2, 6, 5, 4, 1, 3, 2, 0, 1, 0};
    int base = 0; kind = 0; qb = 0; idx = 0;
#pragma unroll
    for (int s = 0; s < 16; ++s) {
        const int n = seg_kind[s] ? 32 : 64;
        if (it >= base && it < base + n) { kind = seg_kind[s]; qb = seg_qb[s]; idx = it - base; }
        base += n;
    }
}

__device__ __forceinline__ void phase_attn(const Params& p, LAS char* L) {
    const int v = vcu(), G = grid_g();
    const int tid = otid(), lane = tid & 63, wave = tid >> 6, l31 = lane & 31, hi = lane >> 5;
    const int* positions = (const int*)p.in[2];
    const bf16_t* proj = (const bf16_t*)(p.ws + WS_PROJ);
    const bf16_t* qm = (const bf16_t*)(p.ws + WS_QM); const bf16_t* kf = (const bf16_t*)(p.ws + WS_KF); const bf16_t* vm = (const bf16_t*)(p.ws + WS_VM);
    bf16_t* att = (bf16_t*)(p.ws + WS_ATT);
    float* od0 = (float*)(p.ws + WS_OD0);
    const float* subg = p.in[16];
    unsigned* qctr = (unsigned*)(p.ws + WS_CTL + 2048);
    LAS unsigned* qslot = (LAS unsigned*)(L + OFF_MISC + 16);
    float lam;
    {
        const float a = p.in[12][lane] * p.in[13][lane], b = p.in[14][lane] * p.in[15][lane];
        lam = __expf(wave_sum(a, lane)) - __expf(wave_sum(b, lane)) + LAMBDA_INIT;
    }
    for (;;) {
        if (tid == 0) *qslot = __hip_atomic_fetch_add(qctr, 1u, __ATOMIC_RELAXED, __HIP_MEMORY_SCOPE_AGENT);
        __syncthreads();
        const int it = (int)*qslot;
        __syncthreads();
        if (it >= 768) break;
        int kind, qb, idx;
        attn_decode(it, kind, qb, idx);
        const int q0 = qb * 256;
        if (kind == 0) {
            const int b = idx >> 3, h = idx & 7; const size_t tb = (size_t)b * SEQ;
            f32x16 o[2];
            attn_map<96, 64, false>(L, qm + tb * 768 + h * 96, 768, kf + tb * 768 + h * 96, 768, vm + tb * 512 + h * 64, 512, positions + tb, 0.f, q0, o, proj + tb * NIN + C_KR, NIN);
            const size_t t = tb + q0 + 32 * wave + l31;
#pragma unroll
            for (int d = 0; d < 2; ++d)
#pragma unroll
                for (int gq = 0; gq < 4; ++gq) {
                    u32x2 w; w.x = pk2(o[d][4 * gq], o[d][4 * gq + 1]); w.y = pk2(o[d][4 * gq + 2], o[d][4 * gq + 3]);
                    *(u32x2*)(att + t * 1024 + h * 64 + 32 * d + 8 * gq + 4 * hi) = w;
                }
        } else {
            const int b = idx >> 2, h = idx & 3; const size_t tb = (size_t)b * SEQ;
            const float slope2 = exp2f(-2.f * (h + 1)) * LOG2E;
            const size_t t = tb + q0 + 32 * wave + l31;
            f32x16 o[4];
            attn_map<64, 128, true>(L, proj + tb * NIN + C_DQ + h * 128, NIN, proj + tb * NIN + C_DK + h * 128, NIN, proj + tb * NIN + C_DV + h * 128, NIN, positions + tb, slope2, q0, o);
#pragma unroll
            for (int d = 0; d < 4; ++d)
#pragma unroll
                for (int gq = 0; gq < 4; ++gq) {
                    f32x4 w = {o[d][4 * gq], o[d][4 * gq + 1], o[d][4 * gq + 2], o[d][4 * gq + 3]};
                    *(f32x4*)(od0 + t * 512 + h * 128 + 32 * d + 8 * gq + 4 * hi) = w;
                }
            attn_map<64, 128, true>(L, proj + tb * NIN + C_DQ + h * 128 + 64, NIN, proj + tb * NIN + C_DK + h * 128 + 64, NIN, proj + tb * NIN + C_DV + h * 128, NIN, positions + tb, slope2, q0, o);
            float ss = 0.f;
#pragma unroll
            for (int d = 0; d < 4; ++d)
#pragma unroll
                for (int gq = 0; gq < 4; ++gq) {
                    const f32x4 w = *(const f32x4*)(od0 + t * 512 + h * 128 + 32 * d + 8 * gq + 4 * hi);
#pragma unroll
                    for (int e = 0; e < 4; ++e) { const float c = w[e] - lam * o[d][4 * gq + e]; o[d][4 * gq + e] = c; ss += c * c; }
                }
            ss += shx(ss, 32, lane);
            const float rstd = rsqrtf(ss * (1.f / 128.f) + 1e-5f) * (1.f - LAMBDA_INIT);
#pragma unroll
            for (int d = 0; d < 4; ++d)
#pragma unroll
                for (int gq = 0; gq < 4; ++gq) {
                    const int dv = 32 * d + 8 * gq + 4 * hi;
                    const f32x4 gv = *(const f32x4*)(subg + dv);
                    u32x2 w; w.x = pk2(o[d][4 * gq] * rstd * gv[0], o[d][4 * gq + 1] * rstd * gv[1]); w.y = pk2(o[d][4 * gq + 2] * rstd * gv[2], o[d][4 * gq + 3] * rstd * gv[3]);
                    *(u32x2*)(att + t * 1024 + 512 + h * 128 + dv) = w;
                }
        }
    }
}

__device__ __forceinline__ void phase_oproj(const Params& p, LAS char* L) {
    const int v = vcu(), G = grid_g();
    const bf16_t* att = (const bf16_t*)(p.ws + WS_ATT);
    const bf16_t* w_o = (const bf16_t*)(p.ws + WS_WB) + WB_O;
    bf16_t* y1 = (bf16_t*)(p.ws + WS_Y1);
    for (int u = v; u < 64 * 4; u += G) {
        const int mt = u >> 2, nt = u & 3, m0 = mt * 256, n0 = nt * 256;
        auto arow = [&](int r) { return (unsigned)(m0 + r) * Dm; };
        auto bcol = [&](int c) { return w_o + n0 + c; };
        auto epi = [&](f32x16 (&acc)[4][2], int seg, LAS char* Ls) {
            store_tile_bf16<4, 256>(Ls, acc, [&](int row, int c) -> bf16_t* { return y1 + (size_t)(m0 + row) * Dm + n0 + 8 * c; });
        };
        gemm_tile<4, 0, true>(L, Dm / 64, Dm, att, arow, bcol, epi);
    }
}

__device__ __forceinline__ void post_attn_tokens(const Params& p, int t0, int nper) {
    const int tid = otid(), lane = tid & 63, wave = tid >> 6;
    const float* x = p.in[0]; const float* pg = p.in[6]; const float* fg = p.in[18];
    const float* mod = (const float*)(p.ws + WS_MOD);
    const bf16_t* y1 = (const bf16_t*)(p.ws + WS_Y1);
    bf16_t* h2 = (bf16_t*)(p.ws + WS_H2);
    for (int i_ = 0; i_ < nper; ++i_) {
        const int t = t0 + wave + NW * i_;
        const int b = t / SEQ;
        const float* mb = mod + b * 6144;
        f32x4 yv[4], xv[4]; float ss = 0.f;
#pragma unroll
        for (int j = 0; j < 4; ++j) {
            const u32x2 raw = *(const u32x2*)(y1 + (size_t)t * Dm + 4 * (lane + 64 * j));
            yv[j] = (f32x4){bflo(raw.x), bfhi(raw.x), bflo(raw.y), bfhi(raw.y)};
            xv[j] = *(const f32x4*)(x + (size_t)t * Dm + 4 * (lane + 64 * j));
            ss += yv[j][0] * yv[j][0] + yv[j][1] * yv[j][1] + yv[j][2] * yv[j][2] + yv[j][3] * yv[j][3];
        }
        ss = wave_sum(ss, lane);
        const float rstd = rsqrtf(ss * (1.f / Dm) + 1e-6f);
        float ss2 = 0.f;
#pragma unroll
        for (int j = 0; j < 4; ++j) {
            const int col = 4 * (lane + 64 * j);
            const f32x4 gv = *(const f32x4*)(pg + col), ga = *(const f32x4*)(mb + 2048 + col);
#pragma unroll
            for (int e = 0; e < 4; ++e) { xv[j][e] = xv[j][e] + ga[e] * (yv[j][e] * rstd * gv[e]); ss2 += xv[j][e] * xv[j][e]; }
            *(f32x4*)(p.out + (size_t)t * Dm + col) = xv[j];
        }
        ss2 = wave_sum(ss2, lane);
        const float rstd2 = rsqrtf(ss2 * (1.f / Dm) + 1e-6f);
#pragma unroll
        for (int j = 0; j < 4; ++j) {
            const int col = 4 * (lane + 64 * j);
            const f32x4 gv = *(const f32x4*)(fg + col), sv = *(const f32x4*)(mb + 4096 + col), hv = *(const f32x4*)(mb + 3072 + col);
            float o[4];
#pragma unroll
            for (int e = 0; e < 4; ++e) o[e] = (xv[j][e] * rstd2 * gv[e]) * (1.f + sv[e]) + hv[e];
            u32x2 w; w.x = pk2(o[0], o[1]); w.y = pk2(o[2], o[3]);
            *(u32x2*)(h2 + (size_t)t * Dm + col) = w;
        }
    }
}

__device__ __forceinline__ unsigned fkey(float f) { const unsigned u = __float_as_uint(f); return (u & 0x80000000u) ? ~u : (u | 0x80000000u); }
template <int CTRL, int RM> __device__ __forceinline__ unsigned dppu(unsigned old, unsigned src) { return (unsigned)__builtin_amdgcn_update_dpp((int)old, (int)src, CTRL, RM, 0xf, false); }
template <int CTRL, int RM> __device__ __forceinline__ float dppf(float old, float src) { return __int_as_float(__builtin_amdgcn_update_dpp(__float_as_int(old), __float_as_int(src), CTRL, RM, 0xf, false)); }
__device__ __forceinline__ unsigned wave_umax(unsigned v) {
    v = max(v, dppu<0x111, 0xf>(v, v)); v = max(v, dppu<0x112, 0xf>(v, v)); v = max(v, dppu<0x114, 0xf>(v, v)); v = max(v, dppu<0x118, 0xf>(v, v));
    v = max(v, dppu<0x142, 0xa>(v, v)); v = max(v, dppu<0x143, 0xc>(v, v));
    return (unsigned)__builtin_amdgcn_readlane((int)v, 63);
}
__device__ __forceinline__ float wave_fsum_dpp(float v) {
    v += dppf<0x111, 0xf>(0.f, v); v += dppf<0x112, 0xf>(0.f, v); v += dppf<0x114, 0xf>(0.f, v); v += dppf<0x118, 0xf>(0.f, v);
    v += dppf<0x142, 0xa>(0.f, v); v += dppf<0x143, 0xc>(0.f, v);
    return __int_as_float(__builtin_amdgcn_readlane(__float_as_int(v), 63));
}
__device__ __forceinline__ void phase_router_route(const Params& p, LAS char* L) {
    const int v = vcu(), G = grid_g();
    const bf16_t* h2 = (const bf16_t*)(p.ws + WS_H2);
    const bf16_t* rw = (const bf16_t*)(p.ws + WS_WB) + WB_R;
    const float* rb = p.in[21];
    int* cnt = (int*)(p.ws + WS_CTL);
    int* la = (int*)(p.ws + WS_LA); float* lw = (float*)(p.ws + WS_LW);
    constexpr int LSTR = 1040;
    LAS int* pe = (LAS int*)(L + 69632);
    LAS float* pw = (LAS float*)(L + 69632 + 2048);
    LAS int* hist = (LAS int*)(L + 69632 + 4096);
    LAS int* basep = (LAS int*)(L + 69632 + 5120);
    for (int u = v; u < T / 64; u += G) {
        const int m0 = u * 64;
        post_attn_tokens(p, m0, 8);
        asm volatile("s_waitcnt vmcnt(0)" ::: "memory");
        __syncthreads();
        auto arow = [&](int r) { return (unsigned)(m0 + r) * Dm; };
        auto bcol = [&](int c) { return rw + c; };
        auto epi = [&](f32x16 (&acc)[1][2], int seg, LAS char* Ls) {
            const int tid_ = otid(), lane = tid_ & 63, wave = tid_ >> 6, wm = wave & 1, wn = wave >> 1, l31 = lane & 31, hi = lane >> 5;
            const int row = 32 * wm + l31;
#pragma unroll
            for (int ni = 0; ni < 2; ++ni)
#pragma unroll
                for (int gq = 0; gq < 4; ++gq) {
                    f32x4 w = {acc[0][ni][4 * gq], acc[0][ni][4 * gq + 1], acc[0][ni][4 * gq + 2], acc[0][ni][4 * gq + 3]};
                    *(LAS f32x4*)(L + row * LSTR + 4 * (nb_of<0>(wn, ni) + 8 * gq + 4 * hi)) = w;
                }
        };
        gemm_tile<1, 0, true>(L, Dm / 64, NE, h2, arow, bcol, epi);
        const int tid = otid(), lane = tid & 63, wave = tid >> 6;
        if (tid < 256) hist[tid] = 0;
        __syncthreads();
        const f32x4 bias = *(const f32x4*)(rb + 4 * lane);
        const int grp = lane >> 3;
#pragma unroll 1
        for (int tt = 0; tt < 8; ++tt) {
            const int tok = 8 * wave + tt;
            const f32x4 lgv = *(LAS f32x4*)(L + tok * LSTR + 16 * lane);
            const float s0 = 1.f / (1.f + __expf(-lgv[0])), s1 = 1.f / (1.f + __expf(-lgv[1])), s2 = 1.f / (1.f + __expf(-lgv[2])), s3 = 1.f / (1.f + __expf(-lgv[3]));
            float v0 = s0 + bias[0], v1 = s1 + bias[1], v2 = s2 + bias[2], v3 = s3 + bias[3];
            float t1 = fmaxf(v0, v1), t2 = fminf(v0, v1);
            { const float a = fmaxf(v2, v3), bq = fminf(v2, v3); const float n1 = fmaxf(t1, a), n2 = fmaxf(fminf(t1, a), fmaxf(t2, bq)); t1 = n1; t2 = n2; }
            { const float o1 = dppf<0xB1, 0xf>(t1, t1), o2 = dppf<0xB1, 0xf>(t2, t2); const float n1 = fmaxf(t1, o1), n2 = fmaxf(fminf(t1, o1), fmaxf(t2, o2)); t1 = n1; t2 = n2; }
            { const float o1 = dppf<0x4E, 0xf>(t1, t1), o2 = dppf<0x4E, 0xf>(t2, t2); const float n1 = fmaxf(t1, o1), n2 = fmaxf(fminf(t1, o1), fmaxf(t2, o2)); t1 = n1; t2 = n2; }
            { const float o1 = shx(t1, 4, lane), o2 = shx(t2, 4, lane); const float n1 = fmaxf(t1, o1), n2 = fmaxf(fminf(t1, o1), fmaxf(t2, o2)); t1 = n1; t2 = n2; }
            const float gs = t1 + t2;
            int rank = 0;
#pragma unroll
            for (int gg = 0; gg < 8; ++gg) { const float og = __int_as_float(__builtin_amdgcn_readlane(__float_as_int(gs), gg * 8)); rank += (og > gs || (og == gs && gg < grp)) ? 1 : 0; }
            if (rank >= 4) { v0 = -INFINITY; v1 = -INFINITY; v2 = -INFINITY; v3 = -INFINITY; }
            unsigned k0 = fkey(v0), k1 = fkey(v1), k2 = fkey(v2), k3 = fkey(v3);
            bool c0 = false, c1 = false, c2 = false, c3 = false;
#pragma unroll
            for (int it = 0; it < TOPK; ++it) {
                const unsigned lb = max(max(k0, k1), max(k2, k3));
                const unsigned m = wave_umax(lb);
                const unsigned long long bal = __ballot(lb == m);
                const int owner = __builtin_ctzll(bal);
                if (lane == owner) {
                    if (k0 == m) { k0 = 0u; c0 = true; } else if (k1 == m) { k1 = 0u; c1 = true; } else if (k2 == m) { k2 = 0u; c2 = true; } else { k3 = 0u; c3 = true; }
                }
            }
            const float wsum = wave_fsum_dpp((c0 ? s0 : 0.f) + (c1 ? s1 : 0.f) + (c2 ? s2 : 0.f) + (c3 ? s3 : 0.f));
            const float wnorm = 2.5f / wsum;
            const unsigned long long b0 = __ballot(c0), b1 = __ballot(c1), b2 = __ballot(c2), b3 = __ballot(c3);
            const unsigned long long lm = (1ull << lane) - 1ull;
            const int q0 = __builtin_popcountll(b0 & lm), a1 = __builtin_popcountll(b0);
            const int q1 = a1 + __builtin_popcountll(b1 & lm), a2 = a1 + __builtin_popcountll(b1);
            const int q2 = a2 + __builtin_popcountll(b2 & lm), a3 = a2 + __builtin_popcountll(b2);
            const int q3 = a3 + __builtin_popcountll(b3 & lm);
            if (c0) { pe[8 * tok + q0] = 4 * lane + 0; pw[8 * tok + q0] = s0 * wnorm; }
            if (c1) { pe[8 * tok + q1] = 4 * lane + 1; pw[8 * tok + q1] = s1 * wnorm; }
            if (c2) { pe[8 * tok + q2] = 4 * lane + 2; pw[8 * tok + q2] = s2 * wnorm; }
            if (c3) { pe[8 * tok + q3] = 4 * lane + 3; pw[8 * tok + q3] = s3 * wnorm; }
        }
        __syncthreads();
        const int my_e = pe[tid];
        const int my_rank = __hip_atomic_fetch_add(hist + my_e, 1, __ATOMIC_RELAXED, __HIP_MEMORY_SCOPE_WORKGROUP);
        __syncthreads();
        if (tid < 256) { const int n = hist[tid]; basep[tid] = n > 0 ? atomicAdd(cnt + tid, n) : 0; }
        __syncthreads();
        {
            const int pos = basep[my_e] + my_rank;
            if (pos < LISTCAP) { la[(size_t)my_e * LISTCAP + pos] = (m0 + (tid >> 3)) * TOPK + (tid & 7); lw[(size_t)my_e * LISTCAP + pos] = pw[tid]; }
        }
        __syncthreads();
    }
}

__device__ __forceinline__ int moe_cnt(const int* cnt, int e) { int c = (e < 256) ? cnt[e] : T; return c > LISTCAP ? LISTCAP : c; }
__device__ __forceinline__ void moe_prefix(const Params& p, LAS char* L) {
    const int tid = otid();
    const int* cnt = (const int*)(p.ws + WS_CTL);
    LAS int* pre = (LAS int*)(L + OFF_PRE);
    LAS int* tl = (LAS int*)(L + OFF_TL);
    __syncthreads();
    for (int i = tid; i < 257; i += NT) { const int c = moe_cnt(cnt, i); tl[i] = (c + 255) >> 8; }
    __syncthreads();
    if (tid == 0) { int s = 0; for (int i = 0; i < 257; ++i) { pre[i] = s; s += tl[i]; } pre[257] = s; }
    __syncthreads();
}
__device__ __forceinline__ int moe_find(LAS int* pre, int g) {
    int lo = 0, hi = 256;
    while (lo < hi) { const int mid = (lo + hi + 1) >> 1; if (pre[mid] <= g) lo = mid; else hi = mid - 1; }
    return lo;
}

template <int MI>
__device__ __forceinline__ void moe1_unit(const Params& p, LAS char* L, int e, int r0, int rows, int j0) {
    const bf16_t* h2 = (const bf16_t*)(p.ws + WS_H2);
    const int* la = (const int*)(p.ws + WS_LA);
    bf16_t* hb = (bf16_t*)(p.ws + WS_HB);
    const float* wg = (e < 256) ? p.in[22] + (size_t)e * Dm * 256 : p.in[25];
    const float* wu = (e < 256) ? p.in[23] + (size_t)e * Dm * 256 : p.in[26];
    LAS int* rowid = (LAS int*)(L + OFF_ROW);
    {
        const int tid = otid();
        if (tid < 64 * MI) { const int rr = tid < rows ? tid : 0; rowid[tid] = (e < 256) ? la[(size_t)e * LISTCAP + r0 + rr] : (AR + r0 + rr); }
        __syncthreads();
    }
    auto arow = [&](int r) { const int a = rowid[r]; const int tok = (e < 256) ? (a >> 3) : (a - AR); return (unsigned)tok * Dm; };
    auto bcol = [&](int c4) { return (c4 < 128) ? (wg + j0 + c4) : (wu + j0 + c4 - 128); };
    auto epi = [&](f32x16 (&acc)[MI][2], int seg, LAS char* Ls) {
#pragma unroll
        for (int mi = 0; mi < MI; ++mi)
#pragma unroll
            for (int r = 0; r < 16; ++r) acc[mi][0][r] = silu_f(acc[mi][0][r]) * acc[mi][1][r];
        store_tile_bf16<MI, 128>(Ls, acc, [&](int row, int c) -> bf16_t* { return row < rows ? hb + (size_t)rowid[row] * 256 + j0 + 8 * c : nullptr; });
    };
    gemm_tile<MI, 1>(L, Dm / 64, 256, h2, arow, bcol, epi);
}
__device__ __forceinline__ void phase_moe1(const Params& p, LAS char* L) {
    const int v = vcu(), G = grid_g();
    const int* cnt = (const int*)(p.ws + WS_CTL);
    moe_prefix(p, L);
    LAS int* pre = (LAS int*)(L + OFF_PRE);
    const int total = __builtin_amdgcn_readfirstlane(pre[257]) * 2;
    for (int u = v; u < total; u += G) {
        const int g = u >> 1, j0 = (u & 1) * 128;
        const int e = __builtin_amdgcn_readfirstlane(moe_find(pre, g)), mt = g - __builtin_amdgcn_readfirstlane(pre[e]);
        const int rows = __builtin_amdgcn_readfirstlane(moe_cnt(cnt, e)) - mt * 256;
        if (rows > 128) moe1_unit<4>(p, L, e, mt * 256, rows < 256 ? rows : 256, j0);
        else moe1_unit<2>(p, L, e, mt * 256, rows, j0);
    }
}

template <int MI>
__device__ __forceinline__ void moe2_unit(const Params& p, LAS char* L, int e, int r0, int rows, int n0) {
    const int* la = (const int*)(p.ws + WS_LA); const float* lw = (const float*)(p.ws + WS_LW);
    const bf16_t* hb = (const bf16_t*)(p.ws + WS_HB);
    unsigned char* yb = (unsigned char*)(p.ws + WS_YB);
    const float* wd = (e < 256) ? p.in[24] + (size_t)e * 256 * Dm : p.in[27];
    LAS int* rowid = (LAS int*)(L + OFF_ROW);
    LAS float* roww = (LAS float*)(L + OFF_RW);
    {
        const int tid = otid();
        if (tid < 64 * MI) {
            const int rr = tid < rows ? tid : 0;
            rowid[tid] = (e < 256) ? la[(size_t)e * LISTCAP + r0 + rr] : (AR + r0 + rr);
            roww[tid] = (e < 256) ? lw[(size_t)e * LISTCAP + r0 + rr] : 1.f;
        }
        __syncthreads();
    }
    auto arow = [&](int r) { return (unsigned)rowid[r] * 256; };
    auto bcol = [&](int c4) { return wd + n0 + c4; };
    auto epi = [&](f32x16 (&acc)[MI][2], int seg, LAS char* Ls) {
        const int tid_ = otid(), lane = tid_ & 63, wave = tid_ >> 6, wm = wave & 1, l31 = lane & 31;
#pragma unroll
        for (int mi = 0; mi < MI; ++mi) {
            const float w = roww[32 * MI * wm + 32 * mi + l31] * YSCALE;
#pragma unroll
            for (int ni = 0; ni < 2; ++ni)
#pragma unroll
                for (int q = 0; q < 16; ++q) acc[mi][ni][q] = __builtin_amdgcn_fmed3f(acc[mi][ni][q] * w, -448.f, 448.f);
        }
        store_tile_fp8<MI>(Ls, acc, [&](int row, int c) -> unsigned char* { return row < rows ? yb + (size_t)rowid[row] * Dm + n0 + seg * 256 + 16 * c : nullptr; });
    };
    gemm_tile<MI, 0, false, 2>(L, 256 / 64, Dm, hb, arow, bcol, epi);
}
__device__ __forceinline__ void phase_moe2(const Params& p, LAS char* L) {
    const int v = vcu(), G = grid_g();
    const int* cnt = (const int*)(p.ws + WS_CTL);
    moe_prefix(p, L);
    LAS int* pre = (LAS int*)(L + OFF_PRE);
    const int total = __builtin_amdgcn_readfirstlane(pre[257]) * 2;
    for (int u = v; u < total; u += G) {
        const int g = u >> 1, n0 = (u & 1) * 512;
        const int e = __builtin_amdgcn_readfirstlane(moe_find(pre, g)), mt = g - __builtin_amdgcn_readfirstlane(pre[e]);
        const int rows = __builtin_amdgcn_readfirstlane(moe_cnt(cnt, e)) - mt * 256;
        if (rows > 128) moe2_unit<4>(p, L, e, mt * 256, rows < 256 ? rows : 256, n0);
        else moe2_unit<2>(p, L, e, mt * 256, rows, n0);
    }
}

__device__ __forceinline__ void phase_final(const Params& p) {
    const int v = vcu(), G = grid_g();
    const int tid = otid(), lane = tid & 63, wave = tid >> 6;
    const float* pg = p.in[19];
    const float* mod = (const float*)(p.ws + WS_MOD);
    const unsigned char* yb = (const unsigned char*)(p.ws + WS_YB);
    for (int t = v * NW + wave; t < T; t += G * NW) {
        const int b = t / SEQ;
        const float* gf = mod + b * 6144 + 5120;
        float y[16];
#pragma unroll
        for (int e = 0; e < 16; ++e) y[e] = 0.f;
#pragma unroll
        for (int k = 0; k < 9; ++k) {
            const size_t row = (k < 8) ? ((size_t)t * TOPK + k) : ((size_t)AR + t);
            const u32x4 raw = *(const u32x4*)(yb + row * Dm + 16 * lane);
#pragma unroll
            for (int e = 0; e < 4; ++e) {
                const f32x2 a = __builtin_amdgcn_cvt_pk_f32_fp8((int)raw[e], false), c = __builtin_amdgcn_cvt_pk_f32_fp8((int)raw[e], true);
                y[4 * e] += a.x; y[4 * e + 1] += a.y; y[4 * e + 2] += c.x; y[4 * e + 3] += c.y;
            }
        }
        float ss = 0.f;
#pragma unroll
        for (int e = 0; e < 16; ++e) { y[e] *= (1.f / YSCALE); ss += y[e] * y[e]; }
        ss = wave_sum(ss, lane);
        const float rstd = rsqrtf(ss * (1.f / Dm) + 1e-6f);
        const int col = 16 * lane;
#pragma unroll
        for (int hq = 0; hq < 4; ++hq) {
            f32x4 xo = *(const f32x4*)(p.out + (size_t)t * Dm + col + 4 * hq);
            const f32x4 gv = *(const f32x4*)(pg + col + 4 * hq), gg = *(const f32x4*)(gf + col + 4 * hq);
#pragma unroll
            for (int e = 0; e < 4; ++e) xo[e] += gg[e] * (y[4 * hq + e] * rstd * gv[e]);
            *(f32x4*)(p.out + (size_t)t * Dm + col + 4 * hq) = xo;
        }
    }
}

#define XB_TMO      128
#define XB_XCNT(j)  (256  + 64 * (j))
#define XB_XSUB(j)  (1280 + 64 * (j))
#define XB_XGEN(j)  (2304 + 64 * (j))
#define XB_TOP      3328
#define XB_TOPGEN   3392
#define XCD_BAR_WORDS 3456
#define XB_SPIN_CAP (1u << 18)
__device__ __forceinline__ unsigned xb_ld(unsigned* p)              { return __hip_atomic_load(p, __ATOMIC_RELAXED, __HIP_MEMORY_SCOPE_AGENT); }
__device__ __forceinline__ unsigned xb_add(unsigned* p, unsigned v) { return __hip_atomic_fetch_add(p, v, __ATOMIC_RELAXED, __HIP_MEMORY_SCOPE_AGENT); }
__device__ __forceinline__ unsigned xb_xcc_id() { return (unsigned)__builtin_amdgcn_s_getreg((3 << 11) | 20) & 0xFu; }
#define XB_SPIN(cond, bar) do { unsigned _sp = 0; while (cond) { __builtin_amdgcn_s_sleep(1); \
    if ((++_sp & 255u) == 0u) { if (xb_ld(&(bar)[XB_TMO])) break; if (_sp > XB_SPIN_CAP) { atomicAdd(&(bar)[XB_TMO], 1u); break; } } } } while (0)
struct XcdBarrier { unsigned* bar; unsigned x; volatile LAS unsigned* st; };
__device__ __forceinline__ XcdBarrier xcd_barrier_post(unsigned* bar, volatile LAS unsigned* st) {
    XcdBarrier b; b.bar = bar; b.x = xb_xcc_id(); b.st = st;
    if (threadIdx.x == 0) (void)xb_add(&bar[XB_XCNT(b.x)], 1u);
    return b;
}
__device__ __forceinline__ void xcd_barrier_complete(unsigned* bar, unsigned x, unsigned& nloc, unsigned& nx) {
    const unsigned G = gridDim.x * gridDim.y * gridDim.z;
    unsigned sum, cnt, mine, sp = 0u;
    for (;;) {
        sum = 0u; cnt = 0u; mine = 0u;
#pragma unroll
        for (unsigned j = 0; j < 16; ++j) { const unsigned c = xb_ld(&bar[XB_XCNT(j)]); sum += c; cnt += (c > 0u) ? 1u : 0u; mine = (j == x) ? c : mine; }
        if (sum == G) break;
        __builtin_amdgcn_s_sleep(1);
        if ((++sp & 255u) == 0u) { if (xb_ld(&bar[XB_TMO])) break; if (sp > XB_SPIN_CAP) { atomicAdd(&bar[XB_TMO], 1u); break; } }
    }
    nloc = mine > 0u ? mine : 1u; nx = cnt > 0u ? cnt : 1u;
}
__device__ __forceinline__ void xcd_barrier(const Params& p, LAS char* L) {
    XcdBarrier b; b.bar = (unsigned*)(p.ws + WS_CTL + 4096); b.x = xb_xcc_id(); b.st = (volatile LAS unsigned*)(L + OFF_MISC);
    asm volatile("s_waitcnt vmcnt(0)" ::: "memory");
    __syncthreads();
    if (threadIdx.x == 0) {
        unsigned* bar = b.bar;
        __builtin_amdgcn_s_waitcnt(0);
        unsigned nloc = b.st[0], nx = b.st[1];
        if (nloc == 0u) { xcd_barrier_complete(bar, b.x, nloc, nx); b.st[0] = nloc; b.st[1] = nx; }
        const unsigned old = xb_add(&bar[XB_XSUB(b.x)], 1u);
        const unsigned gen = old / nloc;
        if (old + 1u == (gen + 1u) * nloc) {
            __builtin_amdgcn_fence(__ATOMIC_RELEASE, "agent");
            asm volatile("s_waitcnt vmcnt(0)" ::: "memory");
            const unsigned og = xb_add(&bar[XB_TOP], 1u);
            const unsigned tg = og / nx;
            if (og + 1u == (tg + 1u) * nx) xb_add(&bar[XB_TOPGEN], 1u);
            else XB_SPIN(xb_ld(&bar[XB_TOPGEN]) == tg, bar);
            __builtin_amdgcn_fence(__ATOMIC_ACQUIRE, "agent");
            xb_add(&bar[XB_XGEN(b.x)], 1u);
            asm volatile("s_waitcnt vmcnt(0)" ::: "memory");
        } else {
            XB_SPIN(xb_ld(&bar[XB_XGEN(b.x)]) == gen, bar);
            __builtin_amdgcn_fence(__ATOMIC_ACQUIRE, "agent");
            asm volatile("s_waitcnt vmcnt(0)" ::: "memory");
        }
    }
    __syncthreads();
}

__global__ void __launch_bounds__(NT, 2) mega(Params p) {
    extern __shared__ __attribute__((aligned(16))) char smem[];
    LAS char* L = (LAS char*)smem;
    if (threadIdx.x < 8) ((LAS unsigned*)(L + OFF_MISC))[threadIdx.x] = 0u;
    __syncthreads();
    (void)xcd_barrier_post((unsigned*)(p.ws + WS_CTL + 4096), (volatile LAS unsigned*)(L + OFF_MISC));
    phase_mod(p, L);
    xcd_barrier(p, L);
    phase_h1(p);
    xcd_barrier(p, L);
    phase_proj(p, L);
    xcd_barrier(p, L);
    phase_qkv(p, L);
    xcd_barrier(p, L);
    phase_attn(p, L);
    xcd_barrier(p, L);
    phase_oproj(p, L);
    xcd_barrier(p, L);
    phase_router_route(p, L);
    xcd_barrier(p, L);
    phase_moe1(p, L);
    xcd_barrier(p, L);
    phase_moe2(p, L);
    xcd_barrier(p, L);
    phase_final(p);
}

extern "C" void kernel_launch(void* const* d_in, const int* in_sizes, int n_in, void* d_out, int out_size, void* d_ws, size_t ws_size, hipStream_t stream) {
    static int grid_blocks = 0;
    if (grid_blocks == 0) {
        if (n_in != 28 || out_size != T * Dm || ws_size < WS_END) {
            fprintf(stderr, "kernel_launch: unexpected problem (n_in %d, out %d, ws %zu); nothing launched\n", n_in, out_size, ws_size);
            grid_blocks = -1; return;
        }
        int dev = 0, cus = 0, per_cu = 0;
        (void)hipGetDevice(&dev);
        (void)hipDeviceGetAttribute(&cus, hipDeviceAttributeMultiprocessorCount, dev);
        if (hipFuncSetAttribute((const void*)mega, hipFuncAttributeMaxDynamicSharedMemorySize, LDS_BYTES) != hipSuccess) {
            fprintf(stderr, "kernel_launch: hipFuncSetAttribute(%d B LDS) failed\n", LDS_BYTES); grid_blocks = -1; return;
        }
        (void)hipOccupancyMaxActiveBlocksPerMultiprocessor(&per_cu, mega, NT, LDS_BYTES);
        if (per_cu < 1) { fprintf(stderr, "kernel_launch: occupancy query says %d blocks per CU\n", per_cu); per_cu = 1; }
        grid_blocks = cus;
        fprintf(stderr, "kernel_launch: %d CUs, occupancy query %d per CU, grid %d\n", cus, per_cu, grid_blocks);
    }
    if (grid_blocks < 0) return;
    (void)hipMemsetAsync((char*)d_ws + WS_CTL, 0, CTL_BYTES, stream);
    Params p{};
    for (int i = 0; i < 28; ++i) p.in[i] = (const float*)d_in[i];
    p.out = (float*)d_out; p.ws = (char*)d_ws;
    void* args[] = {&p};
    hipError_t e = hipLaunchCooperativeKernel((void*)mega, dim3(grid_blocks), dim3(NT), args, LDS_BYTES, stream);
    if (e != hipSuccess) fprintf(stderr, "cooperative launch failed: %s (grid %d)\n", hipGetErrorString(e), grid_blocks);
}
```

```cpp
#include <hip/hip_runtime.h>
#include <cstdio>
#include <cstdint>


typedef unsigned short bf16_t;
typedef float f32x2 __attribute__((ext_vector_type(2)));
typedef short bf16x8 __attribute__((ext_vector_type(8)));
typedef short s16x4 __attribute__((ext_vector_type(4)));
typedef short v4i16_t __attribute__((ext_vector_type(4)));
typedef float f32x16 __attribute__((ext_vector_type(16)));
typedef float f32x4 __attribute__((ext_vector_type(4)));
typedef unsigned u32x4 __attribute__((ext_vector_type(4)));
typedef unsigned u32x2 __attribute__((ext_vector_type(2)));
#define LAS __attribute__((address_space(3)))

constexpr int NT = 512, NW = 8;
constexpr int Dm = 1024, NB = 8, SEQ = 2048, T = NB * SEQ;
constexpr int NIN = 1952;
constexpr int C_CQ = 0, C_CKV = 256, C_KR = 384, C_DQ = 416, C_DK = 928, C_DV = 1440;
constexpr int NE = 256, TOPK = 8, AR = T * TOPK, HROWS = AR + T;
constexpr int LISTCAP = T;
constexpr float LOG2E = 1.4426950408889634f;
constexpr float YSCALE = 32.f;
constexpr float LAMBDA_INIT = 0.2f;

constexpr size_t MiB = 1u << 20;
constexpr size_t WS_CTL = 0, CTL_BYTES = 65536;
constexpr size_t WS_MOD = 65536;
constexpr size_t WS_ROPE = 1 * MiB;
constexpr size_t WS_H1 = 4 * MiB;
constexpr size_t WS_PROJ = 36 * MiB;
constexpr size_t WS_CQN = 100 * MiB;
constexpr size_t WS_CKVN = 108 * MiB;
constexpr size_t WS_QM = 112 * MiB;
constexpr size_t WS_KF = 136 * MiB;
constexpr size_t WS_VM = 160 * MiB;
constexpr size_t WS_ATT = 176 * MiB;
constexpr size_t WS_OD0 = 208 * MiB;
constexpr size_t WS_Y1 = 240 * MiB;
constexpr size_t WS_H2 = 304 * MiB;
constexpr size_t WS_LOG = 336 * MiB;
constexpr size_t WS_LA = 352 * MiB;
constexpr size_t WS_LW = 368 * MiB;
constexpr size_t WS_HB = 384 * MiB;
constexpr size_t WS_YB = 456 * MiB;
constexpr size_t WS_WB = 744 * MiB;
constexpr size_t WB_IN = 0, WB_UQ = WB_IN + (size_t)1024 * 1952, WB_UKV = WB_UQ + 256 * 768, WB_O = WB_UKV + 128 * 1024, WB_R = WB_O + 1024 * 1024, WB_SG = WB_R + 1024 * 256, WB_SU = WB_SG + 1024 * 256, WB_SD = WB_SU + 1024 * 256, WB_END = WB_SD + 256 * 1024;
constexpr size_t WS_END = 760 * MiB;

constexpr int G_XB = 32768, G_WB = 36864, G_BUF = G_XB + G_WB, G_LDS = 2 * G_BUF;
constexpr int OFF_MISC = G_LDS, OFF_PRE = OFF_MISC + 64, OFF_TL = OFF_PRE + 1088;
constexpr int OFF_ROW = OFF_TL + 1088, OFF_RW = OFF_ROW + 1024;
constexpr int OFF_SS = OFF_RW + 1024;
constexpr int LDS_BYTES = G_LDS + 4352 + 4096;

struct Params {
    const float* in[28];
    float* out;
    char* ws;
};

__device__ __forceinline__ unsigned short f2bf(float f) { __bf16 b = (__bf16)f; return __builtin_bit_cast(unsigned short, b); }
typedef __bf16 bf16x2_t __attribute__((ext_vector_type(2)));
__device__ __forceinline__ unsigned pk2(float lo, float hi) { const f32x2 v = {lo, hi}; return __builtin_bit_cast(unsigned, __builtin_convertvector(v, bf16x2_t)); }
__device__ __forceinline__ float bf2f(unsigned short b) { return __uint_as_float(((unsigned)b) << 16); }
__device__ __forceinline__ float bflo(unsigned u) { return __uint_as_float(u << 16); }
__device__ __forceinline__ float bfhi(unsigned u) { return __uint_as_float(u & 0xffff0000u); }
__device__ __forceinline__ int crow(int r, int hi) { return (r & 3) + 8 * (r >> 2) + 4 * hi; }
__device__ __forceinline__ float shx(float v, int m, int lane) { return __int_as_float(__builtin_amdgcn_ds_bpermute((lane ^ m) << 2, __float_as_int(v))); }
__device__ __forceinline__ int shxi(int v, int m, int lane) { return __builtin_amdgcn_ds_bpermute((lane ^ m) << 2, v); }
__device__ __forceinline__ float shl(float v, int src) { return __int_as_float(__builtin_amdgcn_ds_bpermute(src << 2, __float_as_int(v))); }
__device__ __forceinline__ float wave_sum(float v, int lane) {
#pragma unroll
    for (int o = 32; o >= 1; o >>= 1) v += shx(v, o, lane);
    return v;
}
__device__ __forceinline__ float silu_f(float v) { return v / (1.f + __expf(-v)); }
__device__ __forceinline__ s16x4 tr_read(LAS char* p) {
    return __builtin_bit_cast(s16x4, __builtin_amdgcn_ds_read_tr16_b64_v4i16((LAS v4i16_t*)p));
}
__device__ __forceinline__ int otid() { int t = threadIdx.x; asm volatile("" : "+v"(t)); return t; }
__device__ __forceinline__ int grid_g() { return gridDim.x; }
__device__ __forceinline__ int vcu() { const int G = gridDim.x, bx = blockIdx.x; return (G % 8 == 0) ? (bx % 8) * (G / 8) + bx / 8 : bx; }
__device__ __forceinline__ void gld16(u32x4& d, const void* p) { asm volatile("global_load_dwordx4 %0, %1, off" : "+v"(d) : "v"(p) : "memory"); }
__device__ __forceinline__ void gld16(f32x4& d, const void* p) { asm volatile("global_load_dwordx4 %0, %1, off" : "+v"(d) : "v"(p) : "memory"); }
template <int N> __device__ __forceinline__ void vm_wait(u32x4& a, f32x4& b, f32x4& c) { asm volatile("s_waitcnt vmcnt(%3)" : "+v"(a), "+v"(b), "+v"(c) : "n"(N) : "memory"); }
template <int N> __device__ __forceinline__ void vm_wait(f32x4& b, f32x4& c) { asm volatile("s_waitcnt vmcnt(%2)" : "+v"(b), "+v"(c) : "n"(N) : "memory"); }
template <int N> __device__ __forceinline__ void vm_wait(u32x4& a, u32x4& b) { asm volatile("s_waitcnt vmcnt(%2)" : "+v"(a), "+v"(b) : "n"(N) : "memory"); }
template <int N> __device__ __forceinline__ void vm_wait(u32x4& b) { asm volatile("s_waitcnt vmcnt(%1)" : "+v"(b) : "n"(N) : "memory"); }
#define MFMA32(a, b, c) __builtin_amdgcn_mfma_f32_32x32x16_bf16(a, b, c, 0, 0, 0)

template <int NBMODE> __device__ __forceinline__ int nb_of(int wn, int ni) { return NBMODE == 0 ? 64 * wn + 32 * ni : 32 * wn + 128 * ni; }

template <int MI, int NBMODE, bool WBF = false, int NSEG = 1, class AF, class BF, class EF>
__device__ __forceinline__ void gemm_tile(LAS char* L, int nk, long ldw, const bf16_t* abase, AF arow, BF bcol, EF epi) {
    asm volatile("" : "+s"(nk));
    const int tid = otid(), lane = tid & 63, wave = tid >> 6;
    const int wm = wave & 1, wn = wave >> 1, l31 = lane & 31, hi = lane >> 5;
    const int a_chunk = tid & 7, a_row = tid >> 3;
    const int a_w = a_row * 128 + 16 * (a_chunk ^ ((a_row >> 1) & 7));
    const int b_n4 = WBF ? (tid & 31) : (tid & 63), b_kr = WBF ? (tid >> 5) : (tid >> 6);
    const auto bp = bcol((WBF ? 8 : 4) * b_n4) + (long)b_kr * ldw;
    const int b_w = G_XB + b_kr * 576 + (WBF ? 16 : 8) * b_n4;
    const int sw = (l31 >> 1) & 7;
    const int xoff = (32 * MI * wm + l31) * 128;
    const int woff = G_XB + (8 * hi + ((lane & 15) >> 2)) * 576 + 2 * (16 * ((lane >> 4) & 1) + 4 * (lane & 3));
    u32x4 ra[MI]; f32x4 rb[8]; u32x4 rw[4];
#pragma unroll
    for (int i = 0; i < MI; ++i) ra[i] = (u32x4){0u, 0u, 0u, 0u};
#pragma unroll
    for (int i = 0; i < 8; ++i) rb[i] = (f32x4){0.f, 0.f, 0.f, 0.f};
#pragma unroll
    for (int i = 0; i < 4; ++i) rw[i] = (u32x4){0u, 0u, 0u, 0u};
#define G_LOADW(KOFF, Q, SEGC) do { \
        if (WBF) { gld16(rw[Q], bp + (long)((KOFF) + 16 * (Q)) * ldw + (SEGC)); } \
        else { gld16(rb[2 * (Q)], bp + (long)((KOFF) + 16 * (Q)) * ldw + (SEGC)); gld16(rb[2 * (Q) + 1], bp + (long)((KOFF) + 16 * (Q) + 8) * ldw + (SEGC)); } } while (0)
#define G_LOADQ(KT, Q) do { \
        if ((Q) < MI) gld16(ra[(Q) < MI ? (Q) : 0], abase + arow(a_row + 64 * (Q)) + a_chunk * 8 + (KT) * 64); \
        G_LOADW((KT) * 64, Q, 0); } while (0)
#define G_LOADQ_SEL(KT, SEG, Q, OK) do { \
        const int kq_ = (OK) ? (KT) * 64 : 0; const int sc_ = (OK) ? (SEG) * 256 : 0; \
        if ((Q) < MI) gld16(ra[(Q) < MI ? (Q) : 0], abase + arow(a_row + 64 * (Q)) + a_chunk * 8 + kq_); \
        G_LOADW(kq_, Q, sc_); } while (0)
#define G_WAITQ(Q, N) do { \
        if (WBF) { if ((Q) < MI) vm_wait<N>(ra[(Q) < MI ? (Q) : 0], rw[Q]); else vm_wait<N>(rw[Q]); } \
        else { if ((Q) < MI) vm_wait<N>(ra[(Q) < MI ? (Q) : 0], rb[2 * (Q)], rb[2 * (Q) + 1]); else vm_wait<N>(rb[2 * (Q)], rb[2 * (Q) + 1]); } } while (0)
#define G_STOREQ(LP, Q) do { \
        if ((Q) < MI) *(LAS u32x4*)((LP) + a_w + (Q) * 8192) = ra[(Q) < MI ? (Q) : 0]; \
        if (WBF) { *(LAS u32x4*)((LP) + b_w + (Q) * 16 * 576) = rw[Q]; } else { \
        { u32x2 w; w.x = pk2(rb[2 * (Q)][0], rb[2 * (Q)][1]); w.y = pk2(rb[2 * (Q)][2], rb[2 * (Q)][3]); *(LAS u32x2*)((LP) + b_w + (Q) * 16 * 576) = w; } \
        { u32x2 w; w.x = pk2(rb[2 * (Q) + 1][0], rb[2 * (Q) + 1][1]); w.y = pk2(rb[2 * (Q) + 1][2], rb[2 * (Q) + 1][3]); *(LAS u32x2*)((LP) + b_w + (Q) * 16 * 576 + 8 * 576) = w; } } } while (0)
    constexpr int NLW = WBF ? 1 : 2;
    constexpr int NL0 = NLW + ((0 < MI) ? 1 : 0), NL1 = NLW + ((1 < MI) ? 1 : 0), NL2 = NLW + ((2 < MI) ? 1 : 0), NL3 = NLW + ((3 < MI) ? 1 : 0), NLT = NL0 + NL1 + NL2 + NL3;
    G_LOADQ(0, 0); G_LOADQ(0, 1); G_LOADQ(0, 2); G_LOADQ(0, 3);
    G_WAITQ(0, 0); G_WAITQ(1, 0); G_WAITQ(2, 0); G_WAITQ(3, 0);
    G_STOREQ(L, 0); G_STOREQ(L, 1); G_STOREQ(L, 2); G_STOREQ(L, 3);
    G_LOADQ(1, 0); G_LOADQ(1, 1); G_LOADQ(1, 2); G_LOADQ(1, 3);
    f32x16 acc[MI][2];
#pragma unroll
    for (int i = 0; i < MI; ++i)
#pragma unroll
        for (int j = 0; j < 2; ++j)
#pragma unroll
            for (int r = 0; r < 16; ++r) acc[i][j][r] = 0.f;
    __syncthreads();
    const int nt_all = nk * NSEG;
    int lk = (nk == 2) ? 0 : 2, lseg = (nk == 2) ? 1 : 0;
    int ck = 0, cseg = 0;
#pragma nounroll
    for (int kt = 0; kt < nt_all; ++kt) {
        LAS char* Lb = L + (kt & 1) * G_BUF;
        LAS char* Ln = L + ((kt + 1) & 1) * G_BUF;
        const bool ld = kt + 2 < nt_all;
        bf16x8 xf[2][MI], wf[2][2];
#define LOAD_FRAGS(KS, B) do { \
            _Pragma("unroll") for (int mi = 0; mi < MI; ++mi) xf[B][mi] = *(LAS bf16x8*)(Lb + xoff + mi * 4096 + 16 * ((2 * (KS) + hi) ^ sw)); \
            _Pragma("unroll") for (int ni = 0; ni < 2; ++ni) { \
                LAS char* pp = Lb + woff + (KS) * 16 * 576 + 2 * nb_of<NBMODE>(wn, ni); \
                const s16x4 lo = tr_read(pp), h4 = tr_read(pp + 4 * 576); \
                wf[B][ni] = (bf16x8){lo[0], lo[1], lo[2], lo[3], h4[0], h4[1], h4[2], h4[3]}; } } while (0)
#define MMA_STEP(KS) do { \
            _Pragma("unroll") for (int mi = 0; mi < MI; ++mi) \
                _Pragma("unroll") for (int ni = 0; ni < 2; ++ni) acc[mi][ni] = MFMA32(wf[(KS) & 1][ni], xf[(KS) & 1][mi], acc[mi][ni]); } while (0)
#define STAGE_STEP(Q, NREST, NPREV) do { G_WAITQ(Q, (NREST) + (NPREV)); G_STOREQ(Ln, Q); G_LOADQ_SEL(lk, lseg, Q, ld); } while (0)
        LOAD_FRAGS(0, 0);
        LOAD_FRAGS(1, 1); MMA_STEP(0); STAGE_STEP(0, NL1 + NL2 + NL3, 0);           __builtin_amdgcn_sched_barrier(0);
        LOAD_FRAGS(2, 0); MMA_STEP(1); STAGE_STEP(1, NL2 + NL3, NL0);               __builtin_amdgcn_sched_barrier(0);
        LOAD_FRAGS(3, 1); MMA_STEP(2); STAGE_STEP(2, NL3, NL0 + NL1);               __builtin_amdgcn_sched_barrier(0);
        MMA_STEP(3);                   STAGE_STEP(3, 0, NL0 + NL1 + NL2);           __builtin_amdgcn_sched_barrier(0);
#undef LOAD_FRAGS
#undef MMA_STEP
#undef STAGE_STEP
        __syncthreads();
        if (++lk == nk) { lk = 0; ++lseg; }
        if (NSEG > 1) {
            if (++ck == nk) {
                ck = 0;
                if (cseg + 1 < NSEG) {
                    epi(acc, cseg, L + (kt & 1) * G_BUF);
#pragma unroll
                    for (int i = 0; i < MI; ++i)
#pragma unroll
                        for (int j = 0; j < 2; ++j)
#pragma unroll
                            for (int r = 0; r < 16; ++r) acc[i][j][r] = 0.f;
                }
                ++cseg;
            }
        }
    }
    G_WAITQ(0, 0); G_WAITQ(1, 0); G_WAITQ(2, 0); G_WAITQ(3, 0);
#undef G_LOADQ
#undef G_LOADQ_SEL
#undef G_LOADW
#undef G_WAITQ
#undef G_STOREQ
    (void)NLT;
    epi(acc, NSEG - 1, L);
}

template <int MI, int NC, class DF>
__device__ __forceinline__ void store_tile_bf16(LAS char* L, const f32x16 (&acc)[MI][2], DF dst) {
    constexpr int STR = NC * 2 + 16, CPR = NC / 8, BM = 64 * MI;
    const int tid = otid(), lane = tid & 63, wave = tid >> 6, wm = wave & 1, wn = wave >> 1, l31 = lane & 31, hi = lane >> 5;
#pragma unroll
    for (int mi = 0; mi < MI; ++mi)
#pragma unroll
        for (int ni = 0; ni < (NC == 256 ? 2 : 1); ++ni) {
            const int row = 32 * MI * wm + 32 * mi + l31, col = (NC == 256) ? nb_of<0>(wn, ni) : 32 * wn;
#pragma unroll
            for (int gq = 0; gq < 4; ++gq) {
                u32x2 w; w.x = pk2(acc[mi][ni][4 * gq], acc[mi][ni][4 * gq + 1]); w.y = pk2(acc[mi][ni][4 * gq + 2], acc[mi][ni][4 * gq + 3]);
                *(LAS u32x2*)(L + row * STR + 2 * (col + 8 * gq + 4 * hi)) = w;
            }
        }
    __syncthreads();
#pragma unroll
    for (int i = 0; i < (BM * CPR) / NT; ++i) {
        const int id = tid + NT * i, row = id / CPR, c = id % CPR;
        bf16_t* d = dst(row, c);
        if (d) *(u32x4*)d = *(LAS u32x4*)(L + row * STR + 16 * c);
    }
    __syncthreads();
}

template <int MI, class DF>
__device__ __forceinline__ void store_tile_fp8(LAS char* L, const f32x16 (&acc)[MI][2], DF dst) {
    constexpr int STR = 256 + 16, BM = 64 * MI;
    const int tid = otid(), lane = tid & 63, wave = tid >> 6, wm = wave & 1, wn = wave >> 1, l31 = lane & 31, hi = lane >> 5;
#pragma unroll
    for (int mi = 0; mi < MI; ++mi)
#pragma unroll
        for (int ni = 0; ni < 2; ++ni) {
            const int row = 32 * MI * wm + 32 * mi + l31, col = nb_of<0>(wn, ni);
#pragma unroll
            for (int gq = 0; gq < 4; ++gq) {
                int w = 0;
                w = __builtin_amdgcn_cvt_pk_fp8_f32(acc[mi][ni][4 * gq], acc[mi][ni][4 * gq + 1], w, false);
                w = __builtin_amdgcn_cvt_pk_fp8_f32(acc[mi][ni][4 * gq + 2], acc[mi][ni][4 * gq + 3], w, true);
                *(LAS int*)(L + row * STR + (col + 8 * gq + 4 * hi)) = w;
            }
        }
    __syncthreads();
#pragma unroll
    for (int i = 0; i < (BM * 16) / NT; ++i) {
        const int id = tid + NT * i, row = id >> 4, c = id & 15;
        unsigned char* d = dst(row, c);
        if (d) *(u32x4*)d = *(LAS u32x4*)(L + row * STR + 16 * c);
    }
    __syncthreads();
}

__device__ __forceinline__ void phase_mod(const Params& p, LAS char* L) {
    const int v = vcu(), G = grid_g();
    const int tid = otid();
    const float* c = p.in[1]; const float* w_ada = p.in[3]; const float* b_ada = p.in[4];
    float* mod = (float*)(p.ws + WS_MOD);
    LAS float* sc = (LAS float*)L;
    LAS float* red = (LAS float*)(L + 32768);
    bool filled = false;
    for (int item = v; item < 384; item += G) {
        if (!filled) {
            for (int i = tid; i < 8 * 1024; i += NT) sc[i] = silu_f(c[i]);
            __syncthreads(); filled = true;
        }
        const int cx = tid & 15, kl = tid >> 4, col = item * 16 + cx;
        float a[8];
#pragma unroll
        for (int b = 0; b < 8; ++b) a[b] = 0.f;
#pragma unroll 4
        for (int k = kl; k < 1024; k += 32) {
            const float w = w_ada[(size_t)k * 6144 + col];
#pragma unroll
            for (int b = 0; b < 8; ++b) a[b] += sc[b * 1024 + k] * w;
        }
#pragma unroll
        for (int b = 0; b < 8; ++b) red[(b * 32 + kl) * 16 + cx] = a[b];
        __syncthreads();
        if (tid < 128) {
            const int b = tid >> 4, cc = tid & 15; float s = 0.f;
#pragma unroll
            for (int k = 0; k < 32; ++k) s += red[(b * 32 + k) * 16 + cc];
            mod[b * 6144 + item * 16 + cc] = s + b_ada[item * 16 + cc];
        }
        __syncthreads();
    }
    {
        bf16_t* wb = (bf16_t*)(p.ws + WS_WB);
        const size_t gt = (size_t)v * NT + tid, gs = (size_t)G * NT;
        auto conv = [&](const float* src, size_t off, size_t n) {
            for (size_t i = gt; i < n / 4; i += gs) { const f32x4 f = *(const f32x4*)(src + 4 * i); u32x2 w; w.x = pk2(f[0], f[1]); w.y = pk2(f[2], f[3]); *(u32x2*)(wb + off + 4 * i) = w; }
        };
        auto convg = [&](const float* src, size_t off, size_t n, int ncol, const float* gain) {
            for (size_t i = gt; i < n / 4; i += gs) { const float gk = gain[(4 * i) / ncol]; const f32x4 f = *(const f32x4*)(src + 4 * i); u32x2 w; w.x = pk2(f[0] * gk, f[1] * gk); w.y = pk2(f[2] * gk, f[3] * gk); *(u32x2*)(wb + off + 4 * i) = w; }
        };
        conv(p.in[7], WB_IN, (size_t)1024 * 1952); convg(p.in[10], WB_UQ, (size_t)256 * 768, 768, p.in[8]); convg(p.in[11], WB_UKV, (size_t)128 * 1024, 1024, p.in[9]);
        conv(p.in[17], WB_O, (size_t)1024 * 1024); conv(p.in[20], WB_R, (size_t)1024 * 256);
        conv(p.in[25], WB_SG, (size_t)1024 * 256); conv(p.in[26], WB_SU, (size_t)1024 * 256); conv(p.in[27], WB_SD, (size_t)256 * 1024);
    }
}

__device__ __forceinline__ void phase_h1(const Params& p) {
    const int v = vcu(), G = grid_g();
    const int tid = otid(), lane = tid & 63, wave = tid >> 6;
    const float* x = p.in[0]; const int* positions = (const int*)p.in[2]; const float* g = p.in[5];
    const float* mod = (const float*)(p.ws + WS_MOD);
    bf16_t* h1 = (bf16_t*)(p.ws + WS_H1);
    f32x2* rope = (f32x2*)(p.ws + WS_ROPE);
    for (int t = v * NW + wave; t < T; t += G * NW) {
        const int b = t / SEQ;
        const f32x4* xr = (const f32x4*)(x + (size_t)t * Dm);
        f32x4 xv[4]; float ss = 0.f;
#pragma unroll
        for (int j = 0; j < 4; ++j) { xv[j] = xr[lane + 64 * j]; ss += xv[j][0] * xv[j][0] + xv[j][1] * xv[j][1] + xv[j][2] * xv[j][2] + xv[j][3] * xv[j][3]; }
        ss = wave_sum(ss, lane);
        const float rstd = rsqrtf(ss * (1.f / Dm) + 1e-6f);
        const float* sh = mod + b * 6144; const float* scl = sh + 1024;
#pragma unroll
        for (int j = 0; j < 4; ++j) {
            const int col = 4 * (lane + 64 * j);
            const f32x4 gv = *(const f32x4*)(g + col), sv = *(const f32x4*)(scl + col), hv = *(const f32x4*)(sh + col);
            float o[4];
#pragma unroll
            for (int e = 0; e < 4; ++e) o[e] = (xv[j][e] * rstd * gv[e]) * (1.f + sv[e]) + hv[e];
            u32x2 w; w.x = pk2(o[0], o[1]); w.y = pk2(o[2], o[3]);
            *(u32x2*)(h1 + (size_t)t * Dm + col) = w;
        }
        if (lane < 16) {
            const double inv = exp2(-(double)lane * (13.287712379549449 / 16.0));
            const double rev = (double)positions[t] * inv * 0.15915494309189535;
            const float fr = (float)(rev - rint(rev));
            f32x2 cs; cs.x = __builtin_amdgcn_cosf(fr); cs.y = __builtin_amdgcn_sinf(fr);
            rope[(size_t)t * 16 + lane] = cs;
        }
    }
}

__device__ __forceinline__ void phase_proj(const Params& p, LAS char* L) {
    const int v = vcu(), G = grid_g();
    const bf16_t* h1 = (const bf16_t*)(p.ws + WS_H1);
    const bf16_t* w_in = (const bf16_t*)(p.ws + WS_WB) + WB_IN;
    bf16_t* proj = (bf16_t*)(p.ws + WS_PROJ);
    const f32x2* rope = (const f32x2*)(p.ws + WS_ROPE);
    for (int u = v; u < 64 * 8; u += G) {
        const int mt = u >> 3, nt = u & 7, m0 = mt * 256, n0 = nt * 256;
        auto arow = [&](int r) { return (unsigned)(m0 + r) * Dm; };
        auto bcol = [&](int c) { int col = n0 + c; if (col > NIN - 8) col = NIN - 8; return w_in + col; };
        auto epi = [&](f32x16 (&acc)[4][2], int seg, LAS char* Ls) {
            const int tid_ = otid(), lane = tid_ & 63, wave = tid_ >> 6, wm = wave & 1, wn = wave >> 1, l31 = lane & 31, hi = lane >> 5;
            if (nt < 2) {
                LAS float* ssl = (LAS float*)(L + OFF_SS);
                const bool contrib = (nt == 0) || (wn < 2);
#pragma unroll
                for (int mi = 0; mi < 4; ++mi) {
                    float part = 0.f;
#pragma unroll
                    for (int ni = 0; ni < 2; ++ni)
#pragma unroll
                        for (int r = 0; r < 16; ++r) part += acc[mi][ni][r] * acc[mi][ni][r];
                    part += shx(part, 32, lane);
                    if (hi == 0) ssl[(128 * wm + 32 * mi + l31) * 4 + wn] = contrib ? part : 0.f;
                }
                __syncthreads();
                if (tid_ < 256) {
                    const f32x4 q4 = *(LAS f32x4*)(ssl + tid_ * 4);
                    const float ssum = (q4[0] + q4[1]) + (q4[2] + q4[3]);
                    float* rs = (float*)(p.ws + WS_CQN) + (nt == 0 ? 0 : (1 << 18));
                    rs[m0 + tid_] = rsqrtf(ssum * (nt == 0 ? 1.f / 256.f : 1.f / 128.f) + 1e-6f);
                }
            }
#pragma unroll
            for (int ni = 0; ni < 2; ++ni) {
                const int nbg = n0 + nb_of<0>(wn, ni);
                if (nbg == C_KR) {
#pragma unroll
                    for (int mi = 0; mi < 4; ++mi) {
                        const int m = m0 + 128 * wm + 32 * mi + l31;
#pragma unroll
                        for (int r = 0; r < 8; ++r) {
                            const f32x2 cs = rope[(size_t)m * 16 + crow(r, hi)];
                            const float x1 = acc[mi][ni][r], x2 = acc[mi][ni][r + 8];
                            acc[mi][ni][r] = x1 * cs.x - x2 * cs.y; acc[mi][ni][r + 8] = x2 * cs.x + x1 * cs.y;
                        }
                    }
                }
                if (nbg >= C_DQ && nbg < C_DK) {
#pragma unroll
                    for (int mi = 0; mi < 4; ++mi)
#pragma unroll
                        for (int r = 0; r < 16; ++r) acc[mi][ni][r] *= 0.125f * LOG2E;
                }
            }
            store_tile_bf16<4, 256>(Ls, acc, [&](int row, int c) -> bf16_t* { const int col = n0 + 8 * c; return col < NIN ? proj + (size_t)(m0 + row) * NIN + col : nullptr; });
        };
        gemm_tile<4, 0, true>(L, Dm / 64, NIN, h1, arow, bcol, epi);
    }
}

__device__ __forceinline__ void phase_qkv(const Params& p, LAS char* L) {
    const int v = vcu(), G = grid_g();
    const bf16_t* proj = (const bf16_t*)(p.ws + WS_PROJ);
    const float* rstd_q = (const float*)(p.ws + WS_CQN); const float* rstd_kv = rstd_q + (1 << 18);
    const bf16_t* w_uq = (const bf16_t*)(p.ws + WS_WB) + WB_UQ; const bf16_t* w_ukv = (const bf16_t*)(p.ws + WS_WB) + WB_UKV;
    bf16_t* qm = (bf16_t*)(p.ws + WS_QM); bf16_t* kf = (bf16_t*)(p.ws + WS_KF); bf16_t* vm = (bf16_t*)(p.ws + WS_VM);
    const f32x2* rope = (const f32x2*)(p.ws + WS_ROPE);
    const float qscale = LOG2E * 0.10206207261596575f;
    for (int u = v; u < 64 * 7; u += G) {
        const int mt = u / 7, j = u % 7, m0 = mt * 256;
        if (j < 3) {
            const int n0 = j * 256;
            auto arow = [&](int r) { return (unsigned)(m0 + r) * NIN + C_CQ; };
            auto bcol = [&](int c) { return w_uq + n0 + c; };
            auto epi = [&](f32x16 (&acc)[4][2], int seg, LAS char* Ls) {
                const int tid_ = otid(), lane = tid_ & 63, wave = tid_ >> 6, wm = wave & 1, wn = wave >> 1, l31 = lane & 31, hi = lane >> 5;
#pragma unroll
                for (int mi = 0; mi < 4; ++mi) {
                    const int m = m0 + 128 * wm + 32 * mi + l31;
                    const float qs = qscale * rstd_q[m];
#pragma unroll
                    for (int ni = 0; ni < 2; ++ni) {
                        const int nbg = n0 + nb_of<0>(wn, ni);
                        if ((nbg % 96) == 64) {
#pragma unroll
                            for (int r = 0; r < 8; ++r) {
                                const f32x2 cs = rope[(size_t)m * 16 + crow(r, hi)];
                                const float x1 = acc[mi][ni][r], x2 = acc[mi][ni][r + 8];
                                acc[mi][ni][r] = x1 * cs.x - x2 * cs.y; acc[mi][ni][r + 8] = x2 * cs.x + x1 * cs.y;
                            }
                        }
#pragma unroll
                        for (int r = 0; r < 16; ++r) acc[mi][ni][r] *= qs;
                    }
                }
                store_tile_bf16<4, 256>(Ls, acc, [&](int row, int c) -> bf16_t* { return qm + (size_t)(m0 + row) * 768 + n0 + 8 * c; });
            };
            gemm_tile<4, 0, true>(L, 256 / 64, 768, proj, arow, bcol, epi);
        } else {
            const int n0 = (j - 3) * 256;
            auto arow = [&](int r) { return (unsigned)(m0 + r) * NIN + C_CKV; };
            auto bcol = [&](int c) { return w_ukv + n0 + c; };
            auto epi = [&](f32x16 (&acc)[4][2], int seg, LAS char* Ls) {
                {
                    const int tid_ = otid(), lane = tid_ & 63, wave = tid_ >> 6, wm = wave & 1, l31 = lane & 31;
#pragma unroll
                    for (int mi = 0; mi < 4; ++mi) {
                        const float rs = rstd_kv[m0 + 128 * wm + 32 * mi + l31];
#pragma unroll
                        for (int ni = 0; ni < 2; ++ni)
#pragma unroll
                            for (int r = 0; r < 16; ++r) acc[mi][ni][r] *= rs;
                    }
                }
                store_tile_bf16<4, 256>(Ls, acc, [&](int row, int c) -> bf16_t* {
                    const int h = (n0 >> 7) + (c >> 4), cc = c & 15;
                    return cc < 8 ? kf + (size_t)(m0 + row) * 768 + h * 96 + 8 * cc : vm + (size_t)(m0 + row) * 512 + h * 64 + 8 * (cc - 8); });
            };
            gemm_tile<4, 0, true>(L, 128 / 64, 1024, proj, arow, bcol, epi);
        }
    }
}

template <int DQK, int DV, bool ALIBI>
__device__ __forceinline__ void attn_map(LAS char* L, const bf16_t* Q, int ldq, const bf16_t* K, int ldk, const bf16_t* V, int ldv,
                                         const int* posrow, float slope2, int q0, f32x16 (&o)[DV / 32], const bf16_t* K2 = nullptr, int ldk2 = 0) {
    constexpr int KSTR = DQK * 2 + 16, VSTR = DV * 2 + 64, KS = DQK / 16, ND = DV / 32;
    constexpr int K_OFF = 0, V_OFF = 64 * KSTR, P_OFF = V_OFF + 64 * VSTR, ABUF = P_OFF + 256;
    constexpr int KCH = DQK / 8, VCH = DV / 8;
    constexpr int NKI = (64 * KCH + NT - 1) / NT, NVI = (64 * VCH + NT - 1) / NT;
    static_assert(3 * ABUF <= G_LDS, "attention ring");
    const int tid = otid();
    const int lane = tid & 63, wave = tid >> 6, l31 = lane & 31, hi = lane >> 5;
    const int qrow = q0 + 32 * wave + l31;
    unsigned kgo[NKI], klo[NKI], vgo[NVI], vlo[NVI];
    bool k2s[NKI];
#pragma unroll
    for (int i = 0; i < NKI; ++i) { int c = tid + NT * i; if (c >= 64 * KCH) c = 64 * KCH - 1; const int row = c / KCH, ch = c % KCH; k2s[i] = (DQK == 96) && (ch >= 8);
        kgo[i] = k2s[i] ? (unsigned)(row * ldk2 + (ch - 8) * 8) * 2u : (unsigned)(row * ldk + ch * 8) * 2u; klo[i] = K_OFF + row * KSTR + ch * 16; }
#pragma unroll
    for (int i = 0; i < NVI; ++i) { int c = tid + NT * i; if (c >= 64 * VCH) c = 64 * VCH - 1; const int row = c / VCH, ch = c % VCH; vgo[i] = (unsigned)(row * ldv + ch * 8) * 2u; vlo[i] = V_OFF + row * VSTR + ch * 16; }
    bf16x8 qf[KS];
#pragma unroll
    for (int s = 0; s < KS; ++s) qf[s] = *(const bf16x8*)(Q + (size_t)qrow * ldq + 16 * s + 8 * hi);
    const float posq = ALIBI ? (float)posrow[qrow] : 0.f;
#pragma unroll
    for (int d = 0; d < ND; ++d)
#pragma unroll
        for (int r = 0; r < 16; ++r) o[d][r] = 0.f;
    float m_run = -1e30f, l_run = 0.f;
    const int ntile = (q0 + 256) / 64;
    const int qmin = q0 + 32 * wave, qmax = qmin + 31;
    const int vrd = V_OFF + (4 * hi + ((lane & 15) >> 2)) * VSTR + 2 * (16 * ((lane >> 4) & 1) + 4 * (lane & 3));
    u32x4 rk[NKI], rv[NVI]; float rp = 0.f;
#define A_LOAD(T) do { \
        const char* kbase_ = (const char*)(K + (size_t)(T) * 64 * ldk); const char* kbase2_ = (const char*)(K2 + (size_t)(T) * 64 * ldk2); \
        const char* vbase_ = (const char*)(V + (size_t)(T) * 64 * ldv); \
        _Pragma("unroll") for (int i = 0; i < NKI; ++i) rk[i] = *(const u32x4*)((k2s[i] ? kbase2_ : kbase_) + kgo[i]); \
        _Pragma("unroll") for (int i = 0; i < NVI; ++i) rv[i] = *(const u32x4*)(vbase_ + vgo[i]); \
        if (ALIBI && tid < 64) rp = (float)posrow[(T) * 64 + tid]; } while (0)
#define A_STORE(LP) do { \
        _Pragma("unroll") for (int i = 0; i < NKI; ++i) if (tid + NT * i < 64 * KCH) *(LAS u32x4*)((LP) + klo[i]) = rk[i]; \
        _Pragma("unroll") for (int i = 0; i < NVI; ++i) if (tid + NT * i < 64 * VCH) *(LAS u32x4*)((LP) + vlo[i]) = rv[i]; \
        if (ALIBI && tid < 64) *(LAS float*)((LP) + P_OFF + 4 * tid) = rp; } while (0)
#define A_KFRAG(DST, LP, S_) do { DST[0] = *(LAS bf16x8*)((LP) + K_OFF + l31 * KSTR + 32 * (S_) + 16 * hi); DST[1] = *(LAS bf16x8*)((LP) + K_OFF + (32 + l31) * KSTR + 32 * (S_) + 16 * hi); } while (0)
#define A_SCORES(S0, S1, LP, KB) do { \
        bf16x8 kfa_[2], kfb_[2]; \
        A_KFRAG(kfa_, LP, 0); \
        _Pragma("unroll") for (int s = 0; s < KS; s += 2) {        \
            if (s + 1 < KS) A_KFRAG(kfb_, LP, s + 1); \
            if (s == 0) { S0 = MFMA32(kfa_[0], qf[0], z16); S1 = MFMA32(kfa_[1], qf[0], z16); }         \
            else { S0 = MFMA32(kfa_[0], qf[s], S0); S1 = MFMA32(kfa_[1], qf[s], S1); } \
            __builtin_amdgcn_sched_barrier(0); \
            if (s + 1 < KS) { \
                if (s + 2 < KS) A_KFRAG(kfa_, LP, s + 2); \
                S0 = MFMA32(kfb_[0], qf[s + 1], S0); S1 = MFMA32(kfb_[1], qf[s + 1], S1); \
                __builtin_amdgcn_sched_barrier(0); } } \
        if (ALIBI) { \
            _Pragma("unroll") for (int g4 = 0; g4 < 4; ++g4) { \
                const f32x4 pk0_ = *(LAS f32x4*)((LP) + P_OFF + 4 * (8 * g4 + 4 * hi)), pk1_ = *(LAS f32x4*)((LP) + P_OFF + 4 * (32 + 8 * g4 + 4 * hi)); \
                _Pragma("unroll") for (int e = 0; e < 4; ++e) { S0[4 * g4 + e] -= slope2 * fabsf(posq - pk0_[e]); S1[4 * g4 + e] -= slope2 * fabsf(posq - pk1_[e]); } } } \
        if ((KB) + 63 > qmin) { \
            _Pragma("unroll") for (int r = 0; r < 16; ++r) { const int key_ = (KB) + crow(r, hi); if (key_ > qrow) S0[r] = -INFINITY; if (key_ + 32 > qrow) S1[r] = -INFINITY; } } } while (0)
#define A_VFRAG(DST, LP, S_) do { _Pragma("unroll") for (int d = 0; d < ND; ++d) { \
            LAS char* vp_ = (LP) + vrd + 16 * (S_) * VSTR + 64 * d; const s16x4 lo_ = tr_read(vp_), h4_ = tr_read(vp_ + 8 * VSTR); \
            DST[d] = (bf16x8){lo_[0], lo_[1], lo_[2], lo_[3], h4_[0], h4_[1], h4_[2], h4_[3]}; } } while (0)
#define A_SOFTMAX_PV(S0, S1, LP) do { \
        bf16x8 vfa_[ND], vfb_[ND]; \
        A_VFRAG(vfa_, LP, 0);                                       \
        float mxa_ = S0[0], mxb_ = S0[8], mxc_ = S1[0], mxd_ = S1[8];          \
        _Pragma("unroll") for (int r = 1; r < 8; ++r) { mxa_ = fmaxf(mxa_, S0[r]); mxb_ = fmaxf(mxb_, S0[8 + r]); mxc_ = fmaxf(mxc_, S1[r]); mxd_ = fmaxf(mxd_, S1[8 + r]); } \
        float mx_ = fmaxf(fmaxf(mxa_, mxb_), fmaxf(mxc_, mxd_)); \
        { const auto rr_ = __builtin_amdgcn_permlane32_swap(__float_as_uint(mx_), __float_as_uint(mx_), false, false); mx_ = fmaxf(__uint_as_float(rr_[0]), __uint_as_float(rr_[1])); }     \
        if (__any(mx_ > m_run + 8.f)) { \
            const float m_new_ = fmaxf(m_run, mx_); const float alpha_ = __builtin_amdgcn_exp2f(m_run - m_new_); m_run = m_new_; l_run *= alpha_; \
            _Pragma("unroll") for (int d = 0; d < ND; ++d) _Pragma("unroll") for (int r = 0; r < 16; ++r) o[d][r] *= alpha_; } \
        float lsa_ = 0.f, lsb_ = 0.f, lsc_ = 0.f, lsd_ = 0.f; \
        _Pragma("unroll") for (int r = 0; r < 16; ++r) { S0[r] = __builtin_amdgcn_exp2f(S0[r] - m_run); S1[r] = __builtin_amdgcn_exp2f(S1[r] - m_run); } \
        _Pragma("unroll") for (int r = 0; r < 8; ++r) { lsa_ += S0[r]; lsb_ += S0[8 + r]; lsc_ += S1[r]; lsd_ += S1[8 + r]; } \
        l_run += (lsa_ + lsb_) + (lsc_ + lsd_); \
        u32x4 pw_[4]; \
        _Pragma("unroll") for (int j = 0; j < 4; ++j) { \
            pw_[0][j] = pk2(S0[2 * j], S0[2 * j + 1]); pw_[1][j] = pk2(S0[8 + 2 * j], S0[8 + 2 * j + 1]); \
            pw_[2][j] = pk2(S1[2 * j], S1[2 * j + 1]); pw_[3][j] = pk2(S1[8 + 2 * j], S1[8 + 2 * j + 1]); } \
        __builtin_amdgcn_sched_barrier(0); \
        A_VFRAG(vfb_, LP, 1); \
        _Pragma("unroll") for (int d = 0; d < ND; ++d) o[d] = MFMA32(vfa_[d], __builtin_bit_cast(bf16x8, pw_[0]), o[d]); \
        __builtin_amdgcn_sched_barrier(0); \
        A_VFRAG(vfa_, LP, 2); \
        _Pragma("unroll") for (int d = 0; d < ND; ++d) o[d] = MFMA32(vfb_[d], __builtin_bit_cast(bf16x8, pw_[1]), o[d]); \
        __builtin_amdgcn_sched_barrier(0); \
        A_VFRAG(vfb_, LP, 3); \
        _Pragma("unroll") for (int d = 0; d < ND; ++d) o[d] = MFMA32(vfa_[d], __builtin_bit_cast(bf16x8, pw_[2]), o[d]); \
        __builtin_amdgcn_sched_barrier(0); \
        _Pragma("unroll") for (int d = 0; d < ND; ++d) o[d] = MFMA32(vfb_[d], __builtin_bit_cast(bf16x8, pw_[3]), o[d]); \
        __builtin_amdgcn_sched_barrier(0); } while (0)
    A_LOAD(0);
    __syncthreads();
    A_STORE(L);
    A_LOAD(1);
    A_STORE(L + ABUF);
    __syncthreads();
    const f32x16 z16 = {0.f, 0.f, 0.f, 0.f, 0.f, 0.f, 0.f, 0.f, 0.f, 0.f, 0.f, 0.f, 0.f, 0.f, 0.f, 0.f};
    f32x16 sa0, sa1, sb0, sb1;
    A_SCORES(sa0, sa1, L, 0);
    int bc = 0;
#define A_STEP(TL, C0, C1, N0, N1) do { \
        const int kb_ = (TL) * 64; \
        const int bn_ = (bc == 2) ? 0 : bc + 1, bnn_ = (bn_ == 2) ? 0 : bn_ + 1; \
        LAS char* Lc_ = L + bc * ABUF; LAS char* Ln_ = L + bn_ * ABUF; LAS char* Lnn_ = L + bnn_ * ABUF; \
        const bool more2_ = (TL) + 2 < ntile; \
        if (more2_) A_LOAD((TL) + 2); \
        const bool act_c_ = kb_ <= qmax, act_n_ = ((TL) + 1 < ntile) && (kb_ + 64 <= qmax); \
        if (act_n_) {                  \
            A_SCORES(N0, N1, Ln_, kb_ + 64); \
            A_SOFTMAX_PV(C0, C1, Lc_); \
        } else if (act_c_) { \
            A_SOFTMAX_PV(C0, C1, Lc_); \
        } \
        if (more2_) A_STORE(Lnn_); \
        __syncthreads(); \
        bc = bn_; } while (0)
    for (int tl = 0; tl < ntile; tl += 2) {
        A_STEP(tl, sa0, sa1, sb0, sb1);
        A_STEP(tl + 1, sb0, sb1, sa0, sa1);
    }
#undef A_STEP
#undef A_LOAD
#undef A_STORE
#undef A_SCORES
#undef A_SOFTMAX_PV
#undef A_KFRAG
#undef A_VFRAG
    const float lt = l_run + shx(l_run, 32, lane);
    const float inv = 1.f / lt;
#pragma unroll
    for (int d = 0; d < ND; ++d)
#pragma unroll
        for (int r = 0; r < 16; ++r) o[d][r] *= inv;
}

__device__ __forceinline__ void attn_decode(int it, int& kind, int& qb, int& idx) {
    const int seg_kind[16] = {1, 1, 1, 1, 1, 0, 1, 0, 0, 0, 1, 0, 0, 1, 0, 0};
    const int seg_qb[16]   = {7, 6, 5, 4, 3, 7, 2, 6, 5, 4, 1, 3, 2, 0, 1, 0};
    int base = 0; kind = 0; qb = 0; idx = 0;
#pragma unroll
    for (int s = 0; s < 16; ++s) {
        const int n = seg_kind[s] ? 32 : 64;
        if (it >= base && it < base + n) { kind = seg_kind[s]; qb = seg_qb[s]; idx = it - base; }
        base += n;
    }
}

__device__ __forceinline__ void phase_attn(const Params& p, LAS char* L) {
    const int v = vcu(), G = grid_g();
    const int tid = otid(), lane = tid & 63, wave = tid >> 6, l31 = lane & 31, hi = lane >> 5;
    const int* positions = (const int*)p.in[2];
    const bf16_t* proj = (const bf16_t*)(p.ws + WS_PROJ);
    const bf16_t* qm = (const bf16_t*)(p.ws + WS_QM); const bf16_t* kf = (const bf16_t*)(p.ws + WS_KF); const bf16_t* vm = (const bf16_t*)(p.ws + WS_VM);
    bf16_t* att = (bf16_t*)(p.ws + WS_ATT);
    float* od0 = (float*)(p.ws + WS_OD0);
    const float* subg = p.in[16];
    unsigned* qctr = (unsigned*)(p.ws + WS_CTL + 2048);
    LAS unsigned* qslot = (LAS unsigned*)(L + OFF_MISC + 16);
    float lam;
    {
        const float a = p.in[12][lane] * p.in[13][lane], b = p.in[14][lane] * p.in[15][lane];
        lam = __expf(wave_sum(a, lane)) - __expf(wave_sum(b, lane)) + LAMBDA_INIT;
    }
    for (;;) {
        if (tid == 0) *qslot = __hip_atomic_fetch_add(qctr, 1u, __ATOMIC_RELAXED, __HIP_MEMORY_SCOPE_AGENT);
        __syncthreads();
        const int it = (int)*qslot;
        __syncthreads();
        if (it >= 768) break;
        int kind, qb, idx;
        attn_decode(it, kind, qb, idx);
        const int q0 = qb * 256;
        if (kind == 0) {
            const int b = idx >> 3, h = idx & 7; const size_t tb = (size_t)b * SEQ;
            f32x16 o[2];
            attn_map<96, 64, false>(L, qm + tb * 768 + h * 96, 768, kf + tb * 768 + h * 96, 768, vm + tb * 512 + h * 64, 512, positions + tb, 0.f, q0, o, proj + tb * NIN + C_KR, NIN);
            const size_t t = tb + q0 + 32 * wave + l31;
#pragma unroll
            for (int d = 0; d < 2; ++d)
#pragma unroll
                for (int gq = 0; gq < 4; ++gq) {
                    u32x2 w; w.x = pk2(o[d][4 * gq], o[d][4 * gq + 1]); w.y = pk2(o[d][4 * gq + 2], o[d][4 * gq + 3]);
                    *(u32x2*)(att + t * 1024 + h * 64 + 32 * d + 8 * gq + 4 * hi) = w;
                }
        } else {
            const int b = idx >> 2, h = idx & 3; const size_t tb = (size_t)b * SEQ;
            const float slope2 = exp2f(-2.f * (h + 1)) * LOG2E;
            const size_t t = tb + q0 + 32 * wave + l31;
            f32x16 o[4];
            attn_map<64, 128, true>(L, proj + tb * NIN + C_DQ + h * 128, NIN, proj + tb * NIN + C_DK + h * 128, NIN, proj + tb * NIN + C_DV + h * 128, NIN, positions + tb, slope2, q0, o);
#pragma unroll
            for (int d = 0; d < 4; ++d)
#pragma unroll
                for (int gq = 0; gq < 4; ++gq) {
                    f32x4 w = {o[d][4 * gq], o[d][4 * gq + 1], o[d][4 * gq + 2], o[d][4 * gq + 3]};
                    *(f32x4*)(od0 + t * 512 + h * 128 + 32 * d + 8 * gq + 4 * hi) = w;
                }
            attn_map<64, 128, true>(L, proj + tb * NIN + C_DQ + h * 128 + 64, NIN, proj + tb * NIN + C_DK + h * 128 + 64, NIN, proj + tb * NIN + C_DV + h * 128, NIN, positions + tb, slope2, q0, o);
            float ss = 0.f;
#pragma unroll
            for (int d = 0; d < 4; ++d)
#pragma unroll
                for (int gq = 0; gq < 4; ++gq) {
                    const f32x4 w = *(const f32x4*)(od0 + t * 512 + h * 128 + 32 * d + 8 * gq + 4 * hi);
#pragma unroll
                    for (int e = 0; e < 4; ++e) { const float c = w[e] - lam * o[d][4 * gq + e]; o[d][4 * gq + e] = c; ss += c * c; }
                }
            ss += shx(ss, 32, lane);
            const float rstd = rsqrtf(ss * (1.f / 128.f) + 1e-5f) * (1.f - LAMBDA_INIT);
#pragma unroll
            for (int d = 0; d < 4; ++d)
#pragma unroll
                for (int gq = 0; gq < 4; ++gq) {
                    const int dv = 32 * d + 8 * gq + 4 * hi;
                    const f32x4 gv = *(const f32x4*)(subg + dv);
                    u32x2 w; w.x = pk2(o[d][4 * gq] * rstd * gv[0], o[d][4 * gq + 1] * rstd * gv[1]); w.y = pk2(o[d][4 * gq + 2] * rstd * gv[2], o[d][4 * gq + 3] * rstd * gv[3]);
                    *(u32x2*)(att + t * 1024 + 512 + h * 128 + dv) = w;
                }
        }
    }
}

__device__ __forceinline__ void phase_oproj(const Params& p, LAS char* L) {
    const int v = vcu(), G = grid_g();
    const bf16_t* att = (const bf16_t*)(p.ws + WS_ATT);
    const bf16_t* w_o = (const bf16_t*)(p.ws + WS_WB) + WB_O;
    bf16_t* y1 = (bf16_t*)(p.ws + WS_Y1);
    for (int u = v; u < 64 * 4; u += G) {
        const int mt = u >> 2, nt = u & 3, m0 = mt * 256, n0 = nt * 256;
        auto arow = [&](int r) { return (unsigned)(m0 + r) * Dm; };
        auto bcol = [&](int c) { return w_o + n0 + c; };
        auto epi = [&](f32x16 (&acc)[4][2], int seg, LAS char* Ls) {
            store_tile_bf16<4, 256>(Ls, acc, [&](int row, int c) -> bf16_t* { return y1 + (size_t)(m0 + row) * Dm + n0 + 8 * c; });
        };
        gemm_tile<4, 0, true>(L, Dm / 64, Dm, att, arow, bcol, epi);
    }
}

__device__ __forceinline__ void post_attn_tokens(const Params& p, int t0, int nper) {
    const int tid = otid(), lane = tid & 63, wave = tid >> 6;
    const float* x = p.in[0]; const float* pg = p.in[6]; const float* fg = p.in[18];
    const float* mod = (const float*)(p.ws + WS_MOD);
    const bf16_t* y1 = (const bf16_t*)(p.ws + WS_Y1);
    bf16_t* h2 = (bf16_t*)(p.ws + WS_H2);
    for (int i_ = 0; i_ < nper; ++i_) {
        const int t = t0 + wave + NW * i_;
        const int b = t / SEQ;
        const float* mb = mod + b * 6144;
        f32x4 yv[4], xv[4]; float ss = 0.f;
#pragma unroll
        for (int j = 0; j < 4; ++j) {
            const u32x2 raw = *(const u32x2*)(y1 + (size_t)t * Dm + 4 * (lane + 64 * j));
            yv[j] = (f32x4){bflo(raw.x), bfhi(raw.x), bflo(raw.y), bfhi(raw.y)};
            xv[j] = *(const f32x4*)(x + (size_t)t * Dm + 4 * (lane + 64 * j));
            ss += yv[j][0] * yv[j][0] + yv[j][1] * yv[j][1] + yv[j][2] * yv[j][2] + yv[j][3] * yv[j][3];
        }
        ss = wave_sum(ss, lane);
        const float rstd = rsqrtf(ss * (1.f / Dm) + 1e-6f);
        float ss2 = 0.f;
#pragma unroll
        for (int j = 0; j < 4; ++j) {
            const int col = 4 * (lane + 64 * j);
            const f32x4 gv = *(const f32x4*)(pg + col), ga = *(const f32x4*)(mb + 2048 + col);
#pragma unroll
            for (int e = 0; e < 4; ++e) { xv[j][e] = xv[j][e] + ga[e] * (yv[j][e] * rstd * gv[e]); ss2 += xv[j][e] * xv[j][e]; }
            *(f32x4*)(p.out + (size_t)t * Dm + col) = xv[j];
        }
        ss2 = wave_sum(ss2, lane);
        const float rstd2 = rsqrtf(ss2 * (1.f / Dm) + 1e-6f);
#pragma unroll
        for (int j = 0; j < 4; ++j) {
            const int col = 4 * (lane + 64 * j);
            const f32x4 gv = *(const f32x4*)(fg + col), sv = *(const f32x4*)(mb + 4096 + col), hv = *(const f32x4*)(mb + 3072 + col);
            float o[4];
#pragma unroll
            for (int e = 0; e < 4; ++e) o[e] = (xv[j][e] * rstd2 * gv[e]) * (1.f + sv[e]) + hv[e];
            u32x2 w; w.x = pk2(o[0], o[1]); w.y = pk2(o[2], o[3]);
            *(u32x2*)(h2 + (size_t)t * Dm + col) = w;
        }
    }
}

__device__ __forceinline__ unsigned fkey(float f) { const unsigned u = __float_as_uint(f); return (u & 0x80000000u) ? ~u : (u | 0x80000000u); }
template <int CTRL, int RM> __device__ __forceinline__ unsigned dppu(unsigned old, unsigned src) { return (unsigned)__builtin_amdgcn_update_dpp((int)old, (int)src, CTRL, RM, 0xf, false); }
template <int CTRL, int RM> __device__ __forceinline__ float dppf(float old, float src) { return __int_as_float(__builtin_amdgcn_update_dpp(__float_as_int(old), __float_as_int(src), CTRL, RM, 0xf, false)); }
__device__ __forceinline__ unsigned wave_umax(unsigned v) {
    v = max(v, dppu<0x111, 0xf>(v, v)); v = max(v, dppu<0x112, 0xf>(v, v)); v = max(v, dppu<0x114, 0xf>(v, v)); v = max(v, dppu<0x118, 0xf>(v, v));
    v = max(v, dppu<0x142, 0xa>(v, v)); v = max(v, dppu<0x143, 0xc>(v, v));
    return (unsigned)__builtin_amdgcn_readlane((int)v, 63);
}
__device__ __forceinline__ float wave_fsum_dpp(float v) {
    v += dppf<0x111, 0xf>(0.f, v); v += dppf<0x112, 0xf>(0.f, v); v += dppf<0x114, 0xf>(0.f, v); v += dppf<0x118, 0xf>(0.f, v);
    v += dppf<0x142, 0xa>(0.f, v); v += dppf<0x143, 0xc>(0.f, v);
    return __int_as_float(__builtin_amdgcn_readlane(__float_as_int(v), 63));
}
__device__ __forceinline__ void phase_router_route(const Params& p, LAS char* L) {
    const int v = vcu(), G = grid_g();
    const bf16_t* h2 = (const bf16_t*)(p.ws + WS_H2);
    const bf16_t* rw = (const bf16_t*)(p.ws + WS_WB) + WB_R;
    const float* rb = p.in[21];
    int* cnt = (int*)(p.ws + WS_CTL);
    int* la = (int*)(p.ws + WS_LA); float* lw = (float*)(p.ws + WS_LW);
    constexpr int LSTR = 1040;
    LAS int* pe = (LAS int*)(L + 69632);
    LAS float* pw = (LAS float*)(L + 69632 + 2048);
    LAS int* hist = (LAS int*)(L + 69632 + 4096);
    LAS int* basep = (LAS int*)(L + 69632 + 5120);
    for (int u = v; u < T / 64; u += G) {
        const int m0 = u * 64;
        post_attn_tokens(p, m0, 8);
        asm volatile("s_waitcnt vmcnt(0)" ::: "memory");
        __syncthreads();
        auto arow = [&](int r) { return (unsigned)(m0 + r) * Dm; };
        auto bcol = [&](int c) { return rw + c; };
        auto epi = [&](f32x16 (&acc)[1][2], int seg, LAS char* Ls) {
            const int tid_ = otid(), lane = tid_ & 63, wave = tid_ >> 6, wm = wave & 1, wn = wave >> 1, l31 = lane & 31, hi = lane >> 5;
            const int row = 32 * wm + l31;
#pragma unroll
            for (int ni = 0; ni < 2; ++ni)
#pragma unroll
                for (int gq = 0; gq < 4; ++gq) {
                    f32x4 w = {acc[0][ni][4 * gq], acc[0][ni][4 * gq + 1], acc[0][ni][4 * gq + 2], acc[0][ni][4 * gq + 3]};
                    *(LAS f32x4*)(L + row * LSTR + 4 * (nb_of<0>(wn, ni) + 8 * gq + 4 * hi)) = w;
                }
        };
        gemm_tile<1, 0, true>(L, Dm / 64, NE, h2, arow, bcol, epi);
        const int tid = otid(), lane = tid & 63, wave = tid >> 6;
        if (tid < 256) hist[tid] = 0;
        __syncthreads();
        const f32x4 bias = *(const f32x4*)(rb + 4 * lane);
        const int grp = lane >> 3;
#pragma unroll 1
        for (int tt = 0; tt < 8; ++tt) {
            const int tok = 8 * wave + tt;
            const f32x4 lgv = *(LAS f32x4*)(L + tok * LSTR + 16 * lane);
            const float s0 = 1.f / (1.f + __expf(-lgv[0])), s1 = 1.f / (1.f + __expf(-lgv[1])), s2 = 1.f / (1.f + __expf(-lgv[2])), s3 = 1.f / (1.f + __expf(-lgv[3]));
            float v0 = s0 + bias[0], v1 = s1 + bias[1], v2 = s2 + bias[2], v3 = s3 + bias[3];
            float t1 = fmaxf(v0, v1), t2 = fminf(v0, v1);
            { const float a = fmaxf(v2, v3), bq = fminf(v2, v3); const float n1 = fmaxf(t1, a), n2 = fmaxf(fminf(t1, a), fmaxf(t2, bq)); t1 = n1; t2 = n2; }
            { const float o1 = dppf<0xB1, 0xf>(t1, t1), o2 = dppf<0xB1, 0xf>(t2, t2); const float n1 = fmaxf(t1, o1), n2 = fmaxf(fminf(t1, o1), fmaxf(t2, o2)); t1 = n1; t2 = n2; }
            { const float o1 = dppf<0x4E, 0xf>(t1, t1), o2 = dppf<0x4E, 0xf>(t2, t2); const float n1 = fmaxf(t1, o1), n2 = fmaxf(fminf(t1, o1), fmaxf(t2, o2)); t1 = n1; t2 = n2; }
            { const float o1 = shx(t1, 4, lane), o2 = shx(t2, 4, lane); const float n1 = fmaxf(t1, o1), n2 = fmaxf(fminf(t1, o1), fmaxf(t2, o2)); t1 = n1; t2 = n2; }
            const float gs = t1 + t2;
            int rank = 0;
#pragma unroll
            for (int gg = 0; gg < 8; ++gg) { const float og = __int_as_float(__builtin_amdgcn_readlane(__float_as_int(gs), gg * 8)); rank += (og > gs || (og == gs && gg < grp)) ? 1 : 0; }
            if (rank >= 4) { v0 = -INFINITY; v1 = -INFINITY; v2 = -INFINITY; v3 = -INFINITY; }
            unsigned k0 = fkey(v0), k1 = fkey(v1), k2 = fkey(v2), k3 = fkey(v3);
            bool c0 = false, c1 = false, c2 = false, c3 = false;
#pragma unroll
            for (int it = 0; it < TOPK; ++it) {
                const unsigned lb = max(max(k0, k1), max(k2, k3));
                const unsigned m = wave_umax(lb);
                const unsigned long long bal = __ballot(lb == m);
                const int owner = __builtin_ctzll(bal);
                if (lane == owner) {
                    if (k0 == m) { k0 = 0u; c0 = true; } else if (k1 == m) { k1 = 0u; c1 = true; } else if (k2 == m) { k2 = 0u; c2 = true; } else { k3 = 0u; c3 = true; }
                }
            }
            const float wsum = wave_fsum_dpp((c0 ? s0 : 0.f) + (c1 ? s1 : 0.f) + (c2 ? s2 : 0.f) + (c3 ? s3 : 0.f));
            const float wnorm = 2.5f / wsum;
            const unsigned long long b0 = __ballot(c0), b1 = __ballot(c1), b2 = __ballot(c2), b3 = __ballot(c3);
            const unsigned long long lm = (1ull << lane) - 1ull;
            const int q0 = __builtin_popcountll(b0 & lm), a1 = __builtin_popcountll(b0);
            const int q1 = a1 + __builtin_popcountll(b1 & lm), a2 = a1 + __builtin_popcountll(b1);
            const int q2 = a2 + __builtin_popcountll(b2 & lm), a3 = a2 + __builtin_popcountll(b2);
            const int q3 = a3 + __builtin_popcountll(b3 & lm);
            if (c0) { pe[8 * tok + q0] = 4 * lane + 0; pw[8 * tok + q0] = s0 * wnorm; }
            if (c1) { pe[8 * tok + q1] = 4 * lane + 1; pw[8 * tok + q1] = s1 * wnorm; }
            if (c2) { pe[8 * tok + q2] = 4 * lane + 2; pw[8 * tok + q2] = s2 * wnorm; }
            if (c3) { pe[8 * tok + q3] = 4 * lane + 3; pw[8 * tok + q3] = s3 * wnorm; }
        }
        __syncthreads();
        const int my_e = pe[tid];
        const int my_rank = __hip_atomic_fetch_add(hist + my_e, 1, __ATOMIC_RELAXED, __HIP_MEMORY_SCOPE_WORKGROUP);
        __syncthreads();
        if (tid < 256) { const int n = hist[tid]; basep[tid] = n > 0 ? atomicAdd(cnt + tid, n) : 0; }
        __syncthreads();
        {
            const int pos = basep[my_e] + my_rank;
            if (pos < LISTCAP) { la[(size_t)my_e * LISTCAP + pos] = (m0 + (tid >> 3)) * TOPK + (tid & 7); lw[(size_t)my_e * LISTCAP + pos] = pw[tid]; }
        }
        __syncthreads();
    }
}

__device__ __forceinline__ int moe_cnt(const int* cnt, int e) { int c = (e < 256) ? cnt[e] : T; return c > LISTCAP ? LISTCAP : c; }
__device__ __forceinline__ void moe_prefix(const Params& p, LAS char* L) {
    const int tid = otid();
    const int* cnt = (const int*)(p.ws + WS_CTL);
    LAS int* pre = (LAS int*)(L + OFF_PRE);
    LAS int* tl = (LAS int*)(L + OFF_TL);
    __syncthreads();
    for (int i = tid; i < 257; i += NT) { const int c = moe_cnt(cnt, i); tl[i] = (c + 255) >> 8; }
    __syncthreads();
    if (tid == 0) { int s = 0; for (int i = 0; i < 257; ++i) { pre[i] = s; s += tl[i]; } pre[257] = s; }
    __syncthreads();
}
__device__ __forceinline__ int moe_find(LAS int* pre, int g) {
    int lo = 0, hi = 256;
    while (lo < hi) { const int mid = (lo + hi + 1) >> 1; if (pre[mid] <= g) lo = mid; else hi = mid - 1; }
    return lo;
}

template <int MI>
__device__ __forceinline__ void moe1_unit(const Params& p, LAS char* L, int e, int r0, int rows, int j0) {
    const bf16_t* h2 = (const bf16_t*)(p.ws + WS_H2);
    const int* la = (const int*)(p.ws + WS_LA);
    bf16_t* hb = (bf16_t*)(p.ws + WS_HB);
    const float* wg = (e < 256) ? p.in[22] + (size_t)e * Dm * 256 : p.in[25];
    const float* wu = (e < 256) ? p.in[23] + (size_t)e * Dm * 256 : p.in[26];
    LAS int* rowid = (LAS int*)(L + OFF_ROW);
    {
        const int tid = otid();
        if (tid < 64 * MI) { const int rr = tid < rows ? tid : 0; rowid[tid] = (e < 256) ? la[(size_t)e * LISTCAP + r0 + rr] : (AR + r0 + rr); }
        __syncthreads();
    }
    auto arow = [&](int r) { const int a = rowid[r]; const int tok = (e < 256) ? (a >> 3) : (a - AR); return (unsigned)tok * Dm; };
    auto bcol = [&](int c4) { return (c4 < 128) ? (wg + j0 + c4) : (wu + j0 + c4 - 128); };
    auto epi = [&](f32x16 (&acc)[MI][2], int seg, LAS char* Ls) {
#pragma unroll
        for (int mi = 0; mi < MI; ++mi)
#pragma unroll
            for (int r = 0; r < 16; ++r) acc[mi][0][r] = silu_f(acc[mi][0][r]) * acc[mi][1][r];
        store_tile_bf16<MI, 128>(Ls, acc, [&](int row, int c) -> bf16_t* { return row < rows ? hb + (size_t)rowid[row] * 256 + j0 + 8 * c : nullptr; });
    };
    gemm_tile<MI, 1>(L, Dm / 64, 256, h2, arow, bcol, epi);
}
__device__ __forceinline__ void moe1_shared(const Params& p, LAS char* L, int r0, int j0) {
    const bf16_t* h2 = (const bf16_t*)(p.ws + WS_H2);
    bf16_t* hb = (bf16_t*)(p.ws + WS_HB);
    const bf16_t* wg = (const bf16_t*)(p.ws + WS_WB) + WB_SG; const bf16_t* wu = (const bf16_t*)(p.ws + WS_WB) + WB_SU;
    auto arow = [&](int r) { return (unsigned)(r0 + r) * Dm; };
    auto bcol = [&](int c8) { return (c8 < 128) ? (wg + j0 + c8) : (wu + j0 + c8 - 128); };
    auto epi = [&](f32x16 (&acc)[2][2], int seg, LAS char* Ls) {
#pragma unroll
        for (int mi = 0; mi < 2; ++mi)
#pragma unroll
            for (int r = 0; r < 16; ++r) acc[mi][0][r] = silu_f(acc[mi][0][r]) * acc[mi][1][r];
        store_tile_bf16<2, 128>(Ls, acc, [&](int row, int c) -> bf16_t* { return hb + (size_t)(AR + r0 + row) * 256 + j0 + 8 * c; });
    };
    gemm_tile<2, 1, true>(L, Dm / 64, 256, h2, arow, bcol, epi);
}
__device__ __forceinline__ void phase_moe1(const Params& p, LAS char* L) {
    const int v = vcu(), G = grid_g();
    const int* cnt = (const int*)(p.ws + WS_CTL);
    moe_prefix(p, L);
    LAS int* pre = (LAS int*)(L + OFF_PRE);
    const int total = __builtin_amdgcn_readfirstlane(pre[256]) * 2;
    for (int u = v; u < total; u += G) {
        const int g = u >> 1, j0 = (u & 1) * 128;
        const int e = __builtin_amdgcn_readfirstlane(moe_find(pre, g)), mt = g - __builtin_amdgcn_readfirstlane(pre[e]);
        const int rows = __builtin_amdgcn_readfirstlane(moe_cnt(cnt, e)) - mt * 256;
        if (rows > 128) moe1_unit<4>(p, L, e, mt * 256, rows < 256 ? rows : 256, j0);
        else moe1_unit<2>(p, L, e, mt * 256, rows, j0);
    }
    unsigned* qctr = (unsigned*)(p.ws + WS_CTL + 2048) + 128;
    LAS unsigned* qslot = (LAS unsigned*)(L + OFF_MISC + 16);
    const int tid = otid();
    for (;;) {
        if (tid == 0) *qslot = __hip_atomic_fetch_add(qctr, 1u, __ATOMIC_RELAXED, __HIP_MEMORY_SCOPE_AGENT);
        __syncthreads();
        const int q = __builtin_amdgcn_readfirstlane((int)*qslot);
        __syncthreads();
        if (q >= (T / 128) * 2) break;
        moe1_shared(p, L, (q >> 1) * 128, (q & 1) * 128);
    }
}

template <int MI>
__device__ __forceinline__ void moe2_unit(const Params& p, LAS char* L, int e, int r0, int rows, int n0) {
    const int* la = (const int*)(p.ws + WS_LA); const float* lw = (const float*)(p.ws + WS_LW);
    const bf16_t* hb = (const bf16_t*)(p.ws + WS_HB);
    unsigned char* yb = (unsigned char*)(p.ws + WS_YB);
    const float* wd = (e < 256) ? p.in[24] + (size_t)e * 256 * Dm : p.in[27];
    LAS int* rowid = (LAS int*)(L + OFF_ROW);
    LAS float* roww = (LAS float*)(L + OFF_RW);
    {
        const int tid = otid();
        if (tid < 64 * MI) {
            const int rr = tid < rows ? tid : 0;
            rowid[tid] = (e < 256) ? la[(size_t)e * LISTCAP + r0 + rr] : (AR + r0 + rr);
            roww[tid] = (e < 256) ? lw[(size_t)e * LISTCAP + r0 + rr] : 1.f;
        }
        __syncthreads();
    }
    auto arow = [&](int r) { return (unsigned)rowid[r] * 256; };
    auto bcol = [&](int c4) { return wd + n0 + c4; };
    auto epi = [&](f32x16 (&acc)[MI][2], int seg, LAS char* Ls) {
        const int tid_ = otid(), lane = tid_ & 63, wave = tid_ >> 6, wm = wave & 1, l31 = lane & 31;
#pragma unroll
        for (int mi = 0; mi < MI; ++mi) {
            const float w = roww[32 * MI * wm + 32 * mi + l31] * YSCALE;
#pragma unroll
            for (int ni = 0; ni < 2; ++ni)
#pragma unroll
                for (int q = 0; q < 16; ++q) acc[mi][ni][q] = __builtin_amdgcn_fmed3f(acc[mi][ni][q] * w, -448.f, 448.f);
        }
        store_tile_fp8<MI>(Ls, acc, [&](int row, int c) -> unsigned char* { return row < rows ? yb + (size_t)rowid[row] * Dm + n0 + seg * 256 + 16 * c : nullptr; });
    };
    gemm_tile<MI, 0, false, 2>(L, 256 / 64, Dm, hb, arow, bcol, epi);
}
__device__ __forceinline__ void moe2_shared(const Params& p, LAS char* L, int r0, int n0) {
    const bf16_t* hb = (const bf16_t*)(p.ws + WS_HB);
    unsigned char* yb = (unsigned char*)(p.ws + WS_YB);
    const bf16_t* wd = (const bf16_t*)(p.ws + WS_WB) + WB_SD;
    auto arow = [&](int r) { return (unsigned)(AR + r0 + r) * 256; };
    auto bcol = [&](int c8) { return wd + n0 + c8; };
    auto epi = [&](f32x16 (&acc)[2][2], int seg, LAS char* Ls) {
#pragma unroll
        for (int mi = 0; mi < 2; ++mi)
#pragma unroll
            for (int ni = 0; ni < 2; ++ni)
#pragma unroll
                for (int q = 0; q < 16; ++q) acc[mi][ni][q] = __builtin_amdgcn_fmed3f(acc[mi][ni][q] * YSCALE, -448.f, 448.f);
        store_tile_fp8<2>(Ls, acc, [&](int row, int c) -> unsigned char* { return yb + (size_t)(AR + r0 + row) * Dm + n0 + seg * 256 + 16 * c; });
    };
    gemm_tile<2, 0, true, 2>(L, 256 / 64, Dm, hb, arow, bcol, epi);
}
__device__ __forceinline__ void phase_moe2(const Params& p, LAS char* L) {
    const int v = vcu(), G = grid_g();
    const int* cnt = (const int*)(p.ws + WS_CTL);
    moe_prefix(p, L);
    LAS int* pre = (LAS int*)(L + OFF_PRE);
    const int total = __builtin_amdgcn_readfirstlane(pre[256]) * 2;
    for (int u = v; u < total; u += G) {
        const int g = u >> 1, n0 = (u & 1) * 512;
        const int e = __builtin_amdgcn_readfirstlane(moe_find(pre, g)), mt = g - __builtin_amdgcn_readfirstlane(pre[e]);
        const int rows = __builtin_amdgcn_readfirstlane(moe_cnt(cnt, e)) - mt * 256;
        if (rows > 128) moe2_unit<4>(p, L, e, mt * 256, rows < 256 ? rows : 256, n0);
        else moe2_unit<2>(p, L, e, mt * 256, rows, n0);
    }
    unsigned* qctr = (unsigned*)(p.ws + WS_CTL + 2048) + 192;
    LAS unsigned* qslot = (LAS unsigned*)(L + OFF_MISC + 16);
    const int tid = otid();
    for (;;) {
        if (tid == 0) *qslot = __hip_atomic_fetch_add(qctr, 1u, __ATOMIC_RELAXED, __HIP_MEMORY_SCOPE_AGENT);
        __syncthreads();
        const int q = __builtin_amdgcn_readfirstlane((int)*qslot);
        __syncthreads();
        if (q >= (T / 128) * 2) break;
        moe2_shared(p, L, (q >> 1) * 128, (q & 1) * 512);
    }
}

__device__ __forceinline__ void phase_final(const Params& p) {
    const int v = vcu(), G = grid_g();
    const int tid = otid(), lane = tid & 63, wave = tid >> 6;
    const float* pg = p.in[19];
    const float* mod = (const float*)(p.ws + WS_MOD);
    const unsigned char* yb = (const unsigned char*)(p.ws + WS_YB);
    for (int t = v * NW + wave; t < T; t += G * NW) {
        const int b = t / SEQ;
        const float* gf = mod + b * 6144 + 5120;
        float y[16];
#pragma unroll
        for (int e = 0; e < 16; ++e) y[e] = 0.f;
#pragma unroll
        for (int k = 0; k < 9; ++k) {
            const size_t row = (k < 8) ? ((size_t)t * TOPK + k) : ((size_t)AR + t);
            const u32x4 raw = *(const u32x4*)(yb + row * Dm + 16 * lane);
#pragma unroll
            for (int e = 0; e < 4; ++e) {
                const f32x2 a = __builtin_amdgcn_cvt_pk_f32_fp8((int)raw[e], false), c = __builtin_amdgcn_cvt_pk_f32_fp8((int)raw[e], true);
                y[4 * e] += a.x; y[4 * e + 1] += a.y; y[4 * e + 2] += c.x; y[4 * e + 3] += c.y;
            }
        }
        float ss = 0.f;
#pragma unroll
        for (int e = 0; e < 16; ++e) { y[e] *= (1.f / YSCALE); ss += y[e] * y[e]; }
        ss = wave_sum(ss, lane);
        const float rstd = rsqrtf(ss * (1.f / Dm) + 1e-6f);
        const int col = 16 * lane;
#pragma unroll
        for (int hq = 0; hq < 4; ++hq) {
            f32x4 xo = *(const f32x4*)(p.out + (size_t)t * Dm + col + 4 * hq);
            const f32x4 gv = *(const f32x4*)(pg + col + 4 * hq), gg = *(const f32x4*)(gf + col + 4 * hq);
#pragma unroll
            for (int e = 0; e < 4; ++e) xo[e] += gg[e] * (y[4 * hq + e] * rstd * gv[e]);
            *(f32x4*)(p.out + (size_t)t * Dm + col + 4 * hq) = xo;
        }
    }
}

#define XB_TMO      128
#define XB_XCNT(j)  (256  + 64 * (j))
#define XB_XSUB(j)  (1280 + 64 * (j))
#define XB_XGEN(j)  (2304 + 64 * (j))
#define XB_TOP      3328
#define XB_TOPGEN   3392
#define XCD_BAR_WORDS 3456
#define XB_SPIN_CAP (1u << 18)
__device__ __forceinline__ unsigned xb_ld(unsigned* p)              { return __hip_atomic_load(p, __ATOMIC_RELAXED, __HIP_MEMORY_SCOPE_AGENT); }
__device__ __forceinline__ unsigned xb_add(unsigned* p, unsigned v) { return __hip_atomic_fetch_add(p, v, __ATOMIC_RELAXED, __HIP_MEMORY_SCOPE_AGENT); }
__device__ __forceinline__ unsigned xb_xcc_id() { return (unsigned)__builtin_amdgcn_s_getreg((3 << 11) | 20) & 0xFu; }
#define XB_SPIN(cond, bar) do { unsigned _sp = 0; while (cond) { __builtin_amdgcn_s_sleep(1); \
    if ((++_sp & 255u) == 0u) { if (xb_ld(&(bar)[XB_TMO])) break; if (_sp > XB_SPIN_CAP) { atomicAdd(&(bar)[XB_TMO], 1u); break; } } } } while (0)
struct XcdBarrier { unsigned* bar; unsigned x; volatile LAS unsigned* st; };
__device__ __forceinline__ XcdBarrier xcd_barrier_post(unsigned* bar, volatile LAS unsigned* st) {
    XcdBarrier b; b.bar = bar; b.x = xb_xcc_id(); b.st = st;
    if (threadIdx.x == 0) (void)xb_add(&bar[XB_XCNT(b.x)], 1u);
    return b;
}
__device__ __forceinline__ void xcd_barrier_complete(unsigned* bar, unsigned x, unsigned& nloc, unsigned& nx) {
    const unsigned G = gridDim.x * gridDim.y * gridDim.z;
    unsigned sum, cnt, mine, sp = 0u;
    for (;;) {
        sum = 0u; cnt = 0u; mine = 0u;
#pragma unroll
        for (unsigned j = 0; j < 16; ++j) { const unsigned c = xb_ld(&bar[XB_XCNT(j)]); sum += c; cnt += (c > 0u) ? 1u : 0u; mine = (j == x) ? c : mine; }
        if (sum == G) break;
        __builtin_amdgcn_s_sleep(1);
        if ((++sp & 255u) == 0u) { if (xb_ld(&bar[XB_TMO])) break; if (sp > XB_SPIN_CAP) { atomicAdd(&bar[XB_TMO], 1u); break; } }
    }
    nloc = mine > 0u ? mine : 1u; nx = cnt > 0u ? cnt : 1u;
}
__device__ __forceinline__ void xcd_barrier(const Params& p, LAS char* L) {
    XcdBarrier b; b.bar = (unsigned*)(p.ws + WS_CTL + 4096); b.x = xb_xcc_id(); b.st = (volatile LAS unsigned*)(L + OFF_MISC);
    asm volatile("s_waitcnt vmcnt(0)" ::: "memory");
    __syncthreads();
    if (threadIdx.x == 0) {
        unsigned* bar = b.bar;
        __builtin_amdgcn_s_waitcnt(0);
        unsigned nloc = b.st[0], nx = b.st[1];
        if (nloc == 0u) { xcd_barrier_complete(bar, b.x, nloc, nx); b.st[0] = nloc; b.st[1] = nx; }
        const unsigned old = xb_add(&bar[XB_XSUB(b.x)], 1u);
        const unsigned gen = old / nloc;
        if (old + 1u == (gen + 1u) * nloc) {
            __builtin_amdgcn_fence(__ATOMIC_RELEASE, "agent");
            asm volatile("s_waitcnt vmcnt(0)" ::: "memory");
            const unsigned og = xb_add(&bar[XB_TOP], 1u);
            const unsigned tg = og / nx;
            if (og + 1u == (tg + 1u) * nx) xb_add(&bar[XB_TOPGEN], 1u);
            else XB_SPIN(xb_ld(&bar[XB_TOPGEN]) == tg, bar);
            __builtin_amdgcn_fence(__ATOMIC_ACQUIRE, "agent");
            xb_add(&bar[XB_XGEN(b.x)], 1u);
            asm volatile("s_waitcnt vmcnt(0)" ::: "memory");
        } else {
            XB_SPIN(xb_ld(&bar[XB_XGEN(b.x)]) == gen, bar);
            __builtin_amdgcn_fence(__ATOMIC_ACQUIRE, "agent");
            asm volatile("s_waitcnt vmcnt(0)" ::: "memory");
        }
    }
    __syncthreads();
}

__global__ void __launch_bounds__(NT, 2) mega(Params p) {
    extern __shared__ __attribute__((aligned(16))) char smem[];
    LAS char* L = (LAS char*)smem;
    if (threadIdx.x < 8) ((LAS unsigned*)(L + OFF_MISC))[threadIdx.x] = 0u;
    __syncthreads();
    (void)xcd_barrier_post((unsigned*)(p.ws + WS_CTL + 4096), (volatile LAS unsigned*)(L + OFF_MISC));
    phase_mod(p, L);
    xcd_barrier(p, L);
    phase_h1(p);
    xcd_barrier(p, L);
    phase_proj(p, L);
    xcd_barrier(p, L);
    phase_qkv(p, L);
    xcd_barrier(p, L);
    phase_attn(p, L);
    xcd_barrier(p, L);
    phase_oproj(p, L);
    xcd_barrier(p, L);
    phase_router_route(p, L);
    xcd_barrier(p, L);
    phase_moe1(p, L);
    xcd_barrier(p, L);
    phase_moe2(p, L);
    xcd_barrier(p, L);
    phase_final(p);
}

extern "C" void kernel_launch(void* const* d_in, const int* in_sizes, int n_in, void* d_out, int out_size, void* d_ws, size_t ws_size, hipStream_t stream) {
    static int grid_blocks = 0;
    if (grid_blocks == 0) {
        if (n_in != 28 || out_size != T * Dm || ws_size < WS_END) {
            fprintf(stderr, "kernel_launch: unexpected problem (n_in %d, out %d, ws %zu); nothing launched\n", n_in, out_size, ws_size);
            grid_blocks = -1; return;
        }
        int dev = 0, cus = 0, per_cu = 0;
        (void)hipGetDevice(&dev);
        (void)hipDeviceGetAttribute(&cus, hipDeviceAttributeMultiprocessorCount, dev);
        if (hipFuncSetAttribute((const void*)mega, hipFuncAttributeMaxDynamicSharedMemorySize, LDS_BYTES) != hipSuccess) {
            fprintf(stderr, "kernel_launch: hipFuncSetAttribute(%d B LDS) failed\n", LDS_BYTES); grid_blocks = -1; return;
        }
        (void)hipOccupancyMaxActiveBlocksPerMultiprocessor(&per_cu, mega, NT, LDS_BYTES);
        if (per_cu < 1) { fprintf(stderr, "kernel_launch: occupancy query says %d blocks per CU\n", per_cu); per_cu = 1; }
        grid_blocks = cus;
        fprintf(stderr, "kernel_launch: %d CUs, occupancy query %d per CU, grid %d\n", cus, per_cu, grid_blocks);
    }
    if (grid_blocks < 0) return;
    (void)hipMemsetAsync((char*)d_ws + WS_CTL, 0, CTL_BYTES, stream);
    Params p{};
    for (int i = 0; i < 28; ++i) p.in[i] = (const float*)d_in[i];
    p.out = (float*)d_out; p.ws = (char*)d_ws;
    void* args[] = {&p};
    hipError_t e = hipLaunchCooperativeKernel((void*)mega, dim3(grid_blocks), dim3(NT), args, LDS_BYTES, stream);
    if (e != hipSuccess) fprintf(stderr, "cooperative launch failed: %s (grid %d)\n", hipGetErrorString(e), grid_blocks);
}
```

```cpp
#include <hip/hip_runtime.h>
#include <cstdio>
#include <cstdint>


typedef unsigned short bf16_t;
typedef float f32x2 __attribute__((ext_vector_type(2)));
typedef short bf16x8 __attribute__((ext_vector_type(8)));
typedef short s16x4 __attribute__((ext_vector_type(4)));
typedef short v4i16_t __attribute__((ext_vector_type(4)));
typedef float f32x16 __attribute__((ext_vector_type(16)));
typedef float f32x4 __attribute__((ext_vector_type(4)));
typedef unsigned u32x4 __attribute__((ext_vector_type(4)));
typedef unsigned u32x2 __attribute__((ext_vector_type(2)));
#define LAS __attribute__((address_space(3)))

constexpr int NT = 512, NW = 8;
constexpr int Dm = 1024, NB = 8, SEQ = 2048, T = NB * SEQ;
constexpr int NIN = 1952;
constexpr int C_CQ = 0, C_CKV = 256, C_KR = 384, C_DQ = 416, C_DK = 928, C_DV = 1440;
constexpr int NE = 256, TOPK = 8, AR = T * TOPK, HROWS = AR + T;
constexpr int LISTCAP = T;
constexpr float LOG2E = 1.4426950408889634f;
constexpr float YSCALE = 32.f;
constexpr float LAMBDA_INIT = 0.2f;

constexpr size_t MiB = 1u << 20;
constexpr size_t WS_CTL = 0, CTL_BYTES = 65536;
constexpr size_t WS_MOD = 65536;
constexpr size_t WS_ROPE = 1 * MiB;
constexpr size_t WS_H1 = 4 * MiB;
constexpr size_t WS_PROJ = 36 * MiB;
constexpr size_t WS_CQN = 100 * MiB;
constexpr size_t WS_CKVN = 108 * MiB;
constexpr size_t WS_QM = 112 * MiB;
constexpr size_t WS_KF = 136 * MiB;
constexpr size_t WS_VM = 160 * MiB;
constexpr size_t WS_ATT = 176 * MiB;
constexpr size_t WS_OD0 = 208 * MiB;
constexpr size_t WS_Y1 = 240 * MiB;
constexpr size_t WS_H2 = 304 * MiB;
constexpr size_t WS_LOG = 336 * MiB;
constexpr size_t WS_LA = 352 * MiB;
constexpr size_t WS_LW = 368 * MiB;
constexpr size_t WS_HB = 384 * MiB;
constexpr size_t WS_YB = 456 * MiB;
constexpr size_t WS_WB = 744 * MiB;
constexpr size_t WB_IN = 0, WB_UQ = WB_IN + (size_t)1024 * 1952, WB_UKV = WB_UQ + 256 * 768, WB_O = WB_UKV + 128 * 1024, WB_R = WB_O + 1024 * 1024, WB_SG = WB_R + 1024 * 256, WB_SU = WB_SG + 1024 * 256, WB_SD = WB_SU + 1024 * 256, WB_END = WB_SD + 256 * 1024;
constexpr size_t WS_END = 760 * MiB;

constexpr int G_XB = 32768, G_WB = 36864, G_BUF = G_XB + G_WB, G_LDS = 2 * G_BUF;
constexpr int OFF_MISC = G_LDS, OFF_PRE = OFF_MISC + 64, OFF_TL = OFF_PRE + 1088;
constexpr int OFF_ROW = OFF_TL + 1088, OFF_RW = OFF_ROW + 1024;
constexpr int OFF_SS = OFF_RW + 1024;
constexpr int LDS_BYTES = G_LDS + 4352 + 4096;

struct Params {
    const float* in[28];
    float* out;
    char* ws;
};

__device__ __forceinline__ unsigned short f2bf(float f) { __bf16 b = (__bf16)f; return __builtin_bit_cast(unsigned short, b); }
typedef __bf16 bf16x2_t __attribute__((ext_vector_type(2)));
__device__ __forceinline__ unsigned pk2(float lo, float hi) { const f32x2 v = {lo, hi}; return __builtin_bit_cast(unsigned, __builtin_convertvector(v, bf16x2_t)); }
__device__ __forceinline__ float bf2f(unsigned short b) { return __uint_as_float(((unsigned)b) << 16); }
__device__ __forceinline__ float bflo(unsigned u) { return __uint_as_float(u << 16); }
__device__ __forceinline__ float bfhi(unsigned u) { return __uint_as_float(u & 0xffff0000u); }
__device__ __forceinline__ int crow(int r, int hi) { return (r & 3) + 8 * (r >> 2) + 4 * hi; }
__device__ __forceinline__ float shx(float v, int m, int lane) { return __int_as_float(__builtin_amdgcn_ds_bpermute((lane ^ m) << 2, __float_as_int(v))); }
__device__ __forceinline__ int shxi(int v, int m, int lane) { return __builtin_amdgcn_ds_bpermute((lane ^ m) << 2, v); }
__device__ __forceinline__ float shl(float v, int src) { return __int_as_float(__builtin_amdgcn_ds_bpermute(src << 2, __float_as_int(v))); }
__device__ __forceinline__ float wave_sum(float v, int lane) {
#pragma unroll
    for (int o = 32; o >= 1; o >>= 1) v += shx(v, o, lane);
    return v;
}
__device__ __forceinline__ float silu_f(float v) { return v / (1.f + __expf(-v)); }
__device__ __forceinline__ s16x4 tr_read(LAS char* p) {
    return __builtin_bit_cast(s16x4, __builtin_amdgcn_ds_read_tr16_b64_v4i16((LAS v4i16_t*)p));
}
__device__ __forceinline__ int otid() { int t = threadIdx.x; asm volatile("" : "+v"(t)); return t; }
__device__ __forceinline__ int grid_g() { return gridDim.x; }
__device__ __forceinline__ int vcu() { const int G = gridDim.x, bx = blockIdx.x; return (G % 8 == 0) ? (bx % 8) * (G / 8) + bx / 8 : bx; }
__device__ __forceinline__ void gld16(u32x4& d, const void* p) { asm volatile("global_load_dwordx4 %0, %1, off" : "+v"(d) : "v"(p) : "memory"); }
__device__ __forceinline__ void gld16(f32x4& d, const void* p) { asm volatile("global_load_dwordx4 %0, %1, off" : "+v"(d) : "v"(p) : "memory"); }
template <int N> __device__ __forceinline__ void vm_wait(u32x4& a, f32x4& b, f32x4& c) { asm volatile("s_waitcnt vmcnt(%3)" : "+v"(a), "+v"(b), "+v"(c) : "n"(N) : "memory"); }
template <int N> __device__ __forceinline__ void vm_wait(f32x4& b, f32x4& c) { asm volatile("s_waitcnt vmcnt(%2)" : "+v"(b), "+v"(c) : "n"(N) : "memory"); }
template <int N> __device__ __forceinline__ void vm_wait(u32x4& a, u32x4& b) { asm volatile("s_waitcnt vmcnt(%2)" : "+v"(a), "+v"(b) : "n"(N) : "memory"); }
template <int N> __device__ __forceinline__ void vm_wait(u32x4& b) { asm volatile("s_waitcnt vmcnt(%1)" : "+v"(b) : "n"(N) : "memory"); }
#define MFMA32(a, b, c) __builtin_amdgcn_mfma_f32_32x32x16_bf16(a, b, c, 0, 0, 0)

template <int NBMODE> __device__ __forceinline__ int nb_of(int wn, int ni) { return NBMODE == 0 ? 64 * wn + 32 * ni : 32 * wn + 128 * ni; }

template <int MI, int NBMODE, bool WBF = false, int NSEG = 1, class AF, class BF, class EF>
__device__ __forceinline__ void gemm_tile(LAS char* L, int nk, long ldw, const bf16_t* abase, AF arow, BF bcol, EF epi) {
    asm volatile("" : "+s"(nk));
    const int tid = otid(), lane = tid & 63, wave = tid >> 6;
    const int wm = wave & 1, wn = wave >> 1, l31 = lane & 31, hi = lane >> 5;
    const int a_chunk = tid & 7, a_row = tid >> 3;
    const int a_w = a_row * 128 + 16 * (a_chunk ^ ((a_row >> 1) & 7));
    const int b_n4 = WBF ? (tid & 31) : (tid & 63), b_kr = WBF ? (tid >> 5) : (tid >> 6);
    const auto bp = bcol((WBF ? 8 : 4) * b_n4) + (long)b_kr * ldw;
    const int b_w = G_XB + b_kr * 576 + (WBF ? 16 : 8) * b_n4;
    const int sw = (l31 >> 1) & 7;
    const int xoff = (32 * MI * wm + l31) * 128;
    const int woff = G_XB + (8 * hi + ((lane & 15) >> 2)) * 576 + 2 * (16 * ((lane >> 4) & 1) + 4 * (lane & 3));
    u32x4 ra[MI]; f32x4 rb[8]; u32x4 rw[4];
#pragma unroll
    for (int i = 0; i < MI; ++i) ra[i] = (u32x4){0u, 0u, 0u, 0u};
#pragma unroll
    for (int i = 0; i < 8; ++i) rb[i] = (f32x4){0.f, 0.f, 0.f, 0.f};
#pragma unroll
    for (int i = 0; i < 4; ++i) rw[i] = (u32x4){0u, 0u, 0u, 0u};
#define G_LOADW(KOFF, Q, SEGC) do { \
        if (WBF) { gld16(rw[Q], bp + (long)((KOFF) + 16 * (Q)) * ldw + (SEGC)); } \
        else { gld16(rb[2 * (Q)], bp + (long)((KOFF) + 16 * (Q)) * ldw + (SEGC)); gld16(rb[2 * (Q) + 1], bp + (long)((KOFF) + 16 * (Q) + 8) * ldw + (SEGC)); } } while (0)
#define G_LOADQ(KT, Q) do { \
        if ((Q) < MI) gld16(ra[(Q) < MI ? (Q) : 0], abase + arow(a_row + 64 * (Q)) + a_chunk * 8 + (KT) * 64); \
        G_LOADW((KT) * 64, Q, 0); } while (0)
#define G_LOADQ_SEL(KT, SEG, Q, OK) do { \
        const int kq_ = (OK) ? (KT) * 64 : 0; const int sc_ = (OK) ? (SEG) * 256 : 0; \
        if ((Q) < MI) gld16(ra[(Q) < MI ? (Q) : 0], abase + arow(a_row + 64 * (Q)) + a_chunk * 8 + kq_); \
        G_LOADW(kq_, Q, sc_); } while (0)
#define G_WAITQ(Q, N) do { \
        if (WBF) { if ((Q) < MI) vm_wait<N>(ra[(Q) < MI ? (Q) : 0], rw[Q]); else vm_wait<N>(rw[Q]); } \
        else { if ((Q) < MI) vm_wait<N>(ra[(Q) < MI ? (Q) : 0], rb[2 * (Q)], rb[2 * (Q) + 1]); else vm_wait<N>(rb[2 * (Q)], rb[2 * (Q) + 1]); } } while (0)
#define G_STOREQ(LP, Q) do { \
        if ((Q) < MI) *(LAS u32x4*)((LP) + a_w + (Q) * 8192) = ra[(Q) < MI ? (Q) : 0]; \
        if (WBF) { *(LAS u32x4*)((LP) + b_w + (Q) * 16 * 576) = rw[Q]; } else { \
        { u32x2 w; w.x = pk2(rb[2 * (Q)][0], rb[2 * (Q)][1]); w.y = pk2(rb[2 * (Q)][2], rb[2 * (Q)][3]); *(LAS u32x2*)((LP) + b_w + (Q) * 16 * 576) = w; } \
        { u32x2 w; w.x = pk2(rb[2 * (Q) + 1][0], rb[2 * (Q) + 1][1]); w.y = pk2(rb[2 * (Q) + 1][2], rb[2 * (Q) + 1][3]); *(LAS u32x2*)((LP) + b_w + (Q) * 16 * 576 + 8 * 576) = w; } } } while (0)
    constexpr int NLW = WBF ? 1 : 2;
    constexpr int NL0 = NLW + ((0 < MI) ? 1 : 0), NL1 = NLW + ((1 < MI) ? 1 : 0), NL2 = NLW + ((2 < MI) ? 1 : 0), NL3 = NLW + ((3 < MI) ? 1 : 0), NLT = NL0 + NL1 + NL2 + NL3;
    G_LOADQ(0, 0); G_LOADQ(0, 1); G_LOADQ(0, 2); G_LOADQ(0, 3);
    G_WAITQ(0, 0); G_WAITQ(1, 0); G_WAITQ(2, 0); G_WAITQ(3, 0);
    G_STOREQ(L, 0); G_STOREQ(L, 1); G_STOREQ(L, 2); G_STOREQ(L, 3);
    G_LOADQ(1, 0); G_LOADQ(1, 1); G_LOADQ(1, 2); G_LOADQ(1, 3);
    f32x16 acc[MI][2];
#pragma unroll
    for (int i = 0; i < MI; ++i)
#pragma unroll
        for (int j = 0; j < 2; ++j)
#pragma unroll
            for (int r = 0; r < 16; ++r) acc[i][j][r] = 0.f;
    __syncthreads();
    const int nt_all = nk * NSEG;
    int lk = (nk == 2) ? 0 : 2, lseg = (nk == 2) ? 1 : 0;
    int ck = 0, cseg = 0;
#pragma nounroll
    for (int kt = 0; kt < nt_all; ++kt) {
        LAS char* Lb = L + (kt & 1) * G_BUF;
        LAS char* Ln = L + ((kt + 1) & 1) * G_BUF;
        const bool ld = kt + 2 < nt_all;
        bf16x8 xf[2][MI], wf[2][2];
#define LOAD_FRAGS(KS, B) do { \
            _Pragma("unroll") for (int mi = 0; mi < MI; ++mi) xf[B][mi] = *(LAS bf16x8*)(Lb + xoff + mi * 4096 + 16 * ((2 * (KS) + hi) ^ sw)); \
            _Pragma("unroll") for (int ni = 0; ni < 2; ++ni) { \
                LAS char* pp = Lb + woff + (KS) * 16 * 576 + 2 * nb_of<NBMODE>(wn, ni); \
                const s16x4 lo = tr_read(pp), h4 = tr_read(pp + 4 * 576); \
                wf[B][ni] = (bf16x8){lo[0], lo[1], lo[2], lo[3], h4[0], h4[1], h4[2], h4[3]}; } } while (0)
#define MMA_STEP(KS) do { \
            _Pragma("unroll") for (int mi = 0; mi < MI; ++mi) \
                _Pragma("unroll") for (int ni = 0; ni < 2; ++ni) acc[mi][ni] = MFMA32(wf[(KS) & 1][ni], xf[(KS) & 1][mi], acc[mi][ni]); } while (0)
#define STAGE_STEP(Q, NREST, NPREV) do { G_WAITQ(Q, (NREST) + (NPREV)); G_STOREQ(Ln, Q); G_LOADQ_SEL(lk, lseg, Q, ld); } while (0)
        LOAD_FRAGS(0, 0);
        LOAD_FRAGS(1, 1); MMA_STEP(0); STAGE_STEP(0, NL1 + NL2 + NL3, 0);           __builtin_amdgcn_sched_barrier(0);
        LOAD_FRAGS(2, 0); MMA_STEP(1); STAGE_STEP(1, NL2 + NL3, NL0);               __builtin_amdgcn_sched_barrier(0);
        LOAD_FRAGS(3, 1); MMA_STEP(2); STAGE_STEP(2, NL3, NL0 + NL1);               __builtin_amdgcn_sched_barrier(0);
        MMA_STEP(3);                   STAGE_STEP(3, 0, NL0 + NL1 + NL2);           __builtin_amdgcn_sched_barrier(0);
#undef LOAD_FRAGS
#undef MMA_STEP
#undef STAGE_STEP
        __syncthreads();
        if (++lk == nk) { lk = 0; ++lseg; }
        if (NSEG > 1) {
            if (++ck == nk) {
                ck = 0;
                if (cseg + 1 < NSEG) {
                    epi(acc, cseg, L + (kt & 1) * G_BUF);
#pragma unroll
                    for (int i = 0; i < MI; ++i)
#pragma unroll
                        for (int j = 0; j < 2; ++j)
#pragma unroll
                            for (int r = 0; r < 16; ++r) acc[i][j][r] = 0.f;
                }
                ++cseg;
            }
        }
    }
    G_WAITQ(0, 0); G_WAITQ(1, 0); G_WAITQ(2, 0); G_WAITQ(3, 0);
#undef G_LOADQ
#undef G_LOADQ_SEL
#undef G_LOADW
#undef G_WAITQ
#undef G_STOREQ
    (void)NLT;
    epi(acc, NSEG - 1, L);
}

template <int MI, int NC, class DF>
__device__ __forceinline__ void store_tile_bf16(LAS char* L, const f32x16 (&acc)[MI][2], DF dst) {
    constexpr int STR = NC * 2 + 16, CPR = NC / 8, BM = 64 * MI;
    const int tid = otid(), lane = tid & 63, wave = tid >> 6, wm = wave & 1, wn = wave >> 1, l31 = lane & 31, hi = lane >> 5;
#pragma unroll
    for (int mi = 0; mi < MI; ++mi)
#pragma unroll
        for (int ni = 0; ni < (NC == 256 ? 2 : 1); ++ni) {
            const int row = 32 * MI * wm + 32 * mi + l31, col = (NC == 256) ? nb_of<0>(wn, ni) : 32 * wn;
#pragma unroll
            for (int gq = 0; gq < 4; ++gq) {
                u32x2 w; w.x = pk2(acc[mi][ni][4 * gq], acc[mi][ni][4 * gq + 1]); w.y = pk2(acc[mi][ni][4 * gq + 2], acc[mi][ni][4 * gq + 3]);
                *(LAS u32x2*)(L + row * STR + 2 * (col + 8 * gq + 4 * hi)) = w;
            }
        }
    __syncthreads();
#pragma unroll
    for (int i = 0; i < (BM * CPR) / NT; ++i) {
        const int id = tid + NT * i, row = id / CPR, c = id % CPR;
        bf16_t* d = dst(row, c);
        if (d) *(u32x4*)d = *(LAS u32x4*)(L + row * STR + 16 * c);
    }
    __syncthreads();
}

template <int MI, class DF>
__device__ __forceinline__ void store_tile_fp8(LAS char* L, const f32x16 (&acc)[MI][2], DF dst) {
    constexpr int STR = 256 + 16, BM = 64 * MI;
    const int tid = otid(), lane = tid & 63, wave = tid >> 6, wm = wave & 1, wn = wave >> 1, l31 = lane & 31, hi = lane >> 5;
#pragma unroll
    for (int mi = 0; mi < MI; ++mi)
#pragma unroll
        for (int ni = 0; ni < 2; ++ni) {
            const int row = 32 * MI * wm + 32 * mi + l31, col = nb_of<0>(wn, ni);
#pragma unroll
            for (int gq = 0; gq < 4; ++gq) {
                int w = 0;
                w = __builtin_amdgcn_cvt_pk_fp8_f32(acc[mi][ni][4 * gq], acc[mi][ni][4 * gq + 1], w, false);
                w = __builtin_amdgcn_cvt_pk_fp8_f32(acc[mi][ni][4 * gq + 2], acc[mi][ni][4 * gq + 3], w, true);
                *(LAS int*)(L + row * STR + (col + 8 * gq + 4 * hi)) = w;
            }
        }
    __syncthreads();
#pragma unroll
    for (int i = 0; i < (BM * 16) / NT; ++i) {
        const int id = tid + NT * i, row = id >> 4, c = id & 15;
        unsigned char* d = dst(row, c);
        if (d) *(u32x4*)d = *(LAS u32x4*)(L + row * STR + 16 * c);
    }
    __syncthreads();
}

__device__ __forceinline__ void phase_mod(const Params& p, LAS char* L) {
    const int v = vcu(), G = grid_g();
    const int tid = otid();
    const float* c = p.in[1]; const float* w_ada = p.in[3]; const float* b_ada = p.in[4];
    float* mod = (float*)(p.ws + WS_MOD);
    LAS float* sc = (LAS float*)L;
    LAS float* red = (LAS float*)(L + 32768);
    bool filled = false;
    for (int item = v; item < 192; item += G) {
        if (!filled) {
            for (int i = tid; i < 8 * 1024; i += NT) sc[i] = silu_f(c[i]);
            __syncthreads(); filled = true;
        }
        const int cx = tid & 31, kl = tid >> 5, col = item * 32 + cx;
        float a[8];
#pragma unroll
        for (int b = 0; b < 8; ++b) a[b] = 0.f;
#pragma unroll 8
        for (int k = kl; k < 1024; k += 16) {
            const float w = w_ada[(size_t)k * 6144 + col];
#pragma unroll
            for (int b = 0; b < 8; ++b) a[b] += sc[b * 1024 + k] * w;
        }
#pragma unroll
        for (int b = 0; b < 8; ++b) red[(b * 16 + kl) * 32 + cx] = a[b];
        __syncthreads();
        if (tid < 256) {
            const int b = tid >> 5, cc = tid & 31; float s_ = 0.f;
#pragma unroll
            for (int k = 0; k < 16; ++k) s_ += red[(b * 16 + k) * 32 + cc];
            mod[b * 6144 + item * 32 + cc] = s_ + b_ada[item * 32 + cc];
        }
        __syncthreads();
    }
    {
        bf16_t* wb = (bf16_t*)(p.ws + WS_WB);
        const size_t gt = (size_t)v * NT + tid, gs = (size_t)G * NT;
        auto conv = [&](const float* src, size_t off, size_t n) {
            for (size_t i = gt; i < n / 4; i += gs) { const f32x4 f = *(const f32x4*)(src + 4 * i); u32x2 w; w.x = pk2(f[0], f[1]); w.y = pk2(f[2], f[3]); *(u32x2*)(wb + off + 4 * i) = w; }
        };
        auto convg = [&](const float* src, size_t off, size_t n, int ncol, const float* gain) {
            for (size_t i = gt; i < n / 4; i += gs) { const float gk = gain[(4 * i) / ncol]; const f32x4 f = *(const f32x4*)(src + 4 * i); u32x2 w; w.x = pk2(f[0] * gk, f[1] * gk); w.y = pk2(f[2] * gk, f[3] * gk); *(u32x2*)(wb + off + 4 * i) = w; }
        };
        conv(p.in[7], WB_IN, (size_t)1024 * 1952); convg(p.in[10], WB_UQ, (size_t)256 * 768, 768, p.in[8]); convg(p.in[11], WB_UKV, (size_t)128 * 1024, 1024, p.in[9]);
        conv(p.in[17], WB_O, (size_t)1024 * 1024); conv(p.in[20], WB_R, (size_t)1024 * 256);
        conv(p.in[25], WB_SG, (size_t)1024 * 256); conv(p.in[26], WB_SU, (size_t)1024 * 256); conv(p.in[27], WB_SD, (size_t)256 * 1024);
    }
}

__device__ __forceinline__ void phase_h1(const Params& p) {
    const int v = vcu(), G = grid_g();
    const int tid = otid(), lane = tid & 63, wave = tid >> 6;
    const float* x = p.in[0]; const int* positions = (const int*)p.in[2]; const float* g = p.in[5];
    const float* mod = (const float*)(p.ws + WS_MOD);
    bf16_t* h1 = (bf16_t*)(p.ws + WS_H1);
    f32x2* rope = (f32x2*)(p.ws + WS_ROPE);
    for (int t = v * NW + wave; t < T; t += G * NW) {
        const int b = t / SEQ;
        const f32x4* xr = (const f32x4*)(x + (size_t)t * Dm);
        f32x4 xv[4]; float ss = 0.f;
#pragma unroll
        for (int j = 0; j < 4; ++j) { xv[j] = xr[lane + 64 * j]; ss += xv[j][0] * xv[j][0] + xv[j][1] * xv[j][1] + xv[j][2] * xv[j][2] + xv[j][3] * xv[j][3]; }
        ss = wave_sum(ss, lane);
        const float rstd = rsqrtf(ss * (1.f / Dm) + 1e-6f);
        const float* sh = mod + b * 6144; const float* scl = sh + 1024;
#pragma unroll
        for (int j = 0; j < 4; ++j) {
            const int col = 4 * (lane + 64 * j);
            const f32x4 gv = *(const f32x4*)(g + col), sv = *(const f32x4*)(scl + col), hv = *(const f32x4*)(sh + col);
            float o[4];
#pragma unroll
            for (int e = 0; e < 4; ++e) o[e] = (xv[j][e] * rstd * gv[e]) * (1.f + sv[e]) + hv[e];
            u32x2 w; w.x = pk2(o[0], o[1]); w.y = pk2(o[2], o[3]);
            *(u32x2*)(h1 + (size_t)t * Dm + col) = w;
        }
        if (lane < 16) {
            const double inv = exp2(-(double)lane * (13.287712379549449 / 16.0));
            const double rev = (double)positions[t] * inv * 0.15915494309189535;
            const float fr = (float)(rev - rint(rev));
            f32x2 cs; cs.x = __builtin_amdgcn_cosf(fr); cs.y = __builtin_amdgcn_sinf(fr);
            rope[(size_t)t * 16 + lane] = cs;
        }
    }
}

__device__ __forceinline__ void phase_proj(const Params& p, LAS char* L) {
    const int v = vcu(), G = grid_g();
    const bf16_t* h1 = (const bf16_t*)(p.ws + WS_H1);
    const bf16_t* w_in = (const bf16_t*)(p.ws + WS_WB) + WB_IN;
    bf16_t* proj = (bf16_t*)(p.ws + WS_PROJ);
    const f32x2* rope = (const f32x2*)(p.ws + WS_ROPE);
    for (int u = v; u < 64 * 8; u += G) {
        const int mt = u >> 3, nt = u & 7, m0 = mt * 256, n0 = nt * 256;
        auto arow = [&](int r) { return (unsigned)(m0 + r) * Dm; };
        auto bcol = [&](int c) { int col = n0 + c; if (col > NIN - 8) col = NIN - 8; return w_in + col; };
        auto epi = [&](f32x16 (&acc)[4][2], int seg, LAS char* Ls) {
            const int tid_ = otid(), lane = tid_ & 63, wave = tid_ >> 6, wm = wave & 1, wn = wave >> 1, l31 = lane & 31, hi = lane >> 5;
            if (nt < 2) {
                LAS float* ssl = (LAS float*)(L + OFF_SS);
                const bool contrib = (nt == 0) || (wn < 2);
#pragma unroll
                for (int mi = 0; mi < 4; ++mi) {
                    float part = 0.f;
#pragma unroll
                    for (int ni = 0; ni < 2; ++ni)
#pragma unroll
                        for (int r = 0; r < 16; ++r) part += acc[mi][ni][r] * acc[mi][ni][r];
                    part += shx(part, 32, lane);
                    if (hi == 0) ssl[(128 * wm + 32 * mi + l31) * 4 + wn] = contrib ? part : 0.f;
                }
                __syncthreads();
                if (tid_ < 256) {
                    const f32x4 q4 = *(LAS f32x4*)(ssl + tid_ * 4);
                    const float ssum = (q4[0] + q4[1]) + (q4[2] + q4[3]);
                    float* rs = (float*)(p.ws + WS_CQN) + (nt == 0 ? 0 : (1 << 18));
                    rs[m0 + tid_] = rsqrtf(ssum * (nt == 0 ? 1.f / 256.f : 1.f / 128.f) + 1e-6f);
                }
            }
#pragma unroll
            for (int ni = 0; ni < 2; ++ni) {
                const int nbg = n0 + nb_of<0>(wn, ni);
                if (nbg == C_KR) {
#pragma unroll
                    for (int mi = 0; mi < 4; ++mi) {
                        const int m = m0 + 128 * wm + 32 * mi + l31;
#pragma unroll
                        for (int r = 0; r < 8; ++r) {
                            const f32x2 cs = rope[(size_t)m * 16 + crow(r, hi)];
                            const float x1 = acc[mi][ni][r], x2 = acc[mi][ni][r + 8];
                            acc[mi][ni][r] = x1 * cs.x - x2 * cs.y; acc[mi][ni][r + 8] = x2 * cs.x + x1 * cs.y;
                        }
                    }
                }
                if (nbg >= C_DQ && nbg < C_DK) {
#pragma unroll
                    for (int mi = 0; mi < 4; ++mi)
#pragma unroll
                        for (int r = 0; r < 16; ++r) acc[mi][ni][r] *= 0.125f * LOG2E;
                }
            }
            store_tile_bf16<4, 256>(Ls, acc, [&](int row, int c) -> bf16_t* { const int col = n0 + 8 * c; return col < NIN ? proj + (size_t)(m0 + row) * NIN + col : nullptr; });
        };
        gemm_tile<4, 0, true>(L, Dm / 64, NIN, h1, arow, bcol, epi);
    }
}

__device__ __forceinline__ void phase_qkv(const Params& p, LAS char* L) {
    const int v = vcu(), G = grid_g();
    const bf16_t* proj = (const bf16_t*)(p.ws + WS_PROJ);
    const float* rstd_q = (const float*)(p.ws + WS_CQN); const float* rstd_kv = rstd_q + (1 << 18);
    const bf16_t* w_uq = (const bf16_t*)(p.ws + WS_WB) + WB_UQ; const bf16_t* w_ukv = (const bf16_t*)(p.ws + WS_WB) + WB_UKV;
    bf16_t* qm = (bf16_t*)(p.ws + WS_QM); bf16_t* kf = (bf16_t*)(p.ws + WS_KF); bf16_t* vm = (bf16_t*)(p.ws + WS_VM);
    const f32x2* rope = (const f32x2*)(p.ws + WS_ROPE);
    const float qscale = LOG2E * 0.10206207261596575f;
    for (int u = v; u < 64 * 7; u += G) {
        const int mt = u / 7, j = u % 7, m0 = mt * 256;
        if (j < 3) {
            const int n0 = j * 256;
            auto arow = [&](int r) { return (unsigned)(m0 + r) * NIN + C_CQ; };
            auto bcol = [&](int c) { return w_uq + n0 + c; };
            auto epi = [&](f32x16 (&acc)[4][2], int seg, LAS char* Ls) {
                const int tid_ = otid(), lane = tid_ & 63, wave = tid_ >> 6, wm = wave & 1, wn = wave >> 1, l31 = lane & 31, hi = lane >> 5;
#pragma unroll
                for (int mi = 0; mi < 4; ++mi) {
                    const int m = m0 + 128 * wm + 32 * mi + l31;
                    const float qs = qscale * rstd_q[m];
#pragma unroll
                    for (int ni = 0; ni < 2; ++ni) {
                        const int nbg = n0 + nb_of<0>(wn, ni);
                        if ((nbg % 96) == 64) {
#pragma unroll
                            for (int r = 0; r < 8; ++r) {
                                const f32x2 cs = rope[(size_t)m * 16 + crow(r, hi)];
                                const float x1 = acc[mi][ni][r], x2 = acc[mi][ni][r + 8];
                                acc[mi][ni][r] = x1 * cs.x - x2 * cs.y; acc[mi][ni][r + 8] = x2 * cs.x + x1 * cs.y;
                            }
                        }
#pragma unroll
                        for (int r = 0; r < 16; ++r) acc[mi][ni][r] *= qs;
                    }
                }
                store_tile_bf16<4, 256>(Ls, acc, [&](int row, int c) -> bf16_t* { return qm + (size_t)(m0 + row) * 768 + n0 + 8 * c; });
            };
            gemm_tile<4, 0, true>(L, 256 / 64, 768, proj, arow, bcol, epi);
        } else {
            const int n0 = (j - 3) * 256;
            auto arow = [&](int r) { return (unsigned)(m0 + r) * NIN + C_CKV; };
            auto bcol = [&](int c) { return w_ukv + n0 + c; };
            auto epi = [&](f32x16 (&acc)[4][2], int seg, LAS char* Ls) {
                {
                    const int tid_ = otid(), lane = tid_ & 63, wave = tid_ >> 6, wm = wave & 1, l31 = lane & 31;
#pragma unroll
                    for (int mi = 0; mi < 4; ++mi) {
                        const float rs = rstd_kv[m0 + 128 * wm + 32 * mi + l31];
#pragma unroll
                        for (int ni = 0; ni < 2; ++ni)
#pragma unroll
                            for (int r = 0; r < 16; ++r) acc[mi][ni][r] *= rs;
                    }
                }
                store_tile_bf16<4, 256>(Ls, acc, [&](int row, int c) -> bf16_t* {
                    const int h = (n0 >> 7) + (c >> 4), cc = c & 15;
                    return cc < 8 ? kf + (size_t)(m0 + row) * 768 + h * 96 + 8 * cc : vm + (size_t)(m0 + row) * 512 + h * 64 + 8 * (cc - 8); });
            };
            gemm_tile<4, 0, true>(L, 128 / 64, 1024, proj, arow, bcol, epi);
        }
    }
}

template <int DQK, int DV, bool ALIBI>
__device__ __forceinline__ void attn_map(LAS char* L, const bf16_t* Q, int ldq, const bf16_t* K, int ldk, const bf16_t* V, int ldv,
                                         const int* posrow, float slope2, int q0, f32x16 (&o)[DV / 32], const bf16_t* K2 = nullptr, int ldk2 = 0) {
    constexpr int KSTR = DQK * 2 + 16, VSTR = DV * 2 + 64, KS = DQK / 16, ND = DV / 32;
    constexpr int K_OFF = 0, V_OFF = 64 * KSTR, P_OFF = V_OFF + 64 * VSTR, ABUF = P_OFF + 256;
    constexpr int KCH = DQK / 8, VCH = DV / 8;
    constexpr int NKI = (64 * KCH + NT - 1) / NT, NVI = (64 * VCH + NT - 1) / NT;
    static_assert(4 * ABUF <= G_LDS, "attention buffers");
    const int tid = otid();
    const int lane = tid & 63, wave = tid >> 6, l31 = lane & 31, hi = lane >> 5;
    const int qrow = q0 + 32 * wave + l31;
    unsigned kgo[NKI], klo[NKI], vgo[NVI], vlo[NVI];
    bool k2s[NKI];
#pragma unroll
    for (int i = 0; i < NKI; ++i) { int c = tid + NT * i; if (c >= 64 * KCH) c = 64 * KCH - 1; const int row = c / KCH, ch = c % KCH; k2s[i] = (DQK == 96) && (ch >= 8);
        kgo[i] = k2s[i] ? (unsigned)(row * ldk2 + (ch - 8) * 8) * 2u : (unsigned)(row * ldk + ch * 8) * 2u; klo[i] = K_OFF + row * KSTR + ch * 16; }
#pragma unroll
    for (int i = 0; i < NVI; ++i) { int c = tid + NT * i; if (c >= 64 * VCH) c = 64 * VCH - 1; const int row = c / VCH, ch = c % VCH; vgo[i] = (unsigned)(row * ldv + ch * 8) * 2u; vlo[i] = V_OFF + row * VSTR + ch * 16; }
    bf16x8 qf[KS];
#pragma unroll
    for (int s = 0; s < KS; ++s) qf[s] = *(const bf16x8*)(Q + (size_t)qrow * ldq + 16 * s + 8 * hi);
    const float posq = ALIBI ? (float)posrow[qrow] : 0.f;
#pragma unroll
    for (int d = 0; d < ND; ++d)
#pragma unroll
        for (int r = 0; r < 16; ++r) o[d][r] = 0.f;
    float m_run = -1e30f, l_run = 0.f;
    const int ntile = (q0 + 256) / 64;
    const int qmin = q0 + 32 * wave, qmax = qmin + 31;
    const int vrd = V_OFF + (4 * hi + ((lane & 15) >> 2)) * VSTR + 2 * (16 * ((lane >> 4) & 1) + 4 * (lane & 3));
    u32x4 rk[2][NKI], rv[2][NVI]; float rp = 0.f;
#define A_LOAD(T) do {        \
        _Pragma("unroll") for (int h_ = 0; h_ < 2; ++h_) { \
            const char* kbase_ = (const char*)(K + (size_t)(2 * (T) + h_) * 64 * ldk); const char* kbase2_ = (const char*)(K2 + (size_t)(2 * (T) + h_) * 64 * ldk2); \
            const char* vbase_ = (const char*)(V + (size_t)(2 * (T) + h_) * 64 * ldv); \
            _Pragma("unroll") for (int i = 0; i < NKI; ++i) rk[h_][i] = *(const u32x4*)((k2s[i] ? kbase2_ : kbase_) + kgo[i]); \
            _Pragma("unroll") for (int i = 0; i < NVI; ++i) rv[h_][i] = *(const u32x4*)(vbase_ + vgo[i]); } \
        if (ALIBI && tid < 128) rp = (float)posrow[(T) * 128 + tid]; } while (0)
#define A_STORE(LP) do { \
        _Pragma("unroll") for (int h_ = 0; h_ < 2; ++h_) { \
            _Pragma("unroll") for (int i = 0; i < NKI; ++i) if (tid + NT * i < 64 * KCH) *(LAS u32x4*)((LP) + h_ * ABUF + klo[i]) = rk[h_][i]; \
            _Pragma("unroll") for (int i = 0; i < NVI; ++i) if (tid + NT * i < 64 * VCH) *(LAS u32x4*)((LP) + h_ * ABUF + vlo[i]) = rv[h_][i]; } \
        if (ALIBI && tid < 128) *(LAS float*)((LP) + (tid >> 6) * ABUF + P_OFF + 4 * (tid & 63)) = rp; } while (0)
#define A_KFRAG(DST, LP, S_) do { DST[0] = *(LAS bf16x8*)((LP) + K_OFF + l31 * KSTR + 32 * (S_) + 16 * hi); DST[1] = *(LAS bf16x8*)((LP) + K_OFF + (32 + l31) * KSTR + 32 * (S_) + 16 * hi); } while (0)
#define A_SCORES(S0, S1, LP, KB) do { \
        bf16x8 kfa_[2], kfb_[2]; \
        A_KFRAG(kfa_, LP, 0); \
        _Pragma("unroll") for (int s = 0; s < KS; s += 2) {        \
            if (s + 1 < KS) A_KFRAG(kfb_, LP, s + 1); \
            if (s == 0) { S0 = MFMA32(kfa_[0], qf[0], z16); S1 = MFMA32(kfa_[1], qf[0], z16); }         \
            else { S0 = MFMA32(kfa_[0], qf[s], S0); S1 = MFMA32(kfa_[1], qf[s], S1); } \
            __builtin_amdgcn_sched_barrier(0); \
            if (s + 1 < KS) { \
                if (s + 2 < KS) A_KFRAG(kfa_, LP, s + 2); \
                S0 = MFMA32(kfb_[0], qf[s + 1], S0); S1 = MFMA32(kfb_[1], qf[s + 1], S1); \
                __builtin_amdgcn_sched_barrier(0); } } \
        if (ALIBI) { \
            _Pragma("unroll") for (int g4 = 0; g4 < 4; ++g4) { \
                const f32x4 pk0_ = *(LAS f32x4*)((LP) + P_OFF + 4 * (8 * g4 + 4 * hi)), pk1_ = *(LAS f32x4*)((LP) + P_OFF + 4 * (32 + 8 * g4 + 4 * hi)); \
                _Pragma("unroll") for (int e = 0; e < 4; ++e) { S0[4 * g4 + e] -= slope2 * fabsf(posq - pk0_[e]); S1[4 * g4 + e] -= slope2 * fabsf(posq - pk1_[e]); } } } \
        if ((KB) + 63 > qmin) { \
            _Pragma("unroll") for (int r = 0; r < 16; ++r) { const int key_ = (KB) + crow(r, hi); if (key_ > qrow) S0[r] = -INFINITY; if (key_ + 32 > qrow) S1[r] = -INFINITY; } } } while (0)
#define A_VFRAG(DST, LP, S_) do { _Pragma("unroll") for (int d = 0; d < ND; ++d) { \
            LAS char* vp_ = (LP) + vrd + 16 * (S_) * VSTR + 64 * d; const s16x4 lo_ = tr_read(vp_), h4_ = tr_read(vp_ + 8 * VSTR); \
            DST[d] = (bf16x8){lo_[0], lo_[1], lo_[2], lo_[3], h4_[0], h4_[1], h4_[2], h4_[3]}; } } while (0)
#define A_SOFTMAX_PV(S0, S1, LP) do { \
        bf16x8 vfa_[ND], vfb_[ND]; \
        A_VFRAG(vfa_, LP, 0);                                       \
        float mxa_ = S0[0], mxb_ = S0[8], mxc_ = S1[0], mxd_ = S1[8];          \
        _Pragma("unroll") for (int r = 1; r < 8; ++r) { mxa_ = fmaxf(mxa_, S0[r]); mxb_ = fmaxf(mxb_, S0[8 + r]); mxc_ = fmaxf(mxc_, S1[r]); mxd_ = fmaxf(mxd_, S1[8 + r]); } \
        float mx_ = fmaxf(fmaxf(mxa_, mxb_), fmaxf(mxc_, mxd_)); \
        { const auto rr_ = __builtin_amdgcn_permlane32_swap(__float_as_uint(mx_), __float_as_uint(mx_), false, false); mx_ = fmaxf(__uint_as_float(rr_[0]), __uint_as_float(rr_[1])); }     \
        if (__any(mx_ > m_run + 8.f)) { \
            const float m_new_ = fmaxf(m_run, mx_); const float alpha_ = __builtin_amdgcn_exp2f(m_run - m_new_); m_run = m_new_; l_run *= alpha_; \
            _Pragma("unroll") for (int d = 0; d < ND; ++d) _Pragma("unroll") for (int r = 0; r < 16; ++r) o[d][r] *= alpha_; } \
        float lsa_ = 0.f, lsb_ = 0.f, lsc_ = 0.f, lsd_ = 0.f; \
        _Pragma("unroll") for (int r = 0; r < 16; ++r) { S0[r] = __builtin_amdgcn_exp2f(S0[r] - m_run); S1[r] = __builtin_amdgcn_exp2f(S1[r] - m_run); } \
        _Pragma("unroll") for (int r = 0; r < 8; ++r) { lsa_ += S0[r]; lsb_ += S0[8 + r]; lsc_ += S1[r]; lsd_ += S1[8 + r]; } \
        l_run += (lsa_ + lsb_) + (lsc_ + lsd_); \
        u32x4 pw_[4]; \
        _Pragma("unroll") for (int j = 0; j < 4; ++j) { \
            pw_[0][j] = pk2(S0[2 * j], S0[2 * j + 1]); pw_[1][j] = pk2(S0[8 + 2 * j], S0[8 + 2 * j + 1]); \
            pw_[2][j] = pk2(S1[2 * j], S1[2 * j + 1]); pw_[3][j] = pk2(S1[8 + 2 * j], S1[8 + 2 * j + 1]); } \
        __builtin_amdgcn_sched_barrier(0); \
        A_VFRAG(vfb_, LP, 1); \
        _Pragma("unroll") for (int d = 0; d < ND; ++d) o[d] = MFMA32(vfa_[d], __builtin_bit_cast(bf16x8, pw_[0]), o[d]); \
        __builtin_amdgcn_sched_barrier(0); \
        A_VFRAG(vfa_, LP, 2); \
        _Pragma("unroll") for (int d = 0; d < ND; ++d) o[d] = MFMA32(vfb_[d], __builtin_bit_cast(bf16x8, pw_[1]), o[d]); \
        __builtin_amdgcn_sched_barrier(0); \
        A_VFRAG(vfb_, LP, 3); \
        _Pragma("unroll") for (int d = 0; d < ND; ++d) o[d] = MFMA32(vfa_[d], __builtin_bit_cast(bf16x8, pw_[2]), o[d]); \
        __builtin_amdgcn_sched_barrier(0); \
        _Pragma("unroll") for (int d = 0; d < ND; ++d) o[d] = MFMA32(vfb_[d], __builtin_bit_cast(bf16x8, pw_[3]), o[d]); \
        __builtin_amdgcn_sched_barrier(0); } while (0)
    A_LOAD(0);
    __syncthreads();
    A_STORE(L);
    __syncthreads();
    const f32x16 z16 = {0.f, 0.f, 0.f, 0.f, 0.f, 0.f, 0.f, 0.f, 0.f, 0.f, 0.f, 0.f, 0.f, 0.f, 0.f, 0.f};
    f32x16 sa0, sa1, sb0, sb1;
    const int nbt = ntile / 2;
    for (int T = 0; T < nbt; ++T) {
        LAS char* Lc = L + (T & 1) * 2 * ABUF; LAS char* Ln = L + ((T + 1) & 1) * 2 * ABUF;
        const int kb = T * 128;
        const bool more = T + 1 < nbt;
        if (more) A_LOAD(T + 1);
        const bool act0 = kb <= qmax, act1 = kb + 64 <= qmax;
        if (act0) {
            A_SCORES(sa0, sa1, Lc, kb);
            if (act1) {
                A_SCORES(sb0, sb1, Lc + ABUF, kb + 64);
                A_SOFTMAX_PV(sa0, sa1, Lc);
                A_SOFTMAX_PV(sb0, sb1, Lc + ABUF);
            } else {
                A_SOFTMAX_PV(sa0, sa1, Lc);
            }
        }
        if (more) A_STORE(Ln);
        __syncthreads();
    }
#undef A_LOAD
#undef A_STORE
#undef A_SCORES
#undef A_SOFTMAX_PV
#undef A_KFRAG
#undef A_VFRAG
    const float lt = l_run + shx(l_run, 32, lane);
    const float inv = 1.f / lt;
#pragma unroll
    for (int d = 0; d < ND; ++d)
#pragma unroll
        for (int r = 0; r < 16; ++r) o[d][r] *= inv;
}

__device__ __forceinline__ void attn_decode(int it, int& kind, int& qb, int& idx) {
    const int seg_kind[16] = {1, 1, 1, 1, 1, 0, 1, 0, 0, 0, 1, 0, 0, 1, 0, 0};
    const int seg_qb[16]   = {7, 6, 5, 4, 3, 7, 2, 6, 5, 4, 1, 3, 2, 0, 1, 0};
    int base = 0; kind = 0; qb = 0; idx = 0;
#pragma unroll
    for (int s = 0; s < 16; ++s) {
        const int n = seg_kind[s] ? 32 : 64;
        if (it >= base && it < base + n) { kind = seg_kind[s]; qb = seg_qb[s]; idx = it - base; }
        base += n;
    }
}

__device__ __forceinline__ void phase_attn(const Params& p, LAS char* L) {
    const int v = vcu(), G = grid_g();
    const int tid = otid(), lane = tid & 63, wave = tid >> 6, l31 = lane & 31, hi = lane >> 5;
    const int* positions = (const int*)p.in[2];
    const bf16_t* proj = (const bf16_t*)(p.ws + WS_PROJ);
    const bf16_t* qm = (const bf16_t*)(p.ws + WS_QM); const bf16_t* kf = (const bf16_t*)(p.ws + WS_KF); const bf16_t* vm = (const bf16_t*)(p.ws + WS_VM);
    bf16_t* att = (bf16_t*)(p.ws + WS_ATT);
    float* od0 = (float*)(p.ws + WS_OD0);
    const float* subg = p.in[16];
    unsigned* qctr = (unsigned*)(p.ws + WS_CTL + 2048);
    LAS unsigned* qslot = (LAS unsigned*)(L + OFF_MISC + 16);
    float lam;
    {
        const float a = p.in[12][lane] * p.in[13][lane], b = p.in[14][lane] * p.in[15][lane];
        lam = __expf(wave_sum(a, lane)) - __expf(wave_sum(b, lane)) + LAMBDA_INIT;
    }
    for (;;) {
        if (tid == 0) *qslot = __hip_atomic_fetch_add(qctr, 1u, __ATOMIC_RELAXED, __HIP_MEMORY_SCOPE_AGENT);
        __syncthreads();
        const int it = (int)*qslot;
        __syncthreads();
        if (it >= 768) break;
        int kind, qb, idx;
        attn_decode(it, kind, qb, idx);
        const int q0 = qb * 256;
        if (kind == 0) {
            const int b = idx >> 3, h = idx & 7; const size_t tb = (size_t)b * SEQ;
            f32x16 o[2];
            attn_map<96, 64, false>(L, qm + tb * 768 + h * 96, 768, kf + tb * 768 + h * 96, 768, vm + tb * 512 + h * 64, 512, positions + tb, 0.f, q0, o, proj + tb * NIN + C_KR, NIN);
            const size_t t = tb + q0 + 32 * wave + l31;
#pragma unroll
            for (int d = 0; d < 2; ++d)
#pragma unroll
                for (int gq = 0; gq < 4; ++gq) {
                    u32x2 w; w.x = pk2(o[d][4 * gq], o[d][4 * gq + 1]); w.y = pk2(o[d][4 * gq + 2], o[d][4 * gq + 3]);
                    *(u32x2*)(att + t * 1024 + h * 64 + 32 * d + 8 * gq + 4 * hi) = w;
                }
        } else {
            const int b = idx >> 2, h = idx & 3; const size_t tb = (size_t)b * SEQ;
            const float slope2 = exp2f(-2.f * (h + 1)) * LOG2E;
            const size_t t = tb + q0 + 32 * wave + l31;
            f32x16 o[4];
            attn_map<64, 128, true>(L, proj + tb * NIN + C_DQ + h * 128, NIN, proj + tb * NIN + C_DK + h * 128, NIN, proj + tb * NIN + C_DV + h * 128, NIN, positions + tb, slope2, q0, o);
#pragma unroll
            for (int d = 0; d < 4; ++d)
#pragma unroll
                for (int gq = 0; gq < 4; ++gq) {
                    f32x4 w = {o[d][4 * gq], o[d][4 * gq + 1], o[d][4 * gq + 2], o[d][4 * gq + 3]};
                    *(f32x4*)(od0 + t * 512 + h * 128 + 32 * d + 8 * gq + 4 * hi) = w;
                }
            attn_map<64, 128, true>(L, proj + tb * NIN + C_DQ + h * 128 + 64, NIN, proj + tb * NIN + C_DK + h * 128 + 64, NIN, proj + tb * NIN + C_DV + h * 128, NIN, positions + tb, slope2, q0, o);
            float ss = 0.f;
#pragma unroll
            for (int d = 0; d < 4; ++d)
#pragma unroll
                for (int gq = 0; gq < 4; ++gq) {
                    const f32x4 w = *(const f32x4*)(od0 + t * 512 + h * 128 + 32 * d + 8 * gq + 4 * hi);
#pragma unroll
                    for (int e = 0; e < 4; ++e) { const float c = w[e] - lam * o[d][4 * gq + e]; o[d][4 * gq + e] = c; ss += c * c; }
                }
            ss += shx(ss, 32, lane);
            const float rstd = rsqrtf(ss * (1.f / 128.f) + 1e-5f) * (1.f - LAMBDA_INIT);
#pragma unroll
            for (int d = 0; d < 4; ++d)
#pragma unroll
                for (int gq = 0; gq < 4; ++gq) {
                    const int dv = 32 * d + 8 * gq + 4 * hi;
                    const f32x4 gv = *(const f32x4*)(subg + dv);
                    u32x2 w; w.x = pk2(o[d][4 * gq] * rstd * gv[0], o[d][4 * gq + 1] * rstd * gv[1]); w.y = pk2(o[d][4 * gq + 2] * rstd * gv[2], o[d][4 * gq + 3] * rstd * gv[3]);
                    *(u32x2*)(att + t * 1024 + 512 + h * 128 + dv) = w;
                }
        }
    }
}

__device__ __forceinline__ void phase_oproj(const Params& p, LAS char* L) {
    const int v = vcu(), G = grid_g();
    const bf16_t* att = (const bf16_t*)(p.ws + WS_ATT);
    const bf16_t* w_o = (const bf16_t*)(p.ws + WS_WB) + WB_O;
    bf16_t* y1 = (bf16_t*)(p.ws + WS_Y1);
    for (int u = v; u < 64 * 4; u += G) {
        const int mt = u >> 2, nt = u & 3, m0 = mt * 256, n0 = nt * 256;
        auto arow = [&](int r) { return (unsigned)(m0 + r) * Dm; };
        auto bcol = [&](int c) { return w_o + n0 + c; };
        auto epi = [&](f32x16 (&acc)[4][2], int seg, LAS char* Ls) {
            store_tile_bf16<4, 256>(Ls, acc, [&](int row, int c) -> bf16_t* { return y1 + (size_t)(m0 + row) * Dm + n0 + 8 * c; });
        };
        gemm_tile<4, 0, true>(L, Dm / 64, Dm, att, arow, bcol, epi);
    }
}

__device__ __forceinline__ void post_attn_tokens(const Params& p, int t0, int nper) {
    const int tid = otid(), lane = tid & 63, wave = tid >> 6;
    const float* x = p.in[0]; const float* pg = p.in[6]; const float* fg = p.in[18];
    const float* mod = (const float*)(p.ws + WS_MOD);
    const bf16_t* y1 = (const bf16_t*)(p.ws + WS_Y1);
    bf16_t* h2 = (bf16_t*)(p.ws + WS_H2);
    for (int i_ = 0; i_ < nper; ++i_) {
        const int t = t0 + wave + NW * i_;
        const int b = t / SEQ;
        const float* mb = mod + b * 6144;
        f32x4 yv[4], xv[4]; float ss = 0.f;
#pragma unroll
        for (int j = 0; j < 4; ++j) {
            const u32x2 raw = *(const u32x2*)(y1 + (size_t)t * Dm + 4 * (lane + 64 * j));
            yv[j] = (f32x4){bflo(raw.x), bfhi(raw.x), bflo(raw.y), bfhi(raw.y)};
            xv[j] = *(const f32x4*)(x + (size_t)t * Dm + 4 * (lane + 64 * j));
            ss += yv[j][0] * yv[j][0] + yv[j][1] * yv[j][1] + yv[j][2] * yv[j][2] + yv[j][3] * yv[j][3];
        }
        ss = wave_sum(ss, lane);
        const float rstd = rsqrtf(ss * (1.f / Dm) + 1e-6f);
        float ss2 = 0.f;
#pragma unroll
        for (int j = 0; j < 4; ++j) {
            const int col = 4 * (lane + 64 * j);
            const f32x4 gv = *(const f32x4*)(pg + col), ga = *(const f32x4*)(mb + 2048 + col);
#pragma unroll
            for (int e = 0; e < 4; ++e) { xv[j][e] = xv[j][e] + ga[e] * (yv[j][e] * rstd * gv[e]); ss2 += xv[j][e] * xv[j][e]; }
            *(f32x4*)(p.out + (size_t)t * Dm + col) = xv[j];
        }
        ss2 = wave_sum(ss2, lane);
        const float rstd2 = rsqrtf(ss2 * (1.f / Dm) + 1e-6f);
#pragma unroll
        for (int j = 0; j < 4; ++j) {
            const int col = 4 * (lane + 64 * j);
            const f32x4 gv = *(const f32x4*)(fg + col), sv = *(const f32x4*)(mb + 4096 + col), hv = *(const f32x4*)(mb + 3072 + col);
            float o[4];
#pragma unroll
            for (int e = 0; e < 4; ++e) o[e] = (xv[j][e] * rstd2 * gv[e]) * (1.f + sv[e]) + hv[e];
            u32x2 w; w.x = pk2(o[0], o[1]); w.y = pk2(o[2], o[3]);
            *(u32x2*)(h2 + (size_t)t * Dm + col) = w;
        }
    }
}

__device__ __forceinline__ unsigned fkey(float f) { const unsigned u = __float_as_uint(f); return (u & 0x80000000u) ? ~u : (u | 0x80000000u); }
template <int CTRL, int RM> __device__ __forceinline__ unsigned dppu(unsigned old, unsigned src) { return (unsigned)__builtin_amdgcn_update_dpp((int)old, (int)src, CTRL, RM, 0xf, false); }
template <int CTRL, int RM> __device__ __forceinline__ float dppf(float old, float src) { return __int_as_float(__builtin_amdgcn_update_dpp(__float_as_int(old), __float_as_int(src), CTRL, RM, 0xf, false)); }
__device__ __forceinline__ unsigned wave_umax(unsigned v) {
    v = max(v, dppu<0x111, 0xf>(v, v)); v = max(v, dppu<0x112, 0xf>(v, v)); v = max(v, dppu<0x114, 0xf>(v, v)); v = max(v, dppu<0x118, 0xf>(v, v));
    v = max(v, dppu<0x142, 0xa>(v, v)); v = max(v, dppu<0x143, 0xc>(v, v));
    return (unsigned)__builtin_amdgcn_readlane((int)v, 63);
}
__device__ __forceinline__ float wave_fsum_dpp(float v) {
    v += dppf<0x111, 0xf>(0.f, v); v += dppf<0x112, 0xf>(0.f, v); v += dppf<0x114, 0xf>(0.f, v); v += dppf<0x118, 0xf>(0.f, v);
    v += dppf<0x142, 0xa>(0.f, v); v += dppf<0x143, 0xc>(0.f, v);
    return __int_as_float(__builtin_amdgcn_readlane(__float_as_int(v), 63));
}
__device__ __forceinline__ void phase_router_route(const Params& p, LAS char* L) {
    const int v = vcu(), G = grid_g();
    const bf16_t* h2 = (const bf16_t*)(p.ws + WS_H2);
    const bf16_t* rw = (const bf16_t*)(p.ws + WS_WB) + WB_R;
    const float* rb = p.in[21];
    int* cnt = (int*)(p.ws + WS_CTL);
    int* la = (int*)(p.ws + WS_LA); float* lw = (float*)(p.ws + WS_LW);
    constexpr int LSTR = 1040;
    LAS int* pe = (LAS int*)(L + 69632);
    LAS float* pw = (LAS float*)(L + 69632 + 2048);
    LAS int* hist = (LAS int*)(L + 69632 + 4096);
    LAS int* basep = (LAS int*)(L + 69632 + 5120);
    for (int u = v; u < T / 64; u += G) {
        const int m0 = u * 64;
        post_attn_tokens(p, m0, 8);
        asm volatile("s_waitcnt vmcnt(0)" ::: "memory");
        __syncthreads();
        auto arow = [&](int r) { return (unsigned)(m0 + r) * Dm; };
        auto bcol = [&](int c) { return rw + c; };
        auto epi = [&](f32x16 (&acc)[1][2], int seg, LAS char* Ls) {
            const int tid_ = otid(), lane = tid_ & 63, wave = tid_ >> 6, wm = wave & 1, wn = wave >> 1, l31 = lane & 31, hi = lane >> 5;
            const int row = 32 * wm + l31;
#pragma unroll
            for (int ni = 0; ni < 2; ++ni)
#pragma unroll
                for (int gq = 0; gq < 4; ++gq) {
                    f32x4 w = {acc[0][ni][4 * gq], acc[0][ni][4 * gq + 1], acc[0][ni][4 * gq + 2], acc[0][ni][4 * gq + 3]};
                    *(LAS f32x4*)(L + row * LSTR + 4 * (nb_of<0>(wn, ni) + 8 * gq + 4 * hi)) = w;
                }
        };
        gemm_tile<1, 0, true>(L, Dm / 64, NE, h2, arow, bcol, epi);
        const int tid = otid(), lane = tid & 63, wave = tid >> 6;
        if (tid < 256) hist[tid] = 0;
        __syncthreads();
        const f32x4 bias = *(const f32x4*)(rb + 4 * lane);
        const int grp = lane >> 3;
#pragma unroll 1
        for (int tt = 0; tt < 8; ++tt) {
            const int tok = 8 * wave + tt;
            const f32x4 lgv = *(LAS f32x4*)(L + tok * LSTR + 16 * lane);
            const float s0 = 1.f / (1.f + __expf(-lgv[0])), s1 = 1.f / (1.f + __expf(-lgv[1])), s2 = 1.f / (1.f + __expf(-lgv[2])), s3 = 1.f / (1.f + __expf(-lgv[3]));
            float v0 = s0 + bias[0], v1 = s1 + bias[1], v2 = s2 + bias[2], v3 = s3 + bias[3];
            float t1 = fmaxf(v0, v1), t2 = fminf(v0, v1);
            { const float a = fmaxf(v2, v3), bq = fminf(v2, v3); const float n1 = fmaxf(t1, a), n2 = fmaxf(fminf(t1, a), fmaxf(t2, bq)); t1 = n1; t2 = n2; }
            { const float o1 = dppf<0xB1, 0xf>(t1, t1), o2 = dppf<0xB1, 0xf>(t2, t2); const float n1 = fmaxf(t1, o1), n2 = fmaxf(fminf(t1, o1), fmaxf(t2, o2)); t1 = n1; t2 = n2; }
            { const float o1 = dppf<0x4E, 0xf>(t1, t1), o2 = dppf<0x4E, 0xf>(t2, t2); const float n1 = fmaxf(t1, o1), n2 = fmaxf(fminf(t1, o1), fmaxf(t2, o2)); t1 = n1; t2 = n2; }
            { const float o1 = shx(t1, 4, lane), o2 = shx(t2, 4, lane); const float n1 = fmaxf(t1, o1), n2 = fmaxf(fminf(t1, o1), fmaxf(t2, o2)); t1 = n1; t2 = n2; }
            const float gs = t1 + t2;
            int rank = 0;
#pragma unroll
            for (int gg = 0; gg < 8; ++gg) { const float og = __int_as_float(__builtin_amdgcn_readlane(__float_as_int(gs), gg * 8)); rank += (og > gs || (og == gs && gg < grp)) ? 1 : 0; }
            if (rank >= 4) { v0 = -INFINITY; v1 = -INFINITY; v2 = -INFINITY; v3 = -INFINITY; }
            unsigned k0 = fkey(v0), k1 = fkey(v1), k2 = fkey(v2), k3 = fkey(v3);
            bool c0 = false, c1 = false, c2 = false, c3 = false;
#pragma unroll
            for (int it = 0; it < TOPK; ++it) {
                const unsigned lb = max(max(k0, k1), max(k2, k3));
                const unsigned m = wave_umax(lb);
                const unsigned long long bal = __ballot(lb == m);
                const int owner = __builtin_ctzll(bal);
                if (lane == owner) {
                    if (k0 == m) { k0 = 0u; c0 = true; } else if (k1 == m) { k1 = 0u; c1 = true; } else if (k2 == m) { k2 = 0u; c2 = true; } else { k3 = 0u; c3 = true; }
                }
            }
            const float wsum = wave_fsum_dpp((c0 ? s0 : 0.f) + (c1 ? s1 : 0.f) + (c2 ? s2 : 0.f) + (c3 ? s3 : 0.f));
            const float wnorm = 2.5f / wsum;
            const unsigned long long b0 = __ballot(c0), b1 = __ballot(c1), b2 = __ballot(c2), b3 = __ballot(c3);
            const unsigned long long lm = (1ull << lane) - 1ull;
            const int q0 = __builtin_popcountll(b0 & lm), a1 = __builtin_popcountll(b0);
            const int q1 = a1 + __builtin_popcountll(b1 & lm), a2 = a1 + __builtin_popcountll(b1);
            const int q2 = a2 + __builtin_popcountll(b2 & lm), a3 = a2 + __builtin_popcountll(b2);
            const int q3 = a3 + __builtin_popcountll(b3 & lm);
            if (c0) { pe[8 * tok + q0] = 4 * lane + 0; pw[8 * tok + q0] = s0 * wnorm; }
            if (c1) { pe[8 * tok + q1] = 4 * lane + 1; pw[8 * tok + q1] = s1 * wnorm; }
            if (c2) { pe[8 * tok + q2] = 4 * lane + 2; pw[8 * tok + q2] = s2 * wnorm; }
            if (c3) { pe[8 * tok + q3] = 4 * lane + 3; pw[8 * tok + q3] = s3 * wnorm; }
        }
        __syncthreads();
        const int my_e = pe[tid];
        const int my_rank = __hip_atomic_fetch_add(hist + my_e, 1, __ATOMIC_RELAXED, __HIP_MEMORY_SCOPE_WORKGROUP);
        __syncthreads();
        if (tid < 256) { const int n = hist[tid]; basep[tid] = n > 0 ? atomicAdd(cnt + tid, n) : 0; }
        __syncthreads();
        {
            const int pos = basep[my_e] + my_rank;
            if (pos < LISTCAP) { la[(size_t)my_e * LISTCAP + pos] = (m0 + (tid >> 3)) * TOPK + (tid & 7); lw[(size_t)my_e * LISTCAP + pos] = pw[tid]; }
        }
        __syncthreads();
    }
}

__device__ __forceinline__ int moe_cnt(const int* cnt, int e) { int c = (e < 256) ? cnt[e] : T; return c > LISTCAP ? LISTCAP : c; }
__device__ __forceinline__ void moe_prefix(const Params& p, LAS char* L) {
    const int tid = otid();
    const int* cnt = (const int*)(p.ws + WS_CTL);
    LAS int* pre = (LAS int*)(L + OFF_PRE);
    LAS int* tl = (LAS int*)(L + OFF_TL);
    __syncthreads();
    for (int i = tid; i < 257; i += NT) { const int c = moe_cnt(cnt, i); tl[i] = (c + 255) >> 8; }
    __syncthreads();
    if (tid == 0) { int s = 0; for (int i = 0; i < 257; ++i) { pre[i] = s; s += tl[i]; } pre[257] = s; }
    __syncthreads();
}
__device__ __forceinline__ int moe_find(LAS int* pre, int g) {
    int lo = 0, hi = 256;
    while (lo < hi) { const int mid = (lo + hi + 1) >> 1; if (pre[mid] <= g) lo = mid; else hi = mid - 1; }
    return lo;
}

template <int MI>
__device__ __forceinline__ void moe1_unit(const Params& p, LAS char* L, int e, int r0, int rows, int j0) {
    const bf16_t* h2 = (const bf16_t*)(p.ws + WS_H2);
    const int* la = (const int*)(p.ws + WS_LA);
    bf16_t* hb = (bf16_t*)(p.ws + WS_HB);
    const float* wg = (e < 256) ? p.in[22] + (size_t)e * Dm * 256 : p.in[25];
    const float* wu = (e < 256) ? p.in[23] + (size_t)e * Dm * 256 : p.in[26];
    LAS int* rowid = (LAS int*)(L + OFF_ROW);
    {
        const int tid = otid();
        if (tid < 64 * MI) { const int rr = tid < rows ? tid : 0; rowid[tid] = (e < 256) ? la[(size_t)e * LISTCAP + r0 + rr] : (AR + r0 + rr); }
        __syncthreads();
    }
    auto arow = [&](int r) { const int a = rowid[r]; const int tok = (e < 256) ? (a >> 3) : (a - AR); return (unsigned)tok * Dm; };
    auto bcol = [&](int c4) { return (c4 < 128) ? (wg + j0 + c4) : (wu + j0 + c4 - 128); };
    auto epi = [&](f32x16 (&acc)[MI][2], int seg, LAS char* Ls) {
#pragma unroll
        for (int mi = 0; mi < MI; ++mi)
#pragma unroll
            for (int r = 0; r < 16; ++r) acc[mi][0][r] = silu_f(acc[mi][0][r]) * acc[mi][1][r];
        store_tile_bf16<MI, 128>(Ls, acc, [&](int row, int c) -> bf16_t* { return row < rows ? hb + (size_t)rowid[row] * 256 + j0 + 8 * c : nullptr; });
    };
    gemm_tile<MI, 1>(L, Dm / 64, 256, h2, arow, bcol, epi);
}
__device__ __forceinline__ void moe1_shared(const Params& p, LAS char* L, int r0, int j0) {
    const bf16_t* h2 = (const bf16_t*)(p.ws + WS_H2);
    bf16_t* hb = (bf16_t*)(p.ws + WS_HB);
    const bf16_t* wg = (const bf16_t*)(p.ws + WS_WB) + WB_SG; const bf16_t* wu = (const bf16_t*)(p.ws + WS_WB) + WB_SU;
    auto arow = [&](int r) { return (unsigned)(r0 + r) * Dm; };
    auto bcol = [&](int c8) { return (c8 < 128) ? (wg + j0 + c8) : (wu + j0 + c8 - 128); };
    auto epi = [&](f32x16 (&acc)[2][2], int seg, LAS char* Ls) {
#pragma unroll
        for (int mi = 0; mi < 2; ++mi)
#pragma unroll
            for (int r = 0; r < 16; ++r) acc[mi][0][r] = silu_f(acc[mi][0][r]) * acc[mi][1][r];
        store_tile_bf16<2, 128>(Ls, acc, [&](int row, int c) -> bf16_t* { return hb + (size_t)(AR + r0 + row) * 256 + j0 + 8 * c; });
    };
    gemm_tile<2, 1, true>(L, Dm / 64, 256, h2, arow, bcol, epi);
}
__device__ __forceinline__ void phase_moe1(const Params& p, LAS char* L) {
    const int v = vcu(), G = grid_g();
    const int* cnt = (const int*)(p.ws + WS_CTL);
    moe_prefix(p, L);
    LAS int* pre = (LAS int*)(L + OFF_PRE);
    const int total = __builtin_amdgcn_readfirstlane(pre[256]) * 2;
    for (int u = v; u < total; u += G) {
        const int g = u >> 1, j0 = (u & 1) * 128;
        const int e = __builtin_amdgcn_readfirstlane(moe_find(pre, g)), mt = g - __builtin_amdgcn_readfirstlane(pre[e]);
        const int rows = __builtin_amdgcn_readfirstlane(moe_cnt(cnt, e)) - mt * 256;
        if (rows > 128) moe1_unit<4>(p, L, e, mt * 256, rows < 256 ? rows : 256, j0);
        else moe1_unit<2>(p, L, e, mt * 256, rows, j0);
    }
    unsigned* qctr = (unsigned*)(p.ws + WS_CTL + 2048) + 128;
    LAS unsigned* qslot = (LAS unsigned*)(L + OFF_MISC + 16);
    const int tid = otid();
    for (;;) {
        if (tid == 0) *qslot = __hip_atomic_fetch_add(qctr, 1u, __ATOMIC_RELAXED, __HIP_MEMORY_SCOPE_AGENT);
        __syncthreads();
        const int q = __builtin_amdgcn_readfirstlane((int)*qslot);
        __syncthreads();
        if (q >= (T / 128) * 2) break;
        moe1_shared(p, L, (q >> 1) * 128, (q & 1) * 128);
    }
}

template <int MI>
__device__ __forceinline__ void moe2_unit(const Params& p, LAS char* L, int e, int r0, int rows, int n0) {
    const int* la = (const int*)(p.ws + WS_LA); const float* lw = (const float*)(p.ws + WS_LW);
    const bf16_t* hb = (const bf16_t*)(p.ws + WS_HB);
    unsigned char* yb = (unsigned char*)(p.ws + WS_YB);
    const float* wd = (e < 256) ? p.in[24] + (size_t)e * 256 * Dm : p.in[27];
    LAS int* rowid = (LAS int*)(L + OFF_ROW);
    LAS float* roww = (LAS float*)(L + OFF_RW);
    {
        const int tid = otid();
        if (tid < 64 * MI) {
            const int rr = tid < rows ? tid : 0;
            rowid[tid] = (e < 256) ? la[(size_t)e * LISTCAP + r0 + rr] : (AR + r0 + rr);
            roww[tid] = (e < 256) ? lw[(size_t)e * LISTCAP + r0 + rr] : 1.f;
        }
        __syncthreads();
    }
    auto arow = [&](int r) { return (unsigned)rowid[r] * 256; };
    auto bcol = [&](int c4) { return wd + n0 + c4; };
    auto epi = [&](f32x16 (&acc)[MI][2], int seg, LAS char* Ls) {
        const int tid_ = otid(), lane = tid_ & 63, wave = tid_ >> 6, wm = wave & 1, l31 = lane & 31;
#pragma unroll
        for (int mi = 0; mi < MI; ++mi) {
            const float w = roww[32 * MI * wm + 32 * mi + l31] * YSCALE;
#pragma unroll
            for (int ni = 0; ni < 2; ++ni)
#pragma unroll
                for (int q = 0; q < 16; ++q) acc[mi][ni][q] = __builtin_amdgcn_fmed3f(acc[mi][ni][q] * w, -448.f, 448.f);
        }
        store_tile_fp8<MI>(Ls, acc, [&](int row, int c) -> unsigned char* { return row < rows ? yb + (size_t)rowid[row] * Dm + n0 + seg * 256 + 16 * c : nullptr; });
    };
    gemm_tile<MI, 0, false, 2>(L, 256 / 64, Dm, hb, arow, bcol, epi);
}
__device__ __forceinline__ void moe2_shared(const Params& p, LAS char* L, int r0, int n0) {
    const bf16_t* hb = (const bf16_t*)(p.ws + WS_HB);
    unsigned char* yb = (unsigned char*)(p.ws + WS_YB);
    const bf16_t* wd = (const bf16_t*)(p.ws + WS_WB) + WB_SD;
    auto arow = [&](int r) { return (unsigned)(AR + r0 + r) * 256; };
    auto bcol = [&](int c8) { return wd + n0 + c8; };
    auto epi = [&](f32x16 (&acc)[2][2], int seg, LAS char* Ls) {
#pragma unroll
        for (int mi = 0; mi < 2; ++mi)
#pragma unroll
            for (int ni = 0; ni < 2; ++ni)
#pragma unroll
                for (int q = 0; q < 16; ++q) acc[mi][ni][q] = __builtin_amdgcn_fmed3f(acc[mi][ni][q] * YSCALE, -448.f, 448.f);
        store_tile_fp8<2>(Ls, acc, [&](int row, int c) -> unsigned char* { return yb + (size_t)(AR + r0 + row) * Dm + n0 + seg * 256 + 16 * c; });
    };
    gemm_tile<2, 0, true, 2>(L, 256 / 64, Dm, hb, arow, bcol, epi);
}
__device__ __forceinline__ void phase_moe2(const Params& p, LAS char* L) {
    const int v = vcu(), G = grid_g();
    const int* cnt = (const int*)(p.ws + WS_CTL);
    moe_prefix(p, L);
    LAS int* pre = (LAS int*)(L + OFF_PRE);
    const int total = __builtin_amdgcn_readfirstlane(pre[256]) * 2;
    for (int u = v; u < total; u += G) {
        const int g = u >> 1, n0 = (u & 1) * 512;
        const int e = __builtin_amdgcn_readfirstlane(moe_find(pre, g)), mt = g - __builtin_amdgcn_readfirstlane(pre[e]);
        const int rows = __builtin_amdgcn_readfirstlane(moe_cnt(cnt, e)) - mt * 256;
        if (rows > 128) moe2_unit<4>(p, L, e, mt * 256, rows < 256 ? rows : 256, n0);
        else moe2_unit<2>(p, L, e, mt * 256, rows, n0);
    }
    unsigned* qctr = (unsigned*)(p.ws + WS_CTL + 2048) + 192;
    LAS unsigned* qslot = (LAS unsigned*)(L + OFF_MISC + 16);
    const int tid = otid();
    for (;;) {
        if (tid == 0) *qslot = __hip_atomic_fetch_add(qctr, 1u, __ATOMIC_RELAXED, __HIP_MEMORY_SCOPE_AGENT);
        __syncthreads();
        const int q = __builtin_amdgcn_readfirstlane((int)*qslot);
        __syncthreads();
        if (q >= (T / 128) * 2) break;
        moe2_shared(p, L, (q >> 1) * 128, (q & 1) * 512);
    }
}

__device__ __forceinline__ void phase_final(const Params& p) {
    const int v = vcu(), G = grid_g();
    const int tid = otid(), lane = tid & 63, wave = tid >> 6;
    const float* pg = p.in[19];
    const float* mod = (const float*)(p.ws + WS_MOD);
    const unsigned char* yb = (const unsigned char*)(p.ws + WS_YB);
    for (int t = v * NW + wave; t < T; t += G * NW) {
        const int b = t / SEQ;
        const float* gf = mod + b * 6144 + 5120;
        float y[16];
#pragma unroll
        for (int e = 0; e < 16; ++e) y[e] = 0.f;
#pragma unroll
        for (int k = 0; k < 9; ++k) {
            const size_t row = (k < 8) ? ((size_t)t * TOPK + k) : ((size_t)AR + t);
            const u32x4 raw = *(const u32x4*)(yb + row * Dm + 16 * lane);
#pragma unroll
            for (int e = 0; e < 4; ++e) {
                const f32x2 a = __builtin_amdgcn_cvt_pk_f32_fp8((int)raw[e], false), c = __builtin_amdgcn_cvt_pk_f32_fp8((int)raw[e], true);
                y[4 * e] += a.x; y[4 * e + 1] += a.y; y[4 * e + 2] += c.x; y[4 * e + 3] += c.y;
            }
        }
        float ss = 0.f;
#pragma unroll
        for (int e = 0; e < 16; ++e) { y[e] *= (1.f / YSCALE); ss += y[e] * y[e]; }
        ss = wave_sum(ss, lane);
        const float rstd = rsqrtf(ss * (1.f / Dm) + 1e-6f);
        const int col = 16 * lane;
#pragma unroll
        for (int hq = 0; hq < 4; ++hq) {
            f32x4 xo = *(const f32x4*)(p.out + (size_t)t * Dm + col + 4 * hq);
            const f32x4 gv = *(const f32x4*)(pg + col + 4 * hq), gg = *(const f32x4*)(gf + col + 4 * hq);
#pragma unroll
            for (int e = 0; e < 4; ++e) xo[e] += gg[e] * (y[4 * hq + e] * rstd * gv[e]);
            *(f32x4*)(p.out + (size_t)t * Dm + col + 4 * hq) = xo;
        }
    }
}

#define XB_TMO      128
#define XB_XCNT(j)  (256  + 64 * (j))
#define XB_XSUB(j)  (1280 + 64 * (j))
#define XB_XGEN(j)  (2304 + 64 * (j))
#define XB_TOP      3328
#define XB_TOPGEN   3392
#define XCD_BAR_WORDS 3456
#define XB_SPIN_CAP (1u << 18)
__device__ __forceinline__ unsigned xb_ld(unsigned* p)              { return __hip_atomic_load(p, __ATOMIC_RELAXED, __HIP_MEMORY_SCOPE_AGENT); }
__device__ __forceinline__ unsigned xb_add(unsigned* p, unsigned v) { return __hip_atomic_fetch_add(p, v, __ATOMIC_RELAXED, __HIP_MEMORY_SCOPE_AGENT); }
__device__ __forceinline__ unsigned xb_xcc_id() { return (unsigned)__builtin_amdgcn_s_getreg((3 << 11) | 20) & 0xFu; }
#define XB_SPIN(cond, bar) do { unsigned _sp = 0; while (cond) { __builtin_amdgcn_s_sleep(1); \
    if ((++_sp & 255u) == 0u) { if (xb_ld(&(bar)[XB_TMO])) break; if (_sp > XB_SPIN_CAP) { atomicAdd(&(bar)[XB_TMO], 1u); break; } } } } while (0)
struct XcdBarrier { unsigned* bar; unsigned x; volatile LAS unsigned* st; };
__device__ __forceinline__ XcdBarrier xcd_barrier_post(unsigned* bar, volatile LAS unsigned* st) {
    XcdBarrier b; b.bar = bar; b.x = xb_xcc_id(); b.st = st;
    if (threadIdx.x == 0) (void)xb_add(&bar[XB_XCNT(b.x)], 1u);
    return b;
}
__device__ __forceinline__ void xcd_barrier_complete(unsigned* bar, unsigned x, unsigned& nloc, unsigned& nx) {
    const unsigned G = gridDim.x * gridDim.y * gridDim.z;
    unsigned sum, cnt, mine, sp = 0u;
    for (;;) {
        sum = 0u; cnt = 0u; mine = 0u;
#pragma unroll
        for (unsigned j = 0; j < 16; ++j) { const unsigned c = xb_ld(&bar[XB_XCNT(j)]); sum += c; cnt += (c > 0u) ? 1u : 0u; mine = (j == x) ? c : mine; }
        if (sum == G) break;
        __builtin_amdgcn_s_sleep(1);
        if ((++sp & 255u) == 0u) { if (xb_ld(&bar[XB_TMO])) break; if (sp > XB_SPIN_CAP) { atomicAdd(&bar[XB_TMO], 1u); break; } }
    }
    nloc = mine > 0u ? mine : 1u; nx = cnt > 0u ? cnt : 1u;
}
__device__ __forceinline__ void xcd_barrier(const Params& p, LAS char* L) {
    XcdBarrier b; b.bar = (unsigned*)(p.ws + WS_CTL + 4096); b.x = xb_xcc_id(); b.st = (volatile LAS unsigned*)(L + OFF_MISC);
    asm volatile("s_waitcnt vmcnt(0)" ::: "memory");
    __syncthreads();
    if (threadIdx.x == 0) {
        unsigned* bar = b.bar;
        __builtin_amdgcn_s_waitcnt(0);
        unsigned nloc = b.st[0], nx = b.st[1];
        if (nloc == 0u) { xcd_barrier_complete(bar, b.x, nloc, nx); b.st[0] = nloc; b.st[1] = nx; }
        const unsigned old = xb_add(&bar[XB_XSUB(b.x)], 1u);
        const unsigned gen = old / nloc;
        if (old + 1u == (gen + 1u) * nloc) {
            __builtin_amdgcn_fence(__ATOMIC_RELEASE, "agent");
            asm volatile("s_waitcnt vmcnt(0)" ::: "memory");
            const unsigned og = xb_add(&bar[XB_TOP], 1u);
            const unsigned tg = og / nx;
            if (og + 1u == (tg + 1u) * nx) xb_add(&bar[XB_TOPGEN], 1u);
            else XB_SPIN(xb_ld(&bar[XB_TOPGEN]) == tg, bar);
            __builtin_amdgcn_fence(__ATOMIC_ACQUIRE, "agent");
            xb_add(&bar[XB_XGEN(b.x)], 1u);
            asm volatile("s_waitcnt vmcnt(0)" ::: "memory");
        } else {
            XB_SPIN(xb_ld(&bar[XB_XGEN(b.x)]) == gen, bar);
            __builtin_amdgcn_fence(__ATOMIC_ACQUIRE, "agent");
            asm volatile("s_waitcnt vmcnt(0)" ::: "memory");
        }
    }
    __syncthreads();
}

__global__ void __launch_bounds__(NT, 2) mega(Params p) {
    extern __shared__ __attribute__((aligned(16))) char smem[];
    LAS char* L = (LAS char*)smem;
    if (threadIdx.x < 8) ((LAS unsigned*)(L + OFF_MISC))[threadIdx.x] = 0u;
    __syncthreads();
    (void)xcd_barrier_post((unsigned*)(p.ws + WS_CTL + 4096), (volatile LAS unsigned*)(L + OFF_MISC));
    phase_mod(p, L);
    xcd_barrier(p, L);
    phase_h1(p);
    xcd_barrier(p, L);
    phase_proj(p, L);
    xcd_barrier(p, L);
    phase_qkv(p, L);
    xcd_barrier(p, L);
    phase_attn(p, L);
    xcd_barrier(p, L);
    phase_oproj(p, L);
    xcd_barrier(p, L);
    phase_router_route(p, L);
    xcd_barrier(p, L);
    phase_moe1(p, L);
    xcd_barrier(p, L);
    phase_moe2(p, L);
    xcd_barrier(p, L);
    phase_final(p);
}

extern "C" void kernel_launch(void* const* d_in, const int* in_sizes, int n_in, void* d_out, int out_size, void* d_ws, size_t ws_size, hipStream_t stream) {
    static int grid_blocks = 0;
    if (grid_blocks == 0) {
        if (n_in != 28 || out_size != T * Dm || ws_size < WS_END) {
            fprintf(stderr, "kernel_launch: unexpected problem (n_in %d, out %d, ws %zu); nothing launched\n", n_in, out_size, ws_size);
            grid_blocks = -1; return;
        }
        int dev = 0, cus = 0, per_cu = 0;
        (void)hipGetDevice(&dev);
        (void)hipDeviceGetAttribute(&cus, hipDeviceAttributeMultiprocessorCount, dev);
        if (hipFuncSetAttribute((const void*)mega, hipFuncAttributeMaxDynamicSharedMemorySize, LDS_BYTES) != hipSuccess) {
            fprintf(stderr, "kernel_launch: hipFuncSetAttribute(%d B LDS) failed\n", LDS_BYTES); grid_blocks = -1; return;
        }
        (void)hipOccupancyMaxActiveBlocksPerMultiprocessor(&per_cu, mega, NT, LDS_BYTES);
        if (per_cu < 1) { fprintf(stderr, "kernel_launch: occupancy query says %d blocks per CU\n", per_cu); per_cu = 1; }
        grid_blocks = cus;
        fprintf(stderr, "kernel_launch: %d CUs, occupancy query %d per CU, grid %d\n", cus, per_cu, grid_blocks);
    }
    if (grid_blocks < 0) return;
    (void)hipMemsetAsync((char*)d_ws + WS_CTL, 0, CTL_BYTES, stream);
    Params p{};
    for (int i = 0; i < 28; ++i) p.in[i] = (const float*)d_in[i];
    p.out = (float*)d_out; p.ws = (char*)d_ws;
    void* args[] = {&p};
    hipError_t e = hipLaunchCooperativeKernel((void*)mega, dim3(grid_blocks), dim3(NT), args, LDS_BYTES, stream);
    if (e != hipSuccess) fprintf(stderr, "cooperative launch failed: %s (grid %d)\n", hipGetErrorString(e), grid_blocks);
}
```

```cpp
#include <hip/hip_runtime.h>
#include <cstdio>
#include <cstdint>


typedef unsigned short bf16_t;
typedef float f32x2 __attribute__((ext_vector_type(2)));
typedef short bf16x8 __attribute__((ext_vector_type(8)));
typedef short s16x4 __attribute__((ext_vector_type(4)));
typedef short v4i16_t __attribute__((ext_vector_type(4)));
typedef float f32x16 __attribute__((ext_vector_type(16)));
typedef float f32x4 __attribute__((ext_vector_type(4)));
typedef unsigned u32x4 __attribute__((ext_vector_type(4)));
typedef unsigned u32x2 __attribute__((ext_vector_type(2)));
#define LAS __attribute__((address_space(3)))

constexpr int NT = 512, NW = 8;
constexpr int Dm = 1024, NB = 8, SEQ = 2048, T = NB * SEQ;
constexpr int NIN = 1952;
constexpr int C_CQ = 0, C_CKV = 256, C_KR = 384, C_DQ = 416, C_DK = 928, C_DV = 1440;
constexpr int NE = 256, TOPK = 8, AR = T * TOPK, HROWS = AR + T;
constexpr int LISTCAP = T;
constexpr float LOG2E = 1.4426950408889634f;
constexpr float YSCALE = 32.f;
constexpr float LAMBDA_INIT = 0.2f;

constexpr size_t MiB = 1u << 20;
constexpr size_t WS_CTL = 0, CTL_BYTES = 65536;
constexpr size_t WS_MOD = 65536;
constexpr size_t WS_ROPE = 1 * MiB;
constexpr size_t WS_H1 = 4 * MiB;
constexpr size_t WS_PROJ = 36 * MiB;
constexpr size_t WS_CQN = 100 * MiB;
constexpr size_t WS_CKVN = 108 * MiB;
constexpr size_t WS_QM = 112 * MiB;
constexpr size_t WS_KF = 136 * MiB;
constexpr size_t WS_VM = 160 * MiB;
constexpr size_t WS_ATT = 176 * MiB;
constexpr size_t WS_OD0 = 208 * MiB;
constexpr size_t WS_Y1 = 240 * MiB;
constexpr size_t WS_H2 = 304 * MiB;
constexpr size_t WS_LOG = 336 * MiB;
constexpr size_t WS_LA = 352 * MiB;
constexpr size_t WS_LW = 368 * MiB;
constexpr size_t WS_HB = 384 * MiB;
constexpr size_t WS_YB = 456 * MiB;
constexpr size_t WS_WB = 744 * MiB;
constexpr size_t WB_IN = 0, WB_UQ = WB_IN + (size_t)1024 * 1952, WB_UKV = WB_UQ + 256 * 768, WB_O = WB_UKV + 128 * 1024, WB_R = WB_O + 1024 * 1024, WB_SG = WB_R + 1024 * 256, WB_SU = WB_SG + 1024 * 256, WB_SD = WB_SU + 1024 * 256, WB_END = WB_SD + 256 * 1024;
constexpr size_t WS_W8GU = 760 * MiB;
constexpr size_t WS_W8D = 892 * MiB;
constexpr size_t WS_H8 = 960 * MiB;
constexpr size_t WS_END = 976 * MiB;
constexpr float H8SCALE = 16.f, WGUSCALE = 256.f, WDSCALE = 128.f, HBSCALE = 8.f;

constexpr int G_XB = 32768, G_WB = 36864, G_BUF = G_XB + G_WB, G_LDS = 2 * G_BUF;
constexpr int OFF_MISC = G_LDS, OFF_PRE = OFF_MISC + 64, OFF_TL = OFF_PRE + 1088;
constexpr int OFF_ROW = OFF_TL + 1088, OFF_RW = OFF_ROW + 1024;
constexpr int OFF_SS = OFF_RW + 1024;
constexpr int LDS_BYTES = G_LDS + 4352 + 4096;

struct Params {
    const float* in[28];
    float* out;
    char* ws;
};

__device__ __forceinline__ unsigned short f2bf(float f) { __bf16 b = (__bf16)f; return __builtin_bit_cast(unsigned short, b); }
typedef __bf16 bf16x2_t __attribute__((ext_vector_type(2)));
__device__ __forceinline__ unsigned pk2(float lo, float hi) { const f32x2 v = {lo, hi}; return __builtin_bit_cast(unsigned, __builtin_convertvector(v, bf16x2_t)); }
__device__ __forceinline__ float bf2f(unsigned short b) { return __uint_as_float(((unsigned)b) << 16); }
__device__ __forceinline__ float bflo(unsigned u) { return __uint_as_float(u << 16); }
__device__ __forceinline__ float bfhi(unsigned u) { return __uint_as_float(u & 0xffff0000u); }
__device__ __forceinline__ int crow(int r, int hi) { return (r & 3) + 8 * (r >> 2) + 4 * hi; }
__device__ __forceinline__ float shx(float v, int m, int lane) { return __int_as_float(__builtin_amdgcn_ds_bpermute((lane ^ m) << 2, __float_as_int(v))); }
__device__ __forceinline__ int shxi(int v, int m, int lane) { return __builtin_amdgcn_ds_bpermute((lane ^ m) << 2, v); }
__device__ __forceinline__ float shl(float v, int src) { return __int_as_float(__builtin_amdgcn_ds_bpermute(src << 2, __float_as_int(v))); }
__device__ __forceinline__ float wave_sum(float v, int lane) {
#pragma unroll
    for (int o = 32; o >= 1; o >>= 1) v += shx(v, o, lane);
    return v;
}
__device__ __forceinline__ float silu_f(float v) { return v / (1.f + __expf(-v)); }
__device__ __forceinline__ s16x4 tr_read(LAS char* p) {
    return __builtin_bit_cast(s16x4, __builtin_amdgcn_ds_read_tr16_b64_v4i16((LAS v4i16_t*)p));
}
__device__ __forceinline__ int otid() { int t = threadIdx.x; asm volatile("" : "+v"(t)); return t; }
__device__ __forceinline__ int grid_g() { return gridDim.x; }
__device__ __forceinline__ int vcu() { const int G = gridDim.x, bx = blockIdx.x; return (G % 8 == 0) ? (bx % 8) * (G / 8) + bx / 8 : bx; }
__device__ __forceinline__ void gld16(u32x4& d, const void* p) { asm volatile("global_load_dwordx4 %0, %1, off" : "+v"(d) : "v"(p) : "memory"); }
__device__ __forceinline__ void gld16(f32x4& d, const void* p) { asm volatile("global_load_dwordx4 %0, %1, off" : "+v"(d) : "v"(p) : "memory"); }
template <int N> __device__ __forceinline__ void vm_wait(u32x4& a, f32x4& b, f32x4& c) { asm volatile("s_waitcnt vmcnt(%3)" : "+v"(a), "+v"(b), "+v"(c) : "n"(N) : "memory"); }
template <int N> __device__ __forceinline__ void vm_wait(f32x4& b, f32x4& c) { asm volatile("s_waitcnt vmcnt(%2)" : "+v"(b), "+v"(c) : "n"(N) : "memory"); }
template <int N> __device__ __forceinline__ void vm_wait(u32x4& a, u32x4& b) { asm volatile("s_waitcnt vmcnt(%2)" : "+v"(a), "+v"(b) : "n"(N) : "memory"); }
template <int N> __device__ __forceinline__ void vm_wait(u32x4& b) { asm volatile("s_waitcnt vmcnt(%1)" : "+v"(b) : "n"(N) : "memory"); }
#define MFMA32(a, b, c) __builtin_amdgcn_mfma_f32_32x32x16_bf16(a, b, c, 0, 0, 0)

template <int NBMODE> __device__ __forceinline__ int nb_of(int wn, int ni) { return NBMODE == 0 ? 64 * wn + 32 * ni : 32 * wn + 128 * ni; }

template <int MI, int NBMODE, bool WBF = false, int NSEG = 1, class AF, class BF, class EF>
__device__ __forceinline__ void gemm_tile(LAS char* L, int nk, long ldw, const bf16_t* abase, AF arow, BF bcol, EF epi) {
    asm volatile("" : "+s"(nk));
    const int tid = otid(), lane = tid & 63, wave = tid >> 6;
    const int wm = wave & 1, wn = wave >> 1, l31 = lane & 31, hi = lane >> 5;
    const int a_chunk = tid & 7, a_row = tid >> 3;
    const int a_w = a_row * 128 + 16 * (a_chunk ^ ((a_row >> 1) & 7));
    const int b_n4 = WBF ? (tid & 31) : (tid & 63), b_kr = WBF ? (tid >> 5) : (tid >> 6);
    const auto bp = bcol((WBF ? 8 : 4) * b_n4) + (long)b_kr * ldw;
    const int b_w = G_XB + b_kr * 576 + (WBF ? 16 : 8) * b_n4;
    const int sw = (l31 >> 1) & 7;
    const int xoff = (32 * MI * wm + l31) * 128;
    const int woff = G_XB + (8 * hi + ((lane & 15) >> 2)) * 576 + 2 * (16 * ((lane >> 4) & 1) + 4 * (lane & 3));
    u32x4 ra[MI]; f32x4 rb[8]; u32x4 rw[4];
#pragma unroll
    for (int i = 0; i < MI; ++i) ra[i] = (u32x4){0u, 0u, 0u, 0u};
#pragma unroll
    for (int i = 0; i < 8; ++i) rb[i] = (f32x4){0.f, 0.f, 0.f, 0.f};
#pragma unroll
    for (int i = 0; i < 4; ++i) rw[i] = (u32x4){0u, 0u, 0u, 0u};
#define G_LOADW(KOFF, Q, SEGC) do { \
        if (WBF) { gld16(rw[Q], bp + (long)((KOFF) + 16 * (Q)) * ldw + (SEGC)); } \
        else { gld16(rb[2 * (Q)], bp + (long)((KOFF) + 16 * (Q)) * ldw + (SEGC)); gld16(rb[2 * (Q) + 1], bp + (long)((KOFF) + 16 * (Q) + 8) * ldw + (SEGC)); } } while (0)
#define G_LOADQ(KT, Q) do { \
        if ((Q) < MI) gld16(ra[(Q) < MI ? (Q) : 0], abase + arow(a_row + 64 * (Q)) + a_chunk * 8 + (KT) * 64); \
        G_LOADW((KT) * 64, Q, 0); } while (0)
#define G_LOADQ_SEL(KT, SEG, Q, OK) do { \
        const int kq_ = (OK) ? (KT) * 64 : 0; const int sc_ = (OK) ? (SEG) * 256 : 0; \
        if ((Q) < MI) gld16(ra[(Q) < MI ? (Q) : 0], abase + arow(a_row + 64 * (Q)) + a_chunk * 8 + kq_); \
        G_LOADW(kq_, Q, sc_); } while (0)
#define G_WAITQ(Q, N) do { \
        if (WBF) { if ((Q) < MI) vm_wait<N>(ra[(Q) < MI ? (Q) : 0], rw[Q]); else vm_wait<N>(rw[Q]); } \
        else { if ((Q) < MI) vm_wait<N>(ra[(Q) < MI ? (Q) : 0], rb[2 * (Q)], rb[2 * (Q) + 1]); else vm_wait<N>(rb[2 * (Q)], rb[2 * (Q) + 1]); } } while (0)
#define G_STOREQ(LP, Q) do { \
        if ((Q) < MI) *(LAS u32x4*)((LP) + a_w + (Q) * 8192) = ra[(Q) < MI ? (Q) : 0]; \
        if (WBF) { *(LAS u32x4*)((LP) + b_w + (Q) * 16 * 576) = rw[Q]; } else { \
        { u32x2 w; w.x = pk2(rb[2 * (Q)][0], rb[2 * (Q)][1]); w.y = pk2(rb[2 * (Q)][2], rb[2 * (Q)][3]); *(LAS u32x2*)((LP) + b_w + (Q) * 16 * 576) = w; } \
        { u32x2 w; w.x = pk2(rb[2 * (Q) + 1][0], rb[2 * (Q) + 1][1]); w.y = pk2(rb[2 * (Q) + 1][2], rb[2 * (Q) + 1][3]); *(LAS u32x2*)((LP) + b_w + (Q) * 16 * 576 + 8 * 576) = w; } } } while (0)
    constexpr int NLW = WBF ? 1 : 2;
    constexpr int NL0 = NLW + ((0 < MI) ? 1 : 0), NL1 = NLW + ((1 < MI) ? 1 : 0), NL2 = NLW + ((2 < MI) ? 1 : 0), NL3 = NLW + ((3 < MI) ? 1 : 0), NLT = NL0 + NL1 + NL2 + NL3;
    G_LOADQ(0, 0); G_LOADQ(0, 1); G_LOADQ(0, 2); G_LOADQ(0, 3);
    G_WAITQ(0, 0); G_WAITQ(1, 0); G_WAITQ(2, 0); G_WAITQ(3, 0);
    G_STOREQ(L, 0); G_STOREQ(L, 1); G_STOREQ(L, 2); G_STOREQ(L, 3);
    G_LOADQ(1, 0); G_LOADQ(1, 1); G_LOADQ(1, 2); G_LOADQ(1, 3);
    f32x16 acc[MI][2];
#pragma unroll
    for (int i = 0; i < MI; ++i)
#pragma unroll
        for (int j = 0; j < 2; ++j)
#pragma unroll
            for (int r = 0; r < 16; ++r) acc[i][j][r] = 0.f;
    __syncthreads();
    const int nt_all = nk * NSEG;
    int lk = (nk == 2) ? 0 : 2, lseg = (nk == 2) ? 1 : 0;
    int ck = 0, cseg = 0;
#pragma nounroll
    for (int kt = 0; kt < nt_all; ++kt) {
        LAS char* Lb = L + (kt & 1) * G_BUF;
        LAS char* Ln = L + ((kt + 1) & 1) * G_BUF;
        const bool ld = kt + 2 < nt_all;
        bf16x8 xf[2][MI], wf[2][2];
#define LOAD_FRAGS(KS, B) do { \
            _Pragma("unroll") for (int mi = 0; mi < MI; ++mi) xf[B][mi] = *(LAS bf16x8*)(Lb + xoff + mi * 4096 + 16 * ((2 * (KS) + hi) ^ sw)); \
            _Pragma("unroll") for (int ni = 0; ni < 2; ++ni) { \
                LAS char* pp = Lb + woff + (KS) * 16 * 576 + 2 * nb_of<NBMODE>(wn, ni); \
                const s16x4 lo = tr_read(pp), h4 = tr_read(pp + 4 * 576); \
                wf[B][ni] = (bf16x8){lo[0], lo[1], lo[2], lo[3], h4[0], h4[1], h4[2], h4[3]}; } } while (0)
#define MMA_STEP(KS) do { \
            _Pragma("unroll") for (int mi = 0; mi < MI; ++mi) \
                _Pragma("unroll") for (int ni = 0; ni < 2; ++ni) acc[mi][ni] = MFMA32(wf[(KS) & 1][ni], xf[(KS) & 1][mi], acc[mi][ni]); } while (0)
#define STAGE_STEP(Q, NREST, NPREV) do { G_WAITQ(Q, (NREST) + (NPREV)); G_STOREQ(Ln, Q); G_LOADQ_SEL(lk, lseg, Q, ld); } while (0)
        LOAD_FRAGS(0, 0);
        LOAD_FRAGS(1, 1); MMA_STEP(0); STAGE_STEP(0, NL1 + NL2 + NL3, 0);           __builtin_amdgcn_sched_barrier(0);
        LOAD_FRAGS(2, 0); MMA_STEP(1); STAGE_STEP(1, NL2 + NL3, NL0);               __builtin_amdgcn_sched_barrier(0);
        LOAD_FRAGS(3, 1); MMA_STEP(2); STAGE_STEP(2, NL3, NL0 + NL1);               __builtin_amdgcn_sched_barrier(0);
        MMA_STEP(3);                   STAGE_STEP(3, 0, NL0 + NL1 + NL2);           __builtin_amdgcn_sched_barrier(0);
#undef LOAD_FRAGS
#undef MMA_STEP
#undef STAGE_STEP
        __syncthreads();
        if (++lk == nk) { lk = 0; ++lseg; }
        if (NSEG > 1) {
            if (++ck == nk) {
                ck = 0;
                if (cseg + 1 < NSEG) {
                    epi(acc, cseg, L + (kt & 1) * G_BUF);
#pragma unroll
                    for (int i = 0; i < MI; ++i)
#pragma unroll
                        for (int j = 0; j < 2; ++j)
#pragma unroll
                            for (int r = 0; r < 16; ++r) acc[i][j][r] = 0.f;
                }
                ++cseg;
            }
        }
    }
    G_WAITQ(0, 0); G_WAITQ(1, 0); G_WAITQ(2, 0); G_WAITQ(3, 0);
#undef G_LOADQ
#undef G_LOADQ_SEL
#undef G_LOADW
#undef G_WAITQ
#undef G_STOREQ
    (void)NLT;
    epi(acc, NSEG - 1, L);
}

template <int MI, int NC, class DF>
__device__ __forceinline__ void store_tile_bf16(LAS char* L, const f32x16 (&acc)[MI][2], DF dst) {
    constexpr int STR = NC * 2 + 16, CPR = NC / 8, BM = 64 * MI;
    const int tid = otid(), lane = tid & 63, wave = tid >> 6, wm = wave & 1, wn = wave >> 1, l31 = lane & 31, hi = lane >> 5;
#pragma unroll
    for (int mi = 0; mi < MI; ++mi)
#pragma unroll
        for (int ni = 0; ni < (NC == 256 ? 2 : 1); ++ni) {
            const int row = 32 * MI * wm + 32 * mi + l31, col = (NC == 256) ? nb_of<0>(wn, ni) : 32 * wn;
#pragma unroll
            for (int gq = 0; gq < 4; ++gq) {
                u32x2 w; w.x = pk2(acc[mi][ni][4 * gq], acc[mi][ni][4 * gq + 1]); w.y = pk2(acc[mi][ni][4 * gq + 2], acc[mi][ni][4 * gq + 3]);
                *(LAS u32x2*)(L + row * STR + 2 * (col + 8 * gq + 4 * hi)) = w;
            }
        }
    __syncthreads();
#pragma unroll
    for (int i = 0; i < (BM * CPR) / NT; ++i) {
        const int id = tid + NT * i, row = id / CPR, c = id % CPR;
        bf16_t* d = dst(row, c);
        if (d) *(u32x4*)d = *(LAS u32x4*)(L + row * STR + 16 * c);
    }
    __syncthreads();
}

template <int MI, int NC = 256, class DF>
__device__ __forceinline__ void store_tile_fp8(LAS char* L, const f32x16 (&acc)[MI][2], DF dst) {
    constexpr int STR = NC + 16, CPR = NC / 16, BM = 64 * MI;
    const int tid = otid(), lane = tid & 63, wave = tid >> 6, wm = wave & 1, wn = wave >> 1, l31 = lane & 31, hi = lane >> 5;
#pragma unroll
    for (int mi = 0; mi < MI; ++mi)
#pragma unroll
        for (int ni = 0; ni < (NC == 256 ? 2 : 1); ++ni) {
            const int row = 32 * MI * wm + 32 * mi + l31, col = (NC == 256) ? nb_of<0>(wn, ni) : 32 * wn;
#pragma unroll
            for (int gq = 0; gq < 4; ++gq) {
                int w = 0;
                w = __builtin_amdgcn_cvt_pk_fp8_f32(acc[mi][ni][4 * gq], acc[mi][ni][4 * gq + 1], w, false);
                w = __builtin_amdgcn_cvt_pk_fp8_f32(acc[mi][ni][4 * gq + 2], acc[mi][ni][4 * gq + 3], w, true);
                *(LAS int*)(L + row * STR + (col + 8 * gq + 4 * hi)) = w;
            }
        }
    __syncthreads();
#pragma unroll
    for (int i = 0; i < (BM * CPR) / NT; ++i) {
        const int id = tid + NT * i, row = id / CPR, c = id % CPR;
        unsigned char* d = dst(row, c);
        if (d) *(u32x4*)d = *(LAS u32x4*)(L + row * STR + 16 * c);
    }
    __syncthreads();
}

typedef int i32x8 __attribute__((ext_vector_type(8)));
constexpr int G8_XB = 32768;
#define MFMA8(a, b, c) __builtin_amdgcn_mfma_scale_f32_32x32x64_f8f6f4(a, b, c, 0, 0, 0, 0x7f7f7f7f, 0, 0x7f7f7f7f)
template <int MI, int NBMODE, int NSEG = 1, class AF, class WF, class EF>
__device__ __forceinline__ void gemm8_tile(LAS char* L, int nk, const unsigned char* abase, AF arow, const unsigned char* wbase, WF wrow, EF epi) {
    static_assert(MI == 2 || MI == 4, "MI");
    asm volatile("" : "+s"(nk));
    const int tid = otid(), lane = tid & 63, wave = tid >> 6;
    const int wm = wave & 1, wn = wave >> 1, l31 = lane & 31, hi = lane >> 5;
    const int a_chunk = tid & 7, a_row = tid >> 3;
    const int a_w = a_row * 128 + 16 * (a_chunk ^ ((a_row >> 1) & 7));
    const int sw = (l31 >> 1) & 7;
    const int xoff = (32 * MI * wm + l31) * 128;
    const int woff = G8_XB + l31 * 128;
    const int c00 = 16 * ((2 * hi) ^ sw), c01 = 16 * ((2 * hi + 1) ^ sw), c10 = 16 * ((4 + 2 * hi) ^ sw), c11 = 16 * ((5 + 2 * hi) ^ sw);
    u32x4 ra[MI], rw[4];
#pragma unroll
    for (int i = 0; i < MI; ++i) ra[i] = (u32x4){0u, 0u, 0u, 0u};
#pragma unroll
    for (int i = 0; i < 4; ++i) rw[i] = (u32x4){0u, 0u, 0u, 0u};
#define H_LOADQ_SEL(KT, SEG, Q, OK) do { \
        const int kq_ = (OK) ? (KT) * 128 : 0; const int sg_ = (OK) ? (SEG) : 0; \
        if ((Q) < MI) gld16(ra[(Q) < MI ? (Q) : 0], abase + arow(a_row + 64 * (Q)) + a_chunk * 16 + kq_); \
        gld16(rw[Q], wbase + wrow(sg_, a_row + 64 * (Q)) + a_chunk * 16 + kq_); } while (0)
#define H_WAITQ(Q, N) do { if ((Q) < MI) vm_wait<N>(ra[(Q) < MI ? (Q) : 0], rw[Q]); else vm_wait<N>(rw[Q]); } while (0)
#define H_STOREQ(LP, Q) do { \
        if ((Q) < MI) *(LAS u32x4*)((LP) + a_w + (Q) * 8192) = ra[(Q) < MI ? (Q) : 0]; \
        *(LAS u32x4*)((LP) + G8_XB + a_w + (Q) * 8192) = rw[Q]; } while (0)
    constexpr int NL0 = 2, NL1 = 2, NL2 = 1 + ((2 < MI) ? 1 : 0), NL3 = 1 + ((3 < MI) ? 1 : 0);
    H_LOADQ_SEL(0, 0, 0, true); H_LOADQ_SEL(0, 0, 1, true); H_LOADQ_SEL(0, 0, 2, true); H_LOADQ_SEL(0, 0, 3, true);
    H_WAITQ(0, 0); H_WAITQ(1, 0); H_WAITQ(2, 0); H_WAITQ(3, 0);
    H_STOREQ(L, 0); H_STOREQ(L, 1); H_STOREQ(L, 2); H_STOREQ(L, 3);
    H_LOADQ_SEL(1, 0, 0, true); H_LOADQ_SEL(1, 0, 1, true); H_LOADQ_SEL(1, 0, 2, true); H_LOADQ_SEL(1, 0, 3, true);
    f32x16 acc[MI][2];
#pragma unroll
    for (int i = 0; i < MI; ++i)
#pragma unroll
        for (int j = 0; j < 2; ++j)
#pragma unroll
            for (int r = 0; r < 16; ++r) acc[i][j][r] = 0.f;
    __syncthreads();
    const int nt_all = nk * NSEG;
    int lk = (nk == 2) ? 0 : 2, lseg = (nk == 2) ? 1 : 0;
    int ck = 0, cseg = 0;
#pragma nounroll
    for (int kt = 0; kt < nt_all; ++kt) {
        LAS char* Lb = L + (kt & 1) * G_BUF;
        LAS char* Ln = L + ((kt + 1) & 1) * G_BUF;
        const bool ld = kt + 2 < nt_all;
        i32x8 xfA[2], xfB[2], wfA[2], wfB[2];
#define H_FRAG(DST, P, CA, CB) do { const u32x4 lo_ = *(LAS u32x4*)((P) + (CA)), hh_ = *(LAS u32x4*)((P) + (CB)); \
            DST = (i32x8){(int)lo_[0], (int)lo_[1], (int)lo_[2], (int)lo_[3], (int)hh_[0], (int)hh_[1], (int)hh_[2], (int)hh_[3]}; } while (0)
#define H_LDW(DST, S) do { H_FRAG(DST[0], Lb + woff + 128 * nb_of<NBMODE>(wn, 0), (S) ? c10 : c00, (S) ? c11 : c01); H_FRAG(DST[1], Lb + woff + 128 * nb_of<NBMODE>(wn, 1), (S) ? c10 : c00, (S) ? c11 : c01); } while (0)
#define H_LDX(DST, S, M0) do { H_FRAG(DST[0], Lb + xoff + (M0) * 4096, (S) ? c10 : c00, (S) ? c11 : c01); H_FRAG(DST[1], Lb + xoff + ((M0) + 1) * 4096, (S) ? c10 : c00, (S) ? c11 : c01); } while (0)
#define H_MMA(WFR, XFR, M0) do { \
            acc[(M0)][0] = MFMA8(WFR[0], XFR[0], acc[(M0)][0]); acc[(M0)][1] = MFMA8(WFR[1], XFR[0], acc[(M0)][1]); \
            acc[(M0) + 1][0] = MFMA8(WFR[0], XFR[1], acc[(M0) + 1][0]); acc[(M0) + 1][1] = MFMA8(WFR[1], XFR[1], acc[(M0) + 1][1]); } while (0)
#define H_STAGE(Q, NREST, NPREV) do { H_WAITQ(Q, (NREST) + (NPREV)); H_STOREQ(Ln, Q); H_LOADQ_SEL(lk, lseg, Q, ld); } while (0)
        H_LDW(wfA, 0); H_LDX(xfA, 0, 0);
        if (MI == 4) {
            H_LDX(xfB, 0, 2);                 H_MMA(wfA, xfA, 0);      H_STAGE(0, NL1 + NL2 + NL3, 0);   __builtin_amdgcn_sched_barrier(0);
            H_LDW(wfB, 1); H_LDX(xfA, 1, 0);  H_MMA(wfA, xfB, MI - 2); H_STAGE(1, NL2 + NL3, NL0);       __builtin_amdgcn_sched_barrier(0);
            H_LDX(xfB, 1, 2);                 H_MMA(wfB, xfA, 0);      H_STAGE(2, NL3, NL0 + NL1);       __builtin_amdgcn_sched_barrier(0);
                                              H_MMA(wfB, xfB, MI - 2); H_STAGE(3, 0, NL0 + NL1 + NL2);   __builtin_amdgcn_sched_barrier(0);
        } else {
            H_LDW(wfB, 1); H_LDX(xfB, 1, 0);  H_MMA(wfA, xfA, 0);      H_STAGE(0, NL1 + NL2 + NL3, 0); H_STAGE(1, NL2 + NL3, NL0);               __builtin_amdgcn_sched_barrier(0);
                                              H_MMA(wfB, xfB, 0);      H_STAGE(2, NL3, NL0 + NL1);     H_STAGE(3, 0, NL0 + NL1 + NL2);           __builtin_amdgcn_sched_barrier(0);
        }
#undef H_FRAG
#undef H_LDW
#undef H_LDX
#undef H_MMA
#undef H_STAGE
        __syncthreads();
        if (++lk == nk) { lk = 0; ++lseg; }
        if (NSEG > 1) {
            if (++ck == nk) {
                ck = 0;
                if (cseg + 1 < NSEG) {
                    epi(acc, cseg, L + (kt & 1) * G_BUF);
#pragma unroll
                    for (int i = 0; i < MI; ++i)
#pragma unroll
                        for (int j = 0; j < 2; ++j)
#pragma unroll
                            for (int r = 0; r < 16; ++r) acc[i][j][r] = 0.f;
                }
                ++cseg;
            }
        }
    }
    H_WAITQ(0, 0); H_WAITQ(1, 0); H_WAITQ(2, 0); H_WAITQ(3, 0);
#undef H_LOADQ_SEL
#undef H_WAITQ
#undef H_STOREQ
    epi(acc, NSEG - 1, L);
}

__device__ __forceinline__ void phase_mod(const Params& p, LAS char* L) {
    const int v = vcu(), G = grid_g();
    const int tid = otid();
    const float* c = p.in[1]; const float* w_ada = p.in[3]; const float* b_ada = p.in[4];
    float* mod = (float*)(p.ws + WS_MOD);
    LAS float* sc = (LAS float*)L;
    LAS float* red = (LAS float*)(L + 32768);
    bool filled = false;
    for (int item = v; item < 192; item += G) {
        if (!filled) {
            for (int i = tid; i < 8 * 1024; i += NT) sc[i] = silu_f(c[i]);
            __syncthreads(); filled = true;
        }
        const int cx = tid & 31, kl = tid >> 5, col = item * 32 + cx;
        float a[8];
#pragma unroll
        for (int b = 0; b < 8; ++b) a[b] = 0.f;
#pragma unroll 8
        for (int k = kl; k < 1024; k += 16) {
            const float w = w_ada[(size_t)k * 6144 + col];
#pragma unroll
            for (int b = 0; b < 8; ++b) a[b] += sc[b * 1024 + k] * w;
        }
#pragma unroll
        for (int b = 0; b < 8; ++b) red[(b * 16 + kl) * 32 + cx] = a[b];
        __syncthreads();
        if (tid < 256) {
            const int b = tid >> 5, cc = tid & 31; float s_ = 0.f;
#pragma unroll
            for (int k = 0; k < 16; ++k) s_ += red[(b * 16 + k) * 32 + cc];
            mod[b * 6144 + item * 32 + cc] = s_ + b_ada[item * 32 + cc];
        }
        __syncthreads();
    }
    {
        bf16_t* wb = (bf16_t*)(p.ws + WS_WB);
        const size_t gt = (size_t)v * NT + tid, gs = (size_t)G * NT;
        auto conv = [&](const float* src, size_t off, size_t n) {
            for (size_t i = gt; i < n / 4; i += gs) { const f32x4 f = *(const f32x4*)(src + 4 * i); u32x2 w; w.x = pk2(f[0], f[1]); w.y = pk2(f[2], f[3]); *(u32x2*)(wb + off + 4 * i) = w; }
        };
        auto convg = [&](const float* src, size_t off, size_t n, int ncol, const float* gain) {
            for (size_t i = gt; i < n / 4; i += gs) { const float gk = gain[(4 * i) / ncol]; const f32x4 f = *(const f32x4*)(src + 4 * i); u32x2 w; w.x = pk2(f[0] * gk, f[1] * gk); w.y = pk2(f[2] * gk, f[3] * gk); *(u32x2*)(wb + off + 4 * i) = w; }
        };
        conv(p.in[7], WB_IN, (size_t)1024 * 1952); convg(p.in[10], WB_UQ, (size_t)256 * 768, 768, p.in[8]); convg(p.in[11], WB_UKV, (size_t)128 * 1024, 1024, p.in[9]);
        conv(p.in[17], WB_O, (size_t)1024 * 1024); conv(p.in[20], WB_R, (size_t)1024 * 256);
        conv(p.in[25], WB_SG, (size_t)1024 * 256); conv(p.in[26], WB_SU, (size_t)1024 * 256); conv(p.in[27], WB_SD, (size_t)256 * 1024);
    }
}

__device__ __forceinline__ void phase_h1(const Params& p) {
    const int v = vcu(), G = grid_g();
    const int tid = otid(), lane = tid & 63, wave = tid >> 6;
    const float* x = p.in[0]; const int* positions = (const int*)p.in[2]; const float* g = p.in[5];
    const float* mod = (const float*)(p.ws + WS_MOD);
    bf16_t* h1 = (bf16_t*)(p.ws + WS_H1);
    f32x2* rope = (f32x2*)(p.ws + WS_ROPE);
    for (int t = v * NW + wave; t < T; t += G * NW) {
        const int b = t / SEQ;
        const f32x4* xr = (const f32x4*)(x + (size_t)t * Dm);
        f32x4 xv[4]; float ss = 0.f;
#pragma unroll
        for (int j = 0; j < 4; ++j) { xv[j] = xr[lane + 64 * j]; ss += xv[j][0] * xv[j][0] + xv[j][1] * xv[j][1] + xv[j][2] * xv[j][2] + xv[j][3] * xv[j][3]; }
        ss = wave_sum(ss, lane);
        const float rstd = rsqrtf(ss * (1.f / Dm) + 1e-6f);
        const float* sh = mod + b * 6144; const float* scl = sh + 1024;
#pragma unroll
        for (int j = 0; j < 4; ++j) {
            const int col = 4 * (lane + 64 * j);
            const f32x4 gv = *(const f32x4*)(g + col), sv = *(const f32x4*)(scl + col), hv = *(const f32x4*)(sh + col);
            float o[4];
#pragma unroll
            for (int e = 0; e < 4; ++e) o[e] = (xv[j][e] * rstd * gv[e]) * (1.f + sv[e]) + hv[e];
            u32x2 w; w.x = pk2(o[0], o[1]); w.y = pk2(o[2], o[3]);
            *(u32x2*)(h1 + (size_t)t * Dm + col) = w;
        }
        if (lane < 16) {
            const double inv = exp2(-(double)lane * (13.287712379549449 / 16.0));
            const double rev = (double)positions[t] * inv * 0.15915494309189535;
            const float fr = (float)(rev - rint(rev));
            f32x2 cs; cs.x = __builtin_amdgcn_cosf(fr); cs.y = __builtin_amdgcn_sinf(fr);
            rope[(size_t)t * 16 + lane] = cs;
        }
    }
}

__device__ __forceinline__ void phase_proj(const Params& p, LAS char* L) {
    const int v = vcu(), G = grid_g();
    const bf16_t* h1 = (const bf16_t*)(p.ws + WS_H1);
    const bf16_t* w_in = (const bf16_t*)(p.ws + WS_WB) + WB_IN;
    bf16_t* proj = (bf16_t*)(p.ws + WS_PROJ);
    const f32x2* rope = (const f32x2*)(p.ws + WS_ROPE);
    for (int u = v; u < 64 * 8; u += G) {
        const int mt = u >> 3, nt = u & 7, m0 = mt * 256, n0 = nt * 256;
        auto arow = [&](int r) { return (unsigned)(m0 + r) * Dm; };
        auto bcol = [&](int c) { int col = n0 + c; if (col > NIN - 8) col = NIN - 8; return w_in + col; };
        auto epi = [&](f32x16 (&acc)[4][2], int seg, LAS char* Ls) {
            const int tid_ = otid(), lane = tid_ & 63, wave = tid_ >> 6, wm = wave & 1, wn = wave >> 1, l31 = lane & 31, hi = lane >> 5;
            if (nt < 2) {
                LAS float* ssl = (LAS float*)(L + OFF_SS);
                const bool contrib = (nt == 0) || (wn < 2);
#pragma unroll
                for (int mi = 0; mi < 4; ++mi) {
                    float part = 0.f;
#pragma unroll
                    for (int ni = 0; ni < 2; ++ni)
#pragma unroll
                        for (int r = 0; r < 16; ++r) part += acc[mi][ni][r] * acc[mi][ni][r];
                    part += shx(part, 32, lane);
                    if (hi == 0) ssl[(128 * wm + 32 * mi + l31) * 4 + wn] = contrib ? part : 0.f;
                }
                __syncthreads();
                if (tid_ < 256) {
                    const f32x4 q4 = *(LAS f32x4*)(ssl + tid_ * 4);
                    const float ssum = (q4[0] + q4[1]) + (q4[2] + q4[3]);
                    float* rs = (float*)(p.ws + WS_CQN) + (nt == 0 ? 0 : (1 << 18));
                    rs[m0 + tid_] = rsqrtf(ssum * (nt == 0 ? 1.f / 256.f : 1.f / 128.f) + 1e-6f);
                }
            }
#pragma unroll
            for (int ni = 0; ni < 2; ++ni) {
                const int nbg = n0 + nb_of<0>(wn, ni);
                if (nbg == C_KR) {
#pragma unroll
                    for (int mi = 0; mi < 4; ++mi) {
                        const int m = m0 + 128 * wm + 32 * mi + l31;
#pragma unroll
                        for (int r = 0; r < 8; ++r) {
                            const f32x2 cs = rope[(size_t)m * 16 + crow(r, hi)];
                            const float x1 = acc[mi][ni][r], x2 = acc[mi][ni][r + 8];
                            acc[mi][ni][r] = x1 * cs.x - x2 * cs.y; acc[mi][ni][r + 8] = x2 * cs.x + x1 * cs.y;
                        }
                    }
                }
                if (nbg >= C_DQ && nbg < C_DK) {
#pragma unroll
                    for (int mi = 0; mi < 4; ++mi)
#pragma unroll
                        for (int r = 0; r < 16; ++r) acc[mi][ni][r] *= 0.125f * LOG2E;
                }
            }
            store_tile_bf16<4, 256>(Ls, acc, [&](int row, int c) -> bf16_t* { const int col = n0 + 8 * c; return col < NIN ? proj + (size_t)(m0 + row) * NIN + col : nullptr; });
        };
        gemm_tile<4, 0, true>(L, Dm / 64, NIN, h1, arow, bcol, epi);
    }
}

__device__ __forceinline__ void phase_qkv(const Params& p, LAS char* L) {
    const int v = vcu(), G = grid_g();
    const bf16_t* proj = (const bf16_t*)(p.ws + WS_PROJ);
    const float* rstd_q = (const float*)(p.ws + WS_CQN); const float* rstd_kv = rstd_q + (1 << 18);
    const bf16_t* w_uq = (const bf16_t*)(p.ws + WS_WB) + WB_UQ; const bf16_t* w_ukv = (const bf16_t*)(p.ws + WS_WB) + WB_UKV;
    bf16_t* qm = (bf16_t*)(p.ws + WS_QM); bf16_t* kf = (bf16_t*)(p.ws + WS_KF); bf16_t* vm = (bf16_t*)(p.ws + WS_VM);
    const f32x2* rope = (const f32x2*)(p.ws + WS_ROPE);
    const float qscale = LOG2E * 0.10206207261596575f;
    for (int u = v; u < 64 * 7; u += G) {
        const int mt = u / 7, j = u % 7, m0 = mt * 256;
        if (j < 3) {
            const int n0 = j * 256;
            auto arow = [&](int r) { return (unsigned)(m0 + r) * NIN + C_CQ; };
            auto bcol = [&](int c) { return w_uq + n0 + c; };
            auto epi = [&](f32x16 (&acc)[4][2], int seg, LAS char* Ls) {
                const int tid_ = otid(), lane = tid_ & 63, wave = tid_ >> 6, wm = wave & 1, wn = wave >> 1, l31 = lane & 31, hi = lane >> 5;
#pragma unroll
                for (int mi = 0; mi < 4; ++mi) {
                    const int m = m0 + 128 * wm + 32 * mi + l31;
                    const float qs = qscale * rstd_q[m];
#pragma unroll
                    for (int ni = 0; ni < 2; ++ni) {
                        const int nbg = n0 + nb_of<0>(wn, ni);
                        if ((nbg % 96) == 64) {
#pragma unroll
                            for (int r = 0; r < 8; ++r) {
                                const f32x2 cs = rope[(size_t)m * 16 + crow(r, hi)];
                                const float x1 = acc[mi][ni][r], x2 = acc[mi][ni][r + 8];
                                acc[mi][ni][r] = x1 * cs.x - x2 * cs.y; acc[mi][ni][r + 8] = x2 * cs.x + x1 * cs.y;
                            }
                        }
#pragma unroll
                        for (int r = 0; r < 16; ++r) acc[mi][ni][r] *= qs;
                    }
                }
                store_tile_bf16<4, 256>(Ls, acc, [&](int row, int c) -> bf16_t* { return qm + (size_t)(m0 + row) * 768 + n0 + 8 * c; });
            };
            gemm_tile<4, 0, true>(L, 256 / 64, 768, proj, arow, bcol, epi);
        } else {
            const int n0 = (j - 3) * 256;
            auto arow = [&](int r) { return (unsigned)(m0 + r) * NIN + C_CKV; };
            auto bcol = [&](int c) { return w_ukv + n0 + c; };
            auto epi = [&](f32x16 (&acc)[4][2], int seg, LAS char* Ls) {
                {
                    const int tid_ = otid(), lane = tid_ & 63, wave = tid_ >> 6, wm = wave & 1, l31 = lane & 31;
#pragma unroll
                    for (int mi = 0; mi < 4; ++mi) {
                        const float rs = rstd_kv[m0 + 128 * wm + 32 * mi + l31];
#pragma unroll
                        for (int ni = 0; ni < 2; ++ni)
#pragma unroll
                            for (int r = 0; r < 16; ++r) acc[mi][ni][r] *= rs;
                    }
                }
                store_tile_bf16<4, 256>(Ls, acc, [&](int row, int c) -> bf16_t* {
                    const int h = (n0 >> 7) + (c >> 4), cc = c & 15;
                    return cc < 8 ? kf + (size_t)(m0 + row) * 768 + h * 96 + 8 * cc : vm + (size_t)(m0 + row) * 512 + h * 64 + 8 * (cc - 8); });
            };
            gemm_tile<4, 0, true>(L, 128 / 64, 1024, proj, arow, bcol, epi);
        }
    }
}

template <int DQK, int DV, bool ALIBI>
__device__ __forceinline__ void attn_map(LAS char* L, const bf16_t* Q, int ldq, const bf16_t* K, int ldk, const bf16_t* V, int ldv,
                                         const int* posrow, float slope2, int q0, f32x16 (&o)[DV / 32], const bf16_t* K2 = nullptr, int ldk2 = 0) {
    constexpr int KSTR = DQK * 2 + 16, VSTR = DV * 2 + 64, KS = DQK / 16, ND = DV / 32;
    constexpr int K_OFF = 0, V_OFF = 64 * KSTR, P_OFF = V_OFF + 64 * VSTR, ABUF = P_OFF + 256;
    constexpr int KCH = DQK / 8, VCH = DV / 8;
    constexpr int NKI = (64 * KCH + NT - 1) / NT, NVI = (64 * VCH + NT - 1) / NT;
    static_assert(4 * ABUF <= G_LDS, "attention buffers");
    const int tid = otid();
    const int lane = tid & 63, wave = tid >> 6, l31 = lane & 31, hi = lane >> 5;
    const int qrow = q0 + 32 * wave + l31;
    unsigned kgo[NKI], klo[NKI], vgo[NVI], vlo[NVI];
    bool k2s[NKI];
#pragma unroll
    for (int i = 0; i < NKI; ++i) { int c = tid + NT * i; if (c >= 64 * KCH) c = 64 * KCH - 1; const int row = c / KCH, ch = c % KCH; k2s[i] = (DQK == 96) && (ch >= 8);
        kgo[i] = k2s[i] ? (unsigned)(row * ldk2 + (ch - 8) * 8) * 2u : (unsigned)(row * ldk + ch * 8) * 2u; klo[i] = K_OFF + row * KSTR + ch * 16; }
#pragma unroll
    for (int i = 0; i < NVI; ++i) { int c = tid + NT * i; if (c >= 64 * VCH) c = 64 * VCH - 1; const int row = c / VCH, ch = c % VCH; vgo[i] = (unsigned)(row * ldv + ch * 8) * 2u; vlo[i] = V_OFF + row * VSTR + ch * 16; }
    bf16x8 qf[KS];
#pragma unroll
    for (int s = 0; s < KS; ++s) qf[s] = *(const bf16x8*)(Q + (size_t)qrow * ldq + 16 * s + 8 * hi);
    const float posq = ALIBI ? (float)posrow[qrow] : 0.f;
#pragma unroll
    for (int d = 0; d < ND; ++d)
#pragma unroll
        for (int r = 0; r < 16; ++r) o[d][r] = 0.f;
    float m_run = -1e30f, l_run = 0.f;
    const int ntile = (q0 + 256) / 64;
    const int qmin = q0 + 32 * wave, qmax = qmin + 31;
    const int vrd = V_OFF + (4 * hi + ((lane & 15) >> 2)) * VSTR + 2 * (16 * ((lane >> 4) & 1) + 4 * (lane & 3));
    u32x4 rk[2][NKI], rv[2][NVI]; float rp = 0.f;
#define A_LOAD(T) do {        \
        _Pragma("unroll") for (int h_ = 0; h_ < 2; ++h_) { \
            const char* kbase_ = (const char*)(K + (size_t)(2 * (T) + h_) * 64 * ldk); const char* kbase2_ = (const char*)(K2 + (size_t)(2 * (T) + h_) * 64 * ldk2); \
            const char* vbase_ = (const char*)(V + (size_t)(2 * (T) + h_) * 64 * ldv); \
            _Pragma("unroll") for (int i = 0; i < NKI; ++i) rk[h_][i] = *(const u32x4*)((k2s[i] ? kbase2_ : kbase_) + kgo[i]); \
            _Pragma("unroll") for (int i = 0; i < NVI; ++i) rv[h_][i] = *(const u32x4*)(vbase_ + vgo[i]); } \
        if (ALIBI && tid < 128) rp = (float)posrow[(T) * 128 + tid]; } while (0)
#define A_STORE(LP) do { \
        _Pragma("unroll") for (int h_ = 0; h_ < 2; ++h_) { \
            _Pragma("unroll") for (int i = 0; i < NKI; ++i) if (tid + NT * i < 64 * KCH) *(LAS u32x4*)((LP) + h_ * ABUF + klo[i]) = rk[h_][i]; \
            _Pragma("unroll") for (int i = 0; i < NVI; ++i) if (tid + NT * i < 64 * VCH) *(LAS u32x4*)((LP) + h_ * ABUF + vlo[i]) = rv[h_][i]; } \
        if (ALIBI && tid < 128) *(LAS float*)((LP) + (tid >> 6) * ABUF + P_OFF + 4 * (tid & 63)) = rp; } while (0)
#define A_KFRAG(DST, LP, S_) do { DST[0] = *(LAS bf16x8*)((LP) + K_OFF + l31 * KSTR + 32 * (S_) + 16 * hi); DST[1] = *(LAS bf16x8*)((LP) + K_OFF + (32 + l31) * KSTR + 32 * (S_) + 16 * hi); } while (0)
#define A_SCORES(S0, S1, LP, KB) do { \
        bf16x8 kfa_[2], kfb_[2]; \
        A_KFRAG(kfa_, LP, 0); \
        _Pragma("unroll") for (int s = 0; s < KS; s += 2) {        \
            if (s + 1 < KS) A_KFRAG(kfb_, LP, s + 1); \
            if (s == 0) { S0 = MFMA32(kfa_[0], qf[0], z16); S1 = MFMA32(kfa_[1], qf[0], z16); }         \
            else { S0 = MFMA32(kfa_[0], qf[s], S0); S1 = MFMA32(kfa_[1], qf[s], S1); } \
            __builtin_amdgcn_sched_barrier(0); \
            if (s + 1 < KS) { \
                if (s + 2 < KS) A_KFRAG(kfa_, LP, s + 2); \
                S0 = MFMA32(kfb_[0], qf[s + 1], S0); S1 = MFMA32(kfb_[1], qf[s + 1], S1); \
                __builtin_amdgcn_sched_barrier(0); } } \
        if (ALIBI) { \
            _Pragma("unroll") for (int g4 = 0; g4 < 4; ++g4) { \
                const f32x4 pk0_ = *(LAS f32x4*)((LP) + P_OFF + 4 * (8 * g4 + 4 * hi)), pk1_ = *(LAS f32x4*)((LP) + P_OFF + 4 * (32 + 8 * g4 + 4 * hi)); \
                _Pragma("unroll") for (int e = 0; e < 4; ++e) { S0[4 * g4 + e] -= slope2 * fabsf(posq - pk0_[e]); S1[4 * g4 + e] -= slope2 * fabsf(posq - pk1_[e]); } } } \
        if ((KB) + 63 > qmin) { \
            _Pragma("unroll") for (int r = 0; r < 16; ++r) { const int key_ = (KB) + crow(r, hi); if (key_ > qrow) S0[r] = -INFINITY; if (key_ + 32 > qrow) S1[r] = -INFINITY; } } } while (0)
#define A_VFRAG(DST, LP, S_) do { _Pragma("unroll") for (int d = 0; d < ND; ++d) { \
            LAS char* vp_ = (LP) + vrd + 16 * (S_) * VSTR + 64 * d; const s16x4 lo_ = tr_read(vp_), h4_ = tr_read(vp_ + 8 * VSTR); \
            DST[d] = (bf16x8){lo_[0], lo_[1], lo_[2], lo_[3], h4_[0], h4_[1], h4_[2], h4_[3]}; } } while (0)
#define A_SOFTMAX_PV(S0, S1, LP) do { \
        bf16x8 vfa_[ND], vfb_[ND]; \
        A_VFRAG(vfa_, LP, 0);                                       \
        float mxa_ = S0[0], mxb_ = S0[8], mxc_ = S1[0], mxd_ = S1[8];          \
        _Pragma("unroll") for (int r = 1; r < 8; ++r) { mxa_ = fmaxf(mxa_, S0[r]); mxb_ = fmaxf(mxb_, S0[8 + r]); mxc_ = fmaxf(mxc_, S1[r]); mxd_ = fmaxf(mxd_, S1[8 + r]); } \
        float mx_ = fmaxf(fmaxf(mxa_, mxb_), fmaxf(mxc_, mxd_)); \
        { const auto rr_ = __builtin_amdgcn_permlane32_swap(__float_as_uint(mx_), __float_as_uint(mx_), false, false); mx_ = fmaxf(__uint_as_float(rr_[0]), __uint_as_float(rr_[1])); }     \
        if (__any(mx_ > m_run + 8.f)) { \
            const float m_new_ = fmaxf(m_run, mx_); const float alpha_ = __builtin_amdgcn_exp2f(m_run - m_new_); m_run = m_new_; l_run *= alpha_; \
            _Pragma("unroll") for (int d = 0; d < ND; ++d) _Pragma("unroll") for (int r = 0; r < 16; ++r) o[d][r] *= alpha_; } \
        float lsa_ = 0.f, lsb_ = 0.f, lsc_ = 0.f, lsd_ = 0.f; \
        _Pragma("unroll") for (int r = 0; r < 16; ++r) { S0[r] = __builtin_amdgcn_exp2f(S0[r] - m_run); S1[r] = __builtin_amdgcn_exp2f(S1[r] - m_run); } \
        _Pragma("unroll") for (int r = 0; r < 8; ++r) { lsa_ += S0[r]; lsb_ += S0[8 + r]; lsc_ += S1[r]; lsd_ += S1[8 + r]; } \
        l_run += (lsa_ + lsb_) + (lsc_ + lsd_); \
        u32x4 pw_[4]; \
        _Pragma("unroll") for (int j = 0; j < 4; ++j) { \
            pw_[0][j] = pk2(S0[2 * j], S0[2 * j + 1]); pw_[1][j] = pk2(S0[8 + 2 * j], S0[8 + 2 * j + 1]); \
            pw_[2][j] = pk2(S1[2 * j], S1[2 * j + 1]); pw_[3][j] = pk2(S1[8 + 2 * j], S1[8 + 2 * j + 1]); } \
        __builtin_amdgcn_sched_barrier(0); \
        A_VFRAG(vfb_, LP, 1); \
        _Pragma("unroll") for (int d = 0; d < ND; ++d) o[d] = MFMA32(vfa_[d], __builtin_bit_cast(bf16x8, pw_[0]), o[d]); \
        __builtin_amdgcn_sched_barrier(0); \
        A_VFRAG(vfa_, LP, 2); \
        _Pragma("unroll") for (int d = 0; d < ND; ++d) o[d] = MFMA32(vfb_[d], __builtin_bit_cast(bf16x8, pw_[1]), o[d]); \
        __builtin_amdgcn_sched_barrier(0); \
        A_VFRAG(vfb_, LP, 3); \
        _Pragma("unroll") for (int d = 0; d < ND; ++d) o[d] = MFMA32(vfa_[d], __builtin_bit_cast(bf16x8, pw_[2]), o[d]); \
        __builtin_amdgcn_sched_barrier(0); \
        _Pragma("unroll") for (int d = 0; d < ND; ++d) o[d] = MFMA32(vfb_[d], __builtin_bit_cast(bf16x8, pw_[3]), o[d]); \
        __builtin_amdgcn_sched_barrier(0); } while (0)
    A_LOAD(0);
    __syncthreads();
    A_STORE(L);
    __syncthreads();
    const f32x16 z16 = {0.f, 0.f, 0.f, 0.f, 0.f, 0.f, 0.f, 0.f, 0.f, 0.f, 0.f, 0.f, 0.f, 0.f, 0.f, 0.f};
    f32x16 sa0, sa1, sb0, sb1;
    const int nbt = ntile / 2;
    for (int T = 0; T < nbt; ++T) {
        LAS char* Lc = L + (T & 1) * 2 * ABUF; LAS char* Ln = L + ((T + 1) & 1) * 2 * ABUF;
        const int kb = T * 128;
        const bool more = T + 1 < nbt;
        if (more) A_LOAD(T + 1);
        const bool act0 = kb <= qmax, act1 = kb + 64 <= qmax;
        if (act0) {
            A_SCORES(sa0, sa1, Lc, kb);
            if (act1) {
                A_SCORES(sb0, sb1, Lc + ABUF, kb + 64);
                A_SOFTMAX_PV(sa0, sa1, Lc);
                A_SOFTMAX_PV(sb0, sb1, Lc + ABUF);
            } else {
                A_SOFTMAX_PV(sa0, sa1, Lc);
            }
        }
        if (more) A_STORE(Ln);
        __syncthreads();
    }
#undef A_LOAD
#undef A_STORE
#undef A_SCORES
#undef A_SOFTMAX_PV
#undef A_KFRAG
#undef A_VFRAG
    const float lt = l_run + shx(l_run, 32, lane);
    const float inv = 1.f / lt;
#pragma unroll
    for (int d = 0; d < ND; ++d)
#pragma unroll
        for (int r = 0; r < 16; ++r) o[d][r] *= inv;
}

__device__ __forceinline__ void attn_decode(int it, int& kind, int& qb, int& idx) {
    const int seg_kind[16] = {1, 1, 1, 1, 1, 0, 1, 0, 0, 0, 1, 0, 0, 1, 0, 0};
    const int seg_qb[16]   = {7, 6, 5, 4, 3, 7, 2, 6, 5, 4, 1, 3, 2, 0, 1, 0};
    int base = 0; kind = 0; qb = 0; idx = 0;
#pragma unroll
    for (int s = 0; s < 16; ++s) {
        const int n = seg_kind[s] ? 32 : 64;
        if (it >= base && it < base + n) { kind = seg_kind[s]; qb = seg_qb[s]; idx = it - base; }
        base += n;
    }
}

constexpr int NCONV = 257 * 12;
__device__ __forceinline__ void conv_item(const Params& p, LAS char* L, int c) {
    const int tid = otid();
    const int e = c / 12, sub = c - 12 * e;
    const bool down = sub >= 8;
    const float* src; unsigned char* dst; float scale;
    if (!down) {
        const int up = sub >> 2, n0 = (sub & 3) * 64;
        src = (e < 256 ? p.in[22 + up] + (size_t)e * Dm * 256 : p.in[25 + up]) + n0;
        dst = (unsigned char*)(p.ws + WS_W8GU) + ((size_t)e * 512 + up * 256 + n0) * 1024;
        scale = WGUSCALE;
    } else {
        const int n0 = (sub - 8) * 256;
        src = (e < 256 ? p.in[24] + (size_t)e * 256 * Dm : p.in[27]) + n0;
        dst = (unsigned char*)(p.ws + WS_W8D) + ((size_t)e * 1024 + n0) * 256;
        scale = WDSCALE;
    }
    const int np = down ? 1024 : 256, rb = down ? 256 : 1024;
    const int nq = tid & 15, kr = tid >> 4;
    f32x4 v[8][4];
#pragma unroll
    for (int g = 0; g < 8; ++g) {
        const float* sg = src + (down ? 64 * (g >> 1) + (size_t)(128 * (g & 1)) * np : (size_t)(128 * g) * np) + (size_t)(4 * kr) * np + 4 * nq;
#pragma unroll
        for (int kk = 0; kk < 4; ++kk) v[g][kk] = __builtin_nontemporal_load((const f32x4*)(sg + (size_t)kk * np));
    }
#pragma unroll
    for (int g = 0; g < 8; ++g) {
        const int nl0 = (down ? 64 * (g >> 1) : 0) + 4 * nq, kd = kr + 32 * (down ? (g & 1) : g);
        const int pos = 4 * (kd ^ (4 * (nq & 7)));
#pragma unroll
        for (int cc = 0; cc < 4; ++cc) {
            int w = 0;
            w = __builtin_amdgcn_cvt_pk_fp8_f32(v[g][0][cc] * scale, v[g][1][cc] * scale, w, false);
            w = __builtin_amdgcn_cvt_pk_fp8_f32(v[g][2][cc] * scale, v[g][3][cc] * scale, w, true);
            *(LAS int*)(L + (nl0 + cc) * rb + pos) = w;
        }
    }
    __syncthreads();
#pragma unroll
    for (int j = 0; j < 8; ++j) {
        const int id = tid + NT * j;
        const int row = down ? (id >> 4) : (id >> 6), ch = down ? (id & 15) : (id & 63);
        *(u32x4*)(dst + (size_t)16 * id) = *(LAS u32x4*)(L + row * rb + 16 * (ch ^ ((row >> 2) & 7)));
    }
    __syncthreads();
}

__device__ __forceinline__ void phase_attn(const Params& p, LAS char* L) {
    const int v = vcu(), G = grid_g();
    const int tid = otid(), lane = tid & 63, wave = tid >> 6, l31 = lane & 31, hi = lane >> 5;
    const int* positions = (const int*)p.in[2];
    const bf16_t* proj = (const bf16_t*)(p.ws + WS_PROJ);
    const bf16_t* qm = (const bf16_t*)(p.ws + WS_QM); const bf16_t* kf = (const bf16_t*)(p.ws + WS_KF); const bf16_t* vm = (const bf16_t*)(p.ws + WS_VM);
    bf16_t* att = (bf16_t*)(p.ws + WS_ATT);
    float* od0 = (float*)(p.ws + WS_OD0);
    const float* subg = p.in[16];
    unsigned* qctr = (unsigned*)(p.ws + WS_CTL + 2048);
    LAS unsigned* qslot = (LAS unsigned*)(L + OFF_MISC + 16);
    float lam;
    {
        const float a = p.in[12][lane] * p.in[13][lane], b = p.in[14][lane] * p.in[15][lane];
        lam = __expf(wave_sum(a, lane)) - __expf(wave_sum(b, lane)) + LAMBDA_INIT;
    }
    for (;;) {
        if (tid == 0) *qslot = __hip_atomic_fetch_add(qctr, 1u, __ATOMIC_RELAXED, __HIP_MEMORY_SCOPE_AGENT);
        __syncthreads();
        int it = __builtin_amdgcn_readfirstlane((int)*qslot);
        __syncthreads();
        if (it >= 768 + NCONV) break;
        if (it >= 768 * 5) { conv_item(p, L, 768 * 4 + (it - 768 * 5)); continue; }
        if (it % 5 != 0) { conv_item(p, L, (it / 5) * 4 + (it % 5) - 1); continue; }
        it /= 5;
        int kind, qb, idx;
        attn_decode(it, kind, qb, idx);
        const int q0 = qb * 256;
        if (kind == 0) {
            const int b = idx >> 3, h = idx & 7; const size_t tb = (size_t)b * SEQ;
            f32x16 o[2];
            attn_map<96, 64, false>(L, qm + tb * 768 + h * 96, 768, kf + tb * 768 + h * 96, 768, vm + tb * 512 + h * 64, 512, positions + tb, 0.f, q0, o, proj + tb * NIN + C_KR, NIN);
            const size_t t = tb + q0 + 32 * wave + l31;
#pragma unroll
            for (int d = 0; d < 2; ++d)
#pragma unroll
                for (int gq = 0; gq < 4; ++gq) {
                    u32x2 w; w.x = pk2(o[d][4 * gq], o[d][4 * gq + 1]); w.y = pk2(o[d][4 * gq + 2], o[d][4 * gq + 3]);
                    *(u32x2*)(att + t * 1024 + h * 64 + 32 * d + 8 * gq + 4 * hi) = w;
                }
        } else {
            const int b = idx >> 2, h = idx & 3; const size_t tb = (size_t)b * SEQ;
            const float slope2 = exp2f(-2.f * (h + 1)) * LOG2E;
            const size_t t = tb + q0 + 32 * wave + l31;
            f32x16 o[4];
            attn_map<64, 128, true>(L, proj + tb * NIN + C_DQ + h * 128, NIN, proj + tb * NIN + C_DK + h * 128, NIN, proj + tb * NIN + C_DV + h * 128, NIN, positions + tb, slope2, q0, o);
#pragma unroll
            for (int d = 0; d < 4; ++d)
#pragma unroll
                for (int gq = 0; gq < 4; ++gq) {
                    f32x4 w = {o[d][4 * gq], o[d][4 * gq + 1], o[d][4 * gq + 2], o[d][4 * gq + 3]};
                    *(f32x4*)(od0 + t * 512 + h * 128 + 32 * d + 8 * gq + 4 * hi) = w;
                }
            attn_map<64, 128, true>(L, proj + tb * NIN + C_DQ + h * 128 + 64, NIN, proj + tb * NIN + C_DK + h * 128 + 64, NIN, proj + tb * NIN + C_DV + h * 128, NIN, positions + tb, slope2, q0, o);
            float ss = 0.f;
#pragma unroll
            for (int d = 0; d < 4; ++d)
#pragma unroll
                for (int gq = 0; gq < 4; ++gq) {
                    const f32x4 w = *(const f32x4*)(od0 + t * 512 + h * 128 + 32 * d + 8 * gq + 4 * hi);
#pragma unroll
                    for (int e = 0; e < 4; ++e) { const float c = w[e] - lam * o[d][4 * gq + e]; o[d][4 * gq + e] = c; ss += c * c; }
                }
            ss += shx(ss, 32, lane);
            const float rstd = rsqrtf(ss * (1.f / 128.f) + 1e-5f) * (1.f - LAMBDA_INIT);
#pragma unroll
            for (int d = 0; d < 4; ++d)
#pragma unroll
                for (int gq = 0; gq < 4; ++gq) {
                    const int dv = 32 * d + 8 * gq + 4 * hi;
                    const f32x4 gv = *(const f32x4*)(subg + dv);
                    u32x2 w; w.x = pk2(o[d][4 * gq] * rstd * gv[0], o[d][4 * gq + 1] * rstd * gv[1]); w.y = pk2(o[d][4 * gq + 2] * rstd * gv[2], o[d][4 * gq + 3] * rstd * gv[3]);
                    *(u32x2*)(att + t * 1024 + 512 + h * 128 + dv) = w;
                }
        }
    }
}

__device__ __forceinline__ void phase_oproj(const Params& p, LAS char* L) {
    const int v = vcu(), G = grid_g();
    const bf16_t* att = (const bf16_t*)(p.ws + WS_ATT);
    const bf16_t* w_o = (const bf16_t*)(p.ws + WS_WB) + WB_O;
    bf16_t* y1 = (bf16_t*)(p.ws + WS_Y1);
    for (int u = v; u < 64 * 4; u += G) {
        const int mt = u >> 2, nt = u & 3, m0 = mt * 256, n0 = nt * 256;
        auto arow = [&](int r) { return (unsigned)(m0 + r) * Dm; };
        auto bcol = [&](int c) { return w_o + n0 + c; };
        auto epi = [&](f32x16 (&acc)[4][2], int seg, LAS char* Ls) {
            store_tile_bf16<4, 256>(Ls, acc, [&](int row, int c) -> bf16_t* { return y1 + (size_t)(m0 + row) * Dm + n0 + 8 * c; });
        };
        gemm_tile<4, 0, true>(L, Dm / 64, Dm, att, arow, bcol, epi);
    }
}

__device__ __forceinline__ void post_attn_tokens(const Params& p, int t0, int nper) {
    const int tid = otid(), lane = tid & 63, wave = tid >> 6;
    const float* x = p.in[0]; const float* pg = p.in[6]; const float* fg = p.in[18];
    const float* mod = (const float*)(p.ws + WS_MOD);
    const bf16_t* y1 = (const bf16_t*)(p.ws + WS_Y1);
    bf16_t* h2 = (bf16_t*)(p.ws + WS_H2);
    unsigned char* h8 = (unsigned char*)(p.ws + WS_H8);
    for (int i_ = 0; i_ < nper; ++i_) {
        const int t = t0 + wave + NW * i_;
        const int b = t / SEQ;
        const float* mb = mod + b * 6144;
        f32x4 yv[4], xv[4]; float ss = 0.f;
#pragma unroll
        for (int j = 0; j < 4; ++j) {
            const u32x2 raw = *(const u32x2*)(y1 + (size_t)t * Dm + 4 * (lane + 64 * j));
            yv[j] = (f32x4){bflo(raw.x), bfhi(raw.x), bflo(raw.y), bfhi(raw.y)};
            xv[j] = *(const f32x4*)(x + (size_t)t * Dm + 4 * (lane + 64 * j));
            ss += yv[j][0] * yv[j][0] + yv[j][1] * yv[j][1] + yv[j][2] * yv[j][2] + yv[j][3] * yv[j][3];
        }
        ss = wave_sum(ss, lane);
        const float rstd = rsqrtf(ss * (1.f / Dm) + 1e-6f);
        float ss2 = 0.f;
#pragma unroll
        for (int j = 0; j < 4; ++j) {
            const int col = 4 * (lane + 64 * j);
            const f32x4 gv = *(const f32x4*)(pg + col), ga = *(const f32x4*)(mb + 2048 + col);
#pragma unroll
            for (int e = 0; e < 4; ++e) { xv[j][e] = xv[j][e] + ga[e] * (yv[j][e] * rstd * gv[e]); ss2 += xv[j][e] * xv[j][e]; }
            *(f32x4*)(p.out + (size_t)t * Dm + col) = xv[j];
        }
        ss2 = wave_sum(ss2, lane);
        const float rstd2 = rsqrtf(ss2 * (1.f / Dm) + 1e-6f);
#pragma unroll
        for (int j = 0; j < 4; ++j) {
            const int col = 4 * (lane + 64 * j);
            const f32x4 gv = *(const f32x4*)(fg + col), sv = *(const f32x4*)(mb + 4096 + col), hv = *(const f32x4*)(mb + 3072 + col);
            float o[4];
#pragma unroll
            for (int e = 0; e < 4; ++e) o[e] = (xv[j][e] * rstd2 * gv[e]) * (1.f + sv[e]) + hv[e];
            u32x2 w; w.x = pk2(o[0], o[1]); w.y = pk2(o[2], o[3]);
            *(u32x2*)(h2 + (size_t)t * Dm + col) = w;
            int w8 = 0;
            w8 = __builtin_amdgcn_cvt_pk_fp8_f32(__builtin_amdgcn_fmed3f(o[0] * H8SCALE, -448.f, 448.f), __builtin_amdgcn_fmed3f(o[1] * H8SCALE, -448.f, 448.f), w8, false);
            w8 = __builtin_amdgcn_cvt_pk_fp8_f32(__builtin_amdgcn_fmed3f(o[2] * H8SCALE, -448.f, 448.f), __builtin_amdgcn_fmed3f(o[3] * H8SCALE, -448.f, 448.f), w8, true);
            *(int*)(h8 + (size_t)t * Dm + col) = w8;
        }
    }
}

__device__ __forceinline__ unsigned fkey(float f) { const unsigned u = __float_as_uint(f); return (u & 0x80000000u) ? ~u : (u | 0x80000000u); }
template <int CTRL, int RM> __device__ __forceinline__ unsigned dppu(unsigned old, unsigned src) { return (unsigned)__builtin_amdgcn_update_dpp((int)old, (int)src, CTRL, RM, 0xf, false); }
template <int CTRL, int RM> __device__ __forceinline__ float dppf(float old, float src) { return __int_as_float(__builtin_amdgcn_update_dpp(__float_as_int(old), __float_as_int(src), CTRL, RM, 0xf, false)); }
__device__ __forceinline__ unsigned wave_umax(unsigned v) {
    v = max(v, dppu<0x111, 0xf>(v, v)); v = max(v, dppu<0x112, 0xf>(v, v)); v = max(v, dppu<0x114, 0xf>(v, v)); v = max(v, dppu<0x118, 0xf>(v, v));
    v = max(v, dppu<0x142, 0xa>(v, v)); v = max(v, dppu<0x143, 0xc>(v, v));
    return (unsigned)__builtin_amdgcn_readlane((int)v, 63);
}
__device__ __forceinline__ float wave_fsum_dpp(float v) {
    v += dppf<0x111, 0xf>(0.f, v); v += dppf<0x112, 0xf>(0.f, v); v += dppf<0x114, 0xf>(0.f, v); v += dppf<0x118, 0xf>(0.f, v);
    v += dppf<0x142, 0xa>(0.f, v); v += dppf<0x143, 0xc>(0.f, v);
    return __int_as_float(__builtin_amdgcn_readlane(__float_as_int(v), 63));
}
__device__ __forceinline__ void phase_router_route(const Params& p, LAS char* L) {
    const int v = vcu(), G = grid_g();
    const bf16_t* h2 = (const bf16_t*)(p.ws + WS_H2);
    const bf16_t* rw = (const bf16_t*)(p.ws + WS_WB) + WB_R;
    const float* rb = p.in[21];
    int* cnt = (int*)(p.ws + WS_CTL);
    int* la = (int*)(p.ws + WS_LA); float* lw = (float*)(p.ws + WS_LW);
    constexpr int LSTR = 1040;
    LAS int* pe = (LAS int*)(L + 69632);
    LAS float* pw = (LAS float*)(L + 69632 + 2048);
    LAS int* hist = (LAS int*)(L + 69632 + 4096);
    LAS int* basep = (LAS int*)(L + 69632 + 5120);
    for (int u = v; u < T / 64; u += G) {
        const int m0 = u * 64;
        post_attn_tokens(p, m0, 8);
        asm volatile("s_waitcnt vmcnt(0)" ::: "memory");
        __syncthreads();
        auto arow = [&](int r) { return (unsigned)(m0 + r) * Dm; };
        auto bcol = [&](int c) { return rw + c; };
        auto epi = [&](f32x16 (&acc)[1][2], int seg, LAS char* Ls) {
            const int tid_ = otid(), lane = tid_ & 63, wave = tid_ >> 6, wm = wave & 1, wn = wave >> 1, l31 = lane & 31, hi = lane >> 5;
            const int row = 32 * wm + l31;
#pragma unroll
            for (int ni = 0; ni < 2; ++ni)
#pragma unroll
                for (int gq = 0; gq < 4; ++gq) {
                    f32x4 w = {acc[0][ni][4 * gq], acc[0][ni][4 * gq + 1], acc[0][ni][4 * gq + 2], acc[0][ni][4 * gq + 3]};
                    *(LAS f32x4*)(L + row * LSTR + 4 * (nb_of<0>(wn, ni) + 8 * gq + 4 * hi)) = w;
                }
        };
        gemm_tile<1, 0, true>(L, Dm / 64, NE, h2, arow, bcol, epi);
        const int tid = otid(), lane = tid & 63, wave = tid >> 6;
        if (tid < 256) hist[tid] = 0;
        __syncthreads();
        const f32x4 bias = *(const f32x4*)(rb + 4 * lane);
        const int grp = lane >> 3;
#pragma unroll 1
        for (int tt = 0; tt < 8; ++tt) {
            const int tok = 8 * wave + tt;
            const f32x4 lgv = *(LAS f32x4*)(L + tok * LSTR + 16 * lane);
            const float s0 = 1.f / (1.f + __expf(-lgv[0])), s1 = 1.f / (1.f + __expf(-lgv[1])), s2 = 1.f / (1.f + __expf(-lgv[2])), s3 = 1.f / (1.f + __expf(-lgv[3]));
            float v0 = s0 + bias[0], v1 = s1 + bias[1], v2 = s2 + bias[2], v3 = s3 + bias[3];
            float t1 = fmaxf(v0, v1), t2 = fminf(v0, v1);
            { const float a = fmaxf(v2, v3), bq = fminf(v2, v3); const float n1 = fmaxf(t1, a), n2 = fmaxf(fminf(t1, a), fmaxf(t2, bq)); t1 = n1; t2 = n2; }
            { const float o1 = dppf<0xB1, 0xf>(t1, t1), o2 = dppf<0xB1, 0xf>(t2, t2); const float n1 = fmaxf(t1, o1), n2 = fmaxf(fminf(t1, o1), fmaxf(t2, o2)); t1 = n1; t2 = n2; }
            { const float o1 = dppf<0x4E, 0xf>(t1, t1), o2 = dppf<0x4E, 0xf>(t2, t2); const float n1 = fmaxf(t1, o1), n2 = fmaxf(fminf(t1, o1), fmaxf(t2, o2)); t1 = n1; t2 = n2; }
            { const float o1 = shx(t1, 4, lane), o2 = shx(t2, 4, lane); const float n1 = fmaxf(t1, o1), n2 = fmaxf(fminf(t1, o1), fmaxf(t2, o2)); t1 = n1; t2 = n2; }
            const float gs = t1 + t2;
            int rank = 0;
#pragma unroll
            for (int gg = 0; gg < 8; ++gg) { const float og = __int_as_float(__builtin_amdgcn_readlane(__float_as_int(gs), gg * 8)); rank += (og > gs || (og == gs && gg < grp)) ? 1 : 0; }
            if (rank >= 4) { v0 = -INFINITY; v1 = -INFINITY; v2 = -INFINITY; v3 = -INFINITY; }
            unsigned k0 = fkey(v0), k1 = fkey(v1), k2 = fkey(v2), k3 = fkey(v3);
            bool c0 = false, c1 = false, c2 = false, c3 = false;
#pragma unroll
            for (int it = 0; it < TOPK; ++it) {
                const unsigned lb = max(max(k0, k1), max(k2, k3));
                const unsigned m = wave_umax(lb);
                const unsigned long long bal = __ballot(lb == m);
                const int owner = __builtin_ctzll(bal);
                if (lane == owner) {
                    if (k0 == m) { k0 = 0u; c0 = true; } else if (k1 == m) { k1 = 0u; c1 = true; } else if (k2 == m) { k2 = 0u; c2 = true; } else { k3 = 0u; c3 = true; }
                }
            }
            const float wsum = wave_fsum_dpp((c0 ? s0 : 0.f) + (c1 ? s1 : 0.f) + (c2 ? s2 : 0.f) + (c3 ? s3 : 0.f));
            const float wnorm = 2.5f / wsum;
            const unsigned long long b0 = __ballot(c0), b1 = __ballot(c1), b2 = __ballot(c2), b3 = __ballot(c3);
            const unsigned long long lm = (1ull << lane) - 1ull;
            const int q0 = __builtin_popcountll(b0 & lm), a1 = __builtin_popcountll(b0);
            const int q1 = a1 + __builtin_popcountll(b1 & lm), a2 = a1 + __builtin_popcountll(b1);
            const int q2 = a2 + __builtin_popcountll(b2 & lm), a3 = a2 + __builtin_popcountll(b2);
            const int q3 = a3 + __builtin_popcountll(b3 & lm);
            if (c0) { pe[8 * tok + q0] = 4 * lane + 0; pw[8 * tok + q0] = s0 * wnorm; }
            if (c1) { pe[8 * tok + q1] = 4 * lane + 1; pw[8 * tok + q1] = s1 * wnorm; }
            if (c2) { pe[8 * tok + q2] = 4 * lane + 2; pw[8 * tok + q2] = s2 * wnorm; }
            if (c3) { pe[8 * tok + q3] = 4 * lane + 3; pw[8 * tok + q3] = s3 * wnorm; }
        }
        __syncthreads();
        const int my_e = pe[tid];
        const int my_rank = __hip_atomic_fetch_add(hist + my_e, 1, __ATOMIC_RELAXED, __HIP_MEMORY_SCOPE_WORKGROUP);
        __syncthreads();
        if (tid < 256) { const int n = hist[tid]; basep[tid] = n > 0 ? atomicAdd(cnt + tid, n) : 0; }
        __syncthreads();
        {
            const int pos = basep[my_e] + my_rank;
            if (pos < LISTCAP) { la[(size_t)my_e * LISTCAP + pos] = (m0 + (tid >> 3)) * TOPK + (tid & 7); lw[(size_t)my_e * LISTCAP + pos] = pw[tid]; }
        }
        __syncthreads();
    }
}

__device__ __forceinline__ int moe_cnt(const int* cnt, int e) { int c = (e < 256) ? cnt[e] : T; return c > LISTCAP ? LISTCAP : c; }
__device__ __forceinline__ void moe_prefix(const Params& p, LAS char* L) {
    const int tid = otid();
    const int* cnt = (const int*)(p.ws + WS_CTL);
    LAS int* pre = (LAS int*)(L + OFF_PRE);
    LAS int* tl = (LAS int*)(L + OFF_TL);
    __syncthreads();
    for (int i = tid; i < 257; i += NT) { const int c = moe_cnt(cnt, i); tl[i] = (c + 255) >> 8; }
    __syncthreads();
    if (tid == 0) { int s = 0; for (int i = 0; i < 257; ++i) { pre[i] = s; s += tl[i]; } pre[257] = s; }
    __syncthreads();
}
__device__ __forceinline__ int moe_find(LAS int* pre, int g) {
    int lo = 0, hi = 256;
    while (lo < hi) { const int mid = (lo + hi + 1) >> 1; if (pre[mid] <= g) lo = mid; else hi = mid - 1; }
    return lo;
}

template <int MI>
__device__ __forceinline__ void moe1_unit(const Params& p, LAS char* L, int e, int r0, int rows, int j0) {
    const unsigned char* h8 = (const unsigned char*)(p.ws + WS_H8);
    const unsigned char* w8 = (const unsigned char*)(p.ws + WS_W8GU) + (size_t)e * 512 * 1024;
    const int* la = (const int*)(p.ws + WS_LA);
    unsigned char* hb = (unsigned char*)(p.ws + WS_HB);
    LAS int* rowid = (LAS int*)(L + OFF_ROW);
    {
        const int tid = otid();
        if (tid < 64 * MI) { const int rr = tid < rows ? tid : 0; rowid[tid] = (e < 256) ? la[(size_t)e * LISTCAP + r0 + rr] : (AR + r0 + rr); }
        __syncthreads();
    }
    auto arow = [&](int r) { const int a = rowid[r]; const int tok = (e < 256) ? (a >> 3) : (a - AR); return (unsigned)tok * Dm; };
    auto wrow = [&](int seg, int r) { return (unsigned)((r < 128) ? (j0 + r) : (128 + j0 + r)) * 1024u; };
    auto epi = [&](f32x16 (&acc)[MI][2], int seg, LAS char* Ls) {
        constexpr float us = 1.f / (H8SCALE * WGUSCALE);
#pragma unroll
        for (int mi = 0; mi < MI; ++mi)
#pragma unroll
            for (int r = 0; r < 16; ++r) acc[mi][0][r] = __builtin_amdgcn_fmed3f(silu_f(acc[mi][0][r] * us) * (acc[mi][1][r] * (us * HBSCALE)), -448.f, 448.f);
        store_tile_fp8<MI, 128>(Ls, acc, [&](int row, int c) -> unsigned char* { return row < rows ? hb + (size_t)rowid[row] * 256 + j0 + 16 * c : nullptr; });
    };
    gemm8_tile<MI, 1>(L, Dm / 128, h8, arow, w8, wrow, epi);
}
__device__ __forceinline__ void phase_moe1(const Params& p, LAS char* L) {
    const int v = vcu(), G = grid_g();
    const int* cnt = (const int*)(p.ws + WS_CTL);
    moe_prefix(p, L);
    LAS int* pre = (LAS int*)(L + OFF_PRE);
    const int total = __builtin_amdgcn_readfirstlane(pre[256]) * 2;
    for (int u = v; u < total; u += G) {
        const int g = u >> 1, j0 = (u & 1) * 128;
        const int e = __builtin_amdgcn_readfirstlane(moe_find(pre, g)), mt = g - __builtin_amdgcn_readfirstlane(pre[e]);
        const int rows = __builtin_amdgcn_readfirstlane(moe_cnt(cnt, e)) - mt * 256;
        if (rows > 128) moe1_unit<4>(p, L, e, mt * 256, rows < 256 ? rows : 256, j0);
        else moe1_unit<2>(p, L, e, mt * 256, rows, j0);
    }
    unsigned* qctr = (unsigned*)(p.ws + WS_CTL + 2048) + 128;
    LAS unsigned* qslot = (LAS unsigned*)(L + OFF_MISC + 16);
    const int tid = otid();
    for (;;) {
        if (tid == 0) *qslot = __hip_atomic_fetch_add(qctr, 1u, __ATOMIC_RELAXED, __HIP_MEMORY_SCOPE_AGENT);
        __syncthreads();
        const int q = __builtin_amdgcn_readfirstlane((int)*qslot);
        __syncthreads();
        if (q >= (T / 128) * 2) break;
        moe1_unit<2>(p, L, 256, (q >> 1) * 128, 128, (q & 1) * 128);
    }
}

template <int MI>
__device__ __forceinline__ void moe2_unit(const Params& p, LAS char* L, int e, int r0, int rows, int n0) {
    const int* la = (const int*)(p.ws + WS_LA); const float* lw = (const float*)(p.ws + WS_LW);
    const unsigned char* hb = (const unsigned char*)(p.ws + WS_HB);
    unsigned char* yb = (unsigned char*)(p.ws + WS_YB);
    const unsigned char* w8 = (const unsigned char*)(p.ws + WS_W8D) + (size_t)e * 1024 * 256;
    LAS int* rowid = (LAS int*)(L + OFF_ROW);
    LAS float* roww = (LAS float*)(L + OFF_RW);
    {
        const int tid = otid();
        if (tid < 64 * MI) {
            const int rr = tid < rows ? tid : 0;
            rowid[tid] = (e < 256) ? la[(size_t)e * LISTCAP + r0 + rr] : (AR + r0 + rr);
            roww[tid] = (e < 256) ? lw[(size_t)e * LISTCAP + r0 + rr] : 1.f;
        }
        __syncthreads();
    }
    auto arow = [&](int r) { return (unsigned)rowid[r] * 256u; };
    auto wrow = [&](int seg, int r) { return (unsigned)(n0 + seg * 256 + r) * 256u; };
    auto epi = [&](f32x16 (&acc)[MI][2], int seg, LAS char* Ls) {
        const int tid_ = otid(), lane = tid_ & 63, wave = tid_ >> 6, wm = wave & 1, l31 = lane & 31;
#pragma unroll
        for (int mi = 0; mi < MI; ++mi) {
            const float w = roww[32 * MI * wm + 32 * mi + l31] * (YSCALE / (HBSCALE * WDSCALE));
#pragma unroll
            for (int ni = 0; ni < 2; ++ni)
#pragma unroll
                for (int q = 0; q < 16; ++q) acc[mi][ni][q] = __builtin_amdgcn_fmed3f(acc[mi][ni][q] * w, -448.f, 448.f);
        }
        store_tile_fp8<MI>(Ls, acc, [&](int row, int c) -> unsigned char* { return row < rows ? yb + (size_t)rowid[row] * Dm + n0 + seg * 256 + 16 * c : nullptr; });
    };
    gemm8_tile<MI, 0, 2>(L, 256 / 128, hb, arow, w8, wrow, epi);
}
__device__ __forceinline__ void phase_moe2(const Params& p, LAS char* L) {
    const int v = vcu(), G = grid_g();
    const int* cnt = (const int*)(p.ws + WS_CTL);
    moe_prefix(p, L);
    LAS int* pre = (LAS int*)(L + OFF_PRE);
    const int total = __builtin_amdgcn_readfirstlane(pre[256]) * 2;
    for (int u = v; u < total; u += G) {
        const int g = u >> 1, n0 = (u & 1) * 512;
        const int e = __builtin_amdgcn_readfirstlane(moe_find(pre, g)), mt = g - __builtin_amdgcn_readfirstlane(pre[e]);
        const int rows = __builtin_amdgcn_readfirstlane(moe_cnt(cnt, e)) - mt * 256;
        if (rows > 128) moe2_unit<4>(p, L, e, mt * 256, rows < 256 ? rows : 256, n0);
        else moe2_unit<2>(p, L, e, mt * 256, rows, n0);
    }
    unsigned* qctr = (unsigned*)(p.ws + WS_CTL + 2048) + 192;
    LAS unsigned* qslot = (LAS unsigned*)(L + OFF_MISC + 16);
    const int tid = otid();
    for (;;) {
        if (tid == 0) *qslot = __hip_atomic_fetch_add(qctr, 1u, __ATOMIC_RELAXED, __HIP_MEMORY_SCOPE_AGENT);
        __syncthreads();
        const int q = __builtin_amdgcn_readfirstlane((int)*qslot);
        __syncthreads();
        if (q >= (T / 128) * 2) break;
        moe2_unit<2>(p, L, 256, (q >> 1) * 128, 128, (q & 1) * 512);
    }
}

__device__ __forceinline__ void phase_final(const Params& p) {
    const int v = vcu(), G = grid_g();
    const int tid = otid(), lane = tid & 63, wave = tid >> 6;
    const float* pg = p.in[19];
    const float* mod = (const float*)(p.ws + WS_MOD);
    const unsigned char* yb = (const unsigned char*)(p.ws + WS_YB);
    for (int t = v * NW + wave; t < T; t += G * NW) {
        const int b = t / SEQ;
        const float* gf = mod + b * 6144 + 5120;
        float y[16];
#pragma unroll
        for (int e = 0; e < 16; ++e) y[e] = 0.f;
#pragma unroll
        for (int k = 0; k < 9; ++k) {
            const size_t row = (k < 8) ? ((size_t)t * TOPK + k) : ((size_t)AR + t);
            const u32x4 raw = *(const u32x4*)(yb + row * Dm + 16 * lane);
#pragma unroll
            for (int e = 0; e < 4; ++e) {
                const f32x2 a = __builtin_amdgcn_cvt_pk_f32_fp8((int)raw[e], false), c = __builtin_amdgcn_cvt_pk_f32_fp8((int)raw[e], true);
                y[4 * e] += a.x; y[4 * e + 1] += a.y; y[4 * e + 2] += c.x; y[4 * e + 3] += c.y;
            }
        }
        float ss = 0.f;
#pragma unroll
        for (int e = 0; e < 16; ++e) { y[e] *= (1.f / YSCALE); ss += y[e] * y[e]; }
        ss = wave_sum(ss, lane);
        const float rstd = rsqrtf(ss * (1.f / Dm) + 1e-6f);
        const int col = 16 * lane;
#pragma unroll
        for (int hq = 0; hq < 4; ++hq) {
            f32x4 xo = *(const f32x4*)(p.out + (size_t)t * Dm + col + 4 * hq);
            const f32x4 gv = *(const f32x4*)(pg + col + 4 * hq), gg = *(const f32x4*)(gf + col + 4 * hq);
#pragma unroll
            for (int e = 0; e < 4; ++e) xo[e] += gg[e] * (y[4 * hq + e] * rstd * gv[e]);
            *(f32x4*)(p.out + (size_t)t * Dm + col + 4 * hq) = xo;
        }
    }
}

#define XB_TMO      128
#define XB_XCNT(j)  (256  + 64 * (j))
#define XB_XSUB(j)  (1280 + 64 * (j))
#define XB_XGEN(j)  (2304 + 64 * (j))
#define XB_TOP      3328
#define XB_TOPGEN   3392
#define XCD_BAR_WORDS 3456
#define XB_SPIN_CAP (1u << 18)
__device__ __forceinline__ unsigned xb_ld(unsigned* p)              { return __hip_atomic_load(p, __ATOMIC_RELAXED, __HIP_MEMORY_SCOPE_AGENT); }
__device__ __forceinline__ unsigned xb_add(unsigned* p, unsigned v) { return __hip_atomic_fetch_add(p, v, __ATOMIC_RELAXED, __HIP_MEMORY_SCOPE_AGENT); }
__device__ __forceinline__ unsigned xb_xcc_id() { return (unsigned)__builtin_amdgcn_s_getreg((3 << 11) | 20) & 0xFu; }
#define XB_SPIN(cond, bar) do { unsigned _sp = 0; while (cond) { __builtin_amdgcn_s_sleep(1); \
    if ((++_sp & 255u) == 0u) { if (xb_ld(&(bar)[XB_TMO])) break; if (_sp > XB_SPIN_CAP) { atomicAdd(&(bar)[XB_TMO], 1u); break; } } } } while (0)
struct XcdBarrier { unsigned* bar; unsigned x; volatile LAS unsigned* st; };
__device__ __forceinline__ XcdBarrier xcd_barrier_post(unsigned* bar, volatile LAS unsigned* st) {
    XcdBarrier b; b.bar = bar; b.x = xb_xcc_id(); b.st = st;
    if (threadIdx.x == 0) (void)xb_add(&bar[XB_XCNT(b.x)], 1u);
    return b;
}
__device__ __forceinline__ void xcd_barrier_complete(unsigned* bar, unsigned x, unsigned& nloc, unsigned& nx) {
    const unsigned G = gridDim.x * gridDim.y * gridDim.z;
    unsigned sum, cnt, mine, sp = 0u;
    for (;;) {
        sum = 0u; cnt = 0u; mine = 0u;
#pragma unroll
        for (unsigned j = 0; j < 16; ++j) { const unsigned c = xb_ld(&bar[XB_XCNT(j)]); sum += c; cnt += (c > 0u) ? 1u : 0u; mine = (j == x) ? c : mine; }
        if (sum == G) break;
        __builtin_amdgcn_s_sleep(1);
        if ((++sp & 255u) == 0u) { if (xb_ld(&bar[XB_TMO])) break; if (sp > XB_SPIN_CAP) { atomicAdd(&bar[XB_TMO], 1u); break; } }
    }
    nloc = mine > 0u ? mine : 1u; nx = cnt > 0u ? cnt : 1u;
}
__device__ __forceinline__ void xcd_barrier(const Params& p, LAS char* L) {
    XcdBarrier b; b.bar = (unsigned*)(p.ws + WS_CTL + 4096); b.x = xb_xcc_id(); b.st = (volatile LAS unsigned*)(L + OFF_MISC);
    asm volatile("s_waitcnt vmcnt(0)" ::: "memory");
    __syncthreads();
    if (threadIdx.x == 0) {
        unsigned* bar = b.bar;
        __builtin_amdgcn_s_waitcnt(0);
        unsigned nloc = b.st[0], nx = b.st[1];
        if (nloc == 0u) { xcd_barrier_complete(bar, b.x, nloc, nx); b.st[0] = nloc; b.st[1] = nx; }
        const unsigned old = xb_add(&bar[XB_XSUB(b.x)], 1u);
        const unsigned gen = old / nloc;
        if (old + 1u == (gen + 1u) * nloc) {
            __builtin_amdgcn_fence(__ATOMIC_RELEASE, "agent");
            asm volatile("s_waitcnt vmcnt(0)" ::: "memory");
            const unsigned og = xb_add(&bar[XB_TOP], 1u);
            const unsigned tg = og / nx;
            if (og + 1u == (tg + 1u) * nx) xb_add(&bar[XB_TOPGEN], 1u);
            else XB_SPIN(xb_ld(&bar[XB_TOPGEN]) == tg, bar);
            __builtin_amdgcn_fence(__ATOMIC_ACQUIRE, "agent");
            xb_add(&bar[XB_XGEN(b.x)], 1u);
            asm volatile("s_waitcnt vmcnt(0)" ::: "memory");
        } else {
            XB_SPIN(xb_ld(&bar[XB_XGEN(b.x)]) == gen, bar);
            __builtin_amdgcn_fence(__ATOMIC_ACQUIRE, "agent");
            asm volatile("s_waitcnt vmcnt(0)" ::: "memory");
        }
    }
    __syncthreads();
}

__global__ void __launch_bounds__(NT, 2) mega(Params p) {
    extern __shared__ __attribute__((aligned(16))) char smem[];
    LAS char* L = (LAS char*)smem;
    if (threadIdx.x < 8) ((LAS unsigned*)(L + OFF_MISC))[threadIdx.x] = 0u;
    __syncthreads();
    (void)xcd_barrier_post((unsigned*)(p.ws + WS_CTL + 4096), (volatile LAS unsigned*)(L + OFF_MISC));
    phase_mod(p, L);
    xcd_barrier(p, L);
    phase_h1(p);
    xcd_barrier(p, L);
    phase_proj(p, L);
    xcd_barrier(p, L);
    phase_qkv(p, L);
    xcd_barrier(p, L);
    phase_attn(p, L);
    xcd_barrier(p, L);
    phase_oproj(p, L);
    xcd_barrier(p, L);
    phase_router_route(p, L);
    xcd_barrier(p, L);
    phase_moe1(p, L);
    xcd_barrier(p, L);
    phase_moe2(p, L);
    xcd_barrier(p, L);
    phase_final(p);
}

extern "C" void kernel_launch(void* const* d_in, const int* in_sizes, int n_in, void* d_out, int out_size, void* d_ws, size_t ws_size, hipStream_t stream) {
    static int grid_blocks = 0;
    if (grid_blocks == 0) {
        if (n_in != 28 || out_size != T * Dm || ws_size < WS_END) {
            fprintf(stderr, "kernel_launch: unexpected problem (n_in %d, out %d, ws %zu); nothing launched\n", n_in, out_size, ws_size);
            grid_blocks = -1; return;
        }
        int dev = 0, cus = 0, per_cu = 0;
        (void)hipGetDevice(&dev);
        (void)hipDeviceGetAttribute(&cus, hipDeviceAttributeMultiprocessorCount, dev);
        if (hipFuncSetAttribute((const void*)mega, hipFuncAttributeMaxDynamicSharedMemorySize, LDS_BYTES) != hipSuccess) {
            fprintf(stderr, "kernel_launch: hipFuncSetAttribute(%d B LDS) failed\n", LDS_BYTES); grid_blocks = -1; return;
        }
        (void)hipOccupancyMaxActiveBlocksPerMultiprocessor(&per_cu, mega, NT, LDS_BYTES);
        if (per_cu < 1) { fprintf(stderr, "kernel_launch: occupancy query says %d blocks per CU\n", per_cu); per_cu = 1; }
        grid_blocks = cus;
        fprintf(stderr, "kernel_launch: %d CUs, occupancy query %d per CU, grid %d\n", cus, per_cu, grid_blocks);
    }
    if (grid_blocks < 0) return;
    (void)hipMemsetAsync((char*)d_ws + WS_CTL, 0, CTL_BYTES, stream);
    Params p{};
    for (int i = 0; i < 28; ++i) p.in[i] = (const float*)d_in[i];
    p.out = (float*)d_out; p.ws = (char*)d_ws;
    void* args[] = {&p};
    hipError_t e = hipLaunchCooperativeKernel((void*)mega, dim3(grid_blocks), dim3(NT), args, LDS_BYTES, stream);
    if (e != hipSuccess) fprintf(stderr, "cooperative launch failed: %s (grid %d)\n", hipGetErrorString(e), grid_blocks);
}
```

```cpp
#include <hip/hip_runtime.h>
#include <cstdio>
#include <cstdint>


typedef unsigned short bf16_t;
typedef float f32x2 __attribute__((ext_vector_type(2)));
typedef short bf16x8 __attribute__((ext_vector_type(8)));
typedef short s16x4 __attribute__((ext_vector_type(4)));
typedef short v4i16_t __attribute__((ext_vector_type(4)));
typedef float f32x16 __attribute__((ext_vector_type(16)));
typedef float f32x4 __attribute__((ext_vector_type(4)));
typedef unsigned u32x4 __attribute__((ext_vector_type(4)));
typedef unsigned u32x2 __attribute__((ext_vector_type(2)));
#define LAS __attribute__((address_space(3)))

constexpr int NT = 512, NW = 8;
constexpr int Dm = 1024, NB = 8, SEQ = 2048, T = NB * SEQ;
constexpr int NIN = 1952;
constexpr int C_CQ = 0, C_CKV = 256, C_KR = 384, C_DQ = 416, C_DK = 928, C_DV = 1440;
constexpr int NE = 256, TOPK = 8, AR = T * TOPK, HROWS = AR + T;
constexpr int LISTCAP = T;
constexpr float LOG2E = 1.4426950408889634f;
constexpr float YSCALE = 32.f;
constexpr float LAMBDA_INIT = 0.2f;

constexpr size_t MiB = 1u << 20;
constexpr size_t WS_CTL = 0, CTL_BYTES = 65536;
constexpr size_t WS_MOD = 65536;
constexpr size_t WS_ROPE = 1 * MiB;
constexpr size_t WS_H1 = 4 * MiB;
constexpr size_t WS_PROJ = 36 * MiB;
constexpr size_t WS_CQN = 100 * MiB;
constexpr size_t WS_CKVN = 108 * MiB;
constexpr size_t WS_QM = 112 * MiB;
constexpr size_t WS_KF = 136 * MiB;
constexpr size_t WS_VM = 160 * MiB;
constexpr size_t WS_ATT = 176 * MiB;
constexpr size_t WS_OD0 = 208 * MiB;
constexpr size_t WS_Y1 = 240 * MiB;
constexpr size_t WS_H2 = 304 * MiB;
constexpr size_t WS_LOG = 336 * MiB;
constexpr size_t WS_LA = 352 * MiB;
constexpr size_t WS_LW = 368 * MiB;
constexpr size_t WS_HB = 384 * MiB;
constexpr size_t WS_YB = 456 * MiB;
constexpr size_t WS_WB = 744 * MiB;
constexpr size_t WB_IN = 0, WB_UQ = WB_IN + (size_t)1024 * 1952, WB_UKV = WB_UQ + 256 * 768, WB_O = WB_UKV + 128 * 1024, WB_R = WB_O + 1024 * 1024, WB_SG = WB_R + 1024 * 256, WB_SU = WB_SG + 1024 * 256, WB_SD = WB_SU + 1024 * 256, WB_END = WB_SD + 256 * 1024;
constexpr size_t WS_W8GU = 760 * MiB;
constexpr size_t WS_W8D = 892 * MiB;
constexpr size_t WS_H8 = 960 * MiB;
constexpr size_t WS_END = 976 * MiB;
constexpr float H8SCALE = 16.f, WGUSCALE = 256.f, WDSCALE = 128.f, HBSCALE = 8.f;

constexpr int G_XB = 32768, G_WB = 36864, G_BUF = G_XB + G_WB, G_LDS = 2 * G_BUF;
constexpr int OFF_MISC = G_LDS, OFF_PRE = OFF_MISC + 64, OFF_TL = OFF_PRE + 1088;
constexpr int OFF_ROW = OFF_TL + 1088, OFF_RW = OFF_ROW + 1024;
constexpr int OFF_SS = OFF_RW + 1024;
constexpr int LDS_BYTES = G_LDS + 4352 + 4096;

struct Params {
    const float* in[28];
    float* out;
    char* ws;
};

__device__ __forceinline__ unsigned short f2bf(float f) { __bf16 b = (__bf16)f; return __builtin_bit_cast(unsigned short, b); }
typedef __bf16 bf16x2_t __attribute__((ext_vector_type(2)));
__device__ __forceinline__ unsigned pk2(float lo, float hi) { const f32x2 v = {lo, hi}; return __builtin_bit_cast(unsigned, __builtin_convertvector(v, bf16x2_t)); }
__device__ __forceinline__ float bf2f(unsigned short b) { return __uint_as_float(((unsigned)b) << 16); }
__device__ __forceinline__ float bflo(unsigned u) { return __uint_as_float(u << 16); }
__device__ __forceinline__ float bfhi(unsigned u) { return __uint_as_float(u & 0xffff0000u); }
__device__ __forceinline__ int crow(int r, int hi) { return (r & 3) + 8 * (r >> 2) + 4 * hi; }
__device__ __forceinline__ float shx(float v, int m, int lane) { return __int_as_float(__builtin_amdgcn_ds_bpermute((lane ^ m) << 2, __float_as_int(v))); }
__device__ __forceinline__ int shxi(int v, int m, int lane) { return __builtin_amdgcn_ds_bpermute((lane ^ m) << 2, v); }
__device__ __forceinline__ float shl(float v, int src) { return __int_as_float(__builtin_amdgcn_ds_bpermute(src << 2, __float_as_int(v))); }
__device__ __forceinline__ float wave_sum(float v, int lane) {
#pragma unroll
    for (int o = 32; o >= 1; o >>= 1) v += shx(v, o, lane);
    return v;
}
__device__ __forceinline__ float silu_f(float v) { return v / (1.f + __expf(-v)); }
__device__ __forceinline__ s16x4 tr_read(LAS char* p) {
    return __builtin_bit_cast(s16x4, __builtin_amdgcn_ds_read_tr16_b64_v4i16((LAS v4i16_t*)p));
}
__device__ __forceinline__ int otid() { int t = threadIdx.x; asm volatile("" : "+v"(t)); return t; }
__device__ __forceinline__ int grid_g() { return gridDim.x; }
__device__ __forceinline__ int vcu() { const int G = gridDim.x, bx = blockIdx.x; return (G % 8 == 0) ? (bx % 8) * (G / 8) + bx / 8 : bx; }
__device__ __forceinline__ void gld16(u32x4& d, const void* p) { asm volatile("global_load_dwordx4 %0, %1, off" : "+v"(d) : "v"(p) : "memory"); }
__device__ __forceinline__ void gld16(f32x4& d, const void* p) { asm volatile("global_load_dwordx4 %0, %1, off" : "+v"(d) : "v"(p) : "memory"); }
__device__ __forceinline__ void gst16_wt(void* p, u32x4 d) { asm volatile("global_store_dwordx4 %0, %1, off sc1\n\ts_nop 1" :: "v"(p), "v"(d) : "memory"); }
__device__ __forceinline__ void gst8_wt(void* p, u32x2 d) { asm volatile("global_store_dwordx2 %0, %1, off sc1\n\ts_nop 1" :: "v"(p), "v"(d) : "memory"); }
__device__ __forceinline__ void gst4_wt(void* p, int d) { asm volatile("global_store_dword %0, %1, off sc1\n\ts_nop 1" :: "v"(p), "v"(d) : "memory"); }
template <int N> __device__ __forceinline__ void vm_wait(u32x4& a, f32x4& b, f32x4& c) { asm volatile("s_waitcnt vmcnt(%3)" : "+v"(a), "+v"(b), "+v"(c) : "n"(N) : "memory"); }
template <int N> __device__ __forceinline__ void vm_wait(f32x4& b, f32x4& c) { asm volatile("s_waitcnt vmcnt(%2)" : "+v"(b), "+v"(c) : "n"(N) : "memory"); }
template <int N> __device__ __forceinline__ void vm_wait(u32x4& a, u32x4& b) { asm volatile("s_waitcnt vmcnt(%2)" : "+v"(a), "+v"(b) : "n"(N) : "memory"); }
template <int N> __device__ __forceinline__ void vm_wait(u32x4& b) { asm volatile("s_waitcnt vmcnt(%1)" : "+v"(b) : "n"(N) : "memory"); }
#define MFMA32(a, b, c) __builtin_amdgcn_mfma_f32_32x32x16_bf16(a, b, c, 0, 0, 0)

template <int NBMODE> __device__ __forceinline__ int nb_of(int wn, int ni) { return NBMODE == 0 ? 64 * wn + 32 * ni : 32 * wn + 128 * ni; }

template <int MI, int NBMODE, bool WBF = false, int NSEG = 1, class AF, class BF, class EF>
__device__ __forceinline__ void gemm_tile(LAS char* L, int nk, long ldw, const bf16_t* abase, AF arow, BF bcol, EF epi) {
    asm volatile("" : "+s"(nk));
    const int tid = otid(), lane = tid & 63, wave = tid >> 6;
    const int wm = wave & 1, wn = wave >> 1, l31 = lane & 31, hi = lane >> 5;
    const int a_chunk = tid & 7, a_row = tid >> 3;
    const int a_w = a_row * 128 + 16 * (a_chunk ^ ((a_row >> 1) & 7));
    const int b_n4 = WBF ? (tid & 31) : (tid & 63), b_kr = WBF ? (tid >> 5) : (tid >> 6);
    const auto bp = bcol((WBF ? 8 : 4) * b_n4) + (long)b_kr * ldw;
    const int b_w = G_XB + b_kr * 576 + (WBF ? 16 : 8) * b_n4;
    const int sw = (l31 >> 1) & 7;
    const int xoff = (32 * MI * wm + l31) * 128;
    const int woff = G_XB + (8 * hi + ((lane & 15) >> 2)) * 576 + 2 * (16 * ((lane >> 4) & 1) + 4 * (lane & 3));
    u32x4 ra[MI]; f32x4 rb[8]; u32x4 rw[4];
#pragma unroll
    for (int i = 0; i < MI; ++i) ra[i] = (u32x4){0u, 0u, 0u, 0u};
#pragma unroll
    for (int i = 0; i < 8; ++i) rb[i] = (f32x4){0.f, 0.f, 0.f, 0.f};
#pragma unroll
    for (int i = 0; i < 4; ++i) rw[i] = (u32x4){0u, 0u, 0u, 0u};
#define G_LOADW(KOFF, Q, SEGC) do { \
        if (WBF) { gld16(rw[Q], bp + (long)((KOFF) + 16 * (Q)) * ldw + (SEGC)); } \
        else { gld16(rb[2 * (Q)], bp + (long)((KOFF) + 16 * (Q)) * ldw + (SEGC)); gld16(rb[2 * (Q) + 1], bp + (long)((KOFF) + 16 * (Q) + 8) * ldw + (SEGC)); } } while (0)
#define G_LOADQ(KT, Q) do { \
        if ((Q) < MI) gld16(ra[(Q) < MI ? (Q) : 0], abase + arow(a_row + 64 * (Q)) + a_chunk * 8 + (KT) * 64); \
        G_LOADW((KT) * 64, Q, 0); } while (0)
#define G_LOADQ_SEL(KT, SEG, Q, OK) do { \
        const int kq_ = (OK) ? (KT) * 64 : 0; const int sc_ = (OK) ? (SEG) * 256 : 0; \
        if ((Q) < MI) gld16(ra[(Q) < MI ? (Q) : 0], abase + arow(a_row + 64 * (Q)) + a_chunk * 8 + kq_); \
        G_LOADW(kq_, Q, sc_); } while (0)
#define G_WAITQ(Q, N) do { \
        if (WBF) { if ((Q) < MI) vm_wait<N>(ra[(Q) < MI ? (Q) : 0], rw[Q]); else vm_wait<N>(rw[Q]); } \
        else { if ((Q) < MI) vm_wait<N>(ra[(Q) < MI ? (Q) : 0], rb[2 * (Q)], rb[2 * (Q) + 1]); else vm_wait<N>(rb[2 * (Q)], rb[2 * (Q) + 1]); } } while (0)
#define G_STOREQ(LP, Q) do { \
        if ((Q) < MI) *(LAS u32x4*)((LP) + a_w + (Q) * 8192) = ra[(Q) < MI ? (Q) : 0]; \
        if (WBF) { *(LAS u32x4*)((LP) + b_w + (Q) * 16 * 576) = rw[Q]; } else { \
        { u32x2 w; w.x = pk2(rb[2 * (Q)][0], rb[2 * (Q)][1]); w.y = pk2(rb[2 * (Q)][2], rb[2 * (Q)][3]); *(LAS u32x2*)((LP) + b_w + (Q) * 16 * 576) = w; } \
        { u32x2 w; w.x = pk2(rb[2 * (Q) + 1][0], rb[2 * (Q) + 1][1]); w.y = pk2(rb[2 * (Q) + 1][2], rb[2 * (Q) + 1][3]); *(LAS u32x2*)((LP) + b_w + (Q) * 16 * 576 + 8 * 576) = w; } } } while (0)
    constexpr int NLW = WBF ? 1 : 2;
    constexpr int NL0 = NLW + ((0 < MI) ? 1 : 0), NL1 = NLW + ((1 < MI) ? 1 : 0), NL2 = NLW + ((2 < MI) ? 1 : 0), NL3 = NLW + ((3 < MI) ? 1 : 0), NLT = NL0 + NL1 + NL2 + NL3;
    G_LOADQ(0, 0); G_LOADQ(0, 1); G_LOADQ(0, 2); G_LOADQ(0, 3);
    G_WAITQ(0, 0); G_WAITQ(1, 0); G_WAITQ(2, 0); G_WAITQ(3, 0);
    G_STOREQ(L, 0); G_STOREQ(L, 1); G_STOREQ(L, 2); G_STOREQ(L, 3);
    G_LOADQ(1, 0); G_LOADQ(1, 1); G_LOADQ(1, 2); G_LOADQ(1, 3);
    f32x16 acc[MI][2];
#pragma unroll
    for (int i = 0; i < MI; ++i)
#pragma unroll
        for (int j = 0; j < 2; ++j)
#pragma unroll
            for (int r = 0; r < 16; ++r) acc[i][j][r] = 0.f;
    __syncthreads();
    const int nt_all = nk * NSEG;
    int lk = (nk == 2) ? 0 : 2, lseg = (nk == 2) ? 1 : 0;
    int ck = 0, cseg = 0;
#pragma nounroll
    for (int kt = 0; kt < nt_all; ++kt) {
        LAS char* Lb = L + (kt & 1) * G_BUF;
        LAS char* Ln = L + ((kt + 1) & 1) * G_BUF;
        const bool ld = kt + 2 < nt_all;
        bf16x8 xf[2][MI], wf[2][2];
#define LOAD_FRAGS(KS, B) do { \
            _Pragma("unroll") for (int mi = 0; mi < MI; ++mi) xf[B][mi] = *(LAS bf16x8*)(Lb + xoff + mi * 4096 + 16 * ((2 * (KS) + hi) ^ sw)); \
            _Pragma("unroll") for (int ni = 0; ni < 2; ++ni) { \
                LAS char* pp = Lb + woff + (KS) * 16 * 576 + 2 * nb_of<NBMODE>(wn, ni); \
                const s16x4 lo = tr_read(pp), h4 = tr_read(pp + 4 * 576); \
                wf[B][ni] = (bf16x8){lo[0], lo[1], lo[2], lo[3], h4[0], h4[1], h4[2], h4[3]}; } } while (0)
#define MMA_STEP(KS) do { \
            _Pragma("unroll") for (int mi = 0; mi < MI; ++mi) \
                _Pragma("unroll") for (int ni = 0; ni < 2; ++ni) acc[mi][ni] = MFMA32(wf[(KS) & 1][ni], xf[(KS) & 1][mi], acc[mi][ni]); } while (0)
#define STAGE_STEP(Q, NREST, NPREV) do { G_WAITQ(Q, (NREST) + (NPREV)); G_STOREQ(Ln, Q); G_LOADQ_SEL(lk, lseg, Q, ld); } while (0)
        LOAD_FRAGS(0, 0);
        LOAD_FRAGS(1, 1); MMA_STEP(0); STAGE_STEP(0, NL1 + NL2 + NL3, 0);           __builtin_amdgcn_sched_barrier(0);
        LOAD_FRAGS(2, 0); MMA_STEP(1); STAGE_STEP(1, NL2 + NL3, NL0);               __builtin_amdgcn_sched_barrier(0);
        LOAD_FRAGS(3, 1); MMA_STEP(2); STAGE_STEP(2, NL3, NL0 + NL1);               __builtin_amdgcn_sched_barrier(0);
        MMA_STEP(3);                   STAGE_STEP(3, 0, NL0 + NL1 + NL2);           __builtin_amdgcn_sched_barrier(0);
#undef LOAD_FRAGS
#undef MMA_STEP
#undef STAGE_STEP
        __syncthreads();
        if (++lk == nk) { lk = 0; ++lseg; }
        if (NSEG > 1) {
            if (++ck == nk) {
                ck = 0;
                if (cseg + 1 < NSEG) {
                    epi(acc, cseg, L + (kt & 1) * G_BUF);
#pragma unroll
                    for (int i = 0; i < MI; ++i)
#pragma unroll
                        for (int j = 0; j < 2; ++j)
#pragma unroll
                            for (int r = 0; r < 16; ++r) acc[i][j][r] = 0.f;
                }
                ++cseg;
            }
        }
    }
    G_WAITQ(0, 0); G_WAITQ(1, 0); G_WAITQ(2, 0); G_WAITQ(3, 0);
#undef G_LOADQ
#undef G_LOADQ_SEL
#undef G_LOADW
#undef G_WAITQ
#undef G_STOREQ
    (void)NLT;
    epi(acc, NSEG - 1, L);
}

template <int MI, int NC, class DF>
__device__ __forceinline__ void store_tile_bf16(LAS char* L, const f32x16 (&acc)[MI][2], DF dst) {
    constexpr int STR = NC * 2 + 16, CPR = NC / 8, BM = 64 * MI;
    const int tid = otid(), lane = tid & 63, wave = tid >> 6, wm = wave & 1, wn = wave >> 1, l31 = lane & 31, hi = lane >> 5;
#pragma unroll
    for (int mi = 0; mi < MI; ++mi)
#pragma unroll
        for (int ni = 0; ni < (NC == 256 ? 2 : 1); ++ni) {
            const int row = 32 * MI * wm + 32 * mi + l31, col = (NC == 256) ? nb_of<0>(wn, ni) : 32 * wn;
#pragma unroll
            for (int gq = 0; gq < 4; ++gq) {
                u32x2 w; w.x = pk2(acc[mi][ni][4 * gq], acc[mi][ni][4 * gq + 1]); w.y = pk2(acc[mi][ni][4 * gq + 2], acc[mi][ni][4 * gq + 3]);
                *(LAS u32x2*)(L + row * STR + 2 * (col + 8 * gq + 4 * hi)) = w;
            }
        }
    __syncthreads();
#pragma unroll
    for (int i = 0; i < (BM * CPR) / NT; ++i) {
        const int id = tid + NT * i, row = id / CPR, c = id % CPR;
        bf16_t* d = dst(row, c);
        if (d) { const u32x4 t_ = *(LAS u32x4*)(L + row * STR + 16 * c); gst16_wt(d, t_); }
    }
    __syncthreads();
}

template <int MI, int NC = 256, class DF>
__device__ __forceinline__ void store_tile_fp8(LAS char* L, const f32x16 (&acc)[MI][2], DF dst) {
    constexpr int STR = NC + 16, CPR = NC / 16, BM = 64 * MI;
    const int tid = otid(), lane = tid & 63, wave = tid >> 6, wm = wave & 1, wn = wave >> 1, l31 = lane & 31, hi = lane >> 5;
#pragma unroll
    for (int mi = 0; mi < MI; ++mi)
#pragma unroll
        for (int ni = 0; ni < (NC == 256 ? 2 : 1); ++ni) {
            const int row = 32 * MI * wm + 32 * mi + l31, col = (NC == 256) ? nb_of<0>(wn, ni) : 32 * wn;
#pragma unroll
            for (int gq = 0; gq < 4; ++gq) {
                int w = 0;
                w = __builtin_amdgcn_cvt_pk_fp8_f32(acc[mi][ni][4 * gq], acc[mi][ni][4 * gq + 1], w, false);
                w = __builtin_amdgcn_cvt_pk_fp8_f32(acc[mi][ni][4 * gq + 2], acc[mi][ni][4 * gq + 3], w, true);
                *(LAS int*)(L + row * STR + (col + 8 * gq + 4 * hi)) = w;
            }
        }
    __syncthreads();
#pragma unroll
    for (int i = 0; i < (BM * CPR) / NT; ++i) {
        const int id = tid + NT * i, row = id / CPR, c = id % CPR;
        unsigned char* d = dst(row, c);
        if (d) { const u32x4 t_ = *(LAS u32x4*)(L + row * STR + 16 * c); gst16_wt(d, t_); }
    }
    __syncthreads();
}

typedef int i32x8 __attribute__((ext_vector_type(8)));
constexpr int G8_XB = 32768;
#define MFMA8(a, b, c) __builtin_amdgcn_mfma_scale_f32_32x32x64_f8f6f4(a, b, c, 0, 0, 0, 0x7f7f7f7f, 0, 0x7f7f7f7f)
template <int MI, int NBMODE, int NSEG = 1, class AF, class WF, class EF>
__device__ __forceinline__ void gemm8_tile(LAS char* L, int nk, const unsigned char* abase, AF arow, const unsigned char* wbase, WF wrow, EF epi) {
    static_assert(MI == 2 || MI == 4, "MI");
    asm volatile("" : "+s"(nk));
    const int tid = otid(), lane = tid & 63, wave = tid >> 6;
    const int wm = wave & 1, wn = wave >> 1, l31 = lane & 31, hi = lane >> 5;
    const int a_chunk = tid & 7, a_row = tid >> 3;
    const int a_w = a_row * 128 + 16 * (a_chunk ^ ((a_row >> 1) & 7));
    const int sw = (l31 >> 1) & 7;
    const int xoff = (32 * MI * wm + l31) * 128;
    const int woff = G8_XB + l31 * 128;
    const int c00 = 16 * ((2 * hi) ^ sw), c01 = 16 * ((2 * hi + 1) ^ sw), c10 = 16 * ((4 + 2 * hi) ^ sw), c11 = 16 * ((5 + 2 * hi) ^ sw);
    u32x4 ra[MI], rw[4];
#pragma unroll
    for (int i = 0; i < MI; ++i) ra[i] = (u32x4){0u, 0u, 0u, 0u};
#pragma unroll
    for (int i = 0; i < 4; ++i) rw[i] = (u32x4){0u, 0u, 0u, 0u};
#define H_LOADQ_SEL(KT, SEG, Q, OK) do { \
        const int kq_ = (OK) ? (KT) * 128 : 0; const int sg_ = (OK) ? (SEG) : 0; \
        if ((Q) < MI) gld16(ra[(Q) < MI ? (Q) : 0], abase + arow(a_row + 64 * (Q)) + a_chunk * 16 + kq_); \
        gld16(rw[Q], wbase + wrow(sg_, a_row + 64 * (Q)) + a_chunk * 16 + kq_); } while (0)
#define H_WAITQ(Q, N) do { if ((Q) < MI) vm_wait<N>(ra[(Q) < MI ? (Q) : 0], rw[Q]); else vm_wait<N>(rw[Q]); } while (0)
#define H_STOREQ(LP, Q) do { \
        if ((Q) < MI) *(LAS u32x4*)((LP) + a_w + (Q) * 8192) = ra[(Q) < MI ? (Q) : 0]; \
        *(LAS u32x4*)((LP) + G8_XB + a_w + (Q) * 8192) = rw[Q]; } while (0)
    constexpr int NL0 = 2, NL1 = 2, NL2 = 1 + ((2 < MI) ? 1 : 0), NL3 = 1 + ((3 < MI) ? 1 : 0);
    H_LOADQ_SEL(0, 0, 0, true); H_LOADQ_SEL(0, 0, 1, true); H_LOADQ_SEL(0, 0, 2, true); H_LOADQ_SEL(0, 0, 3, true);
    H_WAITQ(0, 0); H_WAITQ(1, 0); H_WAITQ(2, 0); H_WAITQ(3, 0);
    H_STOREQ(L, 0); H_STOREQ(L, 1); H_STOREQ(L, 2); H_STOREQ(L, 3);
    H_LOADQ_SEL(1, 0, 0, true); H_LOADQ_SEL(1, 0, 1, true); H_LOADQ_SEL(1, 0, 2, true); H_LOADQ_SEL(1, 0, 3, true);
    f32x16 acc[MI][2];
#pragma unroll
    for (int i = 0; i < MI; ++i)
#pragma unroll
        for (int j = 0; j < 2; ++j)
#pragma unroll
            for (int r = 0; r < 16; ++r) acc[i][j][r] = 0.f;
    __syncthreads();
    const int nt_all = nk * NSEG;
    int lk = (nk == 2) ? 0 : 2, lseg = (nk == 2) ? 1 : 0;
    int ck = 0, cseg = 0;
#pragma nounroll
    for (int kt = 0; kt < nt_all; ++kt) {
        LAS char* Lb = L + (kt & 1) * G_BUF;
        LAS char* Ln = L + ((kt + 1) & 1) * G_BUF;
        const bool ld = kt + 2 < nt_all;
        i32x8 xfA[2], xfB[2], wfA[2], wfB[2];
#define H_FRAG(DST, P, CA, CB) do { const u32x4 lo_ = *(LAS u32x4*)((P) + (CA)), hh_ = *(LAS u32x4*)((P) + (CB)); \
            DST = (i32x8){(int)lo_[0], (int)lo_[1], (int)lo_[2], (int)lo_[3], (int)hh_[0], (int)hh_[1], (int)hh_[2], (int)hh_[3]}; } while (0)
#define H_LDW(DST, S) do { H_FRAG(DST[0], Lb + woff + 128 * nb_of<NBMODE>(wn, 0), (S) ? c10 : c00, (S) ? c11 : c01); H_FRAG(DST[1], Lb + woff + 128 * nb_of<NBMODE>(wn, 1), (S) ? c10 : c00, (S) ? c11 : c01); } while (0)
#define H_LDX(DST, S, M0) do { H_FRAG(DST[0], Lb + xoff + (M0) * 4096, (S) ? c10 : c00, (S) ? c11 : c01); H_FRAG(DST[1], Lb + xoff + ((M0) + 1) * 4096, (S) ? c10 : c00, (S) ? c11 : c01); } while (0)
#define H_MMA(WFR, XFR, M0) do { \
            acc[(M0)][0] = MFMA8(WFR[0], XFR[0], acc[(M0)][0]); acc[(M0)][1] = MFMA8(WFR[1], XFR[0], acc[(M0)][1]); \
            acc[(M0) + 1][0] = MFMA8(WFR[0], XFR[1], acc[(M0) + 1][0]); acc[(M0) + 1][1] = MFMA8(WFR[1], XFR[1], acc[(M0) + 1][1]); } while (0)
#define H_STAGE(Q, NREST, NPREV) do { H_WAITQ(Q, (NREST) + (NPREV)); H_STOREQ(Ln, Q); H_LOADQ_SEL(lk, lseg, Q, ld); } while (0)
        H_LDW(wfA, 0); H_LDX(xfA, 0, 0);
        if (MI == 4) {
            H_LDX(xfB, 0, 2);                 H_MMA(wfA, xfA, 0);      H_STAGE(0, NL1 + NL2 + NL3, 0);   __builtin_amdgcn_sched_barrier(0);
            H_LDW(wfB, 1); H_LDX(xfA, 1, 0);  H_MMA(wfA, xfB, MI - 2); H_STAGE(1, NL2 + NL3, NL0);       __builtin_amdgcn_sched_barrier(0);
            H_LDX(xfB, 1, 2);                 H_MMA(wfB, xfA, 0);      H_STAGE(2, NL3, NL0 + NL1);       __builtin_amdgcn_sched_barrier(0);
                                              H_MMA(wfB, xfB, MI - 2); H_STAGE(3, 0, NL0 + NL1 + NL2);   __builtin_amdgcn_sched_barrier(0);
        } else {
            H_LDW(wfB, 1); H_LDX(xfB, 1, 0);  H_MMA(wfA, xfA, 0);      H_STAGE(0, NL1 + NL2 + NL3, 0); H_STAGE(1, NL2 + NL3, NL0);               __builtin_amdgcn_sched_barrier(0);
                                              H_MMA(wfB, xfB, 0);      H_STAGE(2, NL3, NL0 + NL1);     H_STAGE(3, 0, NL0 + NL1 + NL2);           __builtin_amdgcn_sched_barrier(0);
        }
#undef H_FRAG
#undef H_LDW
#undef H_LDX
#undef H_MMA
#undef H_STAGE
        __syncthreads();
        if (++lk == nk) { lk = 0; ++lseg; }
        if (NSEG > 1) {
            if (++ck == nk) {
                ck = 0;
                if (cseg + 1 < NSEG) {
                    epi(acc, cseg, L + (kt & 1) * G_BUF);
#pragma unroll
                    for (int i = 0; i < MI; ++i)
#pragma unroll
                        for (int j = 0; j < 2; ++j)
#pragma unroll
                            for (int r = 0; r < 16; ++r) acc[i][j][r] = 0.f;
                }
                ++cseg;
            }
        }
    }
    H_WAITQ(0, 0); H_WAITQ(1, 0); H_WAITQ(2, 0); H_WAITQ(3, 0);
#undef H_LOADQ_SEL
#undef H_WAITQ
#undef H_STOREQ
    epi(acc, NSEG - 1, L);
}

__device__ __forceinline__ void phase_mod(const Params& p, LAS char* L) {
    const int v = vcu(), G = grid_g();
    const int tid = otid();
    const float* c = p.in[1]; const float* w_ada = p.in[3]; const float* b_ada = p.in[4];
    float* mod = (float*)(p.ws + WS_MOD);
    LAS float* sc = (LAS float*)L;
    LAS float* red = (LAS float*)(L + 32768);
    bool filled = false;
    for (int item = v; item < 192; item += G) {
        if (!filled) {
            for (int i = tid; i < 8 * 1024; i += NT) sc[i] = silu_f(c[i]);
            __syncthreads(); filled = true;
        }
        const int cx = tid & 31, kl = tid >> 5, col = item * 32 + cx;
        float a[8];
#pragma unroll
        for (int b = 0; b < 8; ++b) a[b] = 0.f;
#pragma unroll 8
        for (int k = kl; k < 1024; k += 16) {
            const float w = w_ada[(size_t)k * 6144 + col];
#pragma unroll
            for (int b = 0; b < 8; ++b) a[b] += sc[b * 1024 + k] * w;
        }
#pragma unroll
        for (int b = 0; b < 8; ++b) red[(b * 16 + kl) * 32 + cx] = a[b];
        __syncthreads();
        if (tid < 256) {
            const int b = tid >> 5, cc = tid & 31; float s_ = 0.f;
#pragma unroll
            for (int k = 0; k < 16; ++k) s_ += red[(b * 16 + k) * 32 + cc];
            mod[b * 6144 + item * 32 + cc] = s_ + b_ada[item * 32 + cc];
        }
        __syncthreads();
    }
    {
        bf16_t* wb = (bf16_t*)(p.ws + WS_WB);
        const size_t gt = (size_t)v * NT + tid, gs = (size_t)G * NT;
        auto conv = [&](const float* src, size_t off, size_t n) {
            for (size_t i = gt; i < n / 4; i += gs) { const f32x4 f = *(const f32x4*)(src + 4 * i); u32x2 w; w.x = pk2(f[0], f[1]); w.y = pk2(f[2], f[3]); *(u32x2*)(wb + off + 4 * i) = w; }
        };
        auto convg = [&](const float* src, size_t off, size_t n, int ncol, const float* gain) {
            for (size_t i = gt; i < n / 4; i += gs) { const float gk = gain[(4 * i) / ncol]; const f32x4 f = *(const f32x4*)(src + 4 * i); u32x2 w; w.x = pk2(f[0] * gk, f[1] * gk); w.y = pk2(f[2] * gk, f[3] * gk); *(u32x2*)(wb + off + 4 * i) = w; }
        };
        conv(p.in[7], WB_IN, (size_t)1024 * 1952); convg(p.in[10], WB_UQ, (size_t)256 * 768, 768, p.in[8]); convg(p.in[11], WB_UKV, (size_t)128 * 1024, 1024, p.in[9]);
        conv(p.in[17], WB_O, (size_t)1024 * 1024); conv(p.in[20], WB_R, (size_t)1024 * 256);
        conv(p.in[25], WB_SG, (size_t)1024 * 256); conv(p.in[26], WB_SU, (size_t)1024 * 256); conv(p.in[27], WB_SD, (size_t)256 * 1024);
    }
}

__device__ __forceinline__ void phase_h1(const Params& p) {
    const int v = vcu(), G = grid_g();
    const int tid = otid(), lane = tid & 63, wave = tid >> 6;
    const float* x = p.in[0]; const int* positions = (const int*)p.in[2]; const float* g = p.in[5];
    const float* mod = (const float*)(p.ws + WS_MOD);
    bf16_t* h1 = (bf16_t*)(p.ws + WS_H1);
    f32x2* rope = (f32x2*)(p.ws + WS_ROPE);
    for (int t = v * NW + wave; t < T; t += G * NW) {
        const int b = t / SEQ;
        const f32x4* xr = (const f32x4*)(x + (size_t)t * Dm);
        f32x4 xv[4]; float ss = 0.f;
#pragma unroll
        for (int j = 0; j < 4; ++j) { xv[j] = xr[lane + 64 * j]; ss += xv[j][0] * xv[j][0] + xv[j][1] * xv[j][1] + xv[j][2] * xv[j][2] + xv[j][3] * xv[j][3]; }
        ss = wave_sum(ss, lane);
        const float rstd = rsqrtf(ss * (1.f / Dm) + 1e-6f);
        const float* sh = mod + b * 6144; const float* scl = sh + 1024;
#pragma unroll
        for (int j = 0; j < 4; ++j) {
            const int col = 4 * (lane + 64 * j);
            const f32x4 gv = *(const f32x4*)(g + col), sv = *(const f32x4*)(scl + col), hv = *(const f32x4*)(sh + col);
            float o[4];
#pragma unroll
            for (int e = 0; e < 4; ++e) o[e] = (xv[j][e] * rstd * gv[e]) * (1.f + sv[e]) + hv[e];
            u32x2 w; w.x = pk2(o[0], o[1]); w.y = pk2(o[2], o[3]);
            *(u32x2*)(h1 + (size_t)t * Dm + col) = w;
        }
        if (lane < 16) {
            const double inv = exp2(-(double)lane * (13.287712379549449 / 16.0));
            const double rev = (double)positions[t] * inv * 0.15915494309189535;
            const float fr = (float)(rev - rint(rev));
            f32x2 cs; cs.x = __builtin_amdgcn_cosf(fr); cs.y = __builtin_amdgcn_sinf(fr);
            rope[(size_t)t * 16 + lane] = cs;
        }
    }
}

__device__ __forceinline__ void phase_proj(const Params& p, LAS char* L) {
    const int v = vcu(), G = grid_g();
    const bf16_t* h1 = (const bf16_t*)(p.ws + WS_H1);
    const bf16_t* w_in = (const bf16_t*)(p.ws + WS_WB) + WB_IN;
    bf16_t* proj = (bf16_t*)(p.ws + WS_PROJ);
    const f32x2* rope = (const f32x2*)(p.ws + WS_ROPE);
    for (int u = v; u < 64 * 8; u += G) {
        const int mt = u >> 3, nt = u & 7, m0 = mt * 256, n0 = nt * 256;
        auto arow = [&](int r) { return (unsigned)(m0 + r) * Dm; };
        auto bcol = [&](int c) { int col = n0 + c; if (col > NIN - 8) col = NIN - 8; return w_in + col; };
        auto epi = [&](f32x16 (&acc)[4][2], int seg, LAS char* Ls) {
            const int tid_ = otid(), lane = tid_ & 63, wave = tid_ >> 6, wm = wave & 1, wn = wave >> 1, l31 = lane & 31, hi = lane >> 5;
            if (nt < 2) {
                LAS float* ssl = (LAS float*)(L + OFF_SS);
                const bool contrib = (nt == 0) || (wn < 2);
#pragma unroll
                for (int mi = 0; mi < 4; ++mi) {
                    float part = 0.f;
#pragma unroll
                    for (int ni = 0; ni < 2; ++ni)
#pragma unroll
                        for (int r = 0; r < 16; ++r) part += acc[mi][ni][r] * acc[mi][ni][r];
                    part += shx(part, 32, lane);
                    if (hi == 0) ssl[(128 * wm + 32 * mi + l31) * 4 + wn] = contrib ? part : 0.f;
                }
                __syncthreads();
                if (tid_ < 256) {
                    const f32x4 q4 = *(LAS f32x4*)(ssl + tid_ * 4);
                    const float ssum = (q4[0] + q4[1]) + (q4[2] + q4[3]);
                    float* rs = (float*)(p.ws + WS_CQN) + (nt == 0 ? 0 : (1 << 18));
                    rs[m0 + tid_] = rsqrtf(ssum * (nt == 0 ? 1.f / 256.f : 1.f / 128.f) + 1e-6f);
                }
            }
#pragma unroll
            for (int ni = 0; ni < 2; ++ni) {
                const int nbg = n0 + nb_of<0>(wn, ni);
                if (nbg == C_KR) {
#pragma unroll
                    for (int mi = 0; mi < 4; ++mi) {
                        const int m = m0 + 128 * wm + 32 * mi + l31;
#pragma unroll
                        for (int r = 0; r < 8; ++r) {
                            const f32x2 cs = rope[(size_t)m * 16 + crow(r, hi)];
                            const float x1 = acc[mi][ni][r], x2 = acc[mi][ni][r + 8];
                            acc[mi][ni][r] = x1 * cs.x - x2 * cs.y; acc[mi][ni][r + 8] = x2 * cs.x + x1 * cs.y;
                        }
                    }
                }
                if (nbg >= C_DQ && nbg < C_DK) {
#pragma unroll
                    for (int mi = 0; mi < 4; ++mi)
#pragma unroll
                        for (int r = 0; r < 16; ++r) acc[mi][ni][r] *= 0.125f * LOG2E;
                }
            }
            store_tile_bf16<4, 256>(Ls, acc, [&](int row, int c) -> bf16_t* { const int col = n0 + 8 * c; return col < NIN ? proj + (size_t)(m0 + row) * NIN + col : nullptr; });
        };
        gemm_tile<4, 0, true>(L, Dm / 64, NIN, h1, arow, bcol, epi);
    }
}

__device__ __forceinline__ void phase_qkv(const Params& p, LAS char* L) {
    const int v = vcu(), G = grid_g();
    const bf16_t* proj = (const bf16_t*)(p.ws + WS_PROJ);
    const float* rstd_q = (const float*)(p.ws + WS_CQN); const float* rstd_kv = rstd_q + (1 << 18);
    const bf16_t* w_uq = (const bf16_t*)(p.ws + WS_WB) + WB_UQ; const bf16_t* w_ukv = (const bf16_t*)(p.ws + WS_WB) + WB_UKV;
    bf16_t* qm = (bf16_t*)(p.ws + WS_QM); bf16_t* kf = (bf16_t*)(p.ws + WS_KF); bf16_t* vm = (bf16_t*)(p.ws + WS_VM);
    const f32x2* rope = (const f32x2*)(p.ws + WS_ROPE);
    const float qscale = LOG2E * 0.10206207261596575f;
    for (int u = v; u < 64 * 7; u += G) {
        const int mt = u / 7, j = u % 7, m0 = mt * 256;
        if (j < 3) {
            const int n0 = j * 256;
            auto arow = [&](int r) { return (unsigned)(m0 + r) * NIN + C_CQ; };
            auto bcol = [&](int c) { return w_uq + n0 + c; };
            auto epi = [&](f32x16 (&acc)[4][2], int seg, LAS char* Ls) {
                const int tid_ = otid(), lane = tid_ & 63, wave = tid_ >> 6, wm = wave & 1, wn = wave >> 1, l31 = lane & 31, hi = lane >> 5;
#pragma unroll
                for (int mi = 0; mi < 4; ++mi) {
                    const int m = m0 + 128 * wm + 32 * mi + l31;
                    const float qs = qscale * rstd_q[m];
#pragma unroll
                    for (int ni = 0; ni < 2; ++ni) {
                        const int nbg = n0 + nb_of<0>(wn, ni);
                        if ((nbg % 96) == 64) {
#pragma unroll
                            for (int r = 0; r < 8; ++r) {
                                const f32x2 cs = rope[(size_t)m * 16 + crow(r, hi)];
                                const float x1 = acc[mi][ni][r], x2 = acc[mi][ni][r + 8];
                                acc[mi][ni][r] = x1 * cs.x - x2 * cs.y; acc[mi][ni][r + 8] = x2 * cs.x + x1 * cs.y;
                            }
                        }
#pragma unroll
                        for (int r = 0; r < 16; ++r) acc[mi][ni][r] *= qs;
                    }
                }
                store_tile_bf16<4, 256>(Ls, acc, [&](int row, int c) -> bf16_t* { return qm + (size_t)(m0 + row) * 768 + n0 + 8 * c; });
            };
            gemm_tile<4, 0, true>(L, 256 / 64, 768, proj, arow, bcol, epi);
        } else {
            const int n0 = (j - 3) * 256;
            auto arow = [&](int r) { return (unsigned)(m0 + r) * NIN + C_CKV; };
            auto bcol = [&](int c) { return w_ukv + n0 + c; };
            auto epi = [&](f32x16 (&acc)[4][2], int seg, LAS char* Ls) {
                {
                    const int tid_ = otid(), lane = tid_ & 63, wave = tid_ >> 6, wm = wave & 1, l31 = lane & 31;
#pragma unroll
                    for (int mi = 0; mi < 4; ++mi) {
                        const float rs = rstd_kv[m0 + 128 * wm + 32 * mi + l31];
#pragma unroll
                        for (int ni = 0; ni < 2; ++ni)
#pragma unroll
                            for (int r = 0; r < 16; ++r) acc[mi][ni][r] *= rs;
                    }
                }
                store_tile_bf16<4, 256>(Ls, acc, [&](int row, int c) -> bf16_t* {
                    const int h = (n0 >> 7) + (c >> 4), cc = c & 15;
                    return cc < 8 ? kf + (size_t)(m0 + row) * 768 + h * 96 + 8 * cc : vm + (size_t)(m0 + row) * 512 + h * 64 + 8 * (cc - 8); });
            };
            gemm_tile<4, 0, true>(L, 128 / 64, 1024, proj, arow, bcol, epi);
        }
    }
}

template <int DQK, int DV, bool ALIBI>
__device__ __forceinline__ void attn_map(LAS char* L, const bf16_t* Q, int ldq, const bf16_t* K, int ldk, const bf16_t* V, int ldv,
                                         const int* posrow, float slope2, int q0, f32x16 (&o)[DV / 32], const bf16_t* K2 = nullptr, int ldk2 = 0) {
    constexpr int KSTR = DQK * 2 + 16, VSTR = DV * 2 + 64, KS = DQK / 16, ND = DV / 32;
    constexpr int K_OFF = 0, V_OFF = 64 * KSTR, P_OFF = V_OFF + 64 * VSTR, ABUF = P_OFF + 256;
    constexpr int KCH = DQK / 8, VCH = DV / 8;
    constexpr int NKI = (64 * KCH + NT - 1) / NT, NVI = (64 * VCH + NT - 1) / NT;
    static_assert(4 * ABUF <= G_LDS, "attention buffers");
    const int tid = otid();
    const int lane = tid & 63, wave = tid >> 6, l31 = lane & 31, hi = lane >> 5;
    const int qrow = q0 + 32 * wave + l31;
    unsigned kgo[NKI], klo[NKI], vgo[NVI], vlo[NVI];
    bool k2s[NKI];
#pragma unroll
    for (int i = 0; i < NKI; ++i) { int c = tid + NT * i; if (c >= 64 * KCH) c = 64 * KCH - 1; const int row = c / KCH, ch = c % KCH; k2s[i] = (DQK == 96) && (ch >= 8);
        kgo[i] = k2s[i] ? (unsigned)(row * ldk2 + (ch - 8) * 8) * 2u : (unsigned)(row * ldk + ch * 8) * 2u; klo[i] = K_OFF + row * KSTR + ch * 16; }
#pragma unroll
    for (int i = 0; i < NVI; ++i) { int c = tid + NT * i; if (c >= 64 * VCH) c = 64 * VCH - 1; const int row = c / VCH, ch = c % VCH; vgo[i] = (unsigned)(row * ldv + ch * 8) * 2u; vlo[i] = V_OFF + row * VSTR + ch * 16; }
    bf16x8 qf[KS];
#pragma unroll
    for (int s = 0; s < KS; ++s) qf[s] = *(const bf16x8*)(Q + (size_t)qrow * ldq + 16 * s + 8 * hi);
    const float posq = ALIBI ? (float)posrow[qrow] : 0.f;
#pragma unroll
    for (int d = 0; d < ND; ++d)
#pragma unroll
        for (int r = 0; r < 16; ++r) o[d][r] = 0.f;
    float m_run = -1e30f, l_run = 0.f;
    const int ntile = (q0 + 256) / 64;
    const int qmin = q0 + 32 * wave, qmax = qmin + 31;
    const int vrd = V_OFF + (4 * hi + ((lane & 15) >> 2)) * VSTR + 2 * (16 * ((lane >> 4) & 1) + 4 * (lane & 3));
    u32x4 rk[2][NKI], rv[2][NVI]; float rp = 0.f;
#define A_LOAD(T) do {        \
        _Pragma("unroll") for (int h_ = 0; h_ < 2; ++h_) { \
            const char* kbase_ = (const char*)(K + (size_t)(2 * (T) + h_) * 64 * ldk); const char* kbase2_ = (const char*)(K2 + (size_t)(2 * (T) + h_) * 64 * ldk2); \
            const char* vbase_ = (const char*)(V + (size_t)(2 * (T) + h_) * 64 * ldv); \
            _Pragma("unroll") for (int i = 0; i < NKI; ++i) rk[h_][i] = *(const u32x4*)((k2s[i] ? kbase2_ : kbase_) + kgo[i]); \
            _Pragma("unroll") for (int i = 0; i < NVI; ++i) rv[h_][i] = *(const u32x4*)(vbase_ + vgo[i]); } \
        if (ALIBI && tid < 128) rp = (float)posrow[(T) * 128 + tid]; } while (0)
#define A_STORE(LP) do { \
        _Pragma("unroll") for (int h_ = 0; h_ < 2; ++h_) { \
            _Pragma("unroll") for (int i = 0; i < NKI; ++i) if (tid + NT * i < 64 * KCH) *(LAS u32x4*)((LP) + h_ * ABUF + klo[i]) = rk[h_][i]; \
            _Pragma("unroll") for (int i = 0; i < NVI; ++i) if (tid + NT * i < 64 * VCH) *(LAS u32x4*)((LP) + h_ * ABUF + vlo[i]) = rv[h_][i]; } \
        if (ALIBI && tid < 128) *(LAS float*)((LP) + (tid >> 6) * ABUF + P_OFF + 4 * (tid & 63)) = rp; } while (0)
#define A_KFRAG(DST, LP, S_) do { DST[0] = *(LAS bf16x8*)((LP) + K_OFF + l31 * KSTR + 32 * (S_) + 16 * hi); DST[1] = *(LAS bf16x8*)((LP) + K_OFF + (32 + l31) * KSTR + 32 * (S_) + 16 * hi); } while (0)
#define A_SCORES(S0, S1, LP, KB) do { \
        bf16x8 kfa_[2], kfb_[2]; \
        A_KFRAG(kfa_, LP, 0); \
        _Pragma("unroll") for (int s = 0; s < KS; s += 2) {        \
            if (s + 1 < KS) A_KFRAG(kfb_, LP, s + 1); \
            if (s == 0) { S0 = MFMA32(kfa_[0], qf[0], z16); S1 = MFMA32(kfa_[1], qf[0], z16); }         \
            else { S0 = MFMA32(kfa_[0], qf[s], S0); S1 = MFMA32(kfa_[1], qf[s], S1); } \
            __builtin_amdgcn_sched_barrier(0); \
            if (s + 1 < KS) { \
                if (s + 2 < KS) A_KFRAG(kfa_, LP, s + 2); \
                S0 = MFMA32(kfb_[0], qf[s + 1], S0); S1 = MFMA32(kfb_[1], qf[s + 1], S1); \
                __builtin_amdgcn_sched_barrier(0); } } \
        if (ALIBI) { \
            _Pragma("unroll") for (int g4 = 0; g4 < 4; ++g4) { \
                const f32x4 pk0_ = *(LAS f32x4*)((LP) + P_OFF + 4 * (8 * g4 + 4 * hi)), pk1_ = *(LAS f32x4*)((LP) + P_OFF + 4 * (32 + 8 * g4 + 4 * hi)); \
                _Pragma("unroll") for (int e = 0; e < 4; ++e) { S0[4 * g4 + e] -= slope2 * fabsf(posq - pk0_[e]); S1[4 * g4 + e] -= slope2 * fabsf(posq - pk1_[e]); } } } \
        if ((KB) + 63 > qmin) { \
            _Pragma("unroll") for (int r = 0; r < 16; ++r) { const int key_ = (KB) + crow(r, hi); if (key_ > qrow) S0[r] = -INFINITY; if (key_ + 32 > qrow) S1[r] = -INFINITY; } } } while (0)
#define A_VFRAG(DST, LP, S_) do { _Pragma("unroll") for (int d = 0; d < ND; ++d) { \
            LAS char* vp_ = (LP) + vrd + 16 * (S_) * VSTR + 64 * d; const s16x4 lo_ = tr_read(vp_), h4_ = tr_read(vp_ + 8 * VSTR); \
            DST[d] = (bf16x8){lo_[0], lo_[1], lo_[2], lo_[3], h4_[0], h4_[1], h4_[2], h4_[3]}; } } while (0)
#define A_SOFTMAX_PV(S0, S1, LP) do { \
        bf16x8 vfa_[ND], vfb_[ND]; \
        A_VFRAG(vfa_, LP, 0);                                       \
        float mxa_ = S0[0], mxb_ = S0[8], mxc_ = S1[0], mxd_ = S1[8];          \
        _Pragma("unroll") for (int r = 1; r < 8; ++r) { mxa_ = fmaxf(mxa_, S0[r]); mxb_ = fmaxf(mxb_, S0[8 + r]); mxc_ = fmaxf(mxc_, S1[r]); mxd_ = fmaxf(mxd_, S1[8 + r]); } \
        float mx_ = fmaxf(fmaxf(mxa_, mxb_), fmaxf(mxc_, mxd_)); \
        { const auto rr_ = __builtin_amdgcn_permlane32_swap(__float_as_uint(mx_), __float_as_uint(mx_), false, false); mx_ = fmaxf(__uint_as_float(rr_[0]), __uint_as_float(rr_[1])); }     \
        if (__any(mx_ > m_run + 8.f)) { \
            const float m_new_ = fmaxf(m_run, mx_); const float alpha_ = __builtin_amdgcn_exp2f(m_run - m_new_); m_run = m_new_; l_run *= alpha_; \
            _Pragma("unroll") for (int d = 0; d < ND; ++d) _Pragma("unroll") for (int r = 0; r < 16; ++r) o[d][r] *= alpha_; } \
        float lsa_ = 0.f, lsb_ = 0.f, lsc_ = 0.f, lsd_ = 0.f; \
        _Pragma("unroll") for (int r = 0; r < 16; ++r) { S0[r] = __builtin_amdgcn_exp2f(S0[r] - m_run); S1[r] = __builtin_amdgcn_exp2f(S1[r] - m_run); } \
        _Pragma("unroll") for (int r = 0; r < 8; ++r) { lsa_ += S0[r]; lsb_ += S0[8 + r]; lsc_ += S1[r]; lsd_ += S1[8 + r]; } \
        l_run += (lsa_ + lsb_) + (lsc_ + lsd_); \
        u32x4 pw_[4]; \
        _Pragma("unroll") for (int j = 0; j < 4; ++j) { \
            pw_[0][j] = pk2(S0[2 * j], S0[2 * j + 1]); pw_[1][j] = pk2(S0[8 + 2 * j], S0[8 + 2 * j + 1]); \
            pw_[2][j] = pk2(S1[2 * j], S1[2 * j + 1]); pw_[3][j] = pk2(S1[8 + 2 * j], S1[8 + 2 * j + 1]); } \
        __builtin_amdgcn_sched_barrier(0); \
        A_VFRAG(vfb_, LP, 1); \
        _Pragma("unroll") for (int d = 0; d < ND; ++d) o[d] = MFMA32(vfa_[d], __builtin_bit_cast(bf16x8, pw_[0]), o[d]); \
        __builtin_amdgcn_sched_barrier(0); \
        A_VFRAG(vfa_, LP, 2); \
        _Pragma("unroll") for (int d = 0; d < ND; ++d) o[d] = MFMA32(vfb_[d], __builtin_bit_cast(bf16x8, pw_[1]), o[d]); \
        __builtin_amdgcn_sched_barrier(0); \
        A_VFRAG(vfb_, LP, 3); \
        _Pragma("unroll") for (int d = 0; d < ND; ++d) o[d] = MFMA32(vfa_[d], __builtin_bit_cast(bf16x8, pw_[2]), o[d]); \
        __builtin_amdgcn_sched_barrier(0); \
        _Pragma("unroll") for (int d = 0; d < ND; ++d) o[d] = MFMA32(vfb_[d], __builtin_bit_cast(bf16x8, pw_[3]), o[d]); \
        __builtin_amdgcn_sched_barrier(0); } while (0)
    A_LOAD(0);
    __syncthreads();
    A_STORE(L);
    __syncthreads();
    const f32x16 z16 = {0.f, 0.f, 0.f, 0.f, 0.f, 0.f, 0.f, 0.f, 0.f, 0.f, 0.f, 0.f, 0.f, 0.f, 0.f, 0.f};
    f32x16 sa0, sa1, sb0, sb1;
    const int nbt = ntile / 2;
    for (int T = 0; T < nbt; ++T) {
        LAS char* Lc = L + (T & 1) * 2 * ABUF; LAS char* Ln = L + ((T + 1) & 1) * 2 * ABUF;
        const int kb = T * 128;
        const bool more = T + 1 < nbt;
        if (more) A_LOAD(T + 1);
        const bool act0 = kb <= qmax, act1 = kb + 64 <= qmax;
        if (act0) {
            A_SCORES(sa0, sa1, Lc, kb);
            if (act1) {
                A_SCORES(sb0, sb1, Lc + ABUF, kb + 64);
                A_SOFTMAX_PV(sa0, sa1, Lc);
                A_SOFTMAX_PV(sb0, sb1, Lc + ABUF);
            } else {
                A_SOFTMAX_PV(sa0, sa1, Lc);
            }
        }
        if (more) A_STORE(Ln);
        __syncthreads();
    }
#undef A_LOAD
#undef A_STORE
#undef A_SCORES
#undef A_SOFTMAX_PV
#undef A_KFRAG
#undef A_VFRAG
    const float lt = l_run + shx(l_run, 32, lane);
    const float inv = 1.f / lt;
#pragma unroll
    for (int d = 0; d < ND; ++d)
#pragma unroll
        for (int r = 0; r < 16; ++r) o[d][r] *= inv;
}

__device__ __forceinline__ void attn_decode(int it, int& kind, int& qb, int& idx) {
    const int seg_kind[16] = {1, 1, 1, 1, 1, 0, 1, 0, 0, 0, 1, 0, 0, 1, 0, 0};
    const int seg_qb[16]   = {7, 6, 5, 4, 3, 7, 2, 6, 5, 4, 1, 3, 2, 0, 1, 0};
    int base = 0; kind = 0; qb = 0; idx = 0;
#pragma unroll
    for (int s = 0; s < 16; ++s) {
        const int n = seg_kind[s] ? 32 : 64;
        if (it >= base && it < base + n) { kind = seg_kind[s]; qb = seg_qb[s]; idx = it - base; }
        base += n;
    }
}

constexpr int NCONV = 257 * 12;
__device__ __forceinline__ void conv_item(const Params& p, LAS char* L, int c) {
    const int tid = otid();
    const int e = c / 12, sub = c - 12 * e;
    const bool down = sub >= 8;
    const float* src; unsigned char* dst; float scale;
    if (!down) {
        const int up = sub >> 2, n0 = (sub & 3) * 64;
        src = (e < 256 ? p.in[22 + up] + (size_t)e * Dm * 256 : p.in[25 + up]) + n0;
        dst = (unsigned char*)(p.ws + WS_W8GU) + ((size_t)e * 512 + up * 256 + n0) * 1024;
        scale = WGUSCALE;
    } else {
        const int n0 = (sub - 8) * 256;
        src = (e < 256 ? p.in[24] + (size_t)e * 256 * Dm : p.in[27]) + n0;
        dst = (unsigned char*)(p.ws + WS_W8D) + ((size_t)e * 1024 + n0) * 256;
        scale = WDSCALE;
    }
    const int np = down ? 1024 : 256, rb = down ? 256 : 1024;
    const int nq = tid & 15, kr = tid >> 4;
    f32x4 v[8][4];
#pragma unroll
    for (int g = 0; g < 8; ++g) {
        const float* sg = src + (down ? 64 * (g >> 1) + (size_t)(128 * (g & 1)) * np : (size_t)(128 * g) * np) + (size_t)(4 * kr) * np + 4 * nq;
#pragma unroll
        for (int kk = 0; kk < 4; ++kk) v[g][kk] = __builtin_nontemporal_load((const f32x4*)(sg + (size_t)kk * np));
    }
#pragma unroll
    for (int g = 0; g < 8; ++g) {
        const int nl0 = (down ? 64 * (g >> 1) : 0) + 4 * nq, kd = kr + 32 * (down ? (g & 1) : g);
        const int pos = 4 * (kd ^ (4 * (nq & 7)));
#pragma unroll
        for (int cc = 0; cc < 4; ++cc) {
            int w = 0;
            w = __builtin_amdgcn_cvt_pk_fp8_f32(v[g][0][cc] * scale, v[g][1][cc] * scale, w, false);
            w = __builtin_amdgcn_cvt_pk_fp8_f32(v[g][2][cc] * scale, v[g][3][cc] * scale, w, true);
            *(LAS int*)(L + (nl0 + cc) * rb + pos) = w;
        }
    }
    __syncthreads();
#pragma unroll
    for (int j = 0; j < 8; ++j) {
        const int id = tid + NT * j;
        const int row = down ? (id >> 4) : (id >> 6), ch = down ? (id & 15) : (id & 63);
        *(u32x4*)(dst + (size_t)16 * id) = *(LAS u32x4*)(L + row * rb + 16 * (ch ^ ((row >> 2) & 7)));
    }
    __syncthreads();
}

__device__ __forceinline__ void phase_attn(const Params& p, LAS char* L) {
    const int v = vcu(), G = grid_g();
    const int tid = otid(), lane = tid & 63, wave = tid >> 6, l31 = lane & 31, hi = lane >> 5;
    const int* positions = (const int*)p.in[2];
    const bf16_t* proj = (const bf16_t*)(p.ws + WS_PROJ);
    const bf16_t* qm = (const bf16_t*)(p.ws + WS_QM); const bf16_t* kf = (const bf16_t*)(p.ws + WS_KF); const bf16_t* vm = (const bf16_t*)(p.ws + WS_VM);
    bf16_t* att = (bf16_t*)(p.ws + WS_ATT);
    float* od0 = (float*)(p.ws + WS_OD0);
    const float* subg = p.in[16];
    unsigned* qctr = (unsigned*)(p.ws + WS_CTL + 2048);
    LAS unsigned* qslot = (LAS unsigned*)(L + OFF_MISC + 16);
    float lam;
    {
        const float a = p.in[12][lane] * p.in[13][lane], b = p.in[14][lane] * p.in[15][lane];
        lam = __expf(wave_sum(a, lane)) - __expf(wave_sum(b, lane)) + LAMBDA_INIT;
    }
    for (;;) {
        if (tid == 0) *qslot = __hip_atomic_fetch_add(qctr, 1u, __ATOMIC_RELAXED, __HIP_MEMORY_SCOPE_AGENT);
        __syncthreads();
        int it = __builtin_amdgcn_readfirstlane((int)*qslot);
        __syncthreads();
        if (it >= 768 + NCONV) break;
        if (it >= 768 * 5) { conv_item(p, L, 768 * 4 + (it - 768 * 5)); continue; }
        if (it % 5 != 0) { conv_item(p, L, (it / 5) * 4 + (it % 5) - 1); continue; }
        it /= 5;
        int kind, qb, idx;
        attn_decode(it, kind, qb, idx);
        const int q0 = qb * 256;
        if (kind == 0) {
            const int b = idx >> 3, h = idx & 7; const size_t tb = (size_t)b * SEQ;
            f32x16 o[2];
            attn_map<96, 64, false>(L, qm + tb * 768 + h * 96, 768, kf + tb * 768 + h * 96, 768, vm + tb * 512 + h * 64, 512, positions + tb, 0.f, q0, o, proj + tb * NIN + C_KR, NIN);
            const size_t t = tb + q0 + 32 * wave + l31;
#pragma unroll
            for (int d = 0; d < 2; ++d)
#pragma unroll
                for (int gq = 0; gq < 4; ++gq) {
                    u32x2 w; w.x = pk2(o[d][4 * gq], o[d][4 * gq + 1]); w.y = pk2(o[d][4 * gq + 2], o[d][4 * gq + 3]);
                    *(u32x2*)(att + t * 1024 + h * 64 + 32 * d + 8 * gq + 4 * hi) = w;
                }
        } else {
            const int b = idx >> 2, h = idx & 3; const size_t tb = (size_t)b * SEQ;
            const float slope2 = exp2f(-2.f * (h + 1)) * LOG2E;
            const size_t t = tb + q0 + 32 * wave + l31;
            f32x16 o[4];
            attn_map<64, 128, true>(L, proj + tb * NIN + C_DQ + h * 128, NIN, proj + tb * NIN + C_DK + h * 128, NIN, proj + tb * NIN + C_DV + h * 128, NIN, positions + tb, slope2, q0, o);
#pragma unroll
            for (int d = 0; d < 4; ++d)
#pragma unroll
                for (int gq = 0; gq < 4; ++gq) {
                    f32x4 w = {o[d][4 * gq], o[d][4 * gq + 1], o[d][4 * gq + 2], o[d][4 * gq + 3]};
                    *(f32x4*)(od0 + t * 512 + h * 128 + 32 * d + 8 * gq + 4 * hi) = w;
                }
            attn_map<64, 128, true>(L, proj + tb * NIN + C_DQ + h * 128 + 64, NIN, proj + tb * NIN + C_DK + h * 128 + 64, NIN, proj + tb * NIN + C_DV + h * 128, NIN, positions + tb, slope2, q0, o);
            float ss = 0.f;
#pragma unroll
            for (int d = 0; d < 4; ++d)
#pragma unroll
                for (int gq = 0; gq < 4; ++gq) {
                    const f32x4 w = *(const f32x4*)(od0 + t * 512 + h * 128 + 32 * d + 8 * gq + 4 * hi);
#pragma unroll
                    for (int e = 0; e < 4; ++e) { const float c = w[e] - lam * o[d][4 * gq + e]; o[d][4 * gq + e] = c; ss += c * c; }
                }
            ss += shx(ss, 32, lane);
            const float rstd = rsqrtf(ss * (1.f / 128.f) + 1e-5f) * (1.f - LAMBDA_INIT);
#pragma unroll
            for (int d = 0; d < 4; ++d)
#pragma unroll
                for (int gq = 0; gq < 4; ++gq) {
                    const int dv = 32 * d + 8 * gq + 4 * hi;
                    const f32x4 gv = *(const f32x4*)(subg + dv);
                    u32x2 w; w.x = pk2(o[d][4 * gq] * rstd * gv[0], o[d][4 * gq + 1] * rstd * gv[1]); w.y = pk2(o[d][4 * gq + 2] * rstd * gv[2], o[d][4 * gq + 3] * rstd * gv[3]);
                    *(u32x2*)(att + t * 1024 + 512 + h * 128 + dv) = w;
                }
        }
    }
}

__device__ __forceinline__ void phase_oproj(const Params& p, LAS char* L) {
    const int v = vcu(), G = grid_g();
    const bf16_t* att = (const bf16_t*)(p.ws + WS_ATT);
    const bf16_t* w_o = (const bf16_t*)(p.ws + WS_WB) + WB_O;
    bf16_t* y1 = (bf16_t*)(p.ws + WS_Y1);
    for (int u = v; u < 64 * 4; u += G) {
        const int mt = u >> 2, nt = u & 3, m0 = mt * 256, n0 = nt * 256;
        auto arow = [&](int r) { return (unsigned)(m0 + r) * Dm; };
        auto bcol = [&](int c) { return w_o + n0 + c; };
        auto epi = [&](f32x16 (&acc)[4][2], int seg, LAS char* Ls) {
            store_tile_bf16<4, 256>(Ls, acc, [&](int row, int c) -> bf16_t* { return y1 + (size_t)(m0 + row) * Dm + n0 + 8 * c; });
        };
        gemm_tile<4, 0, true>(L, Dm / 64, Dm, att, arow, bcol, epi);
    }
}

__device__ __forceinline__ void post_attn_tokens(const Params& p, int t0, int nper) {
    const int tid = otid(), lane = tid & 63, wave = tid >> 6;
    const float* x = p.in[0]; const float* pg = p.in[6]; const float* fg = p.in[18];
    const float* mod = (const float*)(p.ws + WS_MOD);
    const bf16_t* y1 = (const bf16_t*)(p.ws + WS_Y1);
    bf16_t* h2 = (bf16_t*)(p.ws + WS_H2);
    unsigned char* h8 = (unsigned char*)(p.ws + WS_H8);
    bf16_t* x1b = (bf16_t*)(p.ws + WS_H1);
    for (int i_ = 0; i_ < nper; ++i_) {
        const int t = t0 + wave + NW * i_;
        const int b = t / SEQ;
        const float* mb = mod + b * 6144;
        f32x4 yv[4], xv[4]; float ss = 0.f;
#pragma unroll
        for (int j = 0; j < 4; ++j) {
            const u32x2 raw = *(const u32x2*)(y1 + (size_t)t * Dm + 4 * (lane + 64 * j));
            yv[j] = (f32x4){bflo(raw.x), bfhi(raw.x), bflo(raw.y), bfhi(raw.y)};
            xv[j] = *(const f32x4*)(x + (size_t)t * Dm + 4 * (lane + 64 * j));
            ss += yv[j][0] * yv[j][0] + yv[j][1] * yv[j][1] + yv[j][2] * yv[j][2] + yv[j][3] * yv[j][3];
        }
        ss = wave_sum(ss, lane);
        const float rstd = rsqrtf(ss * (1.f / Dm) + 1e-6f);
        float ss2 = 0.f;
#pragma unroll
        for (int j = 0; j < 4; ++j) {
            const int col = 4 * (lane + 64 * j);
            const f32x4 gv = *(const f32x4*)(pg + col), ga = *(const f32x4*)(mb + 2048 + col);
#pragma unroll
            for (int e = 0; e < 4; ++e) { xv[j][e] = xv[j][e] + ga[e] * (yv[j][e] * rstd * gv[e]); ss2 += xv[j][e] * xv[j][e]; }
            { u32x2 wx; wx.x = pk2(xv[j][0], xv[j][1]); wx.y = pk2(xv[j][2], xv[j][3]); *(u32x2*)(x1b + (size_t)t * Dm + col) = wx; }
        }
        ss2 = wave_sum(ss2, lane);
        const float rstd2 = rsqrtf(ss2 * (1.f / Dm) + 1e-6f);
#pragma unroll
        for (int j = 0; j < 4; ++j) {
            const int col = 4 * (lane + 64 * j);
            const f32x4 gv = *(const f32x4*)(fg + col), sv = *(const f32x4*)(mb + 4096 + col), hv = *(const f32x4*)(mb + 3072 + col);
            float o[4];
#pragma unroll
            for (int e = 0; e < 4; ++e) o[e] = (xv[j][e] * rstd2 * gv[e]) * (1.f + sv[e]) + hv[e];
            u32x2 w; w.x = pk2(o[0], o[1]); w.y = pk2(o[2], o[3]);
            *(u32x2*)(h2 + (size_t)t * Dm + col) = w;
            int w8 = 0;
            w8 = __builtin_amdgcn_cvt_pk_fp8_f32(__builtin_amdgcn_fmed3f(o[0] * H8SCALE, -448.f, 448.f), __builtin_amdgcn_fmed3f(o[1] * H8SCALE, -448.f, 448.f), w8, false);
            w8 = __builtin_amdgcn_cvt_pk_fp8_f32(__builtin_amdgcn_fmed3f(o[2] * H8SCALE, -448.f, 448.f), __builtin_amdgcn_fmed3f(o[3] * H8SCALE, -448.f, 448.f), w8, true);
            *(int*)(h8 + (size_t)t * Dm + col) = w8;
        }
    }
}

__device__ __forceinline__ unsigned fkey(float f) { const unsigned u = __float_as_uint(f); return (u & 0x80000000u) ? ~u : (u | 0x80000000u); }
template <int CTRL, int RM> __device__ __forceinline__ unsigned dppu(unsigned old, unsigned src) { return (unsigned)__builtin_amdgcn_update_dpp((int)old, (int)src, CTRL, RM, 0xf, false); }
template <int CTRL, int RM> __device__ __forceinline__ float dppf(float old, float src) { return __int_as_float(__builtin_amdgcn_update_dpp(__float_as_int(old), __float_as_int(src), CTRL, RM, 0xf, false)); }
__device__ __forceinline__ unsigned wave_umax(unsigned v) {
    v = max(v, dppu<0x111, 0xf>(v, v)); v = max(v, dppu<0x112, 0xf>(v, v)); v = max(v, dppu<0x114, 0xf>(v, v)); v = max(v, dppu<0x118, 0xf>(v, v));
    v = max(v, dppu<0x142, 0xa>(v, v)); v = max(v, dppu<0x143, 0xc>(v, v));
    return (unsigned)__builtin_amdgcn_readlane((int)v, 63);
}
__device__ __forceinline__ float wave_fsum_dpp(float v) {
    v += dppf<0x111, 0xf>(0.f, v); v += dppf<0x112, 0xf>(0.f, v); v += dppf<0x114, 0xf>(0.f, v); v += dppf<0x118, 0xf>(0.f, v);
    v += dppf<0x142, 0xa>(0.f, v); v += dppf<0x143, 0xc>(0.f, v);
    return __int_as_float(__builtin_amdgcn_readlane(__float_as_int(v), 63));
}
__device__ __forceinline__ void phase_router_route(const Params& p, LAS char* L) {
    const int v = vcu(), G = grid_g();
    const bf16_t* h2 = (const bf16_t*)(p.ws + WS_H2);
    const bf16_t* rw = (const bf16_t*)(p.ws + WS_WB) + WB_R;
    const float* rb = p.in[21];
    int* cnt = (int*)(p.ws + WS_CTL);
    int* la = (int*)(p.ws + WS_LA); float* lw = (float*)(p.ws + WS_LW);
    constexpr int LSTR = 1040;
    LAS int* pe = (LAS int*)(L + 69632);
    LAS float* pw = (LAS float*)(L + 69632 + 2048);
    LAS int* hist = (LAS int*)(L + 69632 + 4096);
    LAS int* basep = (LAS int*)(L + 69632 + 5120);
    for (int u = v; u < T / 64; u += G) {
        const int m0 = u * 64;
        post_attn_tokens(p, m0, 8);
        asm volatile("s_waitcnt vmcnt(0)" ::: "memory");
        __syncthreads();
        auto arow = [&](int r) { return (unsigned)(m0 + r) * Dm; };
        auto bcol = [&](int c) { return rw + c; };
        auto epi = [&](f32x16 (&acc)[1][2], int seg, LAS char* Ls) {
            const int tid_ = otid(), lane = tid_ & 63, wave = tid_ >> 6, wm = wave & 1, wn = wave >> 1, l31 = lane & 31, hi = lane >> 5;
            const int row = 32 * wm + l31;
#pragma unroll
            for (int ni = 0; ni < 2; ++ni)
#pragma unroll
                for (int gq = 0; gq < 4; ++gq) {
                    f32x4 w = {acc[0][ni][4 * gq], acc[0][ni][4 * gq + 1], acc[0][ni][4 * gq + 2], acc[0][ni][4 * gq + 3]};
                    *(LAS f32x4*)(L + row * LSTR + 4 * (nb_of<0>(wn, ni) + 8 * gq + 4 * hi)) = w;
                }
        };
        gemm_tile<1, 0, true>(L, Dm / 64, NE, h2, arow, bcol, epi);
        const int tid = otid(), lane = tid & 63, wave = tid >> 6;
        if (tid < 256) hist[tid] = 0;
        __syncthreads();
        const f32x4 bias = *(const f32x4*)(rb + 4 * lane);
        const int grp = lane >> 3;
#pragma unroll 1
        for (int tt = 0; tt < 8; ++tt) {
            const int tok = 8 * wave + tt;
            const f32x4 lgv = *(LAS f32x4*)(L + tok * LSTR + 16 * lane);
            const float s0 = 1.f / (1.f + __expf(-lgv[0])), s1 = 1.f / (1.f + __expf(-lgv[1])), s2 = 1.f / (1.f + __expf(-lgv[2])), s3 = 1.f / (1.f + __expf(-lgv[3]));
            float v0 = s0 + bias[0], v1 = s1 + bias[1], v2 = s2 + bias[2], v3 = s3 + bias[3];
            float t1 = fmaxf(v0, v1), t2 = fminf(v0, v1);
            { const float a = fmaxf(v2, v3), bq = fminf(v2, v3); const float n1 = fmaxf(t1, a), n2 = fmaxf(fminf(t1, a), fmaxf(t2, bq)); t1 = n1; t2 = n2; }
            { const float o1 = dppf<0xB1, 0xf>(t1, t1), o2 = dppf<0xB1, 0xf>(t2, t2); const float n1 = fmaxf(t1, o1), n2 = fmaxf(fminf(t1, o1), fmaxf(t2, o2)); t1 = n1; t2 = n2; }
            { const float o1 = dppf<0x4E, 0xf>(t1, t1), o2 = dppf<0x4E, 0xf>(t2, t2); const float n1 = fmaxf(t1, o1), n2 = fmaxf(fminf(t1, o1), fmaxf(t2, o2)); t1 = n1; t2 = n2; }
            { const float o1 = shx(t1, 4, lane), o2 = shx(t2, 4, lane); const float n1 = fmaxf(t1, o1), n2 = fmaxf(fminf(t1, o1), fmaxf(t2, o2)); t1 = n1; t2 = n2; }
            const float gs = t1 + t2;
            int rank = 0;
#pragma unroll
            for (int gg = 0; gg < 8; ++gg) { const float og = __int_as_float(__builtin_amdgcn_readlane(__float_as_int(gs), gg * 8)); rank += (og > gs || (og == gs && gg < grp)) ? 1 : 0; }
            if (rank >= 4) { v0 = -INFINITY; v1 = -INFINITY; v2 = -INFINITY; v3 = -INFINITY; }
            unsigned k0 = fkey(v0), k1 = fkey(v1), k2 = fkey(v2), k3 = fkey(v3);
            bool c0 = false, c1 = false, c2 = false, c3 = false;
#pragma unroll
            for (int it = 0; it < TOPK; ++it) {
                const unsigned lb = max(max(k0, k1), max(k2, k3));
                const unsigned m = wave_umax(lb);
                const unsigned long long bal = __ballot(lb == m);
                const int owner = __builtin_ctzll(bal);
                if (lane == owner) {
                    if (k0 == m) { k0 = 0u; c0 = true; } else if (k1 == m) { k1 = 0u; c1 = true; } else if (k2 == m) { k2 = 0u; c2 = true; } else { k3 = 0u; c3 = true; }
                }
            }
            const float wsum = wave_fsum_dpp((c0 ? s0 : 0.f) + (c1 ? s1 : 0.f) + (c2 ? s2 : 0.f) + (c3 ? s3 : 0.f));
            const float wnorm = 2.5f / wsum;
            const unsigned long long b0 = __ballot(c0), b1 = __ballot(c1), b2 = __ballot(c2), b3 = __ballot(c3);
            const unsigned long long lm = (1ull << lane) - 1ull;
            const int q0 = __builtin_popcountll(b0 & lm), a1 = __builtin_popcountll(b0);
            const int q1 = a1 + __builtin_popcountll(b1 & lm), a2 = a1 + __builtin_popcountll(b1);
            const int q2 = a2 + __builtin_popcountll(b2 & lm), a3 = a2 + __builtin_popcountll(b2);
            const int q3 = a3 + __builtin_popcountll(b3 & lm);
            if (c0) { pe[8 * tok + q0] = 4 * lane + 0; pw[8 * tok + q0] = s0 * wnorm; }
            if (c1) { pe[8 * tok + q1] = 4 * lane + 1; pw[8 * tok + q1] = s1 * wnorm; }
            if (c2) { pe[8 * tok + q2] = 4 * lane + 2; pw[8 * tok + q2] = s2 * wnorm; }
            if (c3) { pe[8 * tok + q3] = 4 * lane + 3; pw[8 * tok + q3] = s3 * wnorm; }
        }
        __syncthreads();
        const int my_e = pe[tid];
        const int my_rank = __hip_atomic_fetch_add(hist + my_e, 1, __ATOMIC_RELAXED, __HIP_MEMORY_SCOPE_WORKGROUP);
        __syncthreads();
        if (tid < 256) { const int n = hist[tid]; basep[tid] = n > 0 ? atomicAdd(cnt + tid, n) : 0; }
        __syncthreads();
        {
            const int pos = basep[my_e] + my_rank;
            if (pos < LISTCAP) { la[(size_t)my_e * LISTCAP + pos] = (m0 + (tid >> 3)) * TOPK + (tid & 7); lw[(size_t)my_e * LISTCAP + pos] = pw[tid]; }
        }
        __syncthreads();
    }
}

__device__ __forceinline__ int moe_cnt(const int* cnt, int e) { int c = (e < 256) ? cnt[e] : T; return c > LISTCAP ? LISTCAP : c; }
__device__ __forceinline__ void moe_prefix(const Params& p, LAS char* L) {
    const int tid = otid();
    const int* cnt = (const int*)(p.ws + WS_CTL);
    LAS int* pre = (LAS int*)(L + OFF_PRE);
    LAS int* tl = (LAS int*)(L + OFF_TL);
    __syncthreads();
    for (int i = tid; i < 257; i += NT) { const int c = moe_cnt(cnt, i); tl[i] = (c + 255) >> 8; }
    __syncthreads();
    if (tid == 0) { int s = 0; for (int i = 0; i < 257; ++i) { pre[i] = s; s += tl[i]; } pre[257] = s; }
    __syncthreads();
}
__device__ __forceinline__ int moe_find(LAS int* pre, int g) {
    int lo = 0, hi = 256;
    while (lo < hi) { const int mid = (lo + hi + 1) >> 1; if (pre[mid] <= g) lo = mid; else hi = mid - 1; }
    return lo;
}

template <int MI>
__device__ __forceinline__ void moe1_unit(const Params& p, LAS char* L, int e, int r0, int rows, int j0) {
    const unsigned char* h8 = (const unsigned char*)(p.ws + WS_H8);
    const unsigned char* w8 = (const unsigned char*)(p.ws + WS_W8GU) + (size_t)e * 512 * 1024;
    const int* la = (const int*)(p.ws + WS_LA);
    unsigned char* hb = (unsigned char*)(p.ws + WS_HB);
    LAS int* rowid = (LAS int*)(L + OFF_ROW);
    {
        const int tid = otid();
        if (tid < 64 * MI) { const int rr = tid < rows ? tid : 0; rowid[tid] = (e < 256) ? la[(size_t)e * LISTCAP + r0 + rr] : (AR + r0 + rr); }
        __syncthreads();
    }
    auto arow = [&](int r) { const int a = rowid[r]; const int tok = (e < 256) ? (a >> 3) : (a - AR); return (unsigned)tok * Dm; };
    auto wrow = [&](int seg, int r) { return (unsigned)((r < 128) ? (j0 + r) : (128 + j0 + r)) * 1024u; };
    auto epi = [&](f32x16 (&acc)[MI][2], int seg, LAS char* Ls) {
        constexpr float us = 1.f / (H8SCALE * WGUSCALE);
#pragma unroll
        for (int mi = 0; mi < MI; ++mi)
#pragma unroll
            for (int r = 0; r < 16; ++r) acc[mi][0][r] = __builtin_amdgcn_fmed3f(silu_f(acc[mi][0][r] * us) * (acc[mi][1][r] * (us * HBSCALE)), -448.f, 448.f);
        store_tile_fp8<MI, 128>(Ls, acc, [&](int row, int c) -> unsigned char* { return row < rows ? hb + (size_t)rowid[row] * 256 + j0 + 16 * c : nullptr; });
    };
    gemm8_tile<MI, 1>(L, Dm / 128, h8, arow, w8, wrow, epi);
}
__device__ __forceinline__ void phase_moe1(const Params& p, LAS char* L) {
    const int v = vcu(), G = grid_g();
    const int* cnt = (const int*)(p.ws + WS_CTL);
    moe_prefix(p, L);
    LAS int* pre = (LAS int*)(L + OFF_PRE);
    const int total = __builtin_amdgcn_readfirstlane(pre[256]) * 2;
    for (int u = v; u < total; u += G) {
        const int g = u >> 1, j0 = (u & 1) * 128;
        const int e = __builtin_amdgcn_readfirstlane(moe_find(pre, g)), mt = g - __builtin_amdgcn_readfirstlane(pre[e]);
        const int rows = __builtin_amdgcn_readfirstlane(moe_cnt(cnt, e)) - mt * 256;
        if (rows > 128) moe1_unit<4>(p, L, e, mt * 256, rows < 256 ? rows : 256, j0);
        else moe1_unit<2>(p, L, e, mt * 256, rows, j0);
    }
    unsigned* qctr = (unsigned*)(p.ws + WS_CTL + 2048) + 128;
    LAS unsigned* qslot = (LAS unsigned*)(L + OFF_MISC + 16);
    const int tid = otid();
    for (;;) {
        if (tid == 0) *qslot = __hip_atomic_fetch_add(qctr, 1u, __ATOMIC_RELAXED, __HIP_MEMORY_SCOPE_AGENT);
        __syncthreads();
        const int q = __builtin_amdgcn_readfirstlane((int)*qslot);
        __syncthreads();
        if (q >= (T / 128) * 2) break;
        moe1_unit<2>(p, L, 256, (q >> 1) * 128, 128, (q & 1) * 128);
    }
}

template <int MI>
__device__ __forceinline__ void moe2_unit(const Params& p, LAS char* L, int e, int r0, int rows, int n0) {
    const int* la = (const int*)(p.ws + WS_LA); const float* lw = (const float*)(p.ws + WS_LW);
    const unsigned char* hb = (const unsigned char*)(p.ws + WS_HB);
    unsigned char* yb = (unsigned char*)(p.ws + WS_YB);
    const unsigned char* w8 = (const unsigned char*)(p.ws + WS_W8D) + (size_t)e * 1024 * 256;
    LAS int* rowid = (LAS int*)(L + OFF_ROW);
    LAS float* roww = (LAS float*)(L + OFF_RW);
    {
        const int tid = otid();
        if (tid < 64 * MI) {
            const int rr = tid < rows ? tid : 0;
            rowid[tid] = (e < 256) ? la[(size_t)e * LISTCAP + r0 + rr] : (AR + r0 + rr);
            roww[tid] = (e < 256) ? lw[(size_t)e * LISTCAP + r0 + rr] : 1.f;
        }
        __syncthreads();
    }
    auto arow = [&](int r) { return (unsigned)rowid[r] * 256u; };
    auto wrow = [&](int seg, int r) { return (unsigned)(n0 + seg * 256 + r) * 256u; };
    auto epi = [&](f32x16 (&acc)[MI][2], int seg, LAS char* Ls) {
        const int tid_ = otid(), lane = tid_ & 63, wave = tid_ >> 6, wm = wave & 1, l31 = lane & 31;
#pragma unroll
        for (int mi = 0; mi < MI; ++mi) {
            const float w = roww[32 * MI * wm + 32 * mi + l31] * (YSCALE / (HBSCALE * WDSCALE));
#pragma unroll
            for (int ni = 0; ni < 2; ++ni)
#pragma unroll
                for (int q = 0; q < 16; ++q) acc[mi][ni][q] = __builtin_amdgcn_fmed3f(acc[mi][ni][q] * w, -448.f, 448.f);
        }
        store_tile_fp8<MI>(Ls, acc, [&](int row, int c) -> unsigned char* { return row < rows ? yb + (size_t)rowid[row] * Dm + n0 + seg * 256 + 16 * c : nullptr; });
    };
    gemm8_tile<MI, 0, 2>(L, 256 / 128, hb, arow, w8, wrow, epi);
}
__device__ __forceinline__ void phase_moe2(const Params& p, LAS char* L) {
    const int v = vcu(), G = grid_g();
    const int* cnt = (const int*)(p.ws + WS_CTL);
    moe_prefix(p, L);
    LAS int* pre = (LAS int*)(L + OFF_PRE);
    const int total = __builtin_amdgcn_readfirstlane(pre[256]) * 2;
    for (int u = v; u < total; u += G) {
        const int g = u >> 1, n0 = (u & 1) * 512;
        const int e = __builtin_amdgcn_readfirstlane(moe_find(pre, g)), mt = g - __builtin_amdgcn_readfirstlane(pre[e]);
        const int rows = __builtin_amdgcn_readfirstlane(moe_cnt(cnt, e)) - mt * 256;
        if (rows > 128) moe2_unit<4>(p, L, e, mt * 256, rows < 256 ? rows : 256, n0);
        else moe2_unit<2>(p, L, e, mt * 256, rows, n0);
    }
    unsigned* qctr = (unsigned*)(p.ws + WS_CTL + 2048) + 192;
    LAS unsigned* qslot = (LAS unsigned*)(L + OFF_MISC + 16);
    const int tid = otid();
    for (;;) {
        if (tid == 0) *qslot = __hip_atomic_fetch_add(qctr, 1u, __ATOMIC_RELAXED, __HIP_MEMORY_SCOPE_AGENT);
        __syncthreads();
        const int q = __builtin_amdgcn_readfirstlane((int)*qslot);
        __syncthreads();
        if (q >= (T / 128) * 2) break;
        moe2_unit<2>(p, L, 256, (q >> 1) * 128, 128, (q & 1) * 512);
    }
}

__device__ __forceinline__ void phase_final(const Params& p) {
    const int v = vcu(), G = grid_g();
    const int tid = otid(), lane = tid & 63, wave = tid >> 6;
    const float* pg = p.in[19];
    const float* mod = (const float*)(p.ws + WS_MOD);
    const unsigned char* yb = (const unsigned char*)(p.ws + WS_YB);
    const bf16_t* x1b = (const bf16_t*)(p.ws + WS_H1);
    for (int t = v * NW + wave; t < T; t += G * NW) {
        const int b = t / SEQ;
        const float* gf = mod + b * 6144 + 5120;
        float y[16];
#pragma unroll
        for (int e = 0; e < 16; ++e) y[e] = 0.f;
#pragma unroll
        for (int k = 0; k < 9; ++k) {
            const size_t row = (k < 8) ? ((size_t)t * TOPK + k) : ((size_t)AR + t);
            const u32x4 raw = *(const u32x4*)(yb + row * Dm + 16 * lane);
#pragma unroll
            for (int e = 0; e < 4; ++e) {
                const f32x2 a = __builtin_amdgcn_cvt_pk_f32_fp8((int)raw[e], false), c = __builtin_amdgcn_cvt_pk_f32_fp8((int)raw[e], true);
                y[4 * e] += a.x; y[4 * e + 1] += a.y; y[4 * e + 2] += c.x; y[4 * e + 3] += c.y;
            }
        }
        float ss = 0.f;
#pragma unroll
        for (int e = 0; e < 16; ++e) { y[e] *= (1.f / YSCALE); ss += y[e] * y[e]; }
        ss = wave_sum(ss, lane);
        const float rstd = rsqrtf(ss * (1.f / Dm) + 1e-6f);
        const int col = 16 * lane;
#pragma unroll
        for (int hq = 0; hq < 4; ++hq) {
            const u32x2 xr = *(const u32x2*)(x1b + (size_t)t * Dm + col + 4 * hq);
            f32x4 xo = {bflo(xr.x), bfhi(xr.x), bflo(xr.y), bfhi(xr.y)};
            const f32x4 gv = *(const f32x4*)(pg + col + 4 * hq), gg = *(const f32x4*)(gf + col + 4 * hq);
#pragma unroll
            for (int e = 0; e < 4; ++e) xo[e] += gg[e] * (y[4 * hq + e] * rstd * gv[e]);
            *(f32x4*)(p.out + (size_t)t * Dm + col + 4 * hq) = xo;
        }
    }
}

#define XB_TMO      128
#define XB_XCNT(j)  (256  + 64 * (j))
#define XB_XSUB(j)  (1280 + 64 * (j))
#define XB_XGEN(j)  (2304 + 64 * (j))
#define XB_TOP      3328
#define XB_TOPGEN   3392
#define XCD_BAR_WORDS 3456
#define XB_SPIN_CAP (1u << 18)
__device__ __forceinline__ unsigned xb_ld(unsigned* p)              { return __hip_atomic_load(p, __ATOMIC_RELAXED, __HIP_MEMORY_SCOPE_AGENT); }
__device__ __forceinline__ unsigned xb_add(unsigned* p, unsigned v) { return __hip_atomic_fetch_add(p, v, __ATOMIC_RELAXED, __HIP_MEMORY_SCOPE_AGENT); }
__device__ __forceinline__ unsigned xb_xcc_id() { return (unsigned)__builtin_amdgcn_s_getreg((3 << 11) | 20) & 0xFu; }
#define XB_SPIN(cond, bar) do { unsigned _sp = 0; while (cond) { __builtin_amdgcn_s_sleep(1); \
    if ((++_sp & 255u) == 0u) { if (xb_ld(&(bar)[XB_TMO])) break; if (_sp > XB_SPIN_CAP) { atomicAdd(&(bar)[XB_TMO], 1u); break; } } } } while (0)
struct XcdBarrier { unsigned* bar; unsigned x; volatile LAS unsigned* st; };
__device__ __forceinline__ XcdBarrier xcd_barrier_post(unsigned* bar, volatile LAS unsigned* st) {
    XcdBarrier b; b.bar = bar; b.x = xb_xcc_id(); b.st = st;
    if (threadIdx.x == 0) (void)xb_add(&bar[XB_XCNT(b.x)], 1u);
    return b;
}
__device__ __forceinline__ void xcd_barrier_complete(unsigned* bar, unsigned x, unsigned& nloc, unsigned& nx) {
    const unsigned G = gridDim.x * gridDim.y * gridDim.z;
    unsigned sum, cnt, mine, sp = 0u;
    for (;;) {
        sum = 0u; cnt = 0u; mine = 0u;
#pragma unroll
        for (unsigned j = 0; j < 16; ++j) { const unsigned c = xb_ld(&bar[XB_XCNT(j)]); sum += c; cnt += (c > 0u) ? 1u : 0u; mine = (j == x) ? c : mine; }
        if (sum == G) break;
        __builtin_amdgcn_s_sleep(1);
        if ((++sp & 255u) == 0u) { if (xb_ld(&bar[XB_TMO])) break; if (sp > XB_SPIN_CAP) { atomicAdd(&bar[XB_TMO], 1u); break; } }
    }
    nloc = mine > 0u ? mine : 1u; nx = cnt > 0u ? cnt : 1u;
}
__device__ __forceinline__ void xcd_barrier(const Params& p, LAS char* L) {
    XcdBarrier b; b.bar = (unsigned*)(p.ws + WS_CTL + 4096); b.x = xb_xcc_id(); b.st = (volatile LAS unsigned*)(L + OFF_MISC);
    asm volatile("s_waitcnt vmcnt(0)" ::: "memory");
    __syncthreads();
    if (threadIdx.x == 0) {
        unsigned* bar = b.bar;
        __builtin_amdgcn_s_waitcnt(0);
        unsigned nloc = b.st[0], nx = b.st[1];
        if (nloc == 0u) { xcd_barrier_complete(bar, b.x, nloc, nx); b.st[0] = nloc; b.st[1] = nx; }
        const unsigned old = xb_add(&bar[XB_XSUB(b.x)], 1u);
        const unsigned gen = old / nloc;
        if (old + 1u == (gen + 1u) * nloc) {
            __builtin_amdgcn_fence(__ATOMIC_RELEASE, "agent");
            asm volatile("s_waitcnt vmcnt(0)" ::: "memory");
            const unsigned og = xb_add(&bar[XB_TOP], 1u);
            const unsigned tg = og / nx;
            if (og + 1u == (tg + 1u) * nx) xb_add(&bar[XB_TOPGEN], 1u);
            else XB_SPIN(xb_ld(&bar[XB_TOPGEN]) == tg, bar);
            __builtin_amdgcn_fence(__ATOMIC_ACQUIRE, "agent");
            xb_add(&bar[XB_XGEN(b.x)], 1u);
            asm volatile("s_waitcnt vmcnt(0)" ::: "memory");
        } else {
            XB_SPIN(xb_ld(&bar[XB_XGEN(b.x)]) == gen, bar);
            __builtin_amdgcn_fence(__ATOMIC_ACQUIRE, "agent");
            asm volatile("s_waitcnt vmcnt(0)" ::: "memory");
        }
    }
    __syncthreads();
}

__global__ void __launch_bounds__(NT, 2) mega(Params p) {
    extern __shared__ __attribute__((aligned(16))) char smem[];
    LAS char* L = (LAS char*)smem;
    if (threadIdx.x < 8) ((LAS unsigned*)(L + OFF_MISC))[threadIdx.x] = 0u;
    __syncthreads();
    (void)xcd_barrier_post((unsigned*)(p.ws + WS_CTL + 4096), (volatile LAS unsigned*)(L + OFF_MISC));
    phase_mod(p, L);
    xcd_barrier(p, L);
    phase_h1(p);
    xcd_barrier(p, L);
    phase_proj(p, L);
    xcd_barrier(p, L);
    phase_qkv(p, L);
    xcd_barrier(p, L);
    phase_attn(p, L);
    xcd_barrier(p, L);
    phase_oproj(p, L);
    xcd_barrier(p, L);
    phase_router_route(p, L);
    xcd_barrier(p, L);
    phase_moe1(p, L);
    xcd_barrier(p, L);
    phase_moe2(p, L);
    xcd_barrier(p, L);
    phase_final(p);
}

extern "C" void kernel_launch(void* const* d_in, const int* in_sizes, int n_in, void* d_out, int out_size, void* d_ws, size_t ws_size, hipStream_t stream) {
    static int grid_blocks = 0;
    if (grid_blocks == 0) {
        if (n_in != 28 || out_size != T * Dm || ws_size < WS_END) {
            fprintf(stderr, "kernel_launch: unexpected problem (n_in %d, out %d, ws %zu); nothing launched\n", n_in, out_size, ws_size);
            grid_blocks = -1; return;
        }
        int dev = 0, cus = 0, per_cu = 0;
        (void)hipGetDevice(&dev);
        (void)hipDeviceGetAttribute(&cus, hipDeviceAttributeMultiprocessorCount, dev);
        if (hipFuncSetAttribute((const void*)mega, hipFuncAttributeMaxDynamicSharedMemorySize, LDS_BYTES) != hipSuccess) {
            fprintf(stderr, "kernel_launch: hipFuncSetAttribute(%d B LDS) failed\n", LDS_BYTES); grid_blocks = -1; return;
        }
        (void)hipOccupancyMaxActiveBlocksPerMultiprocessor(&per_cu, mega, NT, LDS_BYTES);
        if (per_cu < 1) { fprintf(stderr, "kernel_launch: occupancy query says %d blocks per CU\n", per_cu); per_cu = 1; }
        grid_blocks = cus;
        fprintf(stderr, "kernel_launch: %d CUs, occupancy query %d per CU, grid %d\n", cus, per_cu, grid_blocks);
    }
    if (grid_blocks < 0) return;
    (void)hipMemsetAsync((char*)d_ws + WS_CTL, 0, CTL_BYTES, stream);
    Params p{};
    for (int i = 0; i < 28; ++i) p.in[i] = (const float*)d_in[i];
    p.out = (float*)d_out; p.ws = (char*)d_ws;
    void* args[] = {&p};
    hipError_t e = hipLaunchCooperativeKernel((void*)mega, dim3(grid_blocks), dim3(NT), args, LDS_BYTES, stream);
    if (e != hipSuccess) fprintf(stderr, "cooperative launch failed: %s (grid %d)\n", hipGetErrorString(e), grid_blocks);
}
```

```cpp
#include <hip/hip_runtime.h>
#include <cstdio>
#include <cstdint>


typedef unsigned short bf16_t;
typedef float f32x2 __attribute__((ext_vector_type(2)));
typedef short bf16x8 __attribute__((ext_vector_type(8)));
typedef short s16x4 __attribute__((ext_vector_type(4)));
typedef short v4i16_t __attribute__((ext_vector_type(4)));
typedef float f32x16 __attribute__((ext_vector_type(16)));
typedef float f32x4 __attribute__((ext_vector_type(4)));
typedef unsigned u32x4 __attribute__((ext_vector_type(4)));
typedef unsigned u32x2 __attribute__((ext_vector_type(2)));
#define LAS __attribute__((address_space(3)))

constexpr int NT = 512, NW = 8;
constexpr int Dm = 1024, NB = 8, SEQ = 2048, T = NB * SEQ;
constexpr int NIN = 1952;
constexpr int C_CQ = 0, C_CKV = 256, C_KR = 384, C_DQ = 448, C_DK = 960, C_DV = 1472;
constexpr int PSTR = 2048, NPC = NIN + 32, C_PAD = 416;
constexpr int NE = 256, TOPK = 8, AR = T * TOPK, HROWS = AR + T;
constexpr int LISTCAP = T;
constexpr float LOG2E = 1.4426950408889634f;
constexpr float YSCALE = 32.f;
constexpr float LAMBDA_INIT = 0.2f;

constexpr size_t MiB = 1u << 20;
constexpr size_t WS_CTL = 0, CTL_BYTES = 65536;
constexpr size_t WS_MOD = 65536;
constexpr size_t WS_ROPE = 1 * MiB;
constexpr size_t WS_H1 = 4 * MiB;
constexpr size_t WS_PROJ = 36 * MiB;
constexpr size_t WS_CQN = 100 * MiB;
constexpr size_t WS_CKVN = 108 * MiB;
constexpr size_t WS_QM = 112 * MiB;
constexpr size_t WS_KF = 136 * MiB;
constexpr size_t WS_VM = 160 * MiB;
constexpr size_t WS_ATT = 176 * MiB;
constexpr size_t WS_OD0 = 208 * MiB;
constexpr size_t WS_Y1 = 240 * MiB;
constexpr size_t WS_H2 = 304 * MiB;
constexpr size_t WS_LOG = 336 * MiB;
constexpr size_t WS_LA = 352 * MiB;
constexpr size_t WS_LW = 368 * MiB;
constexpr size_t WS_HB = 384 * MiB;
constexpr size_t WS_YB = 456 * MiB;
constexpr size_t WS_WB = 744 * MiB;
constexpr size_t WB_IN = 0, WB_UQ = WB_IN + (size_t)1024 * 1952, WB_UKV = WB_UQ + 256 * 768, WB_O = WB_UKV + 128 * 1024, WB_R = WB_O + 1024 * 1024, WB_SG = WB_R + 1024 * 256, WB_SU = WB_SG + 1024 * 256, WB_SD = WB_SU + 1024 * 256, WB_END = WB_SD + 256 * 1024;
constexpr size_t WS_W8GU = 760 * MiB;
constexpr size_t WS_W8D = 892 * MiB;
constexpr size_t WS_H8 = 960 * MiB;
constexpr size_t WS_END = 976 * MiB;
constexpr float H8SCALE = 16.f, WGUSCALE = 256.f, WDSCALE = 128.f, HBSCALE = 32.f;
constexpr float ATTSCALE = 64.f;
constexpr float H1SCALE = 16.f, WINSCALE = 1024.f;

constexpr int G_XB = 32768, G_WB = 36864, G_BUF = G_XB + G_WB, G_LDS = 2 * G_BUF;
constexpr int OFF_MISC = G_LDS, OFF_PRE = OFF_MISC + 64, OFF_TL = OFF_PRE + 1088;
constexpr int OFF_ROW = OFF_TL + 1088, OFF_RW = OFF_ROW + 1024;
constexpr int OFF_SS = OFF_RW + 1024;
constexpr int LDS_BYTES = G_LDS + 4352 + 4096;

struct Params {
    const float* in[28];
    float* out;
    char* ws;
};

__device__ __forceinline__ unsigned short f2bf(float f) { __bf16 b = (__bf16)f; return __builtin_bit_cast(unsigned short, b); }
typedef __bf16 bf16x2_t __attribute__((ext_vector_type(2)));
__device__ __forceinline__ unsigned pk2(float lo, float hi) { const f32x2 v = {lo, hi}; return __builtin_bit_cast(unsigned, __builtin_convertvector(v, bf16x2_t)); }
__device__ __forceinline__ float bf2f(unsigned short b) { return __uint_as_float(((unsigned)b) << 16); }
__device__ __forceinline__ float bflo(unsigned u) { return __uint_as_float(u << 16); }
__device__ __forceinline__ float bfhi(unsigned u) { return __uint_as_float(u & 0xffff0000u); }
__device__ __forceinline__ int crow(int r, int hi) { return (r & 3) + 8 * (r >> 2) + 4 * hi; }
__device__ __forceinline__ float shx(float v, int m, int lane) { return __int_as_float(__builtin_amdgcn_ds_bpermute((lane ^ m) << 2, __float_as_int(v))); }
__device__ __forceinline__ int shxi(int v, int m, int lane) { return __builtin_amdgcn_ds_bpermute((lane ^ m) << 2, v); }
__device__ __forceinline__ float shl(float v, int src) { return __int_as_float(__builtin_amdgcn_ds_bpermute(src << 2, __float_as_int(v))); }
__device__ __forceinline__ float wave_sum(float v, int lane) {
#pragma unroll
    for (int o = 32; o >= 1; o >>= 1) v += shx(v, o, lane);
    return v;
}
template <int CTRL, int RM> __device__ __forceinline__ unsigned dppu(unsigned old, unsigned src) { return (unsigned)__builtin_amdgcn_update_dpp((int)old, (int)src, CTRL, RM, 0xf, false); }
template <int CTRL, int RM> __device__ __forceinline__ float dppf(float old, float src) { return __int_as_float(__builtin_amdgcn_update_dpp(__float_as_int(old), __float_as_int(src), CTRL, RM, 0xf, false)); }
__device__ __forceinline__ unsigned wave_umax(unsigned v) {
    v = max(v, dppu<0x111, 0xf>(v, v)); v = max(v, dppu<0x112, 0xf>(v, v)); v = max(v, dppu<0x114, 0xf>(v, v)); v = max(v, dppu<0x118, 0xf>(v, v));
    v = max(v, dppu<0x142, 0xa>(v, v)); v = max(v, dppu<0x143, 0xc>(v, v));
    return (unsigned)__builtin_amdgcn_readlane((int)v, 63);
}
__device__ __forceinline__ float wave_fmax_dpp(float v) {
    v = fmaxf(v, dppf<0x111, 0xf>(v, v)); v = fmaxf(v, dppf<0x112, 0xf>(v, v)); v = fmaxf(v, dppf<0x114, 0xf>(v, v)); v = fmaxf(v, dppf<0x118, 0xf>(v, v));
    v = fmaxf(v, dppf<0x142, 0xa>(v, v)); v = fmaxf(v, dppf<0x143, 0xc>(v, v));
    return __int_as_float(__builtin_amdgcn_readlane(__float_as_int(v), 63));
}
__device__ __forceinline__ float wave_fsum_dpp(float v) {
    v += dppf<0x111, 0xf>(0.f, v); v += dppf<0x112, 0xf>(0.f, v); v += dppf<0x114, 0xf>(0.f, v); v += dppf<0x118, 0xf>(0.f, v);
    v += dppf<0x142, 0xa>(0.f, v); v += dppf<0x143, 0xc>(0.f, v);
    return __int_as_float(__builtin_amdgcn_readlane(__float_as_int(v), 63));
}
__device__ __forceinline__ float silu_f(float v) { return v * __builtin_amdgcn_rcpf(1.f + __expf(-v)); }
__device__ __forceinline__ s16x4 tr_read(LAS char* p) {
    return __builtin_bit_cast(s16x4, __builtin_amdgcn_ds_read_tr16_b64_v4i16((LAS v4i16_t*)p));
}
__device__ __forceinline__ int otid() { int t = threadIdx.x; asm volatile("" : "+v"(t)); return t; }
__device__ __forceinline__ int grid_g() { return gridDim.x; }
__device__ __forceinline__ int vcu() { const int G = gridDim.x, bx = blockIdx.x; return (G % 8 == 0) ? (bx % 8) * (G / 8) + bx / 8 : bx; }
__device__ __forceinline__ void gld16(u32x4& d, const void* p) { asm volatile("global_load_dwordx4 %0, %1, off" : "+v"(d) : "v"(p) : "memory"); }
__device__ __forceinline__ void gld16(f32x4& d, const void* p) { asm volatile("global_load_dwordx4 %0, %1, off" : "+v"(d) : "v"(p) : "memory"); }
__device__ __forceinline__ void gst16_wt(void* p, u32x4 d) { asm volatile("global_store_dwordx4 %0, %1, off sc1\n\ts_nop 1" :: "v"(p), "v"(d) : "memory"); }
__device__ __forceinline__ void gst8_wt(void* p, u32x2 d) { asm volatile("global_store_dwordx2 %0, %1, off sc1\n\ts_nop 1" :: "v"(p), "v"(d) : "memory"); }
__device__ __forceinline__ void gst4_wt(void* p, int d) { asm volatile("global_store_dword %0, %1, off sc1\n\ts_nop 1" :: "v"(p), "v"(d) : "memory"); }
template <int N> __device__ __forceinline__ void vm_wait(u32x4& a, f32x4& b, f32x4& c) { asm volatile("s_waitcnt vmcnt(%3)" : "+v"(a), "+v"(b), "+v"(c) : "n"(N) : "memory"); }
template <int N> __device__ __forceinline__ void vm_wait(f32x4& b, f32x4& c) { asm volatile("s_waitcnt vmcnt(%2)" : "+v"(b), "+v"(c) : "n"(N) : "memory"); }
template <int N> __device__ __forceinline__ void vm_wait(u32x4& a, u32x4& b) { asm volatile("s_waitcnt vmcnt(%2)" : "+v"(a), "+v"(b) : "n"(N) : "memory"); }
template <int N> __device__ __forceinline__ void vm_wait(u32x4& b) { asm volatile("s_waitcnt vmcnt(%1)" : "+v"(b) : "n"(N) : "memory"); }
#define MFMA32(a, b, c) __builtin_amdgcn_mfma_f32_32x32x16_bf16(a, b, c, 0, 0, 0)
#define VMAX3(a, b, c) ({ float d_; asm("v_max3_f32 %0, %1, %2, %3" : "=v"(d_) : "v"(a), "v"(b), "v"(c)); d_; })

template <int NBMODE> __device__ __forceinline__ int nb_of(int wn, int ni) { return NBMODE == 0 ? 64 * wn + 32 * ni : 32 * wn + 128 * ni; }

template <int MI, int NBMODE, bool WBF = false, int NSEG = 1, class AF, class BF, class EF>
__device__ __forceinline__ void gemm_tile(LAS char* L, int nk, long ldw, const bf16_t* abase, AF arow, BF bcol, EF epi) {
    asm volatile("" : "+s"(nk));
    const int tid = otid(), lane = tid & 63, wave = tid >> 6;
    const int wm = wave & 1, wn = wave >> 1, l31 = lane & 31, hi = lane >> 5;
    const int a_chunk = tid & 7, a_row = tid >> 3;
    const int a_w = a_row * 128 + 16 * (a_chunk ^ ((a_row >> 1) & 7));
    const int b_n4 = WBF ? (tid & 31) : (tid & 63), b_kr = WBF ? (tid >> 5) : (tid >> 6);
    const auto bp = bcol((WBF ? 8 : 4) * b_n4) + (long)b_kr * ldw;
    const int b_w = G_XB + b_kr * 576 + (WBF ? 16 : 8) * b_n4;
    const int sw = (l31 >> 1) & 7;
    const int xoff = (32 * MI * wm + l31) * 128;
    const int woff = G_XB + (8 * hi + ((lane & 15) >> 2)) * 576 + 2 * (16 * ((lane >> 4) & 1) + 4 * (lane & 3));
    u32x4 ra[MI]; f32x4 rb[8]; u32x4 rw[4];
#pragma unroll
    for (int i = 0; i < MI; ++i) ra[i] = (u32x4){0u, 0u, 0u, 0u};
#pragma unroll
    for (int i = 0; i < 8; ++i) rb[i] = (f32x4){0.f, 0.f, 0.f, 0.f};
#pragma unroll
    for (int i = 0; i < 4; ++i) rw[i] = (u32x4){0u, 0u, 0u, 0u};
#define G_LOADW(KOFF, Q, SEGC) do { \
        if (WBF) { gld16(rw[Q], bp + (long)((KOFF) + 16 * (Q)) * ldw + (SEGC)); } \
        else { gld16(rb[2 * (Q)], bp + (long)((KOFF) + 16 * (Q)) * ldw + (SEGC)); gld16(rb[2 * (Q) + 1], bp + (long)((KOFF) + 16 * (Q) + 8) * ldw + (SEGC)); } } while (0)
#define G_LOADQ(KT, Q) do { \
        if ((Q) < MI) gld16(ra[(Q) < MI ? (Q) : 0], abase + arow(a_row + 64 * (Q)) + a_chunk * 8 + (KT) * 64); \
        G_LOADW((KT) * 64, Q, 0); } while (0)
#define G_LOADQ_SEL(KT, SEG, Q, OK) do { \
        const int kq_ = (OK) ? (KT) * 64 : 0; const int sc_ = (OK) ? (SEG) * 256 : 0; \
        if ((Q) < MI) gld16(ra[(Q) < MI ? (Q) : 0], abase + arow(a_row + 64 * (Q)) + a_chunk * 8 + kq_); \
        G_LOADW(kq_, Q, sc_); } while (0)
#define G_WAITQ(Q, N) do { \
        if (WBF) { if ((Q) < MI) vm_wait<N>(ra[(Q) < MI ? (Q) : 0], rw[Q]); else vm_wait<N>(rw[Q]); } \
        else { if ((Q) < MI) vm_wait<N>(ra[(Q) < MI ? (Q) : 0], rb[2 * (Q)], rb[2 * (Q) + 1]); else vm_wait<N>(rb[2 * (Q)], rb[2 * (Q) + 1]); } } while (0)
#define G_STOREQ(LP, Q) do { \
        if ((Q) < MI) *(LAS u32x4*)((LP) + a_w + (Q) * 8192) = ra[(Q) < MI ? (Q) : 0]; \
        if (WBF) { *(LAS u32x4*)((LP) + b_w + (Q) * 16 * 576) = rw[Q]; } else { \
        { u32x2 w; w.x = pk2(rb[2 * (Q)][0], rb[2 * (Q)][1]); w.y = pk2(rb[2 * (Q)][2], rb[2 * (Q)][3]); *(LAS u32x2*)((LP) + b_w + (Q) * 16 * 576) = w; } \
        { u32x2 w; w.x = pk2(rb[2 * (Q) + 1][0], rb[2 * (Q) + 1][1]); w.y = pk2(rb[2 * (Q) + 1][2], rb[2 * (Q) + 1][3]); *(LAS u32x2*)((LP) + b_w + (Q) * 16 * 576 + 8 * 576) = w; } } } while (0)
    constexpr int NLW = WBF ? 1 : 2;
    constexpr int NL0 = NLW + ((0 < MI) ? 1 : 0), NL1 = NLW + ((1 < MI) ? 1 : 0), NL2 = NLW + ((2 < MI) ? 1 : 0), NL3 = NLW + ((3 < MI) ? 1 : 0), NLT = NL0 + NL1 + NL2 + NL3;
    G_LOADQ(0, 0); G_LOADQ(0, 1); G_LOADQ(0, 2); G_LOADQ(0, 3);
    G_WAITQ(0, 0); G_WAITQ(1, 0); G_WAITQ(2, 0); G_WAITQ(3, 0);
    G_STOREQ(L, 0); G_STOREQ(L, 1); G_STOREQ(L, 2); G_STOREQ(L, 3);
    G_LOADQ(1, 0); G_LOADQ(1, 1); G_LOADQ(1, 2); G_LOADQ(1, 3);
    f32x16 acc[MI][2];
#pragma unroll
    for (int i = 0; i < MI; ++i)
#pragma unroll
        for (int j = 0; j < 2; ++j)
#pragma unroll
            for (int r = 0; r < 16; ++r) acc[i][j][r] = 0.f;
    __syncthreads();
    const int nt_all = nk * NSEG;
    int lk = (nk == 2) ? 0 : 2, lseg = (nk == 2) ? 1 : 0;
    int ck = 0, cseg = 0;
#pragma nounroll
    for (int kt = 0; kt < nt_all; ++kt) {
        LAS char* Lb = L + (kt & 1) * G_BUF;
        LAS char* Ln = L + ((kt + 1) & 1) * G_BUF;
        const bool ld = kt + 2 < nt_all;
        bf16x8 xf[2][MI], wf[2][2];
#define LOAD_FRAGS(KS, B) do { \
            _Pragma("unroll") for (int mi = 0; mi < MI; ++mi) xf[B][mi] = *(LAS bf16x8*)(Lb + xoff + mi * 4096 + 16 * ((2 * (KS) + hi) ^ sw)); \
            _Pragma("unroll") for (int ni = 0; ni < 2; ++ni) { \
                LAS char* pp = Lb + woff + (KS) * 16 * 576 + 2 * nb_of<NBMODE>(wn, ni); \
                const s16x4 lo = tr_read(pp), h4 = tr_read(pp + 4 * 576); \
                wf[B][ni] = (bf16x8){lo[0], lo[1], lo[2], lo[3], h4[0], h4[1], h4[2], h4[3]}; } } while (0)
#define MMA_STEP(KS) do { \
            _Pragma("unroll") for (int mi = 0; mi < MI; ++mi) \
                _Pragma("unroll") for (int ni = 0; ni < 2; ++ni) acc[mi][ni] = MFMA32(wf[(KS) & 1][ni], xf[(KS) & 1][mi], acc[mi][ni]); } while (0)
#define STAGE_STEP(Q, NREST, NPREV) do { G_WAITQ(Q, (NREST) + (NPREV)); G_STOREQ(Ln, Q); G_LOADQ_SEL(lk, lseg, Q, ld); } while (0)
        LOAD_FRAGS(0, 0);
        LOAD_FRAGS(1, 1); MMA_STEP(0); STAGE_STEP(0, NL1 + NL2 + NL3, 0);           __builtin_amdgcn_sched_barrier(0);
        LOAD_FRAGS(2, 0); MMA_STEP(1); STAGE_STEP(1, NL2 + NL3, NL0);               __builtin_amdgcn_sched_barrier(0);
        LOAD_FRAGS(3, 1); MMA_STEP(2); STAGE_STEP(2, NL3, NL0 + NL1);               __builtin_amdgcn_sched_barrier(0);
        MMA_STEP(3);                   STAGE_STEP(3, 0, NL0 + NL1 + NL2);           __builtin_amdgcn_sched_barrier(0);
#undef LOAD_FRAGS
#undef MMA_STEP
#undef STAGE_STEP
        __syncthreads();
        if (++lk == nk) { lk = 0; ++lseg; }
        if (NSEG > 1) {
            if (++ck == nk) {
                ck = 0;
                if (cseg + 1 < NSEG) {
                    epi(acc, cseg, L + (kt & 1) * G_BUF);
#pragma unroll
                    for (int i = 0; i < MI; ++i)
#pragma unroll
                        for (int j = 0; j < 2; ++j)
#pragma unroll
                            for (int r = 0; r < 16; ++r) acc[i][j][r] = 0.f;
                }
                ++cseg;
            }
        }
    }
    G_WAITQ(0, 0); G_WAITQ(1, 0); G_WAITQ(2, 0); G_WAITQ(3, 0);
#undef G_LOADQ
#undef G_LOADQ_SEL
#undef G_LOADW
#undef G_WAITQ
#undef G_STOREQ
    (void)NLT;
    epi(acc, NSEG - 1, L);
}

template <int MI, int NC, class DF>
__device__ __forceinline__ void store_tile_bf16(LAS char* L, const f32x16 (&acc)[MI][2], DF dst) {
    constexpr int STR = NC * 2 + 16, CPR = NC / 8, BM = 64 * MI;
    const int tid = otid(), lane = tid & 63, wave = tid >> 6, wm = wave & 1, wn = wave >> 1, l31 = lane & 31, hi = lane >> 5;
#pragma unroll
    for (int mi = 0; mi < MI; ++mi)
#pragma unroll
        for (int ni = 0; ni < (NC == 256 ? 2 : 1); ++ni) {
            const int row = 32 * MI * wm + 32 * mi + l31, col = (NC == 256) ? nb_of<0>(wn, ni) : 32 * wn;
#pragma unroll
            for (int gq = 0; gq < 4; ++gq) {
                u32x2 w; w.x = pk2(acc[mi][ni][4 * gq], acc[mi][ni][4 * gq + 1]); w.y = pk2(acc[mi][ni][4 * gq + 2], acc[mi][ni][4 * gq + 3]);
                *(LAS u32x2*)(L + row * STR + 2 * (col + 8 * gq + 4 * hi)) = w;
            }
        }
    __syncthreads();
#pragma unroll
    for (int i = 0; i < (BM * CPR) / NT; ++i) {
        const int id = tid + NT * i, row = id / CPR, c = id % CPR;
        bf16_t* d = dst(row, c);
        if (d) { const u32x4 t_ = *(LAS u32x4*)(L + row * STR + 16 * c); gst16_wt(d, t_); }
    }
    __syncthreads();
}

template <int MI, int NC = 256, class DF>
__device__ __forceinline__ void store_tile_fp8(LAS char* L, const f32x16 (&acc)[MI][2], DF dst) {
    constexpr int STR = NC + 16, CPR = NC / 16, BM = 64 * MI;
    const int tid = otid(), lane = tid & 63, wave = tid >> 6, wm = wave & 1, wn = wave >> 1, l31 = lane & 31, hi = lane >> 5;
    int wp[2] = {0, 0};
#pragma unroll
    for (int mi = 0; mi < MI; ++mi)
#pragma unroll
        for (int ni = 0; ni < (NC == 256 ? 2 : 1); ++ni) {
            const int row = 32 * MI * wm + 32 * mi + l31, col = (NC == 256) ? nb_of<0>(wn, ni) : 32 * wn;
#pragma unroll
            for (int gq = 0; gq < 4; ++gq) {
                int w = wp[gq & 1];
                w = __builtin_amdgcn_cvt_pk_fp8_f32(acc[mi][ni][4 * gq], acc[mi][ni][4 * gq + 1], w, false);
                w = __builtin_amdgcn_cvt_pk_fp8_f32(acc[mi][ni][4 * gq + 2], acc[mi][ni][4 * gq + 3], w, true);
                *(LAS int*)(L + row * STR + (col + 8 * gq + 4 * hi)) = w;
                wp[gq & 1] = w;
            }
        }
    __syncthreads();
#pragma unroll
    for (int i = 0; i < (BM * CPR) / NT; ++i) {
        const int id = tid + NT * i, row = id / CPR, c = id % CPR;
        unsigned char* d = dst(row, c);
        if (d) { const u32x4 t_ = *(LAS u32x4*)(L + row * STR + 16 * c); gst16_wt(d, t_); }
    }
    __syncthreads();
}

typedef int i32x8 __attribute__((ext_vector_type(8)));
constexpr int G8_XB = 32768;
#define MFMA8(a, b, c) __builtin_amdgcn_mfma_scale_f32_32x32x64_f8f6f4(a, b, c, 0, 0, 0, sca, 0, 0x7f7f7f7f)
template <int MI, int NBMODE, int NSEG = 1, class AF, class WF, class EF>
__device__ __forceinline__ void gemm8_tile(LAS char* L, int nk, const unsigned char* abase, AF arow, const unsigned char* wbase, WF wrow, EF epi, const int sca = 0x7f7f7f7f) {
    static_assert(MI == 2 || MI == 4, "MI");
    asm volatile("" : "+s"(nk));
    const int tid = otid(), lane = tid & 63, wave = tid >> 6;
    const int wm = wave & 1, wn = wave >> 1, l31 = lane & 31, hi = lane >> 5;
    const int a_chunk = tid & 7, a_row = tid >> 3;
    const int a_w = a_row * 128 + 16 * (a_chunk ^ ((a_row >> 1) & 7));
    const int sw = (l31 >> 1) & 7;
    const int xoff = (32 * MI * wm + l31) * 128;
    const int woff = G8_XB + l31 * 128;
    const int c00 = 16 * ((2 * hi) ^ sw), c01 = 16 * ((2 * hi + 1) ^ sw), c10 = 16 * ((4 + 2 * hi) ^ sw), c11 = 16 * ((5 + 2 * hi) ^ sw);
    u32x4 ra[MI], rw[4];
#pragma unroll
    for (int i = 0; i < MI; ++i) ra[i] = (u32x4){0u, 0u, 0u, 0u};
#pragma unroll
    for (int i = 0; i < 4; ++i) rw[i] = (u32x4){0u, 0u, 0u, 0u};
    unsigned xo[MI];
#pragma unroll
    for (int q = 0; q < MI; ++q) xo[q] = arow(a_row + 64 * q) + a_chunk * 16;
#define H_LOADQ_SEL(KT, SEG, Q, OK) do { \
        const int kq_ = (OK) ? (KT) * 128 : 0; const int sg_ = (OK) ? (SEG) : 0; \
        if ((Q) < MI) gld16(ra[(Q) < MI ? (Q) : 0], abase + xo[(Q) < MI ? (Q) : 0] + kq_); \
        gld16(rw[Q], wbase + wrow(sg_, a_row + 64 * (Q)) + a_chunk * 16 + kq_); } while (0)
#define H_WAITQ(Q, N) do { if ((Q) < MI) vm_wait<N>(ra[(Q) < MI ? (Q) : 0], rw[Q]); else vm_wait<N>(rw[Q]); } while (0)
#define H_STOREQ(LP, Q) do { \
        if ((Q) < MI) *(LAS u32x4*)((LP) + a_w + (Q) * 8192) = ra[(Q) < MI ? (Q) : 0]; \
        *(LAS u32x4*)((LP) + G8_XB + a_w + (Q) * 8192) = rw[Q]; } while (0)
    constexpr int NL0 = 2, NL1 = 2, NL2 = 1 + ((2 < MI) ? 1 : 0), NL3 = 1 + ((3 < MI) ? 1 : 0);
    H_LOADQ_SEL(0, 0, 0, true); H_LOADQ_SEL(0, 0, 1, true); H_LOADQ_SEL(0, 0, 2, true); H_LOADQ_SEL(0, 0, 3, true);
    H_WAITQ(0, 0); H_WAITQ(1, 0); H_WAITQ(2, 0); H_WAITQ(3, 0);
    H_STOREQ(L, 0); H_STOREQ(L, 1); H_STOREQ(L, 2); H_STOREQ(L, 3);
    H_LOADQ_SEL(1, 0, 0, true); H_LOADQ_SEL(1, 0, 1, true); H_LOADQ_SEL(1, 0, 2, true); H_LOADQ_SEL(1, 0, 3, true);
    f32x16 acc[MI][2];
#pragma unroll
    for (int i = 0; i < MI; ++i)
#pragma unroll
        for (int j = 0; j < 2; ++j)
#pragma unroll
            for (int r = 0; r < 16; ++r) acc[i][j][r] = 0.f;
    __syncthreads();
    const int nt_all = nk * NSEG;
    int lk = (nk == 2) ? 0 : 2, lseg = (nk == 2) ? 1 : 0;
    int ck = 0, cseg = 0;
#pragma nounroll
    for (int kt = 0; kt < nt_all; ++kt) {
        LAS char* Lb = L + (kt & 1) * G_BUF;
        LAS char* Ln = L + ((kt + 1) & 1) * G_BUF;
        const bool ld = kt + 2 < nt_all;
        i32x8 xfA[2], xfB[2], wfA[2], wfB[2];
#define H_FRAG(DST, P, CA, CB) do { const u32x4 lo_ = *(LAS u32x4*)((P) + (CA)), hh_ = *(LAS u32x4*)((P) + (CB)); \
            DST = (i32x8){(int)lo_[0], (int)lo_[1], (int)lo_[2], (int)lo_[3], (int)hh_[0], (int)hh_[1], (int)hh_[2], (int)hh_[3]}; } while (0)
#define H_LDW(DST, S) do { H_FRAG(DST[0], Lb + woff + 128 * nb_of<NBMODE>(wn, 0), (S) ? c10 : c00, (S) ? c11 : c01); H_FRAG(DST[1], Lb + woff + 128 * nb_of<NBMODE>(wn, 1), (S) ? c10 : c00, (S) ? c11 : c01); } while (0)
#define H_LDX(DST, S, M0) do { H_FRAG(DST[0], Lb + xoff + (M0) * 4096, (S) ? c10 : c00, (S) ? c11 : c01); H_FRAG(DST[1], Lb + xoff + ((M0) + 1) * 4096, (S) ? c10 : c00, (S) ? c11 : c01); } while (0)
#define H_MMA(WFR, XFR, M0) do { \
            acc[(M0)][0] = MFMA8(WFR[0], XFR[0], acc[(M0)][0]); acc[(M0)][1] = MFMA8(WFR[1], XFR[0], acc[(M0)][1]); \
            acc[(M0) + 1][0] = MFMA8(WFR[0], XFR[1], acc[(M0) + 1][0]); acc[(M0) + 1][1] = MFMA8(WFR[1], XFR[1], acc[(M0) + 1][1]); } while (0)
#define H_STAGE(Q, NREST, NPREV) do { H_WAITQ(Q, (NREST) + (NPREV)); H_STOREQ(Ln, Q); H_LOADQ_SEL(lk, lseg, Q, ld); } while (0)
        H_LDW(wfA, 0); H_LDX(xfA, 0, 0);
        if (MI == 4) {
            H_LDX(xfB, 0, 2);                 H_MMA(wfA, xfA, 0);      H_STAGE(0, NL1 + NL2 + NL3, 0);   __builtin_amdgcn_sched_barrier(0);
            H_LDW(wfB, 1); H_LDX(xfA, 1, 0);  H_MMA(wfA, xfB, MI - 2); H_STAGE(1, NL2 + NL3, NL0);       __builtin_amdgcn_sched_barrier(0);
            H_LDX(xfB, 1, 2);                 H_MMA(wfB, xfA, 0);      H_STAGE(2, NL3, NL0 + NL1);       __builtin_amdgcn_sched_barrier(0);
                                              H_MMA(wfB, xfB, MI - 2); H_STAGE(3, 0, NL0 + NL1 + NL2);   __builtin_amdgcn_sched_barrier(0);
        } else {
            H_LDW(wfB, 1); H_LDX(xfB, 1, 0);  H_MMA(wfA, xfA, 0);      H_STAGE(0, NL1 + NL2 + NL3, 0); H_STAGE(1, NL2 + NL3, NL0);               __builtin_amdgcn_sched_barrier(0);
                                              H_MMA(wfB, xfB, 0);      H_STAGE(2, NL3, NL0 + NL1);     H_STAGE(3, 0, NL0 + NL1 + NL2);           __builtin_amdgcn_sched_barrier(0);
        }
#undef H_FRAG
#undef H_LDW
#undef H_LDX
#undef H_MMA
#undef H_STAGE
        __syncthreads();
        if (++lk == nk) { lk = 0; ++lseg; }
        if (NSEG > 1) {
            if (++ck == nk) {
                ck = 0;
                if (cseg + 1 < NSEG) {
                    epi(acc, cseg, L + (kt & 1) * G_BUF);
#pragma unroll
                    for (int i = 0; i < MI; ++i)
#pragma unroll
                        for (int j = 0; j < 2; ++j)
#pragma unroll
                            for (int r = 0; r < 16; ++r) acc[i][j][r] = 0.f;
                }
                ++cseg;
            }
        }
    }
    H_WAITQ(0, 0); H_WAITQ(1, 0); H_WAITQ(2, 0); H_WAITQ(3, 0);
#undef H_LOADQ_SEL
#undef H_WAITQ
#undef H_STOREQ
    epi(acc, NSEG - 1, L);
}

__device__ __forceinline__ void phase_mod(const Params& p, LAS char* L) {
    const int v = vcu(), G = grid_g();
    const int tid = otid();
    const float* c = p.in[1]; const float* w_ada = p.in[3]; const float* b_ada = p.in[4];
    float* mod = (float*)(p.ws + WS_MOD);
    LAS float* sc = (LAS float*)L;
    LAS float* red = (LAS float*)(L + 32768);
    bool filled = false;
    for (int item = v; item < 192; item += G) {
        if (!filled) {
            for (int i = tid; i < 8 * 1024; i += NT) sc[i] = silu_f(c[i]);
            __syncthreads(); filled = true;
        }
        const int cx = tid & 31, kl = tid >> 5, col = item * 32 + cx;
        float a[8];
#pragma unroll
        for (int b = 0; b < 8; ++b) a[b] = 0.f;
#pragma unroll 8
        for (int k = kl; k < 1024; k += 16) {
            const float w = w_ada[(size_t)k * 6144 + col];
#pragma unroll
            for (int b = 0; b < 8; ++b) a[b] += sc[b * 1024 + k] * w;
        }
#pragma unroll
        for (int b = 0; b < 8; ++b) red[(b * 16 + kl) * 32 + cx] = a[b];
        __syncthreads();
        if (tid < 256) {
            const int b = tid >> 5, cc = tid & 31; float s_ = 0.f;
#pragma unroll
            for (int k = 0; k < 16; ++k) s_ += red[(b * 16 + k) * 32 + cc];
            mod[b * 6144 + item * 32 + cc] = s_ + b_ada[item * 32 + cc];
        }
        __syncthreads();
    }
    {
        bf16_t* wb = (bf16_t*)(p.ws + WS_WB);
        const size_t gt = (size_t)v * NT + tid, gs = (size_t)G * NT;
        auto conv = [&](const float* src, size_t off, size_t n) {
            for (size_t i = gt; i < n / 4; i += gs) { const f32x4 f = *(const f32x4*)(src + 4 * i); u32x2 w; w.x = pk2(f[0], f[1]); w.y = pk2(f[2], f[3]); *(u32x2*)(wb + off + 4 * i) = w; }
        };
        auto convg = [&](const float* src, size_t off, size_t n, int ncol, const float* gain) {
            for (size_t i = gt; i < n / 4; i += gs) { const float gk = gain[(4 * i) / ncol]; const f32x4 f = *(const f32x4*)(src + 4 * i); u32x2 w; w.x = pk2(f[0] * gk, f[1] * gk); w.y = pk2(f[2] * gk, f[3] * gk); *(u32x2*)(wb + off + 4 * i) = w; }
        };
        auto conv8t = [&](const float* src, unsigned char* w8in, const int NC, const int padc) {
            for (size_t i = gt; i < (size_t)NC * 64; i += gs) {
                const int n = (int)(i % NC), kc = (int)(i / NC);
                float f[16];
#pragma unroll
                for (int j = 0; j < 16; ++j) f[j] = src[(size_t)(16 * kc + j) * NC + n] * WINSCALE;
                u32x4 w;
#pragma unroll
                for (int q = 0; q < 4; ++q) {
                    int t_ = 0;
                    t_ = __builtin_amdgcn_cvt_pk_fp8_f32(f[4 * q], f[4 * q + 1], t_, false);
                    t_ = __builtin_amdgcn_cvt_pk_fp8_f32(f[4 * q + 2], f[4 * q + 3], t_, true);
                    w[q] = (unsigned)t_;
                }
                *(u32x4*)(w8in + (size_t)(n + (n >= padc ? 32 : 0)) * 1024 + 16 * kc) = w;
            }
        };
        conv8t(p.in[7], (unsigned char*)(p.ws + WS_WB), NIN, C_PAD);
        for (size_t i = gt; i < (size_t)32 * 64; i += gs) *(u32x4*)((unsigned char*)(p.ws + WS_WB) + (size_t)(C_PAD + (i >> 6)) * 1024 + 16 * (i & 63)) = (u32x4){0u, 0u, 0u, 0u};
        conv8t(p.in[17], (unsigned char*)((bf16_t*)(p.ws + WS_WB) + WB_O), Dm, 1 << 30);
        convg(p.in[10], WB_UQ, (size_t)256 * 768, 768, p.in[8]); convg(p.in[11], WB_UKV, (size_t)128 * 1024, 1024, p.in[9]);
        conv(p.in[20], WB_R, (size_t)1024 * 256);
    }
}

__device__ __forceinline__ void phase_h1(const Params& p) {
    const int v = vcu(), G = grid_g();
    const int tid = otid(), lane = tid & 63, wave = tid >> 6;
    const float* x = p.in[0]; const int* positions = (const int*)p.in[2]; const float* g = p.in[5];
    const float* mod = (const float*)(p.ws + WS_MOD);
    unsigned char* h1 = (unsigned char*)(p.ws + WS_H1);
    f32x2* rope = (f32x2*)(p.ws + WS_ROPE);
    const int step = G * NW;
    f32x4 gg[4];
#pragma unroll
    for (int j = 0; j < 4; ++j) gg[j] = *(const f32x4*)(g + 4 * (lane + 64 * j));
    f32x4 rx[4], rsh[4], rsc[4]; int rpos = 0;
#define H1_LOAD(TT) do { \
        const float* sh_ = mod + ((TT) / SEQ) * 6144; \
        _Pragma("unroll") for (int j = 0; j < 4; ++j) { const int col_ = 4 * (lane + 64 * j); rx[j] = *(const f32x4*)(x + (size_t)(TT) * Dm + col_); rsh[j] = *(const f32x4*)(sh_ + col_); rsc[j] = *(const f32x4*)(sh_ + 1024 + col_); } \
        rpos = positions[TT]; } while (0)
    int t = v * NW + wave;
    if (t < T) H1_LOAD(t);
    for (; t < T; t += step) {
        f32x4 xv[4], hv[4], sv[4]; const int pos = rpos;
#pragma unroll
        for (int j = 0; j < 4; ++j) { xv[j] = rx[j]; hv[j] = rsh[j]; sv[j] = rsc[j]; }
        const int tn = t + step;
        if (tn < T) H1_LOAD(tn);
        float ss = 0.f;
#pragma unroll
        for (int j = 0; j < 4; ++j) ss += xv[j][0] * xv[j][0] + xv[j][1] * xv[j][1] + xv[j][2] * xv[j][2] + xv[j][3] * xv[j][3];
        ss = wave_fsum_dpp(ss);
        const float rstd = rsqrtf(ss * (1.f / Dm) + 1e-6f);
#pragma unroll
        for (int j = 0; j < 4; ++j) {
            const int col = 4 * (lane + 64 * j);
            float o[4];
#pragma unroll
            for (int e = 0; e < 4; ++e) o[e] = ((xv[j][e] * rstd * gg[j][e]) * (1.f + sv[j][e]) + hv[j][e]) * H1SCALE;
            int w = 0;
            w = __builtin_amdgcn_cvt_pk_fp8_f32(o[0], o[1], w, false);
            w = __builtin_amdgcn_cvt_pk_fp8_f32(o[2], o[3], w, true);
            *(int*)(h1 + (size_t)t * Dm + col) = w;
        }
        if (lane < 16) {
            const double inv = exp2(-(double)lane * (13.287712379549449 / 16.0));
            const double rev = (double)pos * inv * 0.15915494309189535;
            const float fr = (float)(rev - rint(rev));
            f32x2 cs; cs.x = __builtin_amdgcn_cosf(fr); cs.y = __builtin_amdgcn_sinf(fr);
            rope[(size_t)t * 16 + lane] = cs;
        }
    }
#undef H1_LOAD
}

__device__ __forceinline__ void phase_proj(const Params& p, LAS char* L) {
    const int v = vcu(), G = grid_g();
    const unsigned char* h1 = (const unsigned char*)(p.ws + WS_H1);
    const unsigned char* w_in = (const unsigned char*)(p.ws + WS_WB);
    bf16_t* proj = (bf16_t*)(p.ws + WS_PROJ);
    const f32x2* rope = (const f32x2*)(p.ws + WS_ROPE);
    for (int u = v; u < 64 * 8; u += G) {
        const int mt = u >> 3, nt = u & 7, m0 = mt * 256, n0 = nt * 256;
        auto arow = [&](int r) { return (unsigned)(m0 + r) * Dm; };
        auto wrow = [&](int seg, int r) { int col = n0 + r; if (col > NPC - 1) col = NPC - 1; return (unsigned)col * 1024u; };
        auto epi = [&](f32x16 (&acc)[4][2], int seg, LAS char* Ls) {
            const int tid_ = otid(), lane = tid_ & 63, wave = tid_ >> 6, wm = wave & 1, wn = wave >> 1, l31 = lane & 31, hi = lane >> 5;
            if (nt < 2) {
                LAS float* ssl = (LAS float*)(L + OFF_SS);
                const bool contrib = (nt == 0) || (wn < 2);
#pragma unroll
                for (int mi = 0; mi < 4; ++mi) {
                    float part = 0.f;
#pragma unroll
                    for (int ni = 0; ni < 2; ++ni)
#pragma unroll
                        for (int r = 0; r < 16; ++r) part += acc[mi][ni][r] * acc[mi][ni][r];
                    part += shx(part, 32, lane);
                    if (hi == 0) ssl[(128 * wm + 32 * mi + l31) * 4 + wn] = contrib ? part : 0.f;
                }
                __syncthreads();
                if (tid_ < 256) {
                    const f32x4 q4 = *(LAS f32x4*)(ssl + tid_ * 4);
                    const float ssum = (q4[0] + q4[1]) + (q4[2] + q4[3]);
                    float* rs = (float*)(p.ws + WS_CQN) + (nt == 0 ? 0 : (1 << 18));
                    rs[m0 + tid_] = rsqrtf(ssum * (nt == 0 ? 1.f / 256.f : 1.f / 128.f) + 1e-6f);
                }
            }
#pragma unroll
            for (int ni = 0; ni < 2; ++ni) {
                const int nbg = n0 + nb_of<0>(wn, ni);
                if (nbg == C_KR) {
#pragma unroll
                    for (int mi = 0; mi < 4; ++mi) {
                        const int m = m0 + 128 * wm + 32 * mi + l31;
#pragma unroll
                        for (int r = 0; r < 8; ++r) {
                            const f32x2 cs = rope[(size_t)m * 16 + crow(r, hi)];
                            const float x1 = acc[mi][ni][r], x2 = acc[mi][ni][r + 8];
                            acc[mi][ni][r] = x1 * cs.x - x2 * cs.y; acc[mi][ni][r + 8] = x2 * cs.x + x1 * cs.y;
                        }
                    }
                }
                if (nbg >= C_DQ && nbg < C_DK) {
#pragma unroll
                    for (int mi = 0; mi < 4; ++mi)
#pragma unroll
                        for (int r = 0; r < 16; ++r) acc[mi][ni][r] *= 0.125f * LOG2E;
                }
            }
            bf16_t* krc = (bf16_t*)(p.ws + WS_KF + 16 * MiB);
            store_tile_bf16<4, 256>(Ls, acc, [&](int row, int c) -> bf16_t* {
                const int col = n0 + 8 * c;
                if (col >= C_KR && col < C_KR + 32) return krc + (size_t)(m0 + row) * 32 + (col - C_KR);
                return col < NPC ? proj + (size_t)(m0 + row) * PSTR + col : nullptr; });
        };
        static_assert(H1SCALE * WINSCALE == 16384.f, "MFMA scale exponent 0x71 = 2^-14");
        gemm8_tile<4, 0>(L, Dm / 128, h1, arow, w_in, wrow, epi, 0x71717171);
    }
}

__device__ __forceinline__ void phase_qkv(const Params& p, LAS char* L) {
    const int v = vcu(), G = grid_g();
    const bf16_t* proj = (const bf16_t*)(p.ws + WS_PROJ);
    const float* rstd_q = (const float*)(p.ws + WS_CQN); const float* rstd_kv = rstd_q + (1 << 18);
    const bf16_t* w_uq = (const bf16_t*)(p.ws + WS_WB) + WB_UQ; const bf16_t* w_ukv = (const bf16_t*)(p.ws + WS_WB) + WB_UKV;
    bf16_t* qm = (bf16_t*)(p.ws + WS_QM); bf16_t* kf = (bf16_t*)(p.ws + WS_KF); bf16_t* vm = (bf16_t*)(p.ws + WS_VM);
    const f32x2* rope = (const f32x2*)(p.ws + WS_ROPE);
    const float qscale = LOG2E * 0.10206207261596575f;
    for (int u = v; u < 64 * 7; u += G) {
        const int mt = u / 7, j = u % 7, m0 = mt * 256;
        if (j < 3) {
            const int n0 = j * 256;
            auto arow = [&](int r) { return (unsigned)(m0 + r) * PSTR + C_CQ; };
            auto bcol = [&](int c) { return w_uq + n0 + c; };
            auto epi = [&](f32x16 (&acc)[4][2], int seg, LAS char* Ls) {
                const int tid_ = otid(), lane = tid_ & 63, wave = tid_ >> 6, wm = wave & 1, wn = wave >> 1, l31 = lane & 31, hi = lane >> 5;
#pragma unroll
                for (int mi = 0; mi < 4; ++mi) {
                    const int m = m0 + 128 * wm + 32 * mi + l31;
                    const float qs = qscale * rstd_q[m];
#pragma unroll
                    for (int ni = 0; ni < 2; ++ni) {
                        const int nbg = n0 + nb_of<0>(wn, ni);
                        if ((nbg % 96) == 64) {
#pragma unroll
                            for (int r = 0; r < 8; ++r) {
                                const f32x2 cs = rope[(size_t)m * 16 + crow(r, hi)];
                                const float x1 = acc[mi][ni][r], x2 = acc[mi][ni][r + 8];
                                acc[mi][ni][r] = x1 * cs.x - x2 * cs.y; acc[mi][ni][r + 8] = x2 * cs.x + x1 * cs.y;
                            }
                        }
#pragma unroll
                        for (int r = 0; r < 16; ++r) acc[mi][ni][r] *= qs;
                    }
                }
                store_tile_bf16<4, 256>(Ls, acc, [&](int row, int c) -> bf16_t* { return qm + (size_t)(m0 + row) * 768 + n0 + 8 * c; });
            };
            gemm_tile<4, 0, true>(L, 256 / 64, 768, proj, arow, bcol, epi);
        } else {
            const int n0 = (j - 3) * 256;
            auto arow = [&](int r) { return (unsigned)(m0 + r) * PSTR + C_CKV; };
            auto bcol = [&](int c) { return w_ukv + n0 + c; };
            auto epi = [&](f32x16 (&acc)[4][2], int seg, LAS char* Ls) {
                {
                    const int tid_ = otid(), lane = tid_ & 63, wave = tid_ >> 6, wm = wave & 1, l31 = lane & 31;
#pragma unroll
                    for (int mi = 0; mi < 4; ++mi) {
                        const float rs = rstd_kv[m0 + 128 * wm + 32 * mi + l31];
#pragma unroll
                        for (int ni = 0; ni < 2; ++ni)
#pragma unroll
                            for (int r = 0; r < 16; ++r) acc[mi][ni][r] *= rs;
                    }
                }
                store_tile_bf16<4, 256>(Ls, acc, [&](int row, int c) -> bf16_t* {
                    const int h = (n0 >> 7) + (c >> 4), cc = c & 15;
                    return cc < 8 ? kf + (size_t)(m0 + row) * 512 + h * 64 + 8 * cc : vm + (size_t)(m0 + row) * 512 + h * 64 + 8 * (cc - 8); });
            };
            gemm_tile<4, 0, true>(L, 128 / 64, 1024, proj, arow, bcol, epi);
        }
    }
}

template <int DQK, int DV, bool ALIBI>
__device__ __forceinline__ void attn_map(LAS char* L, const bf16_t* Q, int ldq, const bf16_t* K, int ldk, const bf16_t* V, int ldv,
                                         const int* posrow, float slope2, int q0, f32x16 (&o)[DV / 32], const bf16_t* K2 = nullptr, int ldk2 = 0) {
    constexpr int KSTR = DQK * 2 + 16, VSTR = DV * 2 + 64, KS = DQK / 16, ND = DV / 32;
    constexpr int K_OFF = 0, V_OFF = 64 * KSTR, P_OFF = V_OFF + 64 * VSTR, ABUF = P_OFF + 256 + 16;
    constexpr int KCH = DQK / 8, VCH = DV / 8;
    constexpr int NKI = (64 * KCH + NT - 1) / NT, NVI = (64 * VCH + NT - 1) / NT;
    static_assert(4 * ABUF <= G_LDS, "attention buffers");
    const int tid = otid();
    const int lane = tid & 63, wave = tid >> 6, l31 = lane & 31, hi = lane >> 5;
    const int qrow = q0 + 32 * wave + l31;
    unsigned kgo[NKI], klo[NKI], vgo[NVI], vlo[NVI];
    bool k2s[NKI];
#pragma unroll
    for (int i = 0; i < NKI; ++i) { int c = tid + NT * i; if (c >= 64 * KCH) c = 64 * KCH - 1; const int row = c / KCH, ch = c % KCH; k2s[i] = (DQK == 96) && (ch >= 8);
        kgo[i] = k2s[i] ? (unsigned)(row * ldk2 + (ch - 8) * 8) * 2u : (unsigned)(row * ldk + ch * 8) * 2u; klo[i] = K_OFF + row * KSTR + ch * 16; }
#pragma unroll
    for (int i = 0; i < NVI; ++i) { int c = tid + NT * i; if (c >= 64 * VCH) c = 64 * VCH - 1; const int row = c / VCH, ch = c % VCH; vgo[i] = (unsigned)(row * ldv + ch * 8) * 2u; vlo[i] = V_OFF + row * VSTR + ch * 16; }
    bf16x8 qf[KS];
#pragma unroll
    for (int s = 0; s < KS; ++s) qf[s] = *(const bf16x8*)(Q + (size_t)qrow * ldq + 16 * s + 8 * hi);
    const int pqi_ = ALIBI ? posrow[qrow] : 0;
#pragma unroll
    for (int d = 0; d < ND; ++d)
#pragma unroll
        for (int r = 0; r < 16; ++r) o[d][r] = 0.f;
    float m_run = -1e30f, l_run = 0.f;
    const int ntile = (q0 + 256) / 64;
    const int qmin = q0 + 32 * wave, qmax = qmin + 31;
    const int vrd = V_OFF + (4 * hi + ((lane & 15) >> 2)) * VSTR + 2 * (16 * ((lane >> 4) & 1) + 4 * (lane & 3));
    u32x4 rk[2][NKI], rv[2][NVI]; int rpi = 0;
#define A_LOAD(T) do {        \
        _Pragma("unroll") for (int h_ = 0; h_ < 2; ++h_) { \
            const char* kbase_ = (const char*)(K + (size_t)(2 * (T) + h_) * 64 * ldk); const char* kbase2_ = (const char*)(K2 + (size_t)(2 * (T) + h_) * 64 * ldk2); \
            const char* vbase_ = (const char*)(V + (size_t)(2 * (T) + h_) * 64 * ldv); \
            _Pragma("unroll") for (int i = 0; i < NKI; ++i) rk[h_][i] = *(const u32x4*)((k2s[i] ? kbase2_ : kbase_) + kgo[i]); \
            _Pragma("unroll") for (int i = 0; i < NVI; ++i) rv[h_][i] = *(const u32x4*)(vbase_ + vgo[i]); } \
        if (ALIBI) rpi = posrow[(T) * 128 + (tid & 127)]; } while (0)
#define A_STORE(LP) do { \
        _Pragma("unroll") for (int h_ = 0; h_ < 2; ++h_) { \
            _Pragma("unroll") for (int i = 0; i < NKI; ++i) if (tid + NT * i < 64 * KCH) *(LAS u32x4*)((LP) + h_ * ABUF + klo[i]) = rk[h_][i]; \
            _Pragma("unroll") for (int i = 0; i < NVI; ++i) if (tid + NT * i < 64 * VCH) *(LAS u32x4*)((LP) + h_ * ABUF + vlo[i]) = rv[h_][i]; } \
        if (ALIBI && tid < 128) { \
            const float rp = slope2 * (float)rpi; \
            *(LAS float*)((LP) + (tid >> 6) * ABUF + P_OFF + 4 * (tid & 63)) = rp; \
            const float km_ = wave_fmax_dpp(rp); \
            if (lane == 0) *(LAS float*)((LP) + (tid >> 6) * ABUF + P_OFF + 256) = km_; } } while (0)
#define A_KFRAG(DST, LP, S_) do { DST[0] = *(LAS bf16x8*)((LP) + K_OFF + l31 * KSTR + 32 * (S_) + 16 * hi); DST[1] = *(LAS bf16x8*)((LP) + K_OFF + (32 + l31) * KSTR + 32 * (S_) + 16 * hi); } while (0)
#define A_SCORES(S0, S1, LP, KB) do { \
        bf16x8 kfa_[2], kfb_[2]; \
        bool sep_ = true; \
        if (ALIBI) {        \
            sep_ = __int_as_float(__builtin_amdgcn_readfirstlane(__float_as_int(*(LAS float*)((LP) + P_OFF + 256)))) <= qmin_u; \
            _Pragma("unroll") for (int g4 = 0; g4 < 4; ++g4) { \
                const f32x4 a_ = *(LAS f32x4*)((LP) + P_OFF + 4 * (8 * g4 + 4 * hi)), b_ = *(LAS f32x4*)((LP) + P_OFF + 4 * (32 + 8 * g4 + 4 * hi)); \
                _Pragma("unroll") for (int e = 0; e < 4; ++e) { S0[4 * g4 + e] = a_[e]; S1[4 * g4 + e] = b_[e]; } } } \
        A_KFRAG(kfa_, LP, 0); \
        _Pragma("unroll") for (int s = 0; s < KS; s += 2) {        \
            if (s + 1 < KS) A_KFRAG(kfb_, LP, s + 1); \
            if (s == 0 && ALIBI) { S0 = MFMA32(kfa_[0], qf[0], S0); S1 = MFMA32(kfa_[1], qf[0], S1); } \
            else if (s == 0) { S0 = MFMA32(kfa_[0], qf[0], z16); S1 = MFMA32(kfa_[1], qf[0], z16); }         \
            else { S0 = MFMA32(kfa_[0], qf[s], S0); S1 = MFMA32(kfa_[1], qf[s], S1); } \
            __builtin_amdgcn_sched_barrier(0); \
            if (s + 1 < KS) { \
                if (s + 2 < KS) A_KFRAG(kfa_, LP, s + 2); \
                S0 = MFMA32(kfb_[0], qf[s + 1], S0); S1 = MFMA32(kfb_[1], qf[s + 1], S1); \
                __builtin_amdgcn_sched_barrier(0); } } \
        if (ALIBI && !sep_) {        \
            _Pragma("unroll") for (int g4 = 0; g4 < 4; ++g4) { \
                const f32x4 pk0_ = *(LAS f32x4*)((LP) + P_OFF + 4 * (8 * g4 + 4 * hi)), pk1_ = *(LAS f32x4*)((LP) + P_OFF + 4 * (32 + 8 * g4 + 4 * hi)); \
                _Pragma("unroll") for (int e = 0; e < 4; ++e) { S0[4 * g4 + e] -= 2.f * fmaxf(pk0_[e] - aq, 0.f); S1[4 * g4 + e] -= 2.f * fmaxf(pk1_[e] - aq, 0.f); } } } \
        if ((KB) + 63 > qmin) { \
            _Pragma("unroll") for (int r = 0; r < 16; ++r) { const int key_ = (KB) + crow(r, hi); if (key_ > qrow) S0[r] = -INFINITY; if (key_ + 32 > qrow) S1[r] = -INFINITY; } } } while (0)
#define A_VFRAG(DST, LP, S_) do { _Pragma("unroll") for (int d = 0; d < ND; ++d) { \
            LAS char* vp_ = (LP) + vrd + 16 * (S_) * VSTR + 64 * d; const s16x4 lo_ = tr_read(vp_), h4_ = tr_read(vp_ + 8 * VSTR); \
            DST[d] = (bf16x8){lo_[0], lo_[1], lo_[2], lo_[3], h4_[0], h4_[1], h4_[2], h4_[3]}; } } while (0)
#define A_SOFTMAX_PV(S0, S1, LP) do { \
        bf16x8 vfa_[ND], vfb_[ND]; \
        A_VFRAG(vfa_, LP, 0);                                       \
          \
        float mxa_ = VMAX3(S0[0], S0[1], S0[2]), mxb_ = VMAX3(S0[8], S0[9], S0[10]), mxc_ = VMAX3(S1[0], S1[1], S1[2]), mxd_ = VMAX3(S1[8], S1[9], S1[10]); \
        mxa_ = VMAX3(mxa_, S0[3], S0[4]); mxb_ = VMAX3(mxb_, S0[11], S0[12]); mxc_ = VMAX3(mxc_, S1[3], S1[4]); mxd_ = VMAX3(mxd_, S1[11], S1[12]); \
        mxa_ = VMAX3(mxa_, S0[5], S0[6]); mxb_ = VMAX3(mxb_, S0[13], S0[14]); mxc_ = VMAX3(mxc_, S1[5], S1[6]); mxd_ = VMAX3(mxd_, S1[13], S1[14]); \
        mxa_ = VMAX3(mxa_, S0[7], S0[15]); mxc_ = VMAX3(mxc_, S1[7], S1[15]); \
        float mx_ = VMAX3(mxa_, mxb_, mxc_); mx_ = VMAX3(mx_, mxd_, mxd_); \
        { const auto rr_ = __builtin_amdgcn_permlane32_swap(__float_as_uint(mx_), __float_as_uint(mx_), false, false); mx_ = VMAX3(__uint_as_float(rr_[0]), __uint_as_float(rr_[1]), __uint_as_float(rr_[1])); }     \
        if (__any(mx_ > m_run + 8.f)) { \
            const float m_new_ = fmaxf(m_run, mx_); const float alpha_ = __builtin_amdgcn_exp2f(m_run - m_new_); m_run = m_new_; l_run *= alpha_; \
            _Pragma("unroll") for (int d = 0; d < ND; ++d) _Pragma("unroll") for (int r = 0; r < 16; ++r) o[d][r] *= alpha_; } \
        { const f32x2 m2_ = {m_run, m_run};          \
          f32x2 ls0_ = {0.f, 0.f}, ls1_ = {0.f, 0.f}; \
          _Pragma("unroll") for (int r = 0; r < 16; r += 2) { \
            f32x2 a_ = {S0[r], S0[r + 1]}, b_ = {S1[r], S1[r + 1]}; a_ = a_ - m2_; b_ = b_ - m2_; \
            a_.x = __builtin_amdgcn_exp2f(a_.x); a_.y = __builtin_amdgcn_exp2f(a_.y); b_.x = __builtin_amdgcn_exp2f(b_.x); b_.y = __builtin_amdgcn_exp2f(b_.y); \
            S0[r] = a_.x; S0[r + 1] = a_.y; S1[r] = b_.x; S1[r + 1] = b_.y; ls0_ = ls0_ + a_; ls1_ = ls1_ + b_; } \
          l_run += (ls0_.x + ls0_.y) + (ls1_.x + ls1_.y); } \
        u32x4 pw_[4]; \
        _Pragma("unroll") for (int j = 0; j < 4; ++j) { \
            pw_[0][j] = pk2(S0[2 * j], S0[2 * j + 1]); pw_[1][j] = pk2(S0[8 + 2 * j], S0[8 + 2 * j + 1]); \
            pw_[2][j] = pk2(S1[2 * j], S1[2 * j + 1]); pw_[3][j] = pk2(S1[8 + 2 * j], S1[8 + 2 * j + 1]); } \
        __builtin_amdgcn_sched_barrier(0); \
        A_VFRAG(vfb_, LP, 1); \
        _Pragma("unroll") for (int d = 0; d < ND; ++d) o[d] = MFMA32(vfa_[d], __builtin_bit_cast(bf16x8, pw_[0]), o[d]); \
        __builtin_amdgcn_sched_barrier(0); \
        A_VFRAG(vfa_, LP, 2); \
        _Pragma("unroll") for (int d = 0; d < ND; ++d) o[d] = MFMA32(vfb_[d], __builtin_bit_cast(bf16x8, pw_[1]), o[d]); \
        __builtin_amdgcn_sched_barrier(0); \
        A_VFRAG(vfb_, LP, 3); \
        _Pragma("unroll") for (int d = 0; d < ND; ++d) o[d] = MFMA32(vfa_[d], __builtin_bit_cast(bf16x8, pw_[2]), o[d]); \
        __builtin_amdgcn_sched_barrier(0); \
        _Pragma("unroll") for (int d = 0; d < ND; ++d) o[d] = MFMA32(vfb_[d], __builtin_bit_cast(bf16x8, pw_[3]), o[d]); \
        __builtin_amdgcn_sched_barrier(0); } while (0)
    A_LOAD(0);
    const float aq = ALIBI ? slope2 * (float)pqi_ : 0.f;
    float qmin_u = 0.f;
    if (ALIBI) {
        float qm_ = aq;
#pragma unroll
        for (int o_ = 32; o_ >= 1; o_ >>= 1) qm_ = fminf(qm_, shx(qm_, o_, lane));
        qmin_u = __int_as_float(__builtin_amdgcn_readfirstlane(__float_as_int(qm_)));
    }
    __syncthreads();
    A_STORE(L);
    __syncthreads();
    const f32x16 z16 = {0.f, 0.f, 0.f, 0.f, 0.f, 0.f, 0.f, 0.f, 0.f, 0.f, 0.f, 0.f, 0.f, 0.f, 0.f, 0.f};
    f32x16 sa0, sa1, sb0, sb1;
    const int nbt = ntile / 2;
    for (int T = 0; T < nbt; ++T) {
        LAS char* Lc = L + (T & 1) * 2 * ABUF; LAS char* Ln = L + ((T + 1) & 1) * 2 * ABUF;
        const int kb = T * 128;
        const bool more = T + 1 < nbt;
        if (more) A_LOAD(T + 1);
        const bool act0 = kb <= qmax, act1 = kb + 64 <= qmax;
        if (act0) {
            A_SCORES(sa0, sa1, Lc, kb);
            if (act1) {
                A_SCORES(sb0, sb1, Lc + ABUF, kb + 64);
                A_SOFTMAX_PV(sa0, sa1, Lc);
                A_SOFTMAX_PV(sb0, sb1, Lc + ABUF);
            } else {
                A_SOFTMAX_PV(sa0, sa1, Lc);
            }
        }
        if (more) A_STORE(Ln);
        __syncthreads();
    }
#undef A_LOAD
#undef A_STORE
#undef A_SCORES
#undef A_SOFTMAX_PV
#undef A_KFRAG
#undef A_VFRAG
    const float lt = l_run + shx(l_run, 32, lane);
    const float inv = 1.f / lt;
#pragma unroll
    for (int d = 0; d < ND; ++d)
#pragma unroll
        for (int r = 0; r < 16; ++r) o[d][r] *= inv;
}

__device__ __forceinline__ void attn_decode(int it, int& kind, int& qb, int& idx) {
    const int seg_kind[16] = {1, 1, 1, 1, 1, 0, 1, 0, 0, 0, 1, 0, 0, 1, 0, 0};
    const int seg_qb[16]   = {7, 6, 5, 4, 3, 7, 2, 6, 5, 4, 1, 3, 2, 0, 1, 0};
    int base = 0; kind = 0; qb = 0; idx = 0;
#pragma unroll
    for (int s = 0; s < 16; ++s) {
        const int n = seg_kind[s] ? 32 : 64;
        if (it >= base && it < base + n) { kind = seg_kind[s]; qb = seg_qb[s]; idx = it - base; }
        base += n;
    }
}

constexpr int NCONV = 257 * 12;
__device__ __forceinline__ void conv_item(const Params& p, LAS char* L, int c) {
    const int tid = otid();
    const int e = c / 12, sub = c - 12 * e;
    const bool down = sub >= 8;
    const float* src; unsigned char* dst; float scale;
    if (!down) {
        const int up = sub >> 2, n0 = (sub & 3) * 64;
        src = (e < 256 ? p.in[22 + up] + (size_t)e * Dm * 256 : p.in[25 + up]) + n0;
        dst = (unsigned char*)(p.ws + WS_W8GU) + ((size_t)e * 512 + up * 256 + n0) * 1024;
        scale = WGUSCALE;
    } else {
        const int n0 = (sub - 8) * 256;
        src = (e < 256 ? p.in[24] + (size_t)e * 256 * Dm : p.in[27]) + n0;
        dst = (unsigned char*)(p.ws + WS_W8D) + ((size_t)e * 1024 + n0) * 256;
        scale = WDSCALE;
    }
    const int np = down ? 1024 : 256, rb = down ? 256 : 1024;
    const int nq = tid & 15, kr = tid >> 4;
    f32x4 v[8][4];
#pragma unroll
    for (int g = 0; g < 8; ++g) {
        const float* sg = src + (down ? 64 * (g >> 1) + (size_t)(128 * (g & 1)) * np : (size_t)(128 * g) * np) + (size_t)(4 * kr) * np + 4 * nq;
#pragma unroll
        for (int kk = 0; kk < 4; ++kk) v[g][kk] = __builtin_nontemporal_load((const f32x4*)(sg + (size_t)kk * np));
    }
#pragma unroll
    for (int g = 0; g < 8; ++g) {
        const int nl0 = (down ? 64 * (g >> 1) : 0) + 4 * nq, kd = kr + 32 * (down ? (g & 1) : g);
        const int pos = 4 * (kd ^ (4 * (nq & 7)));
#pragma unroll
        for (int cc = 0; cc < 4; ++cc) {
            int w = 0;
            w = __builtin_amdgcn_cvt_pk_fp8_f32(v[g][0][cc] * scale, v[g][1][cc] * scale, w, false);
            w = __builtin_amdgcn_cvt_pk_fp8_f32(v[g][2][cc] * scale, v[g][3][cc] * scale, w, true);
            *(LAS int*)(L + (nl0 + cc) * rb + pos) = w;
        }
    }
    __syncthreads();
#pragma unroll
    for (int j = 0; j < 8; ++j) {
        const int id = tid + NT * j;
        const int row = down ? (id >> 4) : (id >> 6), ch = down ? (id & 15) : (id & 63);
        __builtin_nontemporal_store(*(LAS u32x4*)(L + row * rb + 16 * (ch ^ ((row >> 2) & 7))), (u32x4*)(dst + (size_t)16 * id));
    }
    __syncthreads();
}

__device__ __forceinline__ bool xcd_barrier_arrive(const Params& p, LAS char* L);
__device__ __forceinline__ void xcd_barrier_wait(const Params& p, LAS char* L);
__device__ __forceinline__ void phase_attn(const Params& p, LAS char* L) {
    bool waited = xcd_barrier_arrive(p, L);
    const int v = vcu(), G = grid_g();
    const int tid = otid(), lane = tid & 63, wave = tid >> 6, l31 = lane & 31, hi = lane >> 5;
    const int* positions = (const int*)p.in[2];
    const bf16_t* proj = (const bf16_t*)(p.ws + WS_PROJ);
    const bf16_t* qm = (const bf16_t*)(p.ws + WS_QM); const bf16_t* kf = (const bf16_t*)(p.ws + WS_KF); const bf16_t* vm = (const bf16_t*)(p.ws + WS_VM);
    unsigned char* att = (unsigned char*)(p.ws + WS_ATT);
    float* od0 = (float*)(p.ws + WS_OD0);
    const float* subg = p.in[16];
    unsigned* qctr = (unsigned*)(p.ws + WS_CTL + 2048);
    LAS unsigned* qslot = (LAS unsigned*)(L + OFF_MISC + 16);
    float lam;
    {
        const float a = p.in[12][lane] * p.in[13][lane], b = p.in[14][lane] * p.in[15][lane];
        lam = __expf(wave_sum(a, lane)) - __expf(wave_sum(b, lane)) + LAMBDA_INIT;
    }
    for (bool first = true;; first = false) {
        int it = v;
        if (!first) {
            if (tid == 0) *qslot = __hip_atomic_fetch_add(qctr, 1u, __ATOMIC_RELAXED, __HIP_MEMORY_SCOPE_AGENT) + (unsigned)G;
            __syncthreads();
            it = __builtin_amdgcn_readfirstlane((int)*qslot);
            __syncthreads();
        }
        if (it >= 768 + NCONV) break;
        if (it >= 768 * 5) { conv_item(p, L, 768 * 4 + (it - 768 * 5)); continue; }
        if (it % 5 != 0) { conv_item(p, L, (it / 5) * 4 + (it % 5) - 1); continue; }
        if (!waited) { xcd_barrier_wait(p, L); waited = true; }
        it /= 5;
        int kind, qb, idx;
        attn_decode(it, kind, qb, idx);
        const int q0 = qb * 256;
        if (kind == 0) {
            const int b = idx >> 3, h = idx & 7; const size_t tb = (size_t)b * SEQ;
            f32x16 o[2];
            attn_map<96, 64, false>(L, qm + tb * 768 + h * 96, 768, kf + tb * 512 + h * 64, 512, vm + tb * 512 + h * 64, 512, positions + tb, 0.f, q0, o, (const bf16_t*)(p.ws + WS_KF + 16 * MiB) + tb * 32, 32);
            const size_t t = tb + q0 + 32 * wave + l31;
#pragma unroll
            for (int d = 0; d < 2; ++d)
#pragma unroll
                for (int gq = 0; gq < 4; ++gq) {
                    int w = 0;
                    w = __builtin_amdgcn_cvt_pk_fp8_f32(o[d][4 * gq] * ATTSCALE, o[d][4 * gq + 1] * ATTSCALE, w, false);
                    w = __builtin_amdgcn_cvt_pk_fp8_f32(o[d][4 * gq + 2] * ATTSCALE, o[d][4 * gq + 3] * ATTSCALE, w, true);
                    *(int*)(att + t * 1024 + h * 64 + 32 * d + 8 * gq + 4 * hi) = w;
                }
        } else {
            const int b = idx >> 2, h = idx & 3; const size_t tb = (size_t)b * SEQ;
            const float slope2 = exp2f(-2.f * (h + 1)) * LOG2E;
            const size_t t = tb + q0 + 32 * wave + l31;
            f32x16 o[4];
#define OD0S (od0 + (((size_t)(qb * 32 + idx) * NW + (otid() >> 6)) * 16) * 256 + (otid() & 63) * 4)
            attn_map<64, 128, true>(L, proj + tb * PSTR + C_DQ + h * 128, PSTR, proj + tb * PSTR + C_DK + h * 128, PSTR, proj + tb * PSTR + C_DV + h * 128, PSTR, positions + tb, slope2, q0, o);
#pragma unroll
            for (int c8 = 0; c8 < 8; ++c8) {
                const int d = c8 >> 1, b = 8 * (c8 & 1);
                const u32x4 w = {pk2(o[d][b], o[d][b + 1]), pk2(o[d][b + 2], o[d][b + 3]), pk2(o[d][b + 4], o[d][b + 5]), pk2(o[d][b + 6], o[d][b + 7])};
                *(u32x4*)(OD0S + (size_t)c8 * 256) = w;
            }
            attn_map<64, 128, true>(L, proj + tb * PSTR + C_DQ + h * 128 + 64, PSTR, proj + tb * PSTR + C_DK + h * 128 + 64, PSTR, proj + tb * PSTR + C_DV + h * 128, PSTR, positions + tb, slope2, q0, o);
            float ss = 0.f;
#pragma unroll
            for (int c8 = 0; c8 < 8; ++c8) {
                const int d = c8 >> 1, b = 8 * (c8 & 1);
                const u32x4 w = *(const u32x4*)(OD0S + (size_t)c8 * 256);
#pragma unroll
                for (int j = 0; j < 4; ++j) {
                    const float c0 = __uint_as_float(w[j] << 16) - lam * o[d][b + 2 * j], c1 = __uint_as_float(w[j] & 0xffff0000u) - lam * o[d][b + 2 * j + 1];
                    o[d][b + 2 * j] = c0; o[d][b + 2 * j + 1] = c1; ss += c0 * c0 + c1 * c1;
                }
            }
            ss += shx(ss, 32, lane);
            const float rstd = rsqrtf(ss * (1.f / 128.f) + 1e-5f) * ((1.f - LAMBDA_INIT) * ATTSCALE);
            f32x4 gsub[16];
#pragma unroll
            for (int k = 0; k < 16; ++k) gsub[k] = *(const f32x4*)(subg + 32 * (k >> 2) + 8 * (k & 3) + 4 * hi);
#pragma unroll
            for (int d = 0; d < 4; ++d)
#pragma unroll
                for (int gq = 0; gq < 4; ++gq) {
                    const int dv = 32 * d + 8 * gq + 4 * hi;
                    const f32x4 gv = gsub[4 * d + gq];
                    int w = 0;
                    w = __builtin_amdgcn_cvt_pk_fp8_f32(o[d][4 * gq] * rstd * gv[0], o[d][4 * gq + 1] * rstd * gv[1], w, false);
                    w = __builtin_amdgcn_cvt_pk_fp8_f32(o[d][4 * gq + 2] * rstd * gv[2], o[d][4 * gq + 3] * rstd * gv[3], w, true);
                    *(int*)(att + t * 1024 + 512 + h * 128 + dv) = w;
                }
        }
    }
    if (!waited) xcd_barrier_wait(p, L);
}

__device__ __forceinline__ void phase_oproj(const Params& p, LAS char* L) {
    const int v = vcu(), G = grid_g();
    const unsigned char* att = (const unsigned char*)(p.ws + WS_ATT);
    const unsigned char* w_o = (const unsigned char*)((const bf16_t*)(p.ws + WS_WB) + WB_O);
    bf16_t* y1 = (bf16_t*)(p.ws + WS_Y1);
    for (int u = v; u < 64 * 4; u += G) {
        const int mt = u >> 2, nt = u & 3, m0 = mt * 256, n0 = nt * 256;
        auto arow = [&](int r) { return (unsigned)(m0 + r) * Dm; };
        auto wrow = [&](int seg, int r) { return (unsigned)(n0 + r) * 1024u; };
        auto epi = [&](f32x16 (&acc)[4][2], int seg, LAS char* Ls) {
            store_tile_bf16<4, 256>(Ls, acc, [&](int row, int c) -> bf16_t* { return y1 + (size_t)(m0 + row) * Dm + n0 + 8 * c; });
        };
        static_assert(ATTSCALE * WINSCALE == 65536.f, "MFMA scale exponent 0x6f = 2^-16");
        gemm8_tile<4, 0>(L, Dm / 128, att, arow, w_o, wrow, epi, 0x6f6f6f6f);
    }
}

__device__ __forceinline__ void post_attn_tokens(const Params& p, int t0, int nper) {
    const int tid = otid(), lane = tid & 63, wave = tid >> 6;
    const float* x = p.in[0]; const float* pg = p.in[6]; const float* fg = p.in[18];
    const float* mod = (const float*)(p.ws + WS_MOD);
    const bf16_t* y1 = (const bf16_t*)(p.ws + WS_Y1);
    bf16_t* h2 = (bf16_t*)(p.ws + WS_H2);
    unsigned char* h8 = (unsigned char*)(p.ws + WS_H8);
    bf16_t* x1b = (bf16_t*)(p.ws + WS_H1);
    const float* mb = mod + (t0 / SEQ) * 6144;
    f32x4 g_pg[4], g_ga[4], g_fg[4], g_sv[4], g_hv[4];
#pragma unroll
    for (int j = 0; j < 4; ++j) {
        const int col = 4 * (lane + 64 * j);
        g_pg[j] = *(const f32x4*)(pg + col); g_ga[j] = *(const f32x4*)(mb + 2048 + col);
        g_fg[j] = *(const f32x4*)(fg + col); g_sv[j] = *(const f32x4*)(mb + 4096 + col); g_hv[j] = *(const f32x4*)(mb + 3072 + col);
    }
    u32x2 ryn[4]; f32x4 rxn[4];
#pragma unroll
    for (int j = 0; j < 4; ++j) { ryn[j] = *(const u32x2*)(y1 + (size_t)(t0 + wave) * Dm + 4 * (lane + 64 * j)); rxn[j] = *(const f32x4*)(x + (size_t)(t0 + wave) * Dm + 4 * (lane + 64 * j)); }
    for (int i_ = 0; i_ < nper; ++i_) {
        const int t = t0 + wave + NW * i_;
        const int tn = (i_ + 1 < nper) ? t + NW : t;
        f32x4 yv[4], xv[4]; float ss = 0.f;
#pragma unroll
        for (int j = 0; j < 4; ++j) {
            yv[j] = (f32x4){bflo(ryn[j].x), bfhi(ryn[j].x), bflo(ryn[j].y), bfhi(ryn[j].y)};
            xv[j] = rxn[j];
            ss += yv[j][0] * yv[j][0] + yv[j][1] * yv[j][1] + yv[j][2] * yv[j][2] + yv[j][3] * yv[j][3];
        }
#pragma unroll
        for (int j = 0; j < 4; ++j) { ryn[j] = *(const u32x2*)(y1 + (size_t)tn * Dm + 4 * (lane + 64 * j)); rxn[j] = *(const f32x4*)(x + (size_t)tn * Dm + 4 * (lane + 64 * j)); }
        ss = wave_fsum_dpp(ss);
        const float rstd = rsqrtf(ss * (1.f / Dm) + 1e-6f);
        float ss2 = 0.f;
#pragma unroll
        for (int j = 0; j < 4; ++j) {
            const int col = 4 * (lane + 64 * j);
#pragma unroll
            for (int e = 0; e < 4; ++e) { xv[j][e] = xv[j][e] + g_ga[j][e] * (yv[j][e] * rstd * g_pg[j][e]); ss2 += xv[j][e] * xv[j][e]; }
            { u32x2 wx; wx.x = pk2(xv[j][0], xv[j][1]); wx.y = pk2(xv[j][2], xv[j][3]); __builtin_nontemporal_store(wx, (u32x2*)(x1b + (size_t)t * Dm + col)); }
        }
        ss2 = wave_fsum_dpp(ss2);
        const float rstd2 = rsqrtf(ss2 * (1.f / Dm) + 1e-6f);
#pragma unroll
        for (int j = 0; j < 4; ++j) {
            const int col = 4 * (lane + 64 * j);
            float o[4];
#pragma unroll
            for (int e = 0; e < 4; ++e) o[e] = (xv[j][e] * rstd2 * g_fg[j][e]) * (1.f + g_sv[j][e]) + g_hv[j][e];
            u32x2 w; w.x = pk2(o[0], o[1]); w.y = pk2(o[2], o[3]);
            *(u32x2*)(h2 + (size_t)t * Dm + col) = w;
            int w8 = 0;
            w8 = __builtin_amdgcn_cvt_pk_fp8_f32(o[0] * H8SCALE, o[1] * H8SCALE, w8, false);
            w8 = __builtin_amdgcn_cvt_pk_fp8_f32(o[2] * H8SCALE, o[3] * H8SCALE, w8, true);
            *(int*)(h8 + (size_t)t * Dm + col) = w8;
        }
    }
}

__device__ __forceinline__ unsigned fkey(float f) { const unsigned u = __float_as_uint(f); return (u & 0x80000000u) ? ~u : (u | 0x80000000u); }
__device__ __forceinline__ void phase_router_route(const Params& p, LAS char* L) {
    const int v = vcu(), G = grid_g();
    const bf16_t* h2 = (const bf16_t*)(p.ws + WS_H2);
    const bf16_t* rw = (const bf16_t*)(p.ws + WS_WB) + WB_R;
    const float* rb = p.in[21];
    int* cnt = (int*)(p.ws + WS_CTL);
    int* la = (int*)(p.ws + WS_LA); float* lw = (float*)(p.ws + WS_LW);
    constexpr int LSTR = 1040;
    LAS int* pe = (LAS int*)(L + 69632);
    LAS float* pw = (LAS float*)(L + 69632 + 2048);
    LAS int* hist = (LAS int*)(L + 69632 + 4096);
    LAS int* basep = (LAS int*)(L + 69632 + 5120);
    for (int u = v; u < T / 64; u += G) {
        const int m0 = u * 64;
        post_attn_tokens(p, m0, 8);
        asm volatile("s_waitcnt vmcnt(0)" ::: "memory");
        __syncthreads();
        auto arow = [&](int r) { return (unsigned)(m0 + r) * Dm; };
        auto bcol = [&](int c) { return rw + c; };
        auto epi = [&](f32x16 (&acc)[1][2], int seg, LAS char* Ls) {
            const int tid_ = otid(), lane = tid_ & 63, wave = tid_ >> 6, wm = wave & 1, wn = wave >> 1, l31 = lane & 31, hi = lane >> 5;
            const int row = 32 * wm + l31;
#pragma unroll
            for (int ni = 0; ni < 2; ++ni)
#pragma unroll
                for (int gq = 0; gq < 4; ++gq) {
                    f32x4 w = {acc[0][ni][4 * gq], acc[0][ni][4 * gq + 1], acc[0][ni][4 * gq + 2], acc[0][ni][4 * gq + 3]};
                    *(LAS f32x4*)(L + row * LSTR + 4 * (nb_of<0>(wn, ni) + 8 * gq + 4 * hi)) = w;
                }
        };
        gemm_tile<1, 0, true>(L, Dm / 64, NE, h2, arow, bcol, epi);
        const int tid = otid(), lane = tid & 63, wave = tid >> 6;
        if (tid < 256) hist[tid] = 0;
        __syncthreads();
        const f32x4 bias = *(const f32x4*)(rb + 4 * lane);
        const int grp = lane >> 3;
#pragma unroll 4
        for (int tt = 0; tt < 8; ++tt) {
            const int tok = 8 * wave + tt;
            const f32x4 lgv = *(LAS f32x4*)(L + tok * LSTR + 16 * lane);
            const float s0 = 1.f / (1.f + __expf(-lgv[0])), s1 = 1.f / (1.f + __expf(-lgv[1])), s2 = 1.f / (1.f + __expf(-lgv[2])), s3 = 1.f / (1.f + __expf(-lgv[3]));
            float v0 = s0 + bias[0], v1 = s1 + bias[1], v2 = s2 + bias[2], v3 = s3 + bias[3];
            float t1 = fmaxf(v0, v1), t2 = fminf(v0, v1);
            { const float a = fmaxf(v2, v3), bq = fminf(v2, v3); const float n1 = fmaxf(t1, a), n2 = fmaxf(fminf(t1, a), fmaxf(t2, bq)); t1 = n1; t2 = n2; }
            { const float o1 = dppf<0xB1, 0xf>(t1, t1), o2 = dppf<0xB1, 0xf>(t2, t2); const float n1 = fmaxf(t1, o1), n2 = fmaxf(fminf(t1, o1), fmaxf(t2, o2)); t1 = n1; t2 = n2; }
            { const float o1 = dppf<0x4E, 0xf>(t1, t1), o2 = dppf<0x4E, 0xf>(t2, t2); const float n1 = fmaxf(t1, o1), n2 = fmaxf(fminf(t1, o1), fmaxf(t2, o2)); t1 = n1; t2 = n2; }
            { const float o1 = shx(t1, 4, lane), o2 = shx(t2, 4, lane); const float n1 = fmaxf(t1, o1), n2 = fmaxf(fminf(t1, o1), fmaxf(t2, o2)); t1 = n1; t2 = n2; }
            const float gs = t1 + t2;
            int rank = 0;
#pragma unroll
            for (int gg = 0; gg < 8; ++gg) { const float og = __int_as_float(__builtin_amdgcn_readlane(__float_as_int(gs), gg * 8)); rank += (og > gs || (og == gs && gg < grp)) ? 1 : 0; }
            if (rank >= 4) { v0 = -INFINITY; v1 = -INFINITY; v2 = -INFINITY; v3 = -INFINITY; }
            unsigned k0 = fkey(v0), k1 = fkey(v1), k2 = fkey(v2), k3 = fkey(v3);
            bool c0 = false, c1 = false, c2 = false, c3 = false;
#pragma unroll
            for (int it = 0; it < TOPK; ++it) {
                const unsigned lb = max(max(k0, k1), max(k2, k3));
                const unsigned m = wave_umax(lb);
                const unsigned long long bal = __ballot(lb == m);
                const int owner = __builtin_ctzll(bal);
                if (lane == owner) {
                    if (k0 == m) { k0 = 0u; c0 = true; } else if (k1 == m) { k1 = 0u; c1 = true; } else if (k2 == m) { k2 = 0u; c2 = true; } else { k3 = 0u; c3 = true; }
                }
            }
            const float wsum = wave_fsum_dpp((c0 ? s0 : 0.f) + (c1 ? s1 : 0.f) + (c2 ? s2 : 0.f) + (c3 ? s3 : 0.f));
            const float wnorm = 2.5f / wsum;
            const unsigned long long b0 = __ballot(c0), b1 = __ballot(c1), b2 = __ballot(c2), b3 = __ballot(c3);
            const unsigned long long lm = (1ull << lane) - 1ull;
            const int q0 = __builtin_popcountll(b0 & lm), a1 = __builtin_popcountll(b0);
            const int q1 = a1 + __builtin_popcountll(b1 & lm), a2 = a1 + __builtin_popcountll(b1);
            const int q2 = a2 + __builtin_popcountll(b2 & lm), a3 = a2 + __builtin_popcountll(b2);
            const int q3 = a3 + __builtin_popcountll(b3 & lm);
            if (c0) { pe[8 * tok + q0] = 4 * lane + 0; pw[8 * tok + q0] = s0 * wnorm; }
            if (c1) { pe[8 * tok + q1] = 4 * lane + 1; pw[8 * tok + q1] = s1 * wnorm; }
            if (c2) { pe[8 * tok + q2] = 4 * lane + 2; pw[8 * tok + q2] = s2 * wnorm; }
            if (c3) { pe[8 * tok + q3] = 4 * lane + 3; pw[8 * tok + q3] = s3 * wnorm; }
        }
        __syncthreads();
        const int my_e = pe[tid];
        const int my_rank = __hip_atomic_fetch_add(hist + my_e, 1, __ATOMIC_RELAXED, __HIP_MEMORY_SCOPE_WORKGROUP);
        __syncthreads();
        if (tid < 256) { const int n = hist[tid]; basep[tid] = n > 0 ? atomicAdd(cnt + tid, n) : 0; }
        __syncthreads();
        {
            const int pos = basep[my_e] + my_rank;
            if (pos < LISTCAP) { la[(size_t)my_e * LISTCAP + pos] = (m0 + (tid >> 3)) * TOPK + (tid & 7); lw[(size_t)my_e * LISTCAP + pos] = pw[tid]; }
        }
        __syncthreads();
    }
}

__device__ __forceinline__ int moe_cnt(const int* cnt, int e) { int c = (e < 256) ? cnt[e] : T; return c > LISTCAP ? LISTCAP : c; }
__device__ __forceinline__ int wave_iscan_dpp(int v) {
#define DPPI_(CTRL, RM) __builtin_amdgcn_update_dpp(0, v, CTRL, RM, 0xf, false)
    v += DPPI_(0x111, 0xf); v += DPPI_(0x112, 0xf); v += DPPI_(0x114, 0xf); v += DPPI_(0x118, 0xf);
    v += DPPI_(0x142, 0xa); v += DPPI_(0x143, 0xc);
#undef DPPI_
    return v;
}
__device__ __forceinline__ void moe_prefix(const Params& p, LAS char* L) {
    const int tid = otid(), lane = tid & 63, wave = tid >> 6;
    const int* cnt = (const int*)(p.ws + WS_CTL);
    LAS int* pre = (LAS int*)(L + OFF_PRE);
    LAS int* cntl = (LAS int*)(L + OFF_TL);
    LAS int* wtot = (LAS int*)(L + OFF_TL + 1056);
    int val = 0;
    if (tid < 257) { const int c = moe_cnt(cnt, tid); val = (c + 255) >> 8; cntl[tid] = c; }
    __syncthreads();
    const int incl = wave_iscan_dpp(val);
    if (lane == 63) wtot[wave] = incl;
    __syncthreads();
    int off = 0;
#pragma unroll
    for (int w = 0; w < NW; ++w) off += (w < wave) ? wtot[w] : 0;
    if (tid < 257) pre[tid] = off + incl - val;
    if (tid == 256) pre[257] = off + incl;
    __syncthreads();
}
__device__ __forceinline__ int moe_find(LAS int* pre, int g) {
    const int lane = otid() & 63;
    const u32x4 q = *(LAS u32x4*)(pre + 4 * lane);
    const int c = ((int)q[0] <= g) + ((int)q[1] <= g) + ((int)q[2] <= g) + ((int)q[3] <= g);
    const int full = __builtin_popcountll(__ballot(c == 4));
    const int part = full < 64 ? __builtin_amdgcn_readlane(c, full < 64 ? full : 63) : 0;
    const int tail = (pre[256] <= g) ? 1 : 0;
    return 4 * full + part + tail - 1;
}

template <int MI>
__device__ __forceinline__ void moe1_unit(const Params& p, LAS char* L, int e, int r0, int rows, int j0) {
    const unsigned char* h8 = (const unsigned char*)(p.ws + WS_H8);
    const unsigned char* w8 = (const unsigned char*)(p.ws + WS_W8GU) + (size_t)e * 512 * 1024;
    const int* la = (const int*)(p.ws + WS_LA); const float* lw = (const float*)(p.ws + WS_LW);
    unsigned char* hb = (unsigned char*)(p.ws + WS_HB);
    LAS int* rowid = (LAS int*)(L + OFF_ROW);
    LAS float* roww = (LAS float*)(L + OFF_RW);
    {
        const int tid = otid();
        if (tid < 64 * MI) {
            const int rr = tid < rows ? tid : 0;
            rowid[tid] = (e < 256) ? la[(size_t)e * LISTCAP + r0 + rr] : (AR + r0 + rr);
            roww[tid] = (e < 256) ? lw[(size_t)e * LISTCAP + r0 + rr] : 0.5f;
        }
        __syncthreads();
    }
    auto arow = [&](int r) { const int a = rowid[r]; const int tok = (e < 256) ? (a >> 3) : (a - AR); return (unsigned)tok * Dm; };
    auto wrow = [&](int seg, int r) { return (unsigned)((r < 128) ? (j0 + r) : (128 + j0 + r)) * 1024u; };
    auto epi = [&](f32x16 (&acc)[MI][2], int seg, LAS char* Ls) {
        constexpr float us = 1.f / (H8SCALE * WGUSCALE);
        const f32x2 k1 = {-us * LOG2E, -us * LOG2E}, one2 = {1.f, 1.f};
        const int tid_ = otid(), wm_ = (tid_ >> 6) & 1, l31_ = tid_ & 31;
#pragma unroll
        for (int mi = 0; mi < MI; ++mi) {
            const float wk = roww[32 * MI * wm_ + 32 * mi + l31_] * (us * us * HBSCALE);
            const f32x2 k2 = {wk, wk};
#pragma unroll
            for (int r = 0; r < 16; r += 2) {
                const f32x2 g = {acc[mi][0][r], acc[mi][0][r + 1]}, u = {acc[mi][1][r], acc[mi][1][r + 1]};
                f32x2 t = g * k1;
                t.x = __builtin_amdgcn_exp2f(t.x); t.y = __builtin_amdgcn_exp2f(t.y);
                t = t + one2;
                f32x2 rc; rc.x = __builtin_amdgcn_rcpf(t.x); rc.y = __builtin_amdgcn_rcpf(t.y);
                const f32x2 h = (g * rc) * (u * k2);
                acc[mi][0][r] = h.x; acc[mi][0][r + 1] = h.y;
            }
        }
        store_tile_fp8<MI, 128>(Ls, acc, [&](int row, int c) -> unsigned char* { return row < rows ? hb + (size_t)rowid[row] * 256 + j0 + 16 * c : nullptr; });
    };
    gemm8_tile<MI, 1>(L, Dm / 128, h8, arow, w8, wrow, epi);
}
__device__ __forceinline__ void phase_moe1(const Params& p, LAS char* L) {
    const int v = vcu(), G = grid_g();
    const int* cnt = (const int*)(p.ws + WS_CTL);
    moe_prefix(p, L);
    LAS int* pre = (LAS int*)(L + OFF_PRE);
    const int total = __builtin_amdgcn_readfirstlane(pre[256]) * 2;
    for (int u = v; u < total; u += G) {
        const int g = u >> 1, j0 = (u & 1) * 128;
        const int e = __builtin_amdgcn_readfirstlane(moe_find(pre, g)), mt = g - __builtin_amdgcn_readfirstlane(pre[e]);
        const int rows = __builtin_amdgcn_readfirstlane(((LAS int*)(L + OFF_TL))[e]) - mt * 256;
        if (rows > 128) moe1_unit<4>(p, L, e, mt * 256, rows < 256 ? rows : 256, j0);
        else moe1_unit<2>(p, L, e, mt * 256, rows, j0);
    }
    unsigned* qctr = (unsigned*)(p.ws + WS_CTL + 2048) + 128;
    LAS unsigned* qslot = (LAS unsigned*)(L + OFF_MISC + 16);
    const int tid = otid();
    for (;;) {
        if (tid == 0) *qslot = __hip_atomic_fetch_add(qctr, 1u, __ATOMIC_RELAXED, __HIP_MEMORY_SCOPE_AGENT);
        __syncthreads();
        const int q = __builtin_amdgcn_readfirstlane((int)*qslot);
        __syncthreads();
        if (q >= (T / 128) * 2) break;
        moe1_unit<2>(p, L, 256, (q >> 1) * 128, 128, (q & 1) * 128);
    }
}

template <int MI>
__device__ __forceinline__ void moe2_unit(const Params& p, LAS char* L, int e, int r0, int rows, int n0) {
    const int* la = (const int*)(p.ws + WS_LA); const float* lw = (const float*)(p.ws + WS_LW);
    const unsigned char* hb = (const unsigned char*)(p.ws + WS_HB);
    unsigned char* yb = (unsigned char*)(p.ws + WS_YB);
    const unsigned char* w8 = (const unsigned char*)(p.ws + WS_W8D) + (size_t)e * 1024 * 256;
    LAS int* rowid = (LAS int*)(L + OFF_ROW);
    LAS float* roww = (LAS float*)(L + OFF_RW);
    {
        const int tid = otid();
        if (tid < 64 * MI) {
            const int rr = tid < rows ? tid : 0;
            rowid[tid] = (e < 256) ? la[(size_t)e * LISTCAP + r0 + rr] : (AR + r0 + rr);
        }
        __syncthreads();
    }
    auto arow = [&](int r) { return (unsigned)rowid[r] * 256u; };
    auto wrow = [&](int seg, int r) { return (unsigned)(n0 + seg * 256 + r) * 256u; };
    auto epi = [&](f32x16 (&acc)[MI][2], int seg, LAS char* Ls) {
        store_tile_fp8<MI>(Ls, acc, [&](int row, int c) -> unsigned char* { return row < rows ? yb + (size_t)rowid[row] * Dm + n0 + seg * 256 + 16 * c : nullptr; });
    };
    static_assert(YSCALE * 128.f == HBSCALE * WDSCALE, "MFMA scale exponent below assumes YSCALE / (HBSCALE * WDSCALE) = 2^-7");
    gemm8_tile<MI, 0, 2>(L, 256 / 128, hb, arow, w8, wrow, epi, (e < 256) ? 0x78787878 : 0x79797979);
}
__device__ __forceinline__ void phase_moe2(const Params& p, LAS char* L) {
    const int v = vcu(), G = grid_g();
    const int* cnt = (const int*)(p.ws + WS_CTL);
    LAS int* pre = (LAS int*)(L + OFF_PRE);
    const int total = __builtin_amdgcn_readfirstlane(pre[256]) * 2;
    for (int u = v; u < total; u += G) {
        const int g = u >> 1, n0 = (u & 1) * 512;
        const int e = __builtin_amdgcn_readfirstlane(moe_find(pre, g)), mt = g - __builtin_amdgcn_readfirstlane(pre[e]);
        const int rows = __builtin_amdgcn_readfirstlane(((LAS int*)(L + OFF_TL))[e]) - mt * 256;
        if (rows > 128) moe2_unit<4>(p, L, e, mt * 256, rows < 256 ? rows : 256, n0);
        else moe2_unit<2>(p, L, e, mt * 256, rows, n0);
    }
    unsigned* qctr = (unsigned*)(p.ws + WS_CTL + 2048) + 192;
    LAS unsigned* qslot = (LAS unsigned*)(L + OFF_MISC + 16);
    const int tid = otid();
    for (;;) {
        if (tid == 0) *qslot = __hip_atomic_fetch_add(qctr, 1u, __ATOMIC_RELAXED, __HIP_MEMORY_SCOPE_AGENT);
        __syncthreads();
        const int q = __builtin_amdgcn_readfirstlane((int)*qslot);
        __syncthreads();
        if (q >= (T / 128) * 2) break;
        moe2_unit<2>(p, L, 256, (q >> 1) * 128, 128, (q & 1) * 512);
    }
}

__device__ __forceinline__ void phase_final(const Params& p) {
    const int v = vcu(), G = grid_g();
    const int tid = otid(), lane = tid & 63, wave = tid >> 6;
    const float* pg = p.in[19];
    const float* mod = (const float*)(p.ws + WS_MOD);
    const unsigned char* yb = (const unsigned char*)(p.ws + WS_YB);
    const bf16_t* x1b = (const bf16_t*)(p.ws + WS_H1);
    const int col = 16 * lane, step = G * NW;
    f32x4 gpg[4];
#pragma unroll
    for (int hq = 0; hq < 4; ++hq) gpg[hq] = *(const f32x4*)(pg + col + 4 * hq);
    u32x4 ry[9], rx[2]; f32x4 rg[4];
#define F_LOAD(TT) do { \
        _Pragma("unroll") for (int k = 0; k < 9; ++k) { const size_t row_ = (k < 8) ? ((size_t)(TT) * TOPK + k) : ((size_t)AR + (TT)); ry[k] = *(const u32x4*)(yb + row_ * Dm + 16 * lane); } \
        rx[0] = *(const u32x4*)(x1b + (size_t)(TT) * Dm + col); rx[1] = *(const u32x4*)(x1b + (size_t)(TT) * Dm + col + 8); \
        { const float* gf_ = mod + ((TT) / SEQ) * 6144 + 5120; _Pragma("unroll") for (int hq = 0; hq < 4; ++hq) rg[hq] = *(const f32x4*)(gf_ + col + 4 * hq); } } while (0)
    int t = v * NW + wave;
    if (t < T) F_LOAD(t);
    for (; t < T; t += step) {
        float y[16];
#pragma unroll
        for (int e = 0; e < 16; ++e) y[e] = 0.f;
#pragma unroll
        for (int k = 0; k < 9; ++k) {
#pragma unroll
            for (int e = 0; e < 4; ++e) {
                const f32x2 a = __builtin_amdgcn_cvt_pk_f32_fp8((int)ry[k][e], false), c = __builtin_amdgcn_cvt_pk_f32_fp8((int)ry[k][e], true);
                y[4 * e] += a.x; y[4 * e + 1] += a.y; y[4 * e + 2] += c.x; y[4 * e + 3] += c.y;
            }
        }
        const u32x4 xa = rx[0], xb = rx[1]; f32x4 gg[4];
#pragma unroll
        for (int hq = 0; hq < 4; ++hq) gg[hq] = rg[hq];
        const int tn = t + step;
        if (tn < T) F_LOAD(tn);
        float ss = 0.f;
#pragma unroll
        for (int e = 0; e < 16; ++e) { y[e] *= (1.f / YSCALE); ss += y[e] * y[e]; }
        ss = wave_fsum_dpp(ss);
        const float rstd = rsqrtf(ss * (1.f / Dm) + 1e-6f);
#pragma unroll
        for (int hq = 0; hq < 4; ++hq) {
            const unsigned w0 = (hq < 2) ? xa[2 * hq] : xb[2 * (hq - 2)], w1 = (hq < 2) ? xa[2 * hq + 1] : xb[2 * (hq - 2) + 1];
            f32x4 xo = {bflo(w0), bfhi(w0), bflo(w1), bfhi(w1)};
#pragma unroll
            for (int e = 0; e < 4; ++e) xo[e] += gg[hq][e] * (y[4 * hq + e] * rstd * gpg[hq][e]);
            *(f32x4*)(p.out + (size_t)t * Dm + col + 4 * hq) = xo;
        }
    }
#undef F_LOAD
}

#define XB_TMO      128
#define XB_XCNT(j)  (256  + 64 * (j))
#define XB_XSUB(j)  (1280 + 64 * (j))
#define XB_XGEN(j)  (2304 + 64 * (j))
#define XB_TOP      3328
#define XB_TOPGEN   3392
#define XCD_BAR_WORDS 3456
#define XB_SPIN_CAP (1u << 18)
__device__ __forceinline__ unsigned xb_ld(unsigned* p)              { return __hip_atomic_load(p, __ATOMIC_RELAXED, __HIP_MEMORY_SCOPE_AGENT); }
__device__ __forceinline__ unsigned xb_add(unsigned* p, unsigned v) { return __hip_atomic_fetch_add(p, v, __ATOMIC_RELAXED, __HIP_MEMORY_SCOPE_AGENT); }
__device__ __forceinline__ unsigned xb_xcc_id() { return (unsigned)__builtin_amdgcn_s_getreg((3 << 11) | 20) & 0xFu; }
#define XB_SPIN(cond, bar) do { unsigned _sp = 0; while (cond) { __builtin_amdgcn_s_sleep(1); \
    if ((++_sp & 255u) == 0u) { if (xb_ld(&(bar)[XB_TMO])) break; if (_sp > XB_SPIN_CAP) { atomicAdd(&(bar)[XB_TMO], 1u); break; } } } } while (0)
struct XcdBarrier { unsigned* bar; unsigned x; volatile LAS unsigned* st; };
__device__ __forceinline__ XcdBarrier xcd_barrier_post(unsigned* bar, volatile LAS unsigned* st) {
    XcdBarrier b; b.bar = bar; b.x = xb_xcc_id(); b.st = st;
    if (threadIdx.x == 0) (void)xb_add(&bar[XB_XCNT(b.x)], 1u);
    return b;
}
__device__ __forceinline__ void xcd_barrier_complete(unsigned* bar, unsigned x, unsigned& nloc, unsigned& nx) {
    const unsigned G = gridDim.x * gridDim.y * gridDim.z;
    unsigned sum, cnt, mine, sp = 0u;
    for (;;) {
        sum = 0u; cnt = 0u; mine = 0u;
#pragma unroll
        for (unsigned j = 0; j < 16; ++j) { const unsigned c = xb_ld(&bar[XB_XCNT(j)]); sum += c; cnt += (c > 0u) ? 1u : 0u; mine = (j == x) ? c : mine; }
        if (sum == G) break;
        __builtin_amdgcn_s_sleep(1);
        if ((++sp & 255u) == 0u) { if (xb_ld(&bar[XB_TMO])) break; if (sp > XB_SPIN_CAP) { atomicAdd(&bar[XB_TMO], 1u); break; } }
    }
    nloc = mine > 0u ? mine : 1u; nx = cnt > 0u ? cnt : 1u;
}
__device__ __forceinline__ void xcd_barrier(const Params& p, LAS char* L) {
    XcdBarrier b; b.bar = (unsigned*)(p.ws + WS_CTL + 4096); b.x = xb_xcc_id(); b.st = (volatile LAS unsigned*)(L + OFF_MISC);
    asm volatile("s_waitcnt vmcnt(0)" ::: "memory");
    __syncthreads();
    if (threadIdx.x == 0) {
        unsigned* bar = b.bar;
        __builtin_amdgcn_s_waitcnt(0);
        unsigned nloc = b.st[0], nx = b.st[1];
        if (nloc == 0u) { xcd_barrier_complete(bar, b.x, nloc, nx); b.st[0] = nloc; b.st[1] = nx; }
        const unsigned old = xb_add(&bar[XB_XSUB(b.x)], 1u);
        const unsigned gen = old / nloc;
        if (old + 1u == (gen + 1u) * nloc) {
            __builtin_amdgcn_fence(__ATOMIC_RELEASE, "agent");
            asm volatile("s_waitcnt vmcnt(0)" ::: "memory");
            const unsigned og = xb_add(&bar[XB_TOP], 1u);
            const unsigned tg = og / nx;
            if (og + 1u == (tg + 1u) * nx) xb_add(&bar[XB_TOPGEN], 1u);
            else XB_SPIN(xb_ld(&bar[XB_TOPGEN]) == tg, bar);
            __builtin_amdgcn_fence(__ATOMIC_ACQUIRE, "agent");
            xb_add(&bar[XB_XGEN(b.x)], 1u);
            asm volatile("s_waitcnt vmcnt(0)" ::: "memory");
        } else {
            XB_SPIN(xb_ld(&bar[XB_XGEN(b.x)]) == gen, bar);
            __builtin_amdgcn_fence(__ATOMIC_ACQUIRE, "agent");
            asm volatile("s_waitcnt vmcnt(0)" ::: "memory");
        }
    }
    __syncthreads();
}

__device__ __forceinline__ bool xcd_barrier_arrive(const Params& p, LAS char* L) {
    unsigned* bar = (unsigned*)(p.ws + WS_CTL + 4096); const unsigned x = xb_xcc_id(); volatile LAS unsigned* st = (volatile LAS unsigned*)(L + OFF_MISC);
    asm volatile("s_waitcnt vmcnt(0)" ::: "memory");
    __syncthreads();
    if (threadIdx.x == 0) {
        __builtin_amdgcn_s_waitcnt(0);
        unsigned nloc = st[0], nx = st[1];
        if (nloc == 0u) { xcd_barrier_complete(bar, x, nloc, nx); st[0] = nloc; st[1] = nx; }
        const unsigned old = xb_add(&bar[XB_XSUB(x)], 1u);
        const unsigned gen = old / nloc;
        if (old + 1u == (gen + 1u) * nloc) {
            __builtin_amdgcn_fence(__ATOMIC_RELEASE, "agent");
            asm volatile("s_waitcnt vmcnt(0)" ::: "memory");
            const unsigned og = xb_add(&bar[XB_TOP], 1u);
            const unsigned tg = og / nx;
            if (og + 1u == (tg + 1u) * nx) xb_add(&bar[XB_TOPGEN], 1u);
            else XB_SPIN(xb_ld(&bar[XB_TOPGEN]) == tg, bar);
            __builtin_amdgcn_fence(__ATOMIC_ACQUIRE, "agent");
            xb_add(&bar[XB_XGEN(x)], 1u);
            asm volatile("s_waitcnt vmcnt(0)" ::: "memory");
            st[2] = 0u;
        } else { st[2] = 1u; st[3] = gen; }
    }
    __syncthreads();
    return st[2] == 0u;
}
__device__ __forceinline__ void xcd_barrier_wait(const Params& p, LAS char* L) {
    unsigned* bar = (unsigned*)(p.ws + WS_CTL + 4096); const unsigned x = xb_xcc_id(); volatile LAS unsigned* st = (volatile LAS unsigned*)(L + OFF_MISC);
    __syncthreads();
    if (threadIdx.x == 0) {
        const unsigned gen = st[3];
        XB_SPIN(xb_ld(&bar[XB_XGEN(x)]) == gen, bar);
        __builtin_amdgcn_fence(__ATOMIC_ACQUIRE, "agent");
        asm volatile("s_waitcnt vmcnt(0)" ::: "memory");
        st[2] = 0u;
    }
    __syncthreads();
}

__global__ void __launch_bounds__(NT, 2) mega(Params p) {
    extern __shared__ __attribute__((aligned(16))) char smem[];
    LAS char* L = (LAS char*)smem;
    asm volatile("s_setreg_imm32_b32 hwreg(HW_REG_MODE, 23, 1), 1");
    if (threadIdx.x < 8) ((LAS unsigned*)(L + OFF_MISC))[threadIdx.x] = 0u;
    __syncthreads();
    (void)xcd_barrier_post((unsigned*)(p.ws + WS_CTL + 4096), (volatile LAS unsigned*)(L + OFF_MISC));
    phase_mod(p, L);
    xcd_barrier(p, L);
    phase_h1(p);
    xcd_barrier(p, L);
    phase_proj(p, L);
    xcd_barrier(p, L);
    phase_qkv(p, L);
    phase_attn(p, L);
    xcd_barrier(p, L);
    phase_oproj(p, L);
    xcd_barrier(p, L);
    phase_router_route(p, L);
    xcd_barrier(p, L);
    phase_moe1(p, L);
    xcd_barrier(p, L);
    phase_moe2(p, L);
    xcd_barrier(p, L);
    phase_final(p);
}

extern "C" void kernel_launch(void* const* d_in, const int* in_sizes, int n_in, void* d_out, int out_size, void* d_ws, size_t ws_size, hipStream_t stream) {
    static int grid_blocks = 0;
    if (grid_blocks == 0) {
        if (n_in != 28 || out_size != T * Dm || ws_size < WS_END) {
            fprintf(stderr, "kernel_launch: unexpected problem (n_in %d, out %d, ws %zu); nothing launched\n", n_in, out_size, ws_size);
            grid_blocks = -1; return;
        }
        int dev = 0, cus = 0, per_cu = 0;
        (void)hipGetDevice(&dev);
        (void)hipDeviceGetAttribute(&cus, hipDeviceAttributeMultiprocessorCount, dev);
        if (hipFuncSetAttribute((const void*)mega, hipFuncAttributeMaxDynamicSharedMemorySize, LDS_BYTES) != hipSuccess) {
            fprintf(stderr, "kernel_launch: hipFuncSetAttribute(%d B LDS) failed\n", LDS_BYTES); grid_blocks = -1; return;
        }
        (void)hipOccupancyMaxActiveBlocksPerMultiprocessor(&per_cu, mega, NT, LDS_BYTES);
        if (per_cu < 1) { fprintf(stderr, "kernel_launch: occupancy query says %d blocks per CU\n", per_cu); per_cu = 1; }
        grid_blocks = cus;
        fprintf(stderr, "kernel_launch: %d CUs, occupancy query %d per CU, grid %d\n", cus, per_cu, grid_blocks);
    }
    if (grid_blocks < 0) return;
    (void)hipMemsetAsync((char*)d_ws + WS_CTL, 0, CTL_BYTES, stream);
    Params p{};
    for (int i = 0; i < 28; ++i) p.in[i] = (const float*)d_in[i];
    p.out = (float*)d_out; p.ws = (char*)d_ws;
    void* args[] = {&p};
    hipError_t e = hipLaunchCooperativeKernel((void*)mega, dim3(grid_blocks), dim3(NT), args, LDS_BYTES, stream);
    if (e != hipSuccess) fprintf(stderr, "cooperative launch failed: %s (grid %d)\n", hipGetErrorString(e), grid_blocks);
}
```
